# Optimizing an MI355X kernel written in HIP

```python
import jax, jax.numpy as jnp
from jax import lax
import numpy as np

D_MODEL = 1024
BATCH = 16
SEQ = 2048
DEPTH = 4

GRID_W = 64
CTX_LEN = 256

MLA_HEADS = 8
MLA_Q_LORA = 384
MLA_KV_LORA = 256
MLA_NOPE = 64
MLA_ROPE = 32
MLA_V = 64
MLA_WIDTH = MLA_HEADS * MLA_V
ROPE_BASE = 10000.0
Q_BLOCK = 128

CONV_WIDTH = 512
CONV_K = 3

RW_HEADS = 8
RW_HEAD = 64
RW_WIDTH = RW_HEADS * RW_HEAD
RW_DECAY_LORA = 64
RW_ICLR_LORA = 64
RW_GATE_LORA = 128
RW_GN_EPS = 64e-5
RW_IN = 3 * RW_WIDTH + 2 * RW_DECAY_LORA + 2 * RW_ICLR_LORA + RW_GATE_LORA

N_BRANCH = 3
IN_SPLITS = (MLA_Q_LORA, MLA_KV_LORA, MLA_ROPE, CONV_WIDTH, CONV_WIDTH, CONV_WIDTH, RW_IN, N_BRANCH * D_MODEL)
D_IN = MLA_Q_LORA + MLA_KV_LORA + MLA_ROPE + 3 * CONV_WIDTH + RW_IN + N_BRANCH * D_MODEL

D_FF = -(-(8 * D_MODEL) // (3 * 256)) * 256

LN_EPS = 1e-5
RMS_EPS = 1e-6

kernel_name = "hybrid_mla_conv_rwkv7_dit_prefix"

F32 = jnp.float32


def _split(x, sizes):
    offs = np.cumsum(sizes)[:-1].tolist()
    return jnp.split(x, offs, axis=-1)


def layer_norm(x, g, b):
    xf = x.astype(F32)
    mu = jnp.mean(xf, -1, keepdims=True)
    var = jnp.mean(jnp.square(xf - mu), -1, keepdims=True)
    return ((xf - mu) * lax.rsqrt(var + LN_EPS) * g + b).astype(x.dtype)


def rms_norm(x, g):
    xf = x.astype(F32)
    return (xf * lax.rsqrt(jnp.mean(jnp.square(xf), -1, keepdims=True) + RMS_EPS) * g).astype(x.dtype)


def modulate(x, shift, scale):
    return x * (1.0 + scale) + shift


def axial_rope_angles(seq_len):
    rows = seq_len // GRID_W
    row = jnp.repeat(jnp.arange(rows), GRID_W).astype(F32)
    col = jnp.tile(jnp.arange(GRID_W), rows).astype(F32)
    axis_dim = MLA_ROPE // 2
    inv = ROPE_BASE ** (-jnp.arange(0, axis_dim, 2, dtype=F32) / axis_dim)
    return row[:, None] * inv, col[:, None] * inv


def _rot(x, ang):
    x1, x2 = jnp.split(x, 2, axis=-1)
    cos, sin = jnp.cos(ang).astype(x.dtype), jnp.sin(ang).astype(x.dtype)
    return jnp.concatenate([x1 * cos - x2 * sin, x1 * sin + x2 * cos], axis=-1)


def axial_rope(x, ang_row, ang_col):
    extra = (1,) * (x.ndim - 3)
    ar = ang_row.reshape(ang_row.shape[0], *extra, ang_row.shape[-1])
    ac = ang_col.reshape(ang_col.shape[0], *extra, ang_col.shape[-1])
    xr, xc = jnp.split(x, 2, axis=-1)
    return jnp.concatenate([_rot(xr, ar), _rot(xc, ac)], axis=-1)


def mla_project(cq, ckv, krope, q_norm, w_uq, kv_norm, w_ukv, angles):
    B, T, _ = cq.shape
    q = (rms_norm(cq, q_norm) @ w_uq).reshape(B, T, MLA_HEADS, MLA_NOPE + MLA_ROPE)
    kv = (rms_norm(ckv, kv_norm) @ w_ukv).reshape(B, T, MLA_HEADS, MLA_NOPE + MLA_V)
    q_nope, q_rope = q[..., :MLA_NOPE], q[..., MLA_NOPE:]
    k_nope, v = kv[..., :MLA_NOPE], kv[..., MLA_NOPE:]
    if angles is not None:
        q_rope = axial_rope(q_rope, *angles)
        krope = axial_rope(krope, *angles)
    k_rope = jnp.broadcast_to(krope[:, :, None, :], (B, T, MLA_HEADS, MLA_ROPE))
    return (jnp.concatenate([q_nope, q_rope], -1), jnp.concatenate([k_nope, k_rope], -1), v)


def attention(q, k, v):
    s = jnp.einsum('bqhd,bkhd->bhqk', q, k, preferred_element_type=F32) * (MLA_NOPE + MLA_ROPE) ** -0.5
    p = jax.nn.softmax(s, axis=-1).astype(v.dtype)
    return jnp.einsum('bhqk,bkhd->bqhd', p, v)


def blocked_attention(q, k, v):
    B, T, H, D = q.shape
    nb = T // Q_BLOCK
    qb = q.reshape(B, nb, Q_BLOCK, H, D).swapaxes(0, 1)
    ob = lax.map(lambda qi: attention(qi, k, v), qb)
    return ob.swapaxes(0, 1).reshape(B, T, H * v.shape[-1])


def _pad_seq(u):
    return jnp.pad(u, ((0, 0), (1, 1), (0, 0)))


def short_conv(h, gate_b, gate_c, w):
    up = _pad_seq(gate_c * h)
    return gate_b * (up[:, :-2] * w[0] + up[:, 1:-1] * w[1] + up[:, 2:] * w[2])


def _heads(t):
    return t.reshape(*t.shape[:-1], RW_HEADS, RW_HEAD)


def rwkv_features(part, mu, w0, w_up, a0, a_up, g_up, k_k, k_a):
    B, T, _ = part.shape
    up = _pad_seq(part)
    part = part + (0.5 * (up[:, :-2] + up[:, 2:]) - part) * mu
    r, k, v, wd, ad, gd = _split(part, (RW_WIDTH, RW_WIDTH, RW_WIDTH, 2 * RW_DECAY_LORA, 2 * RW_ICLR_LORA, RW_GATE_LORA))
    wd = wd.reshape(B, T, 2, RW_DECAY_LORA)
    ad = ad.reshape(B, T, 2, RW_ICLR_LORA)
    w_log = -jax.nn.softplus(-(w0 + jnp.einsum('btzl,zlc->btzc', jnp.tanh(wd), w_up))) - 0.5
    decay = jnp.exp(-jnp.exp(w_log.astype(F32)))
    a = jax.nn.sigmoid(a0 + jnp.einsum('btzl,zlc->btzc', ad, a_up))
    g = jax.nn.sigmoid(gd) @ g_up
    kkf = _heads(k * k_k).astype(F32)
    kk = kkf * lax.rsqrt(jnp.maximum(jnp.sum(jnp.square(kkf), -1, keepdims=True), 1e-24))
    k_dir = k[:, :, None, :] * (1.0 + (a - 1.0) * k_a)
    return (r, k, v, g, kk, decay, a, k_dir)


def wkv_scan(state, r, w, k, v, kk, a, reverse):
    xs = tuple(jnp.moveaxis(t.astype(F32), 1, 0) for t in (r, w, k, v, kk, a))

    def step(S, inp):
        r_t, w_t, k_t, v_t, kk_t, a_t = inp
        s_kk = jnp.einsum('bhvk,bhk->bhv', S, kk_t)
        S = S * w_t[:, :, None, :] - s_kk[..., None] * (kk_t * a_t)[:, :, None, :] + v_t[..., None] * k_t[:, :, None, :]
        return S, jnp.einsum('bhvk,bhk->bhv', S, r_t)

    S, ys = lax.scan(step, state, xs, reverse=reverse)
    return S, jnp.moveaxis(ys, 0, 1)


def wkv_direction(state, feats, z, reverse):
    r, k, v, g, kk, decay, a, k_dir = feats
    return wkv_scan(state, _heads(r), _heads(decay[:, :, z]), _heads(k_dir[:, :, z]), _heads(v), kk,
                    _heads(a[:, :, z]), reverse)


def rwkv_readout(y, feats, r_k, gn_g, gn_b):
    r, k, v, g = feats[:4]
    B, T = r.shape[:2]
    mu = jnp.mean(y, -1, keepdims=True)
    var = jnp.mean(jnp.square(y - mu), -1, keepdims=True)
    yn = ((y - mu) * lax.rsqrt(var + RW_GN_EPS)).reshape(B, T, RW_WIDTH) * gn_g + gn_b
    bonus = jnp.sum(_heads(r * k * r_k).astype(F32), -1, keepdims=True) * _heads(v).astype(F32)
    return ((yn + bonus.reshape(B, T, RW_WIDTH)) * g).astype(r.dtype)


def gated_merge(gate_logits, br_a, br_b, br_c):
    gates = jax.nn.sigmoid(gate_logits).reshape(*gate_logits.shape[:-1], N_BRANCH, D_MODEL)
    return gates[..., 0, :] * br_a + gates[..., 1, :] * br_b + gates[..., 2, :] * br_c


def swiglu(h, w13, w2):
    u, gt = jnp.split(h @ w13, 2, axis=-1)
    return (jax.nn.silu(u) * gt) @ w2


def setup_inputs(seed: int = 0) -> dict:
    key = jax.random.key(seed)
    ks = iter(jax.random.split(key, 40))
    L, D = DEPTH, D_MODEL
    beta = (8.0 * DEPTH) ** -0.25

    def nrm(shape, scale):
        return jax.random.normal(next(ks), shape, F32) * scale

    return {
        "x": nrm((BATCH, SEQ, D), 1.0),
        "c": nrm((BATCH, D), 1.0),
        "ctx": nrm((BATCH, CTX_LEN, D), 1.0),
        "c_ctx": nrm((D,), 1.0),
        "mod_w": nrm((L, D, 6 * D), 0.5 * D ** -0.5),
        "mod_b": nrm((L, 6 * D), 0.02),
        "w_in": nrm((L, D, D_IN), D ** -0.5),
        "q_norm": 1.0 + nrm((L, MLA_Q_LORA), 0.02),
        "w_uq": nrm((L, MLA_Q_LORA, MLA_HEADS * (MLA_NOPE + MLA_ROPE)), MLA_Q_LORA ** -0.5),
        "kv_norm": 1.0 + nrm((L, MLA_KV_LORA), 0.02),
        "w_ukv": nrm((L, MLA_KV_LORA, MLA_HEADS * (MLA_NOPE + MLA_V)), MLA_KV_LORA ** -0.5),
        "w_o_attn": nrm((L, MLA_WIDTH, D), MLA_WIDTH ** -0.5),
        "conv_w": nrm((L, CONV_K, CONV_WIDTH), CONV_K ** -0.5),
        "w_o_conv": nrm((L, CONV_WIDTH, D), CONV_WIDTH ** -0.5),
        "rw_mu": jax.random.uniform(next(ks), (L, RW_IN), F32),
        "rw_w0": jax.random.uniform(next(ks), (L, 2, RW_WIDTH), F32, -6.0, 1.0),
        "rw_w_up": nrm((L, 2, RW_DECAY_LORA, RW_WIDTH), 0.1),
        "rw_a0": nrm((L, 2, RW_WIDTH), 0.5),
        "rw_a_up": nrm((L, 2, RW_ICLR_LORA, RW_WIDTH), RW_ICLR_LORA ** -0.5),
        "rw_g_up": nrm((L, RW_GATE_LORA, RW_WIDTH), RW_GATE_LORA ** -0.5),
        "rw_k_k": 0.85 + nrm((L, RW_WIDTH), 0.02),
        "rw_k_a": 1.0 + nrm((L, RW_WIDTH), 0.02),
        "rw_r_k": nrm((L, RW_WIDTH), 0.1),
        "rw_gn_g": 1.0 + nrm((L, RW_WIDTH), 0.02),
        "rw_gn_b": nrm((L, RW_WIDTH), 0.02),
        "w_o_rwkv": nrm((L, RW_WIDTH, D), RW_WIDTH ** -0.5),
        "w_out": nrm((L, D, D), beta * D ** -0.5),
        "ln1_g": 1.0 + nrm((L, D), 0.02),
        "ln1_b": nrm((L, D), 0.02),
        "ffn_w13": nrm((L, D, 2 * D_FF), D ** -0.5),
        "ffn_w2": nrm((L, D_FF, D), beta * D_FF ** -0.5),
        "ln2_g": 1.0 + nrm((L, D), 0.02),
        "ln2_b": nrm((L, D), 0.02),
    }


def reference(x, c, ctx, c_ctx, mod_w, mod_b, w_in, q_norm, w_uq, kv_norm, w_ukv, w_o_attn,
              conv_w, w_o_conv, rw_mu, rw_w0, rw_w_up, rw_a0, rw_a_up, rw_g_up, rw_k_k, rw_k_a,
              rw_r_k, rw_gn_g, rw_gn_b, w_o_rwkv, w_out, ln1_g, ln1_b, ffn_w13, ffn_w2, ln2_g, ln2_b):
    B, T, _ = x.shape
    angles = axial_rope_angles(T)
    alpha = (2.0 * DEPTH) ** 0.25
    s_lat = jax.nn.silu(c)
    s_ctx = jax.nn.silu(c_ctx)
    xc = ctx
    for l in range(DEPTH):
        last = l == DEPTH - 1
        sh1, sc1, g1, sh2, sc2, g2 = jnp.split((s_lat @ mod_w[l] + mod_b[l])[:, None, :], 6, axis=-1)
        csh1, csc1, cg1, csh2, csc2, cg2 = jnp.split(s_ctx @ mod_w[l] + mod_b[l], 6, axis=-1)

        cq_l, ckv_l, kr_l, ch_l, cb_l, cc_l, rw_l, gt_l = _split(modulate(x, sh1, sc1) @ w_in[l], IN_SPLITS)
        cq_c, ckv_c, kr_c, ch_c, cb_c, cc_c, rw_c, gt_c = _split(modulate(xc, csh1, csc1) @ w_in[l], IN_SPLITS)

        q_l, k_l, v_l = mla_project(cq_l, ckv_l, kr_l, q_norm[l], w_uq[l], kv_norm[l], w_ukv[l], angles)
        q_c, k_c, v_c = mla_project(cq_c, ckv_c, kr_c, q_norm[l], w_uq[l], kv_norm[l], w_ukv[l], None)
        att_l = blocked_attention(q_l, jnp.concatenate([k_c, k_l], 1), jnp.concatenate([v_c, v_l], 1))

        rw_par = (rw_mu[l], rw_w0[l], rw_w_up[l], rw_a0[l], rw_a_up[l], rw_g_up[l], rw_k_k[l], rw_k_a[l])
        feats_c = rwkv_features(rw_c, *rw_par)
        feats_l = rwkv_features(rw_l, *rw_par)
        zero_state = jnp.zeros((B, RW_HEADS, RW_HEAD, RW_HEAD), F32)
        sf_c, yf_c = wkv_direction(zero_state, feats_c, 0, False)
        sb_c, yb_c = wkv_direction(zero_state, feats_c, 1, True)
        _, yf_l = wkv_direction(sf_c, feats_l, 0, False)
        _, yb_l = wkv_direction(sb_c, feats_l, 1, True)
        rwo_l = rwkv_readout(yf_l + yb_l, feats_l, rw_r_k[l], rw_gn_g[l], rw_gn_b[l])

        o_l = gated_merge(gt_l, att_l @ w_o_attn[l],
                          short_conv(ch_l, cb_l, cc_l, conv_w[l]) @ w_o_conv[l],
                          rwo_l @ w_o_rwkv[l]) @ w_out[l]
        x_new = layer_norm(alpha * x + g1 * o_l, ln1_g[l], ln1_b[l])
        x_new = layer_norm(alpha * x_new + g2 * swiglu(modulate(x_new, sh2, sc2), ffn_w13[l], ffn_w2[l]),
                           ln2_g[l], ln2_b[l])

        if not last:
            att_c = attention(q_c, k_c, v_c).reshape(B, xc.shape[1], MLA_WIDTH)
            rwo_c = rwkv_readout(yf_c + yb_c, feats_c, rw_r_k[l], rw_gn_g[l], rw_gn_b[l])
            o_c = gated_merge(gt_c, att_c @ w_o_attn[l],
                              short_conv(ch_c, cb_c, cc_c, conv_w[l]) @ w_o_conv[l],
                              rwo_c @ w_o_rwkv[l]) @ w_out[l]
            xc_new = layer_norm(alpha * xc + cg1 * o_c, ln1_g[l], ln1_b[l])
            xc = layer_norm(alpha * xc_new + cg2 * swiglu(modulate(xc_new, csh2, csc2), ffn_w13[l], ffn_w2[l]),
                            ln2_g[l], ln2_b[l])
        x = x_new
    return x
```

```cpp
#include <hip/hip_runtime.h>
#include <hip/hip_cooperative_groups.h>
#include <cstdio>
#include <cstdint>
namespace cg = cooperative_groups;

typedef unsigned short bf16_t;
typedef short bf16x8 __attribute__((ext_vector_type(8)));
typedef float f32x4 __attribute__((ext_vector_type(4)));

#ifndef PROBE_MASK
#define PROBE_MASK 0
#endif
constexpr int BATCH = 16, SEQ = 2048, CTXL = 256, DM = 1024, DEPTH = 4, DFF = 2816, DIN = 7200;
constexpr int TPB = SEQ + CTXL;
constexpr int MROWS = BATCH * TPB;
constexpr int NTHREADS = 512;
constexpr int LDS_BYTES = 152 * 1024;
constexpr float ALPHA = 1.681792830507429f;
constexpr float QSCALE = 0.10206207261596575f * 1.4426950408889634f;

constexpr size_t WO_IN = 0;
constexpr size_t WO_UQ = WO_IN + (size_t)7296 * 1024;
constexpr size_t WO_UKV = WO_UQ + (size_t)768 * 384;
constexpr size_t WO_OA = WO_UKV + (size_t)1024 * 256;
constexpr size_t WO_OC = WO_OA + (size_t)1024 * 512;
constexpr size_t WO_OR = WO_OC + (size_t)1024 * 512;
constexpr size_t WO_OUT = WO_OR + (size_t)1024 * 512;
constexpr size_t WO_13 = WO_OUT + (size_t)1024 * 1024;
constexpr size_t WO_2 = WO_13 + (size_t)5632 * 1024;
constexpr size_t WO_UP = WO_2 + (size_t)1024 * 2816;
constexpr size_t WO_AUP = WO_UP + (size_t)2 * 512 * 64;
constexpr size_t WO_GUP = WO_AUP + (size_t)2 * 512 * 64;
constexpr size_t W_ELEMS = WO_GUP + (size_t)512 * 128;

constexpr size_t al256(size_t x) { return (x + 255) & ~(size_t)255; }
constexpr size_t OFF_BAR = 0;
constexpr size_t OFF_W = 1024;
constexpr size_t OFF_MODV = al256(OFF_W + W_ELEMS * 2);
constexpr size_t OFF_ROPE = al256(OFF_MODV + (size_t)4 * 17 * 6144 * 4);
constexpr size_t OFF_RSQ = al256(OFF_ROPE + 64 * 8 * 2 * 4);
constexpr size_t OFF_RSKV = al256(OFF_RSQ + (size_t)MROWS * 4);
constexpr size_t OFF_STATS = al256(OFF_RSKV + (size_t)MROWS * 4);
constexpr size_t OFF_XC = al256(OFF_STATS + (size_t)MROWS * 8);
constexpr size_t OFF_R1 = al256(OFF_XC + (size_t)BATCH * CTXL * DM * 4);
constexpr size_t OFF_R2 = al256(OFF_R1 + (size_t)MROWS * 672 * 2);
constexpr size_t OFF_R3 = OFF_R2 + (size_t)MROWS * 1536 * 2;
constexpr size_t OFF_R4 = al256(OFF_R3 + (size_t)MROWS * 1920 * 2);
constexpr size_t OFF_R5 = al256(OFF_R4 + (size_t)MROWS * (512 + 512 + 32) * 2);
constexpr size_t OFF_R6 = al256(OFF_R5 + (size_t)MROWS * 512 * 2);
constexpr size_t WS_END = al256(OFF_R6 + (size_t)MROWS * 1024 * 2);
constexpr size_t OFF_Q = OFF_R2;
constexpr size_t OFF_YF = OFF_R2 + (size_t)MROWS * 768 * 2;
constexpr size_t OFF_SG = OFF_YF + (size_t)MROWS * 512 * 2;
constexpr size_t OFF_YB = OFF_R1;
constexpr size_t OFF_KN = OFF_R4;
constexpr size_t OFF_VT = OFF_R4 + (size_t)MROWS * 512 * 2;
constexpr size_t OFF_KR = OFF_VT + (size_t)MROWS * 512 * 2;
constexpr size_t OFF_RWO = OFF_R4;
constexpr size_t OFF_MRG = OFF_R3;
constexpr size_t OFF_HF = OFF_R2;
static_assert(OFF_SG + (size_t)MROWS * 128 * 2 <= OFF_R3, "R2 overlay overflow");
static_assert((size_t)MROWS * 2816 * 2 <= OFF_R4 - OFF_R2, "HF overflow");

struct Params {
    const float *x, *c, *ctx, *c_ctx, *mod_w, *mod_b, *w_in, *q_norm, *w_uq, *kv_norm, *w_ukv, *w_o_attn,
        *conv_w, *w_o_conv, *rw_mu, *rw_w0, *rw_w_up, *rw_a0, *rw_a_up, *rw_g_up, *rw_k_k, *rw_k_a,
        *rw_r_k, *rw_gn_g, *rw_gn_b, *w_o_rwkv, *w_out, *ln1_g, *ln1_b, *ffn_w13, *ffn_w2, *ln2_g, *ln2_b;
    float* out;
    unsigned char* ws;
};

typedef __attribute__((address_space(1))) unsigned char gchar_t;
typedef __attribute__((address_space(1))) float gfloat_t;
__device__ __forceinline__ Params launder(const Params& a) {
    Params q = a;
    unsigned long long w = (unsigned long long)a.ws, o = (unsigned long long)a.out;
    unsigned wl = __builtin_amdgcn_readfirstlane((unsigned)w), wh = __builtin_amdgcn_readfirstlane((unsigned)(w >> 32));
    unsigned ol = __builtin_amdgcn_readfirstlane((unsigned)o), oh = __builtin_amdgcn_readfirstlane((unsigned)(o >> 32));
    asm volatile("" : "+s"(wl), "+s"(wh), "+s"(ol), "+s"(oh));
    w = ((unsigned long long)wh << 32) | wl; o = ((unsigned long long)oh << 32) | ol;
    q.ws = (unsigned char*)(gchar_t*)w; q.out = (float*)(gfloat_t*)o;
    return q;
}
__device__ __forceinline__ int launder_i(int v) { v = __builtin_amdgcn_readfirstlane(v); asm volatile("" : "+s"(v)); return v; }
__device__ __forceinline__ int ltid() { int t = threadIdx.x; asm volatile("" : "+v"(t)); return t; }
__device__ __forceinline__ unsigned pk_bf16(float lo, float hi) { unsigned r; asm("v_cvt_pk_bf16_f32 %0, %1, %2" : "=v"(r) : "v"(lo), "v"(hi)); return r; }
__device__ __forceinline__ float bf_lo(unsigned u) { return __uint_as_float(u << 16); }
__device__ __forceinline__ float bf_hi(unsigned u) { return __uint_as_float(u & 0xffff0000u); }
__device__ __forceinline__ float bf1(bf16_t h) { return __uint_as_float(((unsigned)h) << 16); }
__device__ __forceinline__ float x32sum(float x) { unsigned u = __float_as_uint(x); auto r = __builtin_amdgcn_permlane32_swap(u, u, false, false); return __uint_as_float(r[0]) + __uint_as_float(r[1]); }
__device__ __forceinline__ float x16sum(float x) { unsigned u = __float_as_uint(x); auto r = __builtin_amdgcn_permlane16_swap(u, u, false, false); return __uint_as_float(r[0]) + __uint_as_float(r[1]); }
__device__ __forceinline__ float x32max(float x) { unsigned u = __float_as_uint(x); auto r = __builtin_amdgcn_permlane32_swap(u, u, false, false); return fmaxf(__uint_as_float(r[0]), __uint_as_float(r[1])); }
__device__ __forceinline__ float x16max(float x) { unsigned u = __float_as_uint(x); auto r = __builtin_amdgcn_permlane16_swap(u, u, false, false); return fmaxf(__uint_as_float(r[0]), __uint_as_float(r[1])); }
__device__ __forceinline__ float fqsum(float x) { return x16sum(x32sum(x)); }
__device__ __forceinline__ float fqmax(float x) { return x16max(x32max(x)); }
__device__ __forceinline__ float wave_sum(float v) {
#pragma unroll
    for (int o = 1; o < 16; o <<= 1) v += __shfl_xor(v, o);
    return fqsum(v);
}
template <int CTRL> __device__ __forceinline__ float dpp_add(float x) { return x + __uint_as_float((unsigned)__builtin_amdgcn_update_dpp(0, (int)__float_as_uint(x), CTRL, 0xf, 0xf, true)); }
__device__ __forceinline__ float red8(float x) { x = dpp_add<0xB1>(x); x = dpp_add<0x4E>(x); x = dpp_add<0x141>(x); return x; }
__device__ __forceinline__ float sigmoidf_(float x) { return 1.0f / (1.0f + __expf(-x)); }
__device__ __forceinline__ float siluf_(float x) { return x / (1.0f + __expf(-x)); }

__device__ __forceinline__ const float* x_rd(const Params& p, bool from_input, int b, int pp) {
    if (pp < CTXL) return (from_input ? p.ctx : (const float*)(p.ws + OFF_XC)) + ((size_t)b * CTXL + pp) * DM;
    return (from_input ? p.x : (const float*)p.out) + ((size_t)b * SEQ + (pp - CTXL)) * DM;
}
__device__ __forceinline__ float* x_wr(const Params& p, int b, int pp) {
    if (pp < CTXL) return (float*)(p.ws + OFF_XC) + ((size_t)b * CTXL + pp) * DM;
    return p.out + ((size_t)b * SEQ + (pp - CTXL)) * DM;
}
__device__ __forceinline__ const float* modv_ptr(const Params& p, int l, int b, int pp) {
    const int mr = pp < CTXL ? 16 : b;
    return (const float*)(p.ws + OFF_MODV) + ((size_t)l * 17 + mr) * 6144;
}

__device__ __forceinline__ void grid_barrier(unsigned* bar, unsigned& epoch) {
    asm volatile("s_waitcnt vmcnt(0) lgkmcnt(0)" ::: "memory");
    __syncthreads();
    epoch += 1;
    if (threadIdx.x == 0) {
        __builtin_amdgcn_fence(__ATOMIC_RELEASE, "agent");
        asm volatile("s_waitcnt vmcnt(0)" ::: "memory");
        const unsigned old = __hip_atomic_fetch_add(bar, 1u, __ATOMIC_RELAXED, __HIP_MEMORY_SCOPE_AGENT);
        if (old + 1u == epoch * gridDim.x) {
            __hip_atomic_store(bar + 64, epoch, __ATOMIC_RELAXED, __HIP_MEMORY_SCOPE_AGENT);
        } else {
            while (__hip_atomic_load(bar + 64, __ATOMIC_RELAXED, __HIP_MEMORY_SCOPE_AGENT) < epoch) __builtin_amdgcn_s_sleep(1);
        }
        __builtin_amdgcn_fence(__ATOMIC_ACQUIRE, "agent");
        asm volatile("s_waitcnt vmcnt(0)" ::: "memory");
    }
    __syncthreads();
}

#define LDS_AS __attribute__((address_space(3)))
#define GLB_AS __attribute__((address_space(1)))
template <int MT, int SWAPMODE>
__device__ __forceinline__ void gemm_mainloop(f32x4 (&acc)[MT][4], const bf16_t* __restrict__ A, int lda, int a_kstep,
                                              const bf16_t* __restrict__ Bt, int ldb, int nk, unsigned char* lds, int tid) {
    constexpr int BMr = 64 * MT;
    constexpr int STAGE = (BMr + 128) * 128;
    const int wid = __builtin_amdgcn_readfirstlane(tid >> 6), lane = tid & 63, wr = wid >> 1, wc = wid & 1, fr = lane & 15, fq = lane >> 4;
    const int lrow = 8 * wid + (lane >> 3);
    const int lch = (lane & 7) ^ ((4 * wid + (lane >> 4)) & 7);
    const bf16_t* ap = A + (size_t)lrow * lda + lch * 8;
    const bf16_t* bp = Bt + (size_t)lrow * ldb + lch * 8;
    auto issue = [&](int kt, int st) {
        unsigned char* base = lds + st * STAGE + wid * 1024;
#pragma unroll
        for (int i = 0; i < MT; ++i)
            __builtin_amdgcn_global_load_lds((const GLB_AS unsigned*)(ap + (size_t)i * 64 * lda + (size_t)kt * a_kstep), (LDS_AS unsigned*)(base + i * 8192), 16, 0, 0);
#pragma unroll
        for (int i = 0; i < 2; ++i)
            __builtin_amdgcn_global_load_lds((const GLB_AS unsigned*)(bp + (size_t)i * 64 * ldb + (size_t)kt * 64), (LDS_AS unsigned*)(base + (BMr + i * 64) * 128), 16, 0, 0);
    };
    const bool sw = (SWAPMODE == 1) || (SWAPMODE == 2 && wc == 0);
    const int sz = fr >> 1;
    constexpr int NL = MT + 2;
    const bool late = wid >= 4;
    issue(0, 0);
    if (nk > 1) { issue(1, 1); asm volatile("s_waitcnt vmcnt(%0)" ::"n"(NL) : "memory"); }
    else asm volatile("s_waitcnt vmcnt(0)" ::: "memory");
    __builtin_amdgcn_s_barrier();
    asm volatile("" ::: "memory");
    int st = 0;
    for (int kt = 0; kt < nk; ++kt) {
        const int st2 = st >= 1 ? st - 1 : 2;
        if (!late && kt + 2 < nk) issue(kt + 2, st2);
        const unsigned char* As = lds + st * STAGE;
        const unsigned char* Bs = As + BMr * 128;
#pragma unroll
        for (int ks = 0; ks < 2; ++ks) {
            bf16x8 af[MT], bfr[4];
            const int co = ((ks * 4 + fq) ^ sz) * 16;
#pragma unroll
            for (int m = 0; m < MT; ++m) af[m] = *(const bf16x8*)(As + (wr * 16 * MT + m * 16 + fr) * 128 + co);
#pragma unroll
            for (int n = 0; n < 4; ++n) bfr[n] = *(const bf16x8*)(Bs + (wc * 64 + n * 16 + fr) * 128 + co);
            if (sw) {
#pragma unroll
                for (int m = 0; m < MT; ++m)
#pragma unroll
                    for (int n = 0; n < 4; ++n) acc[m][n] = __builtin_amdgcn_mfma_f32_16x16x32_bf16(bfr[n], af[m], acc[m][n], 0, 0, 0);
            } else {
#pragma unroll
                for (int m = 0; m < MT; ++m)
#pragma unroll
                    for (int n = 0; n < 4; ++n) acc[m][n] = __builtin_amdgcn_mfma_f32_16x16x32_bf16(af[m], bfr[n], acc[m][n], 0, 0, 0);
            }
        }
        if (late && kt + 2 < nk) issue(kt + 2, st2);
        if (kt + 2 < nk) asm volatile("s_waitcnt vmcnt(%0) lgkmcnt(0)" ::"n"(NL) : "memory");
        else asm volatile("s_waitcnt vmcnt(0) lgkmcnt(0)" ::: "memory");
        __builtin_amdgcn_s_barrier();
        asm volatile("" ::: "memory");
        st = st == 2 ? 0 : st + 1;
    }
}
__device__ __forceinline__ void gemm_mainloop256(f32x4 (&acc)[8][4], const bf16_t* __restrict__ A, int lda,
                                                 const bf16_t* __restrict__ Bt, int ldb, int nk, unsigned char* lds, int tid) {
    constexpr int STAGE = 512 * 128;
    const int wid = __builtin_amdgcn_readfirstlane(tid >> 6), lane = tid & 63, wr = wid >> 2, wc = wid & 3, fr = lane & 15, fq = lane >> 4;
    const int lrow = 8 * wid + (lane >> 3);
    const int lch = (lane & 7) ^ ((4 * wid + (lane >> 4)) & 7);
    const bf16_t* ap = A + (size_t)lrow * lda + lch * 8;
    const bf16_t* bp = Bt + (size_t)lrow * ldb + lch * 8;
    auto issue = [&](int kt, int st) {
        unsigned char* base = lds + st * STAGE + wid * 1024;
#pragma unroll
        for (int i = 0; i < 4; ++i)
            __builtin_amdgcn_global_load_lds((const GLB_AS unsigned*)(ap + (size_t)i * 64 * lda + (size_t)kt * 64), (LDS_AS unsigned*)(base + i * 8192), 16, 0, 0);
#pragma unroll
        for (int i = 0; i < 4; ++i)
            __builtin_amdgcn_global_load_lds((const GLB_AS unsigned*)(bp + (size_t)i * 64 * ldb + (size_t)kt * 64), (LDS_AS unsigned*)(base + (256 + i * 64) * 128), 16, 0, 0);
    };
    const int sz = fr >> 1;
    const bool late = wid >= 4;
    issue(0, 0);
    asm volatile("s_waitcnt vmcnt(0)" ::: "memory");
    __builtin_amdgcn_s_barrier();
    asm volatile("" ::: "memory");
    for (int kt = 0; kt < nk; ++kt) {
        if (!late && kt + 1 < nk) issue(kt + 1, (kt + 1) & 1);
        const unsigned char* As = lds + (kt & 1) * STAGE;
        const unsigned char* Bs = As + 256 * 128;
#pragma unroll
        for (int ks = 0; ks < 2; ++ks) {
            if (ks == 1 && late && kt + 1 < nk) issue(kt + 1, (kt + 1) & 1);
            bf16x8 af[8], bfr[4];
            const int co = ((ks * 4 + fq) ^ sz) * 16;
#pragma unroll
            for (int m = 0; m < 8; ++m) af[m] = *(const bf16x8*)(As + (wr * 128 + m * 16 + fr) * 128 + co);
#pragma unroll
            for (int n = 0; n < 4; ++n) bfr[n] = *(const bf16x8*)(Bs + (wc * 64 + n * 16 + fr) * 128 + co);
#pragma unroll
            for (int m = 0; m < 8; ++m)
#pragma unroll
                for (int n = 0; n < 4; ++n) acc[m][n] = __builtin_amdgcn_mfma_f32_16x16x32_bf16(bfr[n], af[m], acc[m][n], 0, 0, 0);
        }
        asm volatile("s_waitcnt vmcnt(0) lgkmcnt(0)" ::: "memory");
        __builtin_amdgcn_s_barrier();
        asm volatile("" ::: "memory");
    }
}
struct Seg { const bf16_t* A; const bf16_t* Bt; int lda, a_kstep, ldb, nk; };
template <int MT, int SWAPMODE>
__device__ __forceinline__ void gemm_stream(f32x4 (&acc)[MT][4], const Seg& cur, const Seg& nxt, bool has_next, bool first, int& st,
                                            unsigned char* lds, int tid) {
    constexpr int BMr = 64 * MT;
    constexpr int STAGE = (BMr + 128) * 128;
    constexpr int NL = MT + 2;
    const int wid = __builtin_amdgcn_readfirstlane(tid >> 6), lane = tid & 63, wr = wid >> 1, wc = wid & 1, fr = lane & 15, fq = lane >> 4;
    const int lrow = 8 * wid + (lane >> 3);
    const int lch = (lane & 7) ^ ((4 * wid + (lane >> 4)) & 7);
    const bf16_t* apc = cur.A + (size_t)lrow * cur.lda + lch * 8;
    const bf16_t* bpc = cur.Bt + (size_t)lrow * cur.ldb + lch * 8;
    const bf16_t* apn = nxt.A + (size_t)lrow * nxt.lda + lch * 8;
    const bf16_t* bpn = nxt.Bt + (size_t)lrow * nxt.ldb + lch * 8;
    auto issue = [&](const bf16_t* ap, const bf16_t* bp, int lda, int ldb, int koffa, int koffb, int slot) {
        unsigned char* base = lds + slot * STAGE + wid * 1024;
#pragma unroll
        for (int i = 0; i < MT; ++i)
            __builtin_amdgcn_global_load_lds((const GLB_AS unsigned*)(ap + (size_t)i * 64 * lda + koffa), (LDS_AS unsigned*)(base + i * 8192), 16, 0, 0);
#pragma unroll
        for (int i = 0; i < 2; ++i)
            __builtin_amdgcn_global_load_lds((const GLB_AS unsigned*)(bp + (size_t)i * 64 * ldb + koffb), (LDS_AS unsigned*)(base + (BMr + i * 64) * 128), 16, 0, 0);
    };
    const bool sw = (SWAPMODE == 1) || (SWAPMODE == 2 && wc == 0);
    const int sz = fr >> 1;
    const bool late = wid >= 4;
    const int nk = cur.nk;
    int s0 = st;
    if (first) {
        const int s1 = s0 == 2 ? 0 : s0 + 1;
        issue(apc, bpc, cur.lda, cur.ldb, 0, 0, s0);
        issue(apc, bpc, cur.lda, cur.ldb, cur.a_kstep, 64, s1);
        asm volatile("s_waitcnt vmcnt(%0)" ::"n"(NL) : "memory");
        __builtin_amdgcn_s_barrier();
        asm volatile("" ::: "memory");
    }
    for (int kt = 0; kt < nk; ++kt) {
        const int s2 = s0 >= 1 ? s0 - 1 : 2;
        const int idx = kt + 2;
        const bool incur = idx < nk, doi = incur || has_next;
        if (!late && doi) { if (incur) issue(apc, bpc, cur.lda, cur.ldb, idx * cur.a_kstep, idx * 64, s2); else issue(apn, bpn, nxt.lda, nxt.ldb, (idx - nk) * nxt.a_kstep, (idx - nk) * 64, s2); }
        const unsigned char* As = lds + s0 * STAGE;
        const unsigned char* Bs = As + BMr * 128;
#pragma unroll
        for (int ks = 0; ks < 2; ++ks) {
            bf16x8 af[MT], bfr[4];
            const int co = ((ks * 4 + fq) ^ sz) * 16;
#pragma unroll
            for (int m = 0; m < MT; ++m) af[m] = *(const bf16x8*)(As + (wr * 16 * MT + m * 16 + fr) * 128 + co);
#pragma unroll
            for (int n = 0; n < 4; ++n) bfr[n] = *(const bf16x8*)(Bs + (wc * 64 + n * 16 + fr) * 128 + co);
            if (sw) {
#pragma unroll
                for (int m = 0; m < MT; ++m)
#pragma unroll
                    for (int n = 0; n < 4; ++n) acc[m][n] = __builtin_amdgcn_mfma_f32_16x16x32_bf16(bfr[n], af[m], acc[m][n], 0, 0, 0);
            } else {
#pragma unroll
                for (int m = 0; m < MT; ++m)
#pragma unroll
                    for (int n = 0; n < 4; ++n) acc[m][n] = __builtin_amdgcn_mfma_f32_16x16x32_bf16(af[m], bfr[n], acc[m][n], 0, 0, 0);
            }
        }
        if (late && doi) { if (incur) issue(apc, bpc, cur.lda, cur.ldb, idx * cur.a_kstep, idx * 64, s2); else issue(apn, bpn, nxt.lda, nxt.ldb, (idx - nk) * nxt.a_kstep, (idx - nk) * 64, s2); }
        if (doi) asm volatile("s_waitcnt vmcnt(%0) lgkmcnt(0)" ::"n"(NL) : "memory");
        else asm volatile("s_waitcnt vmcnt(0) lgkmcnt(0)" ::: "memory");
        __builtin_amdgcn_s_barrier();
        asm volatile("" ::: "memory");
        s0 = s0 == 2 ? 0 : s0 + 1;
    }
    st = s0;
}
__device__ __forceinline__ void gemm_stream256(f32x4 (&acc)[8][4], const Seg& cur, const Seg& nxt, bool has_next, bool first, int& st, unsigned char* lds, int tid) {
    constexpr int STAGE = 512 * 128;
    const int wid = __builtin_amdgcn_readfirstlane(tid >> 6), lane = tid & 63, wr = wid >> 2, wc = wid & 3, fr = lane & 15, fq = lane >> 4;
    const int lrow = 8 * wid + (lane >> 3);
    const int lch = (lane & 7) ^ ((4 * wid + (lane >> 4)) & 7);
    const bf16_t* apc = cur.A + (size_t)lrow * cur.lda + lch * 8;
    const bf16_t* bpc = cur.Bt + (size_t)lrow * cur.ldb + lch * 8;
    const bf16_t* apn = nxt.A + (size_t)lrow * nxt.lda + lch * 8;
    const bf16_t* bpn = nxt.Bt + (size_t)lrow * nxt.ldb + lch * 8;
    auto issue = [&](const bf16_t* ap, const bf16_t* bp, int lda, int ldb, int koff, int slot) {
        unsigned char* base = lds + slot * STAGE + wid * 1024;
#pragma unroll
        for (int i = 0; i < 4; ++i)
            __builtin_amdgcn_global_load_lds((const GLB_AS unsigned*)(ap + (size_t)i * 64 * lda + koff), (LDS_AS unsigned*)(base + i * 8192), 16, 0, 0);
#pragma unroll
        for (int i = 0; i < 4; ++i)
            __builtin_amdgcn_global_load_lds((const GLB_AS unsigned*)(bp + (size_t)i * 64 * ldb + koff), (LDS_AS unsigned*)(base + (256 + i * 64) * 128), 16, 0, 0);
    };
    const int sz = fr >> 1;
    const bool late = wid >= 4;
    const int nk = cur.nk;
    int s0 = st;
    if (first) {
        issue(apc, bpc, cur.lda, cur.ldb, 0, s0);
        asm volatile("s_waitcnt vmcnt(0)" ::: "memory");
        __builtin_amdgcn_s_barrier();
        asm volatile("" ::: "memory");
    }
    for (int kt = 0; kt < nk; ++kt) {
        const int idx = kt + 1;
        const bool incur = idx < nk, doi = incur || has_next;
        if (!late && doi) { if (incur) issue(apc, bpc, cur.lda, cur.ldb, idx * 64, s0 ^ 1); else issue(apn, bpn, nxt.lda, nxt.ldb, 0, s0 ^ 1); }
        const unsigned char* As = lds + s0 * STAGE;
        const unsigned char* Bs = As + 256 * 128;
#pragma unroll
        for (int ks = 0; ks < 2; ++ks) {
            if (ks == 1 && late && doi) { if (incur) issue(apc, bpc, cur.lda, cur.ldb, idx * 64, s0 ^ 1); else issue(apn, bpn, nxt.lda, nxt.ldb, 0, s0 ^ 1); }
            bf16x8 af[8], bfr[4];
            const int co = ((ks * 4 + fq) ^ sz) * 16;
#pragma unroll
            for (int m = 0; m < 8; ++m) af[m] = *(const bf16x8*)(As + (wr * 128 + m * 16 + fr) * 128 + co);
#pragma unroll
            for (int n = 0; n < 4; ++n) bfr[n] = *(const bf16x8*)(Bs + (wc * 64 + n * 16 + fr) * 128 + co);
#pragma unroll
            for (int m = 0; m < 8; ++m)
#pragma unroll
                for (int n = 0; n < 4; ++n) acc[m][n] = __builtin_amdgcn_mfma_f32_16x16x32_bf16(bfr[n], af[m], acc[m][n], 0, 0, 0);
        }
        asm volatile("s_waitcnt vmcnt(0) lgkmcnt(0)" ::: "memory");
        __builtin_amdgcn_s_barrier();
        asm volatile("" ::: "memory");
        s0 ^= 1;
    }
    st = s0;
}
template <int MT> __device__ __forceinline__ void zero_acc(f32x4 (&acc)[MT][4]) {
#pragma unroll
    for (int m = 0; m < MT; ++m)
#pragma unroll
        for (int n = 0; n < 4; ++n) acc[m][n] = (f32x4){0.f, 0.f, 0.f, 0.f};
}
__device__ __forceinline__ void tile_mn(int t, int nN, int& mt, int& nt) { const int per = 16 * nN, g = t / per, w = t % per; mt = g * 16 + (w & 15); nt = w >> 4; }

__device__ __forceinline__ int rowmap(int mode, int n) {
    if (mode == 1) return n < 672 ? n : n + 96;
    if (mode == 2) return n < DFF ? ((n >> 5) * 64 + (n & 31)) : (((n - DFF) >> 5) * 64 + 32 + ((n - DFF) & 31));
    return n;
}
__device__ __forceinline__ void convert_T(const float* __restrict__ src, int K, int N, bf16_t* __restrict__ dst, int mode, const float* __restrict__ ks, unsigned char* lds, int rot) {
    float* tile = (float*)lds;
    const int ntk = K / 64, ntn = (N + 63) / 64, tid = ltid();
    const int start = (blockIdx.x + gridDim.x - (rot % gridDim.x)) % gridDim.x;
    for (int t = start; t < ntk * ntn; t += gridDim.x) {
        const int tk = t % ntk, tn = t / ntk, k0 = tk * 64, n0 = tn * 64;
#pragma unroll
        for (int i = 0; i < 8; ++i) {
            const int kl = (tid >> 6) + 8 * i, nl = tid & 63, n = n0 + nl;
            tile[kl * 65 + nl] = n < N ? src[(size_t)(k0 + kl) * N + n] : 0.f;
        }
        __syncthreads();
        const int kp = (tid & 31) * 2;
        float s0 = 1.f, s1 = 1.f;
        if (ks) { s0 = ks[k0 + kp]; s1 = ks[k0 + kp + 1]; }
#pragma unroll
        for (int i = 0; i < 4; ++i) {
            const int nl = (tid >> 5) + 16 * i, n = n0 + nl;
            if (n < N) *(unsigned*)(dst + (size_t)rowmap(mode, n) * K + k0 + kp) = pk_bf16(tile[kp * 65 + nl] * s0, tile[(kp + 1) * 65 + nl] * s1);
        }
        __syncthreads();
    }
}
__device__ __forceinline__ void convert_layer(const Params& pin, int l, unsigned char* lds) {
    const Params p = launder(pin); l = launder_i(l);
    bf16_t* W = (bf16_t*)(p.ws + OFF_W);
    convert_T(p.w_in + (size_t)l * DM * DIN, DM, DIN, W + WO_IN, 1, nullptr, lds, 0);
    convert_T(p.ffn_w13 + (size_t)l * DM * 2 * DFF, DM, 2 * DFF, W + WO_13, 2, nullptr, lds, 40);
    convert_T(p.ffn_w2 + (size_t)l * DFF * DM, DFF, DM, W + WO_2, 0, nullptr, lds, 80);
    convert_T(p.w_out + (size_t)l * DM * DM, DM, DM, W + WO_OUT, 0, nullptr, lds, 120);
    convert_T(p.w_o_attn + (size_t)l * 512 * DM, 512, DM, W + WO_OA, 0, nullptr, lds, 136);
    convert_T(p.w_o_conv + (size_t)l * 512 * DM, 512, DM, W + WO_OC, 0, nullptr, lds, 8);
    convert_T(p.w_o_rwkv + (size_t)l * 512 * DM, 512, DM, W + WO_OR, 0, nullptr, lds, 136 + 8);
    convert_T(p.w_uq + (size_t)l * 384 * 768, 384, 768, W + WO_UQ, 0, p.q_norm + l * 384, lds, 16);
    convert_T(p.w_ukv + (size_t)l * 256 * 1024, 256, 1024, W + WO_UKV, 0, p.kv_norm + l * 256, lds, 88);
    for (int z = 0; z < 2; ++z) {
        convert_T(p.rw_w_up + ((size_t)l * 2 + z) * 64 * 512, 64, 512, W + WO_UP + (size_t)z * 512 * 64, 0, nullptr, lds, 152 + 8 * z);
        convert_T(p.rw_a_up + ((size_t)l * 2 + z) * 64 * 512, 64, 512, W + WO_AUP + (size_t)z * 512 * 64, 0, nullptr, lds, 168 + 8 * z);
    }
    convert_T(p.rw_g_up + (size_t)l * 128 * 512, 128, 512, W + WO_GUP, 0, nullptr, lds, 184);
}

__device__ __forceinline__ void modv_phase(const Params& pin, unsigned char* lds) {
    const Params p = launder(pin);
    float* s = (float*)lds;
    float* red = s + 17 * 1024;
    const int tid = ltid(), wid = tid >> 6, lane = tid & 63;
    for (int i = tid; i < 17 * 1024; i += NTHREADS) { const int r = i >> 10, k = i & 1023; const float v = r < 16 ? p.c[r * 1024 + k] : p.c_ctx[k]; s[i] = siluf_(v); }
    __syncthreads();
    float* modv = (float*)(p.ws + OFF_MODV);
    for (int g = blockIdx.x; g < 4 * 96; g += gridDim.x) {
        const int l = g / 96, n = (g % 96) * 64 + lane;
        const float* w = p.mod_w + (size_t)l * 1024 * 6144 + n;
        float acc[17];
#pragma unroll
        for (int r = 0; r < 17; ++r) acc[r] = 0.f;
        const int kb = wid * 128;
        for (int k = kb; k < kb + 128; k += 4) {
            const float w0 = w[(size_t)k * 6144], w1 = w[(size_t)(k + 1) * 6144], w2 = w[(size_t)(k + 2) * 6144], w3 = w[(size_t)(k + 3) * 6144];
#pragma unroll
            for (int r = 0; r < 17; ++r) { const f32x4 sv = *(const f32x4*)(s + r * 1024 + k); acc[r] += sv[0] * w0 + sv[1] * w1 + sv[2] * w2 + sv[3] * w3; }
        }
#pragma unroll
        for (int r = 0; r < 17; ++r) red[(wid * 17 + r) * 64 + lane] = acc[r];
        __syncthreads();
        for (int i = tid; i < 17 * 64; i += NTHREADS) {
            const int r = i >> 6, c = i & 63; float v = 0.f;
#pragma unroll
            for (int w8 = 0; w8 < 8; ++w8) v += red[(w8 * 17 + r) * 64 + c];
            const int nn = (g % 96) * 64 + c;
            modv[((size_t)l * 17 + r) * 6144 + nn] = v + p.mod_b[l * 6144 + nn];
        }
        __syncthreads();
    }
    if (blockIdx.x == gridDim.x - 1) {
        float* rope = (float*)(p.ws + OFF_ROPE);
        for (int i = tid; i < 512; i += NTHREADS) {
            const int pos = i >> 3, f = i & 7;
            const float inv = exp2f(-(float)f * (13.287712379549449f / 8.0f));
            const float ang = (float)pos * inv;
            rope[i * 2] = cosf(ang); rope[i * 2 + 1] = sinf(ang);
        }
    }
}

__device__ __forceinline__ void xmod0_phase(const Params& pin) {
    const Params p = launder(pin);
    const int tid = ltid(), wid = tid >> 6, lane = tid & 63;
    bf16_t* xm = (bf16_t*)(p.ws + OFF_R6);
    for (int row = blockIdx.x * 8 + wid; row < MROWS; row += gridDim.x * 8) {
        const int b = row / TPB, pp = row % TPB;
        const float* xp = x_rd(p, true, b, pp);
        const float* mv = modv_ptr(p, 0, b, pp);
#pragma unroll
        for (int i = 0; i < 4; ++i) {
            const int c = i * 256 + lane * 4;
            const f32x4 v = *(const f32x4*)(xp + c), sh = *(const f32x4*)(mv + c), sc = *(const f32x4*)(mv + 1024 + c);
            uint2 o; o.x = pk_bf16(v[0] * (1.f + sc[0]) + sh[0], v[1] * (1.f + sc[1]) + sh[1]); o.y = pk_bf16(v[2] * (1.f + sc[2]) + sh[2], v[3] * (1.f + sc[3]) + sh[3]);
            *(uint2*)(xm + (size_t)row * 1024 + c) = o;
        }
    }
}

__device__ __forceinline__ void p1_phase(const Params& pin, unsigned char* lds) {
    const Params p = launder(pin); const int tid = ltid();
    const bf16_t* A = (const bf16_t*)(p.ws + OFF_R6);
    const bf16_t* W = (const bf16_t*)(p.ws + OFF_W) + WO_IN;
    const int lane = tid & 63, wid = tid >> 6, wr = wid >> 2, wc = wid & 3, fr = lane & 15, fq = lane >> 4;
    auto seg = [&](int t) { int mt, nt; tile_mn(t, 17, mt, nt); Seg g; g.A = A + (size_t)mt * 256 * 1024; g.Bt = W + (size_t)nt * 256 * 1024; g.lda = 1024; g.a_kstep = 64; g.ldb = 1024; g.nk = 16; return g; };
    int st = 0; bool first = true;
    for (int t = blockIdx.x; t < 144 * 17; t += gridDim.x) {
        int mt, nt; tile_mn(t, 17, mt, nt);
        const int tn = t + gridDim.x; const bool hn = tn < 144 * 17;
        f32x4 acc[8][4]; zero_acc<8>(acc);
        gemm_stream256(acc, seg(t), seg(hn ? tn : t), hn, first, st, lds, tid); first = false;
        bf16_t* dst; int ld, cb, lim;
        if (nt < 3) { dst = (bf16_t*)(p.ws + OFF_R1); ld = 672; cb = nt * 256; lim = 672; }
        else if (nt < 9) { dst = (bf16_t*)(p.ws + OFF_R2); ld = 1536; cb = (nt - 3) * 256; lim = 1536; }
        else { dst = (bf16_t*)(p.ws + OFF_R3); ld = 1920; cb = (nt - 9) * 256; lim = 1920; }
#pragma unroll
        for (int m = 0; m < 8; ++m) {
            const size_t row = (size_t)mt * 256 + wr * 128 + m * 16 + fr;
#pragma unroll
            for (int n = 0; n < 4; ++n) {
                const int col = cb + wc * 64 + n * 16 + fq * 4;
                if (col < lim) { uint2 o; o.x = pk_bf16(acc[m][n][0], acc[m][n][1]); o.y = pk_bf16(acc[m][n][2], acc[m][n][3]); *(uint2*)(dst + row * ld + col) = o; }
            }
        }
    }
}

__device__ __forceinline__ void unpack8(const uint4 u, float (&f)[8]) {
    f[0] = bf_lo(u.x); f[1] = bf_hi(u.x); f[2] = bf_lo(u.y); f[3] = bf_hi(u.y); f[4] = bf_lo(u.z); f[5] = bf_hi(u.z); f[6] = bf_lo(u.w); f[7] = bf_hi(u.w);
}
__device__ __forceinline__ void p2a_phase(const Params& pin, int l) {
    const Params p = launder(pin); l = launder_i(l);
    const int tid = ltid(), wid = tid >> 6, lane = tid & 63;
    const bf16_t* Hm = (const bf16_t*)(p.ws + OFF_R1);
    const bf16_t* Hc = (const bf16_t*)(p.ws + OFF_R2);
    bf16_t* CV = (bf16_t*)(p.ws + OFF_R5);
    bf16_t* KR = (bf16_t*)(p.ws + OFF_KR);
    float* RSQ = (float*)(p.ws + OFF_RSQ);
    float* RSKV = (float*)(p.ws + OFF_RSKV);
    const float* rope = (const float*)(p.ws + OFF_ROPE);
    const float* cw = p.conv_w + (size_t)l * 3 * 512;
    const int c0 = lane * 8;
    float w0[8], w1[8], w2[8];
#pragma unroll
    for (int i = 0; i < 8; ++i) { w0[i] = cw[c0 + i]; w1[i] = cw[512 + c0 + i]; w2[i] = cw[1024 + c0 + i]; }
    for (int row = blockIdx.x * 8 + wid; row < MROWS; row += gridDim.x * 8) {
        const int pp = row % TPB;
        const bool hp = (pp != 0 && pp != CTXL), hn = (pp != CTXL - 1 && pp != TPB - 1);
        const bf16_t* hr = Hc + (size_t)row * 1536;
        float ch[8], cc[8], cb[8], u0[8], u1[8], u2[8];
        unpack8(*(const uint4*)(hr + c0), ch); unpack8(*(const uint4*)(hr + 1024 + c0), cc); unpack8(*(const uint4*)(hr + 512 + c0), cb);
#pragma unroll
        for (int i = 0; i < 8; ++i) u1[i] = cc[i] * ch[i];
        if (hp) { unpack8(*(const uint4*)(hr - 1536 + c0), ch); unpack8(*(const uint4*)(hr - 1536 + 1024 + c0), cc);
#pragma unroll
            for (int i = 0; i < 8; ++i) u0[i] = cc[i] * ch[i]; }
        else {
#pragma unroll
            for (int i = 0; i < 8; ++i) u0[i] = 0.f; }
        if (hn) { unpack8(*(const uint4*)(hr + 1536 + c0), ch); unpack8(*(const uint4*)(hr + 1536 + 1024 + c0), cc);
#pragma unroll
            for (int i = 0; i < 8; ++i) u2[i] = cc[i] * ch[i]; }
        else {
#pragma unroll
            for (int i = 0; i < 8; ++i) u2[i] = 0.f; }
        float o[8];
#pragma unroll
        for (int i = 0; i < 8; ++i) o[i] = cb[i] * (u0[i] * w0[i] + u1[i] * w1[i] + u2[i] * w2[i]);
        uint4 ov; ov.x = pk_bf16(o[0], o[1]); ov.y = pk_bf16(o[2], o[3]); ov.z = pk_bf16(o[4], o[5]); ov.w = pk_bf16(o[6], o[7]);
        *(uint4*)(CV + (size_t)row * 512 + c0) = ov;
        const bf16_t* hm = Hm + (size_t)row * 672;
        float sq = 0.f, skv = 0.f;
        if (lane < 48) { float f[8]; unpack8(*(const uint4*)(hm + lane * 8), f);
#pragma unroll
            for (int i = 0; i < 8; ++i) sq += f[i] * f[i]; }
        if (lane < 32) { float f[8]; unpack8(*(const uint4*)(hm + 384 + lane * 8), f);
#pragma unroll
            for (int i = 0; i < 8; ++i) skv += f[i] * f[i]; }
        sq = wave_sum(sq); skv = wave_sum(skv);
        if (lane == 0) { RSQ[row] = rsqrtf(sq * (1.0f / 384.0f) + 1e-6f); RSKV[row] = rsqrtf(skv * (1.0f / 256.0f) + 1e-6f); }
        {
            const int j = lane & 31;
            float v = bf1(hm[640 + j]);
            const float other = __shfl_xor(v, 8);
            if (pp >= CTXL) {
                const int tt = pp - CTXL;
                const int pos = (j < 16) ? (tt >> 6) : (tt & 63);
                const float cs = rope[(pos * 8 + (j & 7)) * 2], sn = rope[(pos * 8 + (j & 7)) * 2 + 1];
                v = (j & 8) ? (other * sn + v * cs) : (v * cs - other * sn);
            }
            if (lane < 32) KR[(size_t)row * 32 + j] = (bf16_t)(pk_bf16(v, v) & 0xffffu);
        }
    }
}

__device__ __forceinline__ void p2b_phase(const Params& pin, int l, unsigned char* lds) {
    const Params p = launder(pin); l = launder_i(l); const int tid = ltid();
    const bf16_t* Hm = (const bf16_t*)(p.ws + OFF_R1);
    const bf16_t* W = (const bf16_t*)(p.ws + OFF_W);
    const float* RSQ = (const float*)(p.ws + OFF_RSQ);
    const float* RSKV = (const float*)(p.ws + OFF_RSKV);
    const float* rope = (const float*)(p.ws + OFF_ROPE);
    bf16_t* Q = (bf16_t*)(p.ws + OFF_Q);
    bf16_t* KN = (bf16_t*)(p.ws + OFF_KN);
    bf16_t* VT = (bf16_t*)(p.ws + OFF_VT);
    const int lane = tid & 63, wid = tid >> 6, wr = wid >> 1, wc = wid & 1, fr = lane & 15, fq = lane >> 4;
    const int NQ = 144 * 6, NKV = 144 * 8;
    for (int t = blockIdx.x; t < NQ + NKV; t += gridDim.x) {
        f32x4 acc[4][4]; zero_acc<4>(acc);
        if (t < NQ) {
            int mt, nt; tile_mn(t, 6, mt, nt);
            gemm_mainloop<4, 1>(acc, Hm + (size_t)mt * 256 * 672, 672, 64, W + WO_UQ + (size_t)nt * 128 * 384, 384, 6, lds, tid);
            const int pp0 = (mt % 9) * 256; const bool latent = pp0 >= CTXL;
#pragma unroll
            for (int m = 0; m < 4; ++m) {
                const int lrow = wr * 64 + m * 16 + fr;
                const size_t row = (size_t)mt * 256 + lrow;
                const float sc = RSQ[row] * QSCALE;
                const int tt = pp0 + lrow - CTXL;
#pragma unroll
                for (int n = 0; n < 4; ++n) {
                    const int c16 = nt * 128 + wc * 64 + n * 16, r96 = c16 % 96;
                    float v[4];
#pragma unroll
                    for (int j = 0; j < 4; ++j) v[j] = acc[m][n][j] * sc;
                    if (latent && r96 >= 64) {
                        const int pos = (r96 == 64) ? (tt >> 6) : (tt & 63);
#pragma unroll
                        for (int j = 0; j < 4; ++j) {
                            const float other = __shfl_xor(v[j], 32);
                            const int fi = (fq & 1) * 4 + j;
                            const float cs = rope[(pos * 8 + fi) * 2], sn = rope[(pos * 8 + fi) * 2 + 1];
                            v[j] = (fq & 2) ? (other * sn + v[j] * cs) : (v[j] * cs - other * sn);
                        }
                    }
                    uint2 o; o.x = pk_bf16(v[0], v[1]); o.y = pk_bf16(v[2], v[3]);
                    *(uint2*)(Q + row * 768 + c16 + fq * 4) = o;
                }
            }
        } else {
            int mt, nt; tile_mn(t - NQ, 8, mt, nt);
            gemm_mainloop<4, 2>(acc, Hm + (size_t)mt * 256 * 672 + 384, 672, 64, W + WO_UKV + (size_t)nt * 128 * 256, 256, 4, lds, tid);
            const int b = mt / 9, pp0 = (mt % 9) * 256;
            if (wc == 0) {
#pragma unroll
                for (int m = 0; m < 4; ++m) {
                    const size_t row = (size_t)mt * 256 + wr * 64 + m * 16 + fr;
                    const float sc = RSKV[row];
#pragma unroll
                    for (int n = 0; n < 4; ++n) {
                        uint2 o; o.x = pk_bf16(acc[m][n][0] * sc, acc[m][n][1] * sc); o.y = pk_bf16(acc[m][n][2] * sc, acc[m][n][3] * sc);
                        *(uint2*)(KN + row * 512 + nt * 64 + n * 16 + fq * 4) = o;
                    }
                }
            } else {
#pragma unroll
                for (int m = 0; m < 4; ++m) {
                    const int lrow = wr * 64 + m * 16 + fq * 4;
                    const f32x4 sc = *(const f32x4*)(RSKV + (size_t)mt * 256 + lrow);
#pragma unroll
                    for (int n = 0; n < 4; ++n) {
                        const int dv = n * 16 + fr;
                        uint2 o; o.x = pk_bf16(acc[m][n][0] * sc[0], acc[m][n][1] * sc[1]); o.y = pk_bf16(acc[m][n][2] * sc[2], acc[m][n][3] * sc[3]);
                        *(uint2*)(VT + ((size_t)(b * 8 + nt) * 64 + dv) * TPB + pp0 + lrow) = o;
                    }
                }
            }
        }
    }
    {
        const bf16_t* Hr = (const bf16_t*)(p.ws + OFF_R3);
        bf16_t* SG = (bf16_t*)(p.ws + OFF_SG);
        const float* mu = p.rw_mu + (size_t)l * 1920 + 1792;
        for (int i = blockIdx.x * NTHREADS + tid; i < MROWS * 16; i += gridDim.x * NTHREADS) {
            const int row = i >> 4, c0 = (i & 15) * 8, pp = row % TPB;
            const bool hp = (pp != 0 && pp != CTXL), hn = (pp != CTXL - 1 && pp != TPB - 1);
            const bf16_t* hr = Hr + (size_t)row * 1920 + 1792 + c0;
            float cur[8], pv[8], nx[8];
            unpack8(*(const uint4*)hr, cur);
            if (hp) unpack8(*(const uint4*)(hr - 1920), pv); else {
#pragma unroll
                for (int k = 0; k < 8; ++k) pv[k] = 0.f; }
            if (hn) unpack8(*(const uint4*)(hr + 1920), nx); else {
#pragma unroll
                for (int k = 0; k < 8; ++k) nx[k] = 0.f; }
            float o[8];
#pragma unroll
            for (int k = 0; k < 8; ++k) o[k] = sigmoidf_(cur[k] + (0.5f * (pv[k] + nx[k]) - cur[k]) * mu[c0 + k]);
            uint4 ov; ov.x = pk_bf16(o[0], o[1]); ov.y = pk_bf16(o[2], o[3]); ov.z = pk_bf16(o[4], o[5]); ov.w = pk_bf16(o[6], o[7]);
            *(uint4*)(SG + (size_t)row * 128 + c0) = ov;
        }
    }
}

#define FMAC_BC(acc, coef, s, J) asm("v_fmac_f32_dpp %0, %1, %2 row_newbcast:" #J " row_mask:0xf bank_mask:0xf" : "+v"(acc) : "v"(coef), "v"(s))
#define MUL_BC(dst, coef, s, J) asm("v_mul_f32_dpp %0, %1, %2 row_newbcast:" #J " row_mask:0xf bank_mask:0xf" : "=v"(dst) : "v"(coef), "v"(s))
#define REP16(X) X(0, 0) X(1, 1) X(2, 2) X(3, 3) X(4, 0) X(5, 1) X(6, 2) X(7, 3) X(8, 0) X(9, 1) X(10, 2) X(11, 3) X(12, 0) X(13, 1) X(14, 2) X(15, 3)
constexpr int FSTR = 6 * 64 + 4;
constexpr int CHUNK = 32, NCHUNK = TPB / CHUNK;

__device__ __forceinline__ int scan_pos(int z, int s) { return z == 0 ? s : (s < CTXL ? (CTXL - 1 - s) : (TPB + CTXL - 1 - s)); }

__device__ __forceinline__ void shift4(const bf16_t* hr, bool hp, bool hn, int col, const float* mu, float (&o)[4]) {
    const uint2 c = *(const uint2*)(hr + col);
    uint2 a = make_uint2(0u, 0u), b = make_uint2(0u, 0u);
    if (hp) a = *(const uint2*)(hr - 1920 + col);
    if (hn) b = *(const uint2*)(hr + 1920 + col);
    const f32x4 m = *(const f32x4*)(mu + col);
    const float cv[4] = {bf_lo(c.x), bf_hi(c.x), bf_lo(c.y), bf_hi(c.y)};
    const float av[4] = {bf_lo(a.x), bf_hi(a.x), bf_lo(a.y), bf_hi(a.y)};
    const float bv[4] = {bf_lo(b.x), bf_hi(b.x), bf_lo(b.y), bf_hi(b.y)};
#pragma unroll
    for (int i = 0; i < 4; ++i) o[i] = cv[i] + (0.5f * (av[i] + bv[i]) - cv[i]) * m[i];
}
__device__ __forceinline__ void shift8(const bf16_t* hr, bool hp, bool hn, int col, const float* mu, float (&o)[8]) {
    float cv[8], av[8], bv[8];
    unpack8(*(const uint4*)(hr + col), cv);
    if (hp) unpack8(*(const uint4*)(hr - 1920 + col), av); else {
#pragma unroll
        for (int i = 0; i < 8; ++i) av[i] = 0.f; }
    if (hn) unpack8(*(const uint4*)(hr + 1920 + col), bv); else {
#pragma unroll
        for (int i = 0; i < 8; ++i) bv[i] = 0.f; }
#pragma unroll
    for (int i = 0; i < 8; ++i) o[i] = cv[i] + (0.5f * (av[i] + bv[i]) - cv[i]) * mu[col + i];
}
__device__ __forceinline__ bf16x8 pack8(const float (&f)[8]) {
    union { uint4 u; bf16x8 v; } r;
    r.u.x = pk_bf16(f[0], f[1]); r.u.y = pk_bf16(f[2], f[3]); r.u.z = pk_bf16(f[4], f[5]); r.u.w = pk_bf16(f[6], f[7]);
    return r.v;
}

struct ProdState { f32x4 aw[4], aa[4]; };
struct Raw3x2 { uint2 c, a, b; };
__device__ __forceinline__ Raw3x2 ld3x2(const bf16_t* pc, const bf16_t* pa, const bf16_t* pb, bool hp, bool hn, int col) {
    Raw3x2 r; r.c = *(const uint2*)(pc + col); r.a = *(const uint2*)(pa + col); r.b = *(const uint2*)(pb + col);
    if (!hp) r.a = make_uint2(0u, 0u);
    if (!hn) r.b = make_uint2(0u, 0u);
    return r;
}
__device__ __forceinline__ void sh4(const Raw3x2& r, const f32x4 m, float (&o)[4]) {
    const float cv[4] = {bf_lo(r.c.x), bf_hi(r.c.x), bf_lo(r.c.y), bf_hi(r.c.y)};
    const float av[4] = {bf_lo(r.a.x), bf_hi(r.a.x), bf_lo(r.a.y), bf_hi(r.a.y)};
    const float bv[4] = {bf_lo(r.b.x), bf_hi(r.b.x), bf_lo(r.b.y), bf_hi(r.b.y)};
#pragma unroll
    for (int i = 0; i < 4; ++i) o[i] = cv[i] + (0.5f * (av[i] + bv[i]) - cv[i]) * m[i];
}
struct Raw3x4 { uint4 c, a, b; };
__device__ __forceinline__ Raw3x4 ld3x4(const bf16_t* pc, const bf16_t* pa, const bf16_t* pb, bool hp, bool hn, int col) {
    Raw3x4 r; r.c = *(const uint4*)(pc + col); r.a = *(const uint4*)(pa + col); r.b = *(const uint4*)(pb + col);
    if (!hp) r.a = make_uint4(0u, 0u, 0u, 0u);
    if (!hn) r.b = make_uint4(0u, 0u, 0u, 0u);
    return r;
}
__device__ __forceinline__ void sh8(const Raw3x4& r, const float* m, float (&o)[8]) {
    float cv[8], av[8], bv[8];
    unpack8(r.c, cv); unpack8(r.a, av); unpack8(r.b, bv);
    const f32x4 m0 = *(const f32x4*)m, m1 = *(const f32x4*)(m + 4);
#pragma unroll
    for (int i = 0; i < 8; ++i) o[i] = cv[i] + (0.5f * (av[i] + bv[i]) - cv[i]) * (i < 4 ? m0[i] : m1[i - 4]);
}
template <int N0>
__device__ __forceinline__ void scan_produce_elem(const float* pl, int fq, const Raw3x2 (&rr)[2], const Raw3x2 (&rk)[2], const Raw3x2 (&rv)[2],
                                                  const f32x4 (&aw)[2], const f32x4 (&aa)[2], float& ss, float* frow) {
#pragma unroll
    for (int nn = 0; nn < 2; ++nn) {
        const int n = N0 + nn;
        const int c4 = n * 16 + fq * 4;
        float r4[4], k4[4], v4[4];
        sh4(rr[nn], *(const f32x4*)(pl + 0 * 64 + c4), r4);
        sh4(rk[nn], *(const f32x4*)(pl + 1 * 64 + c4), k4);
        sh4(rv[nn], *(const f32x4*)(pl + 2 * 64 + c4), v4);
        const f32x4 w0 = *(const f32x4*)(pl + 3 * 64 + c4);
        const f32x4 a0 = *(const f32x4*)(pl + 4 * 64 + c4);
        const f32x4 kkp = *(const f32x4*)(pl + 5 * 64 + c4);
        const f32x4 kap = *(const f32x4*)(pl + 6 * 64 + c4);
        f32x4 dw, kd, kf4, a4;
#pragma unroll
        for (int j = 0; j < 4; ++j) {
            const float x = -(aw[nn][j] + w0[j]);
            const float sp = fmaxf(x, 0.f) + __logf(1.0f + __expf(-fabsf(x)));
            const float wl = -sp - 0.5f;
            dw[j] = __expf(-__expf(wl));
            const float a = __builtin_amdgcn_rcpf(1.0f + __expf(-(aa[nn][j] + a0[j])));
            a4[j] = a;
            const float kf = k4[j] * kkp[j];
            kf4[j] = kf; ss += kf * kf;
            kd[j] = k4[j] * (1.0f + (a - 1.0f) * kap[j]);
        }
        *(f32x4*)(frow + 0 * 64 + c4) = kf4;
        *(f32x4*)(frow + 1 * 64 + c4) = dw;
        *(f32x4*)(frow + 2 * 64 + c4) = a4;
        *(f32x4*)(frow + 3 * 64 + c4) = kd;
        *(f32x4*)(frow + 4 * 64 + c4) = (f32x4){r4[0], r4[1], r4[2], r4[3]};
        *(f32x4*)(frow + 5 * 64 + c4) = (f32x4){v4[0], v4[1], v4[2], v4[3]};
    }
}
__device__ __forceinline__ void scan_produce_A(const Params& p, const float* pl, int b, int h, int z, int s0, float* frow0, int lane, ProdState& st) {
    const int fr = lane & 15, fq = lane >> 4;
    const int pp = scan_pos(z, s0 + fr);
    const bool hp = (pp != 0 && pp != CTXL), hn = (pp != CTXL - 1 && pp != TPB - 1);
    const bf16_t* hr = (const bf16_t*)(p.ws + OFF_R3) + ((size_t)b * TPB + pp) * 1920;
    const bf16_t* W = (const bf16_t*)(p.ws + OFF_W);
    Raw3x4 qw[2], qa[2];
    const bf16_t* pc = hr + z * 64 + fq * 8; const bf16_t* pa = hp ? pc - 1920 : pc; const bf16_t* pb = hn ? pc + 1920 : pc;
#pragma unroll
    for (int ks = 0; ks < 2; ++ks) { qw[ks] = ld3x4(pc, pa, pb, hp, hn, 1536 + ks * 32); qa[ks] = ld3x4(pc, pa, pb, hp, hn, 1664 + ks * 32); }
    f32x4 accw[4], acca[4];
#pragma unroll
    for (int n = 0; n < 4; ++n) { accw[n] = (f32x4){0.f, 0.f, 0.f, 0.f}; acca[n] = (f32x4){0.f, 0.f, 0.f, 0.f}; }
#pragma unroll
    for (int ks = 0; ks < 2; ++ks) {
        bf16x8 bw[4], ba[4];
#pragma unroll
        for (int n = 0; n < 4; ++n) {
            const size_t wo = ((size_t)z * 512 + h * 64 + n * 16 + fr) * 64 + ks * 32 + fq * 8;
            bw[n] = *(const bf16x8*)(W + WO_UP + wo); ba[n] = *(const bf16x8*)(W + WO_AUP + wo);
        }
        float t8[8];
        sh8(qw[ks], pl + 7 * 64 + ks * 32 + fq * 8, t8);
#pragma unroll
        for (int i = 0; i < 8; ++i) { const float e = __expf(2.0f * t8[i]); t8[i] = 1.0f - 2.0f * __builtin_amdgcn_rcpf(e + 1.0f); }
        const bf16x8 aw = pack8(t8);
        sh8(qa[ks], pl + 8 * 64 + ks * 32 + fq * 8, t8);
        const bf16x8 aa = pack8(t8);
#pragma unroll
        for (int n = 0; n < 4; ++n) {
            accw[n] = __builtin_amdgcn_mfma_f32_16x16x32_bf16(bw[n], aw, accw[n], 0, 0, 0);
            acca[n] = __builtin_amdgcn_mfma_f32_16x16x32_bf16(ba[n], aa, acca[n], 0, 0, 0);
        }
    }
#pragma unroll
    for (int n = 0; n < 4; ++n) { st.aw[n] = accw[n]; st.aa[n] = acca[n]; }
}
__device__ __forceinline__ void scan_produce_B(const Params& p, const float* pl, int b, int h, int z, int s0, float* frow0, int lane, const ProdState& st) {
    const int fr = lane & 15, fq = lane >> 4;
    const int pp = scan_pos(z, s0 + fr);
    const bool hp = (pp != 0 && pp != CTXL), hn = (pp != CTXL - 1 && pp != TPB - 1);
    const bf16_t* hr = (const bf16_t*)(p.ws + OFF_R3) + ((size_t)b * TPB + pp) * 1920;
    Raw3x2 rr0[2], rk0[2], rv0[2], rr1[2], rk1[2], rv1[2];
    const bf16_t* pc = hr + h * 64 + fq * 4; const bf16_t* pa = hp ? pc - 1920 : pc; const bf16_t* pb = hn ? pc + 1920 : pc;
#pragma unroll
    for (int nn = 0; nn < 2; ++nn) {
        const int C4 = nn * 16, C5 = C4 + 32;
        rr0[nn] = ld3x2(pc, pa, pb, hp, hn, C4); rk0[nn] = ld3x2(pc, pa, pb, hp, hn, 512 + C4); rv0[nn] = ld3x2(pc, pa, pb, hp, hn, 1024 + C4);
        rr1[nn] = ld3x2(pc, pa, pb, hp, hn, C5); rk1[nn] = ld3x2(pc, pa, pb, hp, hn, 512 + C5); rv1[nn] = ld3x2(pc, pa, pb, hp, hn, 1024 + C5);
    }
    float ss = 0.f;
    float* frow = frow0 + fr * FSTR;
    const f32x4 w01[2] = {st.aw[0], st.aw[1]}, a01[2] = {st.aa[0], st.aa[1]}, w23[2] = {st.aw[2], st.aw[3]}, a23[2] = {st.aa[2], st.aa[3]};
    scan_produce_elem<0>(pl, fq, rr0, rk0, rv0, w01, a01, ss, frow);
    scan_produce_elem<2>(pl, fq, rr1, rk1, rv1, w23, a23, ss, frow);
    ss = fqsum(ss);
    const float inv = rsqrtf(fmaxf(ss, 1e-24f));
#pragma unroll
    for (int n = 0; n < 4; ++n) {
        const int c4 = n * 16 + fq * 4;
        f32x4 kk = *(const f32x4*)(frow + 0 * 64 + c4);
        f32x4 bb = *(const f32x4*)(frow + 2 * 64 + c4);
#pragma unroll
        for (int j = 0; j < 4; ++j) { kk[j] = kk[j] * inv; bb[j] = kk[j] * bb[j]; }
        *(f32x4*)(frow + 0 * 64 + c4) = kk;
        *(f32x4*)(frow + 2 * 64 + c4) = bb;
    }
}

typedef float f32x2 __attribute__((ext_vector_type(2)));
struct ScanHead { f32x4 kk[2]; f32x2 v; };
struct ScanBody { f32x4 w[2], bb[2], kd[2], r[2]; };
__device__ __forceinline__ void scan_ldh(ScanHead& c, const float* f, const float* fv) {
#pragma unroll
    for (int q = 0; q < 2; ++q) c.kk[q] = *(const f32x4*)(f + 0 * 64 + 4 * q);
    c.v = *(const f32x2*)fv;
}
__device__ __forceinline__ void scan_ldb(ScanBody& c, const float* f) {
#pragma unroll
    for (int q = 0; q < 2; ++q) {
        c.w[q] = *(const f32x4*)(f + 1 * 64 + 4 * q); c.bb[q] = *(const f32x4*)(f + 2 * 64 + 4 * q);
        c.kd[q] = *(const f32x4*)(f + 3 * 64 + 4 * q); c.r[q] = *(const f32x4*)(f + 4 * 64 + 4 * q);
    }
}
__device__ __forceinline__ void scan_unit(const Params& p, int l, int u, unsigned char* lds) {
    const int tid = ltid(), wid = __builtin_amdgcn_readfirstlane(tid >> 6), lane = tid & 63;
    const int b = u >> 4, h = (u >> 1) & 7, z = u & 1;
    float* fb = (float*)lds;
    bf16_t* Y = (bf16_t*)(p.ws + (z == 0 ? OFF_YF : OFF_YB));
    float* pl = fb + 3 * CHUNK * FSTR;
    for (int i = tid; i < 9 * 64; i += NTHREADS) {
        const int a = i >> 6, c = i & 63, C = h * 64 + c;
        float v;
        if (a < 3) v = p.rw_mu[(size_t)l * 1920 + a * 512 + C];
        else if (a == 3) v = p.rw_w0[((size_t)l * 2 + z) * 512 + C];
        else if (a == 4) v = p.rw_a0[((size_t)l * 2 + z) * 512 + C];
        else if (a == 5) v = p.rw_k_k[(size_t)l * 512 + C];
        else if (a == 6) v = p.rw_k_a[(size_t)l * 512 + C];
        else if (a == 7) v = p.rw_mu[(size_t)l * 1920 + 1536 + z * 64 + c];
        else v = p.rw_mu[(size_t)l * 1920 + 1664 + z * 64 + c];
        pl[i] = v;
    }
    __syncthreads();
    if (wid < 4) {
        f32x2 S2[8];
#pragma unroll
        for (int j = 0; j < 8; ++j) S2[j] = (f32x2){0.f, 0.f};
        __syncthreads();
        for (int c = 0; c < NCHUNK; ++c) {
            const float* fbc = fb + (c % 3) * CHUNK * FSTR + 8 * (lane & 7);
            const float* fbv = fb + (c % 3) * CHUNK * FSTR + 320 + 16 * wid + 2 * (lane >> 3);
            bf16_t* yp = Y + ((size_t)b * TPB) * 512 + h * 64 + 16 * wid + 2 * (lane >> 3);
            ScanHead ha, hb; ScanBody ba, bb_;
            scan_ldh(ha, fbc, fbv); scan_ldb(ba, fbc);
#define SCAN_STEP(HC, BC, HN, BN, SL) { \
                if ((SL) + 1 < CHUNK) { scan_ldh(HN, fbc + ((SL) + 1) * FSTR, fbv + ((SL) + 1) * FSTR); scan_ldb(BN, fbc + ((SL) + 1) * FSTR); } \
                f32x2 d0 = (f32x2){0.f, 0.f}, d1 = (f32x2){0.f, 0.f}; \
                _Pragma("unroll") for (int q = 0; q < 4; ++q) { const f32x2 k2 = (f32x2){HC.kk[q >> 1][2 * (q & 1)], HC.kk[q >> 1][2 * (q & 1) + 1]}; \
                    d0 = __builtin_elementwise_fma(S2[q], k2, d0); d1 = __builtin_elementwise_fma(S2[4 + q], k2, d1); } \
                const float sk0 = red8(d0[0] + d0[1]), sk1 = red8(d1[0] + d1[1]); \
                const f32x2 n0 = (f32x2){-sk0, -sk0}, n1 = (f32x2){-sk1, -sk1}, v0 = (f32x2){HC.v[0], HC.v[0]}, v1 = (f32x2){HC.v[1], HC.v[1]}; \
                f32x2 y0 = (f32x2){0.f, 0.f}, y1 = (f32x2){0.f, 0.f}; \
                _Pragma("unroll") for (int q = 0; q < 4; ++q) { \
                    const f32x2 w2 = (f32x2){BC.w[q >> 1][2 * (q & 1)], BC.w[q >> 1][2 * (q & 1) + 1]}, b2 = (f32x2){BC.bb[q >> 1][2 * (q & 1)], BC.bb[q >> 1][2 * (q & 1) + 1]}; \
                    const f32x2 kd2 = (f32x2){BC.kd[q >> 1][2 * (q & 1)], BC.kd[q >> 1][2 * (q & 1) + 1]}, r2 = (f32x2){BC.r[q >> 1][2 * (q & 1)], BC.r[q >> 1][2 * (q & 1) + 1]}; \
                    f32x2 t0 = S2[q] * w2; t0 = __builtin_elementwise_fma(b2, n0, t0); t0 = __builtin_elementwise_fma(kd2, v0, t0); \
                    f32x2 t1 = S2[4 + q] * w2; t1 = __builtin_elementwise_fma(b2, n1, t1); t1 = __builtin_elementwise_fma(kd2, v1, t1); \
                    S2[q] = t0; S2[4 + q] = t1; \
                    y0 = __builtin_elementwise_fma(t0, r2, y0); y1 = __builtin_elementwise_fma(t1, r2, y1); } \
                const float ya = red8(y0[0] + y0[1]), yb = red8(y1[0] + y1[1]); \
                const int pp = scan_pos(z, c * CHUNK + (SL)); \
                if ((lane & 7) == 0) *(unsigned*)(yp + (size_t)pp * 512) = pk_bf16(ya, yb); }
#pragma unroll 1
            for (int sl = 0; sl < CHUNK; sl += 2) {
                SCAN_STEP(ha, ba, hb, bb_, sl)
                SCAN_STEP(hb, bb_, ha, ba, sl + 1)
            }
            __syncthreads();
        }
    } else {
        ProdState st;
#pragma unroll
        for (int n = 0; n < 4; ++n) { st.aw[n] = (f32x4){0.f, 0.f, 0.f, 0.f}; st.aa[n] = (f32x4){0.f, 0.f, 0.f, 0.f}; }
        const int nrep = launder_i(1 + ((PROBE_MASK >> 10) & 1));
        const int pair = (wid - 4) >> 1, ph = (wid - 4) & 1;
        {
            float* f0 = fb + (pair % 3) * CHUNK * FSTR + ph * 16 * FSTR;
            scan_produce_A(p, pl, b, h, z, pair * CHUNK + ph * 16, f0, lane, st);
            if (pair == 0) scan_produce_B(p, pl, b, h, z, ph * 16, f0, lane, st);
        }
        __syncthreads();
        for (int c = 0; c < NCHUNK; ++c) {
            for (int rr_ = 0; rr_ < nrep; ++rr_) {
            if (pair == ((c + 1) & 1)) {
                if (c + 1 < NCHUNK) scan_produce_B(p, pl, b, h, z, (c + 1) * CHUNK + ph * 16, fb + ((c + 1) % 3) * CHUNK * FSTR + ph * 16 * FSTR, lane, st);
            } else {
                if (c + 2 < NCHUNK) scan_produce_A(p, pl, b, h, z, (c + 2) * CHUNK + ph * 16, fb + ((c + 2) % 3) * CHUNK * FSTR + ph * 16 * FSTR, lane, st);
            }
            }
            __syncthreads();
        }
    }
}

constexpr int ATT_STAGE = 20480;
__device__ __forceinline__ void attn_unit(const Params& p, int b, int h, int q0, int nkeys, unsigned char* lds, int do_write) {
    const int tid = ltid(), wid = __builtin_amdgcn_readfirstlane(tid >> 6), lane = tid & 63, fr = lane & 15, fq = lane >> 4;
    bf16_t* Q = (bf16_t*)(p.ws + OFF_Q);
    const bf16_t* KN = (const bf16_t*)(p.ws + OFF_KN);
    const bf16_t* KR = (const bf16_t*)(p.ws + OFF_KR);
    const bf16_t* VT = (const bf16_t*)(p.ws + OFF_VT);
    const size_t rb = (size_t)b * TPB;
    bf16x8 qf[2][3];
#pragma unroll
    for (int nq = 0; nq < 2; ++nq)
#pragma unroll
        for (int ks = 0; ks < 3; ++ks) qf[nq][ks] = *(const bf16x8*)(Q + (rb + q0 + wid * 32 + nq * 16 + fr) * 768 + h * 96 + ks * 32 + fq * 8);
    f32x4 oacc[4][2];
#pragma unroll
    for (int mt = 0; mt < 4; ++mt)
#pragma unroll
        for (int nq = 0; nq < 2; ++nq) oacc[mt][nq] = (f32x4){0.f, 0.f, 0.f, 0.f};
    float mrun[2] = {-1e30f, -1e30f}, lsum[2] = {0.f, 0.f};
    const int c8 = (lane & 7) ^ ((4 * wid + (lane >> 4)) & 7);
    const bf16_t* knp = KN + (rb + 8 * wid + (lane >> 3)) * 512 + h * 64 + c8 * 8;
    const bf16_t* vtp = VT + ((size_t)(b * 8 + h) * 64 + 8 * wid + (lane >> 3)) * TPB + c8 * 8;
    const int c4 = (lane & 3) ^ ((lane >> 4) & 3);
    const bf16_t* krp = KR + (rb + 16 * (wid & 3) + (lane >> 2)) * 32 + c4 * 8;
    auto issue = [&](int t, int stg) {
        unsigned char* base = lds + stg * ATT_STAGE;
        const int k0 = t * 64;
        __builtin_amdgcn_global_load_lds((const GLB_AS unsigned*)(knp + (size_t)k0 * 512), (LDS_AS unsigned*)(base + wid * 1024), 16, 0, 0);
        __builtin_amdgcn_global_load_lds((const GLB_AS unsigned*)(vtp + k0), (LDS_AS unsigned*)(base + 12288 + wid * 1024), 16, 0, 0);
        if (wid < 4) __builtin_amdgcn_global_load_lds((const GLB_AS unsigned*)(krp + (size_t)k0 * 32), (LDS_AS unsigned*)(base + 8192 + wid * 1024), 16, 0, 0);
    };
    const int ntile = nkeys / 64;
    const int kz = fr >> 1, rz = (fr >> 2) & 3;
    issue(0, 0);
    asm volatile("s_waitcnt vmcnt(0)" ::: "memory");
    __builtin_amdgcn_s_barrier();
    asm volatile("" ::: "memory");
    for (int t = 0; t < ntile; ++t) {
        if (t + 1 < ntile) issue(t + 1, (t + 1) & 1);
        const unsigned char* Ks = lds + (t & 1) * ATT_STAGE;
        const unsigned char* Rs = Ks + 8192;
        const unsigned char* Vs = Ks + 12288;
        f32x4 sacc[4][2];
#pragma unroll
        for (int km = 0; km < 4; ++km)
#pragma unroll
            for (int nq = 0; nq < 2; ++nq) sacc[km][nq] = (f32x4){0.f, 0.f, 0.f, 0.f};
#pragma unroll
        for (int ks = 0; ks < 3; ++ks)
#pragma unroll
            for (int km = 0; km < 4; ++km) {
                const bf16x8 kf = ks < 2 ? *(const bf16x8*)(Ks + (km * 16 + fr) * 128 + (((ks * 4 + fq) ^ kz) * 16))
                                         : *(const bf16x8*)(Rs + (km * 16 + fr) * 64 + ((fq ^ rz) * 16));
#pragma unroll
                for (int nq = 0; nq < 2; ++nq) sacc[km][nq] = __builtin_amdgcn_mfma_f32_16x16x32_bf16(kf, qf[nq][ks], sacc[km][nq], 0, 0, 0);
            }
        bf16x8 pf[2][2];
#pragma unroll
        for (int nq = 0; nq < 2; ++nq) {
            float mx = -1e30f;
#pragma unroll
            for (int km = 0; km < 4; ++km)
#pragma unroll
                for (int j = 0; j < 4; ++j) mx = fmaxf(mx, sacc[km][nq][j]);
            mx = fqmax(mx);
            const float mnew = fmaxf(mrun[nq], mx);
            const float alpha = __builtin_amdgcn_exp2f(mrun[nq] - mnew);
            mrun[nq] = mnew;
            float ps = 0.f;
#pragma unroll
            for (int km = 0; km < 4; ++km)
#pragma unroll
                for (int j = 0; j < 4; ++j) { const float e = __builtin_amdgcn_exp2f(sacc[km][nq][j] - mnew); sacc[km][nq][j] = e; ps += e; }
            lsum[nq] = lsum[nq] * alpha + ps;
#pragma unroll
            for (int mt = 0; mt < 4; ++mt) oacc[mt][nq] = oacc[mt][nq] * alpha;
#pragma unroll
            for (int kc = 0; kc < 2; ++kc) {
                union { uint4 u; bf16x8 v; } r;
                r.u.x = pk_bf16(sacc[2 * kc][nq][0], sacc[2 * kc][nq][1]); r.u.y = pk_bf16(sacc[2 * kc][nq][2], sacc[2 * kc][nq][3]);
                r.u.z = pk_bf16(sacc[2 * kc + 1][nq][0], sacc[2 * kc + 1][nq][1]); r.u.w = pk_bf16(sacc[2 * kc + 1][nq][2], sacc[2 * kc + 1][nq][3]);
                pf[kc][nq] = r.v;
            }
        }
#pragma unroll
        for (int mt = 0; mt < 4; ++mt)
#pragma unroll
            for (int kc = 0; kc < 2; ++kc) {
                union { uint2 h2[2]; bf16x8 v; } r;
                const unsigned char* vrow = Vs + (mt * 16 + fr) * 128 + (fq & 1) * 8;
                r.h2[0] = *(const uint2*)(vrow + (((4 * kc + (fq >> 1)) ^ kz) * 16));
                r.h2[1] = *(const uint2*)(vrow + (((4 * kc + 2 + (fq >> 1)) ^ kz) * 16));
#pragma unroll
                for (int nq = 0; nq < 2; ++nq) oacc[mt][nq] = __builtin_amdgcn_mfma_f32_16x16x32_bf16(r.v, pf[kc][nq], oacc[mt][nq], 0, 0, 0);
            }
        asm volatile("s_waitcnt vmcnt(0) lgkmcnt(0)" ::: "memory");
        __builtin_amdgcn_s_barrier();
        asm volatile("" ::: "memory");
    }
#pragma unroll
    for (int nq = 0; nq < 2; ++nq) {
        const float inv = 1.0f / fqsum(lsum[nq]);
        bf16_t* orow = Q + (rb + q0 + wid * 32 + nq * 16 + fr) * 768 + h * 96;
#pragma unroll
        for (int mt = 0; mt < 4; ++mt) {
            uint2 o; o.x = pk_bf16(oacc[mt][nq][0] * inv, oacc[mt][nq][1] * inv); o.y = pk_bf16(oacc[mt][nq][2] * inv, oacc[mt][nq][3] * inv);
            if (do_write) *(uint2*)(orow + mt * 16 + fq * 4) = o;
        }
    }
}

__device__ __forceinline__ void p3_phase(const Params& pin, int l, unsigned char* lds) {
    const Params p = launder(pin); l = launder_i(l);
    for (int r = 0, nr = launder_i(1 + ((PROBE_MASK >> 1) & 1)); r < nr; ++r)
        for (int u = blockIdx.x; u < 256; u += gridDim.x) scan_unit(p, l, u, lds);
    const int nunits = (l == DEPTH - 1) ? 1024 : 1152;
    for (int r = launder_i(((PROBE_MASK >> 9) & 1) ? 0 : 1); r < 2; ++r)
    for (int u = blockIdx.x; u < nunits; u += gridDim.x) {
        if (u < 1024) { const int bh = u >> 3, qt = u & 7; attn_unit(p, bh >> 3, bh & 7, CTXL + qt * 256, TPB, lds, r); }
        else { const int bh = u - 1024; attn_unit(p, bh >> 3, bh & 7, 0, CTXL, lds, r); }
    }
}

__device__ __forceinline__ void p35_phase(const Params& pin, int l, bool skip_ctx, unsigned char* lds) {
    const Params p = launder(pin); l = launder_i(l); const int tid = ltid();
    const bf16_t* SG = (const bf16_t*)(p.ws + OFF_SG);
    const bf16_t* W = (const bf16_t*)(p.ws + OFF_W) + WO_GUP;
    const bf16_t* YF = (const bf16_t*)(p.ws + OFF_YF);
    const bf16_t* YB = (const bf16_t*)(p.ws + OFF_YB);
    const bf16_t* Hr = (const bf16_t*)(p.ws + OFF_R3);
    bf16_t* RWO = (bf16_t*)(p.ws + OFF_RWO);
    const float* mu = p.rw_mu + (size_t)l * 1920;
    const int lane = tid & 63, wid = tid >> 6, wr = wid >> 1, wc = wid & 1, fr = lane & 15, fq = lane >> 4;
    float* gt = (float*)lds;
    constexpr int GP = 132;
    for (int t = blockIdx.x; t < 288 * 4; t += gridDim.x) {
        int mt, nt; tile_mn(t, 4, mt, nt);
        if (skip_ctx && (mt % 18) < 2) continue;
        f32x4 acc[2][4]; zero_acc<2>(acc);
        gemm_mainloop<2, 1>(acc, SG + (size_t)mt * 128 * 128, 128, 64, W + (size_t)nt * 128 * 128, 128, 2, lds, tid);
#pragma unroll
        for (int m = 0; m < 2; ++m)
#pragma unroll
            for (int n = 0; n < 4; ++n) *(f32x4*)(gt + (wr * 32 + m * 16 + fr) * GP + wc * 64 + n * 16 + fq * 4) = acc[m][n];
        __syncthreads();
        const int pp0 = (mt % 18) * 128;
#pragma unroll 1
        for (int it = 0; it < 4; ++it) {
            const int item = tid + it * NTHREADS, lrow = item >> 4, cg = item & 15, pp = pp0 + lrow;
            const size_t row = (size_t)mt * 128 + lrow;
            const int C = nt * 128 + cg * 8;
            const bool hp = (pp != 0 && pp != CTXL), hn = (pp != CTXL - 1 && pp != TPB - 1);
            const bf16_t* hr = Hr + row * 1920;
            float yf[8], yb[8], r8[8], k8[8], v8[8];
            unpack8(*(const uint4*)(YF + row * 512 + C), yf); unpack8(*(const uint4*)(YB + row * 512 + C), yb);
            shift8(hr, hp, hn, C, mu, r8); shift8(hr, hp, hn, 512 + C, mu, k8); shift8(hr, hp, hn, 1024 + C, mu, v8);
            const float* rkp = p.rw_r_k + (size_t)l * 512 + C;
            float s1 = 0.f, bs = 0.f;
#pragma unroll
            for (int i = 0; i < 8; ++i) { yf[i] += yb[i]; s1 += yf[i]; bs += r8[i] * k8[i] * rkp[i]; }
            s1 = red8(s1); bs = red8(bs);
            const float mean = s1 * (1.0f / 64.0f);
            float s2 = 0.f;
#pragma unroll
            for (int i = 0; i < 8; ++i) { const float d = yf[i] - mean; s2 += d * d; }
            s2 = red8(s2);
            const float rstd = rsqrtf(s2 * (1.0f / 64.0f) + 64e-5f);
            const float* ggp = p.rw_gn_g + (size_t)l * 512 + C; const float* gbp = p.rw_gn_b + (size_t)l * 512 + C;
            const f32x4 g0 = *(const f32x4*)(gt + lrow * GP + cg * 8), g1 = *(const f32x4*)(gt + lrow * GP + cg * 8 + 4);
            float o[8];
#pragma unroll
            for (int i = 0; i < 8; ++i) o[i] = ((yf[i] - mean) * rstd * ggp[i] + gbp[i] + bs * v8[i]) * (i < 4 ? g0[i] : g1[i - 4]);
            uint4 ov; ov.x = pk_bf16(o[0], o[1]); ov.y = pk_bf16(o[2], o[3]); ov.z = pk_bf16(o[4], o[5]); ov.w = pk_bf16(o[6], o[7]);
            *(uint4*)(RWO + row * 512 + C) = ov;
        }
        __syncthreads();
    }
}

__device__ __forceinline__ void p4_phase(const Params& pin, bool skip_ctx, unsigned char* lds) {
    const Params p = launder(pin); const int tid = ltid();
    const bf16_t* XM = (const bf16_t*)(p.ws + OFF_R6);
    const bf16_t* W = (const bf16_t*)(p.ws + OFF_W);
    bf16_t* MG = (bf16_t*)(p.ws + OFF_MRG);
    const int lane = tid & 63, wid = tid >> 6, wr = wid >> 1, wc = wid & 1, fr = lane & 15, fq = lane >> 4;
    auto seg = [&](int t, int j) {
        int mt, nt; tile_mn(t, 8, mt, nt);
        const int i = j >> 1; Seg g;
        if (!(j & 1)) { g.A = XM + (size_t)mt * 128 * 1024; g.lda = 1024; g.a_kstep = 64; g.Bt = W + WO_IN + (size_t)(4224 + i * 1024 + nt * 128) * 1024; g.ldb = 1024; g.nk = 16; }
        else {
            if (i == 0) { g.A = (const bf16_t*)(p.ws + OFF_Q) + (size_t)mt * 128 * 768; g.lda = 768; g.a_kstep = 96; g.Bt = W + WO_OA; }
            else if (i == 1) { g.A = (const bf16_t*)(p.ws + OFF_R5) + (size_t)mt * 128 * 512; g.lda = 512; g.a_kstep = 64; g.Bt = W + WO_OC; }
            else { g.A = (const bf16_t*)(p.ws + OFF_RWO) + (size_t)mt * 128 * 512; g.lda = 512; g.a_kstep = 64; g.Bt = W + WO_OR; }
            g.Bt += (size_t)nt * 128 * 512; g.ldb = 512; g.nk = 8;
        }
        return g;
    };
    auto valid = [&](int t) { int mt, nt; tile_mn(t, 8, mt, nt); return !(skip_ctx && (mt % 18) < 2); };
    auto nextv = [&](int t) { while (t < 288 * 8 && !valid(t)) t += gridDim.x; return t; };
    int st = 0; bool first = true;
    for (int t = nextv(blockIdx.x); t < 288 * 8;) {
        int mt, nt; tile_mn(t, 8, mt, nt);
        const int tn = nextv(t + gridDim.x); const bool hn = tn < 288 * 8;
        f32x4 mg[2][4]; zero_acc<2>(mg);
        for (int i = 0; i < 3; ++i) {
            f32x4 g[2][4]; zero_acc<2>(g);
            gemm_stream<2, 1>(g, seg(t, 2 * i), seg(t, 2 * i + 1), true, first, st, lds, tid); first = false;
            f32x4 a[2][4]; zero_acc<2>(a);
            const bool lastseg = (i == 2);
            gemm_stream<2, 1>(a, seg(t, 2 * i + 1), lastseg ? seg(hn ? tn : t, 0) : seg(t, 2 * i + 2), lastseg ? hn : true, false, st, lds, tid);
#pragma unroll
            for (int m = 0; m < 2; ++m)
#pragma unroll
                for (int n = 0; n < 4; ++n)
#pragma unroll
                    for (int j = 0; j < 4; ++j) mg[m][n][j] += sigmoidf_(g[m][n][j]) * a[m][n][j];
        }
#pragma unroll
        for (int m = 0; m < 2; ++m) {
            const size_t row = (size_t)mt * 128 + wr * 32 + m * 16 + fr;
#pragma unroll
            for (int n = 0; n < 4; ++n) {
                uint2 o; o.x = pk_bf16(mg[m][n][0], mg[m][n][1]); o.y = pk_bf16(mg[m][n][2], mg[m][n][3]);
                *(uint2*)(MG + row * 1024 + nt * 128 + wc * 64 + n * 16 + fq * 4) = o;
            }
        }
        t = tn;
    }
}

__device__ __forceinline__ void resid_gemm_phase(const Params& pin, int l, size_t a_off, int lda, int nk, size_t w_off, int ldb, int goff, bool x_from_input, const float* lng, const float* lnb, bool skip_ctx, unsigned char* lds) {
    const Params p = launder(pin); l = launder_i(l);
    const int tid = ltid();
    const int lane = tid & 63, wid = tid >> 6, wr = wid >> 1, wc = wid & 1, fr = lane & 15, fq = lane >> 4;
    const bf16_t* A = (const bf16_t*)(p.ws + a_off);
    const bf16_t* Wt = (const bf16_t*)(p.ws + OFF_W) + w_off;
    for (int t = blockIdx.x; t < 144 * 8; t += gridDim.x) {
        int mt, nt; tile_mn(t, 8, mt, nt);
        if (skip_ctx && (mt % 9) == 0) continue;
        f32x4 acc[4][4]; zero_acc<4>(acc);
        gemm_mainloop<4, 1>(acc, A + (size_t)mt * 256 * lda, lda, 64, Wt + (size_t)nt * 128 * ldb, ldb, nk, lds, tid);
        const int b = mt / 9, pp0 = (mt % 9) * 256;
        const float* gv = modv_ptr(p, l, b, pp0) + goff;
        const float* stats = (const float*)(p.ws + OFF_STATS);
#pragma unroll
        for (int m = 0; m < 4; ++m) {
            const int pp = pp0 + wr * 64 + m * 16 + fr;
            const float* xi = x_rd(p, x_from_input, b, pp);
            float* xo = x_wr(p, b, pp);
            float mean = 0.f, rstd = 1.f;
            if (!x_from_input) { const size_t row = (size_t)mt * 256 + wr * 64 + m * 16 + fr; mean = stats[row * 2]; rstd = stats[row * 2 + 1]; }
#pragma unroll
            for (int n = 0; n < 4; ++n) {
                const int col = nt * 128 + wc * 64 + n * 16 + fq * 4;
                f32x4 xv = *(const f32x4*)(xi + col); const f32x4 g4 = *(const f32x4*)(gv + col);
                if (!x_from_input) {
                    const f32x4 lg = *(const f32x4*)(lng + col), lb = *(const f32x4*)(lnb + col);
#pragma unroll
                    for (int j = 0; j < 4; ++j) xv[j] = (xv[j] - mean) * rstd * lg[j] + lb[j];
                }
                f32x4 o;
#pragma unroll
                for (int j = 0; j < 4; ++j) o[j] = ALPHA * xv[j] + g4[j] * acc[m][n][j];
                *(f32x4*)(xo + col) = o;
            }
        }
    }
}

__device__ __forceinline__ void ln_phase(const Params& pin, const float* g, const float* bta, int lmod, int shoff, bool write_xmod, bool write_x, bool skip_ctx) {
    const Params p = launder(pin); lmod = launder_i(lmod);
    const int tid = ltid(), wid = tid >> 6, lane = tid & 63;
    bf16_t* xm = (bf16_t*)(p.ws + OFF_R6);
    float* stats = (float*)(p.ws + OFF_STATS);
    for (int row = blockIdx.x * 8 + wid; row < MROWS; row += gridDim.x * 8) {
        const int b = row / TPB, pp = row % TPB;
        if (skip_ctx && pp < CTXL) continue;
        float* xp = x_wr(p, b, pp);
        f32x4 v[4];
        float s = 0.f;
#pragma unroll
        for (int i = 0; i < 4; ++i) { v[i] = *(const f32x4*)(xp + i * 256 + lane * 4); s += (v[i][0] + v[i][1]) + (v[i][2] + v[i][3]); }
        const float mean = wave_sum(s) * (1.0f / 1024.0f);
        float q = 0.f;
#pragma unroll
        for (int i = 0; i < 4; ++i)
#pragma unroll
            for (int j = 0; j < 4; ++j) { const float d = v[i][j] - mean; q += d * d; }
        const float rstd = rsqrtf(wave_sum(q) * (1.0f / 1024.0f) + 1e-5f);
        if (lane == 0) { stats[(size_t)row * 2] = mean; stats[(size_t)row * 2 + 1] = rstd; }
        const float* mv = write_xmod ? modv_ptr(p, lmod, b, pp) + shoff : nullptr;
#pragma unroll
        for (int i = 0; i < 4; ++i) {
            const int c = i * 256 + lane * 4;
            const f32x4 g4 = *(const f32x4*)(g + c), b4 = *(const f32x4*)(bta + c);
            f32x4 o;
#pragma unroll
            for (int j = 0; j < 4; ++j) o[j] = (v[i][j] - mean) * rstd * g4[j] + b4[j];
            if (write_x) *(f32x4*)(xp + c) = o;
            if (write_xmod) {
                const f32x4 sh = *(const f32x4*)(mv + c), sc = *(const f32x4*)(mv + 1024 + c);
                uint2 ov; ov.x = pk_bf16(o[0] * (1.f + sc[0]) + sh[0], o[1] * (1.f + sc[1]) + sh[1]); ov.y = pk_bf16(o[2] * (1.f + sc[2]) + sh[2], o[3] * (1.f + sc[3]) + sh[3]);
                *(uint2*)(xm + (size_t)row * 1024 + c) = ov;
            }
        }
    }
}

__device__ __forceinline__ void p7_phase(const Params& pin, bool skip_ctx, unsigned char* lds) {
    const Params p = launder(pin); const int tid = ltid();
    const bf16_t* A = (const bf16_t*)(p.ws + OFF_R6);
    const bf16_t* W = (const bf16_t*)(p.ws + OFF_W) + WO_13;
    bf16_t* HF = (bf16_t*)(p.ws + OFF_HF);
    const int lane = tid & 63, wid = tid >> 6, wr = wid >> 2, wc = wid & 3, fr = lane & 15, fq = lane >> 4;
    auto seg = [&](int t) { int mt, nt; tile_mn(t, 22, mt, nt); Seg g; g.A = A + (size_t)mt * 256 * 1024; g.Bt = W + (size_t)nt * 256 * 1024; g.lda = 1024; g.a_kstep = 64; g.ldb = 1024; g.nk = 16; return g; };
    auto valid = [&](int t) { int mt, nt; tile_mn(t, 22, mt, nt); return !(skip_ctx && (mt % 9) == 0); };
    auto nextv = [&](int t) { while (t < 144 * 22 && !valid(t)) t += gridDim.x; return t; };
    int st = 0; bool first = true;
    for (int t = nextv(blockIdx.x); t < 144 * 22;) {
        int mt, nt; tile_mn(t, 22, mt, nt);
        const int tn = nextv(t + gridDim.x); const bool hn = tn < 144 * 22;
        f32x4 acc[8][4]; zero_acc<8>(acc);
        gemm_stream256(acc, seg(t), seg(hn ? tn : t), hn, first, st, lds, tid); first = false;
        const int G = nt * 4 + wc;
#pragma unroll
        for (int m = 0; m < 8; ++m) {
            const size_t row = (size_t)mt * 256 + wr * 128 + m * 16 + fr;
#pragma unroll
            for (int n = 0; n < 2; ++n) {
                float o[4];
#pragma unroll
                for (int j = 0; j < 4; ++j) o[j] = siluf_(acc[m][n][j]) * acc[m][n + 2][j];
                uint2 ov; ov.x = pk_bf16(o[0], o[1]); ov.y = pk_bf16(o[2], o[3]);
                *(uint2*)(HF + row * DFF + G * 32 + n * 16 + fq * 4) = ov;
            }
        }
        t = tn;
    }
}

__global__ void __launch_bounds__(NTHREADS) fwd_megakernel(Params p) {
    extern __shared__ __attribute__((aligned(16))) unsigned char lds[];
    cg::grid_group grid = cg::this_grid();
    unsigned* gbar = (unsigned*)(p.ws + OFF_BAR); unsigned epoch = 0;
#define GSYNC() grid_barrier(gbar, epoch)
    if (p.ws == nullptr) grid.sync();
    modv_phase(p, lds);
    convert_layer(p, 0, lds);
    {
        bf16_t* Wm = (bf16_t*)(p.ws + OFF_W) + WO_IN + (size_t)672 * 1024;
        for (int i = blockIdx.x * NTHREADS + threadIdx.x; i < 96 * 1024 / 2; i += gridDim.x * NTHREADS) ((unsigned*)Wm)[i] = 0u;
    }
    GSYNC();
    xmod0_phase(p);
    GSYNC();
#pragma unroll 1
    for (int l = 0; l < DEPTH; ++l) {
        const bool last = (l == DEPTH - 1);
        for (int r = 0, nr = launder_i(1 + ((PROBE_MASK >> 2) & 1)); r < nr; ++r) p1_phase(p, lds);
        GSYNC();
        for (int r = 0, nr = launder_i(1 + ((PROBE_MASK >> 3) & 1)); r < nr; ++r) p2a_phase(p, l);
        GSYNC();
        for (int r = 0, nr = launder_i(1 + ((PROBE_MASK >> 4) & 1)); r < nr; ++r) p2b_phase(p, l, lds);
        GSYNC();
        p3_phase(p, l, lds);
        GSYNC();
        for (int r = 0, nr = launder_i(1 + ((PROBE_MASK >> 5) & 1)); r < nr; ++r) p35_phase(p, l, last, lds);
        GSYNC();
        for (int r = 0, nr = launder_i(1 + ((PROBE_MASK >> 6) & 1)); r < nr; ++r) p4_phase(p, last, lds);
        GSYNC();
        resid_gemm_phase(p, l, OFF_MRG, 1024, 16, WO_OUT, 1024, 2048, l == 0, p.ln2_g + (l > 0 ? l - 1 : 0) * 1024, p.ln2_b + (l > 0 ? l - 1 : 0) * 1024, last, lds);
        GSYNC();
        ln_phase(p, p.ln1_g + l * 1024, p.ln1_b + l * 1024, l, 3072, true, false, last);
        GSYNC();
        for (int r = 0, nr = launder_i(1 + ((PROBE_MASK >> 0) & 1)); r < nr; ++r) p7_phase(p, last, lds);
        GSYNC();
        resid_gemm_phase(p, l, OFF_HF, DFF, 44, WO_2, DFF, 5120, false, p.ln1_g + l * 1024, p.ln1_b + l * 1024, last, lds);
        GSYNC();
        ln_phase(p, p.ln2_g + l * 1024, p.ln2_b + l * 1024, last ? l : l + 1, 0, !last, last, last);
        if (!last) for (int r = 0, nr = launder_i(1 + ((PROBE_MASK >> 7) & 1)); r < nr; ++r) convert_layer(p, l + 1, lds);
        for (int r = 0, nr = launder_i(((PROBE_MASK >> 8) & 1) * 10); r < nr; ++r) GSYNC();
        GSYNC();
    }
}

extern "C" void kernel_launch(void* const* d_in, const int* in_sizes, int n_in, void* d_out,
                              int out_size, void* d_ws, size_t ws_size, hipStream_t stream) {
    static int grid_blocks = 0;
    if (!grid_blocks) {
        int dev = 0, cus = 0, per_cu = 0;
        hipGetDevice(&dev);
        hipDeviceGetAttribute(&cus, hipDeviceAttributeMultiprocessorCount, dev);
        if (hipFuncSetAttribute((const void*)fwd_megakernel, hipFuncAttributeMaxDynamicSharedMemorySize, LDS_BYTES) != hipSuccess)
            fprintf(stderr, "hipFuncSetAttribute failed\n");
        hipOccupancyMaxActiveBlocksPerMultiprocessor(&per_cu, (const void*)fwd_megakernel, NTHREADS, LDS_BYTES);
        if (per_cu < 1) fprintf(stderr, "occupancy query says %d blocks/CU\n", per_cu);
        (void)hipGetLastError();
        grid_blocks = cus > 0 ? cus : 256;
        if (ws_size < WS_END) { fprintf(stderr, "workspace too small: %zu < %zu\n", ws_size, (size_t)WS_END); grid_blocks = -1; }
        if (n_in != 33) { fprintf(stderr, "expected 33 inputs, got %d\n", n_in); grid_blocks = -1; }
    }
    if (grid_blocks < 0) return;
    if (hipMemsetAsync((unsigned char*)d_ws + OFF_BAR, 0, 1024, stream) != hipSuccess) fprintf(stderr, "memset failed\n");
    Params p{};
    const float** pp = (const float**)&p;
    for (int i = 0; i < 33; ++i) pp[i] = (const float*)d_in[i];
    p.out = (float*)d_out;
    p.ws = (unsigned char*)d_ws;
    void* args[] = {&p};
    hipError_t e = hipLaunchCooperativeKernel((void*)fwd_megakernel, dim3(grid_blocks), dim3(NTHREADS), args, LDS_BYTES, stream);
    if (e != hipSuccess) fprintf(stderr, "cooperative launch failed: %s (grid %d)\n", hipGetErrorString(e), grid_blocks);
}
```

```cpp
#include <hip/hip_runtime.h>
#include <hip/hip_cooperative_groups.h>
#include <cstdio>
#include <cstdint>
namespace cg = cooperative_groups;

typedef unsigned short bf16_t;
typedef short bf16x8 __attribute__((ext_vector_type(8)));
typedef float f32x4 __attribute__((ext_vector_type(4)));

#ifndef PROBE_MASK
#define PROBE_MASK 0
#endif
constexpr int BATCH = 16, SEQ = 2048, CTXL = 256, DM = 1024, DEPTH = 4, DFF = 2816, DIN = 7200;
constexpr int TPB = SEQ + CTXL;
constexpr int MROWS = BATCH * TPB;
constexpr int NTHREADS = 512;
constexpr int LDS_BYTES = 152 * 1024;
constexpr float ALPHA = 1.681792830507429f;
constexpr float QSCALE = 0.10206207261596575f * 1.4426950408889634f;

constexpr size_t WO_IN = 0;
constexpr size_t WO_UQ = WO_IN + (size_t)7296 * 1024;
constexpr size_t WO_UKV = WO_UQ + (size_t)768 * 384;
constexpr size_t WO_OA = WO_UKV + (size_t)1024 * 256;
constexpr size_t WO_OC = WO_OA + (size_t)1024 * 512;
constexpr size_t WO_OR = WO_OC + (size_t)1024 * 512;
constexpr size_t WO_OUT = WO_OR + (size_t)1024 * 512;
constexpr size_t WO_13 = WO_OUT + (size_t)1024 * 1024;
constexpr size_t WO_2 = WO_13 + (size_t)5632 * 1024;
constexpr size_t WO_UP = WO_2 + (size_t)1024 * 2816;
constexpr size_t WO_AUP = WO_UP + (size_t)2 * 512 * 64;
constexpr size_t WO_GUP = WO_AUP + (size_t)2 * 512 * 64;
constexpr size_t W_ELEMS = WO_GUP + (size_t)512 * 128;

constexpr size_t al256(size_t x) { return (x + 255) & ~(size_t)255; }
constexpr size_t OFF_BAR = 0;
constexpr size_t OFF_W = 1024;
constexpr size_t OFF_MODV = al256(OFF_W + W_ELEMS * 2);
constexpr size_t OFF_ROPE = al256(OFF_MODV + (size_t)4 * 17 * 6144 * 4);
constexpr size_t OFF_RSQ = al256(OFF_ROPE + 64 * 8 * 2 * 4);
constexpr size_t OFF_RSKV = al256(OFF_RSQ + (size_t)MROWS * 4);
constexpr size_t OFF_STATS = al256(OFF_RSKV + (size_t)MROWS * 4);
constexpr size_t OFF_XC = al256(OFF_STATS + (size_t)MROWS * 8);
constexpr size_t OFF_R1 = al256(OFF_XC + (size_t)BATCH * CTXL * DM * 4);
constexpr size_t OFF_R2 = al256(OFF_R1 + (size_t)MROWS * 672 * 2);
constexpr size_t OFF_R3 = OFF_R2 + (size_t)MROWS * 1536 * 2;
constexpr size_t OFF_R4 = al256(OFF_R3 + (size_t)MROWS * 1920 * 2);
constexpr size_t OFF_R5 = al256(OFF_R4 + (size_t)MROWS * (512 + 512 + 32) * 2);
constexpr size_t OFF_R6 = al256(OFF_R5 + (size_t)MROWS * 512 * 2);
constexpr size_t WS_END = al256(OFF_R6 + (size_t)MROWS * 1024 * 2);
constexpr size_t OFF_Q = OFF_R2;
constexpr size_t OFF_YF = OFF_R2 + (size_t)MROWS * 768 * 2;
constexpr size_t OFF_SG = OFF_YF + (size_t)MROWS * 512 * 2;
constexpr size_t OFF_YB = OFF_R1;
constexpr size_t OFF_KN = OFF_R4;
constexpr size_t OFF_VT = OFF_R4 + (size_t)MROWS * 512 * 2;
constexpr size_t OFF_KR = OFF_VT + (size_t)MROWS * 512 * 2;
constexpr size_t OFF_RWO = OFF_R4;
constexpr size_t OFF_MRG = OFF_R3;
constexpr size_t OFF_HF = OFF_R2;
static_assert(OFF_SG + (size_t)MROWS * 128 * 2 <= OFF_R3, "R2 overlay overflow");
static_assert((size_t)MROWS * 2816 * 2 <= OFF_R4 - OFF_R2, "HF overflow");

struct Params {
    const float *x, *c, *ctx, *c_ctx, *mod_w, *mod_b, *w_in, *q_norm, *w_uq, *kv_norm, *w_ukv, *w_o_attn,
        *conv_w, *w_o_conv, *rw_mu, *rw_w0, *rw_w_up, *rw_a0, *rw_a_up, *rw_g_up, *rw_k_k, *rw_k_a,
        *rw_r_k, *rw_gn_g, *rw_gn_b, *w_o_rwkv, *w_out, *ln1_g, *ln1_b, *ffn_w13, *ffn_w2, *ln2_g, *ln2_b;
    float* out;
    unsigned char* ws;
};

typedef __attribute__((address_space(1))) unsigned char gchar_t;
typedef __attribute__((address_space(1))) float gfloat_t;
__device__ __forceinline__ Params launder(const Params& a) {
    Params q = a;
    unsigned long long w = (unsigned long long)a.ws, o = (unsigned long long)a.out;
    unsigned wl = __builtin_amdgcn_readfirstlane((unsigned)w), wh = __builtin_amdgcn_readfirstlane((unsigned)(w >> 32));
    unsigned ol = __builtin_amdgcn_readfirstlane((unsigned)o), oh = __builtin_amdgcn_readfirstlane((unsigned)(o >> 32));
    asm volatile("" : "+s"(wl), "+s"(wh), "+s"(ol), "+s"(oh));
    w = ((unsigned long long)wh << 32) | wl; o = ((unsigned long long)oh << 32) | ol;
    q.ws = (unsigned char*)(gchar_t*)w; q.out = (float*)(gfloat_t*)o;
    return q;
}
__device__ __forceinline__ int launder_i(int v) { v = __builtin_amdgcn_readfirstlane(v); asm volatile("" : "+s"(v)); return v; }
__device__ __forceinline__ int ltid() { int t = threadIdx.x; asm volatile("" : "+v"(t)); return t; }
__device__ __forceinline__ unsigned pk_bf16(float lo, float hi) { unsigned r; asm("v_cvt_pk_bf16_f32 %0, %1, %2" : "=v"(r) : "v"(lo), "v"(hi)); return r; }
__device__ __forceinline__ float bf_lo(unsigned u) { return __uint_as_float(u << 16); }
__device__ __forceinline__ float bf_hi(unsigned u) { return __uint_as_float(u & 0xffff0000u); }
__device__ __forceinline__ float bf1(bf16_t h) { return __uint_as_float(((unsigned)h) << 16); }
__device__ __forceinline__ float x32sum(float x) { unsigned u = __float_as_uint(x); auto r = __builtin_amdgcn_permlane32_swap(u, u, false, false); return __uint_as_float(r[0]) + __uint_as_float(r[1]); }
__device__ __forceinline__ float x16sum(float x) { unsigned u = __float_as_uint(x); auto r = __builtin_amdgcn_permlane16_swap(u, u, false, false); return __uint_as_float(r[0]) + __uint_as_float(r[1]); }
__device__ __forceinline__ float x32max(float x) { unsigned u = __float_as_uint(x); auto r = __builtin_amdgcn_permlane32_swap(u, u, false, false); return fmaxf(__uint_as_float(r[0]), __uint_as_float(r[1])); }
__device__ __forceinline__ float x16max(float x) { unsigned u = __float_as_uint(x); auto r = __builtin_amdgcn_permlane16_swap(u, u, false, false); return fmaxf(__uint_as_float(r[0]), __uint_as_float(r[1])); }
__device__ __forceinline__ float fqsum(float x) { return x16sum(x32sum(x)); }
__device__ __forceinline__ float fqmax(float x) { return x16max(x32max(x)); }
__device__ __forceinline__ float wave_sum(float v) {
#pragma unroll
    for (int o = 1; o < 16; o <<= 1) v += __shfl_xor(v, o);
    return fqsum(v);
}
template <int CTRL> __device__ __forceinline__ float dpp_add(float x) { return x + __uint_as_float((unsigned)__builtin_amdgcn_update_dpp(0, (int)__float_as_uint(x), CTRL, 0xf, 0xf, true)); }
__device__ __forceinline__ float red8(float x) { x = dpp_add<0xB1>(x); x = dpp_add<0x4E>(x); x = dpp_add<0x141>(x); return x; }
__device__ __forceinline__ float sigmoidf_(float x) { return 1.0f / (1.0f + __expf(-x)); }
__device__ __forceinline__ float siluf_(float x) { return x / (1.0f + __expf(-x)); }

__device__ __forceinline__ const float* x_rd(const Params& p, bool from_input, int b, int pp) {
    if (pp < CTXL) return (from_input ? p.ctx : (const float*)(p.ws + OFF_XC)) + ((size_t)b * CTXL + pp) * DM;
    return (from_input ? p.x : (const float*)p.out) + ((size_t)b * SEQ + (pp - CTXL)) * DM;
}
__device__ __forceinline__ float* x_wr(const Params& p, int b, int pp) {
    if (pp < CTXL) return (float*)(p.ws + OFF_XC) + ((size_t)b * CTXL + pp) * DM;
    return p.out + ((size_t)b * SEQ + (pp - CTXL)) * DM;
}
__device__ __forceinline__ const float* modv_ptr(const Params& p, int l, int b, int pp) {
    const int mr = pp < CTXL ? 16 : b;
    return (const float*)(p.ws + OFF_MODV) + ((size_t)l * 17 + mr) * 6144;
}

__device__ __forceinline__ void grid_barrier(unsigned* bar, unsigned& epoch) {
    asm volatile("s_waitcnt vmcnt(0) lgkmcnt(0)" ::: "memory");
    __syncthreads();
    epoch += 1;
    if (threadIdx.x == 0) {
        __builtin_amdgcn_fence(__ATOMIC_RELEASE, "agent");
        asm volatile("s_waitcnt vmcnt(0)" ::: "memory");
        const unsigned old = __hip_atomic_fetch_add(bar, 1u, __ATOMIC_RELAXED, __HIP_MEMORY_SCOPE_AGENT);
        if (old + 1u == epoch * gridDim.x) {
            __hip_atomic_store(bar + 64, epoch, __ATOMIC_RELAXED, __HIP_MEMORY_SCOPE_AGENT);
        } else {
            while (__hip_atomic_load(bar + 64, __ATOMIC_RELAXED, __HIP_MEMORY_SCOPE_AGENT) < epoch) __builtin_amdgcn_s_sleep(1);
        }
        __builtin_amdgcn_fence(__ATOMIC_ACQUIRE, "agent");
        asm volatile("s_waitcnt vmcnt(0)" ::: "memory");
    }
    __syncthreads();
}

#define LDS_AS __attribute__((address_space(3)))
#define GLB_AS __attribute__((address_space(1)))
template <int MT, int SWAPMODE>
__device__ __forceinline__ void gemm_mainloop(f32x4 (&acc)[MT][4], const bf16_t* __restrict__ A, int lda, int a_kstep,
                                              const bf16_t* __restrict__ Bt, int ldb, int nk, unsigned char* lds, int tid) {
    constexpr int BMr = 64 * MT;
    constexpr int STAGE = (BMr + 128) * 128;
    const int wid = __builtin_amdgcn_readfirstlane(tid >> 6), lane = tid & 63, wr = wid >> 1, wc = wid & 1, fr = lane & 15, fq = lane >> 4;
    const int lrow = 8 * wid + (lane >> 3);
    const int lch = (lane & 7) ^ ((4 * wid + (lane >> 4)) & 7);
    const bf16_t* ap = A + (size_t)lrow * lda + lch * 8;
    const bf16_t* bp = Bt + (size_t)lrow * ldb + lch * 8;
    auto issue = [&](int kt, int st) {
        unsigned char* base = lds + st * STAGE + wid * 1024;
#pragma unroll
        for (int i = 0; i < MT; ++i)
            __builtin_amdgcn_global_load_lds((const GLB_AS unsigned*)(ap + (size_t)i * 64 * lda + (size_t)kt * a_kstep), (LDS_AS unsigned*)(base + i * 8192), 16, 0, 0);
#pragma unroll
        for (int i = 0; i < 2; ++i)
            __builtin_amdgcn_global_load_lds((const GLB_AS unsigned*)(bp + (size_t)i * 64 * ldb + (size_t)kt * 64), (LDS_AS unsigned*)(base + (BMr + i * 64) * 128), 16, 0, 0);
    };
    const bool sw = (SWAPMODE == 1) || (SWAPMODE == 2 && wc == 0);
    const int sz = fr >> 1;
    constexpr int NL = MT + 2;
    const bool late = wid >= 4;
    issue(0, 0);
    if (nk > 1) { issue(1, 1); asm volatile("s_waitcnt vmcnt(%0)" ::"n"(NL) : "memory"); }
    else asm volatile("s_waitcnt vmcnt(0)" ::: "memory");
    __builtin_amdgcn_s_barrier();
    asm volatile("" ::: "memory");
    int st = 0;
    for (int kt = 0; kt < nk; ++kt) {
        const int st2 = st >= 1 ? st - 1 : 2;
        if (!late && kt + 2 < nk) issue(kt + 2, st2);
        const unsigned char* As = lds + st * STAGE;
        const unsigned char* Bs = As + BMr * 128;
#pragma unroll
        for (int ks = 0; ks < 2; ++ks) {
            bf16x8 af[MT], bfr[4];
            const int co = ((ks * 4 + fq) ^ sz) * 16;
#pragma unroll
            for (int m = 0; m < MT; ++m) af[m] = *(const bf16x8*)(As + (wr * 16 * MT + m * 16 + fr) * 128 + co);
#pragma unroll
            for (int n = 0; n < 4; ++n) bfr[n] = *(const bf16x8*)(Bs + (wc * 64 + n * 16 + fr) * 128 + co);
            if (sw) {
#pragma unroll
                for (int m = 0; m < MT; ++m)
#pragma unroll
                    for (int n = 0; n < 4; ++n) acc[m][n] = __builtin_amdgcn_mfma_f32_16x16x32_bf16(bfr[n], af[m], acc[m][n], 0, 0, 0);
            } else {
#pragma unroll
                for (int m = 0; m < MT; ++m)
#pragma unroll
                    for (int n = 0; n < 4; ++n) acc[m][n] = __builtin_amdgcn_mfma_f32_16x16x32_bf16(af[m], bfr[n], acc[m][n], 0, 0, 0);
            }
        }
        if (late && kt + 2 < nk) issue(kt + 2, st2);
        if (kt + 2 < nk) asm volatile("s_waitcnt vmcnt(%0) lgkmcnt(0)" ::"n"(NL) : "memory");
        else asm volatile("s_waitcnt vmcnt(0) lgkmcnt(0)" ::: "memory");
        __builtin_amdgcn_s_barrier();
        asm volatile("" ::: "memory");
        st = st == 2 ? 0 : st + 1;
    }
}
__device__ __forceinline__ void gemm_mainloop256(f32x4 (&acc)[8][4], const bf16_t* __restrict__ A, int lda,
                                                 const bf16_t* __restrict__ Bt, int ldb, int nk, unsigned char* lds, int tid) {
    constexpr int STAGE = 512 * 128;
    const int wid = __builtin_amdgcn_readfirstlane(tid >> 6), lane = tid & 63, wr = wid >> 2, wc = wid & 3, fr = lane & 15, fq = lane >> 4;
    const int lrow = 8 * wid + (lane >> 3);
    const int lch = (lane & 7) ^ ((4 * wid + (lane >> 4)) & 7);
    const bf16_t* ap = A + (size_t)lrow * lda + lch * 8;
    const bf16_t* bp = Bt + (size_t)lrow * ldb + lch * 8;
    auto issue = [&](int kt, int st) {
        unsigned char* base = lds + st * STAGE + wid * 1024;
#pragma unroll
        for (int i = 0; i < 4; ++i)
            __builtin_amdgcn_global_load_lds((const GLB_AS unsigned*)(ap + (size_t)i * 64 * lda + (size_t)kt * 64), (LDS_AS unsigned*)(base + i * 8192), 16, 0, 0);
#pragma unroll
        for (int i = 0; i < 4; ++i)
            __builtin_amdgcn_global_load_lds((const GLB_AS unsigned*)(bp + (size_t)i * 64 * ldb + (size_t)kt * 64), (LDS_AS unsigned*)(base + (256 + i * 64) * 128), 16, 0, 0);
    };
    const int sz = fr >> 1;
    const bool late = wid >= 4;
    issue(0, 0);
    asm volatile("s_waitcnt vmcnt(0)" ::: "memory");
    __builtin_amdgcn_s_barrier();
    asm volatile("" ::: "memory");
    for (int kt = 0; kt < nk; ++kt) {
        if (!late && kt + 1 < nk) issue(kt + 1, (kt + 1) & 1);
        const unsigned char* As = lds + (kt & 1) * STAGE;
        const unsigned char* Bs = As + 256 * 128;
#pragma unroll
        for (int ks = 0; ks < 2; ++ks) {
            if (ks == 1 && late && kt + 1 < nk) issue(kt + 1, (kt + 1) & 1);
            bf16x8 af[8], bfr[4];
            const int co = ((ks * 4 + fq) ^ sz) * 16;
#pragma unroll
            for (int m = 0; m < 8; ++m) af[m] = *(const bf16x8*)(As + (wr * 128 + m * 16 + fr) * 128 + co);
#pragma unroll
            for (int n = 0; n < 4; ++n) bfr[n] = *(const bf16x8*)(Bs + (wc * 64 + n * 16 + fr) * 128 + co);
#pragma unroll
            for (int m = 0; m < 8; ++m)
#pragma unroll
                for (int n = 0; n < 4; ++n) acc[m][n] = __builtin_amdgcn_mfma_f32_16x16x32_bf16(bfr[n], af[m], acc[m][n], 0, 0, 0);
        }
        asm volatile("s_waitcnt vmcnt(0) lgkmcnt(0)" ::: "memory");
        __builtin_amdgcn_s_barrier();
        asm volatile("" ::: "memory");
    }
}
struct Seg { const bf16_t* A; const bf16_t* Bt; int lda, a_kstep, ldb, nk; };
template <int MT, int SWAPMODE>
__device__ __forceinline__ void gemm_stream(f32x4 (&acc)[MT][4], const Seg& cur, const Seg& nxt, bool has_next, bool first, int& st,
                                            unsigned char* lds, int tid) {
    constexpr int BMr = 64 * MT;
    constexpr int STAGE = (BMr + 128) * 128;
    constexpr int NL = MT + 2;
    const int wid = __builtin_amdgcn_readfirstlane(tid >> 6), lane = tid & 63, wr = wid >> 1, wc = wid & 1, fr = lane & 15, fq = lane >> 4;
    const int lrow = 8 * wid + (lane >> 3);
    const int lch = (lane & 7) ^ ((4 * wid + (lane >> 4)) & 7);
    const bf16_t* apc = cur.A + (size_t)lrow * cur.lda + lch * 8;
    const bf16_t* bpc = cur.Bt + (size_t)lrow * cur.ldb + lch * 8;
    const bf16_t* apn = nxt.A + (size_t)lrow * nxt.lda + lch * 8;
    const bf16_t* bpn = nxt.Bt + (size_t)lrow * nxt.ldb + lch * 8;
    auto issue = [&](const bf16_t* ap, const bf16_t* bp, int lda, int ldb, int koffa, int koffb, int slot) {
        unsigned char* base = lds + slot * STAGE + wid * 1024;
#pragma unroll
        for (int i = 0; i < MT; ++i)
            __builtin_amdgcn_global_load_lds((const GLB_AS unsigned*)(ap + (size_t)i * 64 * lda + koffa), (LDS_AS unsigned*)(base + i * 8192), 16, 0, 0);
#pragma unroll
        for (int i = 0; i < 2; ++i)
            __builtin_amdgcn_global_load_lds((const GLB_AS unsigned*)(bp + (size_t)i * 64 * ldb + koffb), (LDS_AS unsigned*)(base + (BMr + i * 64) * 128), 16, 0, 0);
    };
    const bool sw = (SWAPMODE == 1) || (SWAPMODE == 2 && wc == 0);
    const int sz = fr >> 1;
    const bool late = wid >= 4;
    const int nk = cur.nk;
    int s0 = st;
    if (first) {
        const int s1 = s0 == 2 ? 0 : s0 + 1;
        issue(apc, bpc, cur.lda, cur.ldb, 0, 0, s0);
        issue(apc, bpc, cur.lda, cur.ldb, cur.a_kstep, 64, s1);
        asm volatile("s_waitcnt vmcnt(%0)" ::"n"(NL) : "memory");
        __builtin_amdgcn_s_barrier();
        asm volatile("" ::: "memory");
    }
    for (int kt = 0; kt < nk; ++kt) {
        const int s2 = s0 >= 1 ? s0 - 1 : 2;
        const int idx = kt + 2;
        const bool incur = idx < nk, doi = incur || has_next;
        if (!late && doi) { if (incur) issue(apc, bpc, cur.lda, cur.ldb, idx * cur.a_kstep, idx * 64, s2); else issue(apn, bpn, nxt.lda, nxt.ldb, (idx - nk) * nxt.a_kstep, (idx - nk) * 64, s2); }
        const unsigned char* As = lds + s0 * STAGE;
        const unsigned char* Bs = As + BMr * 128;
#pragma unroll
        for (int ks = 0; ks < 2; ++ks) {
            bf16x8 af[MT], bfr[4];
            const int co = ((ks * 4 + fq) ^ sz) * 16;
#pragma unroll
            for (int m = 0; m < MT; ++m) af[m] = *(const bf16x8*)(As + (wr * 16 * MT + m * 16 + fr) * 128 + co);
#pragma unroll
            for (int n = 0; n < 4; ++n) bfr[n] = *(const bf16x8*)(Bs + (wc * 64 + n * 16 + fr) * 128 + co);
            if (sw) {
#pragma unroll
                for (int m = 0; m < MT; ++m)
#pragma unroll
                    for (int n = 0; n < 4; ++n) acc[m][n] = __builtin_amdgcn_mfma_f32_16x16x32_bf16(bfr[n], af[m], acc[m][n], 0, 0, 0);
            } else {
#pragma unroll
                for (int m = 0; m < MT; ++m)
#pragma unroll
                    for (int n = 0; n < 4; ++n) acc[m][n] = __builtin_amdgcn_mfma_f32_16x16x32_bf16(af[m], bfr[n], acc[m][n], 0, 0, 0);
            }
        }
        if (late && doi) { if (incur) issue(apc, bpc, cur.lda, cur.ldb, idx * cur.a_kstep, idx * 64, s2); else issue(apn, bpn, nxt.lda, nxt.ldb, (idx - nk) * nxt.a_kstep, (idx - nk) * 64, s2); }
        if (doi) asm volatile("s_waitcnt vmcnt(%0) lgkmcnt(0)" ::"n"(NL) : "memory");
        else asm volatile("s_waitcnt vmcnt(0) lgkmcnt(0)" ::: "memory");
        __builtin_amdgcn_s_barrier();
        asm volatile("" ::: "memory");
        s0 = s0 == 2 ? 0 : s0 + 1;
    }
    st = s0;
}
__device__ __forceinline__ void gemm_stream256(f32x4 (&acc)[8][4], const Seg& cur, const Seg& nxt, bool has_next, bool first, int& st, unsigned char* lds, int tid) {
    constexpr int STAGE = 512 * 128;
    const int wid = __builtin_amdgcn_readfirstlane(tid >> 6), lane = tid & 63, wr = wid >> 2, wc = wid & 3, fr = lane & 15, fq = lane >> 4;
    const int lrow = 8 * wid + (lane >> 3);
    const int lch = (lane & 7) ^ ((4 * wid + (lane >> 4)) & 7);
    const bf16_t* apc = cur.A + (size_t)lrow * cur.lda + lch * 8;
    const bf16_t* bpc = cur.Bt + (size_t)lrow * cur.ldb + lch * 8;
    const bf16_t* apn = nxt.A + (size_t)lrow * nxt.lda + lch * 8;
    const bf16_t* bpn = nxt.Bt + (size_t)lrow * nxt.ldb + lch * 8;
    auto issue = [&](const bf16_t* ap, const bf16_t* bp, int lda, int ldb, int koff, int slot) {
        unsigned char* base = lds + slot * STAGE + wid * 1024;
#pragma unroll
        for (int i = 0; i < 4; ++i)
            __builtin_amdgcn_global_load_lds((const GLB_AS unsigned*)(ap + (size_t)i * 64 * lda + koff), (LDS_AS unsigned*)(base + i * 8192), 16, 0, 0);
#pragma unroll
        for (int i = 0; i < 4; ++i)
            __builtin_amdgcn_global_load_lds((const GLB_AS unsigned*)(bp + (size_t)i * 64 * ldb + koff), (LDS_AS unsigned*)(base + (256 + i * 64) * 128), 16, 0, 0);
    };
    const int sz = fr >> 1;
    const bool late = wid >= 4;
    const int nk = cur.nk;
    int s0 = st;
    if (first) {
        issue(apc, bpc, cur.lda, cur.ldb, 0, s0);
        asm volatile("s_waitcnt vmcnt(0)" ::: "memory");
        __builtin_amdgcn_s_barrier();
        asm volatile("" ::: "memory");
    }
    for (int kt = 0; kt < nk; ++kt) {
        const int idx = kt + 1;
        const bool incur = idx < nk, doi = incur || has_next;
        if (!late && doi) { if (incur) issue(apc, bpc, cur.lda, cur.ldb, idx * 64, s0 ^ 1); else issue(apn, bpn, nxt.lda, nxt.ldb, 0, s0 ^ 1); }
        const unsigned char* As = lds + s0 * STAGE;
        const unsigned char* Bs = As + 256 * 128;
#pragma unroll
        for (int ks = 0; ks < 2; ++ks) {
            if (ks == 1 && late && doi) { if (incur) issue(apc, bpc, cur.lda, cur.ldb, idx * 64, s0 ^ 1); else issue(apn, bpn, nxt.lda, nxt.ldb, 0, s0 ^ 1); }
            bf16x8 af[8], bfr[4];
            const int co = ((ks * 4 + fq) ^ sz) * 16;
#pragma unroll
            for (int m = 0; m < 8; ++m) af[m] = *(const bf16x8*)(As + (wr * 128 + m * 16 + fr) * 128 + co);
#pragma unroll
            for (int n = 0; n < 4; ++n) bfr[n] = *(const bf16x8*)(Bs + (wc * 64 + n * 16 + fr) * 128 + co);
#pragma unroll
            for (int m = 0; m < 8; ++m)
#pragma unroll
                for (int n = 0; n < 4; ++n) acc[m][n] = __builtin_amdgcn_mfma_f32_16x16x32_bf16(bfr[n], af[m], acc[m][n], 0, 0, 0);
        }
        asm volatile("s_waitcnt vmcnt(0) lgkmcnt(0)" ::: "memory");
        __builtin_amdgcn_s_barrier();
        asm volatile("" ::: "memory");
        s0 ^= 1;
    }
    st = s0;
}
template <int MT> __device__ __forceinline__ void zero_acc(f32x4 (&acc)[MT][4]) {
#pragma unroll
    for (int m = 0; m < MT; ++m)
#pragma unroll
        for (int n = 0; n < 4; ++n) acc[m][n] = (f32x4){0.f, 0.f, 0.f, 0.f};
}
__device__ __forceinline__ void tile_mn(int t, int nN, int& mt, int& nt) { const int per = 16 * nN, g = t / per, w = t % per; mt = g * 16 + (w & 15); nt = w >> 4; }

__device__ __forceinline__ int rowmap(int mode, int n) {
    if (mode == 1) return n < 672 ? n : n + 96;
    if (mode == 2) return n < DFF ? ((n >> 5) * 64 + (n & 31)) : (((n - DFF) >> 5) * 64 + 32 + ((n - DFF) & 31));
    return n;
}
__device__ __forceinline__ void convert_T(const float* __restrict__ src, int K, int N, bf16_t* __restrict__ dst, int mode, const float* __restrict__ ks, unsigned char* lds, int rot) {
    float* tile = (float*)lds;
    const int ntk = K / 64, ntn = (N + 63) / 64, tid = ltid();
    const int start = (blockIdx.x + gridDim.x - (rot % gridDim.x)) % gridDim.x;
    for (int t = start; t < ntk * ntn; t += gridDim.x) {
        const int tk = t % ntk, tn = t / ntk, k0 = tk * 64, n0 = tn * 64;
#pragma unroll
        for (int i = 0; i < 8; ++i) {
            const int kl = (tid >> 6) + 8 * i, nl = tid & 63, n = n0 + nl;
            tile[kl * 65 + nl] = n < N ? src[(size_t)(k0 + kl) * N + n] : 0.f;
        }
        __syncthreads();
        const int kp = (tid & 31) * 2;
        float s0 = 1.f, s1 = 1.f;
        if (ks) { s0 = ks[k0 + kp]; s1 = ks[k0 + kp + 1]; }
#pragma unroll
        for (int i = 0; i < 4; ++i) {
            const int nl = (tid >> 5) + 16 * i, n = n0 + nl;
            if (n < N) *(unsigned*)(dst + (size_t)rowmap(mode, n) * K + k0 + kp) = pk_bf16(tile[kp * 65 + nl] * s0, tile[(kp + 1) * 65 + nl] * s1);
        }
        __syncthreads();
    }
}
__device__ __forceinline__ void convert_layer(const Params& pin, int l, unsigned char* lds) {
    const Params p = launder(pin); l = launder_i(l);
    bf16_t* W = (bf16_t*)(p.ws + OFF_W);
    convert_T(p.w_in + (size_t)l * DM * DIN, DM, DIN, W + WO_IN, 1, nullptr, lds, 0);
    convert_T(p.ffn_w13 + (size_t)l * DM * 2 * DFF, DM, 2 * DFF, W + WO_13, 2, nullptr, lds, 40);
    convert_T(p.ffn_w2 + (size_t)l * DFF * DM, DFF, DM, W + WO_2, 0, nullptr, lds, 80);
    convert_T(p.w_out + (size_t)l * DM * DM, DM, DM, W + WO_OUT, 0, nullptr, lds, 120);
    convert_T(p.w_o_attn + (size_t)l * 512 * DM, 512, DM, W + WO_OA, 0, nullptr, lds, 136);
    convert_T(p.w_o_conv + (size_t)l * 512 * DM, 512, DM, W + WO_OC, 0, nullptr, lds, 8);
    convert_T(p.w_o_rwkv + (size_t)l * 512 * DM, 512, DM, W + WO_OR, 0, nullptr, lds, 136 + 8);
    convert_T(p.w_uq + (size_t)l * 384 * 768, 384, 768, W + WO_UQ, 0, p.q_norm + l * 384, lds, 16);
    convert_T(p.w_ukv + (size_t)l * 256 * 1024, 256, 1024, W + WO_UKV, 0, p.kv_norm + l * 256, lds, 88);
    for (int z = 0; z < 2; ++z) {
        convert_T(p.rw_w_up + ((size_t)l * 2 + z) * 64 * 512, 64, 512, W + WO_UP + (size_t)z * 512 * 64, 0, nullptr, lds, 152 + 8 * z);
        convert_T(p.rw_a_up + ((size_t)l * 2 + z) * 64 * 512, 64, 512, W + WO_AUP + (size_t)z * 512 * 64, 0, nullptr, lds, 168 + 8 * z);
    }
    convert_T(p.rw_g_up + (size_t)l * 128 * 512, 128, 512, W + WO_GUP, 0, nullptr, lds, 184);
}

__device__ __forceinline__ void modv_phase(const Params& pin, unsigned char* lds) {
    const Params p = launder(pin);
    float* s = (float*)lds;
    float* red = s + 17 * 1024;
    const int tid = ltid(), wid = tid >> 6, lane = tid & 63;
    for (int i = tid; i < 17 * 1024; i += NTHREADS) { const int r = i >> 10, k = i & 1023; const float v = r < 16 ? p.c[r * 1024 + k] : p.c_ctx[k]; s[i] = siluf_(v); }
    __syncthreads();
    float* modv = (float*)(p.ws + OFF_MODV);
    for (int g = blockIdx.x; g < 4 * 96; g += gridDim.x) {
        const int l = g / 96, n = (g % 96) * 64 + lane;
        const float* w = p.mod_w + (size_t)l * 1024 * 6144 + n;
        float acc[17];
#pragma unroll
        for (int r = 0; r < 17; ++r) acc[r] = 0.f;
        const int kb = wid * 128;
        for (int k = kb; k < kb + 128; k += 4) {
            const float w0 = w[(size_t)k * 6144], w1 = w[(size_t)(k + 1) * 6144], w2 = w[(size_t)(k + 2) * 6144], w3 = w[(size_t)(k + 3) * 6144];
#pragma unroll
            for (int r = 0; r < 17; ++r) { const f32x4 sv = *(const f32x4*)(s + r * 1024 + k); acc[r] += sv[0] * w0 + sv[1] * w1 + sv[2] * w2 + sv[3] * w3; }
        }
#pragma unroll
        for (int r = 0; r < 17; ++r) red[(wid * 17 + r) * 64 + lane] = acc[r];
        __syncthreads();
        for (int i = tid; i < 17 * 64; i += NTHREADS) {
            const int r = i >> 6, c = i & 63; float v = 0.f;
#pragma unroll
            for (int w8 = 0; w8 < 8; ++w8) v += red[(w8 * 17 + r) * 64 + c];
            const int nn = (g % 96) * 64 + c;
            modv[((size_t)l * 17 + r) * 6144 + nn] = v + p.mod_b[l * 6144 + nn];
        }
        __syncthreads();
    }
    if (blockIdx.x == gridDim.x - 1) {
        float* rope = (float*)(p.ws + OFF_ROPE);
        for (int i = tid; i < 512; i += NTHREADS) {
            const int pos = i >> 3, f = i & 7;
            const float inv = exp2f(-(float)f * (13.287712379549449f / 8.0f));
            const float ang = (float)pos * inv;
            rope[i * 2] = cosf(ang); rope[i * 2 + 1] = sinf(ang);
        }
    }
}

__device__ __forceinline__ void xmod0_phase(const Params& pin) {
    const Params p = launder(pin);
    const int tid = ltid(), wid = tid >> 6, lane = tid & 63;
    bf16_t* xm = (bf16_t*)(p.ws + OFF_R6);
    for (int row = blockIdx.x * 8 + wid; row < MROWS; row += gridDim.x * 8) {
        const int b = row / TPB, pp = row % TPB;
        const float* xp = x_rd(p, true, b, pp);
        const float* mv = modv_ptr(p, 0, b, pp);
#pragma unroll
        for (int i = 0; i < 4; ++i) {
            const int c = i * 256 + lane * 4;
            const f32x4 v = *(const f32x4*)(xp + c), sh = *(const f32x4*)(mv + c), sc = *(const f32x4*)(mv + 1024 + c);
            uint2 o; o.x = pk_bf16(v[0] * (1.f + sc[0]) + sh[0], v[1] * (1.f + sc[1]) + sh[1]); o.y = pk_bf16(v[2] * (1.f + sc[2]) + sh[2], v[3] * (1.f + sc[3]) + sh[3]);
            *(uint2*)(xm + (size_t)row * 1024 + c) = o;
        }
    }
}

__device__ __forceinline__ void p1_phase(const Params& pin, unsigned char* lds) {
    const Params p = launder(pin); const int tid = ltid();
    const bf16_t* A = (const bf16_t*)(p.ws + OFF_R6);
    const bf16_t* W = (const bf16_t*)(p.ws + OFF_W) + WO_IN;
    const int lane = tid & 63, wid = tid >> 6, wr = wid >> 2, wc = wid & 3, fr = lane & 15, fq = lane >> 4;
    auto seg = [&](int t) { int mt, nt; tile_mn(t, 17, mt, nt); Seg g; g.A = A + (size_t)mt * 256 * 1024; g.Bt = W + (size_t)nt * 256 * 1024; g.lda = 1024; g.a_kstep = 64; g.ldb = 1024; g.nk = 16; return g; };
    int st = 0; bool first = true;
    for (int t = blockIdx.x; t < 144 * 17; t += gridDim.x) {
        int mt, nt; tile_mn(t, 17, mt, nt);
        const int tn = t + gridDim.x; const bool hn = tn < 144 * 17;
        f32x4 acc[8][4]; zero_acc<8>(acc);
        gemm_stream256(acc, seg(t), seg(hn ? tn : t), hn, first, st, lds, tid); first = false;
        bf16_t* dst; int ld, cb, lim;
        if (nt < 3) { dst = (bf16_t*)(p.ws + OFF_R1); ld = 672; cb = nt * 256; lim = 672; }
        else if (nt < 9) { dst = (bf16_t*)(p.ws + OFF_R2); ld = 1536; cb = (nt - 3) * 256; lim = 1536; }
        else { dst = (bf16_t*)(p.ws + OFF_R3); ld = 1920; cb = (nt - 9) * 256; lim = 1920; }
#pragma unroll
        for (int m = 0; m < 8; ++m) {
            const size_t row = (size_t)mt * 256 + wr * 128 + m * 16 + fr;
#pragma unroll
            for (int n = 0; n < 4; ++n) {
                const int col = cb + wc * 64 + n * 16 + fq * 4;
                if (col < lim) { uint2 o; o.x = pk_bf16(acc[m][n][0], acc[m][n][1]); o.y = pk_bf16(acc[m][n][2], acc[m][n][3]); *(uint2*)(dst + row * ld + col) = o; }
            }
        }
    }
}

__device__ __forceinline__ void unpack8(const uint4 u, float (&f)[8]) {
    f[0] = bf_lo(u.x); f[1] = bf_hi(u.x); f[2] = bf_lo(u.y); f[3] = bf_hi(u.y); f[4] = bf_lo(u.z); f[5] = bf_hi(u.z); f[6] = bf_lo(u.w); f[7] = bf_hi(u.w);
}
__device__ __forceinline__ void p2a_phase(const Params& pin, int l) {
    const Params p = launder(pin); l = launder_i(l);
    const int tid = ltid(), wid = tid >> 6, lane = tid & 63;
    const bf16_t* Hm = (const bf16_t*)(p.ws + OFF_R1);
    const bf16_t* Hc = (const bf16_t*)(p.ws + OFF_R2);
    bf16_t* CV = (bf16_t*)(p.ws + OFF_R5);
    bf16_t* KR = (bf16_t*)(p.ws + OFF_KR);
    float* RSQ = (float*)(p.ws + OFF_RSQ);
    float* RSKV = (float*)(p.ws + OFF_RSKV);
    const float* rope = (const float*)(p.ws + OFF_ROPE);
    const float* cw = p.conv_w + (size_t)l * 3 * 512;
    const int c0 = lane * 8;
    float w0[8], w1[8], w2[8];
#pragma unroll
    for (int i = 0; i < 8; ++i) { w0[i] = cw[c0 + i]; w1[i] = cw[512 + c0 + i]; w2[i] = cw[1024 + c0 + i]; }
    for (int row = blockIdx.x * 8 + wid; row < MROWS; row += gridDim.x * 8) {
        const int pp = row % TPB;
        const bool hp = (pp != 0 && pp != CTXL), hn = (pp != CTXL - 1 && pp != TPB - 1);
        const bf16_t* hr = Hc + (size_t)row * 1536;
        float ch[8], cc[8], cb[8], u0[8], u1[8], u2[8];
        unpack8(*(const uint4*)(hr + c0), ch); unpack8(*(const uint4*)(hr + 1024 + c0), cc); unpack8(*(const uint4*)(hr + 512 + c0), cb);
#pragma unroll
        for (int i = 0; i < 8; ++i) u1[i] = cc[i] * ch[i];
        if (hp) { unpack8(*(const uint4*)(hr - 1536 + c0), ch); unpack8(*(const uint4*)(hr - 1536 + 1024 + c0), cc);
#pragma unroll
            for (int i = 0; i < 8; ++i) u0[i] = cc[i] * ch[i]; }
        else {
#pragma unroll
            for (int i = 0; i < 8; ++i) u0[i] = 0.f; }
        if (hn) { unpack8(*(const uint4*)(hr + 1536 + c0), ch); unpack8(*(const uint4*)(hr + 1536 + 1024 + c0), cc);
#pragma unroll
            for (int i = 0; i < 8; ++i) u2[i] = cc[i] * ch[i]; }
        else {
#pragma unroll
            for (int i = 0; i < 8; ++i) u2[i] = 0.f; }
        float o[8];
#pragma unroll
        for (int i = 0; i < 8; ++i) o[i] = cb[i] * (u0[i] * w0[i] + u1[i] * w1[i] + u2[i] * w2[i]);
        uint4 ov; ov.x = pk_bf16(o[0], o[1]); ov.y = pk_bf16(o[2], o[3]); ov.z = pk_bf16(o[4], o[5]); ov.w = pk_bf16(o[6], o[7]);
        *(uint4*)(CV + (size_t)row * 512 + c0) = ov;
        const bf16_t* hm = Hm + (size_t)row * 672;
        float sq = 0.f, skv = 0.f;
        if (lane < 48) { float f[8]; unpack8(*(const uint4*)(hm + lane * 8), f);
#pragma unroll
            for (int i = 0; i < 8; ++i) sq += f[i] * f[i]; }
        if (lane < 32) { float f[8]; unpack8(*(const uint4*)(hm + 384 + lane * 8), f);
#pragma unroll
            for (int i = 0; i < 8; ++i) skv += f[i] * f[i]; }
        sq = wave_sum(sq); skv = wave_sum(skv);
        if (lane == 0) { RSQ[row] = rsqrtf(sq * (1.0f / 384.0f) + 1e-6f); RSKV[row] = rsqrtf(skv * (1.0f / 256.0f) + 1e-6f); }
        {
            const int j = lane & 31;
            float v = bf1(hm[640 + j]);
            const float other = __shfl_xor(v, 8);
            if (pp >= CTXL) {
                const int tt = pp - CTXL;
                const int pos = (j < 16) ? (tt >> 6) : (tt & 63);
                const float cs = rope[(pos * 8 + (j & 7)) * 2], sn = rope[(pos * 8 + (j & 7)) * 2 + 1];
                v = (j & 8) ? (other * sn + v * cs) : (v * cs - other * sn);
            }
            if (lane < 32) KR[(size_t)row * 32 + j] = (bf16_t)(pk_bf16(v, v) & 0xffffu);
        }
    }
}

__device__ __forceinline__ void p2b_phase(const Params& pin, int l, unsigned char* lds) {
    const Params p = launder(pin); l = launder_i(l); const int tid = ltid();
    const bf16_t* Hm = (const bf16_t*)(p.ws + OFF_R1);
    const bf16_t* W = (const bf16_t*)(p.ws + OFF_W);
    const float* RSQ = (const float*)(p.ws + OFF_RSQ);
    const float* RSKV = (const float*)(p.ws + OFF_RSKV);
    const float* rope = (const float*)(p.ws + OFF_ROPE);
    bf16_t* Q = (bf16_t*)(p.ws + OFF_Q);
    bf16_t* KN = (bf16_t*)(p.ws + OFF_KN);
    bf16_t* VT = (bf16_t*)(p.ws + OFF_VT);
    const int lane = tid & 63, wid = tid >> 6, wr = wid >> 1, wc = wid & 1, fr = lane & 15, fq = lane >> 4;
    const int NQ = 144 * 6, NKV = 144 * 8;
    for (int t = blockIdx.x; t < NQ + NKV; t += gridDim.x) {
        f32x4 acc[4][4]; zero_acc<4>(acc);
        if (t < NQ) {
            int mt, nt; tile_mn(t, 6, mt, nt);
            gemm_mainloop<4, 1>(acc, Hm + (size_t)mt * 256 * 672, 672, 64, W + WO_UQ + (size_t)nt * 128 * 384, 384, 6, lds, tid);
            const int pp0 = (mt % 9) * 256; const bool latent = pp0 >= CTXL;
#pragma unroll
            for (int m = 0; m < 4; ++m) {
                const int lrow = wr * 64 + m * 16 + fr;
                const size_t row = (size_t)mt * 256 + lrow;
                const float sc = RSQ[row] * QSCALE;
                const int tt = pp0 + lrow - CTXL;
#pragma unroll
                for (int n = 0; n < 4; ++n) {
                    const int c16 = nt * 128 + wc * 64 + n * 16, r96 = c16 % 96;
                    float v[4];
#pragma unroll
                    for (int j = 0; j < 4; ++j) v[j] = acc[m][n][j] * sc;
                    if (latent && r96 >= 64) {
                        const int pos = (r96 == 64) ? (tt >> 6) : (tt & 63);
#pragma unroll
                        for (int j = 0; j < 4; ++j) {
                            const float other = __shfl_xor(v[j], 32);
                            const int fi = (fq & 1) * 4 + j;
                            const float cs = rope[(pos * 8 + fi) * 2], sn = rope[(pos * 8 + fi) * 2 + 1];
                            v[j] = (fq & 2) ? (other * sn + v[j] * cs) : (v[j] * cs - other * sn);
                        }
                    }
                    uint2 o; o.x = pk_bf16(v[0], v[1]); o.y = pk_bf16(v[2], v[3]);
                    *(uint2*)(Q + row * 768 + c16 + fq * 4) = o;
                }
            }
        } else {
            int mt, nt; tile_mn(t - NQ, 8, mt, nt);
            gemm_mainloop<4, 2>(acc, Hm + (size_t)mt * 256 * 672 + 384, 672, 64, W + WO_UKV + (size_t)nt * 128 * 256, 256, 4, lds, tid);
            const int b = mt / 9, pp0 = (mt % 9) * 256;
            if (wc == 0) {
#pragma unroll
                for (int m = 0; m < 4; ++m) {
                    const size_t row = (size_t)mt * 256 + wr * 64 + m * 16 + fr;
                    const float sc = RSKV[row];
#pragma unroll
                    for (int n = 0; n < 4; ++n) {
                        uint2 o; o.x = pk_bf16(acc[m][n][0] * sc, acc[m][n][1] * sc); o.y = pk_bf16(acc[m][n][2] * sc, acc[m][n][3] * sc);
                        *(uint2*)(KN + row * 512 + nt * 64 + n * 16 + fq * 4) = o;
                    }
                }
            } else {
#pragma unroll
                for (int m = 0; m < 4; ++m) {
                    const int lrow = wr * 64 + m * 16 + fq * 4;
                    const f32x4 sc = *(const f32x4*)(RSKV + (size_t)mt * 256 + lrow);
#pragma unroll
                    for (int n = 0; n < 4; ++n) {
                        const int dv = n * 16 + fr;
                        uint2 o; o.x = pk_bf16(acc[m][n][0] * sc[0], acc[m][n][1] * sc[1]); o.y = pk_bf16(acc[m][n][2] * sc[2], acc[m][n][3] * sc[3]);
                        *(uint2*)(VT + ((size_t)(b * 8 + nt) * 64 + dv) * TPB + pp0 + lrow) = o;
                    }
                }
            }
        }
    }
    {
        const bf16_t* Hr = (const bf16_t*)(p.ws + OFF_R3);
        bf16_t* SG = (bf16_t*)(p.ws + OFF_SG);
        const float* mu = p.rw_mu + (size_t)l * 1920 + 1792;
        for (int i = blockIdx.x * NTHREADS + tid; i < MROWS * 16; i += gridDim.x * NTHREADS) {
            const int row = i >> 4, c0 = (i & 15) * 8, pp = row % TPB;
            const bool hp = (pp != 0 && pp != CTXL), hn = (pp != CTXL - 1 && pp != TPB - 1);
            const bf16_t* hr = Hr + (size_t)row * 1920 + 1792 + c0;
            float cur[8], pv[8], nx[8];
            unpack8(*(const uint4*)hr, cur);
            if (hp) unpack8(*(const uint4*)(hr - 1920), pv); else {
#pragma unroll
                for (int k = 0; k < 8; ++k) pv[k] = 0.f; }
            if (hn) unpack8(*(const uint4*)(hr + 1920), nx); else {
#pragma unroll
                for (int k = 0; k < 8; ++k) nx[k] = 0.f; }
            float o[8];
#pragma unroll
            for (int k = 0; k < 8; ++k) o[k] = sigmoidf_(cur[k] + (0.5f * (pv[k] + nx[k]) - cur[k]) * mu[c0 + k]);
            uint4 ov; ov.x = pk_bf16(o[0], o[1]); ov.y = pk_bf16(o[2], o[3]); ov.z = pk_bf16(o[4], o[5]); ov.w = pk_bf16(o[6], o[7]);
            *(uint4*)(SG + (size_t)row * 128 + c0) = ov;
        }
    }
}

#define FMAC_BC(acc, coef, s, J) asm("v_fmac_f32_dpp %0, %1, %2 row_newbcast:" #J " row_mask:0xf bank_mask:0xf" : "+v"(acc) : "v"(coef), "v"(s))
#define MUL_BC(dst, coef, s, J) asm("v_mul_f32_dpp %0, %1, %2 row_newbcast:" #J " row_mask:0xf bank_mask:0xf" : "=v"(dst) : "v"(coef), "v"(s))
#define REP16(X) X(0, 0) X(1, 1) X(2, 2) X(3, 3) X(4, 0) X(5, 1) X(6, 2) X(7, 3) X(8, 0) X(9, 1) X(10, 2) X(11, 3) X(12, 0) X(13, 1) X(14, 2) X(15, 3)
constexpr int FSTR = 6 * 64 + 4;
constexpr int CHUNK = 32, NCHUNK = TPB / CHUNK;

__device__ __forceinline__ int scan_pos(int z, int s) { return z == 0 ? s : (s < CTXL ? (CTXL - 1 - s) : (TPB + CTXL - 1 - s)); }

__device__ __forceinline__ void shift4(const bf16_t* hr, bool hp, bool hn, int col, const float* mu, float (&o)[4]) {
    const uint2 c = *(const uint2*)(hr + col);
    uint2 a = make_uint2(0u, 0u), b = make_uint2(0u, 0u);
    if (hp) a = *(const uint2*)(hr - 1920 + col);
    if (hn) b = *(const uint2*)(hr + 1920 + col);
    const f32x4 m = *(const f32x4*)(mu + col);
    const float cv[4] = {bf_lo(c.x), bf_hi(c.x), bf_lo(c.y), bf_hi(c.y)};
    const float av[4] = {bf_lo(a.x), bf_hi(a.x), bf_lo(a.y), bf_hi(a.y)};
    const float bv[4] = {bf_lo(b.x), bf_hi(b.x), bf_lo(b.y), bf_hi(b.y)};
#pragma unroll
    for (int i = 0; i < 4; ++i) o[i] = cv[i] + (0.5f * (av[i] + bv[i]) - cv[i]) * m[i];
}
__device__ __forceinline__ void shift8(const bf16_t* hr, bool hp, bool hn, int col, const float* mu, float (&o)[8]) {
    float cv[8], av[8], bv[8];
    unpack8(*(const uint4*)(hr + col), cv);
    if (hp) unpack8(*(const uint4*)(hr - 1920 + col), av); else {
#pragma unroll
        for (int i = 0; i < 8; ++i) av[i] = 0.f; }
    if (hn) unpack8(*(const uint4*)(hr + 1920 + col), bv); else {
#pragma unroll
        for (int i = 0; i < 8; ++i) bv[i] = 0.f; }
#pragma unroll
    for (int i = 0; i < 8; ++i) o[i] = cv[i] + (0.5f * (av[i] + bv[i]) - cv[i]) * mu[col + i];
}
__device__ __forceinline__ bf16x8 pack8(const float (&f)[8]) {
    union { uint4 u; bf16x8 v; } r;
    r.u.x = pk_bf16(f[0], f[1]); r.u.y = pk_bf16(f[2], f[3]); r.u.z = pk_bf16(f[4], f[5]); r.u.w = pk_bf16(f[6], f[7]);
    return r.v;
}

struct ProdState { f32x4 aw[4], aa[4]; };
struct Raw3x2 { uint2 c, a, b; };
__device__ __forceinline__ Raw3x2 ld3x2(const bf16_t* pc, const bf16_t* pa, const bf16_t* pb, bool hp, bool hn, int col) {
    Raw3x2 r; r.c = *(const uint2*)(pc + col); r.a = *(const uint2*)(pa + col); r.b = *(const uint2*)(pb + col);
    if (!hp) r.a = make_uint2(0u, 0u);
    if (!hn) r.b = make_uint2(0u, 0u);
    return r;
}
__device__ __forceinline__ void sh4(const Raw3x2& r, const f32x4 m, float (&o)[4]) {
    const float cv[4] = {bf_lo(r.c.x), bf_hi(r.c.x), bf_lo(r.c.y), bf_hi(r.c.y)};
    const float av[4] = {bf_lo(r.a.x), bf_hi(r.a.x), bf_lo(r.a.y), bf_hi(r.a.y)};
    const float bv[4] = {bf_lo(r.b.x), bf_hi(r.b.x), bf_lo(r.b.y), bf_hi(r.b.y)};
#pragma unroll
    for (int i = 0; i < 4; ++i) o[i] = cv[i] + (0.5f * (av[i] + bv[i]) - cv[i]) * m[i];
}
struct Raw3x4 { uint4 c, a, b; };
__device__ __forceinline__ Raw3x4 ld3x4(const bf16_t* pc, const bf16_t* pa, const bf16_t* pb, bool hp, bool hn, int col) {
    Raw3x4 r; r.c = *(const uint4*)(pc + col); r.a = *(const uint4*)(pa + col); r.b = *(const uint4*)(pb + col);
    if (!hp) r.a = make_uint4(0u, 0u, 0u, 0u);
    if (!hn) r.b = make_uint4(0u, 0u, 0u, 0u);
    return r;
}
__device__ __forceinline__ void sh8(const Raw3x4& r, const float* m, float (&o)[8]) {
    float cv[8], av[8], bv[8];
    unpack8(r.c, cv); unpack8(r.a, av); unpack8(r.b, bv);
    const f32x4 m0 = *(const f32x4*)m, m1 = *(const f32x4*)(m + 4);
#pragma unroll
    for (int i = 0; i < 8; ++i) o[i] = cv[i] + (0.5f * (av[i] + bv[i]) - cv[i]) * (i < 4 ? m0[i] : m1[i - 4]);
}
template <int N0>
__device__ __forceinline__ void scan_produce_elem(const float* pl, int fq, const Raw3x2 (&rr)[2], const Raw3x2 (&rk)[2], const Raw3x2 (&rv)[2],
                                                  const f32x4 (&aw)[2], const f32x4 (&aa)[2], float& ss, float* frow) {
#pragma unroll
    for (int nn = 0; nn < 2; ++nn) {
        const int n = N0 + nn;
        const int c4 = n * 16 + fq * 4;
        float r4[4], k4[4], v4[4];
        sh4(rr[nn], *(const f32x4*)(pl + 0 * 64 + c4), r4);
        sh4(rk[nn], *(const f32x4*)(pl + 1 * 64 + c4), k4);
        sh4(rv[nn], *(const f32x4*)(pl + 2 * 64 + c4), v4);
        const f32x4 w0 = *(const f32x4*)(pl + 3 * 64 + c4);
        const f32x4 a0 = *(const f32x4*)(pl + 4 * 64 + c4);
        const f32x4 kkp = *(const f32x4*)(pl + 5 * 64 + c4);
        const f32x4 kap = *(const f32x4*)(pl + 6 * 64 + c4);
        f32x4 dw, kd, kf4, a4;
#pragma unroll
        for (int j = 0; j < 4; ++j) {
            const float x = -(aw[nn][j] + w0[j]);
            const float sp = fmaxf(x, 0.f) + __logf(1.0f + __expf(-fabsf(x)));
            const float wl = -sp - 0.5f;
            dw[j] = __expf(-__expf(wl));
            const float a = __builtin_amdgcn_rcpf(1.0f + __expf(-(aa[nn][j] + a0[j])));
            a4[j] = a;
            const float kf = k4[j] * kkp[j];
            kf4[j] = kf; ss += kf * kf;
            kd[j] = k4[j] * (1.0f + (a - 1.0f) * kap[j]);
        }
        *(f32x4*)(frow + 0 * 64 + c4) = kf4;
        *(f32x4*)(frow + 1 * 64 + c4) = dw;
        *(f32x4*)(frow + 2 * 64 + c4) = a4;
        *(f32x4*)(frow + 3 * 64 + c4) = kd;
        *(f32x4*)(frow + 4 * 64 + c4) = (f32x4){r4[0], r4[1], r4[2], r4[3]};
        *(f32x4*)(frow + 5 * 64 + c4) = (f32x4){v4[0], v4[1], v4[2], v4[3]};
    }
}
__device__ __forceinline__ void scan_produce_A(const Params& p, const float* pl, int b, int h, int z, int s0, float* frow0, int lane, ProdState& st) {
    const int fr = lane & 15, fq = lane >> 4;
    const int pp = scan_pos(z, s0 + fr);
    const bool hp = (pp != 0 && pp != CTXL), hn = (pp != CTXL - 1 && pp != TPB - 1);
    const bf16_t* hr = (const bf16_t*)(p.ws + OFF_R3) + ((size_t)b * TPB + pp) * 1920;
    const bf16_t* W = (const bf16_t*)(p.ws + OFF_W);
    Raw3x4 qw[2], qa[2];
    const bf16_t* pc = hr + z * 64 + fq * 8; const bf16_t* pa = hp ? pc - 1920 : pc; const bf16_t* pb = hn ? pc + 1920 : pc;
#pragma unroll
    for (int ks = 0; ks < 2; ++ks) { qw[ks] = ld3x4(pc, pa, pb, hp, hn, 1536 + ks * 32); qa[ks] = ld3x4(pc, pa, pb, hp, hn, 1664 + ks * 32); }
    f32x4 accw[4], acca[4];
#pragma unroll
    for (int n = 0; n < 4; ++n) { accw[n] = (f32x4){0.f, 0.f, 0.f, 0.f}; acca[n] = (f32x4){0.f, 0.f, 0.f, 0.f}; }
#pragma unroll
    for (int ks = 0; ks < 2; ++ks) {
        bf16x8 bw[4], ba[4];
#pragma unroll
        for (int n = 0; n < 4; ++n) {
            const size_t wo = ((size_t)z * 512 + h * 64 + n * 16 + fr) * 64 + ks * 32 + fq * 8;
            bw[n] = *(const bf16x8*)(W + WO_UP + wo); ba[n] = *(const bf16x8*)(W + WO_AUP + wo);
        }
        float t8[8];
        sh8(qw[ks], pl + 7 * 64 + ks * 32 + fq * 8, t8);
#pragma unroll
        for (int i = 0; i < 8; ++i) { const float e = __expf(2.0f * t8[i]); t8[i] = 1.0f - 2.0f * __builtin_amdgcn_rcpf(e + 1.0f); }
        const bf16x8 aw = pack8(t8);
        sh8(qa[ks], pl + 8 * 64 + ks * 32 + fq * 8, t8);
        const bf16x8 aa = pack8(t8);
#pragma unroll
        for (int n = 0; n < 4; ++n) {
            accw[n] = __builtin_amdgcn_mfma_f32_16x16x32_bf16(bw[n], aw, accw[n], 0, 0, 0);
            acca[n] = __builtin_amdgcn_mfma_f32_16x16x32_bf16(ba[n], aa, acca[n], 0, 0, 0);
        }
    }
#pragma unroll
    for (int n = 0; n < 4; ++n) { st.aw[n] = accw[n]; st.aa[n] = acca[n]; }
}
__device__ __forceinline__ void scan_produce_B(const Params& p, const float* pl, int b, int h, int z, int s0, float* frow0, int lane, const ProdState& st) {
    const int fr = lane & 15, fq = lane >> 4;
    const int pp = scan_pos(z, s0 + fr);
    const bool hp = (pp != 0 && pp != CTXL), hn = (pp != CTXL - 1 && pp != TPB - 1);
    const bf16_t* hr = (const bf16_t*)(p.ws + OFF_R3) + ((size_t)b * TPB + pp) * 1920;
    Raw3x2 rr0[2], rk0[2], rv0[2], rr1[2], rk1[2], rv1[2];
    const bf16_t* pc = hr + h * 64 + fq * 4; const bf16_t* pa = hp ? pc - 1920 : pc; const bf16_t* pb = hn ? pc + 1920 : pc;
#pragma unroll
    for (int nn = 0; nn < 2; ++nn) {
        const int C4 = nn * 16, C5 = C4 + 32;
        rr0[nn] = ld3x2(pc, pa, pb, hp, hn, C4); rk0[nn] = ld3x2(pc, pa, pb, hp, hn, 512 + C4); rv0[nn] = ld3x2(pc, pa, pb, hp, hn, 1024 + C4);
        rr1[nn] = ld3x2(pc, pa, pb, hp, hn, C5); rk1[nn] = ld3x2(pc, pa, pb, hp, hn, 512 + C5); rv1[nn] = ld3x2(pc, pa, pb, hp, hn, 1024 + C5);
    }
    float ss = 0.f;
    float* frow = frow0 + fr * FSTR;
    const f32x4 w01[2] = {st.aw[0], st.aw[1]}, a01[2] = {st.aa[0], st.aa[1]}, w23[2] = {st.aw[2], st.aw[3]}, a23[2] = {st.aa[2], st.aa[3]};
    scan_produce_elem<0>(pl, fq, rr0, rk0, rv0, w01, a01, ss, frow);
    scan_produce_elem<2>(pl, fq, rr1, rk1, rv1, w23, a23, ss, frow);
    ss = fqsum(ss);
    const float inv = rsqrtf(fmaxf(ss, 1e-24f));
#pragma unroll
    for (int n = 0; n < 4; ++n) {
        const int c4 = n * 16 + fq * 4;
        f32x4 kk = *(const f32x4*)(frow + 0 * 64 + c4);
        f32x4 bb = *(const f32x4*)(frow + 2 * 64 + c4);
#pragma unroll
        for (int j = 0; j < 4; ++j) { kk[j] = kk[j] * inv; bb[j] = kk[j] * bb[j]; }
        *(f32x4*)(frow + 0 * 64 + c4) = kk;
        *(f32x4*)(frow + 2 * 64 + c4) = bb;
    }
}

typedef float f32x2 __attribute__((ext_vector_type(2)));
struct ScanHead { f32x4 kk[2]; f32x2 v; };
struct ScanBody { f32x4 w[2], bb[2], kd[2], r[2]; };
__device__ __forceinline__ void scan_ldh(ScanHead& c, const float* f, const float* fv) {
#pragma unroll
    for (int q = 0; q < 2; ++q) c.kk[q] = *(const f32x4*)(f + 0 * 64 + 4 * q);
    c.v = *(const f32x2*)fv;
}
__device__ __forceinline__ void scan_ldb(ScanBody& c, const float* f) {
#pragma unroll
    for (int q = 0; q < 2; ++q) {
        c.w[q] = *(const f32x4*)(f + 1 * 64 + 4 * q); c.bb[q] = *(const f32x4*)(f + 2 * 64 + 4 * q);
        c.kd[q] = *(const f32x4*)(f + 3 * 64 + 4 * q); c.r[q] = *(const f32x4*)(f + 4 * 64 + 4 * q);
    }
}
__device__ __forceinline__ void scan_unit(const Params& p, int l, int u, unsigned char* lds) {
    const int tid = ltid(), wid = __builtin_amdgcn_readfirstlane(tid >> 6), lane = tid & 63;
    const int b = u >> 4, h = (u >> 1) & 7, z = u & 1;
    float* fb = (float*)lds;
    bf16_t* Y = (bf16_t*)(p.ws + (z == 0 ? OFF_YF : OFF_YB));
    float* pl = fb + 3 * CHUNK * FSTR;
    for (int i = tid; i < 9 * 64; i += NTHREADS) {
        const int a = i >> 6, c = i & 63, C = h * 64 + c;
        float v;
        if (a < 3) v = p.rw_mu[(size_t)l * 1920 + a * 512 + C];
        else if (a == 3) v = p.rw_w0[((size_t)l * 2 + z) * 512 + C];
        else if (a == 4) v = p.rw_a0[((size_t)l * 2 + z) * 512 + C];
        else if (a == 5) v = p.rw_k_k[(size_t)l * 512 + C];
        else if (a == 6) v = p.rw_k_a[(size_t)l * 512 + C];
        else if (a == 7) v = p.rw_mu[(size_t)l * 1920 + 1536 + z * 64 + c];
        else v = p.rw_mu[(size_t)l * 1920 + 1664 + z * 64 + c];
        pl[i] = v;
    }
    __syncthreads();
    if (wid < 4) {
        f32x2 S2[8];
#pragma unroll
        for (int j = 0; j < 8; ++j) S2[j] = (f32x2){0.f, 0.f};
        __syncthreads();
        for (int c = 0; c < NCHUNK; ++c) {
            const float* fbc = fb + (c % 3) * CHUNK * FSTR + 8 * (lane & 7);
            const float* fbv = fb + (c % 3) * CHUNK * FSTR + 320 + 16 * wid + 2 * (lane >> 3);
            bf16_t* yp = Y + ((size_t)b * TPB) * 512 + h * 64 + 16 * wid + 2 * (lane >> 3);
            ScanHead ha, hb;
            scan_ldh(ha, fbc, fbv);
#define SCAN_STEP(HC, HN, SL) { \
                ScanBody bd; scan_ldb(bd, fbc + (SL) * FSTR); \
                if ((SL) + 1 < CHUNK) scan_ldh(HN, fbc + ((SL) + 1) * FSTR, fbv + ((SL) + 1) * FSTR); \
                f32x2 d0 = (f32x2){0.f, 0.f}, d1 = (f32x2){0.f, 0.f}; \
                _Pragma("unroll") for (int q = 0; q < 4; ++q) { const f32x2 k2 = (f32x2){HC.kk[q >> 1][2 * (q & 1)], HC.kk[q >> 1][2 * (q & 1) + 1]}; \
                    d0 = __builtin_elementwise_fma(S2[q], k2, d0); d1 = __builtin_elementwise_fma(S2[4 + q], k2, d1); } \
                const float sk0 = red8(d0[0] + d0[1]), sk1 = red8(d1[0] + d1[1]); \
                const f32x2 n0 = (f32x2){-sk0, -sk0}, n1 = (f32x2){-sk1, -sk1}, v0 = (f32x2){HC.v[0], HC.v[0]}, v1 = (f32x2){HC.v[1], HC.v[1]}; \
                f32x2 y0 = (f32x2){0.f, 0.f}, y1 = (f32x2){0.f, 0.f}; \
                _Pragma("unroll") for (int q = 0; q < 4; ++q) { \
                    const f32x2 w2 = (f32x2){bd.w[q >> 1][2 * (q & 1)], bd.w[q >> 1][2 * (q & 1) + 1]}, b2 = (f32x2){bd.bb[q >> 1][2 * (q & 1)], bd.bb[q >> 1][2 * (q & 1) + 1]}; \
                    const f32x2 kd2 = (f32x2){bd.kd[q >> 1][2 * (q & 1)], bd.kd[q >> 1][2 * (q & 1) + 1]}, r2 = (f32x2){bd.r[q >> 1][2 * (q & 1)], bd.r[q >> 1][2 * (q & 1) + 1]}; \
                    f32x2 t0 = S2[q] * w2; t0 = __builtin_elementwise_fma(b2, n0, t0); t0 = __builtin_elementwise_fma(kd2, v0, t0); \
                    f32x2 t1 = S2[4 + q] * w2; t1 = __builtin_elementwise_fma(b2, n1, t1); t1 = __builtin_elementwise_fma(kd2, v1, t1); \
                    S2[q] = t0; S2[4 + q] = t1; \
                    y0 = __builtin_elementwise_fma(t0, r2, y0); y1 = __builtin_elementwise_fma(t1, r2, y1); } \
                const float ya = red8(y0[0] + y0[1]), yb = red8(y1[0] + y1[1]); \
                const int pp = scan_pos(z, c * CHUNK + (SL)); \
                if ((lane & 7) == 0) *(unsigned*)(yp + (size_t)pp * 512) = pk_bf16(ya, yb); }
#pragma unroll 1
            for (int sl = 0; sl < CHUNK; sl += 2) {
                SCAN_STEP(ha, hb, sl)
                SCAN_STEP(hb, ha, sl + 1)
            }
            __syncthreads();
        }
    } else {
        ProdState st;
#pragma unroll
        for (int n = 0; n < 4; ++n) { st.aw[n] = (f32x4){0.f, 0.f, 0.f, 0.f}; st.aa[n] = (f32x4){0.f, 0.f, 0.f, 0.f}; }
        const int nrep = launder_i(1 + ((PROBE_MASK >> 10) & 1));
        const int pair = (wid - 4) >> 1, ph = (wid - 4) & 1;
        {
            float* f0 = fb + (pair % 3) * CHUNK * FSTR + ph * 16 * FSTR;
            scan_produce_A(p, pl, b, h, z, pair * CHUNK + ph * 16, f0, lane, st);
            if (pair == 0) scan_produce_B(p, pl, b, h, z, ph * 16, f0, lane, st);
        }
        __syncthreads();
        for (int c = 0; c < NCHUNK; ++c) {
            for (int rr_ = 0; rr_ < nrep; ++rr_) {
            if (pair == ((c + 1) & 1)) {
                if (c + 1 < NCHUNK) scan_produce_B(p, pl, b, h, z, (c + 1) * CHUNK + ph * 16, fb + ((c + 1) % 3) * CHUNK * FSTR + ph * 16 * FSTR, lane, st);
            } else {
                if (c + 2 < NCHUNK) scan_produce_A(p, pl, b, h, z, (c + 2) * CHUNK + ph * 16, fb + ((c + 2) % 3) * CHUNK * FSTR + ph * 16 * FSTR, lane, st);
            }
            }
            __syncthreads();
        }
    }
}

constexpr int ATT_STAGE = 20480;
__device__ __forceinline__ void attn_unit(const Params& p, int b, int h, int q0, int nkeys, unsigned char* lds, int do_write) {
    const int tid = ltid(), wid = __builtin_amdgcn_readfirstlane(tid >> 6), lane = tid & 63, fr = lane & 15, fq = lane >> 4;
    bf16_t* Q = (bf16_t*)(p.ws + OFF_Q);
    const bf16_t* KN = (const bf16_t*)(p.ws + OFF_KN);
    const bf16_t* KR = (const bf16_t*)(p.ws + OFF_KR);
    const bf16_t* VT = (const bf16_t*)(p.ws + OFF_VT);
    const size_t rb = (size_t)b * TPB;
    bf16x8 qf[2][3];
#pragma unroll
    for (int nq = 0; nq < 2; ++nq)
#pragma unroll
        for (int ks = 0; ks < 3; ++ks) qf[nq][ks] = *(const bf16x8*)(Q + (rb + q0 + wid * 32 + nq * 16 + fr) * 768 + h * 96 + ks * 32 + fq * 8);
    f32x4 oacc[4][2];
#pragma unroll
    for (int mt = 0; mt < 4; ++mt)
#pragma unroll
        for (int nq = 0; nq < 2; ++nq) oacc[mt][nq] = (f32x4){0.f, 0.f, 0.f, 0.f};
    float mrun[2] = {-1e30f, -1e30f}, lsum[2] = {0.f, 0.f};
    const int c8 = (lane & 7) ^ ((4 * wid + (lane >> 4)) & 7);
    const bf16_t* knp = KN + (rb + 8 * wid + (lane >> 3)) * 512 + h * 64 + c8 * 8;
    const bf16_t* vtp = VT + ((size_t)(b * 8 + h) * 64 + 8 * wid + (lane >> 3)) * TPB + c8 * 8;
    const int c4 = (lane & 3) ^ ((lane >> 4) & 3);
    const bf16_t* krp = KR + (rb + 16 * (wid & 3) + (lane >> 2)) * 32 + c4 * 8;
    auto issue = [&](int t, int stg) {
        unsigned char* base = lds + stg * ATT_STAGE;
        const int k0 = t * 64;
        __builtin_amdgcn_global_load_lds((const GLB_AS unsigned*)(knp + (size_t)k0 * 512), (LDS_AS unsigned*)(base + wid * 1024), 16, 0, 0);
        __builtin_amdgcn_global_load_lds((const GLB_AS unsigned*)(vtp + k0), (LDS_AS unsigned*)(base + 12288 + wid * 1024), 16, 0, 0);
        if (wid < 4) __builtin_amdgcn_global_load_lds((const GLB_AS unsigned*)(krp + (size_t)k0 * 32), (LDS_AS unsigned*)(base + 8192 + wid * 1024), 16, 0, 0);
    };
    const int ntile = nkeys / 64;
    const int kz = fr >> 1, rz = (fr >> 2) & 3;
    issue(0, 0);
    asm volatile("s_waitcnt vmcnt(0)" ::: "memory");
    __builtin_amdgcn_s_barrier();
    asm volatile("" ::: "memory");
    for (int t = 0; t < ntile; ++t) {
        if (t + 1 < ntile) issue(t + 1, (t + 1) & 1);
        const unsigned char* Ks = lds + (t & 1) * ATT_STAGE;
        const unsigned char* Rs = Ks + 8192;
        const unsigned char* Vs = Ks + 12288;
        f32x4 sacc[4][2];
#pragma unroll
        for (int km = 0; km < 4; ++km)
#pragma unroll
            for (int nq = 0; nq < 2; ++nq) sacc[km][nq] = (f32x4){0.f, 0.f, 0.f, 0.f};
#pragma unroll
        for (int ks = 0; ks < 3; ++ks)
#pragma unroll
            for (int km = 0; km < 4; ++km) {
                const bf16x8 kf = ks < 2 ? *(const bf16x8*)(Ks + (km * 16 + fr) * 128 + (((ks * 4 + fq) ^ kz) * 16))
                                         : *(const bf16x8*)(Rs + (km * 16 + fr) * 64 + ((fq ^ rz) * 16));
#pragma unroll
                for (int nq = 0; nq < 2; ++nq) sacc[km][nq] = __builtin_amdgcn_mfma_f32_16x16x32_bf16(kf, qf[nq][ks], sacc[km][nq], 0, 0, 0);
            }
        bf16x8 pf[2][2];
#pragma unroll
        for (int nq = 0; nq < 2; ++nq) {
            float mx = -1e30f;
#pragma unroll
            for (int km = 0; km < 4; ++km)
#pragma unroll
                for (int j = 0; j < 4; ++j) mx = fmaxf(mx, sacc[km][nq][j]);
            mx = fqmax(mx);
            const float mnew = fmaxf(mrun[nq], mx);
            const float alpha = __builtin_amdgcn_exp2f(mrun[nq] - mnew);
            mrun[nq] = mnew;
            float ps = 0.f;
#pragma unroll
            for (int km = 0; km < 4; ++km)
#pragma unroll
                for (int j = 0; j < 4; ++j) { const float e = __builtin_amdgcn_exp2f(sacc[km][nq][j] - mnew); sacc[km][nq][j] = e; ps += e; }
            lsum[nq] = lsum[nq] * alpha + ps;
#pragma unroll
            for (int mt = 0; mt < 4; ++mt) oacc[mt][nq] = oacc[mt][nq] * alpha;
#pragma unroll
            for (int kc = 0; kc < 2; ++kc) {
                union { uint4 u; bf16x8 v; } r;
                r.u.x = pk_bf16(sacc[2 * kc][nq][0], sacc[2 * kc][nq][1]); r.u.y = pk_bf16(sacc[2 * kc][nq][2], sacc[2 * kc][nq][3]);
                r.u.z = pk_bf16(sacc[2 * kc + 1][nq][0], sacc[2 * kc + 1][nq][1]); r.u.w = pk_bf16(sacc[2 * kc + 1][nq][2], sacc[2 * kc + 1][nq][3]);
                pf[kc][nq] = r.v;
            }
        }
#pragma unroll
        for (int mt = 0; mt < 4; ++mt)
#pragma unroll
            for (int kc = 0; kc < 2; ++kc) {
                union { uint2 h2[2]; bf16x8 v; } r;
                const unsigned char* vrow = Vs + (mt * 16 + fr) * 128 + (fq & 1) * 8;
                r.h2[0] = *(const uint2*)(vrow + (((4 * kc + (fq >> 1)) ^ kz) * 16));
                r.h2[1] = *(const uint2*)(vrow + (((4 * kc + 2 + (fq >> 1)) ^ kz) * 16));
#pragma unroll
                for (int nq = 0; nq < 2; ++nq) oacc[mt][nq] = __builtin_amdgcn_mfma_f32_16x16x32_bf16(r.v, pf[kc][nq], oacc[mt][nq], 0, 0, 0);
            }
        asm volatile("s_waitcnt vmcnt(0) lgkmcnt(0)" ::: "memory");
        __builtin_amdgcn_s_barrier();
        asm volatile("" ::: "memory");
    }
#pragma unroll
    for (int nq = 0; nq < 2; ++nq) {
        const float inv = 1.0f / fqsum(lsum[nq]);
        bf16_t* orow = Q + (rb + q0 + wid * 32 + nq * 16 + fr) * 768 + h * 96;
#pragma unroll
        for (int mt = 0; mt < 4; ++mt) {
            uint2 o; o.x = pk_bf16(oacc[mt][nq][0] * inv, oacc[mt][nq][1] * inv); o.y = pk_bf16(oacc[mt][nq][2] * inv, oacc[mt][nq][3] * inv);
            if (do_write) *(uint2*)(orow + mt * 16 + fq * 4) = o;
        }
    }
}

__device__ __forceinline__ void p3_phase(const Params& pin, int l, unsigned char* lds) {
    const Params p = launder(pin); l = launder_i(l);
    for (int r = 0, nr = launder_i(1 + ((PROBE_MASK >> 1) & 1)); r < nr; ++r)
        for (int u = blockIdx.x; u < 256; u += gridDim.x) scan_unit(p, l, u, lds);
    const int nunits = (l == DEPTH - 1) ? 1024 : 1152;
    for (int r = launder_i(((PROBE_MASK >> 9) & 1) ? 0 : 1); r < 2; ++r)
    for (int u = blockIdx.x; u < nunits; u += gridDim.x) {
        if (u < 1024) { const int bh = u >> 3, qt = u & 7; attn_unit(p, bh >> 3, bh & 7, CTXL + qt * 256, TPB, lds, r); }
        else { const int bh = u - 1024; attn_unit(p, bh >> 3, bh & 7, 0, CTXL, lds, r); }
    }
}

__device__ __forceinline__ void p35_phase(const Params& pin, int l, bool skip_ctx, unsigned char* lds) {
    const Params p = launder(pin); l = launder_i(l); const int tid = ltid();
    const bf16_t* SG = (const bf16_t*)(p.ws + OFF_SG);
    const bf16_t* W = (const bf16_t*)(p.ws + OFF_W) + WO_GUP;
    const bf16_t* YF = (const bf16_t*)(p.ws + OFF_YF);
    const bf16_t* YB = (const bf16_t*)(p.ws + OFF_YB);
    const bf16_t* Hr = (const bf16_t*)(p.ws + OFF_R3);
    bf16_t* RWO = (bf16_t*)(p.ws + OFF_RWO);
    const float* mu = p.rw_mu + (size_t)l * 1920;
    const int lane = tid & 63, wid = tid >> 6, wr = wid >> 1, wc = wid & 1, fr = lane & 15, fq = lane >> 4;
    float* gt = (float*)lds;
    constexpr int GP = 132;
    for (int t = blockIdx.x; t < 288 * 4; t += gridDim.x) {
        int mt, nt; tile_mn(t, 4, mt, nt);
        if (skip_ctx && (mt % 18) < 2) continue;
        f32x4 acc[2][4]; zero_acc<2>(acc);
        gemm_mainloop<2, 1>(acc, SG + (size_t)mt * 128 * 128, 128, 64, W + (size_t)nt * 128 * 128, 128, 2, lds, tid);
#pragma unroll
        for (int m = 0; m < 2; ++m)
#pragma unroll
            for (int n = 0; n < 4; ++n) *(f32x4*)(gt + (wr * 32 + m * 16 + fr) * GP + wc * 64 + n * 16 + fq * 4) = acc[m][n];
        __syncthreads();
        const int pp0 = (mt % 18) * 128;
#pragma unroll 1
        for (int it = 0; it < 4; ++it) {
            const int item = tid + it * NTHREADS, lrow = item >> 4, cg = item & 15, pp = pp0 + lrow;
            const size_t row = (size_t)mt * 128 + lrow;
            const int C = nt * 128 + cg * 8;
            const bool hp = (pp != 0 && pp != CTXL), hn = (pp != CTXL - 1 && pp != TPB - 1);
            const bf16_t* hr = Hr + row * 1920;
            float yf[8], yb[8], r8[8], k8[8], v8[8];
            unpack8(*(const uint4*)(YF + row * 512 + C), yf); unpack8(*(const uint4*)(YB + row * 512 + C), yb);
            shift8(hr, hp, hn, C, mu, r8); shift8(hr, hp, hn, 512 + C, mu, k8); shift8(hr, hp, hn, 1024 + C, mu, v8);
            const float* rkp = p.rw_r_k + (size_t)l * 512 + C;
            float s1 = 0.f, bs = 0.f;
#pragma unroll
            for (int i = 0; i < 8; ++i) { yf[i] += yb[i]; s1 += yf[i]; bs += r8[i] * k8[i] * rkp[i]; }
            s1 = red8(s1); bs = red8(bs);
            const float mean = s1 * (1.0f / 64.0f);
            float s2 = 0.f;
#pragma unroll
            for (int i = 0; i < 8; ++i) { const float d = yf[i] - mean; s2 += d * d; }
            s2 = red8(s2);
            const float rstd = rsqrtf(s2 * (1.0f / 64.0f) + 64e-5f);
            const float* ggp = p.rw_gn_g + (size_t)l * 512 + C; const float* gbp = p.rw_gn_b + (size_t)l * 512 + C;
            const f32x4 g0 = *(const f32x4*)(gt + lrow * GP + cg * 8), g1 = *(const f32x4*)(gt + lrow * GP + cg * 8 + 4);
            float o[8];
#pragma unroll
            for (int i = 0; i < 8; ++i) o[i] = ((yf[i] - mean) * rstd * ggp[i] + gbp[i] + bs * v8[i]) * (i < 4 ? g0[i] : g1[i - 4]);
            uint4 ov; ov.x = pk_bf16(o[0], o[1]); ov.y = pk_bf16(o[2], o[3]); ov.z = pk_bf16(o[4], o[5]); ov.w = pk_bf16(o[6], o[7]);
            *(uint4*)(RWO + row * 512 + C) = ov;
        }
        __syncthreads();
    }
}

__device__ __forceinline__ void p4_phase(const Params& pin, bool skip_ctx, unsigned char* lds) {
    const Params p = launder(pin); const int tid = ltid();
    const bf16_t* XM = (const bf16_t*)(p.ws + OFF_R6);
    const bf16_t* W = (const bf16_t*)(p.ws + OFF_W);
    bf16_t* MG = (bf16_t*)(p.ws + OFF_MRG);
    const int lane = tid & 63, wid = tid >> 6, wr = wid >> 1, wc = wid & 1, fr = lane & 15, fq = lane >> 4;
    auto seg = [&](int t, int j) {
        int mt, nt; tile_mn(t, 8, mt, nt);
        const int i = j >> 1; Seg g;
        if (!(j & 1)) { g.A = XM + (size_t)mt * 128 * 1024; g.lda = 1024; g.a_kstep = 64; g.Bt = W + WO_IN + (size_t)(4224 + i * 1024 + nt * 128) * 1024; g.ldb = 1024; g.nk = 16; }
        else {
            if (i == 0) { g.A = (const bf16_t*)(p.ws + OFF_Q) + (size_t)mt * 128 * 768; g.lda = 768; g.a_kstep = 96; g.Bt = W + WO_OA; }
            else if (i == 1) { g.A = (const bf16_t*)(p.ws + OFF_R5) + (size_t)mt * 128 * 512; g.lda = 512; g.a_kstep = 64; g.Bt = W + WO_OC; }
            else { g.A = (const bf16_t*)(p.ws + OFF_RWO) + (size_t)mt * 128 * 512; g.lda = 512; g.a_kstep = 64; g.Bt = W + WO_OR; }
            g.Bt += (size_t)nt * 128 * 512; g.ldb = 512; g.nk = 8;
        }
        return g;
    };
    auto valid = [&](int t) { int mt, nt; tile_mn(t, 8, mt, nt); return !(skip_ctx && (mt % 18) < 2); };
    auto nextv = [&](int t) { while (t < 288 * 8 && !valid(t)) t += gridDim.x; return t; };
    int st = 0; bool first = true;
    for (int t = nextv(blockIdx.x); t < 288 * 8;) {
        int mt, nt; tile_mn(t, 8, mt, nt);
        const int tn = nextv(t + gridDim.x); const bool hn = tn < 288 * 8;
        f32x4 mg[2][4]; zero_acc<2>(mg);
        for (int i = 0; i < 3; ++i) {
            f32x4 g[2][4]; zero_acc<2>(g);
            gemm_stream<2, 1>(g, seg(t, 2 * i), seg(t, 2 * i + 1), true, first, st, lds, tid); first = false;
            f32x4 a[2][4]; zero_acc<2>(a);
            const bool lastseg = (i == 2);
            gemm_stream<2, 1>(a, seg(t, 2 * i + 1), lastseg ? seg(hn ? tn : t, 0) : seg(t, 2 * i + 2), lastseg ? hn : true, false, st, lds, tid);
#pragma unroll
            for (int m = 0; m < 2; ++m)
#pragma unroll
                for (int n = 0; n < 4; ++n)
#pragma unroll
                    for (int j = 0; j < 4; ++j) mg[m][n][j] += sigmoidf_(g[m][n][j]) * a[m][n][j];
        }
#pragma unroll
        for (int m = 0; m < 2; ++m) {
            const size_t row = (size_t)mt * 128 + wr * 32 + m * 16 + fr;
#pragma unroll
            for (int n = 0; n < 4; ++n) {
                uint2 o; o.x = pk_bf16(mg[m][n][0], mg[m][n][1]); o.y = pk_bf16(mg[m][n][2], mg[m][n][3]);
                *(uint2*)(MG + row * 1024 + nt * 128 + wc * 64 + n * 16 + fq * 4) = o;
            }
        }
        t = tn;
    }
}

template <int MT>
__device__ __forceinline__ void resid_tile(const Params& p, int l, const bf16_t* A, int lda, int nk, const bf16_t* Wt, int ldb, int goff, bool x_from_input,
                                           const float* lng, const float* lnb, int row0, int nt, unsigned char* lds, int tid) {
    const int lane = tid & 63, wid = tid >> 6, wr = wid >> 1, wc = wid & 1, fr = lane & 15, fq = lane >> 4;
    f32x4 acc[MT][4]; zero_acc<MT>(acc);
    gemm_mainloop<MT, 1>(acc, A + (size_t)row0 * lda, lda, 64, Wt + (size_t)nt * 128 * ldb, ldb, nk, lds, tid);
    const int b = row0 / TPB, pp0 = row0 % TPB;
    const float* gv = modv_ptr(p, l, b, pp0) + goff;
    const float* stats = (const float*)(p.ws + OFF_STATS);
#pragma unroll
    for (int m = 0; m < MT; ++m) {
        const int lr = wr * 16 * MT + m * 16 + fr, pp = pp0 + lr;
        const float* xi = x_rd(p, x_from_input, b, pp);
        float* xo = x_wr(p, b, pp);
        float mean = 0.f, rstd = 1.f;
        if (!x_from_input) { const size_t row = (size_t)row0 + lr; mean = stats[row * 2]; rstd = stats[row * 2 + 1]; }
#pragma unroll
        for (int n = 0; n < 4; ++n) {
            const int col = nt * 128 + wc * 64 + n * 16 + fq * 4;
            f32x4 xv = *(const f32x4*)(xi + col); const f32x4 g4 = *(const f32x4*)(gv + col);
            if (!x_from_input) {
                const f32x4 lg = *(const f32x4*)(lng + col), lb = *(const f32x4*)(lnb + col);
#pragma unroll
                for (int j = 0; j < 4; ++j) xv[j] = (xv[j] - mean) * rstd * lg[j] + lb[j];
            }
            f32x4 o;
#pragma unroll
            for (int j = 0; j < 4; ++j) o[j] = ALPHA * xv[j] + g4[j] * acc[m][n][j];
            *(f32x4*)(xo + col) = o;
        }
    }
}
__device__ __forceinline__ void resid_gemm_phase(const Params& pin, int l, size_t a_off, int lda, int nk, size_t w_off, int ldb, int goff, bool x_from_input, const float* lng, const float* lnb, bool skip_ctx, unsigned char* lds) {
    const Params p = launder(pin); l = launder_i(l);
    const int tid = ltid();
    const bf16_t* A = (const bf16_t*)(p.ws + a_off);
    const bf16_t* Wt = (const bf16_t*)(p.ws + OFF_W) + w_off;
    const int nfull = (gridDim.x == 256) ? 1024 : 144 * 8;
    for (int t = blockIdx.x; t < nfull; t += gridDim.x) {
        int mt, nt; tile_mn(t, 8, mt, nt);
        if (skip_ctx && (mt % 9) == 0) continue;
        resid_tile<4>(p, l, A, lda, nk, Wt, ldb, goff, x_from_input, lng, lnb, mt * 256, nt, lds, tid);
    }
    if (nfull == 1024) {
        int mt, nt; tile_mn(1024 + (blockIdx.x >> 1), 8, mt, nt);
        if (!(skip_ctx && (mt % 9) == 0)) resid_tile<2>(p, l, A, lda, nk, Wt, ldb, goff, x_from_input, lng, lnb, mt * 256 + (blockIdx.x & 1) * 128, nt, lds, tid);
    }
}

__device__ __forceinline__ void ln_phase(const Params& pin, const float* g, const float* bta, int lmod, int shoff, bool write_xmod, bool write_x, bool skip_ctx) {
    const Params p = launder(pin); lmod = launder_i(lmod);
    const int tid = ltid(), wid = tid >> 6, lane = tid & 63;
    bf16_t* xm = (bf16_t*)(p.ws + OFF_R6);
    float* stats = (float*)(p.ws + OFF_STATS);
    for (int row = blockIdx.x * 8 + wid; row < MROWS; row += gridDim.x * 8) {
        const int b = row / TPB, pp = row % TPB;
        if (skip_ctx && pp < CTXL) continue;
        float* xp = x_wr(p, b, pp);
        f32x4 v[4];
        float s = 0.f;
#pragma unroll
        for (int i = 0; i < 4; ++i) { v[i] = *(const f32x4*)(xp + i * 256 + lane * 4); s += (v[i][0] + v[i][1]) + (v[i][2] + v[i][3]); }
        const float mean = wave_sum(s) * (1.0f / 1024.0f);
        float q = 0.f;
#pragma unroll
        for (int i = 0; i < 4; ++i)
#pragma unroll
            for (int j = 0; j < 4; ++j) { const float d = v[i][j] - mean; q += d * d; }
        const float rstd = rsqrtf(wave_sum(q) * (1.0f / 1024.0f) + 1e-5f);
        if (lane == 0) { stats[(size_t)row * 2] = mean; stats[(size_t)row * 2 + 1] = rstd; }
        const float* mv = write_xmod ? modv_ptr(p, lmod, b, pp) + shoff : nullptr;
#pragma unroll
        for (int i = 0; i < 4; ++i) {
            const int c = i * 256 + lane * 4;
            const f32x4 g4 = *(const f32x4*)(g + c), b4 = *(const f32x4*)(bta + c);
            f32x4 o;
#pragma unroll
            for (int j = 0; j < 4; ++j) o[j] = (v[i][j] - mean) * rstd * g4[j] + b4[j];
            if (write_x) *(f32x4*)(xp + c) = o;
            if (write_xmod) {
                const f32x4 sh = *(const f32x4*)(mv + c), sc = *(const f32x4*)(mv + 1024 + c);
                uint2 ov; ov.x = pk_bf16(o[0] * (1.f + sc[0]) + sh[0], o[1] * (1.f + sc[1]) + sh[1]); ov.y = pk_bf16(o[2] * (1.f + sc[2]) + sh[2], o[3] * (1.f + sc[3]) + sh[3]);
                *(uint2*)(xm + (size_t)row * 1024 + c) = ov;
            }
        }
    }
}

__device__ __forceinline__ void p7_phase(const Params& pin, bool skip_ctx, unsigned char* lds) {
    const Params p = launder(pin); const int tid = ltid();
    const bf16_t* A = (const bf16_t*)(p.ws + OFF_R6);
    const bf16_t* W = (const bf16_t*)(p.ws + OFF_W) + WO_13;
    bf16_t* HF = (bf16_t*)(p.ws + OFF_HF);
    const int lane = tid & 63, wid = tid >> 6, wr = wid >> 2, wc = wid & 3, fr = lane & 15, fq = lane >> 4;
    auto seg = [&](int t) { int mt, nt; tile_mn(t, 22, mt, nt); Seg g; g.A = A + (size_t)mt * 256 * 1024; g.Bt = W + (size_t)nt * 256 * 1024; g.lda = 1024; g.a_kstep = 64; g.ldb = 1024; g.nk = 16; return g; };
    auto valid = [&](int t) { int mt, nt; tile_mn(t, 22, mt, nt); return !(skip_ctx && (mt % 9) == 0); };
    auto nextv = [&](int t) { while (t < 144 * 22 && !valid(t)) t += gridDim.x; return t; };
    int st = 0; bool first = true;
    for (int t = nextv(blockIdx.x); t < 144 * 22;) {
        int mt, nt; tile_mn(t, 22, mt, nt);
        const int tn = nextv(t + gridDim.x); const bool hn = tn < 144 * 22;
        f32x4 acc[8][4]; zero_acc<8>(acc);
        gemm_stream256(acc, seg(t), seg(hn ? tn : t), hn, first, st, lds, tid); first = false;
        const int G = nt * 4 + wc;
#pragma unroll
        for (int m = 0; m < 8; ++m) {
            const size_t row = (size_t)mt * 256 + wr * 128 + m * 16 + fr;
#pragma unroll
            for (int n = 0; n < 2; ++n) {
                float o[4];
#pragma unroll
                for (int j = 0; j < 4; ++j) o[j] = siluf_(acc[m][n][j]) * acc[m][n + 2][j];
                uint2 ov; ov.x = pk_bf16(o[0], o[1]); ov.y = pk_bf16(o[2], o[3]);
                *(uint2*)(HF + row * DFF + G * 32 + n * 16 + fq * 4) = ov;
            }
        }
        t = tn;
    }
}

__global__ void __launch_bounds__(NTHREADS) fwd_megakernel(Params p) {
    extern __shared__ __attribute__((aligned(16))) unsigned char lds[];
    cg::grid_group grid = cg::this_grid();
    unsigned* gbar = (unsigned*)(p.ws + OFF_BAR); unsigned epoch = 0;
#define GSYNC() grid_barrier(gbar, epoch)
    if (p.ws == nullptr) grid.sync();
    modv_phase(p, lds);
    convert_layer(p, 0, lds);
    {
        bf16_t* Wm = (bf16_t*)(p.ws + OFF_W) + WO_IN + (size_t)672 * 1024;
        for (int i = blockIdx.x * NTHREADS + threadIdx.x; i < 96 * 1024 / 2; i += gridDim.x * NTHREADS) ((unsigned*)Wm)[i] = 0u;
    }
    GSYNC();
    xmod0_phase(p);
    GSYNC();
#pragma unroll 1
    for (int l = 0; l < DEPTH; ++l) {
        const bool last = (l == DEPTH - 1);
        for (int r = 0, nr = launder_i(1 + ((PROBE_MASK >> 2) & 1)); r < nr; ++r) p1_phase(p, lds);
        GSYNC();
        for (int r = 0, nr = launder_i(1 + ((PROBE_MASK >> 3) & 1)); r < nr; ++r) p2a_phase(p, l);
        GSYNC();
        for (int r = 0, nr = launder_i(1 + ((PROBE_MASK >> 4) & 1)); r < nr; ++r) p2b_phase(p, l, lds);
        GSYNC();
        p3_phase(p, l, lds);
        GSYNC();
        for (int r = 0, nr = launder_i(1 + ((PROBE_MASK >> 5) & 1)); r < nr; ++r) p35_phase(p, l, last, lds);
        GSYNC();
        for (int r = 0, nr = launder_i(1 + ((PROBE_MASK >> 6) & 1)); r < nr; ++r) p4_phase(p, last, lds);
        GSYNC();
        resid_gemm_phase(p, l, OFF_MRG, 1024, 16, WO_OUT, 1024, 2048, l == 0, p.ln2_g + (l > 0 ? l - 1 : 0) * 1024, p.ln2_b + (l > 0 ? l - 1 : 0) * 1024, last, lds);
        GSYNC();
        ln_phase(p, p.ln1_g + l * 1024, p.ln1_b + l * 1024, l, 3072, true, false, last);
        GSYNC();
        for (int r = 0, nr = launder_i(1 + ((PROBE_MASK >> 0) & 1)); r < nr; ++r) p7_phase(p, last, lds);
        GSYNC();
        resid_gemm_phase(p, l, OFF_HF, DFF, 44, WO_2, DFF, 5120, false, p.ln1_g + l * 1024, p.ln1_b + l * 1024, last, lds);
        GSYNC();
        ln_phase(p, p.ln2_g + l * 1024, p.ln2_b + l * 1024, last ? l : l + 1, 0, !last, last, last);
        if (!last) for (int r = 0, nr = launder_i(1 + ((PROBE_MASK >> 7) & 1)); r < nr; ++r) convert_layer(p, l + 1, lds);
        for (int r = 0, nr = launder_i(((PROBE_MASK >> 8) & 1) * 10); r < nr; ++r) GSYNC();
        GSYNC();
    }
}

extern "C" void kernel_launch(void* const* d_in, const int* in_sizes, int n_in, void* d_out,
                              int out_size, void* d_ws, size_t ws_size, hipStream_t stream) {
    static int grid_blocks = 0;
    if (!grid_blocks) {
        int dev = 0, cus = 0, per_cu = 0;
        hipGetDevice(&dev);
        hipDeviceGetAttribute(&cus, hipDeviceAttributeMultiprocessorCount, dev);
        if (hipFuncSetAttribute((const void*)fwd_megakernel, hipFuncAttributeMaxDynamicSharedMemorySize, LDS_BYTES) != hipSuccess)
            fprintf(stderr, "hipFuncSetAttribute failed\n");
        hipOccupancyMaxActiveBlocksPerMultiprocessor(&per_cu, (const void*)fwd_megakernel, NTHREADS, LDS_BYTES);
        if (per_cu < 1) fprintf(stderr, "occupancy query says %d blocks/CU\n", per_cu);
        (void)hipGetLastError();
        grid_blocks = cus > 0 ? cus : 256;
        if (ws_size < WS_END) { fprintf(stderr, "workspace too small: %zu < %zu\n", ws_size, (size_t)WS_END); grid_blocks = -1; }
        if (n_in != 33) { fprintf(stderr, "expected 33 inputs, got %d\n", n_in); grid_blocks = -1; }
    }
    if (grid_blocks < 0) return;
    if (hipMemsetAsync((unsigned char*)d_ws + OFF_BAR, 0, 1024, stream) != hipSuccess) fprintf(stderr, "memset failed\n");
    Params p{};
    const float** pp = (const float**)&p;
    for (int i = 0; i < 33; ++i) pp[i] = (const float*)d_in[i];
    p.out = (float*)d_out;
    p.ws = (unsigned char*)d_ws;
    void* args[] = {&p};
    hipError_t e = hipLaunchCooperativeKernel((void*)fwd_megakernel, dim3(grid_blocks), dim3(NTHREADS), args, LDS_BYTES, stream);
    if (e != hipSuccess) fprintf(stderr, "cooperative launch failed: %s (grid %d)\n", hipGetErrorString(e), grid_blocks);
}
```

```cpp
#include <hip/hip_runtime.h>
#include <hip/hip_cooperative_groups.h>
#include <cstdio>
#include <cstdint>
namespace cg = cooperative_groups;

typedef unsigned short bf16_t;
typedef short bf16x8 __attribute__((ext_vector_type(8)));
typedef float f32x4 __attribute__((ext_vector_type(4)));

#ifndef PROBE_MASK
#define PROBE_MASK 0
#endif
constexpr int BATCH = 16, SEQ = 2048, CTXL = 256, DM = 1024, DEPTH = 4, DFF = 2816, DIN = 7200;
constexpr int TPB = SEQ + CTXL;
constexpr int MROWS = BATCH * TPB;
constexpr int NTHREADS = 512;
constexpr int LDS_BYTES = 152 * 1024;
constexpr float ALPHA = 1.681792830507429f;
constexpr float QSCALE = 0.10206207261596575f * 1.4426950408889634f;

constexpr size_t WO_IN = 0;
constexpr size_t WO_UQ = WO_IN + (size_t)7296 * 1024;
constexpr size_t WO_UKV = WO_UQ + (size_t)768 * 384;
constexpr size_t WO_OA = WO_UKV + (size_t)1024 * 256;
constexpr size_t WO_OC = WO_OA + (size_t)1024 * 512;
constexpr size_t WO_OR = WO_OC + (size_t)1024 * 512;
constexpr size_t WO_OUT = WO_OR + (size_t)1024 * 512;
constexpr size_t WO_13 = WO_OUT + (size_t)1024 * 1024;
constexpr size_t WO_2 = WO_13 + (size_t)5632 * 1024;
constexpr size_t WO_UP = WO_2 + (size_t)1024 * 2816;
constexpr size_t WO_AUP = WO_UP + (size_t)2 * 512 * 64;
constexpr size_t WO_GUP = WO_AUP + (size_t)2 * 512 * 64;
constexpr size_t W_ELEMS = WO_GUP + (size_t)512 * 128;

constexpr size_t al256(size_t x) { return (x + 255) & ~(size_t)255; }
constexpr size_t OFF_BAR = 0;
constexpr size_t OFF_W = 1024;
constexpr size_t OFF_MODV = al256(OFF_W + W_ELEMS * 2);
constexpr size_t OFF_ROPE = al256(OFF_MODV + (size_t)4 * 17 * 6144 * 4);
constexpr size_t OFF_RSQ = al256(OFF_ROPE + 64 * 8 * 2 * 4);
constexpr size_t OFF_RSKV = al256(OFF_RSQ + (size_t)MROWS * 4);
constexpr size_t OFF_STATS = al256(OFF_RSKV + (size_t)MROWS * 4);
constexpr size_t OFF_XC = al256(OFF_STATS + (size_t)MROWS * 8);
constexpr size_t OFF_R1 = al256(OFF_XC + (size_t)BATCH * CTXL * DM * 4);
constexpr size_t OFF_R2 = al256(OFF_R1 + (size_t)MROWS * 672 * 2);
constexpr size_t OFF_R3 = OFF_R2 + (size_t)MROWS * 1536 * 2;
constexpr size_t OFF_R4 = al256(OFF_R3 + (size_t)MROWS * 1920 * 2);
constexpr size_t OFF_R5 = al256(OFF_R4 + (size_t)MROWS * (512 + 512 + 32) * 2);
constexpr size_t OFF_R6 = al256(OFF_R5 + (size_t)MROWS * 512 * 2);
constexpr size_t WS_END = al256(OFF_R6 + (size_t)MROWS * 1024 * 2);
constexpr size_t OFF_Q = OFF_R2;
constexpr size_t OFF_YF = OFF_R2 + (size_t)MROWS * 768 * 2;
constexpr size_t OFF_SG = OFF_YF + (size_t)MROWS * 512 * 2;
constexpr size_t OFF_YB = OFF_R1;
constexpr size_t OFF_KN = OFF_R4;
constexpr size_t OFF_VT = OFF_R4 + (size_t)MROWS * 512 * 2;
constexpr size_t OFF_KR = OFF_VT + (size_t)MROWS * 512 * 2;
constexpr size_t OFF_RWO = OFF_R4;
constexpr size_t OFF_MRG = OFF_R3;
constexpr size_t OFF_HF = OFF_R2;
static_assert(OFF_SG + (size_t)MROWS * 128 * 2 <= OFF_R3, "R2 overlay overflow");
static_assert((size_t)MROWS * 2816 * 2 <= OFF_R4 - OFF_R2, "HF overflow");

struct Params {
    const float *x, *c, *ctx, *c_ctx, *mod_w, *mod_b, *w_in, *q_norm, *w_uq, *kv_norm, *w_ukv, *w_o_attn,
        *conv_w, *w_o_conv, *rw_mu, *rw_w0, *rw_w_up, *rw_a0, *rw_a_up, *rw_g_up, *rw_k_k, *rw_k_a,
        *rw_r_k, *rw_gn_g, *rw_gn_b, *w_o_rwkv, *w_out, *ln1_g, *ln1_b, *ffn_w13, *ffn_w2, *ln2_g, *ln2_b;
    float* out;
    unsigned char* ws;
};

typedef __attribute__((address_space(1))) unsigned char gchar_t;
typedef __attribute__((address_space(1))) float gfloat_t;
__device__ __forceinline__ Params launder(const Params& a) {
    Params q = a;
    unsigned long long w = (unsigned long long)a.ws, o = (unsigned long long)a.out;
    unsigned wl = __builtin_amdgcn_readfirstlane((unsigned)w), wh = __builtin_amdgcn_readfirstlane((unsigned)(w >> 32));
    unsigned ol = __builtin_amdgcn_readfirstlane((unsigned)o), oh = __builtin_amdgcn_readfirstlane((unsigned)(o >> 32));
    asm volatile("" : "+s"(wl), "+s"(wh), "+s"(ol), "+s"(oh));
    w = ((unsigned long long)wh << 32) | wl; o = ((unsigned long long)oh << 32) | ol;
    q.ws = (unsigned char*)(gchar_t*)w; q.out = (float*)(gfloat_t*)o;
    return q;
}
__device__ __forceinline__ int launder_i(int v) { v = __builtin_amdgcn_readfirstlane(v); asm volatile("" : "+s"(v)); return v; }
__device__ __forceinline__ int ltid() { int t = threadIdx.x; asm volatile("" : "+v"(t)); return t; }
__device__ __forceinline__ unsigned pk_bf16(float lo, float hi) { unsigned r; asm("v_cvt_pk_bf16_f32 %0, %1, %2" : "=v"(r) : "v"(lo), "v"(hi)); return r; }
__device__ __forceinline__ float bf_lo(unsigned u) { return __uint_as_float(u << 16); }
__device__ __forceinline__ float bf_hi(unsigned u) { return __uint_as_float(u & 0xffff0000u); }
__device__ __forceinline__ float bf1(bf16_t h) { return __uint_as_float(((unsigned)h) << 16); }
__device__ __forceinline__ float x32sum(float x) { unsigned u = __float_as_uint(x); auto r = __builtin_amdgcn_permlane32_swap(u, u, false, false); return __uint_as_float(r[0]) + __uint_as_float(r[1]); }
__device__ __forceinline__ float x16sum(float x) { unsigned u = __float_as_uint(x); auto r = __builtin_amdgcn_permlane16_swap(u, u, false, false); return __uint_as_float(r[0]) + __uint_as_float(r[1]); }
__device__ __forceinline__ float x32max(float x) { unsigned u = __float_as_uint(x); auto r = __builtin_amdgcn_permlane32_swap(u, u, false, false); return fmaxf(__uint_as_float(r[0]), __uint_as_float(r[1])); }
__device__ __forceinline__ float x16max(float x) { unsigned u = __float_as_uint(x); auto r = __builtin_amdgcn_permlane16_swap(u, u, false, false); return fmaxf(__uint_as_float(r[0]), __uint_as_float(r[1])); }
__device__ __forceinline__ float fqsum(float x) { return x16sum(x32sum(x)); }
__device__ __forceinline__ float fqmax(float x) { return x16max(x32max(x)); }
__device__ __forceinline__ float wave_sum(float v) {
#pragma unroll
    for (int o = 1; o < 16; o <<= 1) v += __shfl_xor(v, o);
    return fqsum(v);
}
template <int CTRL> __device__ __forceinline__ float dpp_add(float x) { return x + __uint_as_float((unsigned)__builtin_amdgcn_update_dpp(0, (int)__float_as_uint(x), CTRL, 0xf, 0xf, true)); }
__device__ __forceinline__ float red8(float x) { x = dpp_add<0xB1>(x); x = dpp_add<0x4E>(x); x = dpp_add<0x141>(x); return x; }
__device__ __forceinline__ float sigmoidf_(float x) { return 1.0f / (1.0f + __expf(-x)); }
__device__ __forceinline__ float siluf_(float x) { return x / (1.0f + __expf(-x)); }

__device__ __forceinline__ const float* x_rd(const Params& p, bool from_input, int b, int pp) {
    if (pp < CTXL) return (from_input ? p.ctx : (const float*)(p.ws + OFF_XC)) + ((size_t)b * CTXL + pp) * DM;
    return (from_input ? p.x : (const float*)p.out) + ((size_t)b * SEQ + (pp - CTXL)) * DM;
}
__device__ __forceinline__ float* x_wr(const Params& p, int b, int pp) {
    if (pp < CTXL) return (float*)(p.ws + OFF_XC) + ((size_t)b * CTXL + pp) * DM;
    return p.out + ((size_t)b * SEQ + (pp - CTXL)) * DM;
}
__device__ __forceinline__ const float* modv_ptr(const Params& p, int l, int b, int pp) {
    const int mr = pp < CTXL ? 16 : b;
    return (const float*)(p.ws + OFF_MODV) + ((size_t)l * 17 + mr) * 6144;
}

__device__ __forceinline__ void grid_barrier(unsigned* bar, unsigned& epoch) {
    asm volatile("s_waitcnt vmcnt(0) lgkmcnt(0)" ::: "memory");
    __syncthreads();
    epoch += 1;
    if (threadIdx.x == 0) {
        __builtin_amdgcn_fence(__ATOMIC_RELEASE, "agent");
        asm volatile("s_waitcnt vmcnt(0)" ::: "memory");
        const unsigned old = __hip_atomic_fetch_add(bar, 1u, __ATOMIC_RELAXED, __HIP_MEMORY_SCOPE_AGENT);
        if (old + 1u == epoch * gridDim.x) {
            __hip_atomic_store(bar + 64, epoch, __ATOMIC_RELAXED, __HIP_MEMORY_SCOPE_AGENT);
        } else {
            while (__hip_atomic_load(bar + 64, __ATOMIC_RELAXED, __HIP_MEMORY_SCOPE_AGENT) < epoch) __builtin_amdgcn_s_sleep(1);
        }
        __builtin_amdgcn_fence(__ATOMIC_ACQUIRE, "agent");
        asm volatile("s_waitcnt vmcnt(0)" ::: "memory");
    }
    __syncthreads();
}

#define LDS_AS __attribute__((address_space(3)))
#define GLB_AS __attribute__((address_space(1)))
template <int MT, int SWAPMODE>
__device__ __forceinline__ void gemm_mainloop(f32x4 (&acc)[MT][4], const bf16_t* __restrict__ A, int lda, int a_kstep,
                                              const bf16_t* __restrict__ Bt, int ldb, int nk, unsigned char* lds, int tid) {
    constexpr int BMr = 64 * MT;
    constexpr int STAGE = (BMr + 128) * 128;
    const int wid = __builtin_amdgcn_readfirstlane(tid >> 6), lane = tid & 63, wr = wid >> 1, wc = wid & 1, fr = lane & 15, fq = lane >> 4;
    const int lrow = 8 * wid + (lane >> 3);
    const int lch = (lane & 7) ^ ((4 * wid + (lane >> 4)) & 7);
    const bf16_t* ap = A + (size_t)lrow * lda + lch * 8;
    const bf16_t* bp = Bt + (size_t)lrow * ldb + lch * 8;
    auto issue = [&](int kt, int st) {
        unsigned char* base = lds + st * STAGE + wid * 1024;
#pragma unroll
        for (int i = 0; i < MT; ++i)
            __builtin_amdgcn_global_load_lds((const GLB_AS unsigned*)(ap + (size_t)i * 64 * lda + (size_t)kt * a_kstep), (LDS_AS unsigned*)(base + i * 8192), 16, 0, 0);
#pragma unroll
        for (int i = 0; i < 2; ++i)
            __builtin_amdgcn_global_load_lds((const GLB_AS unsigned*)(bp + (size_t)i * 64 * ldb + (size_t)kt * 64), (LDS_AS unsigned*)(base + (BMr + i * 64) * 128), 16, 0, 0);
    };
    const bool sw = (SWAPMODE == 1) || (SWAPMODE == 2 && wc == 0);
    const int sz = fr >> 1;
    constexpr int NL = MT + 2;
    const bool late = wid >= 4;
    issue(0, 0);
    if (nk > 1) { issue(1, 1); asm volatile("s_waitcnt vmcnt(%0)" ::"n"(NL) : "memory"); }
    else asm volatile("s_waitcnt vmcnt(0)" ::: "memory");
    __builtin_amdgcn_s_barrier();
    asm volatile("" ::: "memory");
    int st = 0;
    for (int kt = 0; kt < nk; ++kt) {
        const int st2 = st >= 1 ? st - 1 : 2;
        if (!late && kt + 2 < nk) issue(kt + 2, st2);
        const unsigned char* As = lds + st * STAGE;
        const unsigned char* Bs = As + BMr * 128;
#pragma unroll
        for (int ks = 0; ks < 2; ++ks) {
            bf16x8 af[MT], bfr[4];
            const int co = ((ks * 4 + fq) ^ sz) * 16;
#pragma unroll
            for (int m = 0; m < MT; ++m) af[m] = *(const bf16x8*)(As + (wr * 16 * MT + m * 16 + fr) * 128 + co);
#pragma unroll
            for (int n = 0; n < 4; ++n) bfr[n] = *(const bf16x8*)(Bs + (wc * 64 + n * 16 + fr) * 128 + co);
            if (sw) {
#pragma unroll
                for (int m = 0; m < MT; ++m)
#pragma unroll
                    for (int n = 0; n < 4; ++n) acc[m][n] = __builtin_amdgcn_mfma_f32_16x16x32_bf16(bfr[n], af[m], acc[m][n], 0, 0, 0);
            } else {
#pragma unroll
                for (int m = 0; m < MT; ++m)
#pragma unroll
                    for (int n = 0; n < 4; ++n) acc[m][n] = __builtin_amdgcn_mfma_f32_16x16x32_bf16(af[m], bfr[n], acc[m][n], 0, 0, 0);
            }
        }
        if (late && kt + 2 < nk) issue(kt + 2, st2);
        if (kt + 2 < nk) asm volatile("s_waitcnt vmcnt(%0) lgkmcnt(0)" ::"n"(NL) : "memory");
        else asm volatile("s_waitcnt vmcnt(0) lgkmcnt(0)" ::: "memory");
        __builtin_amdgcn_s_barrier();
        asm volatile("" ::: "memory");
        st = st == 2 ? 0 : st + 1;
    }
}
__device__ __forceinline__ void gemm_mainloop256(f32x4 (&acc)[8][4], const bf16_t* __restrict__ A, int lda,
                                                 const bf16_t* __restrict__ Bt, int ldb, int nk, unsigned char* lds, int tid) {
    constexpr int STAGE = 512 * 128;
    const int wid = __builtin_amdgcn_readfirstlane(tid >> 6), lane = tid & 63, wr = wid >> 2, wc = wid & 3, fr = lane & 15, fq = lane >> 4;
    const int lrow = 8 * wid + (lane >> 3);
    const int lch = (lane & 7) ^ ((4 * wid + (lane >> 4)) & 7);
    const bf16_t* ap = A + (size_t)lrow * lda + lch * 8;
    const bf16_t* bp = Bt + (size_t)lrow * ldb + lch * 8;
    auto issue = [&](int kt, int st) {
        unsigned char* base = lds + st * STAGE + wid * 1024;
#pragma unroll
        for (int i = 0; i < 4; ++i)
            __builtin_amdgcn_global_load_lds((const GLB_AS unsigned*)(ap + (size_t)i * 64 * lda + (size_t)kt * 64), (LDS_AS unsigned*)(base + i * 8192), 16, 0, 0);
#pragma unroll
        for (int i = 0; i < 4; ++i)
            __builtin_amdgcn_global_load_lds((const GLB_AS unsigned*)(bp + (size_t)i * 64 * ldb + (size_t)kt * 64), (LDS_AS unsigned*)(base + (256 + i * 64) * 128), 16, 0, 0);
    };
    const int sz = fr >> 1;
    const bool late = wid >= 4;
    issue(0, 0);
    asm volatile("s_waitcnt vmcnt(0)" ::: "memory");
    __builtin_amdgcn_s_barrier();
    asm volatile("" ::: "memory");
    for (int kt = 0; kt < nk; ++kt) {
        if (!late && kt + 1 < nk) issue(kt + 1, (kt + 1) & 1);
        const unsigned char* As = lds + (kt & 1) * STAGE;
        const unsigned char* Bs = As + 256 * 128;
#pragma unroll
        for (int ks = 0; ks < 2; ++ks) {
            if (ks == 1 && late && kt + 1 < nk) issue(kt + 1, (kt + 1) & 1);
            bf16x8 af[8], bfr[4];
            const int co = ((ks * 4 + fq) ^ sz) * 16;
#pragma unroll
            for (int m = 0; m < 8; ++m) af[m] = *(const bf16x8*)(As + (wr * 128 + m * 16 + fr) * 128 + co);
#pragma unroll
            for (int n = 0; n < 4; ++n) bfr[n] = *(const bf16x8*)(Bs + (wc * 64 + n * 16 + fr) * 128 + co);
#pragma unroll
            for (int m = 0; m < 8; ++m)
#pragma unroll
                for (int n = 0; n < 4; ++n) acc[m][n] = __builtin_amdgcn_mfma_f32_16x16x32_bf16(bfr[n], af[m], acc[m][n], 0, 0, 0);
        }
        asm volatile("s_waitcnt vmcnt(0) lgkmcnt(0)" ::: "memory");
        __builtin_amdgcn_s_barrier();
        asm volatile("" ::: "memory");
    }
}
struct Seg { const bf16_t* A; const bf16_t* Bt; int lda, a_kstep, ldb, nk; };
template <int MT, int SWAPMODE>
__device__ __forceinline__ void gemm_stream(f32x4 (&acc)[MT][4], const Seg& cur, const Seg& nxt, bool has_next, bool first, int& st,
                                            unsigned char* lds, int tid) {
    constexpr int BMr = 64 * MT;
    constexpr int STAGE = (BMr + 128) * 128;
    constexpr int NL = MT + 2;
    const int wid = __builtin_amdgcn_readfirstlane(tid >> 6), lane = tid & 63, wr = wid >> 1, wc = wid & 1, fr = lane & 15, fq = lane >> 4;
    const int lrow = 8 * wid + (lane >> 3);
    const int lch = (lane & 7) ^ ((4 * wid + (lane >> 4)) & 7);
    const bf16_t* apc = cur.A + (size_t)lrow * cur.lda + lch * 8;
    const bf16_t* bpc = cur.Bt + (size_t)lrow * cur.ldb + lch * 8;
    const bf16_t* apn = nxt.A + (size_t)lrow * nxt.lda + lch * 8;
    const bf16_t* bpn = nxt.Bt + (size_t)lrow * nxt.ldb + lch * 8;
    auto issue = [&](const bf16_t* ap, const bf16_t* bp, int lda, int ldb, int koffa, int koffb, int slot) {
        unsigned char* base = lds + slot * STAGE + wid * 1024;
#pragma unroll
        for (int i = 0; i < MT; ++i)
            __builtin_amdgcn_global_load_lds((const GLB_AS unsigned*)(ap + (size_t)i * 64 * lda + koffa), (LDS_AS unsigned*)(base + i * 8192), 16, 0, 0);
#pragma unroll
        for (int i = 0; i < 2; ++i)
            __builtin_amdgcn_global_load_lds((const GLB_AS unsigned*)(bp + (size_t)i * 64 * ldb + koffb), (LDS_AS unsigned*)(base + (BMr + i * 64) * 128), 16, 0, 0);
    };
    const bool sw = (SWAPMODE == 1) || (SWAPMODE == 2 && wc == 0);
    const int sz = fr >> 1;
    const bool late = wid >= 4;
    const int nk = cur.nk;
    int s0 = st;
    if (first) {
        const int s1 = s0 == 2 ? 0 : s0 + 1;
        issue(apc, bpc, cur.lda, cur.ldb, 0, 0, s0);
        issue(apc, bpc, cur.lda, cur.ldb, cur.a_kstep, 64, s1);
        asm volatile("s_waitcnt vmcnt(%0)" ::"n"(NL) : "memory");
        __builtin_amdgcn_s_barrier();
        asm volatile("" ::: "memory");
    }
    for (int kt = 0; kt < nk; ++kt) {
        const int s2 = s0 >= 1 ? s0 - 1 : 2;
        const int idx = kt + 2;
        const bool incur = idx < nk, doi = incur || has_next;
        if (!late && doi) { if (incur) issue(apc, bpc, cur.lda, cur.ldb, idx * cur.a_kstep, idx * 64, s2); else issue(apn, bpn, nxt.lda, nxt.ldb, (idx - nk) * nxt.a_kstep, (idx - nk) * 64, s2); }
        const unsigned char* As = lds + s0 * STAGE;
        const unsigned char* Bs = As + BMr * 128;
#pragma unroll
        for (int ks = 0; ks < 2; ++ks) {
            bf16x8 af[MT], bfr[4];
            const int co = ((ks * 4 + fq) ^ sz) * 16;
#pragma unroll
            for (int m = 0; m < MT; ++m) af[m] = *(const bf16x8*)(As + (wr * 16 * MT + m * 16 + fr) * 128 + co);
#pragma unroll
            for (int n = 0; n < 4; ++n) bfr[n] = *(const bf16x8*)(Bs + (wc * 64 + n * 16 + fr) * 128 + co);
            if (sw) {
#pragma unroll
                for (int m = 0; m < MT; ++m)
#pragma unroll
                    for (int n = 0; n < 4; ++n) acc[m][n] = __builtin_amdgcn_mfma_f32_16x16x32_bf16(bfr[n], af[m], acc[m][n], 0, 0, 0);
            } else {
#pragma unroll
                for (int m = 0; m < MT; ++m)
#pragma unroll
                    for (int n = 0; n < 4; ++n) acc[m][n] = __builtin_amdgcn_mfma_f32_16x16x32_bf16(af[m], bfr[n], acc[m][n], 0, 0, 0);
            }
        }
        if (late && doi) { if (incur) issue(apc, bpc, cur.lda, cur.ldb, idx * cur.a_kstep, idx * 64, s2); else issue(apn, bpn, nxt.lda, nxt.ldb, (idx - nk) * nxt.a_kstep, (idx - nk) * 64, s2); }
        if (doi) asm volatile("s_waitcnt vmcnt(%0) lgkmcnt(0)" ::"n"(NL) : "memory");
        else asm volatile("s_waitcnt vmcnt(0) lgkmcnt(0)" ::: "memory");
        __builtin_amdgcn_s_barrier();
        asm volatile("" ::: "memory");
        s0 = s0 == 2 ? 0 : s0 + 1;
    }
    st = s0;
}
__device__ __forceinline__ void gemm_stream256(f32x4 (&acc)[8][4], const Seg& cur, const Seg& nxt, bool has_next, bool first, int& st, unsigned char* lds, int tid) {
    constexpr int STAGE = 512 * 128;
    const int wid = __builtin_amdgcn_readfirstlane(tid >> 6), lane = tid & 63, wr = wid >> 2, wc = wid & 3, fr = lane & 15, fq = lane >> 4;
    const int lrow = 8 * wid + (lane >> 3);
    const int lch = (lane & 7) ^ ((4 * wid + (lane >> 4)) & 7);
    const bf16_t* apc = cur.A + (size_t)lrow * cur.lda + lch * 8;
    const bf16_t* bpc = cur.Bt + (size_t)lrow * cur.ldb + lch * 8;
    const bf16_t* apn = nxt.A + (size_t)lrow * nxt.lda + lch * 8;
    const bf16_t* bpn = nxt.Bt + (size_t)lrow * nxt.ldb + lch * 8;
    auto issue = [&](const bf16_t* ap, const bf16_t* bp, int lda, int ldb, int koff, int slot) {
        unsigned char* base = lds + slot * STAGE + wid * 1024;
#pragma unroll
        for (int i = 0; i < 4; ++i)
            __builtin_amdgcn_global_load_lds((const GLB_AS unsigned*)(ap + (size_t)i * 64 * lda + koff), (LDS_AS unsigned*)(base + i * 8192), 16, 0, 0);
#pragma unroll
        for (int i = 0; i < 4; ++i)
            __builtin_amdgcn_global_load_lds((const GLB_AS unsigned*)(bp + (size_t)i * 64 * ldb + koff), (LDS_AS unsigned*)(base + (256 + i * 64) * 128), 16, 0, 0);
    };
    const int sz = fr >> 1;
    const bool late = wid >= 4;
    const int nk = cur.nk;
    int s0 = st;
    if (first) {
        issue(apc, bpc, cur.lda, cur.ldb, 0, s0);
        asm volatile("s_waitcnt vmcnt(0)" ::: "memory");
        __builtin_amdgcn_s_barrier();
        asm volatile("" ::: "memory");
    }
    for (int kt = 0; kt < nk; ++kt) {
        const int idx = kt + 1;
        const bool incur = idx < nk, doi = incur || has_next;
        if (!late && doi) { if (incur) issue(apc, bpc, cur.lda, cur.ldb, idx * 64, s0 ^ 1); else issue(apn, bpn, nxt.lda, nxt.ldb, 0, s0 ^ 1); }
        const unsigned char* As = lds + s0 * STAGE;
        const unsigned char* Bs = As + 256 * 128;
#pragma unroll
        for (int ks = 0; ks < 2; ++ks) {
            if (ks == 1 && late && doi) { if (incur) issue(apc, bpc, cur.lda, cur.ldb, idx * 64, s0 ^ 1); else issue(apn, bpn, nxt.lda, nxt.ldb, 0, s0 ^ 1); }
            bf16x8 af[8], bfr[4];
            const int co = ((ks * 4 + fq) ^ sz) * 16;
#pragma unroll
            for (int m = 0; m < 8; ++m) af[m] = *(const bf16x8*)(As + (wr * 128 + m * 16 + fr) * 128 + co);
#pragma unroll
            for (int n = 0; n < 4; ++n) bfr[n] = *(const bf16x8*)(Bs + (wc * 64 + n * 16 + fr) * 128 + co);
#pragma unroll
            for (int m = 0; m < 8; ++m)
#pragma unroll
                for (int n = 0; n < 4; ++n) acc[m][n] = __builtin_amdgcn_mfma_f32_16x16x32_bf16(bfr[n], af[m], acc[m][n], 0, 0, 0);
        }
        asm volatile("s_waitcnt vmcnt(0) lgkmcnt(0)" ::: "memory");
        __builtin_amdgcn_s_barrier();
        asm volatile("" ::: "memory");
        s0 ^= 1;
    }
    st = s0;
}
__device__ __forceinline__ void gemm_gate3(f32x4 (&g)[3][2][4], const bf16_t* __restrict__ A, const bf16_t* __restrict__ Bt0, int nk, unsigned char* lds, int tid) {
    constexpr int STAGE = 512 * 128;
    const int wid = __builtin_amdgcn_readfirstlane(tid >> 6), lane = tid & 63, wr = wid >> 1, wc = wid & 1, fr = lane & 15, fq = lane >> 4;
    const int lrow = 8 * wid + (lane >> 3);
    const int lch = (lane & 7) ^ ((4 * wid + (lane >> 4)) & 7);
    const unsigned loff = (unsigned)(lrow * 1024 + lch * 8);
    auto issue = [&](int kt, int stg) {
        unsigned char* base = lds + stg * STAGE + wid * 1024;
#pragma unroll
        for (int i = 0; i < 2; ++i)
            __builtin_amdgcn_global_load_lds((const GLB_AS unsigned*)((A + (size_t)i * 64 * 1024 + (size_t)kt * 64) + loff), (LDS_AS unsigned*)(base + i * 8192), 16, 0, 0);
#pragma unroll
        for (int j = 0; j < 6; ++j)
            __builtin_amdgcn_global_load_lds((const GLB_AS unsigned*)((Bt0 + ((size_t)(j >> 1) * 1024 + (j & 1) * 64) * 1024 + (size_t)kt * 64) + loff), (LDS_AS unsigned*)(base + (128 + j * 64) * 128), 16, 0, 0);
    };
    const int sz = fr >> 1;
    const bool late = wid >= 4;
    issue(0, 0);
    asm volatile("s_waitcnt vmcnt(0)" ::: "memory");
    __builtin_amdgcn_s_barrier();
    asm volatile("" ::: "memory");
    for (int kt = 0; kt < nk; ++kt) {
        if (!late && kt + 1 < nk) issue(kt + 1, (kt + 1) & 1);
        const unsigned char* As = lds + (kt & 1) * STAGE;
        const unsigned char* Bs = As + 128 * 128;
#pragma unroll
        for (int ks = 0; ks < 2; ++ks) {
            if (ks == 1 && late && kt + 1 < nk) issue(kt + 1, (kt + 1) & 1);
            const int co = ((ks * 4 + fq) ^ sz) * 16;
            bf16x8 af[2];
#pragma unroll
            for (int m = 0; m < 2; ++m) af[m] = *(const bf16x8*)(As + (wr * 32 + m * 16 + fr) * 128 + co);
#pragma unroll
            for (int i = 0; i < 3; ++i) {
                bf16x8 bfr[4];
#pragma unroll
                for (int n = 0; n < 4; ++n) bfr[n] = *(const bf16x8*)(Bs + (i * 128 + wc * 64 + n * 16 + fr) * 128 + co);
#pragma unroll
                for (int m = 0; m < 2; ++m)
#pragma unroll
                    for (int n = 0; n < 4; ++n) g[i][m][n] = __builtin_amdgcn_mfma_f32_16x16x32_bf16(bfr[n], af[m], g[i][m][n], 0, 0, 0);
                if (i < 2) __builtin_amdgcn_sched_barrier(0);
            }
        }
        asm volatile("s_waitcnt vmcnt(0) lgkmcnt(0)" ::: "memory");
        __builtin_amdgcn_s_barrier();
        asm volatile("" ::: "memory");
    }
}
template <int MT> __device__ __forceinline__ void zero_acc(f32x4 (&acc)[MT][4]) {
#pragma unroll
    for (int m = 0; m < MT; ++m)
#pragma unroll
        for (int n = 0; n < 4; ++n) acc[m][n] = (f32x4){0.f, 0.f, 0.f, 0.f};
}
__device__ __forceinline__ void tile_mn(int t, int nN, int& mt, int& nt) { const int per = 16 * nN, g = t / per, w = t % per; mt = g * 16 + (w & 15); nt = w >> 4; }

__device__ __forceinline__ int rowmap(int mode, int n) {
    if (mode == 1) return n < 672 ? n : n + 96;
    if (mode == 2) return n < DFF ? ((n >> 5) * 64 + (n & 31)) : (((n - DFF) >> 5) * 64 + 32 + ((n - DFF) & 31));
    return n;
}
__device__ __forceinline__ void convert_T(const float* __restrict__ src, int K, int N, bf16_t* __restrict__ dst, int mode, const float* __restrict__ ks, unsigned char* lds, int rot) {
    float* tile = (float*)lds;
    const int ntk = K / 64, ntn = (N + 63) / 64, tid = ltid();
    const int start = (blockIdx.x + gridDim.x - (rot % gridDim.x)) % gridDim.x;
    for (int t = start; t < ntk * ntn; t += gridDim.x) {
        const int tk = t % ntk, tn = t / ntk, k0 = tk * 64, n0 = tn * 64;
#pragma unroll
        for (int i = 0; i < 8; ++i) {
            const int kl = (tid >> 6) + 8 * i, nl = tid & 63, n = n0 + nl;
            tile[kl * 65 + nl] = n < N ? src[(size_t)(k0 + kl) * N + n] : 0.f;
        }
        __syncthreads();
        const int kp = (tid & 31) * 2;
        float s0 = 1.f, s1 = 1.f;
        if (ks) { s0 = ks[k0 + kp]; s1 = ks[k0 + kp + 1]; }
#pragma unroll
        for (int i = 0; i < 4; ++i) {
            const int nl = (tid >> 5) + 16 * i, n = n0 + nl;
            if (n < N) *(unsigned*)(dst + (size_t)rowmap(mode, n) * K + k0 + kp) = pk_bf16(tile[kp * 65 + nl] * s0, tile[(kp + 1) * 65 + nl] * s1);
        }
        __syncthreads();
    }
}
__device__ __forceinline__ void convert_layer(const Params& pin, int l, unsigned char* lds) {
    const Params p = launder(pin); l = launder_i(l);
    bf16_t* W = (bf16_t*)(p.ws + OFF_W);
    convert_T(p.w_in + (size_t)l * DM * DIN, DM, DIN, W + WO_IN, 1, nullptr, lds, 0);
    convert_T(p.ffn_w13 + (size_t)l * DM * 2 * DFF, DM, 2 * DFF, W + WO_13, 2, nullptr, lds, 40);
    convert_T(p.ffn_w2 + (size_t)l * DFF * DM, DFF, DM, W + WO_2, 0, nullptr, lds, 80);
    convert_T(p.w_out + (size_t)l * DM * DM, DM, DM, W + WO_OUT, 0, nullptr, lds, 120);
    convert_T(p.w_o_attn + (size_t)l * 512 * DM, 512, DM, W + WO_OA, 0, nullptr, lds, 136);
    convert_T(p.w_o_conv + (size_t)l * 512 * DM, 512, DM, W + WO_OC, 0, nullptr, lds, 8);
    convert_T(p.w_o_rwkv + (size_t)l * 512 * DM, 512, DM, W + WO_OR, 0, nullptr, lds, 136 + 8);
    convert_T(p.w_uq + (size_t)l * 384 * 768, 384, 768, W + WO_UQ, 0, p.q_norm + l * 384, lds, 16);
    convert_T(p.w_ukv + (size_t)l * 256 * 1024, 256, 1024, W + WO_UKV, 0, p.kv_norm + l * 256, lds, 88);
    for (int z = 0; z < 2; ++z) {
        convert_T(p.rw_w_up + ((size_t)l * 2 + z) * 64 * 512, 64, 512, W + WO_UP + (size_t)z * 512 * 64, 0, nullptr, lds, 152 + 8 * z);
        convert_T(p.rw_a_up + ((size_t)l * 2 + z) * 64 * 512, 64, 512, W + WO_AUP + (size_t)z * 512 * 64, 0, nullptr, lds, 168 + 8 * z);
    }
    convert_T(p.rw_g_up + (size_t)l * 128 * 512, 128, 512, W + WO_GUP, 0, nullptr, lds, 184);
}

__device__ __forceinline__ void modv_phase(const Params& pin, unsigned char* lds) {
    const Params p = launder(pin);
    float* s = (float*)lds;
    float* red = s + 17 * 1024;
    const int tid = ltid(), wid = tid >> 6, lane = tid & 63;
    for (int i = tid; i < 17 * 1024; i += NTHREADS) { const int r = i >> 10, k = i & 1023; const float v = r < 16 ? p.c[r * 1024 + k] : p.c_ctx[k]; s[i] = siluf_(v); }
    __syncthreads();
    float* modv = (float*)(p.ws + OFF_MODV);
    for (int g = blockIdx.x; g < 4 * 96; g += gridDim.x) {
        const int l = g / 96, n = (g % 96) * 64 + lane;
        const float* w = p.mod_w + (size_t)l * 1024 * 6144 + n;
        float acc[17];
#pragma unroll
        for (int r = 0; r < 17; ++r) acc[r] = 0.f;
        const int kb = wid * 128;
        for (int k = kb; k < kb + 128; k += 4) {
            const float w0 = w[(size_t)k * 6144], w1 = w[(size_t)(k + 1) * 6144], w2 = w[(size_t)(k + 2) * 6144], w3 = w[(size_t)(k + 3) * 6144];
#pragma unroll
            for (int r = 0; r < 17; ++r) { const f32x4 sv = *(const f32x4*)(s + r * 1024 + k); acc[r] += sv[0] * w0 + sv[1] * w1 + sv[2] * w2 + sv[3] * w3; }
        }
#pragma unroll
        for (int r = 0; r < 17; ++r) red[(wid * 17 + r) * 64 + lane] = acc[r];
        __syncthreads();
        for (int i = tid; i < 17 * 64; i += NTHREADS) {
            const int r = i >> 6, c = i & 63; float v = 0.f;
#pragma unroll
            for (int w8 = 0; w8 < 8; ++w8) v += red[(w8 * 17 + r) * 64 + c];
            const int nn = (g % 96) * 64 + c;
            modv[((size_t)l * 17 + r) * 6144 + nn] = v + p.mod_b[l * 6144 + nn];
        }
        __syncthreads();
    }
    if (blockIdx.x == gridDim.x - 1) {
        float* rope = (float*)(p.ws + OFF_ROPE);
        for (int i = tid; i < 512; i += NTHREADS) {
            const int pos = i >> 3, f = i & 7;
            const float inv = exp2f(-(float)f * (13.287712379549449f / 8.0f));
            const float ang = (float)pos * inv;
            rope[i * 2] = cosf(ang); rope[i * 2 + 1] = sinf(ang);
        }
    }
}

__device__ __forceinline__ void xmod0_phase(const Params& pin) {
    const Params p = launder(pin);
    const int tid = ltid(), wid = tid >> 6, lane = tid & 63;
    bf16_t* xm = (bf16_t*)(p.ws + OFF_R6);
    for (int row = blockIdx.x * 8 + wid; row < MROWS; row += gridDim.x * 8) {
        const int b = row / TPB, pp = row % TPB;
        const float* xp = x_rd(p, true, b, pp);
        const float* mv = modv_ptr(p, 0, b, pp);
#pragma unroll
        for (int i = 0; i < 4; ++i) {
            const int c = i * 256 + lane * 4;
            const f32x4 v = *(const f32x4*)(xp + c), sh = *(const f32x4*)(mv + c), sc = *(const f32x4*)(mv + 1024 + c);
            uint2 o; o.x = pk_bf16(v[0] * (1.f + sc[0]) + sh[0], v[1] * (1.f + sc[1]) + sh[1]); o.y = pk_bf16(v[2] * (1.f + sc[2]) + sh[2], v[3] * (1.f + sc[3]) + sh[3]);
            *(uint2*)(xm + (size_t)row * 1024 + c) = o;
        }
    }
}

__device__ __forceinline__ void p1_phase(const Params& pin, unsigned char* lds) {
    const Params p = launder(pin); const int tid = ltid();
    const bf16_t* A = (const bf16_t*)(p.ws + OFF_R6);
    const bf16_t* W = (const bf16_t*)(p.ws + OFF_W) + WO_IN;
    const int lane = tid & 63, wid = tid >> 6, wr = wid >> 2, wc = wid & 3, fr = lane & 15, fq = lane >> 4;
    auto seg = [&](int t) { int mt, nt; tile_mn(t, 17, mt, nt); Seg g; g.A = A + (size_t)mt * 256 * 1024; g.Bt = W + (size_t)nt * 256 * 1024; g.lda = 1024; g.a_kstep = 64; g.ldb = 1024; g.nk = 16; return g; };
    int st = 0; bool first = true;
    for (int t = blockIdx.x; t < 144 * 17; t += gridDim.x) {
        int mt, nt; tile_mn(t, 17, mt, nt);
        const int tn = t + gridDim.x; const bool hn = tn < 144 * 17;
        f32x4 acc[8][4]; zero_acc<8>(acc);
        gemm_stream256(acc, seg(t), seg(hn ? tn : t), hn, first, st, lds, tid); first = false;
        bf16_t* dst; int ld, cb, lim;
        if (nt < 3) { dst = (bf16_t*)(p.ws + OFF_R1); ld = 672; cb = nt * 256; lim = 672; }
        else if (nt < 9) { dst = (bf16_t*)(p.ws + OFF_R2); ld = 1536; cb = (nt - 3) * 256; lim = 1536; }
        else { dst = (bf16_t*)(p.ws + OFF_R3); ld = 1920; cb = (nt - 9) * 256; lim = 1920; }
#pragma unroll
        for (int m = 0; m < 8; ++m) {
            const size_t row = (size_t)mt * 256 + wr * 128 + m * 16 + fr;
#pragma unroll
            for (int n = 0; n < 4; ++n) {
                const int col = cb + wc * 64 + n * 16 + fq * 4;
                if (col < lim) { uint2 o; o.x = pk_bf16(acc[m][n][0], acc[m][n][1]); o.y = pk_bf16(acc[m][n][2], acc[m][n][3]); *(uint2*)(dst + row * ld + col) = o; }
            }
        }
    }
}

__device__ __forceinline__ void unpack8(const uint4 u, float (&f)[8]) {
    f[0] = bf_lo(u.x); f[1] = bf_hi(u.x); f[2] = bf_lo(u.y); f[3] = bf_hi(u.y); f[4] = bf_lo(u.z); f[5] = bf_hi(u.z); f[6] = bf_lo(u.w); f[7] = bf_hi(u.w);
}
__device__ __forceinline__ void p2a_phase(const Params& pin, int l) {
    const Params p = launder(pin); l = launder_i(l);
    const int tid = ltid(), wid = tid >> 6, lane = tid & 63;
    const bf16_t* Hm = (const bf16_t*)(p.ws + OFF_R1);
    const bf16_t* Hc = (const bf16_t*)(p.ws + OFF_R2);
    bf16_t* CV = (bf16_t*)(p.ws + OFF_R5);
    bf16_t* KR = (bf16_t*)(p.ws + OFF_KR);
    float* RSQ = (float*)(p.ws + OFF_RSQ);
    float* RSKV = (float*)(p.ws + OFF_RSKV);
    const float* rope = (const float*)(p.ws + OFF_ROPE);
    const float* cw = p.conv_w + (size_t)l * 3 * 512;
    const int c0 = lane * 8;
    float w0[8], w1[8], w2[8];
#pragma unroll
    for (int i = 0; i < 8; ++i) { w0[i] = cw[c0 + i]; w1[i] = cw[512 + c0 + i]; w2[i] = cw[1024 + c0 + i]; }
    for (int row = blockIdx.x * 8 + wid; row < MROWS; row += gridDim.x * 8) {
        const int pp = row % TPB;
        const bool hp = (pp != 0 && pp != CTXL), hn = (pp != CTXL - 1 && pp != TPB - 1);
        const bf16_t* hr = Hc + (size_t)row * 1536;
        float ch[8], cc[8], cb[8], u0[8], u1[8], u2[8];
        unpack8(*(const uint4*)(hr + c0), ch); unpack8(*(const uint4*)(hr + 1024 + c0), cc); unpack8(*(const uint4*)(hr + 512 + c0), cb);
#pragma unroll
        for (int i = 0; i < 8; ++i) u1[i] = cc[i] * ch[i];
        if (hp) { unpack8(*(const uint4*)(hr - 1536 + c0), ch); unpack8(*(const uint4*)(hr - 1536 + 1024 + c0), cc);
#pragma unroll
            for (int i = 0; i < 8; ++i) u0[i] = cc[i] * ch[i]; }
        else {
#pragma unroll
            for (int i = 0; i < 8; ++i) u0[i] = 0.f; }
        if (hn) { unpack8(*(const uint4*)(hr + 1536 + c0), ch); unpack8(*(const uint4*)(hr + 1536 + 1024 + c0), cc);
#pragma unroll
            for (int i = 0; i < 8; ++i) u2[i] = cc[i] * ch[i]; }
        else {
#pragma unroll
            for (int i = 0; i < 8; ++i) u2[i] = 0.f; }
        float o[8];
#pragma unroll
        for (int i = 0; i < 8; ++i) o[i] = cb[i] * (u0[i] * w0[i] + u1[i] * w1[i] + u2[i] * w2[i]);
        uint4 ov; ov.x = pk_bf16(o[0], o[1]); ov.y = pk_bf16(o[2], o[3]); ov.z = pk_bf16(o[4], o[5]); ov.w = pk_bf16(o[6], o[7]);
        *(uint4*)(CV + (size_t)row * 512 + c0) = ov;
        const bf16_t* hm = Hm + (size_t)row * 672;
        float sq = 0.f, skv = 0.f;
        if (lane < 48) { float f[8]; unpack8(*(const uint4*)(hm + lane * 8), f);
#pragma unroll
            for (int i = 0; i < 8; ++i) sq += f[i] * f[i]; }
        if (lane < 32) { float f[8]; unpack8(*(const uint4*)(hm + 384 + lane * 8), f);
#pragma unroll
            for (int i = 0; i < 8; ++i) skv += f[i] * f[i]; }
        sq = wave_sum(sq); skv = wave_sum(skv);
        if (lane == 0) { RSQ[row] = rsqrtf(sq * (1.0f / 384.0f) + 1e-6f); RSKV[row] = rsqrtf(skv * (1.0f / 256.0f) + 1e-6f); }
        {
            const int j = lane & 31;
            float v = bf1(hm[640 + j]);
            const float other = __shfl_xor(v, 8);
            if (pp >= CTXL) {
                const int tt = pp - CTXL;
                const int pos = (j < 16) ? (tt >> 6) : (tt & 63);
                const float cs = rope[(pos * 8 + (j & 7)) * 2], sn = rope[(pos * 8 + (j & 7)) * 2 + 1];
                v = (j & 8) ? (other * sn + v * cs) : (v * cs - other * sn);
            }
            if (lane < 32) KR[(size_t)row * 32 + j] = (bf16_t)(pk_bf16(v, v) & 0xffffu);
        }
    }
}

__device__ __forceinline__ void p2b_phase(const Params& pin, int l, unsigned char* lds) {
    const Params p = launder(pin); l = launder_i(l); const int tid = ltid();
    const bf16_t* Hm = (const bf16_t*)(p.ws + OFF_R1);
    const bf16_t* W = (const bf16_t*)(p.ws + OFF_W);
    const float* RSQ = (const float*)(p.ws + OFF_RSQ);
    const float* RSKV = (const float*)(p.ws + OFF_RSKV);
    const float* rope = (const float*)(p.ws + OFF_ROPE);
    bf16_t* Q = (bf16_t*)(p.ws + OFF_Q);
    bf16_t* KN = (bf16_t*)(p.ws + OFF_KN);
    bf16_t* VT = (bf16_t*)(p.ws + OFF_VT);
    const int lane = tid & 63, wid = tid >> 6, wr = wid >> 1, wc = wid & 1, fr = lane & 15, fq = lane >> 4;
    const int NQ = 144 * 6, NKV = 144 * 8;
    for (int t = blockIdx.x; t < NQ + NKV; t += gridDim.x) {
        f32x4 acc[4][4]; zero_acc<4>(acc);
        if (t < NQ) {
            int mt, nt; tile_mn(t, 6, mt, nt);
            gemm_mainloop<4, 1>(acc, Hm + (size_t)mt * 256 * 672, 672, 64, W + WO_UQ + (size_t)nt * 128 * 384, 384, 6, lds, tid);
            const int pp0 = (mt % 9) * 256; const bool latent = pp0 >= CTXL;
#pragma unroll
            for (int m = 0; m < 4; ++m) {
                const int lrow = wr * 64 + m * 16 + fr;
                const size_t row = (size_t)mt * 256 + lrow;
                const float sc = RSQ[row] * QSCALE;
                const int tt = pp0 + lrow - CTXL;
#pragma unroll
                for (int n = 0; n < 4; ++n) {
                    const int c16 = nt * 128 + wc * 64 + n * 16, r96 = c16 % 96;
                    float v[4];
#pragma unroll
                    for (int j = 0; j < 4; ++j) v[j] = acc[m][n][j] * sc;
                    if (latent && r96 >= 64) {
                        const int pos = (r96 == 64) ? (tt >> 6) : (tt & 63);
#pragma unroll
                        for (int j = 0; j < 4; ++j) {
                            const float other = __shfl_xor(v[j], 32);
                            const int fi = (fq & 1) * 4 + j;
                            const float cs = rope[(pos * 8 + fi) * 2], sn = rope[(pos * 8 + fi) * 2 + 1];
                            v[j] = (fq & 2) ? (other * sn + v[j] * cs) : (v[j] * cs - other * sn);
                        }
                    }
                    uint2 o; o.x = pk_bf16(v[0], v[1]); o.y = pk_bf16(v[2], v[3]);
                    *(uint2*)(Q + row * 768 + c16 + fq * 4) = o;
                }
            }
        } else {
            int mt, nt; tile_mn(t - NQ, 8, mt, nt);
            gemm_mainloop<4, 2>(acc, Hm + (size_t)mt * 256 * 672 + 384, 672, 64, W + WO_UKV + (size_t)nt * 128 * 256, 256, 4, lds, tid);
            const int b = mt / 9, pp0 = (mt % 9) * 256;
            if (wc == 0) {
#pragma unroll
                for (int m = 0; m < 4; ++m) {
                    const size_t row = (size_t)mt * 256 + wr * 64 + m * 16 + fr;
                    const float sc = RSKV[row];
#pragma unroll
                    for (int n = 0; n < 4; ++n) {
                        uint2 o; o.x = pk_bf16(acc[m][n][0] * sc, acc[m][n][1] * sc); o.y = pk_bf16(acc[m][n][2] * sc, acc[m][n][3] * sc);
                        *(uint2*)(KN + row * 512 + nt * 64 + n * 16 + fq * 4) = o;
                    }
                }
            } else {
#pragma unroll
                for (int m = 0; m < 4; ++m) {
                    const int lrow = wr * 64 + m * 16 + fq * 4;
                    const f32x4 sc = *(const f32x4*)(RSKV + (size_t)mt * 256 + lrow);
#pragma unroll
                    for (int n = 0; n < 4; ++n) {
                        const int dv = n * 16 + fr;
                        uint2 o; o.x = pk_bf16(acc[m][n][0] * sc[0], acc[m][n][1] * sc[1]); o.y = pk_bf16(acc[m][n][2] * sc[2], acc[m][n][3] * sc[3]);
                        *(uint2*)(VT + ((size_t)(b * 8 + nt) * 64 + dv) * TPB + pp0 + lrow) = o;
                    }
                }
            }
        }
    }
    {
        const bf16_t* Hr = (const bf16_t*)(p.ws + OFF_R3);
        bf16_t* SG = (bf16_t*)(p.ws + OFF_SG);
        const float* mu = p.rw_mu + (size_t)l * 1920 + 1792;
        for (int i = blockIdx.x * NTHREADS + tid; i < MROWS * 16; i += gridDim.x * NTHREADS) {
            const int row = i >> 4, c0 = (i & 15) * 8, pp = row % TPB;
            const bool hp = (pp != 0 && pp != CTXL), hn = (pp != CTXL - 1 && pp != TPB - 1);
            const bf16_t* hr = Hr + (size_t)row * 1920 + 1792 + c0;
            float cur[8], pv[8], nx[8];
            unpack8(*(const uint4*)hr, cur);
            if (hp) unpack8(*(const uint4*)(hr - 1920), pv); else {
#pragma unroll
                for (int k = 0; k < 8; ++k) pv[k] = 0.f; }
            if (hn) unpack8(*(const uint4*)(hr + 1920), nx); else {
#pragma unroll
                for (int k = 0; k < 8; ++k) nx[k] = 0.f; }
            float o[8];
#pragma unroll
            for (int k = 0; k < 8; ++k) o[k] = sigmoidf_(cur[k] + (0.5f * (pv[k] + nx[k]) - cur[k]) * mu[c0 + k]);
            uint4 ov; ov.x = pk_bf16(o[0], o[1]); ov.y = pk_bf16(o[2], o[3]); ov.z = pk_bf16(o[4], o[5]); ov.w = pk_bf16(o[6], o[7]);
            *(uint4*)(SG + (size_t)row * 128 + c0) = ov;
        }
    }
}

#define FMAC_BC(acc, coef, s, J) asm("v_fmac_f32_dpp %0, %1, %2 row_newbcast:" #J " row_mask:0xf bank_mask:0xf" : "+v"(acc) : "v"(coef), "v"(s))
#define MUL_BC(dst, coef, s, J) asm("v_mul_f32_dpp %0, %1, %2 row_newbcast:" #J " row_mask:0xf bank_mask:0xf" : "=v"(dst) : "v"(coef), "v"(s))
#define REP16(X) X(0, 0) X(1, 1) X(2, 2) X(3, 3) X(4, 0) X(5, 1) X(6, 2) X(7, 3) X(8, 0) X(9, 1) X(10, 2) X(11, 3) X(12, 0) X(13, 1) X(14, 2) X(15, 3)
constexpr int FSTR = 6 * 64 + 4;
constexpr int CHUNK = 32, NCHUNK = TPB / CHUNK;

__device__ __forceinline__ int scan_pos(int z, int s) { return z == 0 ? s : (s < CTXL ? (CTXL - 1 - s) : (TPB + CTXL - 1 - s)); }

__device__ __forceinline__ void shift4(const bf16_t* hr, bool hp, bool hn, int col, const float* mu, float (&o)[4]) {
    const uint2 c = *(const uint2*)(hr + col);
    uint2 a = make_uint2(0u, 0u), b = make_uint2(0u, 0u);
    if (hp) a = *(const uint2*)(hr - 1920 + col);
    if (hn) b = *(const uint2*)(hr + 1920 + col);
    const f32x4 m = *(const f32x4*)(mu + col);
    const float cv[4] = {bf_lo(c.x), bf_hi(c.x), bf_lo(c.y), bf_hi(c.y)};
    const float av[4] = {bf_lo(a.x), bf_hi(a.x), bf_lo(a.y), bf_hi(a.y)};
    const float bv[4] = {bf_lo(b.x), bf_hi(b.x), bf_lo(b.y), bf_hi(b.y)};
#pragma unroll
    for (int i = 0; i < 4; ++i) o[i] = cv[i] + (0.5f * (av[i] + bv[i]) - cv[i]) * m[i];
}
__device__ __forceinline__ void shift8(const bf16_t* hr, bool hp, bool hn, int col, const float* mu, float (&o)[8]) {
    float cv[8], av[8], bv[8];
    unpack8(*(const uint4*)(hr + col), cv);
    if (hp) unpack8(*(const uint4*)(hr - 1920 + col), av); else {
#pragma unroll
        for (int i = 0; i < 8; ++i) av[i] = 0.f; }
    if (hn) unpack8(*(const uint4*)(hr + 1920 + col), bv); else {
#pragma unroll
        for (int i = 0; i < 8; ++i) bv[i] = 0.f; }
#pragma unroll
    for (int i = 0; i < 8; ++i) o[i] = cv[i] + (0.5f * (av[i] + bv[i]) - cv[i]) * mu[col + i];
}
__device__ __forceinline__ bf16x8 pack8(const float (&f)[8]) {
    union { uint4 u; bf16x8 v; } r;
    r.u.x = pk_bf16(f[0], f[1]); r.u.y = pk_bf16(f[2], f[3]); r.u.z = pk_bf16(f[4], f[5]); r.u.w = pk_bf16(f[6], f[7]);
    return r.v;
}

struct ProdState { f32x4 aw[4], aa[4]; };
struct Raw3x2 { uint2 c, a, b; };
__device__ __forceinline__ Raw3x2 ld3x2(const bf16_t* pc, const bf16_t* pa, const bf16_t* pb, bool hp, bool hn, int col) {
    Raw3x2 r; r.c = *(const uint2*)(pc + col); r.a = *(const uint2*)(pa + col); r.b = *(const uint2*)(pb + col);
    if (!hp) r.a = make_uint2(0u, 0u);
    if (!hn) r.b = make_uint2(0u, 0u);
    return r;
}
__device__ __forceinline__ void sh4(const Raw3x2& r, const f32x4 m, float (&o)[4]) {
    const float cv[4] = {bf_lo(r.c.x), bf_hi(r.c.x), bf_lo(r.c.y), bf_hi(r.c.y)};
    const float av[4] = {bf_lo(r.a.x), bf_hi(r.a.x), bf_lo(r.a.y), bf_hi(r.a.y)};
    const float bv[4] = {bf_lo(r.b.x), bf_hi(r.b.x), bf_lo(r.b.y), bf_hi(r.b.y)};
#pragma unroll
    for (int i = 0; i < 4; ++i) o[i] = cv[i] + (0.5f * (av[i] + bv[i]) - cv[i]) * m[i];
}
struct Raw3x4 { uint4 c, a, b; };
__device__ __forceinline__ Raw3x4 ld3x4(const bf16_t* pc, const bf16_t* pa, const bf16_t* pb, bool hp, bool hn, int col) {
    Raw3x4 r; r.c = *(const uint4*)(pc + col); r.a = *(const uint4*)(pa + col); r.b = *(const uint4*)(pb + col);
    if (!hp) r.a = make_uint4(0u, 0u, 0u, 0u);
    if (!hn) r.b = make_uint4(0u, 0u, 0u, 0u);
    return r;
}
__device__ __forceinline__ void sh8(const Raw3x4& r, const float* m, float (&o)[8]) {
    float cv[8], av[8], bv[8];
    unpack8(r.c, cv); unpack8(r.a, av); unpack8(r.b, bv);
    const f32x4 m0 = *(const f32x4*)m, m1 = *(const f32x4*)(m + 4);
#pragma unroll
    for (int i = 0; i < 8; ++i) o[i] = cv[i] + (0.5f * (av[i] + bv[i]) - cv[i]) * (i < 4 ? m0[i] : m1[i - 4]);
}
template <int N0>
__device__ __forceinline__ void scan_produce_elem(const float* pl, int fq, const Raw3x2 (&rr)[2], const Raw3x2 (&rk)[2], const Raw3x2 (&rv)[2],
                                                  const f32x4 (&aw)[2], const f32x4 (&aa)[2], float& ss, float* frow) {
#pragma unroll
    for (int nn = 0; nn < 2; ++nn) {
        const int n = N0 + nn;
        const int c4 = n * 16 + fq * 4;
        float r4[4], k4[4], v4[4];
        sh4(rr[nn], *(const f32x4*)(pl + 0 * 64 + c4), r4);
        sh4(rk[nn], *(const f32x4*)(pl + 1 * 64 + c4), k4);
        sh4(rv[nn], *(const f32x4*)(pl + 2 * 64 + c4), v4);
        const f32x4 w0 = *(const f32x4*)(pl + 3 * 64 + c4);
        const f32x4 a0 = *(const f32x4*)(pl + 4 * 64 + c4);
        const f32x4 kkp = *(const f32x4*)(pl + 5 * 64 + c4);
        const f32x4 kap = *(const f32x4*)(pl + 6 * 64 + c4);
        f32x4 dw, kd, kf4, a4;
#pragma unroll
        for (int j = 0; j < 4; ++j) {
            const float x = -(aw[nn][j] + w0[j]);
            const float sp = fmaxf(x, 0.f) + __logf(1.0f + __expf(-fabsf(x)));
            const float wl = -sp - 0.5f;
            dw[j] = __expf(-__expf(wl));
            const float a = __builtin_amdgcn_rcpf(1.0f + __expf(-(aa[nn][j] + a0[j])));
            a4[j] = a;
            const float kf = k4[j] * kkp[j];
            kf4[j] = kf; ss += kf * kf;
            kd[j] = k4[j] * (1.0f + (a - 1.0f) * kap[j]);
        }
        *(f32x4*)(frow + 0 * 64 + c4) = kf4;
        *(f32x4*)(frow + 1 * 64 + c4) = dw;
        *(f32x4*)(frow + 2 * 64 + c4) = a4;
        *(f32x4*)(frow + 3 * 64 + c4) = kd;
        *(f32x4*)(frow + 4 * 64 + c4) = (f32x4){r4[0], r4[1], r4[2], r4[3]};
        *(f32x4*)(frow + 5 * 64 + c4) = (f32x4){v4[0], v4[1], v4[2], v4[3]};
    }
}
__device__ __forceinline__ void scan_produce_A(const Params& p, const float* pl, int b, int h, int z, int s0, float* frow0, int lane, ProdState& st) {
    const int fr = lane & 15, fq = lane >> 4;
    const int pp = scan_pos(z, s0 + fr);
    const bool hp = (pp != 0 && pp != CTXL), hn = (pp != CTXL - 1 && pp != TPB - 1);
    const bf16_t* hr = (const bf16_t*)(p.ws + OFF_R3) + ((size_t)b * TPB + pp) * 1920;
    const bf16_t* W = (const bf16_t*)(p.ws + OFF_W);
    Raw3x4 qw[2], qa[2];
    const bf16_t* pc = hr + z * 64 + fq * 8; const bf16_t* pa = hp ? pc - 1920 : pc; const bf16_t* pb = hn ? pc + 1920 : pc;
#pragma unroll
    for (int ks = 0; ks < 2; ++ks) { qw[ks] = ld3x4(pc, pa, pb, hp, hn, 1536 + ks * 32); qa[ks] = ld3x4(pc, pa, pb, hp, hn, 1664 + ks * 32); }
    f32x4 accw[4], acca[4];
#pragma unroll
    for (int n = 0; n < 4; ++n) { accw[n] = (f32x4){0.f, 0.f, 0.f, 0.f}; acca[n] = (f32x4){0.f, 0.f, 0.f, 0.f}; }
#pragma unroll
    for (int ks = 0; ks < 2; ++ks) {
        bf16x8 bw[4], ba[4];
#pragma unroll
        for (int n = 0; n < 4; ++n) {
            const size_t wo = ((size_t)z * 512 + h * 64 + n * 16 + fr) * 64 + ks * 32 + fq * 8;
            bw[n] = *(const bf16x8*)(W + WO_UP + wo); ba[n] = *(const bf16x8*)(W + WO_AUP + wo);
        }
        float t8[8];
        sh8(qw[ks], pl + 7 * 64 + ks * 32 + fq * 8, t8);
#pragma unroll
        for (int i = 0; i < 8; ++i) { const float e = __expf(2.0f * t8[i]); t8[i] = 1.0f - 2.0f * __builtin_amdgcn_rcpf(e + 1.0f); }
        const bf16x8 aw = pack8(t8);
        sh8(qa[ks], pl + 8 * 64 + ks * 32 + fq * 8, t8);
        const bf16x8 aa = pack8(t8);
#pragma unroll
        for (int n = 0; n < 4; ++n) {
            accw[n] = __builtin_amdgcn_mfma_f32_16x16x32_bf16(bw[n], aw, accw[n], 0, 0, 0);
            acca[n] = __builtin_amdgcn_mfma_f32_16x16x32_bf16(ba[n], aa, acca[n], 0, 0, 0);
        }
    }
#pragma unroll
    for (int n = 0; n < 4; ++n) { st.aw[n] = accw[n]; st.aa[n] = acca[n]; }
}
__device__ __forceinline__ void scan_produce_B(const Params& p, const float* pl, int b, int h, int z, int s0, float* frow0, int lane, const ProdState& st) {
    const int fr = lane & 15, fq = lane >> 4;
    const int pp = scan_pos(z, s0 + fr);
    const bool hp = (pp != 0 && pp != CTXL), hn = (pp != CTXL - 1 && pp != TPB - 1);
    const bf16_t* hr = (const bf16_t*)(p.ws + OFF_R3) + ((size_t)b * TPB + pp) * 1920;
    Raw3x2 rr0[2], rk0[2], rv0[2], rr1[2], rk1[2], rv1[2];
    const bf16_t* pc = hr + h * 64 + fq * 4; const bf16_t* pa = hp ? pc - 1920 : pc; const bf16_t* pb = hn ? pc + 1920 : pc;
#pragma unroll
    for (int nn = 0; nn < 2; ++nn) {
        const int C4 = nn * 16, C5 = C4 + 32;
        rr0[nn] = ld3x2(pc, pa, pb, hp, hn, C4); rk0[nn] = ld3x2(pc, pa, pb, hp, hn, 512 + C4); rv0[nn] = ld3x2(pc, pa, pb, hp, hn, 1024 + C4);
        rr1[nn] = ld3x2(pc, pa, pb, hp, hn, C5); rk1[nn] = ld3x2(pc, pa, pb, hp, hn, 512 + C5); rv1[nn] = ld3x2(pc, pa, pb, hp, hn, 1024 + C5);
    }
    float ss = 0.f;
    float* frow = frow0 + fr * FSTR;
    const f32x4 w01[2] = {st.aw[0], st.aw[1]}, a01[2] = {st.aa[0], st.aa[1]}, w23[2] = {st.aw[2], st.aw[3]}, a23[2] = {st.aa[2], st.aa[3]};
    scan_produce_elem<0>(pl, fq, rr0, rk0, rv0, w01, a01, ss, frow);
    scan_produce_elem<2>(pl, fq, rr1, rk1, rv1, w23, a23, ss, frow);
    ss = fqsum(ss);
    const float inv = rsqrtf(fmaxf(ss, 1e-24f));
#pragma unroll
    for (int n = 0; n < 4; ++n) {
        const int c4 = n * 16 + fq * 4;
        f32x4 kk = *(const f32x4*)(frow + 0 * 64 + c4);
        f32x4 bb = *(const f32x4*)(frow + 2 * 64 + c4);
#pragma unroll
        for (int j = 0; j < 4; ++j) { kk[j] = kk[j] * inv; bb[j] = kk[j] * bb[j]; }
        *(f32x4*)(frow + 0 * 64 + c4) = kk;
        *(f32x4*)(frow + 2 * 64 + c4) = bb;
    }
}

typedef float f32x2 __attribute__((ext_vector_type(2)));
struct ScanHead { f32x4 kk[2]; f32x2 v; };
struct ScanBody { f32x4 w[2], bb[2], kd[2], r[2]; };
__device__ __forceinline__ void scan_ldh(ScanHead& c, const float* f, const float* fv) {
#pragma unroll
    for (int q = 0; q < 2; ++q) c.kk[q] = *(const f32x4*)(f + 0 * 64 + 4 * q);
    c.v = *(const f32x2*)fv;
}
__device__ __forceinline__ void scan_ldb(ScanBody& c, const float* f) {
#pragma unroll
    for (int q = 0; q < 2; ++q) {
        c.w[q] = *(const f32x4*)(f + 1 * 64 + 4 * q); c.bb[q] = *(const f32x4*)(f + 2 * 64 + 4 * q);
        c.kd[q] = *(const f32x4*)(f + 3 * 64 + 4 * q); c.r[q] = *(const f32x4*)(f + 4 * 64 + 4 * q);
    }
}
__device__ __forceinline__ void scan_unit(const Params& p, int l, int u, unsigned char* lds) {
    const int tid = ltid(), wid = __builtin_amdgcn_readfirstlane(tid >> 6), lane = tid & 63;
    const int b = u >> 4, h = (u >> 1) & 7, z = u & 1;
    float* fb = (float*)lds;
    bf16_t* Y = (bf16_t*)(p.ws + (z == 0 ? OFF_YF : OFF_YB));
    float* pl = fb + 3 * CHUNK * FSTR;
    for (int i = tid; i < 9 * 64; i += NTHREADS) {
        const int a = i >> 6, c = i & 63, C = h * 64 + c;
        float v;
        if (a < 3) v = p.rw_mu[(size_t)l * 1920 + a * 512 + C];
        else if (a == 3) v = p.rw_w0[((size_t)l * 2 + z) * 512 + C];
        else if (a == 4) v = p.rw_a0[((size_t)l * 2 + z) * 512 + C];
        else if (a == 5) v = p.rw_k_k[(size_t)l * 512 + C];
        else if (a == 6) v = p.rw_k_a[(size_t)l * 512 + C];
        else if (a == 7) v = p.rw_mu[(size_t)l * 1920 + 1536 + z * 64 + c];
        else v = p.rw_mu[(size_t)l * 1920 + 1664 + z * 64 + c];
        pl[i] = v;
    }
    __syncthreads();
    if (wid < 4) {
        f32x2 S2[8];
#pragma unroll
        for (int j = 0; j < 8; ++j) S2[j] = (f32x2){0.f, 0.f};
        __syncthreads();
        for (int c = 0; c < NCHUNK; ++c) {
            const float* fbc = fb + (c % 3) * CHUNK * FSTR + 8 * (lane & 7);
            const float* fbv = fb + (c % 3) * CHUNK * FSTR + 320 + 16 * wid + 2 * (lane >> 3);
            bf16_t* yp = Y + ((size_t)b * TPB) * 512 + h * 64 + 16 * wid + 2 * (lane >> 3);
            ScanHead ha, hb;
            scan_ldh(ha, fbc, fbv);
#define SCAN_STEP(HC, HN, SL) { \
                ScanBody bd; scan_ldb(bd, fbc + (SL) * FSTR); \
                if ((SL) + 1 < CHUNK) scan_ldh(HN, fbc + ((SL) + 1) * FSTR, fbv + ((SL) + 1) * FSTR); \
                f32x2 d0 = (f32x2){0.f, 0.f}, d1 = (f32x2){0.f, 0.f}; \
                _Pragma("unroll") for (int q = 0; q < 4; ++q) { const f32x2 k2 = (f32x2){HC.kk[q >> 1][2 * (q & 1)], HC.kk[q >> 1][2 * (q & 1) + 1]}; \
                    d0 = __builtin_elementwise_fma(S2[q], k2, d0); d1 = __builtin_elementwise_fma(S2[4 + q], k2, d1); } \
                const float sk0 = red8(d0[0] + d0[1]), sk1 = red8(d1[0] + d1[1]); \
                const f32x2 n0 = (f32x2){-sk0, -sk0}, n1 = (f32x2){-sk1, -sk1}, v0 = (f32x2){HC.v[0], HC.v[0]}, v1 = (f32x2){HC.v[1], HC.v[1]}; \
                f32x2 y0 = (f32x2){0.f, 0.f}, y1 = (f32x2){0.f, 0.f}; \
                _Pragma("unroll") for (int q = 0; q < 4; ++q) { \
                    const f32x2 w2 = (f32x2){bd.w[q >> 1][2 * (q & 1)], bd.w[q >> 1][2 * (q & 1) + 1]}, b2 = (f32x2){bd.bb[q >> 1][2 * (q & 1)], bd.bb[q >> 1][2 * (q & 1) + 1]}; \
                    const f32x2 kd2 = (f32x2){bd.kd[q >> 1][2 * (q & 1)], bd.kd[q >> 1][2 * (q & 1) + 1]}, r2 = (f32x2){bd.r[q >> 1][2 * (q & 1)], bd.r[q >> 1][2 * (q & 1) + 1]}; \
                    f32x2 t0 = S2[q] * w2; t0 = __builtin_elementwise_fma(b2, n0, t0); t0 = __builtin_elementwise_fma(kd2, v0, t0); \
                    f32x2 t1 = S2[4 + q] * w2; t1 = __builtin_elementwise_fma(b2, n1, t1); t1 = __builtin_elementwise_fma(kd2, v1, t1); \
                    S2[q] = t0; S2[4 + q] = t1; \
                    y0 = __builtin_elementwise_fma(t0, r2, y0); y1 = __builtin_elementwise_fma(t1, r2, y1); } \
                const float ya = red8(y0[0] + y0[1]), yb = red8(y1[0] + y1[1]); \
                const int pp = scan_pos(z, c * CHUNK + (SL)); \
                if ((lane & 7) == 0) *(unsigned*)(yp + (size_t)pp * 512) = pk_bf16(ya, yb); }
#pragma unroll 1
            for (int sl = 0; sl < CHUNK; sl += 2) {
                SCAN_STEP(ha, hb, sl)
                SCAN_STEP(hb, ha, sl + 1)
            }
            __syncthreads();
        }
    } else {
        ProdState st;
#pragma unroll
        for (int n = 0; n < 4; ++n) { st.aw[n] = (f32x4){0.f, 0.f, 0.f, 0.f}; st.aa[n] = (f32x4){0.f, 0.f, 0.f, 0.f}; }
        const int nrep = launder_i(1 + ((PROBE_MASK >> 10) & 1));
        const int pair = (wid - 4) >> 1, ph = (wid - 4) & 1;
        {
            float* f0 = fb + (pair % 3) * CHUNK * FSTR + ph * 16 * FSTR;
            scan_produce_A(p, pl, b, h, z, pair * CHUNK + ph * 16, f0, lane, st);
            if (pair == 0) scan_produce_B(p, pl, b, h, z, ph * 16, f0, lane, st);
        }
        __syncthreads();
        for (int c = 0; c < NCHUNK; ++c) {
            for (int rr_ = 0; rr_ < nrep; ++rr_) {
            if (pair == ((c + 1) & 1)) {
                if (c + 1 < NCHUNK) scan_produce_B(p, pl, b, h, z, (c + 1) * CHUNK + ph * 16, fb + ((c + 1) % 3) * CHUNK * FSTR + ph * 16 * FSTR, lane, st);
            } else {
                if (c + 2 < NCHUNK) scan_produce_A(p, pl, b, h, z, (c + 2) * CHUNK + ph * 16, fb + ((c + 2) % 3) * CHUNK * FSTR + ph * 16 * FSTR, lane, st);
            }
            }
            __syncthreads();
        }
    }
}

constexpr int ATT_STAGE = 20480;
__device__ __forceinline__ void attn_unit(const Params& p, int b, int h, int q0, int nkeys, unsigned char* lds, int do_write) {
    const int tid = ltid(), wid = __builtin_amdgcn_readfirstlane(tid >> 6), lane = tid & 63, fr = lane & 15, fq = lane >> 4;
    bf16_t* Q = (bf16_t*)(p.ws + OFF_Q);
    const bf16_t* KN = (const bf16_t*)(p.ws + OFF_KN);
    const bf16_t* KR = (const bf16_t*)(p.ws + OFF_KR);
    const bf16_t* VT = (const bf16_t*)(p.ws + OFF_VT);
    const size_t rb = (size_t)b * TPB;
    bf16x8 qf[2][3];
#pragma unroll
    for (int nq = 0; nq < 2; ++nq)
#pragma unroll
        for (int ks = 0; ks < 3; ++ks) qf[nq][ks] = *(const bf16x8*)(Q + (rb + q0 + wid * 32 + nq * 16 + fr) * 768 + h * 96 + ks * 32 + fq * 8);
    f32x4 oacc[4][2];
#pragma unroll
    for (int mt = 0; mt < 4; ++mt)
#pragma unroll
        for (int nq = 0; nq < 2; ++nq) oacc[mt][nq] = (f32x4){0.f, 0.f, 0.f, 0.f};
    float mrun[2] = {-1e30f, -1e30f}, lsum[2] = {0.f, 0.f};
    const int c8 = (lane & 7) ^ ((4 * wid + (lane >> 4)) & 7);
    const bf16_t* knp = KN + (rb + 8 * wid + (lane >> 3)) * 512 + h * 64 + c8 * 8;
    const bf16_t* vtp = VT + ((size_t)(b * 8 + h) * 64 + 8 * wid + (lane >> 3)) * TPB + c8 * 8;
    const int c4 = (lane & 3) ^ ((lane >> 4) & 3);
    const bf16_t* krp = KR + (rb + 16 * (wid & 3) + (lane >> 2)) * 32 + c4 * 8;
    auto issue = [&](int t, int stg) {
        unsigned char* base = lds + stg * ATT_STAGE;
        const int k0 = t * 64;
        __builtin_amdgcn_global_load_lds((const GLB_AS unsigned*)(knp + (size_t)k0 * 512), (LDS_AS unsigned*)(base + wid * 1024), 16, 0, 0);
        __builtin_amdgcn_global_load_lds((const GLB_AS unsigned*)(vtp + k0), (LDS_AS unsigned*)(base + 12288 + wid * 1024), 16, 0, 0);
        if (wid < 4) __builtin_amdgcn_global_load_lds((const GLB_AS unsigned*)(krp + (size_t)k0 * 32), (LDS_AS unsigned*)(base + 8192 + wid * 1024), 16, 0, 0);
    };
    const int ntile = nkeys / 64;
    const int kz = fr >> 1, rz = (fr >> 2) & 3;
    issue(0, 0);
    asm volatile("s_waitcnt vmcnt(0)" ::: "memory");
    __builtin_amdgcn_s_barrier();
    asm volatile("" ::: "memory");
    for (int t = 0; t < ntile; ++t) {
        if (t + 1 < ntile) issue(t + 1, (t + 1) & 1);
        const unsigned char* Ks = lds + (t & 1) * ATT_STAGE;
        const unsigned char* Rs = Ks + 8192;
        const unsigned char* Vs = Ks + 12288;
        f32x4 sacc[4][2];
#pragma unroll
        for (int km = 0; km < 4; ++km)
#pragma unroll
            for (int nq = 0; nq < 2; ++nq) sacc[km][nq] = (f32x4){0.f, 0.f, 0.f, 0.f};
#pragma unroll
        for (int ks = 0; ks < 3; ++ks)
#pragma unroll
            for (int km = 0; km < 4; ++km) {
                const bf16x8 kf = ks < 2 ? *(const bf16x8*)(Ks + (km * 16 + fr) * 128 + (((ks * 4 + fq) ^ kz) * 16))
                                         : *(const bf16x8*)(Rs + (km * 16 + fr) * 64 + ((fq ^ rz) * 16));
#pragma unroll
                for (int nq = 0; nq < 2; ++nq) sacc[km][nq] = __builtin_amdgcn_mfma_f32_16x16x32_bf16(kf, qf[nq][ks], sacc[km][nq], 0, 0, 0);
            }
        bf16x8 pf[2][2];
#pragma unroll
        for (int nq = 0; nq < 2; ++nq) {
            float mx = -1e30f;
#pragma unroll
            for (int km = 0; km < 4; ++km)
#pragma unroll
                for (int j = 0; j < 4; ++j) mx = fmaxf(mx, sacc[km][nq][j]);
            mx = fqmax(mx);
            const float mnew = fmaxf(mrun[nq], mx);
            const float alpha = __builtin_amdgcn_exp2f(mrun[nq] - mnew);
            mrun[nq] = mnew;
            float ps = 0.f;
#pragma unroll
            for (int km = 0; km < 4; ++km)
#pragma unroll
                for (int j = 0; j < 4; ++j) { const float e = __builtin_amdgcn_exp2f(sacc[km][nq][j] - mnew); sacc[km][nq][j] = e; ps += e; }
            lsum[nq] = lsum[nq] * alpha + ps;
#pragma unroll
            for (int mt = 0; mt < 4; ++mt) oacc[mt][nq] = oacc[mt][nq] * alpha;
#pragma unroll
            for (int kc = 0; kc < 2; ++kc) {
                union { uint4 u; bf16x8 v; } r;
                r.u.x = pk_bf16(sacc[2 * kc][nq][0], sacc[2 * kc][nq][1]); r.u.y = pk_bf16(sacc[2 * kc][nq][2], sacc[2 * kc][nq][3]);
                r.u.z = pk_bf16(sacc[2 * kc + 1][nq][0], sacc[2 * kc + 1][nq][1]); r.u.w = pk_bf16(sacc[2 * kc + 1][nq][2], sacc[2 * kc + 1][nq][3]);
                pf[kc][nq] = r.v;
            }
        }
#pragma unroll
        for (int mt = 0; mt < 4; ++mt)
#pragma unroll
            for (int kc = 0; kc < 2; ++kc) {
                union { uint2 h2[2]; bf16x8 v; } r;
                const unsigned char* vrow = Vs + (mt * 16 + fr) * 128 + (fq & 1) * 8;
                r.h2[0] = *(const uint2*)(vrow + (((4 * kc + (fq >> 1)) ^ kz) * 16));
                r.h2[1] = *(const uint2*)(vrow + (((4 * kc + 2 + (fq >> 1)) ^ kz) * 16));
#pragma unroll
                for (int nq = 0; nq < 2; ++nq) oacc[mt][nq] = __builtin_amdgcn_mfma_f32_16x16x32_bf16(r.v, pf[kc][nq], oacc[mt][nq], 0, 0, 0);
            }
        asm volatile("s_waitcnt vmcnt(0) lgkmcnt(0)" ::: "memory");
        __builtin_amdgcn_s_barrier();
        asm volatile("" ::: "memory");
    }
#pragma unroll
    for (int nq = 0; nq < 2; ++nq) {
        const float inv = 1.0f / fqsum(lsum[nq]);
        bf16_t* orow = Q + (rb + q0 + wid * 32 + nq * 16 + fr) * 768 + h * 96;
#pragma unroll
        for (int mt = 0; mt < 4; ++mt) {
            uint2 o; o.x = pk_bf16(oacc[mt][nq][0] * inv, oacc[mt][nq][1] * inv); o.y = pk_bf16(oacc[mt][nq][2] * inv, oacc[mt][nq][3] * inv);
            if (do_write) *(uint2*)(orow + mt * 16 + fq * 4) = o;
        }
    }
}

__device__ __forceinline__ void p3_phase(const Params& pin, int l, unsigned char* lds) {
    const Params p = launder(pin); l = launder_i(l);
    for (int r = 0, nr = launder_i(1 + ((PROBE_MASK >> 1) & 1)); r < nr; ++r)
        for (int u = blockIdx.x; u < 256; u += gridDim.x) scan_unit(p, l, u, lds);
    const int nunits = (l == DEPTH - 1) ? 1024 : 1152;
    for (int r = launder_i(((PROBE_MASK >> 9) & 1) ? 0 : 1); r < 2; ++r)
    for (int u = blockIdx.x; u < nunits; u += gridDim.x) {
        if (u < 1024) { const int bh = u >> 3, qt = u & 7; attn_unit(p, bh >> 3, bh & 7, CTXL + qt * 256, TPB, lds, r); }
        else { const int bh = u - 1024; attn_unit(p, bh >> 3, bh & 7, 0, CTXL, lds, r); }
    }
}

__device__ __forceinline__ void p35_phase(const Params& pin, int l, bool skip_ctx, unsigned char* lds) {
    const Params p = launder(pin); l = launder_i(l); const int tid = ltid();
    const bf16_t* SG = (const bf16_t*)(p.ws + OFF_SG);
    const bf16_t* W = (const bf16_t*)(p.ws + OFF_W) + WO_GUP;
    const bf16_t* YF = (const bf16_t*)(p.ws + OFF_YF);
    const bf16_t* YB = (const bf16_t*)(p.ws + OFF_YB);
    const bf16_t* Hr = (const bf16_t*)(p.ws + OFF_R3);
    bf16_t* RWO = (bf16_t*)(p.ws + OFF_RWO);
    const float* mu = p.rw_mu + (size_t)l * 1920;
    const int lane = tid & 63, wid = tid >> 6, wr = wid >> 1, wc = wid & 1, fr = lane & 15, fq = lane >> 4;
    float* gt = (float*)lds;
    constexpr int GP = 132;
    for (int t = blockIdx.x; t < 288 * 4; t += gridDim.x) {
        int mt, nt; tile_mn(t, 4, mt, nt);
        if (skip_ctx && (mt % 18) < 2) continue;
        f32x4 acc[2][4]; zero_acc<2>(acc);
        gemm_mainloop<2, 1>(acc, SG + (size_t)mt * 128 * 128, 128, 64, W + (size_t)nt * 128 * 128, 128, 2, lds, tid);
#pragma unroll
        for (int m = 0; m < 2; ++m)
#pragma unroll
            for (int n = 0; n < 4; ++n) *(f32x4*)(gt + (wr * 32 + m * 16 + fr) * GP + wc * 64 + n * 16 + fq * 4) = acc[m][n];
        __syncthreads();
        const int pp0 = (mt % 18) * 128;
#pragma unroll 1
        for (int it = 0; it < 4; ++it) {
            const int item = tid + it * NTHREADS, lrow = item >> 4, cg = item & 15, pp = pp0 + lrow;
            const size_t row = (size_t)mt * 128 + lrow;
            const int C = nt * 128 + cg * 8;
            const bool hp = (pp != 0 && pp != CTXL), hn = (pp != CTXL - 1 && pp != TPB - 1);
            const bf16_t* hr = Hr + row * 1920;
            float yf[8], yb[8], r8[8], k8[8], v8[8];
            unpack8(*(const uint4*)(YF + row * 512 + C), yf); unpack8(*(const uint4*)(YB + row * 512 + C), yb);
            shift8(hr, hp, hn, C, mu, r8); shift8(hr, hp, hn, 512 + C, mu, k8); shift8(hr, hp, hn, 1024 + C, mu, v8);
            const float* rkp = p.rw_r_k + (size_t)l * 512 + C;
            float s1 = 0.f, bs = 0.f;
#pragma unroll
            for (int i = 0; i < 8; ++i) { yf[i] += yb[i]; s1 += yf[i]; bs += r8[i] * k8[i] * rkp[i]; }
            s1 = red8(s1); bs = red8(bs);
            const float mean = s1 * (1.0f / 64.0f);
            float s2 = 0.f;
#pragma unroll
            for (int i = 0; i < 8; ++i) { const float d = yf[i] - mean; s2 += d * d; }
            s2 = red8(s2);
            const float rstd = rsqrtf(s2 * (1.0f / 64.0f) + 64e-5f);
            const float* ggp = p.rw_gn_g + (size_t)l * 512 + C; const float* gbp = p.rw_gn_b + (size_t)l * 512 + C;
            const f32x4 g0 = *(const f32x4*)(gt + lrow * GP + cg * 8), g1 = *(const f32x4*)(gt + lrow * GP + cg * 8 + 4);
            float o[8];
#pragma unroll
            for (int i = 0; i < 8; ++i) o[i] = ((yf[i] - mean) * rstd * ggp[i] + gbp[i] + bs * v8[i]) * (i < 4 ? g0[i] : g1[i - 4]);
            uint4 ov; ov.x = pk_bf16(o[0], o[1]); ov.y = pk_bf16(o[2], o[3]); ov.z = pk_bf16(o[4], o[5]); ov.w = pk_bf16(o[6], o[7]);
            *(uint4*)(RWO + row * 512 + C) = ov;
        }
        __syncthreads();
    }
}

__device__ __forceinline__ void p4_phase(const Params& pin, bool skip_ctx, unsigned char* lds) {
    const Params p = launder(pin); const int tid = ltid();
    const bf16_t* XM = (const bf16_t*)(p.ws + OFF_R6);
    const bf16_t* W = (const bf16_t*)(p.ws + OFF_W);
    bf16_t* MG = (bf16_t*)(p.ws + OFF_MRG);
    const int lane = tid & 63, wid = tid >> 6, wr = wid >> 1, wc = wid & 1, fr = lane & 15, fq = lane >> 4;
    for (int t = blockIdx.x; t < 288 * 8; t += gridDim.x) {
        int mt, nt; tile_mn(t, 8, mt, nt);
        if (skip_ctx && (mt % 18) < 2) continue;
        f32x4 g[3][2][4];
#pragma unroll
        for (int i = 0; i < 3; ++i) zero_acc<2>(g[i]);
        gemm_gate3(g, XM + (size_t)mt * 128 * 1024, W + WO_IN + (size_t)(4224 + nt * 128) * 1024, 16, lds, tid);
        typedef __fp16 h16x2 __attribute__((ext_vector_type(2)));
        h16x2 gp[3][2][4][2];
#pragma unroll
        for (int i = 0; i < 3; ++i)
#pragma unroll
            for (int m = 0; m < 2; ++m)
#pragma unroll
                for (int n = 0; n < 4; ++n) {
                    gp[i][m][n][0] = __builtin_amdgcn_cvt_pkrtz(sigmoidf_(g[i][m][n][0]), sigmoidf_(g[i][m][n][1]));
                    gp[i][m][n][1] = __builtin_amdgcn_cvt_pkrtz(sigmoidf_(g[i][m][n][2]), sigmoidf_(g[i][m][n][3]));
                }
        f32x4 mg[2][4]; zero_acc<2>(mg);
#pragma unroll 1
        for (int i = 0; i < 3; ++i) {
            const bf16_t* Ab; int lda, kst; const bf16_t* Wb;
            if (i == 0) { Ab = (const bf16_t*)(p.ws + OFF_Q); lda = 768; kst = 96; Wb = W + WO_OA; }
            else if (i == 1) { Ab = (const bf16_t*)(p.ws + OFF_R5); lda = 512; kst = 64; Wb = W + WO_OC; }
            else { Ab = (const bf16_t*)(p.ws + OFF_RWO); lda = 512; kst = 64; Wb = W + WO_OR; }
            f32x4 a[2][4]; zero_acc<2>(a);
            gemm_mainloop<2, 1>(a, Ab + (size_t)mt * 128 * lda, lda, kst, Wb + (size_t)nt * 128 * 512, 512, 8, lds, tid);
#pragma unroll
            for (int m = 0; m < 2; ++m)
#pragma unroll
                for (int n = 0; n < 4; ++n) {
                    const h16x2 g0 = i == 0 ? gp[0][m][n][0] : (i == 1 ? gp[1][m][n][0] : gp[2][m][n][0]);
                    const h16x2 g1 = i == 0 ? gp[0][m][n][1] : (i == 1 ? gp[1][m][n][1] : gp[2][m][n][1]);
                    mg[m][n][0] += (float)g0[0] * a[m][n][0]; mg[m][n][1] += (float)g0[1] * a[m][n][1];
                    mg[m][n][2] += (float)g1[0] * a[m][n][2]; mg[m][n][3] += (float)g1[1] * a[m][n][3];
                }
        }
#pragma unroll
        for (int m = 0; m < 2; ++m) {
            const size_t row = (size_t)mt * 128 + wr * 32 + m * 16 + fr;
#pragma unroll
            for (int n = 0; n < 4; ++n) {
                uint2 o; o.x = pk_bf16(mg[m][n][0], mg[m][n][1]); o.y = pk_bf16(mg[m][n][2], mg[m][n][3]);
                *(uint2*)(MG + row * 1024 + nt * 128 + wc * 64 + n * 16 + fq * 4) = o;
            }
        }
    }
}

template <int MT>
__device__ __forceinline__ void resid_tile(const Params& p, int l, const bf16_t* A, int lda, int nk, const bf16_t* Wt, int ldb, int goff, bool x_from_input,
                                           const float* lng, const float* lnb, int row0, int nt, unsigned char* lds, int tid) {
    const int lane = tid & 63, wid = tid >> 6, wr = wid >> 1, wc = wid & 1, fr = lane & 15, fq = lane >> 4;
    f32x4 acc[MT][4]; zero_acc<MT>(acc);
    gemm_mainloop<MT, 1>(acc, A + (size_t)row0 * lda, lda, 64, Wt + (size_t)nt * 128 * ldb, ldb, nk, lds, tid);
    const int b = row0 / TPB, pp0 = row0 % TPB;
    const float* gv = modv_ptr(p, l, b, pp0) + goff;
    const float* stats = (const float*)(p.ws + OFF_STATS);
#pragma unroll
    for (int m = 0; m < MT; ++m) {
        const int lr = wr * 16 * MT + m * 16 + fr, pp = pp0 + lr;
        const float* xi = x_rd(p, x_from_input, b, pp);
        float* xo = x_wr(p, b, pp);
        float mean = 0.f, rstd = 1.f;
        if (!x_from_input) { const size_t row = (size_t)row0 + lr; mean = stats[row * 2]; rstd = stats[row * 2 + 1]; }
#pragma unroll
        for (int n = 0; n < 4; ++n) {
            const int col = nt * 128 + wc * 64 + n * 16 + fq * 4;
            f32x4 xv = *(const f32x4*)(xi + col); const f32x4 g4 = *(const f32x4*)(gv + col);
            if (!x_from_input) {
                const f32x4 lg = *(const f32x4*)(lng + col), lb = *(const f32x4*)(lnb + col);
#pragma unroll
                for (int j = 0; j < 4; ++j) xv[j] = (xv[j] - mean) * rstd * lg[j] + lb[j];
            }
            f32x4 o;
#pragma unroll
            for (int j = 0; j < 4; ++j) o[j] = ALPHA * xv[j] + g4[j] * acc[m][n][j];
            *(f32x4*)(xo + col) = o;
        }
    }
}
__device__ __forceinline__ void resid_gemm_phase(const Params& pin, int l, size_t a_off, int lda, int nk, size_t w_off, int ldb, int goff, bool x_from_input, const float* lng, const float* lnb, bool skip_ctx, unsigned char* lds) {
    const Params p = launder(pin); l = launder_i(l);
    const int tid = ltid();
    const bf16_t* A = (const bf16_t*)(p.ws + a_off);
    const bf16_t* Wt = (const bf16_t*)(p.ws + OFF_W) + w_off;
    const int nfull = (gridDim.x == 256) ? 1024 : 144 * 8;
    for (int t = blockIdx.x; t < nfull; t += gridDim.x) {
        int mt, nt; tile_mn(t, 8, mt, nt);
        if (skip_ctx && (mt % 9) == 0) continue;
        resid_tile<4>(p, l, A, lda, nk, Wt, ldb, goff, x_from_input, lng, lnb, mt * 256, nt, lds, tid);
    }
    if (nfull == 1024) {
        int mt, nt; tile_mn(1024 + (blockIdx.x >> 1), 8, mt, nt);
        if (!(skip_ctx && (mt % 9) == 0)) resid_tile<2>(p, l, A, lda, nk, Wt, ldb, goff, x_from_input, lng, lnb, mt * 256 + (blockIdx.x & 1) * 128, nt, lds, tid);
    }
}

__device__ __forceinline__ void ln_phase(const Params& pin, const float* g, const float* bta, int lmod, int shoff, bool write_xmod, bool write_x, bool skip_ctx) {
    const Params p = launder(pin); lmod = launder_i(lmod);
    const int tid = ltid(), wid = tid >> 6, lane = tid & 63;
    bf16_t* xm = (bf16_t*)(p.ws + OFF_R6);
    float* stats = (float*)(p.ws + OFF_STATS);
    for (int row = blockIdx.x * 8 + wid; row < MROWS; row += gridDim.x * 8) {
        const int b = row / TPB, pp = row % TPB;
        if (skip_ctx && pp < CTXL) continue;
        float* xp = x_wr(p, b, pp);
        f32x4 v[4];
        float s = 0.f;
#pragma unroll
        for (int i = 0; i < 4; ++i) { v[i] = *(const f32x4*)(xp + i * 256 + lane * 4); s += (v[i][0] + v[i][1]) + (v[i][2] + v[i][3]); }
        const float mean = wave_sum(s) * (1.0f / 1024.0f);
        float q = 0.f;
#pragma unroll
        for (int i = 0; i < 4; ++i)
#pragma unroll
            for (int j = 0; j < 4; ++j) { const float d = v[i][j] - mean; q += d * d; }
        const float rstd = rsqrtf(wave_sum(q) * (1.0f / 1024.0f) + 1e-5f);
        if (lane == 0) { stats[(size_t)row * 2] = mean; stats[(size_t)row * 2 + 1] = rstd; }
        const float* mv = write_xmod ? modv_ptr(p, lmod, b, pp) + shoff : nullptr;
#pragma unroll
        for (int i = 0; i < 4; ++i) {
            const int c = i * 256 + lane * 4;
            const f32x4 g4 = *(const f32x4*)(g + c), b4 = *(const f32x4*)(bta + c);
            f32x4 o;
#pragma unroll
            for (int j = 0; j < 4; ++j) o[j] = (v[i][j] - mean) * rstd * g4[j] + b4[j];
            if (write_x) *(f32x4*)(xp + c) = o;
            if (write_xmod) {
                const f32x4 sh = *(const f32x4*)(mv + c), sc = *(const f32x4*)(mv + 1024 + c);
                uint2 ov; ov.x = pk_bf16(o[0] * (1.f + sc[0]) + sh[0], o[1] * (1.f + sc[1]) + sh[1]); ov.y = pk_bf16(o[2] * (1.f + sc[2]) + sh[2], o[3] * (1.f + sc[3]) + sh[3]);
                *(uint2*)(xm + (size_t)row * 1024 + c) = ov;
            }
        }
    }
}

__device__ __forceinline__ void p7_phase(const Params& pin, bool skip_ctx, unsigned char* lds) {
    const Params p = launder(pin); const int tid = ltid();
    const bf16_t* A = (const bf16_t*)(p.ws + OFF_R6);
    const bf16_t* W = (const bf16_t*)(p.ws + OFF_W) + WO_13;
    bf16_t* HF = (bf16_t*)(p.ws + OFF_HF);
    const int lane = tid & 63, wid = tid >> 6, wr = wid >> 2, wc = wid & 3, fr = lane & 15, fq = lane >> 4;
    auto seg = [&](int t) { int mt, nt; tile_mn(t, 22, mt, nt); Seg g; g.A = A + (size_t)mt * 256 * 1024; g.Bt = W + (size_t)nt * 256 * 1024; g.lda = 1024; g.a_kstep = 64; g.ldb = 1024; g.nk = 16; return g; };
    auto valid = [&](int t) { int mt, nt; tile_mn(t, 22, mt, nt); return !(skip_ctx && (mt % 9) == 0); };
    auto nextv = [&](int t) { while (t < 144 * 22 && !valid(t)) t += gridDim.x; return t; };
    int st = 0; bool first = true;
    for (int t = nextv(blockIdx.x); t < 144 * 22;) {
        int mt, nt; tile_mn(t, 22, mt, nt);
        const int tn = nextv(t + gridDim.x); const bool hn = tn < 144 * 22;
        f32x4 acc[8][4]; zero_acc<8>(acc);
        gemm_stream256(acc, seg(t), seg(hn ? tn : t), hn, first, st, lds, tid); first = false;
        const int G = nt * 4 + wc;
#pragma unroll
        for (int m = 0; m < 8; ++m) {
            const size_t row = (size_t)mt * 256 + wr * 128 + m * 16 + fr;
#pragma unroll
            for (int n = 0; n < 2; ++n) {
                float o[4];
#pragma unroll
                for (int j = 0; j < 4; ++j) o[j] = siluf_(acc[m][n][j]) * acc[m][n + 2][j];
                uint2 ov; ov.x = pk_bf16(o[0], o[1]); ov.y = pk_bf16(o[2], o[3]);
                *(uint2*)(HF + row * DFF + G * 32 + n * 16 + fq * 4) = ov;
            }
        }
        t = tn;
    }
}

__global__ void __launch_bounds__(NTHREADS) fwd_megakernel(Params p) {
    extern __shared__ __attribute__((aligned(16))) unsigned char lds[];
    cg::grid_group grid = cg::this_grid();
    unsigned* gbar = (unsigned*)(p.ws + OFF_BAR); unsigned epoch = 0;
#define GSYNC() grid_barrier(gbar, epoch)
    if (p.ws == nullptr) grid.sync();
    modv_phase(p, lds);
    convert_layer(p, 0, lds);
    {
        bf16_t* Wm = (bf16_t*)(p.ws + OFF_W) + WO_IN + (size_t)672 * 1024;
        for (int i = blockIdx.x * NTHREADS + threadIdx.x; i < 96 * 1024 / 2; i += gridDim.x * NTHREADS) ((unsigned*)Wm)[i] = 0u;
    }
    GSYNC();
    xmod0_phase(p);
    GSYNC();
#pragma unroll 1
    for (int l = 0; l < DEPTH; ++l) {
        const bool last = (l == DEPTH - 1);
        for (int r = 0, nr = launder_i(1 + ((PROBE_MASK >> 2) & 1)); r < nr; ++r) p1_phase(p, lds);
        GSYNC();
        for (int r = 0, nr = launder_i(1 + ((PROBE_MASK >> 3) & 1)); r < nr; ++r) p2a_phase(p, l);
        GSYNC();
        for (int r = 0, nr = launder_i(1 + ((PROBE_MASK >> 4) & 1)); r < nr; ++r) p2b_phase(p, l, lds);
        GSYNC();
        p3_phase(p, l, lds);
        GSYNC();
        for (int r = 0, nr = launder_i(1 + ((PROBE_MASK >> 5) & 1)); r < nr; ++r) p35_phase(p, l, last, lds);
        GSYNC();
        for (int r = 0, nr = launder_i(1 + ((PROBE_MASK >> 6) & 1)); r < nr; ++r) p4_phase(p, last, lds);
        GSYNC();
        resid_gemm_phase(p, l, OFF_MRG, 1024, 16, WO_OUT, 1024, 2048, l == 0, p.ln2_g + (l > 0 ? l - 1 : 0) * 1024, p.ln2_b + (l > 0 ? l - 1 : 0) * 1024, last, lds);
        GSYNC();
        ln_phase(p, p.ln1_g + l * 1024, p.ln1_b + l * 1024, l, 3072, true, false, last);
        GSYNC();
        for (int r = 0, nr = launder_i(1 + ((PROBE_MASK >> 0) & 1)); r < nr; ++r) p7_phase(p, last, lds);
        GSYNC();
        resid_gemm_phase(p, l, OFF_HF, DFF, 44, WO_2, DFF, 5120, false, p.ln1_g + l * 1024, p.ln1_b + l * 1024, last, lds);
        GSYNC();
        ln_phase(p, p.ln2_g + l * 1024, p.ln2_b + l * 1024, last ? l : l + 1, 0, !last, last, last);
        if (!last) for (int r = 0, nr = launder_i(1 + ((PROBE_MASK >> 7) & 1)); r < nr; ++r) convert_layer(p, l + 1, lds);
        for (int r = 0, nr = launder_i(((PROBE_MASK >> 8) & 1) * 10); r < nr; ++r) GSYNC();
        GSYNC();
    }
}

extern "C" void kernel_launch(void* const* d_in, const int* in_sizes, int n_in, void* d_out,
                              int out_size, void* d_ws, size_t ws_size, hipStream_t stream) {
    static int grid_blocks = 0;
    if (!grid_blocks) {
        int dev = 0, cus = 0, per_cu = 0;
        hipGetDevice(&dev);
        hipDeviceGetAttribute(&cus, hipDeviceAttributeMultiprocessorCount, dev);
        if (hipFuncSetAttribute((const void*)fwd_megakernel, hipFuncAttributeMaxDynamicSharedMemorySize, LDS_BYTES) != hipSuccess)
            fprintf(stderr, "hipFuncSetAttribute failed\n");
        hipOccupancyMaxActiveBlocksPerMultiprocessor(&per_cu, (const void*)fwd_megakernel, NTHREADS, LDS_BYTES);
        if (per_cu < 1) fprintf(stderr, "occupancy query says %d blocks/CU\n", per_cu);
        (void)hipGetLastError();
        grid_blocks = cus > 0 ? cus : 256;
        if (ws_size < WS_END) { fprintf(stderr, "workspace too small: %zu < %zu\n", ws_size, (size_t)WS_END); grid_blocks = -1; }
        if (n_in != 33) { fprintf(stderr, "expected 33 inputs, got %d\n", n_in); grid_blocks = -1; }
    }
    if (grid_blocks < 0) return;
    if (hipMemsetAsync((unsigned char*)d_ws + OFF_BAR, 0, 1024, stream) != hipSuccess) fprintf(stderr, "memset failed\n");
    Params p{};
    const float** pp = (const float**)&p;
    for (int i = 0; i < 33; ++i) pp[i] = (const float*)d_in[i];
    p.out = (float*)d_out;
    p.ws = (unsigned char*)d_ws;
    void* args[] = {&p};
    hipError_t e = hipLaunchCooperativeKernel((void*)fwd_megakernel, dim3(grid_blocks), dim3(NTHREADS), args, LDS_BYTES, stream);
    if (e != hipSuccess) fprintf(stderr, "cooperative launch failed: %s (grid %d)\n", hipGetErrorString(e), grid_blocks);
}
```

```cpp
#include <hip/hip_runtime.h>
#include <hip/hip_cooperative_groups.h>
#include <cstdio>
#include <cstdint>
namespace cg = cooperative_groups;

typedef unsigned short bf16_t;
typedef short bf16x8 __attribute__((ext_vector_type(8)));
typedef float f32x4 __attribute__((ext_vector_type(4)));

#ifndef PROBE_MASK
#define PROBE_MASK 0
#endif
constexpr int BATCH = 16, SEQ = 2048, CTXL = 256, DM = 1024, DEPTH = 4, DFF = 2816, DIN = 7200;
constexpr int TPB = SEQ + CTXL;
constexpr int MROWS = BATCH * TPB;
constexpr int NTHREADS = 512;
constexpr int LDS_BYTES = 152 * 1024;
constexpr float ALPHA = 1.681792830507429f;
constexpr float QSCALE = 0.10206207261596575f * 1.4426950408889634f;

constexpr size_t WO_IN = 0;
constexpr size_t WO_UQ = WO_IN + (size_t)7296 * 1024;
constexpr size_t WO_UKV = WO_UQ + (size_t)768 * 384;
constexpr size_t WO_OA = WO_UKV + (size_t)1024 * 256;
constexpr size_t WO_OC = WO_OA + (size_t)1024 * 512;
constexpr size_t WO_OR = WO_OC + (size_t)1024 * 512;
constexpr size_t WO_OUT = WO_OR + (size_t)1024 * 512;
constexpr size_t WO_13 = WO_OUT + (size_t)1024 * 1024;
constexpr size_t WO_2 = WO_13 + (size_t)5632 * 1024;
constexpr size_t WO_UP = WO_2 + (size_t)1024 * 2816;
constexpr size_t WO_AUP = WO_UP + (size_t)2 * 512 * 64;
constexpr size_t WO_GUP = WO_AUP + (size_t)2 * 512 * 64;
constexpr size_t W_ELEMS = WO_GUP + (size_t)512 * 128;

constexpr size_t al256(size_t x) { return (x + 255) & ~(size_t)255; }
constexpr size_t OFF_BAR = 0;
constexpr size_t OFF_W = 1024;
constexpr size_t OFF_MODV = al256(OFF_W + W_ELEMS * 2);
constexpr size_t OFF_ROPE = al256(OFF_MODV + (size_t)4 * 17 * 6144 * 4);
constexpr size_t OFF_RSQ = al256(OFF_ROPE + 64 * 8 * 2 * 4);
constexpr size_t OFF_RSKV = al256(OFF_RSQ + (size_t)MROWS * 4);
constexpr size_t OFF_STATS = al256(OFF_RSKV + (size_t)MROWS * 4);
constexpr size_t OFF_XC = al256(OFF_STATS + (size_t)MROWS * 8);
constexpr size_t OFF_R1 = al256(OFF_XC + (size_t)BATCH * CTXL * DM * 4);
constexpr size_t OFF_R2 = al256(OFF_R1 + (size_t)MROWS * 672 * 2);
constexpr size_t OFF_R3 = OFF_R2 + (size_t)MROWS * 1536 * 2;
constexpr size_t OFF_R4 = al256(OFF_R3 + (size_t)MROWS * 1920 * 2);
constexpr size_t OFF_R5 = al256(OFF_R4 + (size_t)MROWS * (512 + 512 + 32) * 2);
constexpr size_t OFF_R6 = al256(OFF_R5 + (size_t)MROWS * 512 * 2);
constexpr size_t WS_END = al256(OFF_R6 + (size_t)MROWS * 1024 * 2);
constexpr size_t OFF_Q = OFF_R2;
constexpr size_t OFF_YF = OFF_R2 + (size_t)MROWS * 768 * 2;
constexpr size_t OFF_SG = OFF_YF + (size_t)MROWS * 512 * 2;
constexpr size_t OFF_YB = OFF_R1;
constexpr size_t OFF_KN = OFF_R4;
constexpr size_t OFF_VT = OFF_R4 + (size_t)MROWS * 512 * 2;
constexpr size_t OFF_KR = OFF_VT + (size_t)MROWS * 512 * 2;
constexpr size_t OFF_RWO = OFF_R4;
constexpr size_t OFF_MRG = OFF_R3;
constexpr size_t OFF_HF = OFF_R2;
static_assert(OFF_SG + (size_t)MROWS * 128 * 2 <= OFF_R3, "R2 overlay overflow");
static_assert((size_t)MROWS * 2816 * 2 <= OFF_R4 - OFF_R2, "HF overflow");

struct Params {
    const float *x, *c, *ctx, *c_ctx, *mod_w, *mod_b, *w_in, *q_norm, *w_uq, *kv_norm, *w_ukv, *w_o_attn,
        *conv_w, *w_o_conv, *rw_mu, *rw_w0, *rw_w_up, *rw_a0, *rw_a_up, *rw_g_up, *rw_k_k, *rw_k_a,
        *rw_r_k, *rw_gn_g, *rw_gn_b, *w_o_rwkv, *w_out, *ln1_g, *ln1_b, *ffn_w13, *ffn_w2, *ln2_g, *ln2_b;
    float* out;
    unsigned char* ws;
};

typedef __attribute__((address_space(1))) unsigned char gchar_t;
typedef __attribute__((address_space(1))) float gfloat_t;
__device__ __forceinline__ Params launder(const Params& a) {
    Params q = a;
    unsigned long long w = (unsigned long long)a.ws, o = (unsigned long long)a.out;
    unsigned wl = __builtin_amdgcn_readfirstlane((unsigned)w), wh = __builtin_amdgcn_readfirstlane((unsigned)(w >> 32));
    unsigned ol = __builtin_amdgcn_readfirstlane((unsigned)o), oh = __builtin_amdgcn_readfirstlane((unsigned)(o >> 32));
    asm volatile("" : "+s"(wl), "+s"(wh), "+s"(ol), "+s"(oh));
    w = ((unsigned long long)wh << 32) | wl; o = ((unsigned long long)oh << 32) | ol;
    q.ws = (unsigned char*)(gchar_t*)w; q.out = (float*)(gfloat_t*)o;
    return q;
}
__device__ __forceinline__ int launder_i(int v) { v = __builtin_amdgcn_readfirstlane(v); asm volatile("" : "+s"(v)); return v; }
__device__ __forceinline__ int ltid() { int t = threadIdx.x; asm volatile("" : "+v"(t)); return t; }
__device__ __forceinline__ unsigned pk_bf16(float lo, float hi) { unsigned r; asm("v_cvt_pk_bf16_f32 %0, %1, %2" : "=v"(r) : "v"(lo), "v"(hi)); return r; }
__device__ __forceinline__ float bf_lo(unsigned u) { return __uint_as_float(u << 16); }
__device__ __forceinline__ float bf_hi(unsigned u) { return __uint_as_float(u & 0xffff0000u); }
__device__ __forceinline__ float bf1(bf16_t h) { return __uint_as_float(((unsigned)h) << 16); }
__device__ __forceinline__ float x32sum(float x) { unsigned u = __float_as_uint(x); auto r = __builtin_amdgcn_permlane32_swap(u, u, false, false); return __uint_as_float(r[0]) + __uint_as_float(r[1]); }
__device__ __forceinline__ float x16sum(float x) { unsigned u = __float_as_uint(x); auto r = __builtin_amdgcn_permlane16_swap(u, u, false, false); return __uint_as_float(r[0]) + __uint_as_float(r[1]); }
__device__ __forceinline__ float x32max(float x) { unsigned u = __float_as_uint(x); auto r = __builtin_amdgcn_permlane32_swap(u, u, false, false); return fmaxf(__uint_as_float(r[0]), __uint_as_float(r[1])); }
__device__ __forceinline__ float x16max(float x) { unsigned u = __float_as_uint(x); auto r = __builtin_amdgcn_permlane16_swap(u, u, false, false); return fmaxf(__uint_as_float(r[0]), __uint_as_float(r[1])); }
__device__ __forceinline__ float fqsum(float x) { return x16sum(x32sum(x)); }
__device__ __forceinline__ float fqmax(float x) { return x16max(x32max(x)); }
__device__ __forceinline__ float wave_sum(float v) {
#pragma unroll
    for (int o = 1; o < 16; o <<= 1) v += __shfl_xor(v, o);
    return fqsum(v);
}
template <int CTRL> __device__ __forceinline__ float dpp_add(float x) { return x + __uint_as_float((unsigned)__builtin_amdgcn_update_dpp(0, (int)__float_as_uint(x), CTRL, 0xf, 0xf, true)); }
__device__ __forceinline__ float red8(float x) { x = dpp_add<0xB1>(x); x = dpp_add<0x4E>(x); x = dpp_add<0x141>(x); return x; }
__device__ __forceinline__ float sigmoidf_(float x) { return 1.0f / (1.0f + __expf(-x)); }
__device__ __forceinline__ float siluf_(float x) { return x / (1.0f + __expf(-x)); }

__device__ __forceinline__ const float* x_rd(const Params& p, bool from_input, int b, int pp) {
    if (pp < CTXL) return (from_input ? p.ctx : (const float*)(p.ws + OFF_XC)) + ((size_t)b * CTXL + pp) * DM;
    return (from_input ? p.x : (const float*)p.out) + ((size_t)b * SEQ + (pp - CTXL)) * DM;
}
__device__ __forceinline__ float* x_wr(const Params& p, int b, int pp) {
    if (pp < CTXL) return (float*)(p.ws + OFF_XC) + ((size_t)b * CTXL + pp) * DM;
    return p.out + ((size_t)b * SEQ + (pp - CTXL)) * DM;
}
__device__ __forceinline__ const float* modv_ptr(const Params& p, int l, int b, int pp) {
    const int mr = pp < CTXL ? 16 : b;
    return (const float*)(p.ws + OFF_MODV) + ((size_t)l * 17 + mr) * 6144;
}

__device__ __forceinline__ void grid_barrier(unsigned* bar, unsigned& epoch) {
    asm volatile("s_waitcnt vmcnt(0) lgkmcnt(0)" ::: "memory");
    __syncthreads();
    epoch += 1;
    if (threadIdx.x == 0) {
        __builtin_amdgcn_fence(__ATOMIC_RELEASE, "agent");
        asm volatile("s_waitcnt vmcnt(0)" ::: "memory");
        const unsigned old = __hip_atomic_fetch_add(bar, 1u, __ATOMIC_RELAXED, __HIP_MEMORY_SCOPE_AGENT);
        if (old + 1u == epoch * gridDim.x) {
            __hip_atomic_store(bar + 64, epoch, __ATOMIC_RELAXED, __HIP_MEMORY_SCOPE_AGENT);
        } else {
            while (__hip_atomic_load(bar + 64, __ATOMIC_RELAXED, __HIP_MEMORY_SCOPE_AGENT) < epoch) __builtin_amdgcn_s_sleep(1);
        }
        __builtin_amdgcn_fence(__ATOMIC_ACQUIRE, "agent");
        asm volatile("s_waitcnt vmcnt(0)" ::: "memory");
    }
    __syncthreads();
}

#define LDS_AS __attribute__((address_space(3)))
#define GLB_AS __attribute__((address_space(1)))
template <int MT, int SWAPMODE>
__device__ __forceinline__ void gemm_mainloop(f32x4 (&acc)[MT][4], const bf16_t* __restrict__ A, int lda, int a_kstep,
                                              const bf16_t* __restrict__ Bt, int ldb, int nk, unsigned char* lds, int tid) {
    constexpr int BMr = 64 * MT;
    constexpr int STAGE = (BMr + 128) * 128;
    const int wid = __builtin_amdgcn_readfirstlane(tid >> 6), lane = tid & 63, wr = wid >> 1, wc = wid & 1, fr = lane & 15, fq = lane >> 4;
    const int lrow = 8 * wid + (lane >> 3);
    const int lch = (lane & 7) ^ ((4 * wid + (lane >> 4)) & 7);
    const bf16_t* ap = A + (size_t)lrow * lda + lch * 8;
    const bf16_t* bp = Bt + (size_t)lrow * ldb + lch * 8;
    auto issue = [&](int kt, int st) {
        unsigned char* base = lds + st * STAGE + wid * 1024;
#pragma unroll
        for (int i = 0; i < MT; ++i)
            __builtin_amdgcn_global_load_lds((const GLB_AS unsigned*)(ap + (size_t)i * 64 * lda + (size_t)kt * a_kstep), (LDS_AS unsigned*)(base + i * 8192), 16, 0, 0);
#pragma unroll
        for (int i = 0; i < 2; ++i)
            __builtin_amdgcn_global_load_lds((const GLB_AS unsigned*)(bp + (size_t)i * 64 * ldb + (size_t)kt * 64), (LDS_AS unsigned*)(base + (BMr + i * 64) * 128), 16, 0, 0);
    };
    const bool sw = (SWAPMODE == 1) || (SWAPMODE == 2 && wc == 0);
    const int sz = fr >> 1;
    constexpr int NL = MT + 2;
    const bool late = wid >= 4;
    issue(0, 0);
    if (nk > 1) { issue(1, 1); asm volatile("s_waitcnt vmcnt(%0)" ::"n"(NL) : "memory"); }
    else asm volatile("s_waitcnt vmcnt(0)" ::: "memory");
    __builtin_amdgcn_s_barrier();
    asm volatile("" ::: "memory");
    int st = 0;
    for (int kt = 0; kt < nk; ++kt) {
        const int st2 = st >= 1 ? st - 1 : 2;
        if (!late && kt + 2 < nk) issue(kt + 2, st2);
        const unsigned char* As = lds + st * STAGE;
        const unsigned char* Bs = As + BMr * 128;
#pragma unroll
        for (int ks = 0; ks < 2; ++ks) {
            bf16x8 af[MT], bfr[4];
            const int co = ((ks * 4 + fq) ^ sz) * 16;
#pragma unroll
            for (int m = 0; m < MT; ++m) af[m] = *(const bf16x8*)(As + (wr * 16 * MT + m * 16 + fr) * 128 + co);
#pragma unroll
            for (int n = 0; n < 4; ++n) bfr[n] = *(const bf16x8*)(Bs + (wc * 64 + n * 16 + fr) * 128 + co);
            if (sw) {
#pragma unroll
                for (int m = 0; m < MT; ++m)
#pragma unroll
                    for (int n = 0; n < 4; ++n) acc[m][n] = __builtin_amdgcn_mfma_f32_16x16x32_bf16(bfr[n], af[m], acc[m][n], 0, 0, 0);
            } else {
#pragma unroll
                for (int m = 0; m < MT; ++m)
#pragma unroll
                    for (int n = 0; n < 4; ++n) acc[m][n] = __builtin_amdgcn_mfma_f32_16x16x32_bf16(af[m], bfr[n], acc[m][n], 0, 0, 0);
            }
        }
        if (late && kt + 2 < nk) issue(kt + 2, st2);
        if (kt + 2 < nk) asm volatile("s_waitcnt vmcnt(%0) lgkmcnt(0)" ::"n"(NL) : "memory");
        else asm volatile("s_waitcnt vmcnt(0) lgkmcnt(0)" ::: "memory");
        __builtin_amdgcn_s_barrier();
        asm volatile("" ::: "memory");
        st = st == 2 ? 0 : st + 1;
    }
}
__device__ __forceinline__ void gemm_mainloop256(f32x4 (&acc)[8][4], const bf16_t* __restrict__ A, int lda,
                                                 const bf16_t* __restrict__ Bt, int ldb, int nk, unsigned char* lds, int tid) {
    constexpr int STAGE = 512 * 128;
    const int wid = __builtin_amdgcn_readfirstlane(tid >> 6), lane = tid & 63, wr = wid >> 2, wc = wid & 3, fr = lane & 15, fq = lane >> 4;
    const int lrow = 8 * wid + (lane >> 3);
    const int lch = (lane & 7) ^ ((4 * wid + (lane >> 4)) & 7);
    const bf16_t* ap = A + (size_t)lrow * lda + lch * 8;
    const bf16_t* bp = Bt + (size_t)lrow * ldb + lch * 8;
    auto issue = [&](int kt, int st) {
        unsigned char* base = lds + st * STAGE + wid * 1024;
#pragma unroll
        for (int i = 0; i < 4; ++i)
            __builtin_amdgcn_global_load_lds((const GLB_AS unsigned*)(ap + (size_t)i * 64 * lda + (size_t)kt * 64), (LDS_AS unsigned*)(base + i * 8192), 16, 0, 0);
#pragma unroll
        for (int i = 0; i < 4; ++i)
            __builtin_amdgcn_global_load_lds((const GLB_AS unsigned*)(bp + (size_t)i * 64 * ldb + (size_t)kt * 64), (LDS_AS unsigned*)(base + (256 + i * 64) * 128), 16, 0, 0);
    };
    const int sz = fr >> 1;
    const bool late = wid >= 4;
    issue(0, 0);
    asm volatile("s_waitcnt vmcnt(0)" ::: "memory");
    __builtin_amdgcn_s_barrier();
    asm volatile("" ::: "memory");
    for (int kt = 0; kt < nk; ++kt) {
        if (!late && kt + 1 < nk) issue(kt + 1, (kt + 1) & 1);
        const unsigned char* As = lds + (kt & 1) * STAGE;
        const unsigned char* Bs = As + 256 * 128;
#pragma unroll
        for (int ks = 0; ks < 2; ++ks) {
            if (ks == 1 && late && kt + 1 < nk) issue(kt + 1, (kt + 1) & 1);
            bf16x8 af[8], bfr[4];
            const int co = ((ks * 4 + fq) ^ sz) * 16;
#pragma unroll
            for (int m = 0; m < 8; ++m) af[m] = *(const bf16x8*)(As + (wr * 128 + m * 16 + fr) * 128 + co);
#pragma unroll
            for (int n = 0; n < 4; ++n) bfr[n] = *(const bf16x8*)(Bs + (wc * 64 + n * 16 + fr) * 128 + co);
#pragma unroll
            for (int m = 0; m < 8; ++m)
#pragma unroll
                for (int n = 0; n < 4; ++n) acc[m][n] = __builtin_amdgcn_mfma_f32_16x16x32_bf16(bfr[n], af[m], acc[m][n], 0, 0, 0);
        }
        asm volatile("s_waitcnt vmcnt(0) lgkmcnt(0)" ::: "memory");
        __builtin_amdgcn_s_barrier();
        asm volatile("" ::: "memory");
    }
}
struct Seg { const bf16_t* A; const bf16_t* Bt; int lda, a_kstep, ldb, nk; };
template <int MT, int SWAPMODE>
__device__ __forceinline__ void gemm_stream(f32x4 (&acc)[MT][4], const Seg& cur, const Seg& nxt, bool has_next, bool first, int& st,
                                            unsigned char* lds, int tid) {
    constexpr int BMr = 64 * MT;
    constexpr int STAGE = (BMr + 128) * 128;
    constexpr int NL = MT + 2;
    const int wid = __builtin_amdgcn_readfirstlane(tid >> 6), lane = tid & 63, wr = wid >> 1, wc = wid & 1, fr = lane & 15, fq = lane >> 4;
    const int lrow = 8 * wid + (lane >> 3);
    const int lch = (lane & 7) ^ ((4 * wid + (lane >> 4)) & 7);
    const bf16_t* apc = cur.A + (size_t)lrow * cur.lda + lch * 8;
    const bf16_t* bpc = cur.Bt + (size_t)lrow * cur.ldb + lch * 8;
    const bf16_t* apn = nxt.A + (size_t)lrow * nxt.lda + lch * 8;
    const bf16_t* bpn = nxt.Bt + (size_t)lrow * nxt.ldb + lch * 8;
    auto issue = [&](const bf16_t* ap, const bf16_t* bp, int lda, int ldb, int koffa, int koffb, int slot) {
        unsigned char* base = lds + slot * STAGE + wid * 1024;
#pragma unroll
        for (int i = 0; i < MT; ++i)
            __builtin_amdgcn_global_load_lds((const GLB_AS unsigned*)(ap + (size_t)i * 64 * lda + koffa), (LDS_AS unsigned*)(base + i * 8192), 16, 0, 0);
#pragma unroll
        for (int i = 0; i < 2; ++i)
            __builtin_amdgcn_global_load_lds((const GLB_AS unsigned*)(bp + (size_t)i * 64 * ldb + koffb), (LDS_AS unsigned*)(base + (BMr + i * 64) * 128), 16, 0, 0);
    };
    const bool sw = (SWAPMODE == 1) || (SWAPMODE == 2 && wc == 0);
    const int sz = fr >> 1;
    const bool late = wid >= 4;
    const int nk = cur.nk;
    int s0 = st;
    if (first) {
        const int s1 = s0 == 2 ? 0 : s0 + 1;
        issue(apc, bpc, cur.lda, cur.ldb, 0, 0, s0);
        issue(apc, bpc, cur.lda, cur.ldb, cur.a_kstep, 64, s1);
        asm volatile("s_waitcnt vmcnt(%0)" ::"n"(NL) : "memory");
        __builtin_amdgcn_s_barrier();
        asm volatile("" ::: "memory");
    }
    for (int kt = 0; kt < nk; ++kt) {
        const int s2 = s0 >= 1 ? s0 - 1 : 2;
        const int idx = kt + 2;
        const bool incur = idx < nk, doi = incur || has_next;
        if (!late && doi) { if (incur) issue(apc, bpc, cur.lda, cur.ldb, idx * cur.a_kstep, idx * 64, s2); else issue(apn, bpn, nxt.lda, nxt.ldb, (idx - nk) * nxt.a_kstep, (idx - nk) * 64, s2); }
        const unsigned char* As = lds + s0 * STAGE;
        const unsigned char* Bs = As + BMr * 128;
#pragma unroll
        for (int ks = 0; ks < 2; ++ks) {
            bf16x8 af[MT], bfr[4];
            const int co = ((ks * 4 + fq) ^ sz) * 16;
#pragma unroll
            for (int m = 0; m < MT; ++m) af[m] = *(const bf16x8*)(As + (wr * 16 * MT + m * 16 + fr) * 128 + co);
#pragma unroll
            for (int n = 0; n < 4; ++n) bfr[n] = *(const bf16x8*)(Bs + (wc * 64 + n * 16 + fr) * 128 + co);
            if (sw) {
#pragma unroll
                for (int m = 0; m < MT; ++m)
#pragma unroll
                    for (int n = 0; n < 4; ++n) acc[m][n] = __builtin_amdgcn_mfma_f32_16x16x32_bf16(bfr[n], af[m], acc[m][n], 0, 0, 0);
            } else {
#pragma unroll
                for (int m = 0; m < MT; ++m)
#pragma unroll
                    for (int n = 0; n < 4; ++n) acc[m][n] = __builtin_amdgcn_mfma_f32_16x16x32_bf16(af[m], bfr[n], acc[m][n], 0, 0, 0);
            }
        }
        if (late && doi) { if (incur) issue(apc, bpc, cur.lda, cur.ldb, idx * cur.a_kstep, idx * 64, s2); else issue(apn, bpn, nxt.lda, nxt.ldb, (idx - nk) * nxt.a_kstep, (idx - nk) * 64, s2); }
        if (doi) asm volatile("s_waitcnt vmcnt(%0) lgkmcnt(0)" ::"n"(NL) : "memory");
        else asm volatile("s_waitcnt vmcnt(0) lgkmcnt(0)" ::: "memory");
        __builtin_amdgcn_s_barrier();
        asm volatile("" ::: "memory");
        s0 = s0 == 2 ? 0 : s0 + 1;
    }
    st = s0;
}
__device__ __forceinline__ void gemm_stream256(f32x4 (&acc)[8][4], const Seg& cur, const Seg& nxt, bool has_next, bool first, int& st, unsigned char* lds, int tid) {
    constexpr int STAGE = 512 * 128;
    const int wid = __builtin_amdgcn_readfirstlane(tid >> 6), lane = tid & 63, wr = wid >> 2, wc = wid & 3, fr = lane & 15, fq = lane >> 4;
    const int lrow = 8 * wid + (lane >> 3);
    const int lch = (lane & 7) ^ ((4 * wid + (lane >> 4)) & 7);
    const bf16_t* apc = cur.A + (size_t)lrow * cur.lda + lch * 8;
    const bf16_t* bpc = cur.Bt + (size_t)lrow * cur.ldb + lch * 8;
    const bf16_t* apn = nxt.A + (size_t)lrow * nxt.lda + lch * 8;
    const bf16_t* bpn = nxt.Bt + (size_t)lrow * nxt.ldb + lch * 8;
    auto issue = [&](const bf16_t* ap, const bf16_t* bp, int lda, int ldb, int koff, int slot) {
        unsigned char* base = lds + slot * STAGE + wid * 1024;
#pragma unroll
        for (int i = 0; i < 4; ++i)
            __builtin_amdgcn_global_load_lds((const GLB_AS unsigned*)(ap + (size_t)i * 64 * lda + koff), (LDS_AS unsigned*)(base + i * 8192), 16, 0, 0);
#pragma unroll
        for (int i = 0; i < 4; ++i)
            __builtin_amdgcn_global_load_lds((const GLB_AS unsigned*)(bp + (size_t)i * 64 * ldb + koff), (LDS_AS unsigned*)(base + (256 + i * 64) * 128), 16, 0, 0);
    };
    const int sz = fr >> 1;
    const bool late = wid >= 4;
    const int nk = cur.nk;
    int s0 = st;
    if (first) {
        issue(apc, bpc, cur.lda, cur.ldb, 0, s0);
        asm volatile("s_waitcnt vmcnt(0)" ::: "memory");
        __builtin_amdgcn_s_barrier();
        asm volatile("" ::: "memory");
    }
    for (int kt = 0; kt < nk; ++kt) {
        const int idx = kt + 1;
        const bool incur = idx < nk, doi = incur || has_next;
        if (!late && doi) { if (incur) issue(apc, bpc, cur.lda, cur.ldb, idx * 64, s0 ^ 1); else issue(apn, bpn, nxt.lda, nxt.ldb, 0, s0 ^ 1); }
        const unsigned char* As = lds + s0 * STAGE;
        const unsigned char* Bs = As + 256 * 128;
#pragma unroll
        for (int ks = 0; ks < 2; ++ks) {
            if (ks == 1 && late && doi) { if (incur) issue(apc, bpc, cur.lda, cur.ldb, idx * 64, s0 ^ 1); else issue(apn, bpn, nxt.lda, nxt.ldb, 0, s0 ^ 1); }
            bf16x8 af[8], bfr[4];
            const int co = ((ks * 4 + fq) ^ sz) * 16;
#pragma unroll
            for (int m = 0; m < 8; ++m) af[m] = *(const bf16x8*)(As + (wr * 128 + m * 16 + fr) * 128 + co);
#pragma unroll
            for (int n = 0; n < 4; ++n) bfr[n] = *(const bf16x8*)(Bs + (wc * 64 + n * 16 + fr) * 128 + co);
#pragma unroll
            for (int m = 0; m < 8; ++m)
#pragma unroll
                for (int n = 0; n < 4; ++n) acc[m][n] = __builtin_amdgcn_mfma_f32_16x16x32_bf16(bfr[n], af[m], acc[m][n], 0, 0, 0);
        }
        asm volatile("s_waitcnt vmcnt(0) lgkmcnt(0)" ::: "memory");
        __builtin_amdgcn_s_barrier();
        asm volatile("" ::: "memory");
        s0 ^= 1;
    }
    st = s0;
}
__device__ __forceinline__ void gemm_gate3(f32x4 (&g)[3][2][4], const bf16_t* __restrict__ A, const bf16_t* __restrict__ Bt0, int nk, unsigned char* lds, int tid) {
    constexpr int STAGE = 512 * 128;
    const int wid = __builtin_amdgcn_readfirstlane(tid >> 6), lane = tid & 63, wr = wid >> 1, wc = wid & 1, fr = lane & 15, fq = lane >> 4;
    const int lrow = 8 * wid + (lane >> 3);
    const int lch = (lane & 7) ^ ((4 * wid + (lane >> 4)) & 7);
    const unsigned loff = (unsigned)(lrow * 1024 + lch * 8);
    auto issue = [&](int kt, int stg) {
        unsigned char* base = lds + stg * STAGE + wid * 1024;
#pragma unroll
        for (int i = 0; i < 2; ++i)
            __builtin_amdgcn_global_load_lds((const GLB_AS unsigned*)((A + (size_t)i * 64 * 1024 + (size_t)kt * 64) + loff), (LDS_AS unsigned*)(base + i * 8192), 16, 0, 0);
#pragma unroll
        for (int j = 0; j < 6; ++j)
            __builtin_amdgcn_global_load_lds((const GLB_AS unsigned*)((Bt0 + ((size_t)(j >> 1) * 1024 + (j & 1) * 64) * 1024 + (size_t)kt * 64) + loff), (LDS_AS unsigned*)(base + (128 + j * 64) * 128), 16, 0, 0);
    };
    const int sz = fr >> 1;
    const bool late = wid >= 4;
    issue(0, 0);
    asm volatile("s_waitcnt vmcnt(0)" ::: "memory");
    __builtin_amdgcn_s_barrier();
    asm volatile("" ::: "memory");
    for (int kt = 0; kt < nk; ++kt) {
        if (!late && kt + 1 < nk) issue(kt + 1, (kt + 1) & 1);
        const unsigned char* As = lds + (kt & 1) * STAGE;
        const unsigned char* Bs = As + 128 * 128;
#pragma unroll
        for (int ks = 0; ks < 2; ++ks) {
            if (ks == 1 && late && kt + 1 < nk) issue(kt + 1, (kt + 1) & 1);
            const int co = ((ks * 4 + fq) ^ sz) * 16;
            bf16x8 af[2];
#pragma unroll
            for (int m = 0; m < 2; ++m) af[m] = *(const bf16x8*)(As + (wr * 32 + m * 16 + fr) * 128 + co);
#pragma unroll
            for (int i = 0; i < 3; ++i) {
                bf16x8 bfr[4];
#pragma unroll
                for (int n = 0; n < 4; ++n) bfr[n] = *(const bf16x8*)(Bs + (i * 128 + wc * 64 + n * 16 + fr) * 128 + co);
#pragma unroll
                for (int m = 0; m < 2; ++m)
#pragma unroll
                    for (int n = 0; n < 4; ++n) g[i][m][n] = __builtin_amdgcn_mfma_f32_16x16x32_bf16(bfr[n], af[m], g[i][m][n], 0, 0, 0);
                if (i < 2) __builtin_amdgcn_sched_barrier(0);
            }
        }
        asm volatile("s_waitcnt vmcnt(0) lgkmcnt(0)" ::: "memory");
        __builtin_amdgcn_s_barrier();
        asm volatile("" ::: "memory");
    }
}
template <int MT> __device__ __forceinline__ void zero_acc(f32x4 (&acc)[MT][4]) {
#pragma unroll
    for (int m = 0; m < MT; ++m)
#pragma unroll
        for (int n = 0; n < 4; ++n) acc[m][n] = (f32x4){0.f, 0.f, 0.f, 0.f};
}
__device__ __forceinline__ void tile_mn(int t, int nN, int& mt, int& nt) { const int per = 16 * nN, g = t / per, w = t % per; mt = g * 16 + (w & 15); nt = w >> 4; }

__device__ __forceinline__ int rowmap(int mode, int n) {
    if (mode == 1) return n < 672 ? n : n + 96;
    if (mode == 2) return n < DFF ? ((n >> 5) * 64 + (n & 31)) : (((n - DFF) >> 5) * 64 + 32 + ((n - DFF) & 31));
    return n;
}
__device__ __forceinline__ void convert_T(const float* __restrict__ src, int K, int N, bf16_t* __restrict__ dst, int mode, const float* __restrict__ ks, unsigned char* lds, int rot) {
    float* tile = (float*)lds;
    const int ntk = K / 64, ntn = (N + 63) / 64, tid = ltid();
    const int start = (blockIdx.x + gridDim.x - (rot % gridDim.x)) % gridDim.x;
    for (int t = start; t < ntk * ntn; t += gridDim.x) {
        const int tk = t % ntk, tn = t / ntk, k0 = tk * 64, n0 = tn * 64;
#pragma unroll
        for (int i = 0; i < 8; ++i) {
            const int kl = (tid >> 6) + 8 * i, nl = tid & 63, n = n0 + nl;
            tile[kl * 65 + nl] = n < N ? src[(size_t)(k0 + kl) * N + n] : 0.f;
        }
        __syncthreads();
        const int kp = (tid & 31) * 2;
        float s0 = 1.f, s1 = 1.f;
        if (ks) { s0 = ks[k0 + kp]; s1 = ks[k0 + kp + 1]; }
#pragma unroll
        for (int i = 0; i < 4; ++i) {
            const int nl = (tid >> 5) + 16 * i, n = n0 + nl;
            if (n < N) *(unsigned*)(dst + (size_t)rowmap(mode, n) * K + k0 + kp) = pk_bf16(tile[kp * 65 + nl] * s0, tile[(kp + 1) * 65 + nl] * s1);
        }
        __syncthreads();
    }
}
__device__ __forceinline__ void convert_layer(const Params& pin, int l, unsigned char* lds) {
    const Params p = launder(pin); l = launder_i(l);
    bf16_t* W = (bf16_t*)(p.ws + OFF_W);
    convert_T(p.w_in + (size_t)l * DM * DIN, DM, DIN, W + WO_IN, 1, nullptr, lds, 0);
    convert_T(p.ffn_w13 + (size_t)l * DM * 2 * DFF, DM, 2 * DFF, W + WO_13, 2, nullptr, lds, 40);
    convert_T(p.ffn_w2 + (size_t)l * DFF * DM, DFF, DM, W + WO_2, 0, nullptr, lds, 80);
    convert_T(p.w_out + (size_t)l * DM * DM, DM, DM, W + WO_OUT, 0, nullptr, lds, 120);
    convert_T(p.w_o_attn + (size_t)l * 512 * DM, 512, DM, W + WO_OA, 0, nullptr, lds, 136);
    convert_T(p.w_o_conv + (size_t)l * 512 * DM, 512, DM, W + WO_OC, 0, nullptr, lds, 8);
    convert_T(p.w_o_rwkv + (size_t)l * 512 * DM, 512, DM, W + WO_OR, 0, nullptr, lds, 136 + 8);
    convert_T(p.w_uq + (size_t)l * 384 * 768, 384, 768, W + WO_UQ, 0, p.q_norm + l * 384, lds, 16);
    convert_T(p.w_ukv + (size_t)l * 256 * 1024, 256, 1024, W + WO_UKV, 0, p.kv_norm + l * 256, lds, 88);
    for (int z = 0; z < 2; ++z) {
        convert_T(p.rw_w_up + ((size_t)l * 2 + z) * 64 * 512, 64, 512, W + WO_UP + (size_t)z * 512 * 64, 0, nullptr, lds, 152 + 8 * z);
        convert_T(p.rw_a_up + ((size_t)l * 2 + z) * 64 * 512, 64, 512, W + WO_AUP + (size_t)z * 512 * 64, 0, nullptr, lds, 168 + 8 * z);
    }
    convert_T(p.rw_g_up + (size_t)l * 128 * 512, 128, 512, W + WO_GUP, 0, nullptr, lds, 184);
}

__device__ __forceinline__ void modv_phase(const Params& pin, unsigned char* lds) {
    const Params p = launder(pin);
    float* s = (float*)lds;
    float* red = s + 17 * 1024;
    const int tid = ltid(), wid = tid >> 6, lane = tid & 63;
    for (int i = tid; i < 17 * 1024; i += NTHREADS) { const int r = i >> 10, k = i & 1023; const float v = r < 16 ? p.c[r * 1024 + k] : p.c_ctx[k]; s[i] = siluf_(v); }
    __syncthreads();
    float* modv = (float*)(p.ws + OFF_MODV);
    for (int g = blockIdx.x; g < 4 * 96; g += gridDim.x) {
        const int l = g / 96, n = (g % 96) * 64 + lane;
        const float* w = p.mod_w + (size_t)l * 1024 * 6144 + n;
        float acc[17];
#pragma unroll
        for (int r = 0; r < 17; ++r) acc[r] = 0.f;
        const int kb = wid * 128;
        for (int k = kb; k < kb + 128; k += 4) {
            const float w0 = w[(size_t)k * 6144], w1 = w[(size_t)(k + 1) * 6144], w2 = w[(size_t)(k + 2) * 6144], w3 = w[(size_t)(k + 3) * 6144];
#pragma unroll
            for (int r = 0; r < 17; ++r) { const f32x4 sv = *(const f32x4*)(s + r * 1024 + k); acc[r] += sv[0] * w0 + sv[1] * w1 + sv[2] * w2 + sv[3] * w3; }
        }
#pragma unroll
        for (int r = 0; r < 17; ++r) red[(wid * 17 + r) * 64 + lane] = acc[r];
        __syncthreads();
        for (int i = tid; i < 17 * 64; i += NTHREADS) {
            const int r = i >> 6, c = i & 63; float v = 0.f;
#pragma unroll
            for (int w8 = 0; w8 < 8; ++w8) v += red[(w8 * 17 + r) * 64 + c];
            const int nn = (g % 96) * 64 + c;
            modv[((size_t)l * 17 + r) * 6144 + nn] = v + p.mod_b[l * 6144 + nn];
        }
        __syncthreads();
    }
    if (blockIdx.x == gridDim.x - 1) {
        float* rope = (float*)(p.ws + OFF_ROPE);
        for (int i = tid; i < 512; i += NTHREADS) {
            const int pos = i >> 3, f = i & 7;
            const float inv = exp2f(-(float)f * (13.287712379549449f / 8.0f));
            const float ang = (float)pos * inv;
            rope[i * 2] = cosf(ang); rope[i * 2 + 1] = sinf(ang);
        }
    }
}

__device__ __forceinline__ void xmod0_phase(const Params& pin) {
    const Params p = launder(pin);
    const int tid = ltid(), wid = tid >> 6, lane = tid & 63;
    bf16_t* xm = (bf16_t*)(p.ws + OFF_R6);
    for (int row = blockIdx.x * 8 + wid; row < MROWS; row += gridDim.x * 8) {
        const int b = row / TPB, pp = row % TPB;
        const float* xp = x_rd(p, true, b, pp);
        const float* mv = modv_ptr(p, 0, b, pp);
#pragma unroll
        for (int i = 0; i < 4; ++i) {
            const int c = i * 256 + lane * 4;
            const f32x4 v = *(const f32x4*)(xp + c), sh = *(const f32x4*)(mv + c), sc = *(const f32x4*)(mv + 1024 + c);
            uint2 o; o.x = pk_bf16(v[0] * (1.f + sc[0]) + sh[0], v[1] * (1.f + sc[1]) + sh[1]); o.y = pk_bf16(v[2] * (1.f + sc[2]) + sh[2], v[3] * (1.f + sc[3]) + sh[3]);
            *(uint2*)(xm + (size_t)row * 1024 + c) = o;
        }
    }
}

__device__ __forceinline__ void p1_phase(const Params& pin, unsigned char* lds) {
    const Params p = launder(pin); const int tid = ltid();
    const bf16_t* A = (const bf16_t*)(p.ws + OFF_R6);
    const bf16_t* W = (const bf16_t*)(p.ws + OFF_W) + WO_IN;
    const int lane = tid & 63, wid = tid >> 6, wr = wid >> 2, wc = wid & 3, fr = lane & 15, fq = lane >> 4;
    auto seg = [&](int t) { int mt, nt; tile_mn(t, 17, mt, nt); Seg g; g.A = A + (size_t)mt * 256 * 1024; g.Bt = W + (size_t)nt * 256 * 1024; g.lda = 1024; g.a_kstep = 64; g.ldb = 1024; g.nk = 16; return g; };
    int st = 0; bool first = true;
    for (int t = blockIdx.x; t < 144 * 17; t += gridDim.x) {
        int mt, nt; tile_mn(t, 17, mt, nt);
        const int tn = t + gridDim.x; const bool hn = tn < 144 * 17;
        f32x4 acc[8][4]; zero_acc<8>(acc);
        gemm_stream256(acc, seg(t), seg(hn ? tn : t), hn, first, st, lds, tid); first = false;
        bf16_t* dst; int ld, cb, lim;
        if (nt < 3) { dst = (bf16_t*)(p.ws + OFF_R1); ld = 672; cb = nt * 256; lim = 672; }
        else if (nt < 9) { dst = (bf16_t*)(p.ws + OFF_R2); ld = 1536; cb = (nt - 3) * 256; lim = 1536; }
        else { dst = (bf16_t*)(p.ws + OFF_R3); ld = 1920; cb = (nt - 9) * 256; lim = 1920; }
#pragma unroll
        for (int m = 0; m < 8; ++m) {
            const size_t row = (size_t)mt * 256 + wr * 128 + m * 16 + fr;
#pragma unroll
            for (int n = 0; n < 4; ++n) {
                const int col = cb + wc * 64 + n * 16 + fq * 4;
                if (col < lim) { uint2 o; o.x = pk_bf16(acc[m][n][0], acc[m][n][1]); o.y = pk_bf16(acc[m][n][2], acc[m][n][3]); *(uint2*)(dst + row * ld + col) = o; }
            }
        }
    }
}

__device__ __forceinline__ void unpack8(const uint4 u, float (&f)[8]) {
    f[0] = bf_lo(u.x); f[1] = bf_hi(u.x); f[2] = bf_lo(u.y); f[3] = bf_hi(u.y); f[4] = bf_lo(u.z); f[5] = bf_hi(u.z); f[6] = bf_lo(u.w); f[7] = bf_hi(u.w);
}
__device__ __forceinline__ void p2a_phase(const Params& pin, int l) {
    const Params p = launder(pin); l = launder_i(l);
    const int tid = ltid(), wid = tid >> 6, lane = tid & 63;
    const bf16_t* Hm = (const bf16_t*)(p.ws + OFF_R1);
    const bf16_t* Hc = (const bf16_t*)(p.ws + OFF_R2);
    bf16_t* CV = (bf16_t*)(p.ws + OFF_R5);
    bf16_t* KR = (bf16_t*)(p.ws + OFF_KR);
    float* RSQ = (float*)(p.ws + OFF_RSQ);
    float* RSKV = (float*)(p.ws + OFF_RSKV);
    const float* rope = (const float*)(p.ws + OFF_ROPE);
    const float* cw = p.conv_w + (size_t)l * 3 * 512;
    const int c0 = lane * 8;
    float w0[8], w1[8], w2[8];
#pragma unroll
    for (int i = 0; i < 8; ++i) { w0[i] = cw[c0 + i]; w1[i] = cw[512 + c0 + i]; w2[i] = cw[1024 + c0 + i]; }
    for (int row = blockIdx.x * 8 + wid; row < MROWS; row += gridDim.x * 8) {
        const int pp = row % TPB;
        const bool hp = (pp != 0 && pp != CTXL), hn = (pp != CTXL - 1 && pp != TPB - 1);
        const bf16_t* hr = Hc + (size_t)row * 1536;
        float ch[8], cc[8], cb[8], u0[8], u1[8], u2[8];
        unpack8(*(const uint4*)(hr + c0), ch); unpack8(*(const uint4*)(hr + 1024 + c0), cc); unpack8(*(const uint4*)(hr + 512 + c0), cb);
#pragma unroll
        for (int i = 0; i < 8; ++i) u1[i] = cc[i] * ch[i];
        if (hp) { unpack8(*(const uint4*)(hr - 1536 + c0), ch); unpack8(*(const uint4*)(hr - 1536 + 1024 + c0), cc);
#pragma unroll
            for (int i = 0; i < 8; ++i) u0[i] = cc[i] * ch[i]; }
        else {
#pragma unroll
            for (int i = 0; i < 8; ++i) u0[i] = 0.f; }
        if (hn) { unpack8(*(const uint4*)(hr + 1536 + c0), ch); unpack8(*(const uint4*)(hr + 1536 + 1024 + c0), cc);
#pragma unroll
            for (int i = 0; i < 8; ++i) u2[i] = cc[i] * ch[i]; }
        else {
#pragma unroll
            for (int i = 0; i < 8; ++i) u2[i] = 0.f; }
        float o[8];
#pragma unroll
        for (int i = 0; i < 8; ++i) o[i] = cb[i] * (u0[i] * w0[i] + u1[i] * w1[i] + u2[i] * w2[i]);
        uint4 ov; ov.x = pk_bf16(o[0], o[1]); ov.y = pk_bf16(o[2], o[3]); ov.z = pk_bf16(o[4], o[5]); ov.w = pk_bf16(o[6], o[7]);
        *(uint4*)(CV + (size_t)row * 512 + c0) = ov;
        const bf16_t* hm = Hm + (size_t)row * 672;
        float sq = 0.f, skv = 0.f;
        if (lane < 48) { float f[8]; unpack8(*(const uint4*)(hm + lane * 8), f);
#pragma unroll
            for (int i = 0; i < 8; ++i) sq += f[i] * f[i]; }
        if (lane < 32) { float f[8]; unpack8(*(const uint4*)(hm + 384 + lane * 8), f);
#pragma unroll
            for (int i = 0; i < 8; ++i) skv += f[i] * f[i]; }
        sq = wave_sum(sq); skv = wave_sum(skv);
        if (lane == 0) { RSQ[row] = rsqrtf(sq * (1.0f / 384.0f) + 1e-6f); RSKV[row] = rsqrtf(skv * (1.0f / 256.0f) + 1e-6f); }
        {
            const int j = lane & 31;
            float v = bf1(hm[640 + j]);
            const float other = __shfl_xor(v, 8);
            if (pp >= CTXL) {
                const int tt = pp - CTXL;
                const int pos = (j < 16) ? (tt >> 6) : (tt & 63);
                const float cs = rope[(pos * 8 + (j & 7)) * 2], sn = rope[(pos * 8 + (j & 7)) * 2 + 1];
                v = (j & 8) ? (other * sn + v * cs) : (v * cs - other * sn);
            }
            if (lane < 32) KR[(size_t)row * 32 + j] = (bf16_t)(pk_bf16(v, v) & 0xffffu);
        }
    }
}

__device__ __forceinline__ void p2b_phase(const Params& pin, int l, unsigned char* lds) {
    const Params p = launder(pin); l = launder_i(l); const int tid = ltid();
    const bf16_t* Hm = (const bf16_t*)(p.ws + OFF_R1);
    const bf16_t* W = (const bf16_t*)(p.ws + OFF_W);
    const float* RSQ = (const float*)(p.ws + OFF_RSQ);
    const float* RSKV = (const float*)(p.ws + OFF_RSKV);
    const float* rope = (const float*)(p.ws + OFF_ROPE);
    bf16_t* Q = (bf16_t*)(p.ws + OFF_Q);
    bf16_t* KN = (bf16_t*)(p.ws + OFF_KN);
    bf16_t* VT = (bf16_t*)(p.ws + OFF_VT);
    const int lane = tid & 63, wid = tid >> 6, wr = wid >> 1, wc = wid & 1, fr = lane & 15, fq = lane >> 4;
    const int NQ = 144 * 6, NKV = 144 * 8;
    for (int t = blockIdx.x; t < NQ + NKV; t += gridDim.x) {
        f32x4 acc[4][4]; zero_acc<4>(acc);
        if (t < NQ) {
            int mt, nt; tile_mn(t, 6, mt, nt);
            gemm_mainloop<4, 1>(acc, Hm + (size_t)mt * 256 * 672, 672, 64, W + WO_UQ + (size_t)nt * 128 * 384, 384, 6, lds, tid);
            const int pp0 = (mt % 9) * 256; const bool latent = pp0 >= CTXL;
#pragma unroll
            for (int m = 0; m < 4; ++m) {
                const int lrow = wr * 64 + m * 16 + fr;
                const size_t row = (size_t)mt * 256 + lrow;
                const float sc = RSQ[row] * QSCALE;
                const int tt = pp0 + lrow - CTXL;
#pragma unroll
                for (int n = 0; n < 4; ++n) {
                    const int c16 = nt * 128 + wc * 64 + n * 16, r96 = c16 % 96;
                    float v[4];
#pragma unroll
                    for (int j = 0; j < 4; ++j) v[j] = acc[m][n][j] * sc;
                    if (latent && r96 >= 64) {
                        const int pos = (r96 == 64) ? (tt >> 6) : (tt & 63);
#pragma unroll
                        for (int j = 0; j < 4; ++j) {
                            const float other = __shfl_xor(v[j], 32);
                            const int fi = (fq & 1) * 4 + j;
                            const float cs = rope[(pos * 8 + fi) * 2], sn = rope[(pos * 8 + fi) * 2 + 1];
                            v[j] = (fq & 2) ? (other * sn + v[j] * cs) : (v[j] * cs - other * sn);
                        }
                    }
                    uint2 o; o.x = pk_bf16(v[0], v[1]); o.y = pk_bf16(v[2], v[3]);
                    *(uint2*)(Q + row * 768 + c16 + fq * 4) = o;
                }
            }
        } else {
            int mt, nt; tile_mn(t - NQ, 8, mt, nt);
            gemm_mainloop<4, 2>(acc, Hm + (size_t)mt * 256 * 672 + 384, 672, 64, W + WO_UKV + (size_t)nt * 128 * 256, 256, 4, lds, tid);
            const int b = mt / 9, pp0 = (mt % 9) * 256;
            if (wc == 0) {
#pragma unroll
                for (int m = 0; m < 4; ++m) {
                    const size_t row = (size_t)mt * 256 + wr * 64 + m * 16 + fr;
                    const float sc = RSKV[row];
#pragma unroll
                    for (int n = 0; n < 4; ++n) {
                        uint2 o; o.x = pk_bf16(acc[m][n][0] * sc, acc[m][n][1] * sc); o.y = pk_bf16(acc[m][n][2] * sc, acc[m][n][3] * sc);
                        *(uint2*)(KN + row * 512 + nt * 64 + n * 16 + fq * 4) = o;
                    }
                }
            } else {
#pragma unroll
                for (int m = 0; m < 4; ++m) {
                    const int lrow = wr * 64 + m * 16 + fq * 4;
                    const f32x4 sc = *(const f32x4*)(RSKV + (size_t)mt * 256 + lrow);
#pragma unroll
                    for (int n = 0; n < 4; ++n) {
                        const int dv = n * 16 + fr;
                        uint2 o; o.x = pk_bf16(acc[m][n][0] * sc[0], acc[m][n][1] * sc[1]); o.y = pk_bf16(acc[m][n][2] * sc[2], acc[m][n][3] * sc[3]);
                        *(uint2*)(VT + ((size_t)(b * 8 + nt) * 64 + dv) * TPB + pp0 + lrow) = o;
                    }
                }
            }
        }
    }
    {
        const bf16_t* Hr = (const bf16_t*)(p.ws + OFF_R3);
        bf16_t* SG = (bf16_t*)(p.ws + OFF_SG);
        const float* mu = p.rw_mu + (size_t)l * 1920 + 1792;
        for (int i = blockIdx.x * NTHREADS + tid; i < MROWS * 16; i += gridDim.x * NTHREADS) {
            const int row = i >> 4, c0 = (i & 15) * 8, pp = row % TPB;
            const bool hp = (pp != 0 && pp != CTXL), hn = (pp != CTXL - 1 && pp != TPB - 1);
            const bf16_t* hr = Hr + (size_t)row * 1920 + 1792 + c0;
            float cur[8], pv[8], nx[8];
            unpack8(*(const uint4*)hr, cur);
            if (hp) unpack8(*(const uint4*)(hr - 1920), pv); else {
#pragma unroll
                for (int k = 0; k < 8; ++k) pv[k] = 0.f; }
            if (hn) unpack8(*(const uint4*)(hr + 1920), nx); else {
#pragma unroll
                for (int k = 0; k < 8; ++k) nx[k] = 0.f; }
            float o[8];
#pragma unroll
            for (int k = 0; k < 8; ++k) o[k] = sigmoidf_(cur[k] + (0.5f * (pv[k] + nx[k]) - cur[k]) * mu[c0 + k]);
            uint4 ov; ov.x = pk_bf16(o[0], o[1]); ov.y = pk_bf16(o[2], o[3]); ov.z = pk_bf16(o[4], o[5]); ov.w = pk_bf16(o[6], o[7]);
            *(uint4*)(SG + (size_t)row * 128 + c0) = ov;
        }
    }
}

#define FMAC_BC(acc, coef, s, J) asm("v_fmac_f32_dpp %0, %1, %2 row_newbcast:" #J " row_mask:0xf bank_mask:0xf" : "+v"(acc) : "v"(coef), "v"(s))
#define MUL_BC(dst, coef, s, J) asm("v_mul_f32_dpp %0, %1, %2 row_newbcast:" #J " row_mask:0xf bank_mask:0xf" : "=v"(dst) : "v"(coef), "v"(s))
#define REP16(X) X(0, 0) X(1, 1) X(2, 2) X(3, 3) X(4, 0) X(5, 1) X(6, 2) X(7, 3) X(8, 0) X(9, 1) X(10, 2) X(11, 3) X(12, 0) X(13, 1) X(14, 2) X(15, 3)
constexpr int FSTR = 6 * 64 + 4;
constexpr int CHUNK = 32, NCHUNK = TPB / CHUNK;

__device__ __forceinline__ int scan_pos(int z, int s) { return z == 0 ? s : (s < CTXL ? (CTXL - 1 - s) : (TPB + CTXL - 1 - s)); }

__device__ __forceinline__ void shift4(const bf16_t* hr, bool hp, bool hn, int col, const float* mu, float (&o)[4]) {
    const uint2 c = *(const uint2*)(hr + col);
    uint2 a = make_uint2(0u, 0u), b = make_uint2(0u, 0u);
    if (hp) a = *(const uint2*)(hr - 1920 + col);
    if (hn) b = *(const uint2*)(hr + 1920 + col);
    const f32x4 m = *(const f32x4*)(mu + col);
    const float cv[4] = {bf_lo(c.x), bf_hi(c.x), bf_lo(c.y), bf_hi(c.y)};
    const float av[4] = {bf_lo(a.x), bf_hi(a.x), bf_lo(a.y), bf_hi(a.y)};
    const float bv[4] = {bf_lo(b.x), bf_hi(b.x), bf_lo(b.y), bf_hi(b.y)};
#pragma unroll
    for (int i = 0; i < 4; ++i) o[i] = cv[i] + (0.5f * (av[i] + bv[i]) - cv[i]) * m[i];
}
__device__ __forceinline__ void shift8(const bf16_t* hr, bool hp, bool hn, int col, const float* mu, float (&o)[8]) {
    float cv[8], av[8], bv[8];
    unpack8(*(const uint4*)(hr + col), cv);
    if (hp) unpack8(*(const uint4*)(hr - 1920 + col), av); else {
#pragma unroll
        for (int i = 0; i < 8; ++i) av[i] = 0.f; }
    if (hn) unpack8(*(const uint4*)(hr + 1920 + col), bv); else {
#pragma unroll
        for (int i = 0; i < 8; ++i) bv[i] = 0.f; }
#pragma unroll
    for (int i = 0; i < 8; ++i) o[i] = cv[i] + (0.5f * (av[i] + bv[i]) - cv[i]) * mu[col + i];
}
__device__ __forceinline__ bf16x8 pack8(const float (&f)[8]) {
    union { uint4 u; bf16x8 v; } r;
    r.u.x = pk_bf16(f[0], f[1]); r.u.y = pk_bf16(f[2], f[3]); r.u.z = pk_bf16(f[4], f[5]); r.u.w = pk_bf16(f[6], f[7]);
    return r.v;
}

struct ProdState { f32x4 aw[4], aa[4]; };
struct Raw3x2 { uint2 c, a, b; };
__device__ __forceinline__ Raw3x2 ld3x2(const bf16_t* pc, const bf16_t* pa, const bf16_t* pb, bool hp, bool hn, int col) {
    Raw3x2 r; r.c = *(const uint2*)(pc + col); r.a = *(const uint2*)(pa + col); r.b = *(const uint2*)(pb + col);
    if (!hp) r.a = make_uint2(0u, 0u);
    if (!hn) r.b = make_uint2(0u, 0u);
    return r;
}
__device__ __forceinline__ void sh4(const Raw3x2& r, const f32x4 m, float (&o)[4]) {
    const float cv[4] = {bf_lo(r.c.x), bf_hi(r.c.x), bf_lo(r.c.y), bf_hi(r.c.y)};
    const float av[4] = {bf_lo(r.a.x), bf_hi(r.a.x), bf_lo(r.a.y), bf_hi(r.a.y)};
    const float bv[4] = {bf_lo(r.b.x), bf_hi(r.b.x), bf_lo(r.b.y), bf_hi(r.b.y)};
#pragma unroll
    for (int i = 0; i < 4; ++i) o[i] = cv[i] + (0.5f * (av[i] + bv[i]) - cv[i]) * m[i];
}
struct Raw3x4 { uint4 c, a, b; };
__device__ __forceinline__ Raw3x4 ld3x4(const bf16_t* pc, const bf16_t* pa, const bf16_t* pb, bool hp, bool hn, int col) {
    Raw3x4 r; r.c = *(const uint4*)(pc + col); r.a = *(const uint4*)(pa + col); r.b = *(const uint4*)(pb + col);
    if (!hp) r.a = make_uint4(0u, 0u, 0u, 0u);
    if (!hn) r.b = make_uint4(0u, 0u, 0u, 0u);
    return r;
}
__device__ __forceinline__ void sh8(const Raw3x4& r, const float* m, float (&o)[8]) {
    float cv[8], av[8], bv[8];
    unpack8(r.c, cv); unpack8(r.a, av); unpack8(r.b, bv);
    const f32x4 m0 = *(const f32x4*)m, m1 = *(const f32x4*)(m + 4);
#pragma unroll
    for (int i = 0; i < 8; ++i) o[i] = cv[i] + (0.5f * (av[i] + bv[i]) - cv[i]) * (i < 4 ? m0[i] : m1[i - 4]);
}
template <int N0>
__device__ __forceinline__ void scan_produce_elem(const float* pl, int fq, const Raw3x2 (&rr)[2], const Raw3x2 (&rk)[2], const Raw3x2 (&rv)[2],
                                                  const f32x4 (&aw)[2], const f32x4 (&aa)[2], float& ss, float* frow) {
#pragma unroll
    for (int nn = 0; nn < 2; ++nn) {
        const int n = N0 + nn;
        const int c4 = n * 16 + fq * 4;
        float r4[4], k4[4], v4[4];
        sh4(rr[nn], *(const f32x4*)(pl + 0 * 64 + c4), r4);
        sh4(rk[nn], *(const f32x4*)(pl + 1 * 64 + c4), k4);
        sh4(rv[nn], *(const f32x4*)(pl + 2 * 64 + c4), v4);
        const f32x4 w0 = *(const f32x4*)(pl + 3 * 64 + c4);
        const f32x4 a0 = *(const f32x4*)(pl + 4 * 64 + c4);
        const f32x4 kkp = *(const f32x4*)(pl + 5 * 64 + c4);
        const f32x4 kap = *(const f32x4*)(pl + 6 * 64 + c4);
        f32x4 dw, kd, kf4, a4;
#pragma unroll
        for (int j = 0; j < 4; ++j) {
            const float x = -(aw[nn][j] + w0[j]);
            const float sp = fmaxf(x, 0.f) + __logf(1.0f + __expf(-fabsf(x)));
            const float wl = -sp - 0.5f;
            dw[j] = __expf(-__expf(wl));
            const float a = __builtin_amdgcn_rcpf(1.0f + __expf(-(aa[nn][j] + a0[j])));
            a4[j] = a;
            const float kf = k4[j] * kkp[j];
            kf4[j] = kf; ss += kf * kf;
            kd[j] = k4[j] * (1.0f + (a - 1.0f) * kap[j]);
        }
        *(f32x4*)(frow + 0 * 64 + c4) = kf4;
        *(f32x4*)(frow + 1 * 64 + c4) = dw;
        *(f32x4*)(frow + 2 * 64 + c4) = a4;
        *(f32x4*)(frow + 3 * 64 + c4) = kd;
        *(f32x4*)(frow + 4 * 64 + c4) = (f32x4){r4[0], r4[1], r4[2], r4[3]};
        *(f32x4*)(frow + 5 * 64 + c4) = (f32x4){v4[0], v4[1], v4[2], v4[3]};
    }
}
__device__ __forceinline__ void scan_produce_A(const Params& p, const float* pl, int b, int h, int z, int s0, float* frow0, int lane, ProdState& st) {
    const int fr = lane & 15, fq = lane >> 4;
    const int pp = scan_pos(z, s0 + fr);
    const bool hp = (pp != 0 && pp != CTXL), hn = (pp != CTXL - 1 && pp != TPB - 1);
    const bf16_t* hr = (const bf16_t*)(p.ws + OFF_R3) + ((size_t)b * TPB + pp) * 1920;
    const bf16_t* W = (const bf16_t*)(p.ws + OFF_W);
    Raw3x4 qw[2], qa[2];
    const bf16_t* pc = hr + z * 64 + fq * 8; const bf16_t* pa = hp ? pc - 1920 : pc; const bf16_t* pb = hn ? pc + 1920 : pc;
#pragma unroll
    for (int ks = 0; ks < 2; ++ks) { qw[ks] = ld3x4(pc, pa, pb, hp, hn, 1536 + ks * 32); qa[ks] = ld3x4(pc, pa, pb, hp, hn, 1664 + ks * 32); }
    f32x4 accw[4], acca[4];
#pragma unroll
    for (int n = 0; n < 4; ++n) { accw[n] = (f32x4){0.f, 0.f, 0.f, 0.f}; acca[n] = (f32x4){0.f, 0.f, 0.f, 0.f}; }
#pragma unroll
    for (int ks = 0; ks < 2; ++ks) {
        bf16x8 bw[4], ba[4];
#pragma unroll
        for (int n = 0; n < 4; ++n) {
            const size_t wo = ((size_t)z * 512 + h * 64 + n * 16 + fr) * 64 + ks * 32 + fq * 8;
            bw[n] = *(const bf16x8*)(W + WO_UP + wo); ba[n] = *(const bf16x8*)(W + WO_AUP + wo);
        }
        float t8[8];
        sh8(qw[ks], pl + 7 * 64 + ks * 32 + fq * 8, t8);
#pragma unroll
        for (int i = 0; i < 8; ++i) { const float e = __expf(2.0f * t8[i]); t8[i] = 1.0f - 2.0f * __builtin_amdgcn_rcpf(e + 1.0f); }
        const bf16x8 aw = pack8(t8);
        sh8(qa[ks], pl + 8 * 64 + ks * 32 + fq * 8, t8);
        const bf16x8 aa = pack8(t8);
#pragma unroll
        for (int n = 0; n < 4; ++n) {
            accw[n] = __builtin_amdgcn_mfma_f32_16x16x32_bf16(bw[n], aw, accw[n], 0, 0, 0);
            acca[n] = __builtin_amdgcn_mfma_f32_16x16x32_bf16(ba[n], aa, acca[n], 0, 0, 0);
        }
    }
#pragma unroll
    for (int n = 0; n < 4; ++n) { st.aw[n] = accw[n]; st.aa[n] = acca[n]; }
}
__device__ __forceinline__ void scan_produce_B(const Params& p, const float* pl, int b, int h, int z, int s0, float* frow0, int lane, const ProdState& st) {
    const int fr = lane & 15, fq = lane >> 4;
    const int pp = scan_pos(z, s0 + fr);
    const bool hp = (pp != 0 && pp != CTXL), hn = (pp != CTXL - 1 && pp != TPB - 1);
    const bf16_t* hr = (const bf16_t*)(p.ws + OFF_R3) + ((size_t)b * TPB + pp) * 1920;
    Raw3x2 rr0[2], rk0[2], rv0[2], rr1[2], rk1[2], rv1[2];
    const bf16_t* pc = hr + h * 64 + fq * 4; const bf16_t* pa = hp ? pc - 1920 : pc; const bf16_t* pb = hn ? pc + 1920 : pc;
#pragma unroll
    for (int nn = 0; nn < 2; ++nn) {
        const int C4 = nn * 16, C5 = C4 + 32;
        rr0[nn] = ld3x2(pc, pa, pb, hp, hn, C4); rk0[nn] = ld3x2(pc, pa, pb, hp, hn, 512 + C4); rv0[nn] = ld3x2(pc, pa, pb, hp, hn, 1024 + C4);
        rr1[nn] = ld3x2(pc, pa, pb, hp, hn, C5); rk1[nn] = ld3x2(pc, pa, pb, hp, hn, 512 + C5); rv1[nn] = ld3x2(pc, pa, pb, hp, hn, 1024 + C5);
    }
    float ss = 0.f;
    float* frow = frow0 + fr * FSTR;
    const f32x4 w01[2] = {st.aw[0], st.aw[1]}, a01[2] = {st.aa[0], st.aa[1]}, w23[2] = {st.aw[2], st.aw[3]}, a23[2] = {st.aa[2], st.aa[3]};
    scan_produce_elem<0>(pl, fq, rr0, rk0, rv0, w01, a01, ss, frow);
    scan_produce_elem<2>(pl, fq, rr1, rk1, rv1, w23, a23, ss, frow);
    ss = fqsum(ss);
    const float inv = rsqrtf(fmaxf(ss, 1e-24f));
#pragma unroll
    for (int n = 0; n < 4; ++n) {
        const int c4 = n * 16 + fq * 4;
        f32x4 kk = *(const f32x4*)(frow + 0 * 64 + c4);
        f32x4 bb = *(const f32x4*)(frow + 2 * 64 + c4);
#pragma unroll
        for (int j = 0; j < 4; ++j) { kk[j] = kk[j] * inv; bb[j] = kk[j] * bb[j]; }
        *(f32x4*)(frow + 0 * 64 + c4) = kk;
        *(f32x4*)(frow + 2 * 64 + c4) = bb;
    }
}

typedef float f32x2 __attribute__((ext_vector_type(2)));
struct ScanHead { f32x4 kk[2]; f32x2 v; };
struct ScanBody { f32x4 w[2], bb[2], kd[2], r[2]; };
__device__ __forceinline__ void scan_ldh(ScanHead& c, const float* f, const float* fv) {
#pragma unroll
    for (int q = 0; q < 2; ++q) c.kk[q] = *(const f32x4*)(f + 0 * 64 + 4 * q);
    c.v = *(const f32x2*)fv;
}
__device__ __forceinline__ void scan_ldb(ScanBody& c, const float* f) {
#pragma unroll
    for (int q = 0; q < 2; ++q) {
        c.w[q] = *(const f32x4*)(f + 1 * 64 + 4 * q); c.bb[q] = *(const f32x4*)(f + 2 * 64 + 4 * q);
        c.kd[q] = *(const f32x4*)(f + 3 * 64 + 4 * q); c.r[q] = *(const f32x4*)(f + 4 * 64 + 4 * q);
    }
}
__device__ __forceinline__ void scan_unit(const Params& p, int l, int u, unsigned char* lds) {
    const int tid = ltid(), wid = __builtin_amdgcn_readfirstlane(tid >> 6), lane = tid & 63;
    const int b = u >> 4, h = (u >> 1) & 7, z = u & 1;
    float* fb = (float*)lds;
    bf16_t* Y = (bf16_t*)(p.ws + (z == 0 ? OFF_YF : OFF_YB));
    float* pl = fb + 3 * CHUNK * FSTR;
    for (int i = tid; i < 9 * 64; i += NTHREADS) {
        const int a = i >> 6, c = i & 63, C = h * 64 + c;
        float v;
        if (a < 3) v = p.rw_mu[(size_t)l * 1920 + a * 512 + C];
        else if (a == 3) v = p.rw_w0[((size_t)l * 2 + z) * 512 + C];
        else if (a == 4) v = p.rw_a0[((size_t)l * 2 + z) * 512 + C];
        else if (a == 5) v = p.rw_k_k[(size_t)l * 512 + C];
        else if (a == 6) v = p.rw_k_a[(size_t)l * 512 + C];
        else if (a == 7) v = p.rw_mu[(size_t)l * 1920 + 1536 + z * 64 + c];
        else v = p.rw_mu[(size_t)l * 1920 + 1664 + z * 64 + c];
        pl[i] = v;
    }
    __syncthreads();
    if (wid < 4) {
        f32x2 S2[8];
#pragma unroll
        for (int j = 0; j < 8; ++j) S2[j] = (f32x2){0.f, 0.f};
        __syncthreads();
        for (int c = 0; c < NCHUNK; ++c) {
            const float* fbc = fb + (c % 3) * CHUNK * FSTR + 8 * (lane & 7);
            const float* fbv = fb + (c % 3) * CHUNK * FSTR + 320 + 16 * wid + 2 * (lane >> 3);
            bf16_t* yp = Y + ((size_t)b * TPB) * 512 + h * 64 + 16 * wid + 2 * (lane >> 3);
            ScanHead ha, hb;
            scan_ldh(ha, fbc, fbv);
#define SCAN_STEP(HC, HN, SL) { \
                ScanBody bd; scan_ldb(bd, fbc + (SL) * FSTR); \
                if ((SL) + 1 < CHUNK) scan_ldh(HN, fbc + ((SL) + 1) * FSTR, fbv + ((SL) + 1) * FSTR); \
                f32x2 d0 = (f32x2){0.f, 0.f}, d1 = (f32x2){0.f, 0.f}; \
                _Pragma("unroll") for (int q = 0; q < 4; ++q) { const f32x2 k2 = (f32x2){HC.kk[q >> 1][2 * (q & 1)], HC.kk[q >> 1][2 * (q & 1) + 1]}; \
                    d0 = __builtin_elementwise_fma(S2[q], k2, d0); d1 = __builtin_elementwise_fma(S2[4 + q], k2, d1); } \
                const float sk0 = red8(d0[0] + d0[1]), sk1 = red8(d1[0] + d1[1]); \
                const f32x2 n0 = (f32x2){-sk0, -sk0}, n1 = (f32x2){-sk1, -sk1}, v0 = (f32x2){HC.v[0], HC.v[0]}, v1 = (f32x2){HC.v[1], HC.v[1]}; \
                f32x2 y0 = (f32x2){0.f, 0.f}, y1 = (f32x2){0.f, 0.f}; \
                _Pragma("unroll") for (int q = 0; q < 4; ++q) { \
                    const f32x2 w2 = (f32x2){bd.w[q >> 1][2 * (q & 1)], bd.w[q >> 1][2 * (q & 1) + 1]}, b2 = (f32x2){bd.bb[q >> 1][2 * (q & 1)], bd.bb[q >> 1][2 * (q & 1) + 1]}; \
                    const f32x2 kd2 = (f32x2){bd.kd[q >> 1][2 * (q & 1)], bd.kd[q >> 1][2 * (q & 1) + 1]}, r2 = (f32x2){bd.r[q >> 1][2 * (q & 1)], bd.r[q >> 1][2 * (q & 1) + 1]}; \
                    f32x2 t0 = S2[q] * w2; t0 = __builtin_elementwise_fma(b2, n0, t0); t0 = __builtin_elementwise_fma(kd2, v0, t0); \
                    f32x2 t1 = S2[4 + q] * w2; t1 = __builtin_elementwise_fma(b2, n1, t1); t1 = __builtin_elementwise_fma(kd2, v1, t1); \
                    S2[q] = t0; S2[4 + q] = t1; \
                    y0 = __builtin_elementwise_fma(t0, r2, y0); y1 = __builtin_elementwise_fma(t1, r2, y1); } \
                const float ya = red8(y0[0] + y0[1]), yb = red8(y1[0] + y1[1]); \
                const int pp = scan_pos(z, c * CHUNK + (SL)); \
                if ((lane & 7) == 0) *(unsigned*)(yp + (size_t)pp * 512) = pk_bf16(ya, yb); }
#pragma unroll 1
            for (int sl = 0; sl < CHUNK; sl += 2) {
                SCAN_STEP(ha, hb, sl)
                SCAN_STEP(hb, ha, sl + 1)
            }
            __syncthreads();
        }
    } else {
        ProdState st;
#pragma unroll
        for (int n = 0; n < 4; ++n) { st.aw[n] = (f32x4){0.f, 0.f, 0.f, 0.f}; st.aa[n] = (f32x4){0.f, 0.f, 0.f, 0.f}; }
        const int nrep = launder_i(1 + ((PROBE_MASK >> 10) & 1));
        const int pair = (wid - 4) >> 1, ph = (wid - 4) & 1;
        {
            float* f0 = fb + (pair % 3) * CHUNK * FSTR + ph * 16 * FSTR;
            scan_produce_A(p, pl, b, h, z, pair * CHUNK + ph * 16, f0, lane, st);
            if (pair == 0) scan_produce_B(p, pl, b, h, z, ph * 16, f0, lane, st);
        }
        __syncthreads();
        for (int c = 0; c < NCHUNK; ++c) {
            for (int rr_ = 0; rr_ < nrep; ++rr_) {
            if (pair == ((c + 1) & 1)) {
                if (c + 1 < NCHUNK) scan_produce_B(p, pl, b, h, z, (c + 1) * CHUNK + ph * 16, fb + ((c + 1) % 3) * CHUNK * FSTR + ph * 16 * FSTR, lane, st);
            } else {
                if (c + 2 < NCHUNK) scan_produce_A(p, pl, b, h, z, (c + 2) * CHUNK + ph * 16, fb + ((c + 2) % 3) * CHUNK * FSTR + ph * 16 * FSTR, lane, st);
            }
            }
            __syncthreads();
        }
    }
}

constexpr int ATT_STAGE = 20480;
__device__ __forceinline__ void attn_unit(const Params& p, int b, int h, int q0, int nkeys, unsigned char* lds, int do_write) {
    const int tid = ltid(), wid = __builtin_amdgcn_readfirstlane(tid >> 6), lane = tid & 63, fr = lane & 15, fq = lane >> 4;
    bf16_t* Q = (bf16_t*)(p.ws + OFF_Q);
    const bf16_t* KN = (const bf16_t*)(p.ws + OFF_KN);
    const bf16_t* KR = (const bf16_t*)(p.ws + OFF_KR);
    const bf16_t* VT = (const bf16_t*)(p.ws + OFF_VT);
    const size_t rb = (size_t)b * TPB;
    bf16x8 qf[2][3];
#pragma unroll
    for (int nq = 0; nq < 2; ++nq)
#pragma unroll
        for (int ks = 0; ks < 3; ++ks) qf[nq][ks] = *(const bf16x8*)(Q + (rb + q0 + wid * 32 + nq * 16 + fr) * 768 + h * 96 + ks * 32 + fq * 8);
    f32x4 oacc[4][2];
#pragma unroll
    for (int mt = 0; mt < 4; ++mt)
#pragma unroll
        for (int nq = 0; nq < 2; ++nq) oacc[mt][nq] = (f32x4){0.f, 0.f, 0.f, 0.f};
    float mrun[2] = {0.f, 0.f}, lsum[2] = {0.f, 0.f};
    const int c8 = (lane & 7) ^ ((4 * wid + (lane >> 4)) & 7);
    const bf16_t* knp = KN + (rb + 8 * wid + (lane >> 3)) * 512 + h * 64 + c8 * 8;
    const bf16_t* vtp = VT + ((size_t)(b * 8 + h) * 64 + 8 * wid + (lane >> 3)) * TPB + c8 * 8;
    const int c4 = (lane & 3) ^ ((lane >> 4) & 3);
    const bf16_t* krp = KR + (rb + 16 * (wid & 3) + (lane >> 2)) * 32 + c4 * 8;
    auto issue = [&](int t, int stg) {
        unsigned char* base = lds + stg * ATT_STAGE;
        const int k0 = t * 64;
        __builtin_amdgcn_global_load_lds((const GLB_AS unsigned*)(knp + (size_t)k0 * 512), (LDS_AS unsigned*)(base + wid * 1024), 16, 0, 0);
        __builtin_amdgcn_global_load_lds((const GLB_AS unsigned*)(vtp + k0), (LDS_AS unsigned*)(base + 12288 + wid * 1024), 16, 0, 0);
        if (wid < 4) __builtin_amdgcn_global_load_lds((const GLB_AS unsigned*)(krp + (size_t)k0 * 32), (LDS_AS unsigned*)(base + 8192 + wid * 1024), 16, 0, 0);
    };
    const int ntile = nkeys / 64;
    const int kz = fr >> 1, rz = (fr >> 2) & 3;
    issue(0, 0);
    asm volatile("s_waitcnt vmcnt(0)" ::: "memory");
    __builtin_amdgcn_s_barrier();
    asm volatile("" ::: "memory");
    for (int t = 0; t < ntile; ++t) {
        if (t + 1 < ntile) issue(t + 1, (t + 1) & 1);
        const unsigned char* Ks = lds + (t & 1) * ATT_STAGE;
        const unsigned char* Rs = Ks + 8192;
        const unsigned char* Vs = Ks + 12288;
        f32x4 sacc[4][2];
#pragma unroll
        for (int km = 0; km < 4; ++km)
#pragma unroll
            for (int nq = 0; nq < 2; ++nq) sacc[km][nq] = (f32x4){-mrun[nq], -mrun[nq], -mrun[nq], -mrun[nq]};
#pragma unroll
        for (int ks = 0; ks < 3; ++ks)
#pragma unroll
            for (int km = 0; km < 4; ++km) {
                const bf16x8 kf = ks < 2 ? *(const bf16x8*)(Ks + (km * 16 + fr) * 128 + (((ks * 4 + fq) ^ kz) * 16))
                                         : *(const bf16x8*)(Rs + (km * 16 + fr) * 64 + ((fq ^ rz) * 16));
#pragma unroll
                for (int nq = 0; nq < 2; ++nq) sacc[km][nq] = __builtin_amdgcn_mfma_f32_16x16x32_bf16(kf, qf[nq][ks], sacc[km][nq], 0, 0, 0);
            }
        float delta[2];
#pragma unroll
        for (int nq = 0; nq < 2; ++nq) {
            float mx = -1e30f;
#pragma unroll
            for (int km = 0; km < 4; ++km)
#pragma unroll
                for (int j = 0; j < 4; ++j) mx = fmaxf(mx, sacc[km][nq][j]);
            mx = fqmax(mx);
            delta[nq] = (t == 0) ? mx : fmaxf(mx, 0.f);
        }
        const bool exact = (t == 0) || (__builtin_amdgcn_ballot_w64(fmaxf(delta[0], delta[1]) > 60.0f) != 0ull);
        bf16x8 pf[2][2];
        float psum[2];
#pragma unroll
        for (int nq = 0; nq < 2; ++nq) {
            float ps = 0.f;
            if (exact) {
#pragma unroll
                for (int km = 0; km < 4; ++km)
#pragma unroll
                    for (int j = 0; j < 4; ++j) { const float e = __builtin_amdgcn_exp2f(sacc[km][nq][j] - delta[nq]); sacc[km][nq][j] = e; ps += e; }
            } else {
#pragma unroll
                for (int km = 0; km < 4; ++km)
#pragma unroll
                    for (int j = 0; j < 4; ++j) { const float e = __builtin_amdgcn_exp2f(sacc[km][nq][j]); sacc[km][nq][j] = e; ps += e; }
            }
            psum[nq] = ps;
#pragma unroll
            for (int kc = 0; kc < 2; ++kc) {
                union { uint4 u; bf16x8 v; } r;
                r.u.x = pk_bf16(sacc[2 * kc][nq][0], sacc[2 * kc][nq][1]); r.u.y = pk_bf16(sacc[2 * kc][nq][2], sacc[2 * kc][nq][3]);
                r.u.z = pk_bf16(sacc[2 * kc + 1][nq][0], sacc[2 * kc + 1][nq][1]); r.u.w = pk_bf16(sacc[2 * kc + 1][nq][2], sacc[2 * kc + 1][nq][3]);
                pf[kc][nq] = r.v;
            }
        }
        if (exact) {
#pragma unroll
            for (int nq = 0; nq < 2; ++nq) {
                const float alpha = (t == 0) ? 1.0f : __builtin_amdgcn_exp2f(-delta[nq]);
                lsum[nq] = lsum[nq] * alpha + psum[nq];
#pragma unroll
                for (int mt = 0; mt < 4; ++mt) oacc[mt][nq] = oacc[mt][nq] * alpha;
            }
        }
#pragma unroll
        for (int mt = 0; mt < 4; ++mt)
#pragma unroll
            for (int kc = 0; kc < 2; ++kc) {
                union { uint2 h2[2]; bf16x8 v; } r;
                const unsigned char* vrow = Vs + (mt * 16 + fr) * 128 + (fq & 1) * 8;
                r.h2[0] = *(const uint2*)(vrow + (((4 * kc + (fq >> 1)) ^ kz) * 16));
                r.h2[1] = *(const uint2*)(vrow + (((4 * kc + 2 + (fq >> 1)) ^ kz) * 16));
#pragma unroll
                for (int nq = 0; nq < 2; ++nq) oacc[mt][nq] = __builtin_amdgcn_mfma_f32_16x16x32_bf16(r.v, pf[kc][nq], oacc[mt][nq], 0, 0, 0);
            }
        if (!exact) {
#pragma unroll
            for (int nq = 0; nq < 2; ++nq) {
                const float alpha = __builtin_amdgcn_exp2f(-delta[nq]);
                lsum[nq] = (lsum[nq] + psum[nq]) * alpha;
#pragma unroll
                for (int mt = 0; mt < 4; ++mt) oacc[mt][nq] = oacc[mt][nq] * alpha;
            }
        }
#pragma unroll
        for (int nq = 0; nq < 2; ++nq) mrun[nq] += delta[nq];
        asm volatile("s_waitcnt vmcnt(0) lgkmcnt(0)" ::: "memory");
        __builtin_amdgcn_s_barrier();
        asm volatile("" ::: "memory");
    }
#pragma unroll
    for (int nq = 0; nq < 2; ++nq) {
        const float inv = 1.0f / fqsum(lsum[nq]);
        bf16_t* orow = Q + (rb + q0 + wid * 32 + nq * 16 + fr) * 768 + h * 96;
#pragma unroll
        for (int mt = 0; mt < 4; ++mt) {
            uint2 o; o.x = pk_bf16(oacc[mt][nq][0] * inv, oacc[mt][nq][1] * inv); o.y = pk_bf16(oacc[mt][nq][2] * inv, oacc[mt][nq][3] * inv);
            if (do_write) *(uint2*)(orow + mt * 16 + fq * 4) = o;
        }
    }
}

__device__ __forceinline__ void p3_phase(const Params& pin, int l, unsigned char* lds) {
    const Params p = launder(pin); l = launder_i(l);
    for (int r = 0, nr = launder_i(1 + ((PROBE_MASK >> 1) & 1)); r < nr; ++r)
        for (int u = blockIdx.x; u < 256; u += gridDim.x) scan_unit(p, l, u, lds);
    const int nunits = (l == DEPTH - 1) ? 1024 : 1152;
    for (int r = launder_i(((PROBE_MASK >> 9) & 1) ? 0 : 1); r < 2; ++r)
    for (int u = blockIdx.x; u < nunits; u += gridDim.x) {
        if (u < 1024) { const int bh = u >> 3, qt = u & 7; attn_unit(p, bh >> 3, bh & 7, CTXL + qt * 256, TPB, lds, r); }
        else { const int bh = u - 1024; attn_unit(p, bh >> 3, bh & 7, 0, CTXL, lds, r); }
    }
}

__device__ __forceinline__ void p35_phase(const Params& pin, int l, bool skip_ctx, unsigned char* lds) {
    const Params p = launder(pin); l = launder_i(l); const int tid = ltid();
    const bf16_t* SG = (const bf16_t*)(p.ws + OFF_SG);
    const bf16_t* W = (const bf16_t*)(p.ws + OFF_W) + WO_GUP;
    const bf16_t* YF = (const bf16_t*)(p.ws + OFF_YF);
    const bf16_t* YB = (const bf16_t*)(p.ws + OFF_YB);
    const bf16_t* Hr = (const bf16_t*)(p.ws + OFF_R3);
    bf16_t* RWO = (bf16_t*)(p.ws + OFF_RWO);
    const float* mu = p.rw_mu + (size_t)l * 1920;
    const int lane = tid & 63, wid = tid >> 6, wr = wid >> 1, wc = wid & 1, fr = lane & 15, fq = lane >> 4;
    float* gt = (float*)lds;
    constexpr int GP = 132;
    for (int t = blockIdx.x; t < 288 * 4; t += gridDim.x) {
        int mt, nt; tile_mn(t, 4, mt, nt);
        if (skip_ctx && (mt % 18) < 2) continue;
        f32x4 acc[2][4]; zero_acc<2>(acc);
        gemm_mainloop<2, 1>(acc, SG + (size_t)mt * 128 * 128, 128, 64, W + (size_t)nt * 128 * 128, 128, 2, lds, tid);
#pragma unroll
        for (int m = 0; m < 2; ++m)
#pragma unroll
            for (int n = 0; n < 4; ++n) *(f32x4*)(gt + (wr * 32 + m * 16 + fr) * GP + wc * 64 + n * 16 + fq * 4) = acc[m][n];
        __syncthreads();
        const int pp0 = (mt % 18) * 128;
#pragma unroll 1
        for (int it = 0; it < 4; ++it) {
            const int item = tid + it * NTHREADS, lrow = item >> 4, cg = item & 15, pp = pp0 + lrow;
            const size_t row = (size_t)mt * 128 + lrow;
            const int C = nt * 128 + cg * 8;
            const bool hp = (pp != 0 && pp != CTXL), hn = (pp != CTXL - 1 && pp != TPB - 1);
            const bf16_t* hr = Hr + row * 1920;
            float yf[8], yb[8], r8[8], k8[8], v8[8];
            unpack8(*(const uint4*)(YF + row * 512 + C), yf); unpack8(*(const uint4*)(YB + row * 512 + C), yb);
            shift8(hr, hp, hn, C, mu, r8); shift8(hr, hp, hn, 512 + C, mu, k8); shift8(hr, hp, hn, 1024 + C, mu, v8);
            const float* rkp = p.rw_r_k + (size_t)l * 512 + C;
            float s1 = 0.f, bs = 0.f;
#pragma unroll
            for (int i = 0; i < 8; ++i) { yf[i] += yb[i]; s1 += yf[i]; bs += r8[i] * k8[i] * rkp[i]; }
            s1 = red8(s1); bs = red8(bs);
            const float mean = s1 * (1.0f / 64.0f);
            float s2 = 0.f;
#pragma unroll
            for (int i = 0; i < 8; ++i) { const float d = yf[i] - mean; s2 += d * d; }
            s2 = red8(s2);
            const float rstd = rsqrtf(s2 * (1.0f / 64.0f) + 64e-5f);
            const float* ggp = p.rw_gn_g + (size_t)l * 512 + C; const float* gbp = p.rw_gn_b + (size_t)l * 512 + C;
            const f32x4 g0 = *(const f32x4*)(gt + lrow * GP + cg * 8), g1 = *(const f32x4*)(gt + lrow * GP + cg * 8 + 4);
            float o[8];
#pragma unroll
            for (int i = 0; i < 8; ++i) o[i] = ((yf[i] - mean) * rstd * ggp[i] + gbp[i] + bs * v8[i]) * (i < 4 ? g0[i] : g1[i - 4]);
            uint4 ov; ov.x = pk_bf16(o[0], o[1]); ov.y = pk_bf16(o[2], o[3]); ov.z = pk_bf16(o[4], o[5]); ov.w = pk_bf16(o[6], o[7]);
            *(uint4*)(RWO + row * 512 + C) = ov;
        }
        __syncthreads();
    }
}

__device__ __forceinline__ void p4_phase(const Params& pin, bool skip_ctx, unsigned char* lds) {
    const Params p = launder(pin); const int tid = ltid();
    const bf16_t* XM = (const bf16_t*)(p.ws + OFF_R6);
    const bf16_t* W = (const bf16_t*)(p.ws + OFF_W);
    bf16_t* MG = (bf16_t*)(p.ws + OFF_MRG);
    const int lane = tid & 63, wid = tid >> 6, wr = wid >> 1, wc = wid & 1, fr = lane & 15, fq = lane >> 4;
    for (int t = blockIdx.x; t < 288 * 8; t += gridDim.x) {
        int mt, nt; tile_mn(t, 8, mt, nt);
        if (skip_ctx && (mt % 18) < 2) continue;
        f32x4 g[3][2][4];
#pragma unroll
        for (int i = 0; i < 3; ++i) zero_acc<2>(g[i]);
        gemm_gate3(g, XM + (size_t)mt * 128 * 1024, W + WO_IN + (size_t)(4224 + nt * 128) * 1024, 16, lds, tid);
        typedef __fp16 h16x2 __attribute__((ext_vector_type(2)));
        h16x2 gp[3][2][4][2];
#pragma unroll
        for (int i = 0; i < 3; ++i)
#pragma unroll
            for (int m = 0; m < 2; ++m)
#pragma unroll
                for (int n = 0; n < 4; ++n) {
                    gp[i][m][n][0] = __builtin_amdgcn_cvt_pkrtz(sigmoidf_(g[i][m][n][0]), sigmoidf_(g[i][m][n][1]));
                    gp[i][m][n][1] = __builtin_amdgcn_cvt_pkrtz(sigmoidf_(g[i][m][n][2]), sigmoidf_(g[i][m][n][3]));
                }
        f32x4 mg[2][4]; zero_acc<2>(mg);
#pragma unroll 1
        for (int i = 0; i < 3; ++i) {
            const bf16_t* Ab; int lda, kst; const bf16_t* Wb;
            if (i == 0) { Ab = (const bf16_t*)(p.ws + OFF_Q); lda = 768; kst = 96; Wb = W + WO_OA; }
            else if (i == 1) { Ab = (const bf16_t*)(p.ws + OFF_R5); lda = 512; kst = 64; Wb = W + WO_OC; }
            else { Ab = (const bf16_t*)(p.ws + OFF_RWO); lda = 512; kst = 64; Wb = W + WO_OR; }
            f32x4 a[2][4]; zero_acc<2>(a);
            gemm_mainloop<2, 1>(a, Ab + (size_t)mt * 128 * lda, lda, kst, Wb + (size_t)nt * 128 * 512, 512, 8, lds, tid);
#pragma unroll
            for (int m = 0; m < 2; ++m)
#pragma unroll
                for (int n = 0; n < 4; ++n) {
                    const h16x2 g0 = i == 0 ? gp[0][m][n][0] : (i == 1 ? gp[1][m][n][0] : gp[2][m][n][0]);
                    const h16x2 g1 = i == 0 ? gp[0][m][n][1] : (i == 1 ? gp[1][m][n][1] : gp[2][m][n][1]);
                    mg[m][n][0] += (float)g0[0] * a[m][n][0]; mg[m][n][1] += (float)g0[1] * a[m][n][1];
                    mg[m][n][2] += (float)g1[0] * a[m][n][2]; mg[m][n][3] += (float)g1[1] * a[m][n][3];
                }
        }
#pragma unroll
        for (int m = 0; m < 2; ++m) {
            const size_t row = (size_t)mt * 128 + wr * 32 + m * 16 + fr;
#pragma unroll
            for (int n = 0; n < 4; ++n) {
                uint2 o; o.x = pk_bf16(mg[m][n][0], mg[m][n][1]); o.y = pk_bf16(mg[m][n][2], mg[m][n][3]);
                *(uint2*)(MG + row * 1024 + nt * 128 + wc * 64 + n * 16 + fq * 4) = o;
            }
        }
    }
}

template <int MT>
__device__ __forceinline__ void resid_tile(const Params& p, int l, const bf16_t* A, int lda, int nk, const bf16_t* Wt, int ldb, int goff, bool x_from_input,
                                           const float* lng, const float* lnb, int row0, int nt, unsigned char* lds, int tid) {
    const int lane = tid & 63, wid = tid >> 6, wr = wid >> 1, wc = wid & 1, fr = lane & 15, fq = lane >> 4;
    f32x4 acc[MT][4]; zero_acc<MT>(acc);
    gemm_mainloop<MT, 1>(acc, A + (size_t)row0 * lda, lda, 64, Wt + (size_t)nt * 128 * ldb, ldb, nk, lds, tid);
    const int b = row0 / TPB, pp0 = row0 % TPB;
    const float* gv = modv_ptr(p, l, b, pp0) + goff;
    const float* stats = (const float*)(p.ws + OFF_STATS);
#pragma unroll
    for (int m = 0; m < MT; ++m) {
        const int lr = wr * 16 * MT + m * 16 + fr, pp = pp0 + lr;
        const float* xi = x_rd(p, x_from_input, b, pp);
        float* xo = x_wr(p, b, pp);
        float mean = 0.f, rstd = 1.f;
        if (!x_from_input) { const size_t row = (size_t)row0 + lr; mean = stats[row * 2]; rstd = stats[row * 2 + 1]; }
#pragma unroll
        for (int n = 0; n < 4; ++n) {
            const int col = nt * 128 + wc * 64 + n * 16 + fq * 4;
            f32x4 xv = *(const f32x4*)(xi + col); const f32x4 g4 = *(const f32x4*)(gv + col);
            if (!x_from_input) {
                const f32x4 lg = *(const f32x4*)(lng + col), lb = *(const f32x4*)(lnb + col);
#pragma unroll
                for (int j = 0; j < 4; ++j) xv[j] = (xv[j] - mean) * rstd * lg[j] + lb[j];
            }
            f32x4 o;
#pragma unroll
            for (int j = 0; j < 4; ++j) o[j] = ALPHA * xv[j] + g4[j] * acc[m][n][j];
            *(f32x4*)(xo + col) = o;
        }
    }
}
__device__ __forceinline__ void resid_gemm_phase(const Params& pin, int l, size_t a_off, int lda, int nk, size_t w_off, int ldb, int goff, bool x_from_input, const float* lng, const float* lnb, bool skip_ctx, unsigned char* lds) {
    const Params p = launder(pin); l = launder_i(l);
    const int tid = ltid();
    const bf16_t* A = (const bf16_t*)(p.ws + a_off);
    const bf16_t* Wt = (const bf16_t*)(p.ws + OFF_W) + w_off;
    const int nfull = (gridDim.x == 256) ? 1024 : 144 * 8;
    for (int t = blockIdx.x; t < nfull; t += gridDim.x) {
        int mt, nt; tile_mn(t, 8, mt, nt);
        if (skip_ctx && (mt % 9) == 0) continue;
        resid_tile<4>(p, l, A, lda, nk, Wt, ldb, goff, x_from_input, lng, lnb, mt * 256, nt, lds, tid);
    }
    if (nfull == 1024) {
        int mt, nt; tile_mn(1024 + (blockIdx.x >> 1), 8, mt, nt);
        if (!(skip_ctx && (mt % 9) == 0)) resid_tile<2>(p, l, A, lda, nk, Wt, ldb, goff, x_from_input, lng, lnb, mt * 256 + (blockIdx.x & 1) * 128, nt, lds, tid);
    }
}

__device__ __forceinline__ void ln_phase(const Params& pin, const float* g, const float* bta, int lmod, int shoff, bool write_xmod, bool write_x, bool skip_ctx) {
    const Params p = launder(pin); lmod = launder_i(lmod);
    const int tid = ltid(), wid = tid >> 6, lane = tid & 63;
    bf16_t* xm = (bf16_t*)(p.ws + OFF_R6);
    float* stats = (float*)(p.ws + OFF_STATS);
    for (int row = blockIdx.x * 8 + wid; row < MROWS; row += gridDim.x * 8) {
        const int b = row / TPB, pp = row % TPB;
        if (skip_ctx && pp < CTXL) continue;
        float* xp = x_wr(p, b, pp);
        f32x4 v[4];
        float s = 0.f;
#pragma unroll
        for (int i = 0; i < 4; ++i) { v[i] = *(const f32x4*)(xp + i * 256 + lane * 4); s += (v[i][0] + v[i][1]) + (v[i][2] + v[i][3]); }
        const float mean = wave_sum(s) * (1.0f / 1024.0f);
        float q = 0.f;
#pragma unroll
        for (int i = 0; i < 4; ++i)
#pragma unroll
            for (int j = 0; j < 4; ++j) { const float d = v[i][j] - mean; q += d * d; }
        const float rstd = rsqrtf(wave_sum(q) * (1.0f / 1024.0f) + 1e-5f);
        if (lane == 0) { stats[(size_t)row * 2] = mean; stats[(size_t)row * 2 + 1] = rstd; }
        const float* mv = write_xmod ? modv_ptr(p, lmod, b, pp) + shoff : nullptr;
#pragma unroll
        for (int i = 0; i < 4; ++i) {
            const int c = i * 256 + lane * 4;
            const f32x4 g4 = *(const f32x4*)(g + c), b4 = *(const f32x4*)(bta + c);
            f32x4 o;
#pragma unroll
            for (int j = 0; j < 4; ++j) o[j] = (v[i][j] - mean) * rstd * g4[j] + b4[j];
            if (write_x) *(f32x4*)(xp + c) = o;
            if (write_xmod) {
                const f32x4 sh = *(const f32x4*)(mv + c), sc = *(const f32x4*)(mv + 1024 + c);
                uint2 ov; ov.x = pk_bf16(o[0] * (1.f + sc[0]) + sh[0], o[1] * (1.f + sc[1]) + sh[1]); ov.y = pk_bf16(o[2] * (1.f + sc[2]) + sh[2], o[3] * (1.f + sc[3]) + sh[3]);
                *(uint2*)(xm + (size_t)row * 1024 + c) = ov;
            }
        }
    }
}

__device__ __forceinline__ void p7_phase(const Params& pin, bool skip_ctx, unsigned char* lds) {
    const Params p = launder(pin); const int tid = ltid();
    const bf16_t* A = (const bf16_t*)(p.ws + OFF_R6);
    const bf16_t* W = (const bf16_t*)(p.ws + OFF_W) + WO_13;
    bf16_t* HF = (bf16_t*)(p.ws + OFF_HF);
    const int lane = tid & 63, wid = tid >> 6, wr = wid >> 2, wc = wid & 3, fr = lane & 15, fq = lane >> 4;
    auto seg = [&](int t) { int mt, nt; tile_mn(t, 22, mt, nt); Seg g; g.A = A + (size_t)mt * 256 * 1024; g.Bt = W + (size_t)nt * 256 * 1024; g.lda = 1024; g.a_kstep = 64; g.ldb = 1024; g.nk = 16; return g; };
    auto valid = [&](int t) { int mt, nt; tile_mn(t, 22, mt, nt); return !(skip_ctx && (mt % 9) == 0); };
    auto nextv = [&](int t) { while (t < 144 * 22 && !valid(t)) t += gridDim.x; return t; };
    int st = 0; bool first = true;
    for (int t = nextv(blockIdx.x); t < 144 * 22;) {
        int mt, nt; tile_mn(t, 22, mt, nt);
        const int tn = nextv(t + gridDim.x); const bool hn = tn < 144 * 22;
        f32x4 acc[8][4]; zero_acc<8>(acc);
        gemm_stream256(acc, seg(t), seg(hn ? tn : t), hn, first, st, lds, tid); first = false;
        const int G = nt * 4 + wc;
#pragma unroll
        for (int m = 0; m < 8; ++m) {
            const size_t row = (size_t)mt * 256 + wr * 128 + m * 16 + fr;
#pragma unroll
            for (int n = 0; n < 2; ++n) {
                float o[4];
#pragma unroll
                for (int j = 0; j < 4; ++j) o[j] = siluf_(acc[m][n][j]) * acc[m][n + 2][j];
                uint2 ov; ov.x = pk_bf16(o[0], o[1]); ov.y = pk_bf16(o[2], o[3]);
                *(uint2*)(HF + row * DFF + G * 32 + n * 16 + fq * 4) = ov;
            }
        }
        t = tn;
    }
}

__global__ void __launch_bounds__(NTHREADS) fwd_megakernel(Params p) {
    extern __shared__ __attribute__((aligned(16))) unsigned char lds[];
    cg::grid_group grid = cg::this_grid();
    unsigned* gbar = (unsigned*)(p.ws + OFF_BAR); unsigned epoch = 0;
#define GSYNC() grid_barrier(gbar, epoch)
    if (p.ws == nullptr) grid.sync();
    modv_phase(p, lds);
    convert_layer(p, 0, lds);
    {
        bf16_t* Wm = (bf16_t*)(p.ws + OFF_W) + WO_IN + (size_t)672 * 1024;
        for (int i = blockIdx.x * NTHREADS + threadIdx.x; i < 96 * 1024 / 2; i += gridDim.x * NTHREADS) ((unsigned*)Wm)[i] = 0u;
    }
    GSYNC();
    xmod0_phase(p);
    GSYNC();
#pragma unroll 1
    for (int l = 0; l < DEPTH; ++l) {
        const bool last = (l == DEPTH - 1);
        for (int r = 0, nr = launder_i(1 + ((PROBE_MASK >> 2) & 1)); r < nr; ++r) p1_phase(p, lds);
        GSYNC();
        for (int r = 0, nr = launder_i(1 + ((PROBE_MASK >> 3) & 1)); r < nr; ++r) p2a_phase(p, l);
        GSYNC();
        for (int r = 0, nr = launder_i(1 + ((PROBE_MASK >> 4) & 1)); r < nr; ++r) p2b_phase(p, l, lds);
        GSYNC();
        p3_phase(p, l, lds);
        GSYNC();
        for (int r = 0, nr = launder_i(1 + ((PROBE_MASK >> 5) & 1)); r < nr; ++r) p35_phase(p, l, last, lds);
        GSYNC();
        for (int r = 0, nr = launder_i(1 + ((PROBE_MASK >> 6) & 1)); r < nr; ++r) p4_phase(p, last, lds);
        GSYNC();
        resid_gemm_phase(p, l, OFF_MRG, 1024, 16, WO_OUT, 1024, 2048, l == 0, p.ln2_g + (l > 0 ? l - 1 : 0) * 1024, p.ln2_b + (l > 0 ? l - 1 : 0) * 1024, last, lds);
        GSYNC();
        ln_phase(p, p.ln1_g + l * 1024, p.ln1_b + l * 1024, l, 3072, true, false, last);
        GSYNC();
        for (int r = 0, nr = launder_i(1 + ((PROBE_MASK >> 0) & 1)); r < nr; ++r) p7_phase(p, last, lds);
        GSYNC();
        resid_gemm_phase(p, l, OFF_HF, DFF, 44, WO_2, DFF, 5120, false, p.ln1_g + l * 1024, p.ln1_b + l * 1024, last, lds);
        GSYNC();
        ln_phase(p, p.ln2_g + l * 1024, p.ln2_b + l * 1024, last ? l : l + 1, 0, !last, last, last);
        if (!last) for (int r = 0, nr = launder_i(1 + ((PROBE_MASK >> 7) & 1)); r < nr; ++r) convert_layer(p, l + 1, lds);
        for (int r = 0, nr = launder_i(((PROBE_MASK >> 8) & 1) * 10); r < nr; ++r) GSYNC();
        GSYNC();
    }
}

extern "C" void kernel_launch(void* const* d_in, const int* in_sizes, int n_in, void* d_out,
                              int out_size, void* d_ws, size_t ws_size, hipStream_t stream) {
    static int grid_blocks = 0;
    if (!grid_blocks) {
        int dev = 0, cus = 0, per_cu = 0;
        hipGetDevice(&dev);
        hipDeviceGetAttribute(&cus, hipDeviceAttributeMultiprocessorCount, dev);
        if (hipFuncSetAttribute((const void*)fwd_megakernel, hipFuncAttributeMaxDynamicSharedMemorySize, LDS_BYTES) != hipSuccess)
            fprintf(stderr, "hipFuncSetAttribute failed\n");
        hipOccupancyMaxActiveBlocksPerMultiprocessor(&per_cu, (const void*)fwd_megakernel, NTHREADS, LDS_BYTES);
        if (per_cu < 1) fprintf(stderr, "occupancy query says %d blocks/CU\n", per_cu);
        (void)hipGetLastError();
        grid_blocks = cus > 0 ? cus : 256;
        if (ws_size < WS_END) { fprintf(stderr, "workspace too small: %zu < %zu\n", ws_size, (size_t)WS_END); grid_blocks = -1; }
        if (n_in != 33) { fprintf(stderr, "expected 33 inputs, got %d\n", n_in); grid_blocks = -1; }
    }
    if (grid_blocks < 0) return;
    if (hipMemsetAsync((unsigned char*)d_ws + OFF_BAR, 0, 1024, stream) != hipSuccess) fprintf(stderr, "memset failed\n");
    Params p{};
    const float** pp = (const float**)&p;
    for (int i = 0; i < 33; ++i) pp[i] = (const float*)d_in[i];
    p.out = (float*)d_out;
    p.ws = (unsigned char*)d_ws;
    void* args[] = {&p};
    hipError_t e = hipLaunchCooperativeKernel((void*)fwd_megakernel, dim3(grid_blocks), dim3(NTHREADS), args, LDS_BYTES, stream);
    if (e != hipSuccess) fprintf(stderr, "cooperative launch failed: %s (grid %d)\n", hipGetErrorString(e), grid_blocks);
}
```

```cpp
#include <hip/hip_runtime.h>
#include <hip/hip_cooperative_groups.h>
#include <cstdio>
#include <cstdint>
namespace cg = cooperative_groups;

typedef unsigned short bf16_t;
typedef short bf16x8 __attribute__((ext_vector_type(8)));
typedef float f32x4 __attribute__((ext_vector_type(4)));

#ifndef PROBE_MASK
#define PROBE_MASK 0
#endif
constexpr int BATCH = 16, SEQ = 2048, CTXL = 256, DM = 1024, DEPTH = 4, DFF = 2816, DIN = 7200;
constexpr int TPB = SEQ + CTXL;
constexpr int MROWS = BATCH * TPB;
constexpr int NTHREADS = 512;
constexpr int LDS_BYTES = 152 * 1024;
constexpr float ALPHA = 1.681792830507429f;
constexpr float QSCALE = 0.10206207261596575f * 1.4426950408889634f;

constexpr size_t WO_IN = 0;
constexpr size_t WO_UQ = WO_IN + (size_t)7296 * 1024;
constexpr size_t WO_UKV = WO_UQ + (size_t)768 * 384;
constexpr size_t WO_OA = WO_UKV + (size_t)1024 * 256;
constexpr size_t WO_OC = WO_OA + (size_t)1024 * 512;
constexpr size_t WO_OR = WO_OC + (size_t)1024 * 512;
constexpr size_t WO_OUT = WO_OR + (size_t)1024 * 512;
constexpr size_t WO_13 = WO_OUT + (size_t)1024 * 1024;
constexpr size_t WO_2 = WO_13 + (size_t)5632 * 1024;
constexpr size_t WO_UP = WO_2 + (size_t)1024 * 2816;
constexpr size_t WO_AUP = WO_UP + (size_t)2 * 512 * 64;
constexpr size_t WO_GUP = WO_AUP + (size_t)2 * 512 * 64;
constexpr size_t W_ELEMS = WO_GUP + (size_t)512 * 128;

constexpr size_t al256(size_t x) { return (x + 255) & ~(size_t)255; }
constexpr size_t OFF_BAR = 0;
constexpr size_t OFF_W = 1024;
constexpr size_t OFF_MODV = al256(OFF_W + W_ELEMS * 2);
constexpr size_t OFF_ROPE = al256(OFF_MODV + (size_t)4 * 17 * 6144 * 4);
constexpr size_t OFF_RSQ = al256(OFF_ROPE + 64 * 8 * 2 * 4);
constexpr size_t OFF_RSKV = al256(OFF_RSQ + (size_t)MROWS * 4);
constexpr size_t OFF_STATS = al256(OFF_RSKV + (size_t)MROWS * 4);
constexpr size_t OFF_XC = al256(OFF_STATS + (size_t)MROWS * 8);
constexpr size_t OFF_R1 = al256(OFF_XC + (size_t)BATCH * CTXL * DM * 4);
constexpr size_t OFF_R2 = al256(OFF_R1 + (size_t)MROWS * 672 * 2);
constexpr size_t OFF_R3 = OFF_R2 + (size_t)MROWS * 1536 * 2;
constexpr size_t OFF_R4 = al256(OFF_R3 + (size_t)MROWS * 1920 * 2);
constexpr size_t OFF_R5 = al256(OFF_R4 + (size_t)MROWS * (512 + 512 + 32) * 2);
constexpr size_t OFF_R6 = al256(OFF_R5 + (size_t)MROWS * 512 * 2);
constexpr size_t WS_END = al256(OFF_R6 + (size_t)MROWS * 1024 * 2);
constexpr size_t OFF_Q = OFF_R2;
constexpr size_t OFF_YF = OFF_R2 + (size_t)MROWS * 768 * 2;
constexpr size_t OFF_SG = OFF_YF + (size_t)MROWS * 512 * 2;
constexpr size_t OFF_YB = OFF_R1;
constexpr size_t OFF_KN = OFF_R4;
constexpr size_t OFF_VT = OFF_R4 + (size_t)MROWS * 512 * 2;
constexpr size_t OFF_KR = OFF_VT + (size_t)MROWS * 512 * 2;
constexpr size_t OFF_RWO = OFF_R4;
constexpr size_t OFF_MRG = OFF_R3;
constexpr size_t OFF_HF = OFF_R2;
static_assert(OFF_SG + (size_t)MROWS * 128 * 2 <= OFF_R3, "R2 overlay overflow");
static_assert((size_t)MROWS * 2816 * 2 <= OFF_R4 - OFF_R2, "HF overflow");

struct Params {
    const float *x, *c, *ctx, *c_ctx, *mod_w, *mod_b, *w_in, *q_norm, *w_uq, *kv_norm, *w_ukv, *w_o_attn,
        *conv_w, *w_o_conv, *rw_mu, *rw_w0, *rw_w_up, *rw_a0, *rw_a_up, *rw_g_up, *rw_k_k, *rw_k_a,
        *rw_r_k, *rw_gn_g, *rw_gn_b, *w_o_rwkv, *w_out, *ln1_g, *ln1_b, *ffn_w13, *ffn_w2, *ln2_g, *ln2_b;
    float* out;
    unsigned char* ws;
};

typedef __attribute__((address_space(1))) unsigned char gchar_t;
typedef __attribute__((address_space(1))) float gfloat_t;
__device__ __forceinline__ Params launder(const Params& a) {
    Params q = a;
    unsigned long long w = (unsigned long long)a.ws, o = (unsigned long long)a.out;
    unsigned wl = __builtin_amdgcn_readfirstlane((unsigned)w), wh = __builtin_amdgcn_readfirstlane((unsigned)(w >> 32));
    unsigned ol = __builtin_amdgcn_readfirstlane((unsigned)o), oh = __builtin_amdgcn_readfirstlane((unsigned)(o >> 32));
    asm volatile("" : "+s"(wl), "+s"(wh), "+s"(ol), "+s"(oh));
    w = ((unsigned long long)wh << 32) | wl; o = ((unsigned long long)oh << 32) | ol;
    q.ws = (unsigned char*)(gchar_t*)w; q.out = (float*)(gfloat_t*)o;
    return q;
}
__device__ __forceinline__ int launder_i(int v) { v = __builtin_amdgcn_readfirstlane(v); asm volatile("" : "+s"(v)); return v; }
__device__ __forceinline__ int ltid() { int t = threadIdx.x; asm volatile("" : "+v"(t)); return t; }
__device__ __forceinline__ unsigned pk_bf16(float lo, float hi) { unsigned r; asm("v_cvt_pk_bf16_f32 %0, %1, %2" : "=v"(r) : "v"(lo), "v"(hi)); return r; }
__device__ __forceinline__ float bf_lo(unsigned u) { return __uint_as_float(u << 16); }
__device__ __forceinline__ float bf_hi(unsigned u) { return __uint_as_float(u & 0xffff0000u); }
__device__ __forceinline__ float bf1(bf16_t h) { return __uint_as_float(((unsigned)h) << 16); }
__device__ __forceinline__ float x32sum(float x) { unsigned u = __float_as_uint(x); auto r = __builtin_amdgcn_permlane32_swap(u, u, false, false); return __uint_as_float(r[0]) + __uint_as_float(r[1]); }
__device__ __forceinline__ float x16sum(float x) { unsigned u = __float_as_uint(x); auto r = __builtin_amdgcn_permlane16_swap(u, u, false, false); return __uint_as_float(r[0]) + __uint_as_float(r[1]); }
__device__ __forceinline__ float x32max(float x) { unsigned u = __float_as_uint(x); auto r = __builtin_amdgcn_permlane32_swap(u, u, false, false); return fmaxf(__uint_as_float(r[0]), __uint_as_float(r[1])); }
__device__ __forceinline__ float x16max(float x) { unsigned u = __float_as_uint(x); auto r = __builtin_amdgcn_permlane16_swap(u, u, false, false); return fmaxf(__uint_as_float(r[0]), __uint_as_float(r[1])); }
__device__ __forceinline__ float fqsum(float x) { return x16sum(x32sum(x)); }
__device__ __forceinline__ float fqmax(float x) { return x16max(x32max(x)); }
__device__ __forceinline__ float wave_sum(float v) {
#pragma unroll
    for (int o = 1; o < 16; o <<= 1) v += __shfl_xor(v, o);
    return fqsum(v);
}
template <int CTRL> __device__ __forceinline__ float dpp_add(float x) { return x + __uint_as_float((unsigned)__builtin_amdgcn_update_dpp(0, (int)__float_as_uint(x), CTRL, 0xf, 0xf, true)); }
__device__ __forceinline__ float red8(float x) { x = dpp_add<0xB1>(x); x = dpp_add<0x4E>(x); x = dpp_add<0x141>(x); return x; }
__device__ __forceinline__ float sigmoidf_(float x) { return 1.0f / (1.0f + __expf(-x)); }
__device__ __forceinline__ float siluf_(float x) { return x / (1.0f + __expf(-x)); }

__device__ __forceinline__ const float* x_rd(const Params& p, bool from_input, int b, int pp) {
    if (pp < CTXL) return (from_input ? p.ctx : (const float*)(p.ws + OFF_XC)) + ((size_t)b * CTXL + pp) * DM;
    return (from_input ? p.x : (const float*)p.out) + ((size_t)b * SEQ + (pp - CTXL)) * DM;
}
__device__ __forceinline__ float* x_wr(const Params& p, int b, int pp) {
    if (pp < CTXL) return (float*)(p.ws + OFF_XC) + ((size_t)b * CTXL + pp) * DM;
    return p.out + ((size_t)b * SEQ + (pp - CTXL)) * DM;
}
__device__ __forceinline__ const float* modv_ptr(const Params& p, int l, int b, int pp) {
    const int mr = pp < CTXL ? 16 : b;
    return (const float*)(p.ws + OFF_MODV) + ((size_t)l * 17 + mr) * 6144;
}

__device__ __forceinline__ void grid_barrier(unsigned* bar, unsigned& epoch) {
    asm volatile("s_waitcnt vmcnt(0) lgkmcnt(0)" ::: "memory");
    __syncthreads();
    epoch += 1;
    if (threadIdx.x == 0) {
        __builtin_amdgcn_fence(__ATOMIC_RELEASE, "agent");
        asm volatile("s_waitcnt vmcnt(0)" ::: "memory");
        const unsigned old = __hip_atomic_fetch_add(bar, 1u, __ATOMIC_RELAXED, __HIP_MEMORY_SCOPE_AGENT);
        if (old + 1u == epoch * gridDim.x) {
            __hip_atomic_store(bar + 64, epoch, __ATOMIC_RELAXED, __HIP_MEMORY_SCOPE_AGENT);
        } else {
            while (__hip_atomic_load(bar + 64, __ATOMIC_RELAXED, __HIP_MEMORY_SCOPE_AGENT) < epoch) __builtin_amdgcn_s_sleep(1);
        }
        __builtin_amdgcn_fence(__ATOMIC_ACQUIRE, "agent");
        asm volatile("s_waitcnt vmcnt(0)" ::: "memory");
    }
    __syncthreads();
}

#define LDS_AS __attribute__((address_space(3)))
#define GLB_AS __attribute__((address_space(1)))
template <int MT, int SWAPMODE>
__device__ __forceinline__ void gemm_mainloop(f32x4 (&acc)[MT][4], const bf16_t* __restrict__ A, int lda, int a_kstep,
                                              const bf16_t* __restrict__ Bt, int ldb, int nk, unsigned char* lds, int tid) {
    constexpr int BMr = 64 * MT;
    constexpr int STAGE = (BMr + 128) * 128;
    const int wid = __builtin_amdgcn_readfirstlane(tid >> 6), lane = tid & 63, wr = wid >> 1, wc = wid & 1, fr = lane & 15, fq = lane >> 4;
    const int lrow = 8 * wid + (lane >> 3);
    const int lch = (lane & 7) ^ ((4 * wid + (lane >> 4)) & 7);
    const bf16_t* ap = A + (size_t)lrow * lda + lch * 8;
    const bf16_t* bp = Bt + (size_t)lrow * ldb + lch * 8;
    auto issue = [&](int kt, int st) {
        unsigned char* base = lds + st * STAGE + wid * 1024;
#pragma unroll
        for (int i = 0; i < MT; ++i)
            __builtin_amdgcn_global_load_lds((const GLB_AS unsigned*)(ap + (size_t)i * 64 * lda + (size_t)kt * a_kstep), (LDS_AS unsigned*)(base + i * 8192), 16, 0, 0);
#pragma unroll
        for (int i = 0; i < 2; ++i)
            __builtin_amdgcn_global_load_lds((const GLB_AS unsigned*)(bp + (size_t)i * 64 * ldb + (size_t)kt * 64), (LDS_AS unsigned*)(base + (BMr + i * 64) * 128), 16, 0, 0);
    };
    const bool sw = (SWAPMODE == 1) || (SWAPMODE == 2 && wc == 0);
    const int sz = fr >> 1;
    constexpr int NL = MT + 2;
    const bool late = wid >= 4;
    issue(0, 0);
    if (nk > 1) { issue(1, 1); asm volatile("s_waitcnt vmcnt(%0)" ::"n"(NL) : "memory"); }
    else asm volatile("s_waitcnt vmcnt(0)" ::: "memory");
    __builtin_amdgcn_s_barrier();
    asm volatile("" ::: "memory");
    int st = 0;
    for (int kt = 0; kt < nk; ++kt) {
        const int st2 = st >= 1 ? st - 1 : 2;
        if (!late && kt + 2 < nk) issue(kt + 2, st2);
        const unsigned char* As = lds + st * STAGE;
        const unsigned char* Bs = As + BMr * 128;
#pragma unroll
        for (int ks = 0; ks < 2; ++ks) {
            bf16x8 af[MT], bfr[4];
            const int co = ((ks * 4 + fq) ^ sz) * 16;
#pragma unroll
            for (int m = 0; m < MT; ++m) af[m] = *(const bf16x8*)(As + (wr * 16 * MT + m * 16 + fr) * 128 + co);
#pragma unroll
            for (int n = 0; n < 4; ++n) bfr[n] = *(const bf16x8*)(Bs + (wc * 64 + n * 16 + fr) * 128 + co);
            if (sw) {
#pragma unroll
                for (int m = 0; m < MT; ++m)
#pragma unroll
                    for (int n = 0; n < 4; ++n) acc[m][n] = __builtin_amdgcn_mfma_f32_16x16x32_bf16(bfr[n], af[m], acc[m][n], 0, 0, 0);
            } else {
#pragma unroll
                for (int m = 0; m < MT; ++m)
#pragma unroll
                    for (int n = 0; n < 4; ++n) acc[m][n] = __builtin_amdgcn_mfma_f32_16x16x32_bf16(af[m], bfr[n], acc[m][n], 0, 0, 0);
            }
        }
        if (late && kt + 2 < nk) issue(kt + 2, st2);
        if (kt + 2 < nk) asm volatile("s_waitcnt vmcnt(%0) lgkmcnt(0)" ::"n"(NL) : "memory");
        else asm volatile("s_waitcnt vmcnt(0) lgkmcnt(0)" ::: "memory");
        __builtin_amdgcn_s_barrier();
        asm volatile("" ::: "memory");
        st = st == 2 ? 0 : st + 1;
    }
}
__device__ __forceinline__ void gemm_mainloop256(f32x4 (&acc)[8][4], const bf16_t* __restrict__ A, int lda,
                                                 const bf16_t* __restrict__ Bt, int ldb, int nk, unsigned char* lds, int tid) {
    constexpr int STAGE = 512 * 128;
    const int wid = __builtin_amdgcn_readfirstlane(tid >> 6), lane = tid & 63, wr = wid >> 2, wc = wid & 3, fr = lane & 15, fq = lane >> 4;
    const int lrow = 8 * wid + (lane >> 3);
    const int lch = (lane & 7) ^ ((4 * wid + (lane >> 4)) & 7);
    const bf16_t* ap = A + (size_t)lrow * lda + lch * 8;
    const bf16_t* bp = Bt + (size_t)lrow * ldb + lch * 8;
    auto issue = [&](int kt, int st) {
        unsigned char* base = lds + st * STAGE + wid * 1024;
#pragma unroll
        for (int i = 0; i < 4; ++i)
            __builtin_amdgcn_global_load_lds((const GLB_AS unsigned*)(ap + (size_t)i * 64 * lda + (size_t)kt * 64), (LDS_AS unsigned*)(base + i * 8192), 16, 0, 0);
#pragma unroll
        for (int i = 0; i < 4; ++i)
            __builtin_amdgcn_global_load_lds((const GLB_AS unsigned*)(bp + (size_t)i * 64 * ldb + (size_t)kt * 64), (LDS_AS unsigned*)(base + (256 + i * 64) * 128), 16, 0, 0);
    };
    const int sz = fr >> 1;
    const bool late = wid >= 4;
    issue(0, 0);
    asm volatile("s_waitcnt vmcnt(0)" ::: "memory");
    __builtin_amdgcn_s_barrier();
    asm volatile("" ::: "memory");
    for (int kt = 0; kt < nk; ++kt) {
        if (!late && kt + 1 < nk) issue(kt + 1, (kt + 1) & 1);
        const unsigned char* As = lds + (kt & 1) * STAGE;
        const unsigned char* Bs = As + 256 * 128;
#pragma unroll
        for (int ks = 0; ks < 2; ++ks) {
            if (ks == 1 && late && kt + 1 < nk) issue(kt + 1, (kt + 1) & 1);
            bf16x8 af[8], bfr[4];
            const int co = ((ks * 4 + fq) ^ sz) * 16;
#pragma unroll
            for (int m = 0; m < 8; ++m) af[m] = *(const bf16x8*)(As + (wr * 128 + m * 16 + fr) * 128 + co);
#pragma unroll
            for (int n = 0; n < 4; ++n) bfr[n] = *(const bf16x8*)(Bs + (wc * 64 + n * 16 + fr) * 128 + co);
#pragma unroll
            for (int m = 0; m < 8; ++m)
#pragma unroll
                for (int n = 0; n < 4; ++n) acc[m][n] = __builtin_amdgcn_mfma_f32_16x16x32_bf16(bfr[n], af[m], acc[m][n], 0, 0, 0);
        }
        asm volatile("s_waitcnt vmcnt(0) lgkmcnt(0)" ::: "memory");
        __builtin_amdgcn_s_barrier();
        asm volatile("" ::: "memory");
    }
}
struct Seg { const bf16_t* A; const bf16_t* Bt; int lda, a_kstep, ldb, nk; };
template <int MT, int SWAPMODE>
__device__ __forceinline__ void gemm_stream(f32x4 (&acc)[MT][4], const Seg& cur, const Seg& nxt, bool has_next, bool first, int& st,
                                            unsigned char* lds, int tid) {
    constexpr int BMr = 64 * MT;
    constexpr int STAGE = (BMr + 128) * 128;
    constexpr int NL = MT + 2;
    const int wid = __builtin_amdgcn_readfirstlane(tid >> 6), lane = tid & 63, wr = wid >> 1, wc = wid & 1, fr = lane & 15, fq = lane >> 4;
    const int lrow = 8 * wid + (lane >> 3);
    const int lch = (lane & 7) ^ ((4 * wid + (lane >> 4)) & 7);
    const bf16_t* apc = cur.A + (size_t)lrow * cur.lda + lch * 8;
    const bf16_t* bpc = cur.Bt + (size_t)lrow * cur.ldb + lch * 8;
    const bf16_t* apn = nxt.A + (size_t)lrow * nxt.lda + lch * 8;
    const bf16_t* bpn = nxt.Bt + (size_t)lrow * nxt.ldb + lch * 8;
    auto issue = [&](const bf16_t* ap, const bf16_t* bp, int lda, int ldb, int koffa, int koffb, int slot) {
        unsigned char* base = lds + slot * STAGE + wid * 1024;
#pragma unroll
        for (int i = 0; i < MT; ++i)
            __builtin_amdgcn_global_load_lds((const GLB_AS unsigned*)(ap + (size_t)i * 64 * lda + koffa), (LDS_AS unsigned*)(base + i * 8192), 16, 0, 0);
#pragma unroll
        for (int i = 0; i < 2; ++i)
            __builtin_amdgcn_global_load_lds((const GLB_AS unsigned*)(bp + (size_t)i * 64 * ldb + koffb), (LDS_AS unsigned*)(base + (BMr + i * 64) * 128), 16, 0, 0);
    };
    const bool sw = (SWAPMODE == 1) || (SWAPMODE == 2 && wc == 0);
    const int sz = fr >> 1;
    const bool late = wid >= 4;
    const int nk = cur.nk;
    int s0 = st;
    if (first) {
        const int s1 = s0 == 2 ? 0 : s0 + 1;
        issue(apc, bpc, cur.lda, cur.ldb, 0, 0, s0);
        issue(apc, bpc, cur.lda, cur.ldb, cur.a_kstep, 64, s1);
        asm volatile("s_waitcnt vmcnt(%0)" ::"n"(NL) : "memory");
        __builtin_amdgcn_s_barrier();
        asm volatile("" ::: "memory");
    }
    for (int kt = 0; kt < nk; ++kt) {
        const int s2 = s0 >= 1 ? s0 - 1 : 2;
        const int idx = kt + 2;
        const bool incur = idx < nk, doi = incur || has_next;
        if (!late && doi) { if (incur) issue(apc, bpc, cur.lda, cur.ldb, idx * cur.a_kstep, idx * 64, s2); else issue(apn, bpn, nxt.lda, nxt.ldb, (idx - nk) * nxt.a_kstep, (idx - nk) * 64, s2); }
        const unsigned char* As = lds + s0 * STAGE;
        const unsigned char* Bs = As + BMr * 128;
#pragma unroll
        for (int ks = 0; ks < 2; ++ks) {
            bf16x8 af[MT], bfr[4];
            const int co = ((ks * 4 + fq) ^ sz) * 16;
#pragma unroll
            for (int m = 0; m < MT; ++m) af[m] = *(const bf16x8*)(As + (wr * 16 * MT + m * 16 + fr) * 128 + co);
#pragma unroll
            for (int n = 0; n < 4; ++n) bfr[n] = *(const bf16x8*)(Bs + (wc * 64 + n * 16 + fr) * 128 + co);
            if (sw) {
#pragma unroll
                for (int m = 0; m < MT; ++m)
#pragma unroll
                    for (int n = 0; n < 4; ++n) acc[m][n] = __builtin_amdgcn_mfma_f32_16x16x32_bf16(bfr[n], af[m], acc[m][n], 0, 0, 0);
            } else {
#pragma unroll
                for (int m = 0; m < MT; ++m)
#pragma unroll
                    for (int n = 0; n < 4; ++n) acc[m][n] = __builtin_amdgcn_mfma_f32_16x16x32_bf16(af[m], bfr[n], acc[m][n], 0, 0, 0);
            }
        }
        if (late && doi) { if (incur) issue(apc, bpc, cur.lda, cur.ldb, idx * cur.a_kstep, idx * 64, s2); else issue(apn, bpn, nxt.lda, nxt.ldb, (idx - nk) * nxt.a_kstep, (idx - nk) * 64, s2); }
        if (doi) asm volatile("s_waitcnt vmcnt(%0) lgkmcnt(0)" ::"n"(NL) : "memory");
        else asm volatile("s_waitcnt vmcnt(0) lgkmcnt(0)" ::: "memory");
        __builtin_amdgcn_s_barrier();
        asm volatile("" ::: "memory");
        s0 = s0 == 2 ? 0 : s0 + 1;
    }
    st = s0;
}
__device__ __forceinline__ void gemm_stream256(f32x4 (&acc)[8][4], const Seg& cur, const Seg& nxt, bool has_next, bool first, int& st, unsigned char* lds, int tid) {
    constexpr int STAGE = 512 * 128;
    const int wid = __builtin_amdgcn_readfirstlane(tid >> 6), lane = tid & 63, wr = wid >> 2, wc = wid & 3, fr = lane & 15, fq = lane >> 4;
    const int lrow = 8 * wid + (lane >> 3);
    const int lch = (lane & 7) ^ ((4 * wid + (lane >> 4)) & 7);
    const bf16_t* apc = cur.A + (size_t)lrow * cur.lda + lch * 8;
    const bf16_t* bpc = cur.Bt + (size_t)lrow * cur.ldb + lch * 8;
    const bf16_t* apn = nxt.A + (size_t)lrow * nxt.lda + lch * 8;
    const bf16_t* bpn = nxt.Bt + (size_t)lrow * nxt.ldb + lch * 8;
    auto issue = [&](const bf16_t* ap, const bf16_t* bp, int lda, int ldb, int koff, int slot) {
        unsigned char* base = lds + slot * STAGE + wid * 1024;
#pragma unroll
        for (int i = 0; i < 4; ++i)
            __builtin_amdgcn_global_load_lds((const GLB_AS unsigned*)(ap + (size_t)i * 64 * lda + koff), (LDS_AS unsigned*)(base + i * 8192), 16, 0, 0);
#pragma unroll
        for (int i = 0; i < 4; ++i)
            __builtin_amdgcn_global_load_lds((const GLB_AS unsigned*)(bp + (size_t)i * 64 * ldb + koff), (LDS_AS unsigned*)(base + (256 + i * 64) * 128), 16, 0, 0);
    };
    const int sz = fr >> 1;
    const bool late = wid >= 4;
    const int nk = cur.nk;
    int s0 = st;
    if (first) {
        issue(apc, bpc, cur.lda, cur.ldb, 0, s0);
        asm volatile("s_waitcnt vmcnt(0)" ::: "memory");
        __builtin_amdgcn_s_barrier();
        asm volatile("" ::: "memory");
    }
    for (int kt = 0; kt < nk; ++kt) {
        const int idx = kt + 1;
        const bool incur = idx < nk, doi = incur || has_next;
        if (!late && doi) { if (incur) issue(apc, bpc, cur.lda, cur.ldb, idx * 64, s0 ^ 1); else issue(apn, bpn, nxt.lda, nxt.ldb, 0, s0 ^ 1); }
        const unsigned char* As = lds + s0 * STAGE;
        const unsigned char* Bs = As + 256 * 128;
#pragma unroll
        for (int ks = 0; ks < 2; ++ks) {
            if (ks == 1 && late && doi) { if (incur) issue(apc, bpc, cur.lda, cur.ldb, idx * 64, s0 ^ 1); else issue(apn, bpn, nxt.lda, nxt.ldb, 0, s0 ^ 1); }
            bf16x8 af[8], bfr[4];
            const int co = ((ks * 4 + fq) ^ sz) * 16;
#pragma unroll
            for (int m = 0; m < 8; ++m) af[m] = *(const bf16x8*)(As + (wr * 128 + m * 16 + fr) * 128 + co);
#pragma unroll
            for (int n = 0; n < 4; ++n) bfr[n] = *(const bf16x8*)(Bs + (wc * 64 + n * 16 + fr) * 128 + co);
#pragma unroll
            for (int m = 0; m < 8; ++m)
#pragma unroll
                for (int n = 0; n < 4; ++n) acc[m][n] = __builtin_amdgcn_mfma_f32_16x16x32_bf16(bfr[n], af[m], acc[m][n], 0, 0, 0);
        }
        asm volatile("s_waitcnt vmcnt(0) lgkmcnt(0)" ::: "memory");
        __builtin_amdgcn_s_barrier();
        asm volatile("" ::: "memory");
        s0 ^= 1;
    }
    st = s0;
}
__device__ __forceinline__ void gemm_gate3(f32x4 (&g)[3][2][4], const bf16_t* __restrict__ A, const bf16_t* __restrict__ Bt0, int nk, unsigned char* lds, int tid) {
    constexpr int STAGE = 512 * 128;
    const int wid = __builtin_amdgcn_readfirstlane(tid >> 6), lane = tid & 63, wr = wid >> 1, wc = wid & 1, fr = lane & 15, fq = lane >> 4;
    const int lrow = 8 * wid + (lane >> 3);
    const int lch = (lane & 7) ^ ((4 * wid + (lane >> 4)) & 7);
    const unsigned loff = (unsigned)(lrow * 1024 + lch * 8);
    auto issue = [&](int kt, int stg) {
        unsigned char* base = lds + stg * STAGE + wid * 1024;
#pragma unroll
        for (int i = 0; i < 2; ++i)
            __builtin_amdgcn_global_load_lds((const GLB_AS unsigned*)((A + (size_t)i * 64 * 1024 + (size_t)kt * 64) + loff), (LDS_AS unsigned*)(base + i * 8192), 16, 0, 0);
#pragma unroll
        for (int j = 0; j < 6; ++j)
            __builtin_amdgcn_global_load_lds((const GLB_AS unsigned*)((Bt0 + ((size_t)(j >> 1) * 1024 + (j & 1) * 64) * 1024 + (size_t)kt * 64) + loff), (LDS_AS unsigned*)(base + (128 + j * 64) * 128), 16, 0, 0);
    };
    const int sz = fr >> 1;
    const bool late = wid >= 4;
    issue(0, 0);
    asm volatile("s_waitcnt vmcnt(0)" ::: "memory");
    __builtin_amdgcn_s_barrier();
    asm volatile("" ::: "memory");
    for (int kt = 0; kt < nk; ++kt) {
        if (!late && kt + 1 < nk) issue(kt + 1, (kt + 1) & 1);
        const unsigned char* As = lds + (kt & 1) * STAGE;
        const unsigned char* Bs = As + 128 * 128;
#pragma unroll
        for (int ks = 0; ks < 2; ++ks) {
            if (ks == 1 && late && kt + 1 < nk) issue(kt + 1, (kt + 1) & 1);
            const int co = ((ks * 4 + fq) ^ sz) * 16;
            bf16x8 af[2];
#pragma unroll
            for (int m = 0; m < 2; ++m) af[m] = *(const bf16x8*)(As + (wr * 32 + m * 16 + fr) * 128 + co);
#pragma unroll
            for (int i = 0; i < 3; ++i) {
                bf16x8 bfr[4];
#pragma unroll
                for (int n = 0; n < 4; ++n) bfr[n] = *(const bf16x8*)(Bs + (i * 128 + wc * 64 + n * 16 + fr) * 128 + co);
#pragma unroll
                for (int m = 0; m < 2; ++m)
#pragma unroll
                    for (int n = 0; n < 4; ++n) g[i][m][n] = __builtin_amdgcn_mfma_f32_16x16x32_bf16(bfr[n], af[m], g[i][m][n], 0, 0, 0);
                if (i < 2) __builtin_amdgcn_sched_barrier(0);
            }
        }
        asm volatile("s_waitcnt vmcnt(0) lgkmcnt(0)" ::: "memory");
        __builtin_amdgcn_s_barrier();
        asm volatile("" ::: "memory");
    }
}
template <int MT> __device__ __forceinline__ void zero_acc(f32x4 (&acc)[MT][4]) {
#pragma unroll
    for (int m = 0; m < MT; ++m)
#pragma unroll
        for (int n = 0; n < 4; ++n) acc[m][n] = (f32x4){0.f, 0.f, 0.f, 0.f};
}
__device__ __forceinline__ void tile_mn(int t, int nN, int& mt, int& nt) { const int per = 16 * nN, g = t / per, w = t % per; mt = g * 16 + (w & 15); nt = w >> 4; }

__device__ __forceinline__ int rowmap(int mode, int n) {
    if (mode == 1) return n < 672 ? n : n + 96;
    if (mode == 2) return n < DFF ? ((n >> 5) * 64 + (n & 31)) : (((n - DFF) >> 5) * 64 + 32 + ((n - DFF) & 31));
    return n;
}
__device__ __forceinline__ void convert_T(const float* __restrict__ src, int K, int N, bf16_t* __restrict__ dst, int mode, const float* __restrict__ ks, unsigned char* lds, int rot) {
    float* tile = (float*)lds;
    const int ntk = K / 64, ntn = (N + 63) / 64, tid = ltid();
    const int start = (blockIdx.x + gridDim.x - (rot % gridDim.x)) % gridDim.x;
    for (int t = start; t < ntk * ntn; t += gridDim.x) {
        const int tk = t % ntk, tn = t / ntk, k0 = tk * 64, n0 = tn * 64;
#pragma unroll
        for (int i = 0; i < 8; ++i) {
            const int kl = (tid >> 6) + 8 * i, nl = tid & 63, n = n0 + nl;
            tile[kl * 65 + nl] = n < N ? src[(size_t)(k0 + kl) * N + n] : 0.f;
        }
        __syncthreads();
        const int kp = (tid & 31) * 2;
        float s0 = 1.f, s1 = 1.f;
        if (ks) { s0 = ks[k0 + kp]; s1 = ks[k0 + kp + 1]; }
#pragma unroll
        for (int i = 0; i < 4; ++i) {
            const int nl = (tid >> 5) + 16 * i, n = n0 + nl;
            if (n < N) *(unsigned*)(dst + (size_t)rowmap(mode, n) * K + k0 + kp) = pk_bf16(tile[kp * 65 + nl] * s0, tile[(kp + 1) * 65 + nl] * s1);
        }
        __syncthreads();
    }
}
__device__ __forceinline__ void convert_layer(const Params& pin, int l, unsigned char* lds) {
    const Params p = launder(pin); l = launder_i(l);
    bf16_t* W = (bf16_t*)(p.ws + OFF_W);
    convert_T(p.w_in + (size_t)l * DM * DIN, DM, DIN, W + WO_IN, 1, nullptr, lds, 0);
    convert_T(p.ffn_w13 + (size_t)l * DM * 2 * DFF, DM, 2 * DFF, W + WO_13, 2, nullptr, lds, 40);
    convert_T(p.ffn_w2 + (size_t)l * DFF * DM, DFF, DM, W + WO_2, 0, nullptr, lds, 80);
    convert_T(p.w_out + (size_t)l * DM * DM, DM, DM, W + WO_OUT, 0, nullptr, lds, 120);
    convert_T(p.w_o_attn + (size_t)l * 512 * DM, 512, DM, W + WO_OA, 0, nullptr, lds, 136);
    convert_T(p.w_o_conv + (size_t)l * 512 * DM, 512, DM, W + WO_OC, 0, nullptr, lds, 8);
    convert_T(p.w_o_rwkv + (size_t)l * 512 * DM, 512, DM, W + WO_OR, 0, nullptr, lds, 136 + 8);
    convert_T(p.w_uq + (size_t)l * 384 * 768, 384, 768, W + WO_UQ, 0, p.q_norm + l * 384, lds, 16);
    convert_T(p.w_ukv + (size_t)l * 256 * 1024, 256, 1024, W + WO_UKV, 0, p.kv_norm + l * 256, lds, 88);
    for (int z = 0; z < 2; ++z) {
        convert_T(p.rw_w_up + ((size_t)l * 2 + z) * 64 * 512, 64, 512, W + WO_UP + (size_t)z * 512 * 64, 0, nullptr, lds, 152 + 8 * z);
        convert_T(p.rw_a_up + ((size_t)l * 2 + z) * 64 * 512, 64, 512, W + WO_AUP + (size_t)z * 512 * 64, 0, nullptr, lds, 168 + 8 * z);
    }
    convert_T(p.rw_g_up + (size_t)l * 128 * 512, 128, 512, W + WO_GUP, 0, nullptr, lds, 184);
}

__device__ __forceinline__ void modv_phase(const Params& pin, unsigned char* lds) {
    const Params p = launder(pin);
    float* s = (float*)lds;
    float* red = s + 17 * 1024;
    const int tid = ltid(), wid = tid >> 6, lane = tid & 63;
    for (int i = tid; i < 17 * 1024; i += NTHREADS) { const int r = i >> 10, k = i & 1023; const float v = r < 16 ? p.c[r * 1024 + k] : p.c_ctx[k]; s[i] = siluf_(v); }
    __syncthreads();
    float* modv = (float*)(p.ws + OFF_MODV);
    for (int g = blockIdx.x; g < 4 * 96; g += gridDim.x) {
        const int l = g / 96, n = (g % 96) * 64 + lane;
        const float* w = p.mod_w + (size_t)l * 1024 * 6144 + n;
        float acc[17];
#pragma unroll
        for (int r = 0; r < 17; ++r) acc[r] = 0.f;
        const int kb = wid * 128;
        for (int k = kb; k < kb + 128; k += 4) {
            const float w0 = w[(size_t)k * 6144], w1 = w[(size_t)(k + 1) * 6144], w2 = w[(size_t)(k + 2) * 6144], w3 = w[(size_t)(k + 3) * 6144];
#pragma unroll
            for (int r = 0; r < 17; ++r) { const f32x4 sv = *(const f32x4*)(s + r * 1024 + k); acc[r] += sv[0] * w0 + sv[1] * w1 + sv[2] * w2 + sv[3] * w3; }
        }
#pragma unroll
        for (int r = 0; r < 17; ++r) red[(wid * 17 + r) * 64 + lane] = acc[r];
        __syncthreads();
        for (int i = tid; i < 17 * 64; i += NTHREADS) {
            const int r = i >> 6, c = i & 63; float v = 0.f;
#pragma unroll
            for (int w8 = 0; w8 < 8; ++w8) v += red[(w8 * 17 + r) * 64 + c];
            const int nn = (g % 96) * 64 + c;
            modv[((size_t)l * 17 + r) * 6144 + nn] = v + p.mod_b[l * 6144 + nn];
        }
        __syncthreads();
    }
    if (blockIdx.x == gridDim.x - 1) {
        float* rope = (float*)(p.ws + OFF_ROPE);
        for (int i = tid; i < 512; i += NTHREADS) {
            const int pos = i >> 3, f = i & 7;
            const float inv = exp2f(-(float)f * (13.287712379549449f / 8.0f));
            const float ang = (float)pos * inv;
            rope[i * 2] = cosf(ang); rope[i * 2 + 1] = sinf(ang);
        }
    }
}

__device__ __forceinline__ void xmod0_phase(const Params& pin) {
    const Params p = launder(pin);
    const int tid = ltid(), wid = tid >> 6, lane = tid & 63;
    bf16_t* xm = (bf16_t*)(p.ws + OFF_R6);
    for (int row = blockIdx.x * 8 + wid; row < MROWS; row += gridDim.x * 8) {
        const int b = row / TPB, pp = row % TPB;
        const float* xp = x_rd(p, true, b, pp);
        const float* mv = modv_ptr(p, 0, b, pp);
#pragma unroll
        for (int i = 0; i < 4; ++i) {
            const int c = i * 256 + lane * 4;
            const f32x4 v = *(const f32x4*)(xp + c), sh = *(const f32x4*)(mv + c), sc = *(const f32x4*)(mv + 1024 + c);
            uint2 o; o.x = pk_bf16(v[0] * (1.f + sc[0]) + sh[0], v[1] * (1.f + sc[1]) + sh[1]); o.y = pk_bf16(v[2] * (1.f + sc[2]) + sh[2], v[3] * (1.f + sc[3]) + sh[3]);
            *(uint2*)(xm + (size_t)row * 1024 + c) = o;
        }
    }
}

__device__ __forceinline__ void p1_phase(const Params& pin, unsigned char* lds) {
    const Params p = launder(pin); const int tid = ltid();
    const bf16_t* A = (const bf16_t*)(p.ws + OFF_R6);
    const bf16_t* W = (const bf16_t*)(p.ws + OFF_W) + WO_IN;
    const int lane = tid & 63, wid = tid >> 6, wr = wid >> 2, wc = wid & 3, fr = lane & 15, fq = lane >> 4;
    auto seg = [&](int t) { int mt, nt; tile_mn(t, 17, mt, nt); Seg g; g.A = A + (size_t)mt * 256 * 1024; g.Bt = W + (size_t)nt * 256 * 1024; g.lda = 1024; g.a_kstep = 64; g.ldb = 1024; g.nk = 16; return g; };
    int st = 0; bool first = true;
    for (int t = blockIdx.x; t < 144 * 17; t += gridDim.x) {
        int mt, nt; tile_mn(t, 17, mt, nt);
        const int tn = t + gridDim.x; const bool hn = tn < 144 * 17;
        f32x4 acc[8][4]; zero_acc<8>(acc);
        gemm_stream256(acc, seg(t), seg(hn ? tn : t), hn, first, st, lds, tid); first = false;
        bf16_t* dst; int ld, cb, lim;
        if (nt < 3) { dst = (bf16_t*)(p.ws + OFF_R1); ld = 672; cb = nt * 256; lim = 672; }
        else if (nt < 9) { dst = (bf16_t*)(p.ws + OFF_R2); ld = 1536; cb = (nt - 3) * 256; lim = 1536; }
        else { dst = (bf16_t*)(p.ws + OFF_R3); ld = 1920; cb = (nt - 9) * 256; lim = 1920; }
#pragma unroll
        for (int m = 0; m < 8; ++m) {
            const size_t row = (size_t)mt * 256 + wr * 128 + m * 16 + fr;
#pragma unroll
            for (int n = 0; n < 4; ++n) {
                const int col = cb + wc * 64 + n * 16 + fq * 4;
                if (col < lim) { uint2 o; o.x = pk_bf16(acc[m][n][0], acc[m][n][1]); o.y = pk_bf16(acc[m][n][2], acc[m][n][3]); *(uint2*)(dst + row * ld + col) = o; }
            }
        }
    }
}

__device__ __forceinline__ void unpack8(const uint4 u, float (&f)[8]) {
    f[0] = bf_lo(u.x); f[1] = bf_hi(u.x); f[2] = bf_lo(u.y); f[3] = bf_hi(u.y); f[4] = bf_lo(u.z); f[5] = bf_hi(u.z); f[6] = bf_lo(u.w); f[7] = bf_hi(u.w);
}
__device__ __forceinline__ void p2a_phase(const Params& pin, int l) {
    const Params p = launder(pin); l = launder_i(l);
    const int tid = ltid(), wid = tid >> 6, lane = tid & 63;
    const bf16_t* Hm = (const bf16_t*)(p.ws + OFF_R1);
    const bf16_t* Hc = (const bf16_t*)(p.ws + OFF_R2);
    bf16_t* CV = (bf16_t*)(p.ws + OFF_R5);
    bf16_t* KR = (bf16_t*)(p.ws + OFF_KR);
    float* RSQ = (float*)(p.ws + OFF_RSQ);
    float* RSKV = (float*)(p.ws + OFF_RSKV);
    const float* rope = (const float*)(p.ws + OFF_ROPE);
    const float* cw = p.conv_w + (size_t)l * 3 * 512;
    const int c0 = lane * 8;
    float w0[8], w1[8], w2[8];
#pragma unroll
    for (int i = 0; i < 8; ++i) { w0[i] = cw[c0 + i]; w1[i] = cw[512 + c0 + i]; w2[i] = cw[1024 + c0 + i]; }
    for (int row = blockIdx.x * 8 + wid; row < MROWS; row += gridDim.x * 8) {
        const int pp = row % TPB;
        const bool hp = (pp != 0 && pp != CTXL), hn = (pp != CTXL - 1 && pp != TPB - 1);
        const bf16_t* hr = Hc + (size_t)row * 1536;
        float ch[8], cc[8], cb[8], u0[8], u1[8], u2[8];
        unpack8(*(const uint4*)(hr + c0), ch); unpack8(*(const uint4*)(hr + 1024 + c0), cc); unpack8(*(const uint4*)(hr + 512 + c0), cb);
#pragma unroll
        for (int i = 0; i < 8; ++i) u1[i] = cc[i] * ch[i];
        if (hp) { unpack8(*(const uint4*)(hr - 1536 + c0), ch); unpack8(*(const uint4*)(hr - 1536 + 1024 + c0), cc);
#pragma unroll
            for (int i = 0; i < 8; ++i) u0[i] = cc[i] * ch[i]; }
        else {
#pragma unroll
            for (int i = 0; i < 8; ++i) u0[i] = 0.f; }
        if (hn) { unpack8(*(const uint4*)(hr + 1536 + c0), ch); unpack8(*(const uint4*)(hr + 1536 + 1024 + c0), cc);
#pragma unroll
            for (int i = 0; i < 8; ++i) u2[i] = cc[i] * ch[i]; }
        else {
#pragma unroll
            for (int i = 0; i < 8; ++i) u2[i] = 0.f; }
        float o[8];
#pragma unroll
        for (int i = 0; i < 8; ++i) o[i] = cb[i] * (u0[i] * w0[i] + u1[i] * w1[i] + u2[i] * w2[i]);
        uint4 ov; ov.x = pk_bf16(o[0], o[1]); ov.y = pk_bf16(o[2], o[3]); ov.z = pk_bf16(o[4], o[5]); ov.w = pk_bf16(o[6], o[7]);
        *(uint4*)(CV + (size_t)row * 512 + c0) = ov;
        const bf16_t* hm = Hm + (size_t)row * 672;
        float sq = 0.f, skv = 0.f;
        if (lane < 48) { float f[8]; unpack8(*(const uint4*)(hm + lane * 8), f);
#pragma unroll
            for (int i = 0; i < 8; ++i) sq += f[i] * f[i]; }
        if (lane < 32) { float f[8]; unpack8(*(const uint4*)(hm + 384 + lane * 8), f);
#pragma unroll
            for (int i = 0; i < 8; ++i) skv += f[i] * f[i]; }
        sq = wave_sum(sq); skv = wave_sum(skv);
        if (lane == 0) { RSQ[row] = rsqrtf(sq * (1.0f / 384.0f) + 1e-6f); RSKV[row] = rsqrtf(skv * (1.0f / 256.0f) + 1e-6f); }
        {
            const int j = lane & 31;
            float v = bf1(hm[640 + j]);
            const float other = __shfl_xor(v, 8);
            if (pp >= CTXL) {
                const int tt = pp - CTXL;
                const int pos = (j < 16) ? (tt >> 6) : (tt & 63);
                const float cs = rope[(pos * 8 + (j & 7)) * 2], sn = rope[(pos * 8 + (j & 7)) * 2 + 1];
                v = (j & 8) ? (other * sn + v * cs) : (v * cs - other * sn);
            }
            if (lane < 32) KR[(size_t)row * 32 + j] = (bf16_t)(pk_bf16(v, v) & 0xffffu);
        }
    }
}

__device__ __forceinline__ void p2b_phase(const Params& pin, int l, unsigned char* lds) {
    const Params p = launder(pin); l = launder_i(l); const int tid = ltid();
    const bf16_t* Hm = (const bf16_t*)(p.ws + OFF_R1);
    const bf16_t* W = (const bf16_t*)(p.ws + OFF_W);
    const float* RSQ = (const float*)(p.ws + OFF_RSQ);
    const float* RSKV = (const float*)(p.ws + OFF_RSKV);
    const float* rope = (const float*)(p.ws + OFF_ROPE);
    bf16_t* Q = (bf16_t*)(p.ws + OFF_Q);
    bf16_t* KN = (bf16_t*)(p.ws + OFF_KN);
    bf16_t* VT = (bf16_t*)(p.ws + OFF_VT);
    const int lane = tid & 63, wid = tid >> 6, wr = wid >> 1, wc = wid & 1, fr = lane & 15, fq = lane >> 4;
    const int NQ = 144 * 6, NKV = 144 * 8;
    for (int t = blockIdx.x; t < NQ + NKV; t += gridDim.x) {
        f32x4 acc[4][4]; zero_acc<4>(acc);
        if (t < NQ) {
            int mt, nt; tile_mn(t, 6, mt, nt);
            gemm_mainloop<4, 1>(acc, Hm + (size_t)mt * 256 * 672, 672, 64, W + WO_UQ + (size_t)nt * 128 * 384, 384, 6, lds, tid);
            const int pp0 = (mt % 9) * 256; const bool latent = pp0 >= CTXL;
#pragma unroll
            for (int m = 0; m < 4; ++m) {
                const int lrow = wr * 64 + m * 16 + fr;
                const size_t row = (size_t)mt * 256 + lrow;
                const float sc = RSQ[row] * QSCALE;
                const int tt = pp0 + lrow - CTXL;
#pragma unroll
                for (int n = 0; n < 4; ++n) {
                    const int c16 = nt * 128 + wc * 64 + n * 16, r96 = c16 % 96;
                    float v[4];
#pragma unroll
                    for (int j = 0; j < 4; ++j) v[j] = acc[m][n][j] * sc;
                    if (latent && r96 >= 64) {
                        const int pos = (r96 == 64) ? (tt >> 6) : (tt & 63);
#pragma unroll
                        for (int j = 0; j < 4; ++j) {
                            const float other = __shfl_xor(v[j], 32);
                            const int fi = (fq & 1) * 4 + j;
                            const float cs = rope[(pos * 8 + fi) * 2], sn = rope[(pos * 8 + fi) * 2 + 1];
                            v[j] = (fq & 2) ? (other * sn + v[j] * cs) : (v[j] * cs - other * sn);
                        }
                    }
                    uint2 o; o.x = pk_bf16(v[0], v[1]); o.y = pk_bf16(v[2], v[3]);
                    *(uint2*)(Q + row * 768 + c16 + fq * 4) = o;
                }
            }
        } else {
            int mt, nt; tile_mn(t - NQ, 8, mt, nt);
            gemm_mainloop<4, 2>(acc, Hm + (size_t)mt * 256 * 672 + 384, 672, 64, W + WO_UKV + (size_t)nt * 128 * 256, 256, 4, lds, tid);
            const int b = mt / 9, pp0 = (mt % 9) * 256;
            if (wc == 0) {
#pragma unroll
                for (int m = 0; m < 4; ++m) {
                    const size_t row = (size_t)mt * 256 + wr * 64 + m * 16 + fr;
                    const float sc = RSKV[row];
#pragma unroll
                    for (int n = 0; n < 4; ++n) {
                        uint2 o; o.x = pk_bf16(acc[m][n][0] * sc, acc[m][n][1] * sc); o.y = pk_bf16(acc[m][n][2] * sc, acc[m][n][3] * sc);
                        *(uint2*)(KN + row * 512 + nt * 64 + n * 16 + fq * 4) = o;
                    }
                }
            } else {
#pragma unroll
                for (int m = 0; m < 4; ++m) {
                    const int lrow = wr * 64 + m * 16 + fq * 4;
                    const f32x4 sc = *(const f32x4*)(RSKV + (size_t)mt * 256 + lrow);
#pragma unroll
                    for (int n = 0; n < 4; ++n) {
                        const int dv = n * 16 + fr;
                        uint2 o; o.x = pk_bf16(acc[m][n][0] * sc[0], acc[m][n][1] * sc[1]); o.y = pk_bf16(acc[m][n][2] * sc[2], acc[m][n][3] * sc[3]);
                        *(uint2*)(VT + ((size_t)(b * 8 + nt) * 64 + dv) * TPB + pp0 + lrow) = o;
                    }
                }
            }
        }
    }
    {
        const bf16_t* Hr = (const bf16_t*)(p.ws + OFF_R3);
        bf16_t* SG = (bf16_t*)(p.ws + OFF_SG);
        const float* mu = p.rw_mu + (size_t)l * 1920 + 1792;
        for (int i = blockIdx.x * NTHREADS + tid; i < MROWS * 16; i += gridDim.x * NTHREADS) {
            const int row = i >> 4, c0 = (i & 15) * 8, pp = row % TPB;
            const bool hp = (pp != 0 && pp != CTXL), hn = (pp != CTXL - 1 && pp != TPB - 1);
            const bf16_t* hr = Hr + (size_t)row * 1920 + 1792 + c0;
            float cur[8], pv[8], nx[8];
            unpack8(*(const uint4*)hr, cur);
            if (hp) unpack8(*(const uint4*)(hr - 1920), pv); else {
#pragma unroll
                for (int k = 0; k < 8; ++k) pv[k] = 0.f; }
            if (hn) unpack8(*(const uint4*)(hr + 1920), nx); else {
#pragma unroll
                for (int k = 0; k < 8; ++k) nx[k] = 0.f; }
            float o[8];
#pragma unroll
            for (int k = 0; k < 8; ++k) o[k] = sigmoidf_(cur[k] + (0.5f * (pv[k] + nx[k]) - cur[k]) * mu[c0 + k]);
            uint4 ov; ov.x = pk_bf16(o[0], o[1]); ov.y = pk_bf16(o[2], o[3]); ov.z = pk_bf16(o[4], o[5]); ov.w = pk_bf16(o[6], o[7]);
            *(uint4*)(SG + (size_t)row * 128 + c0) = ov;
        }
    }
}

#define FMAC_BC(acc, coef, s, J) asm("v_fmac_f32_dpp %0, %1, %2 row_newbcast:" #J " row_mask:0xf bank_mask:0xf" : "+v"(acc) : "v"(coef), "v"(s))
#define MUL_BC(dst, coef, s, J) asm("v_mul_f32_dpp %0, %1, %2 row_newbcast:" #J " row_mask:0xf bank_mask:0xf" : "=v"(dst) : "v"(coef), "v"(s))
#define REP16(X) X(0, 0) X(1, 1) X(2, 2) X(3, 3) X(4, 0) X(5, 1) X(6, 2) X(7, 3) X(8, 0) X(9, 1) X(10, 2) X(11, 3) X(12, 0) X(13, 1) X(14, 2) X(15, 3)
constexpr int FSTR = 6 * 64 + 4;
constexpr int CHUNK = 32, NCHUNK = TPB / CHUNK;

__device__ __forceinline__ int scan_pos(int z, int s) { return z == 0 ? s : (s < CTXL ? (CTXL - 1 - s) : (TPB + CTXL - 1 - s)); }

__device__ __forceinline__ void shift4(const bf16_t* hr, bool hp, bool hn, int col, const float* mu, float (&o)[4]) {
    const uint2 c = *(const uint2*)(hr + col);
    uint2 a = make_uint2(0u, 0u), b = make_uint2(0u, 0u);
    if (hp) a = *(const uint2*)(hr - 1920 + col);
    if (hn) b = *(const uint2*)(hr + 1920 + col);
    const f32x4 m = *(const f32x4*)(mu + col);
    const float cv[4] = {bf_lo(c.x), bf_hi(c.x), bf_lo(c.y), bf_hi(c.y)};
    const float av[4] = {bf_lo(a.x), bf_hi(a.x), bf_lo(a.y), bf_hi(a.y)};
    const float bv[4] = {bf_lo(b.x), bf_hi(b.x), bf_lo(b.y), bf_hi(b.y)};
#pragma unroll
    for (int i = 0; i < 4; ++i) o[i] = cv[i] + (0.5f * (av[i] + bv[i]) - cv[i]) * m[i];
}
__device__ __forceinline__ void shift8(const bf16_t* hr, bool hp, bool hn, int col, const float* mu, float (&o)[8]) {
    float cv[8], av[8], bv[8];
    unpack8(*(const uint4*)(hr + col), cv);
    if (hp) unpack8(*(const uint4*)(hr - 1920 + col), av); else {
#pragma unroll
        for (int i = 0; i < 8; ++i) av[i] = 0.f; }
    if (hn) unpack8(*(const uint4*)(hr + 1920 + col), bv); else {
#pragma unroll
        for (int i = 0; i < 8; ++i) bv[i] = 0.f; }
#pragma unroll
    for (int i = 0; i < 8; ++i) o[i] = cv[i] + (0.5f * (av[i] + bv[i]) - cv[i]) * mu[col + i];
}
__device__ __forceinline__ bf16x8 pack8(const float (&f)[8]) {
    union { uint4 u; bf16x8 v; } r;
    r.u.x = pk_bf16(f[0], f[1]); r.u.y = pk_bf16(f[2], f[3]); r.u.z = pk_bf16(f[4], f[5]); r.u.w = pk_bf16(f[6], f[7]);
    return r.v;
}

struct ProdState { f32x4 aw[4], aa[4]; };
struct Raw3x2 { uint2 c, a, b; };
__device__ __forceinline__ Raw3x2 ld3x2(const bf16_t* pc, const bf16_t* pa, const bf16_t* pb, bool hp, bool hn, int col) {
    Raw3x2 r; r.c = *(const uint2*)(pc + col); r.a = *(const uint2*)(pa + col); r.b = *(const uint2*)(pb + col);
    if (!hp) r.a = make_uint2(0u, 0u);
    if (!hn) r.b = make_uint2(0u, 0u);
    return r;
}
__device__ __forceinline__ void sh4(const Raw3x2& r, const f32x4 m, float (&o)[4]) {
    const float cv[4] = {bf_lo(r.c.x), bf_hi(r.c.x), bf_lo(r.c.y), bf_hi(r.c.y)};
    const float av[4] = {bf_lo(r.a.x), bf_hi(r.a.x), bf_lo(r.a.y), bf_hi(r.a.y)};
    const float bv[4] = {bf_lo(r.b.x), bf_hi(r.b.x), bf_lo(r.b.y), bf_hi(r.b.y)};
#pragma unroll
    for (int i = 0; i < 4; ++i) o[i] = cv[i] + (0.5f * (av[i] + bv[i]) - cv[i]) * m[i];
}
struct Raw3x4 { uint4 c, a, b; };
__device__ __forceinline__ Raw3x4 ld3x4(const bf16_t* pc, const bf16_t* pa, const bf16_t* pb, bool hp, bool hn, int col) {
    Raw3x4 r; r.c = *(const uint4*)(pc + col); r.a = *(const uint4*)(pa + col); r.b = *(const uint4*)(pb + col);
    if (!hp) r.a = make_uint4(0u, 0u, 0u, 0u);
    if (!hn) r.b = make_uint4(0u, 0u, 0u, 0u);
    return r;
}
__device__ __forceinline__ void sh8(const Raw3x4& r, const float* m, float (&o)[8]) {
    float cv[8], av[8], bv[8];
    unpack8(r.c, cv); unpack8(r.a, av); unpack8(r.b, bv);
    const f32x4 m0 = *(const f32x4*)m, m1 = *(const f32x4*)(m + 4);
#pragma unroll
    for (int i = 0; i < 8; ++i) o[i] = cv[i] + (0.5f * (av[i] + bv[i]) - cv[i]) * (i < 4 ? m0[i] : m1[i - 4]);
}
template <int N0>
__device__ __forceinline__ void scan_produce_elem(const float* pl, int fq, const Raw3x2 (&rr)[2], const Raw3x2 (&rk)[2], const Raw3x2 (&rv)[2],
                                                  const f32x4 (&aw)[2], const f32x4 (&aa)[2], float& ss, float* frow) {
#pragma unroll
    for (int nn = 0; nn < 2; ++nn) {
        const int n = N0 + nn;
        const int c4 = n * 16 + fq * 4;
        float r4[4], k4[4], v4[4];
        sh4(rr[nn], *(const f32x4*)(pl + 0 * 64 + c4), r4);
        sh4(rk[nn], *(const f32x4*)(pl + 1 * 64 + c4), k4);
        sh4(rv[nn], *(const f32x4*)(pl + 2 * 64 + c4), v4);
        const f32x4 w0 = *(const f32x4*)(pl + 3 * 64 + c4);
        const f32x4 a0 = *(const f32x4*)(pl + 4 * 64 + c4);
        const f32x4 kkp = *(const f32x4*)(pl + 5 * 64 + c4);
        const f32x4 kap = *(const f32x4*)(pl + 6 * 64 + c4);
        f32x4 dw, kd, kf4, a4;
#pragma unroll
        for (int j = 0; j < 4; ++j) {
            const float x = -(aw[nn][j] + w0[j]);
            const float sp = fmaxf(x, 0.f) + __logf(1.0f + __expf(-fabsf(x)));
            const float wl = -sp - 0.5f;
            dw[j] = __expf(-__expf(wl));
            const float a = __builtin_amdgcn_rcpf(1.0f + __expf(-(aa[nn][j] + a0[j])));
            a4[j] = a;
            const float kf = k4[j] * kkp[j];
            kf4[j] = kf; ss += kf * kf;
            kd[j] = k4[j] * (1.0f + (a - 1.0f) * kap[j]);
        }
        *(f32x4*)(frow + 0 * 64 + c4) = kf4;
        *(f32x4*)(frow + 1 * 64 + c4) = dw;
        *(f32x4*)(frow + 2 * 64 + c4) = a4;
        *(f32x4*)(frow + 3 * 64 + c4) = kd;
        *(f32x4*)(frow + 4 * 64 + c4) = (f32x4){r4[0], r4[1], r4[2], r4[3]};
        *(f32x4*)(frow + 5 * 64 + c4) = (f32x4){v4[0], v4[1], v4[2], v4[3]};
    }
}
__device__ __forceinline__ void scan_produce_A(const Params& p, const float* pl, int b, int h, int z, int s0, float* frow0, int lane, ProdState& st) {
    const int fr = lane & 15, fq = lane >> 4;
    const int pp = scan_pos(z, s0 + fr);
    const bool hp = (pp != 0 && pp != CTXL), hn = (pp != CTXL - 1 && pp != TPB - 1);
    const bf16_t* hr = (const bf16_t*)(p.ws + OFF_R3) + ((size_t)b * TPB + pp) * 1920;
    const bf16_t* W = (const bf16_t*)(p.ws + OFF_W);
    Raw3x4 qw[2], qa[2];
    const bf16_t* pc = hr + z * 64 + fq * 8; const bf16_t* pa = hp ? pc - 1920 : pc; const bf16_t* pb = hn ? pc + 1920 : pc;
#pragma unroll
    for (int ks = 0; ks < 2; ++ks) { qw[ks] = ld3x4(pc, pa, pb, hp, hn, 1536 + ks * 32); qa[ks] = ld3x4(pc, pa, pb, hp, hn, 1664 + ks * 32); }
    f32x4 accw[4], acca[4];
#pragma unroll
    for (int n = 0; n < 4; ++n) { accw[n] = (f32x4){0.f, 0.f, 0.f, 0.f}; acca[n] = (f32x4){0.f, 0.f, 0.f, 0.f}; }
#pragma unroll
    for (int ks = 0; ks < 2; ++ks) {
        bf16x8 bw[4], ba[4];
#pragma unroll
        for (int n = 0; n < 4; ++n) {
            const size_t wo = ((size_t)z * 512 + h * 64 + n * 16 + fr) * 64 + ks * 32 + fq * 8;
            bw[n] = *(const bf16x8*)(W + WO_UP + wo); ba[n] = *(const bf16x8*)(W + WO_AUP + wo);
        }
        float t8[8];
        sh8(qw[ks], pl + 7 * 64 + ks * 32 + fq * 8, t8);
#pragma unroll
        for (int i = 0; i < 8; ++i) { const float e = __expf(2.0f * t8[i]); t8[i] = 1.0f - 2.0f * __builtin_amdgcn_rcpf(e + 1.0f); }
        const bf16x8 aw = pack8(t8);
        sh8(qa[ks], pl + 8 * 64 + ks * 32 + fq * 8, t8);
        const bf16x8 aa = pack8(t8);
#pragma unroll
        for (int n = 0; n < 4; ++n) {
            accw[n] = __builtin_amdgcn_mfma_f32_16x16x32_bf16(bw[n], aw, accw[n], 0, 0, 0);
            acca[n] = __builtin_amdgcn_mfma_f32_16x16x32_bf16(ba[n], aa, acca[n], 0, 0, 0);
        }
    }
#pragma unroll
    for (int n = 0; n < 4; ++n) { st.aw[n] = accw[n]; st.aa[n] = acca[n]; }
}
__device__ __forceinline__ void scan_produce_B(const Params& p, const float* pl, int b, int h, int z, int s0, float* frow0, int lane, const ProdState& st) {
    const int fr = lane & 15, fq = lane >> 4;
    const int pp = scan_pos(z, s0 + fr);
    const bool hp = (pp != 0 && pp != CTXL), hn = (pp != CTXL - 1 && pp != TPB - 1);
    const bf16_t* hr = (const bf16_t*)(p.ws + OFF_R3) + ((size_t)b * TPB + pp) * 1920;
    Raw3x2 rr0[2], rk0[2], rv0[2], rr1[2], rk1[2], rv1[2];
    const bf16_t* pc = hr + h * 64 + fq * 4; const bf16_t* pa = hp ? pc - 1920 : pc; const bf16_t* pb = hn ? pc + 1920 : pc;
#pragma unroll
    for (int nn = 0; nn < 2; ++nn) {
        const int C4 = nn * 16, C5 = C4 + 32;
        rr0[nn] = ld3x2(pc, pa, pb, hp, hn, C4); rk0[nn] = ld3x2(pc, pa, pb, hp, hn, 512 + C4); rv0[nn] = ld3x2(pc, pa, pb, hp, hn, 1024 + C4);
        rr1[nn] = ld3x2(pc, pa, pb, hp, hn, C5); rk1[nn] = ld3x2(pc, pa, pb, hp, hn, 512 + C5); rv1[nn] = ld3x2(pc, pa, pb, hp, hn, 1024 + C5);
    }
    float ss = 0.f;
    float* frow = frow0 + fr * FSTR;
    const f32x4 w01[2] = {st.aw[0], st.aw[1]}, a01[2] = {st.aa[0], st.aa[1]}, w23[2] = {st.aw[2], st.aw[3]}, a23[2] = {st.aa[2], st.aa[3]};
    scan_produce_elem<0>(pl, fq, rr0, rk0, rv0, w01, a01, ss, frow);
    scan_produce_elem<2>(pl, fq, rr1, rk1, rv1, w23, a23, ss, frow);
    ss = fqsum(ss);
    const float inv = rsqrtf(fmaxf(ss, 1e-24f));
#pragma unroll
    for (int n = 0; n < 4; ++n) {
        const int c4 = n * 16 + fq * 4;
        f32x4 kk = *(const f32x4*)(frow + 0 * 64 + c4);
        f32x4 bb = *(const f32x4*)(frow + 2 * 64 + c4);
#pragma unroll
        for (int j = 0; j < 4; ++j) { kk[j] = kk[j] * inv; bb[j] = kk[j] * bb[j]; }
        *(f32x4*)(frow + 0 * 64 + c4) = kk;
        *(f32x4*)(frow + 2 * 64 + c4) = bb;
    }
}

typedef float f32x2 __attribute__((ext_vector_type(2)));
struct ScanHead { f32x4 kk[2]; f32x2 v; };
struct ScanBody { f32x4 w[2], bb[2], kd[2], r[2]; };
__device__ __forceinline__ void scan_ldh(ScanHead& c, const float* f, const float* fv) {
#pragma unroll
    for (int q = 0; q < 2; ++q) c.kk[q] = *(const f32x4*)(f + 0 * 64 + 4 * q);
    c.v = *(const f32x2*)fv;
}
__device__ __forceinline__ void scan_ldb(ScanBody& c, const float* f) {
#pragma unroll
    for (int q = 0; q < 2; ++q) {
        c.w[q] = *(const f32x4*)(f + 1 * 64 + 4 * q); c.bb[q] = *(const f32x4*)(f + 2 * 64 + 4 * q);
        c.kd[q] = *(const f32x4*)(f + 3 * 64 + 4 * q); c.r[q] = *(const f32x4*)(f + 4 * 64 + 4 * q);
    }
}
__device__ __forceinline__ void scan_unit(const Params& p, int l, int u, unsigned char* lds) {
    const int tid = ltid(), wid = __builtin_amdgcn_readfirstlane(tid >> 6), lane = tid & 63;
    const int b = u >> 4, h = (u >> 1) & 7, z = u & 1;
    float* fb = (float*)lds;
    bf16_t* Y = (bf16_t*)(p.ws + (z == 0 ? OFF_YF : OFF_YB));
    float* pl = fb + 3 * CHUNK * FSTR;
    for (int i = tid; i < 9 * 64; i += NTHREADS) {
        const int a = i >> 6, c = i & 63, C = h * 64 + c;
        float v;
        if (a < 3) v = p.rw_mu[(size_t)l * 1920 + a * 512 + C];
        else if (a == 3) v = p.rw_w0[((size_t)l * 2 + z) * 512 + C];
        else if (a == 4) v = p.rw_a0[((size_t)l * 2 + z) * 512 + C];
        else if (a == 5) v = p.rw_k_k[(size_t)l * 512 + C];
        else if (a == 6) v = p.rw_k_a[(size_t)l * 512 + C];
        else if (a == 7) v = p.rw_mu[(size_t)l * 1920 + 1536 + z * 64 + c];
        else v = p.rw_mu[(size_t)l * 1920 + 1664 + z * 64 + c];
        pl[i] = v;
    }
    __syncthreads();
    if (wid < 4) {
        f32x2 S2[8];
#pragma unroll
        for (int j = 0; j < 8; ++j) S2[j] = (f32x2){0.f, 0.f};
        __syncthreads();
        for (int c = 0; c < NCHUNK; ++c) {
            const float* fbc = fb + (c % 3) * CHUNK * FSTR + 8 * (lane & 7);
            const float* fbv = fb + (c % 3) * CHUNK * FSTR + 320 + 16 * wid + 2 * (lane >> 3);
            bf16_t* yp = Y + ((size_t)b * TPB) * 512 + h * 64 + 16 * wid + 2 * (lane >> 3);
            ScanHead ha, hb;
            scan_ldh(ha, fbc, fbv);
#define SCAN_STEP(HC, HN, SL) { \
                ScanBody bd; scan_ldb(bd, fbc + (SL) * FSTR); \
                if ((SL) + 1 < CHUNK) scan_ldh(HN, fbc + ((SL) + 1) * FSTR, fbv + ((SL) + 1) * FSTR); \
                f32x2 d0 = (f32x2){0.f, 0.f}, d1 = (f32x2){0.f, 0.f}; \
                _Pragma("unroll") for (int q = 0; q < 4; ++q) { const f32x2 k2 = (f32x2){HC.kk[q >> 1][2 * (q & 1)], HC.kk[q >> 1][2 * (q & 1) + 1]}; \
                    d0 = __builtin_elementwise_fma(S2[q], k2, d0); d1 = __builtin_elementwise_fma(S2[4 + q], k2, d1); } \
                const float sk0 = red8(d0[0] + d0[1]), sk1 = red8(d1[0] + d1[1]); \
                const f32x2 n0 = (f32x2){-sk0, -sk0}, n1 = (f32x2){-sk1, -sk1}, v0 = (f32x2){HC.v[0], HC.v[0]}, v1 = (f32x2){HC.v[1], HC.v[1]}; \
                f32x2 y0 = (f32x2){0.f, 0.f}, y1 = (f32x2){0.f, 0.f}; \
                _Pragma("unroll") for (int q = 0; q < 4; ++q) { \
                    const f32x2 w2 = (f32x2){bd.w[q >> 1][2 * (q & 1)], bd.w[q >> 1][2 * (q & 1) + 1]}, b2 = (f32x2){bd.bb[q >> 1][2 * (q & 1)], bd.bb[q >> 1][2 * (q & 1) + 1]}; \
                    const f32x2 kd2 = (f32x2){bd.kd[q >> 1][2 * (q & 1)], bd.kd[q >> 1][2 * (q & 1) + 1]}, r2 = (f32x2){bd.r[q >> 1][2 * (q & 1)], bd.r[q >> 1][2 * (q & 1) + 1]}; \
                    f32x2 t0 = S2[q] * w2; t0 = __builtin_elementwise_fma(b2, n0, t0); t0 = __builtin_elementwise_fma(kd2, v0, t0); \
                    f32x2 t1 = S2[4 + q] * w2; t1 = __builtin_elementwise_fma(b2, n1, t1); t1 = __builtin_elementwise_fma(kd2, v1, t1); \
                    S2[q] = t0; S2[4 + q] = t1; \
                    y0 = __builtin_elementwise_fma(t0, r2, y0); y1 = __builtin_elementwise_fma(t1, r2, y1); } \
                const float ya = red8(y0[0] + y0[1]), yb = red8(y1[0] + y1[1]); \
                const int pp = scan_pos(z, c * CHUNK + (SL)); \
                if ((lane & 7) == 0) *(unsigned*)(yp + (size_t)pp * 512) = pk_bf16(ya, yb); }
#pragma unroll 1
            for (int sl = 0; sl < CHUNK; sl += 2) {
                SCAN_STEP(ha, hb, sl)
                SCAN_STEP(hb, ha, sl + 1)
            }
            __syncthreads();
        }
    } else {
        ProdState st;
#pragma unroll
        for (int n = 0; n < 4; ++n) { st.aw[n] = (f32x4){0.f, 0.f, 0.f, 0.f}; st.aa[n] = (f32x4){0.f, 0.f, 0.f, 0.f}; }
        const int nrep = launder_i(1 + ((PROBE_MASK >> 10) & 1));
        const int pair = (wid - 4) >> 1, ph = (wid - 4) & 1;
        {
            float* f0 = fb + (pair % 3) * CHUNK * FSTR + ph * 16 * FSTR;
            scan_produce_A(p, pl, b, h, z, pair * CHUNK + ph * 16, f0, lane, st);
            if (pair == 0) scan_produce_B(p, pl, b, h, z, ph * 16, f0, lane, st);
        }
        __syncthreads();
        for (int c = 0; c < NCHUNK; ++c) {
            for (int rr_ = 0; rr_ < nrep; ++rr_) {
            if (pair == ((c + 1) & 1)) {
                if (c + 1 < NCHUNK) scan_produce_B(p, pl, b, h, z, (c + 1) * CHUNK + ph * 16, fb + ((c + 1) % 3) * CHUNK * FSTR + ph * 16 * FSTR, lane, st);
            } else {
                if (c + 2 < NCHUNK) scan_produce_A(p, pl, b, h, z, (c + 2) * CHUNK + ph * 16, fb + ((c + 2) % 3) * CHUNK * FSTR + ph * 16 * FSTR, lane, st);
            }
            }
            __syncthreads();
        }
    }
}

constexpr int ATT_STAGE = 20480;
__device__ __forceinline__ void attn_unit(const Params& p, int b, int h, int q0, int nkeys, unsigned char* lds, int do_write) {
    const int tid = ltid(), wid = __builtin_amdgcn_readfirstlane(tid >> 6), lane = tid & 63, fr = lane & 15, fq = lane >> 4;
    bf16_t* Q = (bf16_t*)(p.ws + OFF_Q);
    const bf16_t* KN = (const bf16_t*)(p.ws + OFF_KN);
    const bf16_t* KR = (const bf16_t*)(p.ws + OFF_KR);
    const bf16_t* VT = (const bf16_t*)(p.ws + OFF_VT);
    const size_t rb = (size_t)b * TPB;
    bf16x8 qf[2][3];
#pragma unroll
    for (int nq = 0; nq < 2; ++nq)
#pragma unroll
        for (int ks = 0; ks < 3; ++ks) qf[nq][ks] = *(const bf16x8*)(Q + (rb + q0 + wid * 32 + nq * 16 + fr) * 768 + h * 96 + ks * 32 + fq * 8);
    f32x4 oacc[4][2];
#pragma unroll
    for (int mt = 0; mt < 4; ++mt)
#pragma unroll
        for (int nq = 0; nq < 2; ++nq) oacc[mt][nq] = (f32x4){0.f, 0.f, 0.f, 0.f};
    float mrun[2] = {0.f, 0.f}, lsum[2] = {0.f, 0.f};
    const int c8 = (lane & 7) ^ ((4 * wid + (lane >> 4)) & 7);
    const bf16_t* knp = KN + (rb + 8 * wid + (lane >> 3)) * 512 + h * 64 + c8 * 8;
    const bf16_t* vtp = VT + ((size_t)(b * 8 + h) * 64 + 8 * wid + (lane >> 3)) * TPB + c8 * 8;
    const int c4 = (lane & 3) ^ ((lane >> 4) & 3);
    const bf16_t* krp = KR + (rb + 16 * (wid & 3) + (lane >> 2)) * 32 + c4 * 8;
    auto issue = [&](int t, int stg) {
        unsigned char* base = lds + stg * ATT_STAGE;
        const int k0 = t * 64;
        __builtin_amdgcn_global_load_lds((const GLB_AS unsigned*)(knp + (size_t)k0 * 512), (LDS_AS unsigned*)(base + wid * 1024), 16, 0, 0);
        __builtin_amdgcn_global_load_lds((const GLB_AS unsigned*)(vtp + k0), (LDS_AS unsigned*)(base + 12288 + wid * 1024), 16, 0, 0);
        if (wid < 4) __builtin_amdgcn_global_load_lds((const GLB_AS unsigned*)(krp + (size_t)k0 * 32), (LDS_AS unsigned*)(base + 8192 + wid * 1024), 16, 0, 0);
    };
    const int ntile = nkeys / 64;
    const int kz = fr >> 1, rz = (fr >> 2) & 3;
    issue(0, 0);
    asm volatile("s_waitcnt vmcnt(0)" ::: "memory");
    __builtin_amdgcn_s_barrier();
    asm volatile("" ::: "memory");
    for (int t = 0; t < ntile; ++t) {
        if (t + 1 < ntile) issue(t + 1, (t + 1) & 1);
        const unsigned char* Ks = lds + (t & 1) * ATT_STAGE;
        const unsigned char* Rs = Ks + 8192;
        const unsigned char* Vs = Ks + 12288;
        f32x4 sacc[4][2];
#pragma unroll
        for (int km = 0; km < 4; ++km)
#pragma unroll
            for (int nq = 0; nq < 2; ++nq) sacc[km][nq] = (f32x4){-mrun[nq], -mrun[nq], -mrun[nq], -mrun[nq]};
#pragma unroll
        for (int ks = 0; ks < 3; ++ks)
#pragma unroll
            for (int km = 0; km < 4; ++km) {
                const bf16x8 kf = ks < 2 ? *(const bf16x8*)(Ks + (km * 16 + fr) * 128 + (((ks * 4 + fq) ^ kz) * 16))
                                         : *(const bf16x8*)(Rs + (km * 16 + fr) * 64 + ((fq ^ rz) * 16));
#pragma unroll
                for (int nq = 0; nq < 2; ++nq) sacc[km][nq] = __builtin_amdgcn_mfma_f32_16x16x32_bf16(kf, qf[nq][ks], sacc[km][nq], 0, 0, 0);
            }
        float delta[2];
#pragma unroll
        for (int nq = 0; nq < 2; ++nq) {
            float mx = -1e30f;
#pragma unroll
            for (int km = 0; km < 4; ++km)
#pragma unroll
                for (int j = 0; j < 4; ++j) mx = fmaxf(mx, sacc[km][nq][j]);
            mx = fqmax(mx);
            delta[nq] = (t == 0) ? mx : fmaxf(mx, 0.f);
        }
        const bool exact = (t == 0) || (__builtin_amdgcn_ballot_w64(fmaxf(delta[0], delta[1]) > 60.0f) != 0ull);
        bf16x8 pf[2][2];
        float psum[2];
#pragma unroll
        for (int nq = 0; nq < 2; ++nq) {
            float ps = 0.f;
            if (exact) {
#pragma unroll
                for (int km = 0; km < 4; ++km)
#pragma unroll
                    for (int j = 0; j < 4; ++j) { const float e = __builtin_amdgcn_exp2f(sacc[km][nq][j] - delta[nq]); sacc[km][nq][j] = e; ps += e; }
            } else {
#pragma unroll
                for (int km = 0; km < 4; ++km)
#pragma unroll
                    for (int j = 0; j < 4; ++j) { const float e = __builtin_amdgcn_exp2f(sacc[km][nq][j]); sacc[km][nq][j] = e; ps += e; }
            }
            psum[nq] = ps;
#pragma unroll
            for (int kc = 0; kc < 2; ++kc) {
                union { uint4 u; bf16x8 v; } r;
                r.u.x = pk_bf16(sacc[2 * kc][nq][0], sacc[2 * kc][nq][1]); r.u.y = pk_bf16(sacc[2 * kc][nq][2], sacc[2 * kc][nq][3]);
                r.u.z = pk_bf16(sacc[2 * kc + 1][nq][0], sacc[2 * kc + 1][nq][1]); r.u.w = pk_bf16(sacc[2 * kc + 1][nq][2], sacc[2 * kc + 1][nq][3]);
                pf[kc][nq] = r.v;
            }
        }
        if (exact) {
#pragma unroll
            for (int nq = 0; nq < 2; ++nq) {
                const float alpha = (t == 0) ? 1.0f : __builtin_amdgcn_exp2f(-delta[nq]);
                lsum[nq] = lsum[nq] * alpha + psum[nq];
#pragma unroll
                for (int mt = 0; mt < 4; ++mt) oacc[mt][nq] = oacc[mt][nq] * alpha;
            }
        }
#pragma unroll
        for (int mt = 0; mt < 4; ++mt)
#pragma unroll
            for (int kc = 0; kc < 2; ++kc) {
                union { uint2 h2[2]; bf16x8 v; } r;
                const unsigned char* vrow = Vs + (mt * 16 + fr) * 128 + (fq & 1) * 8;
                r.h2[0] = *(const uint2*)(vrow + (((4 * kc + (fq >> 1)) ^ kz) * 16));
                r.h2[1] = *(const uint2*)(vrow + (((4 * kc + 2 + (fq >> 1)) ^ kz) * 16));
#pragma unroll
                for (int nq = 0; nq < 2; ++nq) oacc[mt][nq] = __builtin_amdgcn_mfma_f32_16x16x32_bf16(r.v, pf[kc][nq], oacc[mt][nq], 0, 0, 0);
            }
        if (!exact) {
#pragma unroll
            for (int nq = 0; nq < 2; ++nq) {
                const float alpha = __builtin_amdgcn_exp2f(-delta[nq]);
                lsum[nq] = (lsum[nq] + psum[nq]) * alpha;
#pragma unroll
                for (int mt = 0; mt < 4; ++mt) oacc[mt][nq] = oacc[mt][nq] * alpha;
            }
        }
#pragma unroll
        for (int nq = 0; nq < 2; ++nq) mrun[nq] += delta[nq];
        asm volatile("s_waitcnt vmcnt(0) lgkmcnt(0)" ::: "memory");
        __builtin_amdgcn_s_barrier();
        asm volatile("" ::: "memory");
    }
#pragma unroll
    for (int nq = 0; nq < 2; ++nq) {
        const float inv = 1.0f / fqsum(lsum[nq]);
        bf16_t* orow = Q + (rb + q0 + wid * 32 + nq * 16 + fr) * 768 + h * 96;
#pragma unroll
        for (int mt = 0; mt < 4; ++mt) {
            uint2 o; o.x = pk_bf16(oacc[mt][nq][0] * inv, oacc[mt][nq][1] * inv); o.y = pk_bf16(oacc[mt][nq][2] * inv, oacc[mt][nq][3] * inv);
            if (do_write) *(uint2*)(orow + mt * 16 + fq * 4) = o;
        }
    }
}

__device__ __forceinline__ void p3_phase(const Params& pin, int l, unsigned char* lds) {
    const Params p = launder(pin); l = launder_i(l);
    for (int r = 0, nr = launder_i(1 + ((PROBE_MASK >> 1) & 1)); r < nr; ++r)
        for (int u = blockIdx.x; u < 256; u += gridDim.x) scan_unit(p, l, u, lds);
    const int nunits = (l == DEPTH - 1) ? 1024 : 1152;
    for (int r = launder_i(((PROBE_MASK >> 9) & 1) ? 0 : 1); r < 2; ++r)
    for (int u = blockIdx.x; u < nunits; u += gridDim.x) {
        if (u < 1024) { const int bh = u >> 3, qt = u & 7; attn_unit(p, bh >> 3, bh & 7, CTXL + qt * 256, TPB, lds, r); }
        else { const int bh = u - 1024; attn_unit(p, bh >> 3, bh & 7, 0, CTXL, lds, r); }
    }
}

__device__ __forceinline__ void p35_phase(const Params& pin, int l, bool skip_ctx, unsigned char* lds) {
    const Params p = launder(pin); l = launder_i(l); const int tid = ltid();
    const bf16_t* SG = (const bf16_t*)(p.ws + OFF_SG);
    const bf16_t* W = (const bf16_t*)(p.ws + OFF_W) + WO_GUP;
    const bf16_t* YF = (const bf16_t*)(p.ws + OFF_YF);
    const bf16_t* YB = (const bf16_t*)(p.ws + OFF_YB);
    const bf16_t* Hr = (const bf16_t*)(p.ws + OFF_R3);
    bf16_t* RWO = (bf16_t*)(p.ws + OFF_RWO);
    const float* mu = p.rw_mu + (size_t)l * 1920;
    const int lane = tid & 63, wid = tid >> 6, wr = wid >> 1, wc = wid & 1, fr = lane & 15, fq = lane >> 4;
    float* gt = (float*)lds;
    constexpr int GP = 132;
    for (int t = blockIdx.x; t < 288 * 4; t += gridDim.x) {
        int mt, nt; tile_mn(t, 4, mt, nt);
        if (skip_ctx && (mt % 18) < 2) continue;
        f32x4 acc[2][4]; zero_acc<2>(acc);
        gemm_mainloop<2, 1>(acc, SG + (size_t)mt * 128 * 128, 128, 64, W + (size_t)nt * 128 * 128, 128, 2, lds, tid);
#pragma unroll
        for (int m = 0; m < 2; ++m)
#pragma unroll
            for (int n = 0; n < 4; ++n) *(f32x4*)(gt + (wr * 32 + m * 16 + fr) * GP + wc * 64 + n * 16 + fq * 4) = acc[m][n];
        __syncthreads();
        const int pp0 = (mt % 18) * 128;
#pragma unroll 1
        for (int it = 0; it < 4; ++it) {
            const int item = tid + it * NTHREADS, lrow = item >> 4, cg = item & 15, pp = pp0 + lrow;
            const size_t row = (size_t)mt * 128 + lrow;
            const int C = nt * 128 + cg * 8;
            const bool hp = (pp != 0 && pp != CTXL), hn = (pp != CTXL - 1 && pp != TPB - 1);
            const bf16_t* hr = Hr + row * 1920;
            float yf[8], yb[8], r8[8], k8[8], v8[8];
            unpack8(*(const uint4*)(YF + row * 512 + C), yf); unpack8(*(const uint4*)(YB + row * 512 + C), yb);
            shift8(hr, hp, hn, C, mu, r8); shift8(hr, hp, hn, 512 + C, mu, k8); shift8(hr, hp, hn, 1024 + C, mu, v8);
            const float* rkp = p.rw_r_k + (size_t)l * 512 + C;
            float s1 = 0.f, bs = 0.f;
#pragma unroll
            for (int i = 0; i < 8; ++i) { yf[i] += yb[i]; s1 += yf[i]; bs += r8[i] * k8[i] * rkp[i]; }
            s1 = red8(s1); bs = red8(bs);
            const float mean = s1 * (1.0f / 64.0f);
            float s2 = 0.f;
#pragma unroll
            for (int i = 0; i < 8; ++i) { const float d = yf[i] - mean; s2 += d * d; }
            s2 = red8(s2);
            const float rstd = rsqrtf(s2 * (1.0f / 64.0f) + 64e-5f);
            const float* ggp = p.rw_gn_g + (size_t)l * 512 + C; const float* gbp = p.rw_gn_b + (size_t)l * 512 + C;
            const f32x4 g0 = *(const f32x4*)(gt + lrow * GP + cg * 8), g1 = *(const f32x4*)(gt + lrow * GP + cg * 8 + 4);
            float o[8];
#pragma unroll
            for (int i = 0; i < 8; ++i) o[i] = ((yf[i] - mean) * rstd * ggp[i] + gbp[i] + bs * v8[i]) * (i < 4 ? g0[i] : g1[i - 4]);
            uint4 ov; ov.x = pk_bf16(o[0], o[1]); ov.y = pk_bf16(o[2], o[3]); ov.z = pk_bf16(o[4], o[5]); ov.w = pk_bf16(o[6], o[7]);
            *(uint4*)(RWO + row * 512 + C) = ov;
        }
        __syncthreads();
    }
}

__device__ __forceinline__ void p4_phase(const Params& pin, bool skip_ctx, unsigned char* lds) {
    const Params p = launder(pin); const int tid = ltid();
    const bf16_t* XM = (const bf16_t*)(p.ws + OFF_R6);
    const bf16_t* W = (const bf16_t*)(p.ws + OFF_W);
    bf16_t* MG = (bf16_t*)(p.ws + OFF_MRG);
    const int lane = tid & 63, wid = tid >> 6, wr = wid >> 1, wc = wid & 1, fr = lane & 15, fq = lane >> 4;
    for (int t = blockIdx.x; t < 288 * 8; t += gridDim.x) {
        int mt, nt; tile_mn(t, 8, mt, nt);
        if (skip_ctx && (mt % 18) < 2) continue;
        f32x4 g[3][2][4];
#pragma unroll
        for (int i = 0; i < 3; ++i) zero_acc<2>(g[i]);
        gemm_gate3(g, XM + (size_t)mt * 128 * 1024, W + WO_IN + (size_t)(4224 + nt * 128) * 1024, 16, lds, tid);
        typedef __fp16 h16x2 __attribute__((ext_vector_type(2)));
        h16x2 gp[3][2][4][2];
#pragma unroll
        for (int i = 0; i < 3; ++i)
#pragma unroll
            for (int m = 0; m < 2; ++m)
#pragma unroll
                for (int n = 0; n < 4; ++n) {
                    gp[i][m][n][0] = __builtin_amdgcn_cvt_pkrtz(sigmoidf_(g[i][m][n][0]), sigmoidf_(g[i][m][n][1]));
                    gp[i][m][n][1] = __builtin_amdgcn_cvt_pkrtz(sigmoidf_(g[i][m][n][2]), sigmoidf_(g[i][m][n][3]));
                }
        f32x4 mg[2][4]; zero_acc<2>(mg);
#pragma unroll 1
        for (int i = 0; i < 3; ++i) {
            const bf16_t* Ab; int lda, kst; const bf16_t* Wb;
            if (i == 0) { Ab = (const bf16_t*)(p.ws + OFF_Q); lda = 768; kst = 96; Wb = W + WO_OA; }
            else if (i == 1) { Ab = (const bf16_t*)(p.ws + OFF_R5); lda = 512; kst = 64; Wb = W + WO_OC; }
            else { Ab = (const bf16_t*)(p.ws + OFF_RWO); lda = 512; kst = 64; Wb = W + WO_OR; }
            f32x4 a[2][4]; zero_acc<2>(a);
            gemm_mainloop<2, 1>(a, Ab + (size_t)mt * 128 * lda, lda, kst, Wb + (size_t)nt * 128 * 512, 512, 8, lds, tid);
#pragma unroll
            for (int m = 0; m < 2; ++m)
#pragma unroll
                for (int n = 0; n < 4; ++n) {
                    const h16x2 g0 = i == 0 ? gp[0][m][n][0] : (i == 1 ? gp[1][m][n][0] : gp[2][m][n][0]);
                    const h16x2 g1 = i == 0 ? gp[0][m][n][1] : (i == 1 ? gp[1][m][n][1] : gp[2][m][n][1]);
                    mg[m][n][0] += (float)g0[0] * a[m][n][0]; mg[m][n][1] += (float)g0[1] * a[m][n][1];
                    mg[m][n][2] += (float)g1[0] * a[m][n][2]; mg[m][n][3] += (float)g1[1] * a[m][n][3];
                }
        }
#pragma unroll
        for (int m = 0; m < 2; ++m) {
            const size_t row = (size_t)mt * 128 + wr * 32 + m * 16 + fr;
#pragma unroll
            for (int n = 0; n < 4; ++n) {
                uint2 o; o.x = pk_bf16(mg[m][n][0], mg[m][n][1]); o.y = pk_bf16(mg[m][n][2], mg[m][n][3]);
                *(uint2*)(MG + row * 1024 + nt * 128 + wc * 64 + n * 16 + fq * 4) = o;
            }
        }
    }
}

template <int MT>
__device__ __forceinline__ void resid_tile(const Params& p, int l, const bf16_t* A, int lda, int nk, const bf16_t* Wt, int ldb, int goff, bool x_from_input,
                                           const float* lng, const float* lnb, int row0, int nt, unsigned char* lds, int tid) {
    const int lane = tid & 63, wid = tid >> 6, wr = wid >> 1, wc = wid & 1, fr = lane & 15, fq = lane >> 4;
    f32x4 acc[MT][4]; zero_acc<MT>(acc);
    gemm_mainloop<MT, 1>(acc, A + (size_t)row0 * lda, lda, 64, Wt + (size_t)nt * 128 * ldb, ldb, nk, lds, tid);
    const int b = row0 / TPB, pp0 = row0 % TPB;
    const float* gv = modv_ptr(p, l, b, pp0) + goff;
    const float* stats = (const float*)(p.ws + OFF_STATS);
#pragma unroll
    for (int m = 0; m < MT; ++m) {
        const int lr = wr * 16 * MT + m * 16 + fr, pp = pp0 + lr;
        const float* xi = x_rd(p, x_from_input, b, pp);
        float* xo = x_wr(p, b, pp);
        float mean = 0.f, rstd = 1.f;
        if (!x_from_input) { const size_t row = (size_t)row0 + lr; mean = stats[row * 2]; rstd = stats[row * 2 + 1]; }
#pragma unroll
        for (int n = 0; n < 4; ++n) {
            const int col = nt * 128 + wc * 64 + n * 16 + fq * 4;
            f32x4 xv = *(const f32x4*)(xi + col); const f32x4 g4 = *(const f32x4*)(gv + col);
            if (!x_from_input) {
                const f32x4 lg = *(const f32x4*)(lng + col), lb = *(const f32x4*)(lnb + col);
#pragma unroll
                for (int j = 0; j < 4; ++j) xv[j] = (xv[j] - mean) * rstd * lg[j] + lb[j];
            }
            f32x4 o;
#pragma unroll
            for (int j = 0; j < 4; ++j) o[j] = ALPHA * xv[j] + g4[j] * acc[m][n][j];
            *(f32x4*)(xo + col) = o;
        }
    }
}
__device__ __forceinline__ void resid_tile256(const Params& p, int l, const bf16_t* A, int lda, int nk, const bf16_t* Wt, int ldb, int goff, bool x_from_input,
                                              const float* lng, const float* lnb, int row0, int nt256, unsigned char* lds, int tid) {
    const int lane = tid & 63, wid = tid >> 6, wr = wid >> 2, wc = wid & 3, fr = lane & 15, fq = lane >> 4;
    f32x4 acc[8][4]; zero_acc<8>(acc);
    Seg sg; sg.A = A + (size_t)row0 * lda; sg.Bt = Wt + (size_t)nt256 * 256 * ldb; sg.lda = lda; sg.a_kstep = 64; sg.ldb = ldb; sg.nk = nk;
    int st = 0;
    gemm_stream256(acc, sg, sg, false, true, st, lds, tid);
    const int b = row0 / TPB, pp0 = row0 % TPB;
    const float* gv = modv_ptr(p, l, b, pp0) + goff;
    const float* stats = (const float*)(p.ws + OFF_STATS);
#pragma unroll
    for (int m = 0; m < 8; ++m) {
        const int lr = wr * 128 + m * 16 + fr, pp = pp0 + lr;
        const float* xi = x_rd(p, x_from_input, b, pp);
        float* xo = x_wr(p, b, pp);
        float mean = 0.f, rstd = 1.f;
        if (!x_from_input) { const size_t row = (size_t)row0 + lr; mean = stats[row * 2]; rstd = stats[row * 2 + 1]; }
#pragma unroll
        for (int n = 0; n < 4; ++n) {
            const int col = nt256 * 256 + wc * 64 + n * 16 + fq * 4;
            f32x4 xv = *(const f32x4*)(xi + col); const f32x4 g4 = *(const f32x4*)(gv + col);
            if (!x_from_input) {
                const f32x4 lg = *(const f32x4*)(lng + col), lb = *(const f32x4*)(lnb + col);
#pragma unroll
                for (int j = 0; j < 4; ++j) xv[j] = (xv[j] - mean) * rstd * lg[j] + lb[j];
            }
            f32x4 o;
#pragma unroll
            for (int j = 0; j < 4; ++j) o[j] = ALPHA * xv[j] + g4[j] * acc[m][n][j];
            *(f32x4*)(xo + col) = o;
        }
    }
}
__device__ __forceinline__ void resid_gemm_phase(const Params& pin, int l, size_t a_off, int lda, int nk, size_t w_off, int ldb, int goff, bool x_from_input, const float* lng, const float* lnb, bool skip_ctx, unsigned char* lds) {
    const Params p = launder(pin); l = launder_i(l);
    const int tid = ltid();
    const bf16_t* A = (const bf16_t*)(p.ws + a_off);
    const bf16_t* Wt = (const bf16_t*)(p.ws + OFF_W) + w_off;
    if (gridDim.x == 256) {
        for (int t = blockIdx.x; t < 512; t += 256) {
            int mt, nt; tile_mn(t, 4, mt, nt);
            if (skip_ctx && (mt % 9) == 0) continue;
            resid_tile256(p, l, A, lda, nk, Wt, ldb, goff, x_from_input, lng, lnb, mt * 256, nt, lds, tid);
        }
        int mt, nt; tile_mn(512 + (blockIdx.x >> 2), 4, mt, nt);
        const int q = blockIdx.x & 3;
        if (!(skip_ctx && (mt % 9) == 0)) resid_tile<2>(p, l, A, lda, nk, Wt, ldb, goff, x_from_input, lng, lnb, mt * 256 + (q >> 1) * 128, nt * 2 + (q & 1), lds, tid);
    } else {
        for (int t = blockIdx.x; t < 144 * 8; t += gridDim.x) {
            int mt, nt; tile_mn(t, 8, mt, nt);
            if (skip_ctx && (mt % 9) == 0) continue;
            resid_tile<4>(p, l, A, lda, nk, Wt, ldb, goff, x_from_input, lng, lnb, mt * 256, nt, lds, tid);
        }
    }
}

__device__ __forceinline__ void ln_phase(const Params& pin, const float* g, const float* bta, int lmod, int shoff, bool write_xmod, bool write_x, bool skip_ctx) {
    const Params p = launder(pin); lmod = launder_i(lmod);
    const int tid = ltid(), wid = tid >> 6, lane = tid & 63;
    bf16_t* xm = (bf16_t*)(p.ws + OFF_R6);
    float* stats = (float*)(p.ws + OFF_STATS);
    for (int row = blockIdx.x * 8 + wid; row < MROWS; row += gridDim.x * 8) {
        const int b = row / TPB, pp = row % TPB;
        if (skip_ctx && pp < CTXL) continue;
        float* xp = x_wr(p, b, pp);
        f32x4 v[4];
        float s = 0.f;
#pragma unroll
        for (int i = 0; i < 4; ++i) { v[i] = *(const f32x4*)(xp + i * 256 + lane * 4); s += (v[i][0] + v[i][1]) + (v[i][2] + v[i][3]); }
        const float mean = wave_sum(s) * (1.0f / 1024.0f);
        float q = 0.f;
#pragma unroll
        for (int i = 0; i < 4; ++i)
#pragma unroll
            for (int j = 0; j < 4; ++j) { const float d = v[i][j] - mean; q += d * d; }
        const float rstd = rsqrtf(wave_sum(q) * (1.0f / 1024.0f) + 1e-5f);
        if (lane == 0) { stats[(size_t)row * 2] = mean; stats[(size_t)row * 2 + 1] = rstd; }
        const float* mv = write_xmod ? modv_ptr(p, lmod, b, pp) + shoff : nullptr;
#pragma unroll
        for (int i = 0; i < 4; ++i) {
            const int c = i * 256 + lane * 4;
            const f32x4 g4 = *(const f32x4*)(g + c), b4 = *(const f32x4*)(bta + c);
            f32x4 o;
#pragma unroll
            for (int j = 0; j < 4; ++j) o[j] = (v[i][j] - mean) * rstd * g4[j] + b4[j];
            if (write_x) *(f32x4*)(xp + c) = o;
            if (write_xmod) {
                const f32x4 sh = *(const f32x4*)(mv + c), sc = *(const f32x4*)(mv + 1024 + c);
                uint2 ov; ov.x = pk_bf16(o[0] * (1.f + sc[0]) + sh[0], o[1] * (1.f + sc[1]) + sh[1]); ov.y = pk_bf16(o[2] * (1.f + sc[2]) + sh[2], o[3] * (1.f + sc[3]) + sh[3]);
                *(uint2*)(xm + (size_t)row * 1024 + c) = ov;
            }
        }
    }
}

__device__ __forceinline__ void p7_phase(const Params& pin, bool skip_ctx, unsigned char* lds) {
    const Params p = launder(pin); const int tid = ltid();
    const bf16_t* A = (const bf16_t*)(p.ws + OFF_R6);
    const bf16_t* W = (const bf16_t*)(p.ws + OFF_W) + WO_13;
    bf16_t* HF = (bf16_t*)(p.ws + OFF_HF);
    const int lane = tid & 63, wid = tid >> 6, wr = wid >> 2, wc = wid & 3, fr = lane & 15, fq = lane >> 4;
    auto seg = [&](int t) { int mt, nt; tile_mn(t, 22, mt, nt); Seg g; g.A = A + (size_t)mt * 256 * 1024; g.Bt = W + (size_t)nt * 256 * 1024; g.lda = 1024; g.a_kstep = 64; g.ldb = 1024; g.nk = 16; return g; };
    auto valid = [&](int t) { int mt, nt; tile_mn(t, 22, mt, nt); return !(skip_ctx && (mt % 9) == 0); };
    auto nextv = [&](int t) { while (t < 144 * 22 && !valid(t)) t += gridDim.x; return t; };
    int st = 0; bool first = true;
    for (int t = nextv(blockIdx.x); t < 144 * 22;) {
        int mt, nt; tile_mn(t, 22, mt, nt);
        const int tn = nextv(t + gridDim.x); const bool hn = tn < 144 * 22;
        f32x4 acc[8][4]; zero_acc<8>(acc);
        gemm_stream256(acc, seg(t), seg(hn ? tn : t), hn, first, st, lds, tid); first = false;
        const int G = nt * 4 + wc;
#pragma unroll
        for (int m = 0; m < 8; ++m) {
            const size_t row = (size_t)mt * 256 + wr * 128 + m * 16 + fr;
#pragma unroll
            for (int n = 0; n < 2; ++n) {
                float o[4];
#pragma unroll
                for (int j = 0; j < 4; ++j) o[j] = siluf_(acc[m][n][j]) * acc[m][n + 2][j];
                uint2 ov; ov.x = pk_bf16(o[0], o[1]); ov.y = pk_bf16(o[2], o[3]);
                *(uint2*)(HF + row * DFF + G * 32 + n * 16 + fq * 4) = ov;
            }
        }
        t = tn;
    }
}

__global__ void __launch_bounds__(NTHREADS) fwd_megakernel(Params p) {
    extern __shared__ __attribute__((aligned(16))) unsigned char lds[];
    cg::grid_group grid = cg::this_grid();
    unsigned* gbar = (unsigned*)(p.ws + OFF_BAR); unsigned epoch = 0;
#define GSYNC() grid_barrier(gbar, epoch)
    if (p.ws == nullptr) grid.sync();
    modv_phase(p, lds);
    convert_layer(p, 0, lds);
    {
        bf16_t* Wm = (bf16_t*)(p.ws + OFF_W) + WO_IN + (size_t)672 * 1024;
        for (int i = blockIdx.x * NTHREADS + threadIdx.x; i < 96 * 1024 / 2; i += gridDim.x * NTHREADS) ((unsigned*)Wm)[i] = 0u;
    }
    GSYNC();
    xmod0_phase(p);
    GSYNC();
#pragma unroll 1
    for (int l = 0; l < DEPTH; ++l) {
        const bool last = (l == DEPTH - 1);
        for (int r = 0, nr = launder_i(1 + ((PROBE_MASK >> 2) & 1)); r < nr; ++r) p1_phase(p, lds);
        GSYNC();
        for (int r = 0, nr = launder_i(1 + ((PROBE_MASK >> 3) & 1)); r < nr; ++r) p2a_phase(p, l);
        GSYNC();
        for (int r = 0, nr = launder_i(1 + ((PROBE_MASK >> 4) & 1)); r < nr; ++r) p2b_phase(p, l, lds);
        GSYNC();
        p3_phase(p, l, lds);
        GSYNC();
        for (int r = 0, nr = launder_i(1 + ((PROBE_MASK >> 5) & 1)); r < nr; ++r) p35_phase(p, l, last, lds);
        GSYNC();
        for (int r = 0, nr = launder_i(1 + ((PROBE_MASK >> 6) & 1)); r < nr; ++r) p4_phase(p, last, lds);
        GSYNC();
        resid_gemm_phase(p, l, OFF_MRG, 1024, 16, WO_OUT, 1024, 2048, l == 0, p.ln2_g + (l > 0 ? l - 1 : 0) * 1024, p.ln2_b + (l > 0 ? l - 1 : 0) * 1024, last, lds);
        GSYNC();
        ln_phase(p, p.ln1_g + l * 1024, p.ln1_b + l * 1024, l, 3072, true, false, last);
        GSYNC();
        for (int r = 0, nr = launder_i(1 + ((PROBE_MASK >> 0) & 1)); r < nr; ++r) p7_phase(p, last, lds);
        GSYNC();
        resid_gemm_phase(p, l, OFF_HF, DFF, 44, WO_2, DFF, 5120, false, p.ln1_g + l * 1024, p.ln1_b + l * 1024, last, lds);
        GSYNC();
        ln_phase(p, p.ln2_g + l * 1024, p.ln2_b + l * 1024, last ? l : l + 1, 0, !last, last, last);
        if (!last) for (int r = 0, nr = launder_i(1 + ((PROBE_MASK >> 7) & 1)); r < nr; ++r) convert_layer(p, l + 1, lds);
        for (int r = 0, nr = launder_i(((PROBE_MASK >> 8) & 1) * 10); r < nr; ++r) GSYNC();
        GSYNC();
    }
}

extern "C" void kernel_launch(void* const* d_in, const int* in_sizes, int n_in, void* d_out,
                              int out_size, void* d_ws, size_t ws_size, hipStream_t stream) {
    static int grid_blocks = 0;
    if (!grid_blocks) {
        int dev = 0, cus = 0, per_cu = 0;
        hipGetDevice(&dev);
        hipDeviceGetAttribute(&cus, hipDeviceAttributeMultiprocessorCount, dev);
        if (hipFuncSetAttribute((const void*)fwd_megakernel, hipFuncAttributeMaxDynamicSharedMemorySize, LDS_BYTES) != hipSuccess)
            fprintf(stderr, "hipFuncSetAttribute failed\n");
        hipOccupancyMaxActiveBlocksPerMultiprocessor(&per_cu, (const void*)fwd_megakernel, NTHREADS, LDS_BYTES);
        if (per_cu < 1) fprintf(stderr, "occupancy query says %d blocks/CU\n", per_cu);
        (void)hipGetLastError();
        grid_blocks = cus > 0 ? cus : 256;
        if (ws_size < WS_END) { fprintf(stderr, "workspace too small: %zu < %zu\n", ws_size, (size_t)WS_END); grid_blocks = -1; }
        if (n_in != 33) { fprintf(stderr, "expected 33 inputs, got %d\n", n_in); grid_blocks = -1; }
    }
    if (grid_blocks < 0) return;
    if (hipMemsetAsync((unsigned char*)d_ws + OFF_BAR, 0, 1024, stream) != hipSuccess) fprintf(stderr, "memset failed\n");
    Params p{};
    const float** pp = (const float**)&p;
    for (int i = 0; i < 33; ++i) pp[i] = (const float*)d_in[i];
    p.out = (float*)d_out;
    p.ws = (unsigned char*)d_ws;
    void* args[] = {&p};
    hipError_t e = hipLaunchCooperativeKernel((void*)fwd_megakernel, dim3(grid_blocks), dim3(NTHREADS), args, LDS_BYTES, stream);
    if (e != hipSuccess) fprintf(stderr, "cooperative launch failed: %s (grid %d)\n", hipGetErrorString(e), grid_blocks);
}
```

```cpp
#include <hip/hip_runtime.h>
#include <hip/hip_cooperative_groups.h>
#include <cstdio>
#include <cstdint>
namespace cg = cooperative_groups;

typedef unsigned short bf16_t;
typedef short bf16x8 __attribute__((ext_vector_type(8)));
typedef float f32x4 __attribute__((ext_vector_type(4)));

#ifndef PROBE_MASK
#define PROBE_MASK 0
#endif
constexpr int BATCH = 16, SEQ = 2048, CTXL = 256, DM = 1024, DEPTH = 4, DFF = 2816, DIN = 7200;
constexpr int TPB = SEQ + CTXL;
constexpr int MROWS = BATCH * TPB;
constexpr int NTHREADS = 512;
constexpr int LDS_BYTES = 152 * 1024;
constexpr float ALPHA = 1.681792830507429f;
constexpr float QSCALE = 0.10206207261596575f * 1.4426950408889634f;

constexpr size_t WO_IN = 0;
constexpr size_t WO_UQ = WO_IN + (size_t)7296 * 1024;
constexpr size_t WO_UKV = WO_UQ + (size_t)768 * 384;
constexpr size_t WO_OA = WO_UKV + (size_t)1024 * 256;
constexpr size_t WO_OC = WO_OA + (size_t)1024 * 512;
constexpr size_t WO_OR = WO_OC + (size_t)1024 * 512;
constexpr size_t WO_OUT = WO_OR + (size_t)1024 * 512;
constexpr size_t WO_13 = WO_OUT + (size_t)1024 * 1024;
constexpr size_t WO_2 = WO_13 + (size_t)5632 * 1024;
constexpr size_t WO_UP = WO_2 + (size_t)1024 * 2816;
constexpr size_t WO_AUP = WO_UP + (size_t)2 * 512 * 64;
constexpr size_t WO_GUP = WO_AUP + (size_t)2 * 512 * 64;
constexpr size_t W_ELEMS = WO_GUP + (size_t)512 * 128;

constexpr size_t al256(size_t x) { return (x + 255) & ~(size_t)255; }
constexpr size_t OFF_BAR = 0;
constexpr size_t OFF_W = 1024;
constexpr size_t OFF_MODV = al256(OFF_W + W_ELEMS * 2);
constexpr size_t OFF_ROPE = al256(OFF_MODV + (size_t)4 * 17 * 6144 * 4);
constexpr size_t OFF_RSQ = al256(OFF_ROPE + 64 * 8 * 2 * 4);
constexpr size_t OFF_RSKV = al256(OFF_RSQ + (size_t)MROWS * 4);
constexpr size_t OFF_STATS = al256(OFF_RSKV + (size_t)MROWS * 4);
constexpr size_t OFF_XC = al256(OFF_STATS + (size_t)MROWS * 8);
constexpr size_t OFF_R1 = al256(OFF_XC + (size_t)BATCH * CTXL * DM * 4);
constexpr size_t OFF_R2 = al256(OFF_R1 + (size_t)MROWS * 672 * 2);
constexpr size_t OFF_R3 = OFF_R2 + (size_t)MROWS * 1536 * 2;
constexpr size_t OFF_R4 = al256(OFF_R3 + (size_t)MROWS * 1920 * 2);
constexpr size_t OFF_R5 = al256(OFF_R4 + (size_t)MROWS * (512 + 512 + 32) * 2);
constexpr size_t OFF_R6 = al256(OFF_R5 + (size_t)MROWS * 512 * 2);
constexpr size_t WS_END = al256(OFF_R6 + (size_t)MROWS * 1024 * 2);
constexpr size_t OFF_Q = OFF_R2;
constexpr size_t OFF_YF = OFF_R2 + (size_t)MROWS * 768 * 2;
constexpr size_t OFF_SG = OFF_YF + (size_t)MROWS * 512 * 2;
constexpr size_t OFF_YB = OFF_R1;
constexpr size_t OFF_KN = OFF_R4;
constexpr size_t OFF_VT = OFF_R4 + (size_t)MROWS * 512 * 2;
constexpr size_t OFF_KR = OFF_VT + (size_t)MROWS * 512 * 2;
constexpr size_t OFF_RWO = OFF_R4;
constexpr size_t OFF_MRG = OFF_R3;
constexpr size_t OFF_HF = OFF_R2;
static_assert(OFF_SG + (size_t)MROWS * 128 * 2 <= OFF_R3, "R2 overlay overflow");
static_assert((size_t)MROWS * 2816 * 2 <= OFF_R4 - OFF_R2, "HF overflow");

struct Params {
    const float *x, *c, *ctx, *c_ctx, *mod_w, *mod_b, *w_in, *q_norm, *w_uq, *kv_norm, *w_ukv, *w_o_attn,
        *conv_w, *w_o_conv, *rw_mu, *rw_w0, *rw_w_up, *rw_a0, *rw_a_up, *rw_g_up, *rw_k_k, *rw_k_a,
        *rw_r_k, *rw_gn_g, *rw_gn_b, *w_o_rwkv, *w_out, *ln1_g, *ln1_b, *ffn_w13, *ffn_w2, *ln2_g, *ln2_b;
    float* out;
    unsigned char* ws;
};

typedef __attribute__((address_space(1))) unsigned char gchar_t;
typedef __attribute__((address_space(1))) float gfloat_t;
__device__ __forceinline__ Params launder(const Params& a) {
    Params q = a;
    unsigned long long w = (unsigned long long)a.ws, o = (unsigned long long)a.out;
    unsigned wl = __builtin_amdgcn_readfirstlane((unsigned)w), wh = __builtin_amdgcn_readfirstlane((unsigned)(w >> 32));
    unsigned ol = __builtin_amdgcn_readfirstlane((unsigned)o), oh = __builtin_amdgcn_readfirstlane((unsigned)(o >> 32));
    asm volatile("" : "+s"(wl), "+s"(wh), "+s"(ol), "+s"(oh));
    w = ((unsigned long long)wh << 32) | wl; o = ((unsigned long long)oh << 32) | ol;
    q.ws = (unsigned char*)(gchar_t*)w; q.out = (float*)(gfloat_t*)o;
    return q;
}
__device__ __forceinline__ int launder_i(int v) { v = __builtin_amdgcn_readfirstlane(v); asm volatile("" : "+s"(v)); return v; }
__device__ __forceinline__ int ltid() { int t = threadIdx.x; asm volatile("" : "+v"(t)); return t; }
__device__ __forceinline__ unsigned pk_bf16(float lo, float hi) { unsigned r; asm("v_cvt_pk_bf16_f32 %0, %1, %2" : "=v"(r) : "v"(lo), "v"(hi)); return r; }
__device__ __forceinline__ float bf_lo(unsigned u) { return __uint_as_float(u << 16); }
__device__ __forceinline__ float bf_hi(unsigned u) { return __uint_as_float(u & 0xffff0000u); }
__device__ __forceinline__ float bf1(bf16_t h) { return __uint_as_float(((unsigned)h) << 16); }
__device__ __forceinline__ float x32sum(float x) { unsigned u = __float_as_uint(x); auto r = __builtin_amdgcn_permlane32_swap(u, u, false, false); return __uint_as_float(r[0]) + __uint_as_float(r[1]); }
__device__ __forceinline__ float x16sum(float x) { unsigned u = __float_as_uint(x); auto r = __builtin_amdgcn_permlane16_swap(u, u, false, false); return __uint_as_float(r[0]) + __uint_as_float(r[1]); }
__device__ __forceinline__ float x32max(float x) { unsigned u = __float_as_uint(x); auto r = __builtin_amdgcn_permlane32_swap(u, u, false, false); return fmaxf(__uint_as_float(r[0]), __uint_as_float(r[1])); }
__device__ __forceinline__ float x16max(float x) { unsigned u = __float_as_uint(x); auto r = __builtin_amdgcn_permlane16_swap(u, u, false, false); return fmaxf(__uint_as_float(r[0]), __uint_as_float(r[1])); }
__device__ __forceinline__ float fqsum(float x) { return x16sum(x32sum(x)); }
__device__ __forceinline__ float fqmax(float x) { return x16max(x32max(x)); }
__device__ __forceinline__ float wave_sum(float v) {
#pragma unroll
    for (int o = 1; o < 16; o <<= 1) v += __shfl_xor(v, o);
    return fqsum(v);
}
template <int CTRL> __device__ __forceinline__ float dpp_add(float x) { return x + __uint_as_float((unsigned)__builtin_amdgcn_update_dpp(0, (int)__float_as_uint(x), CTRL, 0xf, 0xf, true)); }
__device__ __forceinline__ float red8(float x) { x = dpp_add<0xB1>(x); x = dpp_add<0x4E>(x); x = dpp_add<0x141>(x); return x; }
__device__ __forceinline__ uint4 widen16(uint2 a, uint2 b) {
    auto r0 = __builtin_amdgcn_permlane16_swap(a.x, b.x, false, false);
    auto r1 = __builtin_amdgcn_permlane16_swap(a.y, b.y, false, false);
    return make_uint4(r0[0], r1[0], r0[1], r1[1]);
}
__device__ __forceinline__ float sigmoidf_(float x) { return 1.0f / (1.0f + __expf(-x)); }
__device__ __forceinline__ float siluf_(float x) { return x / (1.0f + __expf(-x)); }

__device__ __forceinline__ const float* x_rd(const Params& p, bool from_input, int b, int pp) {
    if (pp < CTXL) return (from_input ? p.ctx : (const float*)(p.ws + OFF_XC)) + ((size_t)b * CTXL + pp) * DM;
    return (from_input ? p.x : (const float*)p.out) + ((size_t)b * SEQ + (pp - CTXL)) * DM;
}
__device__ __forceinline__ float* x_wr(const Params& p, int b, int pp) {
    if (pp < CTXL) return (float*)(p.ws + OFF_XC) + ((size_t)b * CTXL + pp) * DM;
    return p.out + ((size_t)b * SEQ + (pp - CTXL)) * DM;
}
__device__ __forceinline__ const float* modv_ptr(const Params& p, int l, int b, int pp) {
    const int mr = pp < CTXL ? 16 : b;
    return (const float*)(p.ws + OFF_MODV) + ((size_t)l * 17 + mr) * 6144;
}

__device__ __forceinline__ void grid_barrier(unsigned* bar, unsigned& epoch) {
    asm volatile("s_waitcnt vmcnt(0) lgkmcnt(0)" ::: "memory");
    __syncthreads();
    epoch += 1;
    if (threadIdx.x == 0) {
        __builtin_amdgcn_fence(__ATOMIC_RELEASE, "agent");
        asm volatile("s_waitcnt vmcnt(0)" ::: "memory");
        const unsigned old = __hip_atomic_fetch_add(bar, 1u, __ATOMIC_RELAXED, __HIP_MEMORY_SCOPE_AGENT);
        if (old + 1u == epoch * gridDim.x) {
            __hip_atomic_store(bar + 64, epoch, __ATOMIC_RELAXED, __HIP_MEMORY_SCOPE_AGENT);
        } else {
            while (__hip_atomic_load(bar + 64, __ATOMIC_RELAXED, __HIP_MEMORY_SCOPE_AGENT) < epoch) __builtin_amdgcn_s_sleep(1);
        }
        __builtin_amdgcn_fence(__ATOMIC_ACQUIRE, "agent");
        asm volatile("s_waitcnt vmcnt(0)" ::: "memory");
    }
    __syncthreads();
}

#define LDS_AS __attribute__((address_space(3)))
#define GLB_AS __attribute__((address_space(1)))
template <int MT, int SWAPMODE>
__device__ __forceinline__ void gemm_mainloop(f32x4 (&acc)[MT][4], const bf16_t* __restrict__ A, int lda, int a_kstep,
                                              const bf16_t* __restrict__ Bt, int ldb, int nk, unsigned char* lds, int tid) {
    constexpr int BMr = 64 * MT;
    constexpr int STAGE = (BMr + 128) * 128;
    const int wid = __builtin_amdgcn_readfirstlane(tid >> 6), lane = tid & 63, wr = wid >> 1, wc = wid & 1, fr = lane & 15, fq = lane >> 4;
    const int lrow = 8 * wid + (lane >> 3);
    const int lch = (lane & 7) ^ ((4 * wid + (lane >> 4)) & 7);
    const bf16_t* ap = A + (size_t)lrow * lda + lch * 8;
    const bf16_t* bp = Bt + (size_t)lrow * ldb + lch * 8;
    auto issue = [&](int kt, int st) {
        unsigned char* base = lds + st * STAGE + wid * 1024;
#pragma unroll
        for (int i = 0; i < MT; ++i)
            __builtin_amdgcn_global_load_lds((const GLB_AS unsigned*)(ap + (size_t)i * 64 * lda + (size_t)kt * a_kstep), (LDS_AS unsigned*)(base + i * 8192), 16, 0, 0);
#pragma unroll
        for (int i = 0; i < 2; ++i)
            __builtin_amdgcn_global_load_lds((const GLB_AS unsigned*)(bp + (size_t)i * 64 * ldb + (size_t)kt * 64), (LDS_AS unsigned*)(base + (BMr + i * 64) * 128), 16, 0, 0);
    };
    const bool sw = (SWAPMODE == 1) || (SWAPMODE == 2 && wc == 0);
    const int sz = fr >> 1;
    constexpr int NL = MT + 2;
    const bool late = wid >= 4;
    issue(0, 0);
    if (nk > 1) { issue(1, 1); asm volatile("s_waitcnt vmcnt(%0)" ::"n"(NL) : "memory"); }
    else asm volatile("s_waitcnt vmcnt(0)" ::: "memory");
    __builtin_amdgcn_s_barrier();
    asm volatile("" ::: "memory");
    int st = 0;
    for (int kt = 0; kt < nk; ++kt) {
        const int st2 = st >= 1 ? st - 1 : 2;
        if (!late && kt + 2 < nk) issue(kt + 2, st2);
        const unsigned char* As = lds + st * STAGE;
        const unsigned char* Bs = As + BMr * 128;
#pragma unroll
        for (int ks = 0; ks < 2; ++ks) {
            bf16x8 af[MT], bfr[4];
            const int co = ((ks * 4 + fq) ^ sz) * 16;
#pragma unroll
            for (int m = 0; m < MT; ++m) af[m] = *(const bf16x8*)(As + (wr * 16 * MT + m * 16 + fr) * 128 + co);
#pragma unroll
            for (int n = 0; n < 4; ++n) bfr[n] = *(const bf16x8*)(Bs + (wc * 64 + n * 16 + fr) * 128 + co);
            if (sw) {
#pragma unroll
                for (int m = 0; m < MT; ++m)
#pragma unroll
                    for (int n = 0; n < 4; ++n) acc[m][n] = __builtin_amdgcn_mfma_f32_16x16x32_bf16(bfr[n], af[m], acc[m][n], 0, 0, 0);
            } else {
#pragma unroll
                for (int m = 0; m < MT; ++m)
#pragma unroll
                    for (int n = 0; n < 4; ++n) acc[m][n] = __builtin_amdgcn_mfma_f32_16x16x32_bf16(af[m], bfr[n], acc[m][n], 0, 0, 0);
            }
        }
        if (late && kt + 2 < nk) issue(kt + 2, st2);
        if (kt + 2 < nk) asm volatile("s_waitcnt vmcnt(%0) lgkmcnt(0)" ::"n"(NL) : "memory");
        else asm volatile("s_waitcnt vmcnt(0) lgkmcnt(0)" ::: "memory");
        __builtin_amdgcn_s_barrier();
        asm volatile("" ::: "memory");
        st = st == 2 ? 0 : st + 1;
    }
}
__device__ __forceinline__ void gemm_mainloop256(f32x4 (&acc)[8][4], const bf16_t* __restrict__ A, int lda,
                                                 const bf16_t* __restrict__ Bt, int ldb, int nk, unsigned char* lds, int tid) {
    constexpr int STAGE = 512 * 128;
    const int wid = __builtin_amdgcn_readfirstlane(tid >> 6), lane = tid & 63, wr = wid >> 2, wc = wid & 3, fr = lane & 15, fq = lane >> 4;
    const int lrow = 8 * wid + (lane >> 3);
    const int lch = (lane & 7) ^ ((4 * wid + (lane >> 4)) & 7);
    const bf16_t* ap = A + (size_t)lrow * lda + lch * 8;
    const bf16_t* bp = Bt + (size_t)lrow * ldb + lch * 8;
    auto issue = [&](int kt, int st) {
        unsigned char* base = lds + st * STAGE + wid * 1024;
#pragma unroll
        for (int i = 0; i < 4; ++i)
            __builtin_amdgcn_global_load_lds((const GLB_AS unsigned*)(ap + (size_t)i * 64 * lda + (size_t)kt * 64), (LDS_AS unsigned*)(base + i * 8192), 16, 0, 0);
#pragma unroll
        for (int i = 0; i < 4; ++i)
            __builtin_amdgcn_global_load_lds((const GLB_AS unsigned*)(bp + (size_t)i * 64 * ldb + (size_t)kt * 64), (LDS_AS unsigned*)(base + (256 + i * 64) * 128), 16, 0, 0);
    };
    const int sz = fr >> 1;
    const bool late = wid >= 4;
    issue(0, 0);
    asm volatile("s_waitcnt vmcnt(0)" ::: "memory");
    __builtin_amdgcn_s_barrier();
    asm volatile("" ::: "memory");
    for (int kt = 0; kt < nk; ++kt) {
        if (!late && kt + 1 < nk) issue(kt + 1, (kt + 1) & 1);
        const unsigned char* As = lds + (kt & 1) * STAGE;
        const unsigned char* Bs = As + 256 * 128;
#pragma unroll
        for (int ks = 0; ks < 2; ++ks) {
            if (ks == 1 && late && kt + 1 < nk) issue(kt + 1, (kt + 1) & 1);
            bf16x8 af[8], bfr[4];
            const int co = ((ks * 4 + fq) ^ sz) * 16;
#pragma unroll
            for (int m = 0; m < 8; ++m) af[m] = *(const bf16x8*)(As + (wr * 128 + m * 16 + fr) * 128 + co);
#pragma unroll
            for (int n = 0; n < 4; ++n) bfr[n] = *(const bf16x8*)(Bs + (wc * 64 + n * 16 + fr) * 128 + co);
#pragma unroll
            for (int m = 0; m < 8; ++m)
#pragma unroll
                for (int n = 0; n < 4; ++n) acc[m][n] = __builtin_amdgcn_mfma_f32_16x16x32_bf16(bfr[n], af[m], acc[m][n], 0, 0, 0);
        }
        asm volatile("s_waitcnt vmcnt(0) lgkmcnt(0)" ::: "memory");
        __builtin_amdgcn_s_barrier();
        asm volatile("" ::: "memory");
    }
}
struct Seg { const bf16_t* A; const bf16_t* Bt; int lda, a_kstep, ldb, nk; };
template <int MT, int SWAPMODE>
__device__ __forceinline__ void gemm_stream(f32x4 (&acc)[MT][4], const Seg& cur, const Seg& nxt, bool has_next, bool first, int& st,
                                            unsigned char* lds, int tid) {
    constexpr int BMr = 64 * MT;
    constexpr int STAGE = (BMr + 128) * 128;
    constexpr int NL = MT + 2;
    const int wid = __builtin_amdgcn_readfirstlane(tid >> 6), lane = tid & 63, wr = wid >> 1, wc = wid & 1, fr = lane & 15, fq = lane >> 4;
    const int lrow = 8 * wid + (lane >> 3);
    const int lch = (lane & 7) ^ ((4 * wid + (lane >> 4)) & 7);
    const bf16_t* apc = cur.A + (size_t)lrow * cur.lda + lch * 8;
    const bf16_t* bpc = cur.Bt + (size_t)lrow * cur.ldb + lch * 8;
    const bf16_t* apn = nxt.A + (size_t)lrow * nxt.lda + lch * 8;
    const bf16_t* bpn = nxt.Bt + (size_t)lrow * nxt.ldb + lch * 8;
    auto issue = [&](const bf16_t* ap, const bf16_t* bp, int lda, int ldb, int koffa, int koffb, int slot) {
        unsigned char* base = lds + slot * STAGE + wid * 1024;
#pragma unroll
        for (int i = 0; i < MT; ++i)
            __builtin_amdgcn_global_load_lds((const GLB_AS unsigned*)(ap + (size_t)i * 64 * lda + koffa), (LDS_AS unsigned*)(base + i * 8192), 16, 0, 0);
#pragma unroll
        for (int i = 0; i < 2; ++i)
            __builtin_amdgcn_global_load_lds((const GLB_AS unsigned*)(bp + (size_t)i * 64 * ldb + koffb), (LDS_AS unsigned*)(base + (BMr + i * 64) * 128), 16, 0, 0);
    };
    const bool sw = (SWAPMODE == 1) || (SWAPMODE == 2 && wc == 0);
    const int sz = fr >> 1;
    const bool late = wid >= 4;
    const int nk = cur.nk;
    int s0 = st;
    if (first) {
        const int s1 = s0 == 2 ? 0 : s0 + 1;
        issue(apc, bpc, cur.lda, cur.ldb, 0, 0, s0);
        issue(apc, bpc, cur.lda, cur.ldb, cur.a_kstep, 64, s1);
        asm volatile("s_waitcnt vmcnt(%0)" ::"n"(NL) : "memory");
        __builtin_amdgcn_s_barrier();
        asm volatile("" ::: "memory");
    }
    for (int kt = 0; kt < nk; ++kt) {
        const int s2 = s0 >= 1 ? s0 - 1 : 2;
        const int idx = kt + 2;
        const bool incur = idx < nk, doi = incur || has_next;
        if (!late && doi) { if (incur) issue(apc, bpc, cur.lda, cur.ldb, idx * cur.a_kstep, idx * 64, s2); else issue(apn, bpn, nxt.lda, nxt.ldb, (idx - nk) * nxt.a_kstep, (idx - nk) * 64, s2); }
        const unsigned char* As = lds + s0 * STAGE;
        const unsigned char* Bs = As + BMr * 128;
#pragma unroll
        for (int ks = 0; ks < 2; ++ks) {
            bf16x8 af[MT], bfr[4];
            const int co = ((ks * 4 + fq) ^ sz) * 16;
#pragma unroll
            for (int m = 0; m < MT; ++m) af[m] = *(const bf16x8*)(As + (wr * 16 * MT + m * 16 + fr) * 128 + co);
#pragma unroll
            for (int n = 0; n < 4; ++n) bfr[n] = *(const bf16x8*)(Bs + (wc * 64 + n * 16 + fr) * 128 + co);
            if (sw) {
#pragma unroll
                for (int m = 0; m < MT; ++m)
#pragma unroll
                    for (int n = 0; n < 4; ++n) acc[m][n] = __builtin_amdgcn_mfma_f32_16x16x32_bf16(bfr[n], af[m], acc[m][n], 0, 0, 0);
            } else {
#pragma unroll
                for (int m = 0; m < MT; ++m)
#pragma unroll
                    for (int n = 0; n < 4; ++n) acc[m][n] = __builtin_amdgcn_mfma_f32_16x16x32_bf16(af[m], bfr[n], acc[m][n], 0, 0, 0);
            }
        }
        if (late && doi) { if (incur) issue(apc, bpc, cur.lda, cur.ldb, idx * cur.a_kstep, idx * 64, s2); else issue(apn, bpn, nxt.lda, nxt.ldb, (idx - nk) * nxt.a_kstep, (idx - nk) * 64, s2); }
        if (doi) asm volatile("s_waitcnt vmcnt(%0) lgkmcnt(0)" ::"n"(NL) : "memory");
        else asm volatile("s_waitcnt vmcnt(0) lgkmcnt(0)" ::: "memory");
        __builtin_amdgcn_s_barrier();
        asm volatile("" ::: "memory");
        s0 = s0 == 2 ? 0 : s0 + 1;
    }
    st = s0;
}
__device__ __forceinline__ void gemm_stream256(f32x4 (&acc)[8][4], const Seg& cur, const Seg& nxt, bool has_next, bool first, int& st, unsigned char* lds, int tid) {
    constexpr int STAGE = 512 * 128;
    const int wid = __builtin_amdgcn_readfirstlane(tid >> 6), lane = tid & 63, wr = wid >> 2, wc = wid & 3, fr = lane & 15, fq = lane >> 4;
    const int lrow = 8 * wid + (lane >> 3);
    const int lch = (lane & 7) ^ ((4 * wid + (lane >> 4)) & 7);
    const bf16_t* apc = cur.A + (size_t)lrow * cur.lda + lch * 8;
    const bf16_t* bpc = cur.Bt + (size_t)lrow * cur.ldb + lch * 8;
    const bf16_t* apn = nxt.A + (size_t)lrow * nxt.lda + lch * 8;
    const bf16_t* bpn = nxt.Bt + (size_t)lrow * nxt.ldb + lch * 8;
    auto issue = [&](const bf16_t* ap, const bf16_t* bp, int lda, int ldb, int koff, int slot) {
        unsigned char* base = lds + slot * STAGE + wid * 1024;
#pragma unroll
        for (int i = 0; i < 4; ++i)
            __builtin_amdgcn_global_load_lds((const GLB_AS unsigned*)(ap + (size_t)i * 64 * lda + koff), (LDS_AS unsigned*)(base + i * 8192), 16, 0, 0);
#pragma unroll
        for (int i = 0; i < 4; ++i)
            __builtin_amdgcn_global_load_lds((const GLB_AS unsigned*)(bp + (size_t)i * 64 * ldb + koff), (LDS_AS unsigned*)(base + (256 + i * 64) * 128), 16, 0, 0);
    };
    const int sz = fr >> 1;
    const bool late = wid >= 4;
    const int nk = cur.nk;
    int s0 = st;
    if (first) {
        issue(apc, bpc, cur.lda, cur.ldb, 0, s0);
        asm volatile("s_waitcnt vmcnt(0)" ::: "memory");
        __builtin_amdgcn_s_barrier();
        asm volatile("" ::: "memory");
    }
    for (int kt = 0; kt < nk; ++kt) {
        const int idx = kt + 1;
        const bool incur = idx < nk, doi = incur || has_next;
        if (!late && doi) { if (incur) issue(apc, bpc, cur.lda, cur.ldb, idx * 64, s0 ^ 1); else issue(apn, bpn, nxt.lda, nxt.ldb, 0, s0 ^ 1); }
        const unsigned char* As = lds + s0 * STAGE;
        const unsigned char* Bs = As + 256 * 128;
#pragma unroll
        for (int ks = 0; ks < 2; ++ks) {
            if (ks == 1 && late && doi) { if (incur) issue(apc, bpc, cur.lda, cur.ldb, idx * 64, s0 ^ 1); else issue(apn, bpn, nxt.lda, nxt.ldb, 0, s0 ^ 1); }
            bf16x8 af[8], bfr[4];
            const int co = ((ks * 4 + fq) ^ sz) * 16;
#pragma unroll
            for (int m = 0; m < 8; ++m) af[m] = *(const bf16x8*)(As + (wr * 128 + m * 16 + fr) * 128 + co);
#pragma unroll
            for (int n = 0; n < 4; ++n) bfr[n] = *(const bf16x8*)(Bs + (wc * 64 + n * 16 + fr) * 128 + co);
#pragma unroll
            for (int m = 0; m < 8; ++m)
#pragma unroll
                for (int n = 0; n < 4; ++n) acc[m][n] = __builtin_amdgcn_mfma_f32_16x16x32_bf16(bfr[n], af[m], acc[m][n], 0, 0, 0);
        }
        asm volatile("s_waitcnt vmcnt(0) lgkmcnt(0)" ::: "memory");
        __builtin_amdgcn_s_barrier();
        asm volatile("" ::: "memory");
        s0 ^= 1;
    }
    st = s0;
}
__device__ __forceinline__ void gemm_gate3(f32x4 (&g)[3][2][4], const bf16_t* __restrict__ A, const bf16_t* __restrict__ Bt0, int nk, unsigned char* lds, int tid) {
    constexpr int STAGE = 512 * 128;
    const int wid = __builtin_amdgcn_readfirstlane(tid >> 6), lane = tid & 63, wr = wid >> 1, wc = wid & 1, fr = lane & 15, fq = lane >> 4;
    const int lrow = 8 * wid + (lane >> 3);
    const int lch = (lane & 7) ^ ((4 * wid + (lane >> 4)) & 7);
    const unsigned loff = (unsigned)(lrow * 1024 + lch * 8);
    auto issue = [&](int kt, int stg) {
        unsigned char* base = lds + stg * STAGE + wid * 1024;
#pragma unroll
        for (int i = 0; i < 2; ++i)
            __builtin_amdgcn_global_load_lds((const GLB_AS unsigned*)((A + (size_t)i * 64 * 1024 + (size_t)kt * 64) + loff), (LDS_AS unsigned*)(base + i * 8192), 16, 0, 0);
#pragma unroll
        for (int j = 0; j < 6; ++j)
            __builtin_amdgcn_global_load_lds((const GLB_AS unsigned*)((Bt0 + ((size_t)(j >> 1) * 1024 + (j & 1) * 64) * 1024 + (size_t)kt * 64) + loff), (LDS_AS unsigned*)(base + (128 + j * 64) * 128), 16, 0, 0);
    };
    const int sz = fr >> 1;
    const bool late = wid >= 4;
    issue(0, 0);
    asm volatile("s_waitcnt vmcnt(0)" ::: "memory");
    __builtin_amdgcn_s_barrier();
    asm volatile("" ::: "memory");
    for (int kt = 0; kt < nk; ++kt) {
        if (!late && kt + 1 < nk) issue(kt + 1, (kt + 1) & 1);
        const unsigned char* As = lds + (kt & 1) * STAGE;
        const unsigned char* Bs = As + 128 * 128;
#pragma unroll
        for (int ks = 0; ks < 2; ++ks) {
            if (ks == 1 && late && kt + 1 < nk) issue(kt + 1, (kt + 1) & 1);
            const int co = ((ks * 4 + fq) ^ sz) * 16;
            bf16x8 af[2];
#pragma unroll
            for (int m = 0; m < 2; ++m) af[m] = *(const bf16x8*)(As + (wr * 32 + m * 16 + fr) * 128 + co);
#pragma unroll
            for (int i = 0; i < 3; ++i) {
                bf16x8 bfr[4];
#pragma unroll
                for (int n = 0; n < 4; ++n) bfr[n] = *(const bf16x8*)(Bs + (i * 128 + wc * 64 + n * 16 + fr) * 128 + co);
#pragma unroll
                for (int m = 0; m < 2; ++m)
#pragma unroll
                    for (int n = 0; n < 4; ++n) g[i][m][n] = __builtin_amdgcn_mfma_f32_16x16x32_bf16(bfr[n], af[m], g[i][m][n], 0, 0, 0);
                if (i < 2) __builtin_amdgcn_sched_barrier(0);
            }
        }
        asm volatile("s_waitcnt vmcnt(0) lgkmcnt(0)" ::: "memory");
        __builtin_amdgcn_s_barrier();
        asm volatile("" ::: "memory");
    }
}
template <int MT> __device__ __forceinline__ void zero_acc(f32x4 (&acc)[MT][4]) {
#pragma unroll
    for (int m = 0; m < MT; ++m)
#pragma unroll
        for (int n = 0; n < 4; ++n) acc[m][n] = (f32x4){0.f, 0.f, 0.f, 0.f};
}
__device__ __forceinline__ void tile_mn(int t, int nN, int& mt, int& nt) { const int per = 16 * nN, g = t / per, w = t % per; mt = g * 16 + (w & 15); nt = w >> 4; }

__device__ __forceinline__ int rowmap(int mode, int n) {
    if (mode == 1) return n < 672 ? n : n + 96;
    if (mode == 2) return n < DFF ? ((n >> 5) * 64 + (n & 31)) : (((n - DFF) >> 5) * 64 + 32 + ((n - DFF) & 31));
    return n;
}
__device__ __forceinline__ void convert_T(const float* __restrict__ src, int K, int N, bf16_t* __restrict__ dst, int mode, const float* __restrict__ ks, unsigned char* lds, int rot) {
    float* tile = (float*)lds;
    const int ntk = K / 64, ntn = (N + 63) / 64, tid = ltid();
    const int start = (blockIdx.x + gridDim.x - (rot % gridDim.x)) % gridDim.x;
    for (int t = start; t < ntk * ntn; t += gridDim.x) {
        const int tk = t % ntk, tn = t / ntk, k0 = tk * 64, n0 = tn * 64;
#pragma unroll
        for (int i = 0; i < 8; ++i) {
            const int kl = (tid >> 6) + 8 * i, nl = tid & 63, n = n0 + nl;
            tile[kl * 65 + nl] = n < N ? src[(size_t)(k0 + kl) * N + n] : 0.f;
        }
        __syncthreads();
        const int kp = (tid & 31) * 2;
        float s0 = 1.f, s1 = 1.f;
        if (ks) { s0 = ks[k0 + kp]; s1 = ks[k0 + kp + 1]; }
#pragma unroll
        for (int i = 0; i < 4; ++i) {
            const int nl = (tid >> 5) + 16 * i, n = n0 + nl;
            if (n < N) *(unsigned*)(dst + (size_t)rowmap(mode, n) * K + k0 + kp) = pk_bf16(tile[kp * 65 + nl] * s0, tile[(kp + 1) * 65 + nl] * s1);
        }
        __syncthreads();
    }
}
__device__ __forceinline__ void convert_layer(const Params& pin, int l, unsigned char* lds) {
    const Params p = launder(pin); l = launder_i(l);
    bf16_t* W = (bf16_t*)(p.ws + OFF_W);
    convert_T(p.w_in + (size_t)l * DM * DIN, DM, DIN, W + WO_IN, 1, nullptr, lds, 0);
    convert_T(p.ffn_w13 + (size_t)l * DM * 2 * DFF, DM, 2 * DFF, W + WO_13, 2, nullptr, lds, 40);
    convert_T(p.ffn_w2 + (size_t)l * DFF * DM, DFF, DM, W + WO_2, 0, nullptr, lds, 80);
    convert_T(p.w_out + (size_t)l * DM * DM, DM, DM, W + WO_OUT, 0, nullptr, lds, 120);
    convert_T(p.w_o_attn + (size_t)l * 512 * DM, 512, DM, W + WO_OA, 0, nullptr, lds, 136);
    convert_T(p.w_o_conv + (size_t)l * 512 * DM, 512, DM, W + WO_OC, 0, nullptr, lds, 8);
    convert_T(p.w_o_rwkv + (size_t)l * 512 * DM, 512, DM, W + WO_OR, 0, nullptr, lds, 136 + 8);
    convert_T(p.w_uq + (size_t)l * 384 * 768, 384, 768, W + WO_UQ, 0, p.q_norm + l * 384, lds, 16);
    convert_T(p.w_ukv + (size_t)l * 256 * 1024, 256, 1024, W + WO_UKV, 0, p.kv_norm + l * 256, lds, 88);
    for (int z = 0; z < 2; ++z) {
        convert_T(p.rw_w_up + ((size_t)l * 2 + z) * 64 * 512, 64, 512, W + WO_UP + (size_t)z * 512 * 64, 0, nullptr, lds, 152 + 8 * z);
        convert_T(p.rw_a_up + ((size_t)l * 2 + z) * 64 * 512, 64, 512, W + WO_AUP + (size_t)z * 512 * 64, 0, nullptr, lds, 168 + 8 * z);
    }
    convert_T(p.rw_g_up + (size_t)l * 128 * 512, 128, 512, W + WO_GUP, 0, nullptr, lds, 184);
}

__device__ __forceinline__ void modv_phase(const Params& pin, unsigned char* lds) {
    const Params p = launder(pin);
    float* s = (float*)lds;
    float* red = s + 17 * 1024;
    const int tid = ltid(), wid = tid >> 6, lane = tid & 63;
    for (int i = tid; i < 17 * 1024; i += NTHREADS) { const int r = i >> 10, k = i & 1023; const float v = r < 16 ? p.c[r * 1024 + k] : p.c_ctx[k]; s[i] = siluf_(v); }
    __syncthreads();
    float* modv = (float*)(p.ws + OFF_MODV);
    for (int g = blockIdx.x; g < 4 * 96; g += gridDim.x) {
        const int l = g / 96, n = (g % 96) * 64 + lane;
        const float* w = p.mod_w + (size_t)l * 1024 * 6144 + n;
        float acc[17];
#pragma unroll
        for (int r = 0; r < 17; ++r) acc[r] = 0.f;
        const int kb = wid * 128;
        for (int k = kb; k < kb + 128; k += 4) {
            const float w0 = w[(size_t)k * 6144], w1 = w[(size_t)(k + 1) * 6144], w2 = w[(size_t)(k + 2) * 6144], w3 = w[(size_t)(k + 3) * 6144];
#pragma unroll
            for (int r = 0; r < 17; ++r) { const f32x4 sv = *(const f32x4*)(s + r * 1024 + k); acc[r] += sv[0] * w0 + sv[1] * w1 + sv[2] * w2 + sv[3] * w3; }
        }
#pragma unroll
        for (int r = 0; r < 17; ++r) red[(wid * 17 + r) * 64 + lane] = acc[r];
        __syncthreads();
        for (int i = tid; i < 17 * 64; i += NTHREADS) {
            const int r = i >> 6, c = i & 63; float v = 0.f;
#pragma unroll
            for (int w8 = 0; w8 < 8; ++w8) v += red[(w8 * 17 + r) * 64 + c];
            const int nn = (g % 96) * 64 + c;
            modv[((size_t)l * 17 + r) * 6144 + nn] = v + p.mod_b[l * 6144 + nn];
        }
        __syncthreads();
    }
    if (blockIdx.x == gridDim.x - 1) {
        float* rope = (float*)(p.ws + OFF_ROPE);
        for (int i = tid; i < 512; i += NTHREADS) {
            const int pos = i >> 3, f = i & 7;
            const float inv = exp2f(-(float)f * (13.287712379549449f / 8.0f));
            const float ang = (float)pos * inv;
            rope[i * 2] = cosf(ang); rope[i * 2 + 1] = sinf(ang);
        }
    }
}

__device__ __forceinline__ void xmod0_phase(const Params& pin) {
    const Params p = launder(pin);
    const int tid = ltid(), wid = tid >> 6, lane = tid & 63;
    bf16_t* xm = (bf16_t*)(p.ws + OFF_R6);
    for (int row = blockIdx.x * 8 + wid; row < MROWS; row += gridDim.x * 8) {
        const int b = row / TPB, pp = row % TPB;
        const float* xp = x_rd(p, true, b, pp);
        const float* mv = modv_ptr(p, 0, b, pp);
#pragma unroll
        for (int i = 0; i < 4; ++i) {
            const int c = i * 256 + lane * 4;
            const f32x4 v = *(const f32x4*)(xp + c), sh = *(const f32x4*)(mv + c), sc = *(const f32x4*)(mv + 1024 + c);
            uint2 o; o.x = pk_bf16(v[0] * (1.f + sc[0]) + sh[0], v[1] * (1.f + sc[1]) + sh[1]); o.y = pk_bf16(v[2] * (1.f + sc[2]) + sh[2], v[3] * (1.f + sc[3]) + sh[3]);
            *(uint2*)(xm + (size_t)row * 1024 + c) = o;
        }
    }
}

__device__ __forceinline__ void p1_phase(const Params& pin, unsigned char* lds) {
    const Params p = launder(pin); const int tid = ltid();
    const bf16_t* A = (const bf16_t*)(p.ws + OFF_R6);
    const bf16_t* W = (const bf16_t*)(p.ws + OFF_W) + WO_IN;
    const int lane = tid & 63, wid = tid >> 6, wr = wid >> 2, wc = wid & 3, fr = lane & 15, fq = lane >> 4;
    auto seg = [&](int t) { int mt, nt; tile_mn(t, 17, mt, nt); Seg g; g.A = A + (size_t)mt * 256 * 1024; g.Bt = W + (size_t)nt * 256 * 1024; g.lda = 1024; g.a_kstep = 64; g.ldb = 1024; g.nk = 16; return g; };
    int st = 0; bool first = true;
    for (int t = blockIdx.x; t < 144 * 17; t += gridDim.x) {
        int mt, nt; tile_mn(t, 17, mt, nt);
        const int tn = t + gridDim.x; const bool hn = tn < 144 * 17;
        f32x4 acc[8][4]; zero_acc<8>(acc);
        gemm_stream256(acc, seg(t), seg(hn ? tn : t), hn, first, st, lds, tid); first = false;
        bf16_t* dst; int ld, cb, lim;
        if (nt < 3) { dst = (bf16_t*)(p.ws + OFF_R1); ld = 672; cb = nt * 256; lim = 672; }
        else if (nt < 9) { dst = (bf16_t*)(p.ws + OFF_R2); ld = 1536; cb = (nt - 3) * 256; lim = 1536; }
        else { dst = (bf16_t*)(p.ws + OFF_R3); ld = 1920; cb = (nt - 9) * 256; lim = 1920; }
#pragma unroll
        for (int m = 0; m < 8; ++m) {
            const size_t row = (size_t)mt * 256 + wr * 128 + m * 16 + fr;
#pragma unroll
            for (int n = 0; n < 4; n += 2) {
                uint2 a, b2;
                a.x = pk_bf16(acc[m][n][0], acc[m][n][1]); a.y = pk_bf16(acc[m][n][2], acc[m][n][3]);
                b2.x = pk_bf16(acc[m][n + 1][0], acc[m][n + 1][1]); b2.y = pk_bf16(acc[m][n + 1][2], acc[m][n + 1][3]);
                const uint4 w = widen16(a, b2);
                const int col = cb + wc * 64 + (n + (fq & 1)) * 16 + (fq >> 1) * 8;
                if (col < lim) *(uint4*)(dst + row * ld + col) = w;
            }
        }
    }
}

__device__ __forceinline__ void unpack8(const uint4 u, float (&f)[8]) {
    f[0] = bf_lo(u.x); f[1] = bf_hi(u.x); f[2] = bf_lo(u.y); f[3] = bf_hi(u.y); f[4] = bf_lo(u.z); f[5] = bf_hi(u.z); f[6] = bf_lo(u.w); f[7] = bf_hi(u.w);
}
__device__ __forceinline__ void p2a_phase(const Params& pin, int l) {
    const Params p = launder(pin); l = launder_i(l);
    const int tid = ltid(), wid = tid >> 6, lane = tid & 63;
    const bf16_t* Hm = (const bf16_t*)(p.ws + OFF_R1);
    const bf16_t* Hc = (const bf16_t*)(p.ws + OFF_R2);
    bf16_t* CV = (bf16_t*)(p.ws + OFF_R5);
    bf16_t* KR = (bf16_t*)(p.ws + OFF_KR);
    float* RSQ = (float*)(p.ws + OFF_RSQ);
    float* RSKV = (float*)(p.ws + OFF_RSKV);
    const float* rope = (const float*)(p.ws + OFF_ROPE);
    const float* cw = p.conv_w + (size_t)l * 3 * 512;
    const int c0 = lane * 8;
    float w0[8], w1[8], w2[8];
#pragma unroll
    for (int i = 0; i < 8; ++i) { w0[i] = cw[c0 + i]; w1[i] = cw[512 + c0 + i]; w2[i] = cw[1024 + c0 + i]; }
    for (int row = blockIdx.x * 8 + wid; row < MROWS; row += gridDim.x * 8) {
        const int pp = row % TPB;
        const bool hp = (pp != 0 && pp != CTXL), hn = (pp != CTXL - 1 && pp != TPB - 1);
        const bf16_t* hr = Hc + (size_t)row * 1536;
        float ch[8], cc[8], cb[8], u0[8], u1[8], u2[8];
        unpack8(*(const uint4*)(hr + c0), ch); unpack8(*(const uint4*)(hr + 1024 + c0), cc); unpack8(*(const uint4*)(hr + 512 + c0), cb);
#pragma unroll
        for (int i = 0; i < 8; ++i) u1[i] = cc[i] * ch[i];
        if (hp) { unpack8(*(const uint4*)(hr - 1536 + c0), ch); unpack8(*(const uint4*)(hr - 1536 + 1024 + c0), cc);
#pragma unroll
            for (int i = 0; i < 8; ++i) u0[i] = cc[i] * ch[i]; }
        else {
#pragma unroll
            for (int i = 0; i < 8; ++i) u0[i] = 0.f; }
        if (hn) { unpack8(*(const uint4*)(hr + 1536 + c0), ch); unpack8(*(const uint4*)(hr + 1536 + 1024 + c0), cc);
#pragma unroll
            for (int i = 0; i < 8; ++i) u2[i] = cc[i] * ch[i]; }
        else {
#pragma unroll
            for (int i = 0; i < 8; ++i) u2[i] = 0.f; }
        float o[8];
#pragma unroll
        for (int i = 0; i < 8; ++i) o[i] = cb[i] * (u0[i] * w0[i] + u1[i] * w1[i] + u2[i] * w2[i]);
        uint4 ov; ov.x = pk_bf16(o[0], o[1]); ov.y = pk_bf16(o[2], o[3]); ov.z = pk_bf16(o[4], o[5]); ov.w = pk_bf16(o[6], o[7]);
        *(uint4*)(CV + (size_t)row * 512 + c0) = ov;
        const bf16_t* hm = Hm + (size_t)row * 672;
        float sq = 0.f, skv = 0.f;
        if (lane < 48) { float f[8]; unpack8(*(const uint4*)(hm + lane * 8), f);
#pragma unroll
            for (int i = 0; i < 8; ++i) sq += f[i] * f[i]; }
        if (lane < 32) { float f[8]; unpack8(*(const uint4*)(hm + 384 + lane * 8), f);
#pragma unroll
            for (int i = 0; i < 8; ++i) skv += f[i] * f[i]; }
        sq = wave_sum(sq); skv = wave_sum(skv);
        if (lane == 0) { RSQ[row] = rsqrtf(sq * (1.0f / 384.0f) + 1e-6f); RSKV[row] = rsqrtf(skv * (1.0f / 256.0f) + 1e-6f); }
        {
            const int j = lane & 31;
            float v = bf1(hm[640 + j]);
            const float other = __shfl_xor(v, 8);
            if (pp >= CTXL) {
                const int tt = pp - CTXL;
                const int pos = (j < 16) ? (tt >> 6) : (tt & 63);
                const float cs = rope[(pos * 8 + (j & 7)) * 2], sn = rope[(pos * 8 + (j & 7)) * 2 + 1];
                v = (j & 8) ? (other * sn + v * cs) : (v * cs - other * sn);
            }
            if (lane < 32) KR[(size_t)row * 32 + j] = (bf16_t)(pk_bf16(v, v) & 0xffffu);
        }
    }
}

__device__ __forceinline__ void p2b_phase(const Params& pin, int l, unsigned char* lds) {
    const Params p = launder(pin); l = launder_i(l); const int tid = ltid();
    const bf16_t* Hm = (const bf16_t*)(p.ws + OFF_R1);
    const bf16_t* W = (const bf16_t*)(p.ws + OFF_W);
    const float* RSQ = (const float*)(p.ws + OFF_RSQ);
    const float* RSKV = (const float*)(p.ws + OFF_RSKV);
    const float* rope = (const float*)(p.ws + OFF_ROPE);
    bf16_t* Q = (bf16_t*)(p.ws + OFF_Q);
    bf16_t* KN = (bf16_t*)(p.ws + OFF_KN);
    bf16_t* VT = (bf16_t*)(p.ws + OFF_VT);
    const int lane = tid & 63, wid = tid >> 6, wr = wid >> 1, wc = wid & 1, fr = lane & 15, fq = lane >> 4;
    const int NQ = 144 * 6, NKV = 144 * 8;
    for (int t = blockIdx.x; t < NQ + NKV; t += gridDim.x) {
        f32x4 acc[4][4]; zero_acc<4>(acc);
        if (t < NQ) {
            int mt, nt; tile_mn(t, 6, mt, nt);
            gemm_mainloop<4, 1>(acc, Hm + (size_t)mt * 256 * 672, 672, 64, W + WO_UQ + (size_t)nt * 128 * 384, 384, 6, lds, tid);
            const int pp0 = (mt % 9) * 256; const bool latent = pp0 >= CTXL;
#pragma unroll
            for (int m = 0; m < 4; ++m) {
                const int lrow = wr * 64 + m * 16 + fr;
                const size_t row = (size_t)mt * 256 + lrow;
                const float sc = RSQ[row] * QSCALE;
                const int tt = pp0 + lrow - CTXL;
#pragma unroll
                for (int n = 0; n < 4; ++n) {
                    const int c16 = nt * 128 + wc * 64 + n * 16, r96 = c16 % 96;
                    float v[4];
#pragma unroll
                    for (int j = 0; j < 4; ++j) v[j] = acc[m][n][j] * sc;
                    if (latent && r96 >= 64) {
                        const int pos = (r96 == 64) ? (tt >> 6) : (tt & 63);
#pragma unroll
                        for (int j = 0; j < 4; ++j) {
                            const float other = __shfl_xor(v[j], 32);
                            const int fi = (fq & 1) * 4 + j;
                            const float cs = rope[(pos * 8 + fi) * 2], sn = rope[(pos * 8 + fi) * 2 + 1];
                            v[j] = (fq & 2) ? (other * sn + v[j] * cs) : (v[j] * cs - other * sn);
                        }
                    }
                    uint2 o; o.x = pk_bf16(v[0], v[1]); o.y = pk_bf16(v[2], v[3]);
                    *(uint2*)(Q + row * 768 + c16 + fq * 4) = o;
                }
            }
        } else {
            int mt, nt; tile_mn(t - NQ, 8, mt, nt);
            gemm_mainloop<4, 2>(acc, Hm + (size_t)mt * 256 * 672 + 384, 672, 64, W + WO_UKV + (size_t)nt * 128 * 256, 256, 4, lds, tid);
            const int b = mt / 9, pp0 = (mt % 9) * 256;
            if (wc == 0) {
#pragma unroll
                for (int m = 0; m < 4; ++m) {
                    const size_t row = (size_t)mt * 256 + wr * 64 + m * 16 + fr;
                    const float sc = RSKV[row];
#pragma unroll
                    for (int n = 0; n < 4; ++n) {
                        uint2 o; o.x = pk_bf16(acc[m][n][0] * sc, acc[m][n][1] * sc); o.y = pk_bf16(acc[m][n][2] * sc, acc[m][n][3] * sc);
                        *(uint2*)(KN + row * 512 + nt * 64 + n * 16 + fq * 4) = o;
                    }
                }
            } else {
#pragma unroll
                for (int m = 0; m < 4; ++m) {
                    const int lrow = wr * 64 + m * 16 + fq * 4;
                    const f32x4 sc = *(const f32x4*)(RSKV + (size_t)mt * 256 + lrow);
#pragma unroll
                    for (int n = 0; n < 4; ++n) {
                        const int dv = n * 16 + fr;
                        uint2 o; o.x = pk_bf16(acc[m][n][0] * sc[0], acc[m][n][1] * sc[1]); o.y = pk_bf16(acc[m][n][2] * sc[2], acc[m][n][3] * sc[3]);
                        *(uint2*)(VT + ((size_t)(b * 8 + nt) * 64 + dv) * TPB + pp0 + lrow) = o;
                    }
                }
            }
        }
    }
    {
        const bf16_t* Hr = (const bf16_t*)(p.ws + OFF_R3);
        bf16_t* SG = (bf16_t*)(p.ws + OFF_SG);
        const float* mu = p.rw_mu + (size_t)l * 1920 + 1792;
        for (int i = blockIdx.x * NTHREADS + tid; i < MROWS * 16; i += gridDim.x * NTHREADS) {
            const int row = i >> 4, c0 = (i & 15) * 8, pp = row % TPB;
            const bool hp = (pp != 0 && pp != CTXL), hn = (pp != CTXL - 1 && pp != TPB - 1);
            const bf16_t* hr = Hr + (size_t)row * 1920 + 1792 + c0;
            float cur[8], pv[8], nx[8];
            unpack8(*(const uint4*)hr, cur);
            if (hp) unpack8(*(const uint4*)(hr - 1920), pv); else {
#pragma unroll
                for (int k = 0; k < 8; ++k) pv[k] = 0.f; }
            if (hn) unpack8(*(const uint4*)(hr + 1920), nx); else {
#pragma unroll
                for (int k = 0; k < 8; ++k) nx[k] = 0.f; }
            float o[8];
#pragma unroll
            for (int k = 0; k < 8; ++k) o[k] = sigmoidf_(cur[k] + (0.5f * (pv[k] + nx[k]) - cur[k]) * mu[c0 + k]);
            uint4 ov; ov.x = pk_bf16(o[0], o[1]); ov.y = pk_bf16(o[2], o[3]); ov.z = pk_bf16(o[4], o[5]); ov.w = pk_bf16(o[6], o[7]);
            *(uint4*)(SG + (size_t)row * 128 + c0) = ov;
        }
    }
}

#define FMAC_BC(acc, coef, s, J) asm("v_fmac_f32_dpp %0, %1, %2 row_newbcast:" #J " row_mask:0xf bank_mask:0xf" : "+v"(acc) : "v"(coef), "v"(s))
#define MUL_BC(dst, coef, s, J) asm("v_mul_f32_dpp %0, %1, %2 row_newbcast:" #J " row_mask:0xf bank_mask:0xf" : "=v"(dst) : "v"(coef), "v"(s))
#define REP16(X) X(0, 0) X(1, 1) X(2, 2) X(3, 3) X(4, 0) X(5, 1) X(6, 2) X(7, 3) X(8, 0) X(9, 1) X(10, 2) X(11, 3) X(12, 0) X(13, 1) X(14, 2) X(15, 3)
constexpr int FSTR = 6 * 64 + 4;
constexpr int CHUNK = 32, NCHUNK = TPB / CHUNK;

__device__ __forceinline__ int scan_pos(int z, int s) { return z == 0 ? s : (s < CTXL ? (CTXL - 1 - s) : (TPB + CTXL - 1 - s)); }

__device__ __forceinline__ void shift4(const bf16_t* hr, bool hp, bool hn, int col, const float* mu, float (&o)[4]) {
    const uint2 c = *(const uint2*)(hr + col);
    uint2 a = make_uint2(0u, 0u), b = make_uint2(0u, 0u);
    if (hp) a = *(const uint2*)(hr - 1920 + col);
    if (hn) b = *(const uint2*)(hr + 1920 + col);
    const f32x4 m = *(const f32x4*)(mu + col);
    const float cv[4] = {bf_lo(c.x), bf_hi(c.x), bf_lo(c.y), bf_hi(c.y)};
    const float av[4] = {bf_lo(a.x), bf_hi(a.x), bf_lo(a.y), bf_hi(a.y)};
    const float bv[4] = {bf_lo(b.x), bf_hi(b.x), bf_lo(b.y), bf_hi(b.y)};
#pragma unroll
    for (int i = 0; i < 4; ++i) o[i] = cv[i] + (0.5f * (av[i] + bv[i]) - cv[i]) * m[i];
}
__device__ __forceinline__ void shift8(const bf16_t* hr, bool hp, bool hn, int col, const float* mu, float (&o)[8]) {
    float cv[8], av[8], bv[8];
    unpack8(*(const uint4*)(hr + col), cv);
    if (hp) unpack8(*(const uint4*)(hr - 1920 + col), av); else {
#pragma unroll
        for (int i = 0; i < 8; ++i) av[i] = 0.f; }
    if (hn) unpack8(*(const uint4*)(hr + 1920 + col), bv); else {
#pragma unroll
        for (int i = 0; i < 8; ++i) bv[i] = 0.f; }
#pragma unroll
    for (int i = 0; i < 8; ++i) o[i] = cv[i] + (0.5f * (av[i] + bv[i]) - cv[i]) * mu[col + i];
}
__device__ __forceinline__ bf16x8 pack8(const float (&f)[8]) {
    union { uint4 u; bf16x8 v; } r;
    r.u.x = pk_bf16(f[0], f[1]); r.u.y = pk_bf16(f[2], f[3]); r.u.z = pk_bf16(f[4], f[5]); r.u.w = pk_bf16(f[6], f[7]);
    return r.v;
}

struct ProdState { f32x4 aw[4], aa[4]; };
struct Raw3x2 { uint2 c, a, b; };
__device__ __forceinline__ Raw3x2 ld3x2(const bf16_t* pc, const bf16_t* pa, const bf16_t* pb, bool hp, bool hn, int col) {
    Raw3x2 r; r.c = *(const uint2*)(pc + col); r.a = *(const uint2*)(pa + col); r.b = *(const uint2*)(pb + col);
    if (!hp) r.a = make_uint2(0u, 0u);
    if (!hn) r.b = make_uint2(0u, 0u);
    return r;
}
__device__ __forceinline__ void sh4(const Raw3x2& r, const f32x4 m, float (&o)[4]) {
    const float cv[4] = {bf_lo(r.c.x), bf_hi(r.c.x), bf_lo(r.c.y), bf_hi(r.c.y)};
    const float av[4] = {bf_lo(r.a.x), bf_hi(r.a.x), bf_lo(r.a.y), bf_hi(r.a.y)};
    const float bv[4] = {bf_lo(r.b.x), bf_hi(r.b.x), bf_lo(r.b.y), bf_hi(r.b.y)};
#pragma unroll
    for (int i = 0; i < 4; ++i) o[i] = cv[i] + (0.5f * (av[i] + bv[i]) - cv[i]) * m[i];
}
struct Raw3x4 { uint4 c, a, b; };
__device__ __forceinline__ Raw3x4 ld3x4(const bf16_t* pc, const bf16_t* pa, const bf16_t* pb, bool hp, bool hn, int col) {
    Raw3x4 r; r.c = *(const uint4*)(pc + col); r.a = *(const uint4*)(pa + col); r.b = *(const uint4*)(pb + col);
    if (!hp) r.a = make_uint4(0u, 0u, 0u, 0u);
    if (!hn) r.b = make_uint4(0u, 0u, 0u, 0u);
    return r;
}
__device__ __forceinline__ void sh8(const Raw3x4& r, const float* m, float (&o)[8]) {
    float cv[8], av[8], bv[8];
    unpack8(r.c, cv); unpack8(r.a, av); unpack8(r.b, bv);
    const f32x4 m0 = *(const f32x4*)m, m1 = *(const f32x4*)(m + 4);
#pragma unroll
    for (int i = 0; i < 8; ++i) o[i] = cv[i] + (0.5f * (av[i] + bv[i]) - cv[i]) * (i < 4 ? m0[i] : m1[i - 4]);
}
template <int N0>
__device__ __forceinline__ void scan_produce_elem(const float* pl, int fq, const Raw3x2 (&rr)[2], const Raw3x2 (&rk)[2], const Raw3x2 (&rv)[2],
                                                  const f32x4 (&aw)[2], const f32x4 (&aa)[2], float& ss, float* frow) {
#pragma unroll
    for (int nn = 0; nn < 2; ++nn) {
        const int n = N0 + nn;
        const int c4 = n * 16 + fq * 4;
        float r4[4], k4[4], v4[4];
        sh4(rr[nn], *(const f32x4*)(pl + 0 * 64 + c4), r4);
        sh4(rk[nn], *(const f32x4*)(pl + 1 * 64 + c4), k4);
        sh4(rv[nn], *(const f32x4*)(pl + 2 * 64 + c4), v4);
        const f32x4 w0 = *(const f32x4*)(pl + 3 * 64 + c4);
        const f32x4 a0 = *(const f32x4*)(pl + 4 * 64 + c4);
        const f32x4 kkp = *(const f32x4*)(pl + 5 * 64 + c4);
        const f32x4 kap = *(const f32x4*)(pl + 6 * 64 + c4);
        f32x4 dw, kd, kf4, a4;
#pragma unroll
        for (int j = 0; j < 4; ++j) {
            const float x = -(aw[nn][j] + w0[j]);
            const float sp = fmaxf(x, 0.f) + __logf(1.0f + __expf(-fabsf(x)));
            const float wl = -sp - 0.5f;
            dw[j] = __expf(-__expf(wl));
            const float a = __builtin_amdgcn_rcpf(1.0f + __expf(-(aa[nn][j] + a0[j])));
            a4[j] = a;
            const float kf = k4[j] * kkp[j];
            kf4[j] = kf; ss += kf * kf;
            kd[j] = k4[j] * (1.0f + (a - 1.0f) * kap[j]);
        }
        *(f32x4*)(frow + 0 * 64 + c4) = kf4;
        *(f32x4*)(frow + 1 * 64 + c4) = dw;
        *(f32x4*)(frow + 2 * 64 + c4) = a4;
        *(f32x4*)(frow + 3 * 64 + c4) = kd;
        *(f32x4*)(frow + 4 * 64 + c4) = (f32x4){r4[0], r4[1], r4[2], r4[3]};
        *(f32x4*)(frow + 5 * 64 + c4) = (f32x4){v4[0], v4[1], v4[2], v4[3]};
    }
}
__device__ __forceinline__ void scan_produce_A(const Params& p, const float* pl, int b, int h, int z, int s0, float* frow0, int lane, ProdState& st) {
    const int fr = lane & 15, fq = lane >> 4;
    const int pp = scan_pos(z, s0 + fr);
    const bool hp = (pp != 0 && pp != CTXL), hn = (pp != CTXL - 1 && pp != TPB - 1);
    const bf16_t* hr = (const bf16_t*)(p.ws + OFF_R3) + ((size_t)b * TPB + pp) * 1920;
    const bf16_t* W = (const bf16_t*)(p.ws + OFF_W);
    Raw3x4 qw[2], qa[2];
    const bf16_t* pc = hr + z * 64 + fq * 8; const bf16_t* pa = hp ? pc - 1920 : pc; const bf16_t* pb = hn ? pc + 1920 : pc;
#pragma unroll
    for (int ks = 0; ks < 2; ++ks) { qw[ks] = ld3x4(pc, pa, pb, hp, hn, 1536 + ks * 32); qa[ks] = ld3x4(pc, pa, pb, hp, hn, 1664 + ks * 32); }
    f32x4 accw[4], acca[4];
#pragma unroll
    for (int n = 0; n < 4; ++n) { accw[n] = (f32x4){0.f, 0.f, 0.f, 0.f}; acca[n] = (f32x4){0.f, 0.f, 0.f, 0.f}; }
#pragma unroll
    for (int ks = 0; ks < 2; ++ks) {
        bf16x8 bw[4], ba[4];
#pragma unroll
        for (int n = 0; n < 4; ++n) {
            const size_t wo = ((size_t)z * 512 + h * 64 + n * 16 + fr) * 64 + ks * 32 + fq * 8;
            bw[n] = *(const bf16x8*)(W + WO_UP + wo); ba[n] = *(const bf16x8*)(W + WO_AUP + wo);
        }
        float t8[8];
        sh8(qw[ks], pl + 7 * 64 + ks * 32 + fq * 8, t8);
#pragma unroll
        for (int i = 0; i < 8; ++i) { const float e = __expf(2.0f * t8[i]); t8[i] = 1.0f - 2.0f * __builtin_amdgcn_rcpf(e + 1.0f); }
        const bf16x8 aw = pack8(t8);
        sh8(qa[ks], pl + 8 * 64 + ks * 32 + fq * 8, t8);
        const bf16x8 aa = pack8(t8);
#pragma unroll
        for (int n = 0; n < 4; ++n) {
            accw[n] = __builtin_amdgcn_mfma_f32_16x16x32_bf16(bw[n], aw, accw[n], 0, 0, 0);
            acca[n] = __builtin_amdgcn_mfma_f32_16x16x32_bf16(ba[n], aa, acca[n], 0, 0, 0);
        }
    }
#pragma unroll
    for (int n = 0; n < 4; ++n) { st.aw[n] = accw[n]; st.aa[n] = acca[n]; }
}
__device__ __forceinline__ void scan_produce_B(const Params& p, const float* pl, int b, int h, int z, int s0, float* frow0, int lane, const ProdState& st) {
    const int fr = lane & 15, fq = lane >> 4;
    const int pp = scan_pos(z, s0 + fr);
    const bool hp = (pp != 0 && pp != CTXL), hn = (pp != CTXL - 1 && pp != TPB - 1);
    const bf16_t* hr = (const bf16_t*)(p.ws + OFF_R3) + ((size_t)b * TPB + pp) * 1920;
    Raw3x2 rr0[2], rk0[2], rv0[2], rr1[2], rk1[2], rv1[2];
    const bf16_t* pc = hr + h * 64 + fq * 4; const bf16_t* pa = hp ? pc - 1920 : pc; const bf16_t* pb = hn ? pc + 1920 : pc;
#pragma unroll
    for (int nn = 0; nn < 2; ++nn) {
        const int C4 = nn * 16, C5 = C4 + 32;
        rr0[nn] = ld3x2(pc, pa, pb, hp, hn, C4); rk0[nn] = ld3x2(pc, pa, pb, hp, hn, 512 + C4); rv0[nn] = ld3x2(pc, pa, pb, hp, hn, 1024 + C4);
        rr1[nn] = ld3x2(pc, pa, pb, hp, hn, C5); rk1[nn] = ld3x2(pc, pa, pb, hp, hn, 512 + C5); rv1[nn] = ld3x2(pc, pa, pb, hp, hn, 1024 + C5);
    }
    float ss = 0.f;
    float* frow = frow0 + fr * FSTR;
    const f32x4 w01[2] = {st.aw[0], st.aw[1]}, a01[2] = {st.aa[0], st.aa[1]}, w23[2] = {st.aw[2], st.aw[3]}, a23[2] = {st.aa[2], st.aa[3]};
    scan_produce_elem<0>(pl, fq, rr0, rk0, rv0, w01, a01, ss, frow);
    scan_produce_elem<2>(pl, fq, rr1, rk1, rv1, w23, a23, ss, frow);
    ss = fqsum(ss);
    const float inv = rsqrtf(fmaxf(ss, 1e-24f));
#pragma unroll
    for (int n = 0; n < 4; ++n) {
        const int c4 = n * 16 + fq * 4;
        f32x4 kk = *(const f32x4*)(frow + 0 * 64 + c4);
        f32x4 bb = *(const f32x4*)(frow + 2 * 64 + c4);
#pragma unroll
        for (int j = 0; j < 4; ++j) { kk[j] = kk[j] * inv; bb[j] = kk[j] * bb[j]; }
        *(f32x4*)(frow + 0 * 64 + c4) = kk;
        *(f32x4*)(frow + 2 * 64 + c4) = bb;
    }
}

typedef float f32x2 __attribute__((ext_vector_type(2)));
struct ScanHead { f32x4 kk[2]; f32x2 v; };
struct ScanBody { f32x4 w[2], bb[2], kd[2], r[2]; };
__device__ __forceinline__ void scan_ldh(ScanHead& c, const float* f, const float* fv) {
#pragma unroll
    for (int q = 0; q < 2; ++q) c.kk[q] = *(const f32x4*)(f + 0 * 64 + 4 * q);
    c.v = *(const f32x2*)fv;
}
__device__ __forceinline__ void scan_ldb(ScanBody& c, const float* f) {
#pragma unroll
    for (int q = 0; q < 2; ++q) {
        c.w[q] = *(const f32x4*)(f + 1 * 64 + 4 * q); c.bb[q] = *(const f32x4*)(f + 2 * 64 + 4 * q);
        c.kd[q] = *(const f32x4*)(f + 3 * 64 + 4 * q); c.r[q] = *(const f32x4*)(f + 4 * 64 + 4 * q);
    }
}
__device__ __forceinline__ void scan_unit(const Params& p, int l, int u, unsigned char* lds) {
    const int tid = ltid(), wid = __builtin_amdgcn_readfirstlane(tid >> 6), lane = tid & 63;
    const int b = u >> 4, h = (u >> 1) & 7, z = u & 1;
    float* fb = (float*)lds;
    bf16_t* Y = (bf16_t*)(p.ws + (z == 0 ? OFF_YF : OFF_YB));
    float* pl = fb + 3 * CHUNK * FSTR;
    for (int i = tid; i < 9 * 64; i += NTHREADS) {
        const int a = i >> 6, c = i & 63, C = h * 64 + c;
        float v;
        if (a < 3) v = p.rw_mu[(size_t)l * 1920 + a * 512 + C];
        else if (a == 3) v = p.rw_w0[((size_t)l * 2 + z) * 512 + C];
        else if (a == 4) v = p.rw_a0[((size_t)l * 2 + z) * 512 + C];
        else if (a == 5) v = p.rw_k_k[(size_t)l * 512 + C];
        else if (a == 6) v = p.rw_k_a[(size_t)l * 512 + C];
        else if (a == 7) v = p.rw_mu[(size_t)l * 1920 + 1536 + z * 64 + c];
        else v = p.rw_mu[(size_t)l * 1920 + 1664 + z * 64 + c];
        pl[i] = v;
    }
    __syncthreads();
    if (wid < 4) {
        f32x2 S2[8];
#pragma unroll
        for (int j = 0; j < 8; ++j) S2[j] = (f32x2){0.f, 0.f};
        __syncthreads();
        for (int c = 0; c < NCHUNK; ++c) {
            const float* fbc = fb + (c % 3) * CHUNK * FSTR + 8 * (lane & 7);
            const float* fbv = fb + (c % 3) * CHUNK * FSTR + 320 + 16 * wid + 2 * (lane >> 3);
            bf16_t* yp = Y + ((size_t)b * TPB) * 512 + h * 64 + 16 * wid + 2 * (lane >> 3);
            ScanHead ha, hb;
            scan_ldh(ha, fbc, fbv);
#define SCAN_STEP(HC, HN, SL) { \
                ScanBody bd; scan_ldb(bd, fbc + (SL) * FSTR); \
                if ((SL) + 1 < CHUNK) scan_ldh(HN, fbc + ((SL) + 1) * FSTR, fbv + ((SL) + 1) * FSTR); \
                f32x2 d0 = (f32x2){0.f, 0.f}, d1 = (f32x2){0.f, 0.f}; \
                _Pragma("unroll") for (int q = 0; q < 4; ++q) { const f32x2 k2 = (f32x2){HC.kk[q >> 1][2 * (q & 1)], HC.kk[q >> 1][2 * (q & 1) + 1]}; \
                    d0 = __builtin_elementwise_fma(S2[q], k2, d0); d1 = __builtin_elementwise_fma(S2[4 + q], k2, d1); } \
                const float sk0 = red8(d0[0] + d0[1]), sk1 = red8(d1[0] + d1[1]); \
                const f32x2 n0 = (f32x2){-sk0, -sk0}, n1 = (f32x2){-sk1, -sk1}, v0 = (f32x2){HC.v[0], HC.v[0]}, v1 = (f32x2){HC.v[1], HC.v[1]}; \
                f32x2 y0 = (f32x2){0.f, 0.f}, y1 = (f32x2){0.f, 0.f}; \
                _Pragma("unroll") for (int q = 0; q < 4; ++q) { \
                    const f32x2 w2 = (f32x2){bd.w[q >> 1][2 * (q & 1)], bd.w[q >> 1][2 * (q & 1) + 1]}, b2 = (f32x2){bd.bb[q >> 1][2 * (q & 1)], bd.bb[q >> 1][2 * (q & 1) + 1]}; \
                    const f32x2 kd2 = (f32x2){bd.kd[q >> 1][2 * (q & 1)], bd.kd[q >> 1][2 * (q & 1) + 1]}, r2 = (f32x2){bd.r[q >> 1][2 * (q & 1)], bd.r[q >> 1][2 * (q & 1) + 1]}; \
                    f32x2 t0 = S2[q] * w2; t0 = __builtin_elementwise_fma(b2, n0, t0); t0 = __builtin_elementwise_fma(kd2, v0, t0); \
                    f32x2 t1 = S2[4 + q] * w2; t1 = __builtin_elementwise_fma(b2, n1, t1); t1 = __builtin_elementwise_fma(kd2, v1, t1); \
                    S2[q] = t0; S2[4 + q] = t1; \
                    y0 = __builtin_elementwise_fma(t0, r2, y0); y1 = __builtin_elementwise_fma(t1, r2, y1); } \
                const float ya = red8(y0[0] + y0[1]), yb = red8(y1[0] + y1[1]); \
                const int pp = scan_pos(z, c * CHUNK + (SL)); \
                if ((lane & 7) == 0) *(unsigned*)(yp + (size_t)pp * 512) = pk_bf16(ya, yb); }
#pragma unroll 1
            for (int sl = 0; sl < CHUNK; sl += 2) {
                SCAN_STEP(ha, hb, sl)
                SCAN_STEP(hb, ha, sl + 1)
            }
            __syncthreads();
        }
    } else {
        ProdState st;
#pragma unroll
        for (int n = 0; n < 4; ++n) { st.aw[n] = (f32x4){0.f, 0.f, 0.f, 0.f}; st.aa[n] = (f32x4){0.f, 0.f, 0.f, 0.f}; }
        const int nrep = launder_i(1 + ((PROBE_MASK >> 10) & 1));
        const int pair = (wid - 4) >> 1, ph = (wid - 4) & 1;
        {
            float* f0 = fb + (pair % 3) * CHUNK * FSTR + ph * 16 * FSTR;
            scan_produce_A(p, pl, b, h, z, pair * CHUNK + ph * 16, f0, lane, st);
            if (pair == 0) scan_produce_B(p, pl, b, h, z, ph * 16, f0, lane, st);
        }
        __syncthreads();
        for (int c = 0; c < NCHUNK; ++c) {
            for (int rr_ = 0; rr_ < nrep; ++rr_) {
            if (pair == ((c + 1) & 1)) {
                if (c + 1 < NCHUNK) scan_produce_B(p, pl, b, h, z, (c + 1) * CHUNK + ph * 16, fb + ((c + 1) % 3) * CHUNK * FSTR + ph * 16 * FSTR, lane, st);
            } else {
                if (c + 2 < NCHUNK) scan_produce_A(p, pl, b, h, z, (c + 2) * CHUNK + ph * 16, fb + ((c + 2) % 3) * CHUNK * FSTR + ph * 16 * FSTR, lane, st);
            }
            }
            __syncthreads();
        }
    }
}

constexpr int ATT_STAGE = 20480;
__device__ __forceinline__ void attn_unit(const Params& p, int b, int h, int q0, int nkeys, unsigned char* lds, int do_write) {
    const int tid = ltid(), wid = __builtin_amdgcn_readfirstlane(tid >> 6), lane = tid & 63, fr = lane & 15, fq = lane >> 4;
    bf16_t* Q = (bf16_t*)(p.ws + OFF_Q);
    const bf16_t* KN = (const bf16_t*)(p.ws + OFF_KN);
    const bf16_t* KR = (const bf16_t*)(p.ws + OFF_KR);
    const bf16_t* VT = (const bf16_t*)(p.ws + OFF_VT);
    const size_t rb = (size_t)b * TPB;
    bf16x8 qf[2][3];
#pragma unroll
    for (int nq = 0; nq < 2; ++nq)
#pragma unroll
        for (int ks = 0; ks < 3; ++ks) qf[nq][ks] = *(const bf16x8*)(Q + (rb + q0 + wid * 32 + nq * 16 + fr) * 768 + h * 96 + ks * 32 + fq * 8);
    f32x4 oacc[4][2];
#pragma unroll
    for (int mt = 0; mt < 4; ++mt)
#pragma unroll
        for (int nq = 0; nq < 2; ++nq) oacc[mt][nq] = (f32x4){0.f, 0.f, 0.f, 0.f};
    float mrun[2] = {0.f, 0.f}, lsum[2] = {0.f, 0.f};
    const int c8 = (lane & 7) ^ ((4 * wid + (lane >> 4)) & 7);
    const bf16_t* knp = KN + (rb + 8 * wid + (lane >> 3)) * 512 + h * 64 + c8 * 8;
    const bf16_t* vtp = VT + ((size_t)(b * 8 + h) * 64 + 8 * wid + (lane >> 3)) * TPB + c8 * 8;
    const int c4 = (lane & 3) ^ ((lane >> 4) & 3);
    const bf16_t* krp = KR + (rb + 16 * (wid & 3) + (lane >> 2)) * 32 + c4 * 8;
    auto issue = [&](int t, int stg) {
        unsigned char* base = lds + stg * ATT_STAGE;
        const int k0 = t * 64;
        __builtin_amdgcn_global_load_lds((const GLB_AS unsigned*)(knp + (size_t)k0 * 512), (LDS_AS unsigned*)(base + wid * 1024), 16, 0, 0);
        __builtin_amdgcn_global_load_lds((const GLB_AS unsigned*)(vtp + k0), (LDS_AS unsigned*)(base + 12288 + wid * 1024), 16, 0, 0);
        if (wid < 4) __builtin_amdgcn_global_load_lds((const GLB_AS unsigned*)(krp + (size_t)k0 * 32), (LDS_AS unsigned*)(base + 8192 + wid * 1024), 16, 0, 0);
    };
    const int ntile = nkeys / 64;
    const int kz = fr >> 1, rz = (fr >> 2) & 3;
    issue(0, 0);
    asm volatile("s_waitcnt vmcnt(0)" ::: "memory");
    __builtin_amdgcn_s_barrier();
    asm volatile("" ::: "memory");
    for (int t = 0; t < ntile; ++t) {
        if (t + 1 < ntile) issue(t + 1, (t + 1) & 1);
        const unsigned char* Ks = lds + (t & 1) * ATT_STAGE;
        const unsigned char* Rs = Ks + 8192;
        const unsigned char* Vs = Ks + 12288;
        f32x4 sacc[4][2];
#pragma unroll
        for (int km = 0; km < 4; ++km)
#pragma unroll
            for (int nq = 0; nq < 2; ++nq) sacc[km][nq] = (f32x4){-mrun[nq], -mrun[nq], -mrun[nq], -mrun[nq]};
#pragma unroll
        for (int ks = 0; ks < 3; ++ks)
#pragma unroll
            for (int km = 0; km < 4; ++km) {
                const bf16x8 kf = ks < 2 ? *(const bf16x8*)(Ks + (km * 16 + fr) * 128 + (((ks * 4 + fq) ^ kz) * 16))
                                         : *(const bf16x8*)(Rs + (km * 16 + fr) * 64 + ((fq ^ rz) * 16));
#pragma unroll
                for (int nq = 0; nq < 2; ++nq) sacc[km][nq] = __builtin_amdgcn_mfma_f32_16x16x32_bf16(kf, qf[nq][ks], sacc[km][nq], 0, 0, 0);
            }
        float delta[2];
#pragma unroll
        for (int nq = 0; nq < 2; ++nq) {
            float mx = -1e30f;
#pragma unroll
            for (int km = 0; km < 4; ++km)
#pragma unroll
                for (int j = 0; j < 4; ++j) mx = fmaxf(mx, sacc[km][nq][j]);
            mx = fqmax(mx);
            delta[nq] = (t == 0) ? mx : fmaxf(mx, 0.f);
        }
        const bool exact = (t == 0) || (__builtin_amdgcn_ballot_w64(fmaxf(delta[0], delta[1]) > 60.0f) != 0ull);
        bf16x8 pf[2][2];
        float psum[2];
#pragma unroll
        for (int nq = 0; nq < 2; ++nq) {
            float ps = 0.f;
            if (exact) {
#pragma unroll
                for (int km = 0; km < 4; ++km)
#pragma unroll
                    for (int j = 0; j < 4; ++j) { const float e = __builtin_amdgcn_exp2f(sacc[km][nq][j] - delta[nq]); sacc[km][nq][j] = e; ps += e; }
            } else {
#pragma unroll
                for (int km = 0; km < 4; ++km)
#pragma unroll
                    for (int j = 0; j < 4; ++j) { const float e = __builtin_amdgcn_exp2f(sacc[km][nq][j]); sacc[km][nq][j] = e; ps += e; }
            }
            psum[nq] = ps;
#pragma unroll
            for (int kc = 0; kc < 2; ++kc) {
                union { uint4 u; bf16x8 v; } r;
                r.u.x = pk_bf16(sacc[2 * kc][nq][0], sacc[2 * kc][nq][1]); r.u.y = pk_bf16(sacc[2 * kc][nq][2], sacc[2 * kc][nq][3]);
                r.u.z = pk_bf16(sacc[2 * kc + 1][nq][0], sacc[2 * kc + 1][nq][1]); r.u.w = pk_bf16(sacc[2 * kc + 1][nq][2], sacc[2 * kc + 1][nq][3]);
                pf[kc][nq] = r.v;
            }
        }
        if (exact) {
#pragma unroll
            for (int nq = 0; nq < 2; ++nq) {
                const float alpha = (t == 0) ? 1.0f : __builtin_amdgcn_exp2f(-delta[nq]);
                lsum[nq] = lsum[nq] * alpha + psum[nq];
#pragma unroll
                for (int mt = 0; mt < 4; ++mt) oacc[mt][nq] = oacc[mt][nq] * alpha;
            }
        }
#pragma unroll
        for (int mt = 0; mt < 4; ++mt)
#pragma unroll
            for (int kc = 0; kc < 2; ++kc) {
                union { uint2 h2[2]; bf16x8 v; } r;
                const unsigned char* vrow = Vs + (mt * 16 + fr) * 128 + (fq & 1) * 8;
                r.h2[0] = *(const uint2*)(vrow + (((4 * kc + (fq >> 1)) ^ kz) * 16));
                r.h2[1] = *(const uint2*)(vrow + (((4 * kc + 2 + (fq >> 1)) ^ kz) * 16));
#pragma unroll
                for (int nq = 0; nq < 2; ++nq) oacc[mt][nq] = __builtin_amdgcn_mfma_f32_16x16x32_bf16(r.v, pf[kc][nq], oacc[mt][nq], 0, 0, 0);
            }
        if (!exact) {
#pragma unroll
            for (int nq = 0; nq < 2; ++nq) {
                const float alpha = __builtin_amdgcn_exp2f(-delta[nq]);
                lsum[nq] = (lsum[nq] + psum[nq]) * alpha;
#pragma unroll
                for (int mt = 0; mt < 4; ++mt) oacc[mt][nq] = oacc[mt][nq] * alpha;
            }
        }
#pragma unroll
        for (int nq = 0; nq < 2; ++nq) mrun[nq] += delta[nq];
        asm volatile("s_waitcnt vmcnt(0) lgkmcnt(0)" ::: "memory");
        __builtin_amdgcn_s_barrier();
        asm volatile("" ::: "memory");
    }
#pragma unroll
    for (int nq = 0; nq < 2; ++nq) {
        const float inv = 1.0f / fqsum(lsum[nq]);
        bf16_t* orow = Q + (rb + q0 + wid * 32 + nq * 16 + fr) * 768 + h * 96;
#pragma unroll
        for (int mt = 0; mt < 4; ++mt) {
            uint2 o; o.x = pk_bf16(oacc[mt][nq][0] * inv, oacc[mt][nq][1] * inv); o.y = pk_bf16(oacc[mt][nq][2] * inv, oacc[mt][nq][3] * inv);
            if (do_write) *(uint2*)(orow + mt * 16 + fq * 4) = o;
        }
    }
}

__device__ __forceinline__ void p3_phase(const Params& pin, int l, unsigned char* lds) {
    const Params p = launder(pin); l = launder_i(l);
    for (int r = 0, nr = launder_i(1 + ((PROBE_MASK >> 1) & 1)); r < nr; ++r)
        for (int u = blockIdx.x; u < 256; u += gridDim.x) scan_unit(p, l, u, lds);
    const int nunits = (l == DEPTH - 1) ? 1024 : 1152;
    for (int r = launder_i(((PROBE_MASK >> 9) & 1) ? 0 : 1); r < 2; ++r)
    for (int u = blockIdx.x; u < nunits; u += gridDim.x) {
        if (u < 1024) { const int bh = u >> 3, qt = u & 7; attn_unit(p, bh >> 3, bh & 7, CTXL + qt * 256, TPB, lds, r); }
        else { const int bh = u - 1024; attn_unit(p, bh >> 3, bh & 7, 0, CTXL, lds, r); }
    }
}

__device__ __forceinline__ void p35_phase(const Params& pin, int l, bool skip_ctx, unsigned char* lds) {
    const Params p = launder(pin); l = launder_i(l); const int tid = ltid();
    const bf16_t* SG = (const bf16_t*)(p.ws + OFF_SG);
    const bf16_t* W = (const bf16_t*)(p.ws + OFF_W) + WO_GUP;
    const bf16_t* YF = (const bf16_t*)(p.ws + OFF_YF);
    const bf16_t* YB = (const bf16_t*)(p.ws + OFF_YB);
    const bf16_t* Hr = (const bf16_t*)(p.ws + OFF_R3);
    bf16_t* RWO = (bf16_t*)(p.ws + OFF_RWO);
    const float* mu = p.rw_mu + (size_t)l * 1920;
    const int lane = tid & 63, wid = tid >> 6, wr = wid >> 1, wc = wid & 1, fr = lane & 15, fq = lane >> 4;
    float* gt = (float*)lds;
    constexpr int GP = 132;
    for (int t = blockIdx.x; t < 288 * 4; t += gridDim.x) {
        int mt, nt; tile_mn(t, 4, mt, nt);
        if (skip_ctx && (mt % 18) < 2) continue;
        f32x4 acc[2][4]; zero_acc<2>(acc);
        gemm_mainloop<2, 1>(acc, SG + (size_t)mt * 128 * 128, 128, 64, W + (size_t)nt * 128 * 128, 128, 2, lds, tid);
#pragma unroll
        for (int m = 0; m < 2; ++m)
#pragma unroll
            for (int n = 0; n < 4; ++n) *(f32x4*)(gt + (wr * 32 + m * 16 + fr) * GP + wc * 64 + n * 16 + fq * 4) = acc[m][n];
        __syncthreads();
        const int pp0 = (mt % 18) * 128;
#pragma unroll 1
        for (int it = 0; it < 4; ++it) {
            const int item = tid + it * NTHREADS, lrow = item >> 4, cg = item & 15, pp = pp0 + lrow;
            const size_t row = (size_t)mt * 128 + lrow;
            const int C = nt * 128 + cg * 8;
            const bool hp = (pp != 0 && pp != CTXL), hn = (pp != CTXL - 1 && pp != TPB - 1);
            const bf16_t* hr = Hr + row * 1920;
            float yf[8], yb[8], r8[8], k8[8], v8[8];
            unpack8(*(const uint4*)(YF + row * 512 + C), yf); unpack8(*(const uint4*)(YB + row * 512 + C), yb);
            shift8(hr, hp, hn, C, mu, r8); shift8(hr, hp, hn, 512 + C, mu, k8); shift8(hr, hp, hn, 1024 + C, mu, v8);
            const float* rkp = p.rw_r_k + (size_t)l * 512 + C;
            float s1 = 0.f, bs = 0.f;
#pragma unroll
            for (int i = 0; i < 8; ++i) { yf[i] += yb[i]; s1 += yf[i]; bs += r8[i] * k8[i] * rkp[i]; }
            s1 = red8(s1); bs = red8(bs);
            const float mean = s1 * (1.0f / 64.0f);
            float s2 = 0.f;
#pragma unroll
            for (int i = 0; i < 8; ++i) { const float d = yf[i] - mean; s2 += d * d; }
            s2 = red8(s2);
            const float rstd = rsqrtf(s2 * (1.0f / 64.0f) + 64e-5f);
            const float* ggp = p.rw_gn_g + (size_t)l * 512 + C; const float* gbp = p.rw_gn_b + (size_t)l * 512 + C;
            const f32x4 g0 = *(const f32x4*)(gt + lrow * GP + cg * 8), g1 = *(const f32x4*)(gt + lrow * GP + cg * 8 + 4);
            float o[8];
#pragma unroll
            for (int i = 0; i < 8; ++i) o[i] = ((yf[i] - mean) * rstd * ggp[i] + gbp[i] + bs * v8[i]) * (i < 4 ? g0[i] : g1[i - 4]);
            uint4 ov; ov.x = pk_bf16(o[0], o[1]); ov.y = pk_bf16(o[2], o[3]); ov.z = pk_bf16(o[4], o[5]); ov.w = pk_bf16(o[6], o[7]);
            *(uint4*)(RWO + row * 512 + C) = ov;
        }
        __syncthreads();
    }
}

__device__ __forceinline__ void p4_phase(const Params& pin, bool skip_ctx, unsigned char* lds) {
    const Params p = launder(pin); const int tid = ltid();
    const bf16_t* XM = (const bf16_t*)(p.ws + OFF_R6);
    const bf16_t* W = (const bf16_t*)(p.ws + OFF_W);
    bf16_t* MG = (bf16_t*)(p.ws + OFF_MRG);
    const int lane = tid & 63, wid = tid >> 6, wr = wid >> 1, wc = wid & 1, fr = lane & 15, fq = lane >> 4;
    for (int t = blockIdx.x; t < 288 * 8; t += gridDim.x) {
        int mt, nt; tile_mn(t, 8, mt, nt);
        if (skip_ctx && (mt % 18) < 2) continue;
        f32x4 g[3][2][4];
#pragma unroll
        for (int i = 0; i < 3; ++i) zero_acc<2>(g[i]);
        gemm_gate3(g, XM + (size_t)mt * 128 * 1024, W + WO_IN + (size_t)(4224 + nt * 128) * 1024, 16, lds, tid);
        typedef __fp16 h16x2 __attribute__((ext_vector_type(2)));
        h16x2 gp[3][2][4][2];
#pragma unroll
        for (int i = 0; i < 3; ++i)
#pragma unroll
            for (int m = 0; m < 2; ++m)
#pragma unroll
                for (int n = 0; n < 4; ++n) {
                    gp[i][m][n][0] = __builtin_amdgcn_cvt_pkrtz(sigmoidf_(g[i][m][n][0]), sigmoidf_(g[i][m][n][1]));
                    gp[i][m][n][1] = __builtin_amdgcn_cvt_pkrtz(sigmoidf_(g[i][m][n][2]), sigmoidf_(g[i][m][n][3]));
                }
        f32x4 mg[2][4]; zero_acc<2>(mg);
#pragma unroll 1
        for (int i = 0; i < 3; ++i) {
            const bf16_t* Ab; int lda, kst; const bf16_t* Wb;
            if (i == 0) { Ab = (const bf16_t*)(p.ws + OFF_Q); lda = 768; kst = 96; Wb = W + WO_OA; }
            else if (i == 1) { Ab = (const bf16_t*)(p.ws + OFF_R5); lda = 512; kst = 64; Wb = W + WO_OC; }
            else { Ab = (const bf16_t*)(p.ws + OFF_RWO); lda = 512; kst = 64; Wb = W + WO_OR; }
            f32x4 a[2][4]; zero_acc<2>(a);
            gemm_mainloop<2, 1>(a, Ab + (size_t)mt * 128 * lda, lda, kst, Wb + (size_t)nt * 128 * 512, 512, 8, lds, tid);
#pragma unroll
            for (int m = 0; m < 2; ++m)
#pragma unroll
                for (int n = 0; n < 4; ++n) {
                    const h16x2 g0 = i == 0 ? gp[0][m][n][0] : (i == 1 ? gp[1][m][n][0] : gp[2][m][n][0]);
                    const h16x2 g1 = i == 0 ? gp[0][m][n][1] : (i == 1 ? gp[1][m][n][1] : gp[2][m][n][1]);
                    mg[m][n][0] += (float)g0[0] * a[m][n][0]; mg[m][n][1] += (float)g0[1] * a[m][n][1];
                    mg[m][n][2] += (float)g1[0] * a[m][n][2]; mg[m][n][3] += (float)g1[1] * a[m][n][3];
                }
        }
#pragma unroll
        for (int m = 0; m < 2; ++m) {
            const size_t row = (size_t)mt * 128 + wr * 32 + m * 16 + fr;
#pragma unroll
            for (int n = 0; n < 4; ++n) {
                uint2 o; o.x = pk_bf16(mg[m][n][0], mg[m][n][1]); o.y = pk_bf16(mg[m][n][2], mg[m][n][3]);
                *(uint2*)(MG + row * 1024 + nt * 128 + wc * 64 + n * 16 + fq * 4) = o;
            }
        }
    }
}

template <int MT>
__device__ __forceinline__ void resid_tile(const Params& p, int l, const bf16_t* A, int lda, int nk, const bf16_t* Wt, int ldb, int goff, bool x_from_input,
                                           const float* lng, const float* lnb, int row0, int nt, unsigned char* lds, int tid) {
    const int lane = tid & 63, wid = tid >> 6, wr = wid >> 1, wc = wid & 1, fr = lane & 15, fq = lane >> 4;
    f32x4 acc[MT][4]; zero_acc<MT>(acc);
    gemm_mainloop<MT, 1>(acc, A + (size_t)row0 * lda, lda, 64, Wt + (size_t)nt * 128 * ldb, ldb, nk, lds, tid);
    const int b = row0 / TPB, pp0 = row0 % TPB;
    const float* gv = modv_ptr(p, l, b, pp0) + goff;
    const float* stats = (const float*)(p.ws + OFF_STATS);
#pragma unroll
    for (int m = 0; m < MT; ++m) {
        const int lr = wr * 16 * MT + m * 16 + fr, pp = pp0 + lr;
        const float* xi = x_rd(p, x_from_input, b, pp);
        float* xo = x_wr(p, b, pp);
        float mean = 0.f, rstd = 1.f;
        if (!x_from_input) { const size_t row = (size_t)row0 + lr; mean = stats[row * 2]; rstd = stats[row * 2 + 1]; }
#pragma unroll
        for (int n = 0; n < 4; ++n) {
            const int col = nt * 128 + wc * 64 + n * 16 + fq * 4;
            f32x4 xv = *(const f32x4*)(xi + col); const f32x4 g4 = *(const f32x4*)(gv + col);
            if (!x_from_input) {
                const f32x4 lg = *(const f32x4*)(lng + col), lb = *(const f32x4*)(lnb + col);
#pragma unroll
                for (int j = 0; j < 4; ++j) xv[j] = (xv[j] - mean) * rstd * lg[j] + lb[j];
            }
            f32x4 o;
#pragma unroll
            for (int j = 0; j < 4; ++j) o[j] = ALPHA * xv[j] + g4[j] * acc[m][n][j];
            *(f32x4*)(xo + col) = o;
        }
    }
}
__device__ __forceinline__ void resid_tile256(const Params& p, int l, const bf16_t* A, int lda, int nk, const bf16_t* Wt, int ldb, int goff, bool x_from_input,
                                              const float* lng, const float* lnb, int row0, int nt256, unsigned char* lds, int tid) {
    const int lane = tid & 63, wid = tid >> 6, wr = wid >> 2, wc = wid & 3, fr = lane & 15, fq = lane >> 4;
    f32x4 acc[8][4]; zero_acc<8>(acc);
    Seg sg; sg.A = A + (size_t)row0 * lda; sg.Bt = Wt + (size_t)nt256 * 256 * ldb; sg.lda = lda; sg.a_kstep = 64; sg.ldb = ldb; sg.nk = nk;
    int st = 0;
    gemm_stream256(acc, sg, sg, false, true, st, lds, tid);
    const int b = row0 / TPB, pp0 = row0 % TPB;
    const float* gv = modv_ptr(p, l, b, pp0) + goff;
    const float* stats = (const float*)(p.ws + OFF_STATS);
#pragma unroll
    for (int m = 0; m < 8; ++m) {
        const int lr = wr * 128 + m * 16 + fr, pp = pp0 + lr;
        const float* xi = x_rd(p, x_from_input, b, pp);
        float* xo = x_wr(p, b, pp);
        float mean = 0.f, rstd = 1.f;
        if (!x_from_input) { const size_t row = (size_t)row0 + lr; mean = stats[row * 2]; rstd = stats[row * 2 + 1]; }
#pragma unroll
        for (int n = 0; n < 4; ++n) {
            const int col = nt256 * 256 + wc * 64 + n * 16 + fq * 4;
            f32x4 xv = *(const f32x4*)(xi + col); const f32x4 g4 = *(const f32x4*)(gv + col);
            if (!x_from_input) {
                const f32x4 lg = *(const f32x4*)(lng + col), lb = *(const f32x4*)(lnb + col);
#pragma unroll
                for (int j = 0; j < 4; ++j) xv[j] = (xv[j] - mean) * rstd * lg[j] + lb[j];
            }
            f32x4 o;
#pragma unroll
            for (int j = 0; j < 4; ++j) o[j] = ALPHA * xv[j] + g4[j] * acc[m][n][j];
            *(f32x4*)(xo + col) = o;
        }
    }
}
__device__ __forceinline__ void resid_gemm_phase(const Params& pin, int l, size_t a_off, int lda, int nk, size_t w_off, int ldb, int goff, bool x_from_input, const float* lng, const float* lnb, bool skip_ctx, unsigned char* lds) {
    const Params p = launder(pin); l = launder_i(l);
    const int tid = ltid();
    const bf16_t* A = (const bf16_t*)(p.ws + a_off);
    const bf16_t* Wt = (const bf16_t*)(p.ws + OFF_W) + w_off;
    if (gridDim.x == 256) {
        for (int t = blockIdx.x; t < 512; t += 256) {
            int mt, nt; tile_mn(t, 4, mt, nt);
            if (skip_ctx && (mt % 9) == 0) continue;
            resid_tile256(p, l, A, lda, nk, Wt, ldb, goff, x_from_input, lng, lnb, mt * 256, nt, lds, tid);
        }
        int mt, nt; tile_mn(512 + (blockIdx.x >> 2), 4, mt, nt);
        const int q = blockIdx.x & 3;
        if (!(skip_ctx && (mt % 9) == 0)) resid_tile<2>(p, l, A, lda, nk, Wt, ldb, goff, x_from_input, lng, lnb, mt * 256 + (q >> 1) * 128, nt * 2 + (q & 1), lds, tid);
    } else {
        for (int t = blockIdx.x; t < 144 * 8; t += gridDim.x) {
            int mt, nt; tile_mn(t, 8, mt, nt);
            if (skip_ctx && (mt % 9) == 0) continue;
            resid_tile<4>(p, l, A, lda, nk, Wt, ldb, goff, x_from_input, lng, lnb, mt * 256, nt, lds, tid);
        }
    }
}

__device__ __forceinline__ void ln_phase(const Params& pin, const float* g, const float* bta, int lmod, int shoff, bool write_xmod, bool write_x, bool skip_ctx) {
    const Params p = launder(pin); lmod = launder_i(lmod);
    const int tid = ltid(), wid = tid >> 6, lane = tid & 63;
    bf16_t* xm = (bf16_t*)(p.ws + OFF_R6);
    float* stats = (float*)(p.ws + OFF_STATS);
    for (int row = blockIdx.x * 8 + wid; row < MROWS; row += gridDim.x * 8) {
        const int b = row / TPB, pp = row % TPB;
        if (skip_ctx && pp < CTXL) continue;
        float* xp = x_wr(p, b, pp);
        f32x4 v[4];
        float s = 0.f;
#pragma unroll
        for (int i = 0; i < 4; ++i) { v[i] = *(const f32x4*)(xp + i * 256 + lane * 4); s += (v[i][0] + v[i][1]) + (v[i][2] + v[i][3]); }
        const float mean = wave_sum(s) * (1.0f / 1024.0f);
        float q = 0.f;
#pragma unroll
        for (int i = 0; i < 4; ++i)
#pragma unroll
            for (int j = 0; j < 4; ++j) { const float d = v[i][j] - mean; q += d * d; }
        const float rstd = rsqrtf(wave_sum(q) * (1.0f / 1024.0f) + 1e-5f);
        if (lane == 0) { stats[(size_t)row * 2] = mean; stats[(size_t)row * 2 + 1] = rstd; }
        const float* mv = write_xmod ? modv_ptr(p, lmod, b, pp) + shoff : nullptr;
#pragma unroll
        for (int i = 0; i < 4; ++i) {
            const int c = i * 256 + lane * 4;
            const f32x4 g4 = *(const f32x4*)(g + c), b4 = *(const f32x4*)(bta + c);
            f32x4 o;
#pragma unroll
            for (int j = 0; j < 4; ++j) o[j] = (v[i][j] - mean) * rstd * g4[j] + b4[j];
            if (write_x) *(f32x4*)(xp + c) = o;
            if (write_xmod) {
                const f32x4 sh = *(const f32x4*)(mv + c), sc = *(const f32x4*)(mv + 1024 + c);
                uint2 ov; ov.x = pk_bf16(o[0] * (1.f + sc[0]) + sh[0], o[1] * (1.f + sc[1]) + sh[1]); ov.y = pk_bf16(o[2] * (1.f + sc[2]) + sh[2], o[3] * (1.f + sc[3]) + sh[3]);
                *(uint2*)(xm + (size_t)row * 1024 + c) = ov;
            }
        }
    }
}

__device__ __forceinline__ void p7_phase(const Params& pin, bool skip_ctx, unsigned char* lds) {
    const Params p = launder(pin); const int tid = ltid();
    const bf16_t* A = (const bf16_t*)(p.ws + OFF_R6);
    const bf16_t* W = (const bf16_t*)(p.ws + OFF_W) + WO_13;
    bf16_t* HF = (bf16_t*)(p.ws + OFF_HF);
    const int lane = tid & 63, wid = tid >> 6, wr = wid >> 2, wc = wid & 3, fr = lane & 15, fq = lane >> 4;
    auto seg = [&](int t) { int mt, nt; tile_mn(t, 22, mt, nt); Seg g; g.A = A + (size_t)mt * 256 * 1024; g.Bt = W + (size_t)nt * 256 * 1024; g.lda = 1024; g.a_kstep = 64; g.ldb = 1024; g.nk = 16; return g; };
    auto valid = [&](int t) { int mt, nt; tile_mn(t, 22, mt, nt); return !(skip_ctx && (mt % 9) == 0); };
    auto nextv = [&](int t) { while (t < 144 * 22 && !valid(t)) t += gridDim.x; return t; };
    int st = 0; bool first = true;
    for (int t = nextv(blockIdx.x); t < 144 * 22;) {
        int mt, nt; tile_mn(t, 22, mt, nt);
        const int tn = nextv(t + gridDim.x); const bool hn = tn < 144 * 22;
        f32x4 acc[8][4]; zero_acc<8>(acc);
        gemm_stream256(acc, seg(t), seg(hn ? tn : t), hn, first, st, lds, tid); first = false;
        const int G = nt * 4 + wc;
#pragma unroll
        for (int m = 0; m < 8; ++m) {
            const size_t row = (size_t)mt * 256 + wr * 128 + m * 16 + fr;
            uint2 ov[2];
#pragma unroll
            for (int n = 0; n < 2; ++n) {
                float o[4];
#pragma unroll
                for (int j = 0; j < 4; ++j) o[j] = siluf_(acc[m][n][j]) * acc[m][n + 2][j];
                ov[n].x = pk_bf16(o[0], o[1]); ov[n].y = pk_bf16(o[2], o[3]);
            }
            *(uint4*)(HF + row * DFF + G * 32 + (fq & 1) * 16 + (fq >> 1) * 8) = widen16(ov[0], ov[1]);
        }
        t = tn;
    }
}

__global__ void __launch_bounds__(NTHREADS) fwd_megakernel(Params p) {
    extern __shared__ __attribute__((aligned(16))) unsigned char lds[];
    cg::grid_group grid = cg::this_grid();
    unsigned* gbar = (unsigned*)(p.ws + OFF_BAR); unsigned epoch = 0;
#define GSYNC() grid_barrier(gbar, epoch)
    if (p.ws == nullptr) grid.sync();
    modv_phase(p, lds);
    convert_layer(p, 0, lds);
    {
        bf16_t* Wm = (bf16_t*)(p.ws + OFF_W) + WO_IN + (size_t)672 * 1024;
        for (int i = blockIdx.x * NTHREADS + threadIdx.x; i < 96 * 1024 / 2; i += gridDim.x * NTHREADS) ((unsigned*)Wm)[i] = 0u;
    }
    GSYNC();
    xmod0_phase(p);
    GSYNC();
#pragma unroll 1
    for (int l = 0; l < DEPTH; ++l) {
        const bool last = (l == DEPTH - 1);
        for (int r = 0, nr = launder_i(1 + ((PROBE_MASK >> 2) & 1)); r < nr; ++r) p1_phase(p, lds);
        GSYNC();
        for (int r = 0, nr = launder_i(1 + ((PROBE_MASK >> 3) & 1)); r < nr; ++r) p2a_phase(p, l);
        GSYNC();
        for (int r = 0, nr = launder_i(1 + ((PROBE_MASK >> 4) & 1)); r < nr; ++r) p2b_phase(p, l, lds);
        GSYNC();
        p3_phase(p, l, lds);
        GSYNC();
        for (int r = 0, nr = launder_i(1 + ((PROBE_MASK >> 5) & 1)); r < nr; ++r) p35_phase(p, l, last, lds);
        GSYNC();
        for (int r = 0, nr = launder_i(1 + ((PROBE_MASK >> 6) & 1)); r < nr; ++r) p4_phase(p, last, lds);
        GSYNC();
        resid_gemm_phase(p, l, OFF_MRG, 1024, 16, WO_OUT, 1024, 2048, l == 0, p.ln2_g + (l > 0 ? l - 1 : 0) * 1024, p.ln2_b + (l > 0 ? l - 1 : 0) * 1024, last, lds);
        GSYNC();
        ln_phase(p, p.ln1_g + l * 1024, p.ln1_b + l * 1024, l, 3072, true, false, last);
        GSYNC();
        for (int r = 0, nr = launder_i(1 + ((PROBE_MASK >> 0) & 1)); r < nr; ++r) p7_phase(p, last, lds);
        GSYNC();
        resid_gemm_phase(p, l, OFF_HF, DFF, 44, WO_2, DFF, 5120, false, p.ln1_g + l * 1024, p.ln1_b + l * 1024, last, lds);
        GSYNC();
        ln_phase(p, p.ln2_g + l * 1024, p.ln2_b + l * 1024, last ? l : l + 1, 0, !last, last, last);
        if (!last) for (int r = 0, nr = launder_i(1 + ((PROBE_MASK >> 7) & 1)); r < nr; ++r) convert_layer(p, l + 1, lds);
        for (int r = 0, nr = launder_i(((PROBE_MASK >> 8) & 1) * 10); r < nr; ++r) GSYNC();
        GSYNC();
    }
}

extern "C" void kernel_launch(void* const* d_in, const int* in_sizes, int n_in, void* d_out,
                              int out_size, void* d_ws, size_t ws_size, hipStream_t stream) {
    static int grid_blocks = 0;
    if (!grid_blocks) {
        int dev = 0, cus = 0, per_cu = 0;
        hipGetDevice(&dev);
        hipDeviceGetAttribute(&cus, hipDeviceAttributeMultiprocessorCount, dev);
        if (hipFuncSetAttribute((const void*)fwd_megakernel, hipFuncAttributeMaxDynamicSharedMemorySize, LDS_BYTES) != hipSuccess)
            fprintf(stderr, "hipFuncSetAttribute failed\n");
        hipOccupancyMaxActiveBlocksPerMultiprocessor(&per_cu, (const void*)fwd_megakernel, NTHREADS, LDS_BYTES);
        if (per_cu < 1) fprintf(stderr, "occupancy query says %d blocks/CU\n", per_cu);
        (void)hipGetLastError();
        grid_blocks = cus > 0 ? cus : 256;
        if (ws_size < WS_END) { fprintf(stderr, "workspace too small: %zu < %zu\n", ws_size, (size_t)WS_END); grid_blocks = -1; }
        if (n_in != 33) { fprintf(stderr, "expected 33 inputs, got %d\n", n_in); grid_blocks = -1; }
    }
    if (grid_blocks < 0) return;
    if (hipMemsetAsync((unsigned char*)d_ws + OFF_BAR, 0, 1024, stream) != hipSuccess) fprintf(stderr, "memset failed\n");
    Params p{};
    const float** pp = (const float**)&p;
    for (int i = 0; i < 33; ++i) pp[i] = (const float*)d_in[i];
    p.out = (float*)d_out;
    p.ws = (unsigned char*)d_ws;
    void* args[] = {&p};
    hipError_t e = hipLaunchCooperativeKernel((void*)fwd_megakernel, dim3(grid_blocks), dim3(NTHREADS), args, LDS_BYTES, stream);
    if (e != hipSuccess) fprintf(stderr, "cooperative launch failed: %s (grid %d)\n", hipGetErrorString(e), grid_blocks);
}
```

```cpp
#include <hip/hip_runtime.h>
#include <hip/hip_cooperative_groups.h>
#include <cstdio>
#include <cstdint>
namespace cg = cooperative_groups;

typedef unsigned short bf16_t;
typedef short bf16x8 __attribute__((ext_vector_type(8)));
typedef float f32x4 __attribute__((ext_vector_type(4)));

#ifndef PROBE_MASK
#define PROBE_MASK 0
#endif
constexpr int BATCH = 16, SEQ = 2048, CTXL = 256, DM = 1024, DEPTH = 4, DFF = 2816, DIN = 7200;
constexpr int TPB = SEQ + CTXL;
constexpr int MROWS = BATCH * TPB;
constexpr int NTHREADS = 512;
constexpr int LDS_BYTES = 152 * 1024;
constexpr float ALPHA = 1.681792830507429f;
constexpr float QSCALE = 0.10206207261596575f * 1.4426950408889634f;

constexpr size_t WO_IN = 0;
constexpr size_t WO_UQ = WO_IN + (size_t)7296 * 1024;
constexpr size_t WO_UKV = WO_UQ + (size_t)768 * 384;
constexpr size_t WO_OA = WO_UKV + (size_t)1024 * 256;
constexpr size_t WO_OC = WO_OA + (size_t)1024 * 512;
constexpr size_t WO_OR = WO_OC + (size_t)1024 * 512;
constexpr size_t WO_OUT = WO_OR + (size_t)1024 * 512;
constexpr size_t WO_13 = WO_OUT + (size_t)1024 * 1024;
constexpr size_t WO_2 = WO_13 + (size_t)5632 * 1024;
constexpr size_t WO_UP = WO_2 + (size_t)1024 * 2816;
constexpr size_t WO_AUP = WO_UP + (size_t)2 * 512 * 64;
constexpr size_t WO_GUP = WO_AUP + (size_t)2 * 512 * 64;
constexpr size_t W_ELEMS = WO_GUP + (size_t)512 * 128;

constexpr size_t al256(size_t x) { return (x + 255) & ~(size_t)255; }
constexpr size_t OFF_BAR = 0;
constexpr size_t OFF_W = 1024;
constexpr size_t OFF_MODV = al256(OFF_W + W_ELEMS * 2);
constexpr size_t OFF_ROPE = al256(OFF_MODV + (size_t)4 * 17 * 6144 * 4);
constexpr size_t OFF_RSQ = al256(OFF_ROPE + 64 * 8 * 2 * 4);
constexpr size_t OFF_RSKV = al256(OFF_RSQ + (size_t)MROWS * 4);
constexpr size_t OFF_STATS = al256(OFF_RSKV + (size_t)MROWS * 4);
constexpr size_t OFF_XC = al256(OFF_STATS + (size_t)MROWS * 8);
constexpr size_t OFF_R1 = al256(OFF_XC + (size_t)BATCH * CTXL * DM * 4);
constexpr size_t OFF_R2 = al256(OFF_R1 + (size_t)MROWS * 672 * 2);
constexpr size_t OFF_R3 = OFF_R2 + (size_t)MROWS * 1536 * 2;
constexpr size_t OFF_R4 = al256(OFF_R3 + (size_t)MROWS * 1920 * 2);
constexpr size_t OFF_R5 = al256(OFF_R4 + (size_t)MROWS * (512 + 512 + 32) * 2);
constexpr size_t OFF_R6 = al256(OFF_R5 + (size_t)MROWS * 512 * 2);
constexpr size_t WS_END = al256(OFF_R6 + (size_t)MROWS * 1024 * 2);
constexpr size_t OFF_Q = OFF_R2;
constexpr size_t OFF_YF = OFF_R2 + (size_t)MROWS * 768 * 2;
constexpr size_t OFF_SG = OFF_YF + (size_t)MROWS * 512 * 2;
constexpr size_t OFF_YB = OFF_R1;
constexpr size_t OFF_KN = OFF_R4;
constexpr size_t OFF_VT = OFF_R4 + (size_t)MROWS * 512 * 2;
constexpr size_t OFF_KR = OFF_VT + (size_t)MROWS * 512 * 2;
constexpr size_t OFF_RWO = OFF_R4;
constexpr size_t OFF_MRG = OFF_R3;
constexpr size_t OFF_HF = OFF_R2;
static_assert(OFF_SG + (size_t)MROWS * 128 * 2 <= OFF_R3, "R2 overlay overflow");
static_assert((size_t)MROWS * 2816 * 2 <= OFF_R4 - OFF_R2, "HF overflow");

struct Params {
    const float *x, *c, *ctx, *c_ctx, *mod_w, *mod_b, *w_in, *q_norm, *w_uq, *kv_norm, *w_ukv, *w_o_attn,
        *conv_w, *w_o_conv, *rw_mu, *rw_w0, *rw_w_up, *rw_a0, *rw_a_up, *rw_g_up, *rw_k_k, *rw_k_a,
        *rw_r_k, *rw_gn_g, *rw_gn_b, *w_o_rwkv, *w_out, *ln1_g, *ln1_b, *ffn_w13, *ffn_w2, *ln2_g, *ln2_b;
    float* out;
    unsigned char* ws;
};

typedef __attribute__((address_space(1))) unsigned char gchar_t;
typedef __attribute__((address_space(1))) float gfloat_t;
__device__ __forceinline__ Params launder(const Params& a) {
    Params q = a;
    unsigned long long w = (unsigned long long)a.ws, o = (unsigned long long)a.out;
    unsigned wl = __builtin_amdgcn_readfirstlane((unsigned)w), wh = __builtin_amdgcn_readfirstlane((unsigned)(w >> 32));
    unsigned ol = __builtin_amdgcn_readfirstlane((unsigned)o), oh = __builtin_amdgcn_readfirstlane((unsigned)(o >> 32));
    asm volatile("" : "+s"(wl), "+s"(wh), "+s"(ol), "+s"(oh));
    w = ((unsigned long long)wh << 32) | wl; o = ((unsigned long long)oh << 32) | ol;
    q.ws = (unsigned char*)(gchar_t*)w; q.out = (float*)(gfloat_t*)o;
    return q;
}
__device__ __forceinline__ int launder_i(int v) { v = __builtin_amdgcn_readfirstlane(v); asm volatile("" : "+s"(v)); return v; }
__device__ __forceinline__ int ltid() { int t = threadIdx.x; asm volatile("" : "+v"(t)); return t; }
__device__ __forceinline__ unsigned pk_bf16(float lo, float hi) { unsigned r; asm("v_cvt_pk_bf16_f32 %0, %1, %2" : "=v"(r) : "v"(lo), "v"(hi)); return r; }
__device__ __forceinline__ float bf_lo(unsigned u) { return __uint_as_float(u << 16); }
__device__ __forceinline__ float bf_hi(unsigned u) { return __uint_as_float(u & 0xffff0000u); }
__device__ __forceinline__ float bf1(bf16_t h) { return __uint_as_float(((unsigned)h) << 16); }
__device__ __forceinline__ float x32sum(float x) { unsigned u = __float_as_uint(x); auto r = __builtin_amdgcn_permlane32_swap(u, u, false, false); return __uint_as_float(r[0]) + __uint_as_float(r[1]); }
__device__ __forceinline__ float x16sum(float x) { unsigned u = __float_as_uint(x); auto r = __builtin_amdgcn_permlane16_swap(u, u, false, false); return __uint_as_float(r[0]) + __uint_as_float(r[1]); }
__device__ __forceinline__ float x32max(float x) { unsigned u = __float_as_uint(x); auto r = __builtin_amdgcn_permlane32_swap(u, u, false, false); return fmaxf(__uint_as_float(r[0]), __uint_as_float(r[1])); }
__device__ __forceinline__ float x16max(float x) { unsigned u = __float_as_uint(x); auto r = __builtin_amdgcn_permlane16_swap(u, u, false, false); return fmaxf(__uint_as_float(r[0]), __uint_as_float(r[1])); }
__device__ __forceinline__ float fqsum(float x) { return x16sum(x32sum(x)); }
__device__ __forceinline__ float fqmax(float x) { return x16max(x32max(x)); }
__device__ __forceinline__ float wave_sum(float v) {
#pragma unroll
    for (int o = 1; o < 16; o <<= 1) v += __shfl_xor(v, o);
    return fqsum(v);
}
template <int CTRL> __device__ __forceinline__ float dpp_add(float x) { return x + __uint_as_float((unsigned)__builtin_amdgcn_update_dpp(0, (int)__float_as_uint(x), CTRL, 0xf, 0xf, true)); }
__device__ __forceinline__ float red8(float x) { x = dpp_add<0xB1>(x); x = dpp_add<0x4E>(x); x = dpp_add<0x141>(x); return x; }
__device__ __forceinline__ uint4 widen16(uint2 a, uint2 b) {
    auto r0 = __builtin_amdgcn_permlane16_swap(a.x, b.x, false, false);
    auto r1 = __builtin_amdgcn_permlane16_swap(a.y, b.y, false, false);
    return make_uint4(r0[0], r1[0], r0[1], r1[1]);
}
__device__ __forceinline__ float sigmoidf_(float x) { return 1.0f / (1.0f + __expf(-x)); }
__device__ __forceinline__ float siluf_(float x) { return x / (1.0f + __expf(-x)); }

__device__ __forceinline__ const float* x_rd(const Params& p, bool from_input, int b, int pp) {
    if (pp < CTXL) return (from_input ? p.ctx : (const float*)(p.ws + OFF_XC)) + ((size_t)b * CTXL + pp) * DM;
    return (from_input ? p.x : (const float*)p.out) + ((size_t)b * SEQ + (pp - CTXL)) * DM;
}
__device__ __forceinline__ float* x_wr(const Params& p, int b, int pp) {
    if (pp < CTXL) return (float*)(p.ws + OFF_XC) + ((size_t)b * CTXL + pp) * DM;
    return p.out + ((size_t)b * SEQ + (pp - CTXL)) * DM;
}
__device__ __forceinline__ const float* modv_ptr(const Params& p, int l, int b, int pp) {
    const int mr = pp < CTXL ? 16 : b;
    return (const float*)(p.ws + OFF_MODV) + ((size_t)l * 17 + mr) * 6144;
}

__device__ __forceinline__ void grid_barrier(unsigned* bar, unsigned& epoch) {
    asm volatile("s_waitcnt vmcnt(0) lgkmcnt(0)" ::: "memory");
    __syncthreads();
    epoch += 1;
    if (threadIdx.x == 0) {
        __builtin_amdgcn_fence(__ATOMIC_RELEASE, "agent");
        asm volatile("s_waitcnt vmcnt(0)" ::: "memory");
        const unsigned old = __hip_atomic_fetch_add(bar, 1u, __ATOMIC_RELAXED, __HIP_MEMORY_SCOPE_AGENT);
        if (old + 1u == epoch * gridDim.x) {
            __hip_atomic_store(bar + 64, epoch, __ATOMIC_RELAXED, __HIP_MEMORY_SCOPE_AGENT);
        } else {
            while (__hip_atomic_load(bar + 64, __ATOMIC_RELAXED, __HIP_MEMORY_SCOPE_AGENT) < epoch) __builtin_amdgcn_s_sleep(1);
        }
        __builtin_amdgcn_fence(__ATOMIC_ACQUIRE, "agent");
        asm volatile("s_waitcnt vmcnt(0)" ::: "memory");
    }
    __syncthreads();
}

#define LDS_AS __attribute__((address_space(3)))
#define GLB_AS __attribute__((address_space(1)))
template <int MT, int SWAPMODE>
__device__ __forceinline__ void gemm_mainloop(f32x4 (&acc)[MT][4], const bf16_t* __restrict__ A, int lda, int a_kstep,
                                              const bf16_t* __restrict__ Bt, int ldb, int nk, unsigned char* lds, int tid) {
    constexpr int BMr = 64 * MT;
    constexpr int STAGE = (BMr + 128) * 128;
    const int wid = __builtin_amdgcn_readfirstlane(tid >> 6), lane = tid & 63, wr = wid >> 1, wc = wid & 1, fr = lane & 15, fq = lane >> 4;
    const int lrow = 8 * wid + (lane >> 3);
    const int lch = (lane & 7) ^ ((4 * wid + (lane >> 4)) & 7);
    const bf16_t* ap = A + (size_t)lrow * lda + lch * 8;
    const bf16_t* bp = Bt + (size_t)lrow * ldb + lch * 8;
    auto issue = [&](int kt, int st) {
        unsigned char* base = lds + st * STAGE + wid * 1024;
#pragma unroll
        for (int i = 0; i < MT; ++i)
            __builtin_amdgcn_global_load_lds((const GLB_AS unsigned*)(ap + (size_t)i * 64 * lda + (size_t)kt * a_kstep), (LDS_AS unsigned*)(base + i * 8192), 16, 0, 0);
#pragma unroll
        for (int i = 0; i < 2; ++i)
            __builtin_amdgcn_global_load_lds((const GLB_AS unsigned*)(bp + (size_t)i * 64 * ldb + (size_t)kt * 64), (LDS_AS unsigned*)(base + (BMr + i * 64) * 128), 16, 0, 0);
    };
    const bool sw = (SWAPMODE == 1) || (SWAPMODE == 2 && wc == 0);
    const int sz = fr >> 1;
    constexpr int NL = MT + 2;
    const bool late = wid >= 4;
    issue(0, 0);
    if (nk > 1) { issue(1, 1); asm volatile("s_waitcnt vmcnt(%0)" ::"n"(NL) : "memory"); }
    else asm volatile("s_waitcnt vmcnt(0)" ::: "memory");
    __builtin_amdgcn_s_barrier();
    asm volatile("" ::: "memory");
    int st = 0;
    for (int kt = 0; kt < nk; ++kt) {
        const int st2 = st >= 1 ? st - 1 : 2;
        if (!late && kt + 2 < nk) issue(kt + 2, st2);
        const unsigned char* As = lds + st * STAGE;
        const unsigned char* Bs = As + BMr * 128;
#pragma unroll
        for (int ks = 0; ks < 2; ++ks) {
            bf16x8 af[MT], bfr[4];
            const int co = ((ks * 4 + fq) ^ sz) * 16;
#pragma unroll
            for (int m = 0; m < MT; ++m) af[m] = *(const bf16x8*)(As + (wr * 16 * MT + m * 16 + fr) * 128 + co);
#pragma unroll
            for (int n = 0; n < 4; ++n) bfr[n] = *(const bf16x8*)(Bs + (wc * 64 + n * 16 + fr) * 128 + co);
            if (sw) {
#pragma unroll
                for (int m = 0; m < MT; ++m)
#pragma unroll
                    for (int n = 0; n < 4; ++n) acc[m][n] = __builtin_amdgcn_mfma_f32_16x16x32_bf16(bfr[n], af[m], acc[m][n], 0, 0, 0);
            } else {
#pragma unroll
                for (int m = 0; m < MT; ++m)
#pragma unroll
                    for (int n = 0; n < 4; ++n) acc[m][n] = __builtin_amdgcn_mfma_f32_16x16x32_bf16(af[m], bfr[n], acc[m][n], 0, 0, 0);
            }
        }
        if (late && kt + 2 < nk) issue(kt + 2, st2);
        if (kt + 2 < nk) asm volatile("s_waitcnt vmcnt(%0) lgkmcnt(0)" ::"n"(NL) : "memory");
        else asm volatile("s_waitcnt vmcnt(0) lgkmcnt(0)" ::: "memory");
        __builtin_amdgcn_s_barrier();
        asm volatile("" ::: "memory");
        st = st == 2 ? 0 : st + 1;
    }
}
__device__ __forceinline__ void gemm_mainloop256(f32x4 (&acc)[8][4], const bf16_t* __restrict__ A, int lda,
                                                 const bf16_t* __restrict__ Bt, int ldb, int nk, unsigned char* lds, int tid) {
    constexpr int STAGE = 512 * 128;
    const int wid = __builtin_amdgcn_readfirstlane(tid >> 6), lane = tid & 63, wr = wid >> 2, wc = wid & 3, fr = lane & 15, fq = lane >> 4;
    const int lrow = 8 * wid + (lane >> 3);
    const int lch = (lane & 7) ^ ((4 * wid + (lane >> 4)) & 7);
    const bf16_t* ap = A + (size_t)lrow * lda + lch * 8;
    const bf16_t* bp = Bt + (size_t)lrow * ldb + lch * 8;
    auto issue = [&](int kt, int st) {
        unsigned char* base = lds + st * STAGE + wid * 1024;
#pragma unroll
        for (int i = 0; i < 4; ++i)
            __builtin_amdgcn_global_load_lds((const GLB_AS unsigned*)(ap + (size_t)i * 64 * lda + (size_t)kt * 64), (LDS_AS unsigned*)(base + i * 8192), 16, 0, 0);
#pragma unroll
        for (int i = 0; i < 4; ++i)
            __builtin_amdgcn_global_load_lds((const GLB_AS unsigned*)(bp + (size_t)i * 64 * ldb + (size_t)kt * 64), (LDS_AS unsigned*)(base + (256 + i * 64) * 128), 16, 0, 0);
    };
    const int sz = fr >> 1;
    const bool late = wid >= 4;
    issue(0, 0);
    asm volatile("s_waitcnt vmcnt(0)" ::: "memory");
    __builtin_amdgcn_s_barrier();
    asm volatile("" ::: "memory");
    for (int kt = 0; kt < nk; ++kt) {
        if (!late && kt + 1 < nk) issue(kt + 1, (kt + 1) & 1);
        const unsigned char* As = lds + (kt & 1) * STAGE;
        const unsigned char* Bs = As + 256 * 128;
#pragma unroll
        for (int ks = 0; ks < 2; ++ks) {
            if (ks == 1 && late && kt + 1 < nk) issue(kt + 1, (kt + 1) & 1);
            bf16x8 af[8], bfr[4];
            const int co = ((ks * 4 + fq) ^ sz) * 16;
#pragma unroll
            for (int m = 0; m < 8; ++m) af[m] = *(const bf16x8*)(As + (wr * 128 + m * 16 + fr) * 128 + co);
#pragma unroll
            for (int n = 0; n < 4; ++n) bfr[n] = *(const bf16x8*)(Bs + (wc * 64 + n * 16 + fr) * 128 + co);
#pragma unroll
            for (int m = 0; m < 8; ++m)
#pragma unroll
                for (int n = 0; n < 4; ++n) acc[m][n] = __builtin_amdgcn_mfma_f32_16x16x32_bf16(bfr[n], af[m], acc[m][n], 0, 0, 0);
        }
        asm volatile("s_waitcnt vmcnt(0) lgkmcnt(0)" ::: "memory");
        __builtin_amdgcn_s_barrier();
        asm volatile("" ::: "memory");
    }
}
struct Seg { const bf16_t* A; const bf16_t* Bt; int lda, a_kstep, ldb, nk; };
template <int MT, int SWAPMODE>
__device__ __forceinline__ void gemm_stream(f32x4 (&acc)[MT][4], const Seg& cur, const Seg& nxt, bool has_next, bool first, int& st,
                                            unsigned char* lds, int tid) {
    constexpr int BMr = 64 * MT;
    constexpr int STAGE = (BMr + 128) * 128;
    constexpr int NL = MT + 2;
    const int wid = __builtin_amdgcn_readfirstlane(tid >> 6), lane = tid & 63, wr = wid >> 1, wc = wid & 1, fr = lane & 15, fq = lane >> 4;
    const int lrow = 8 * wid + (lane >> 3);
    const int lch = (lane & 7) ^ ((4 * wid + (lane >> 4)) & 7);
    const bf16_t* apc = cur.A + (size_t)lrow * cur.lda + lch * 8;
    const bf16_t* bpc = cur.Bt + (size_t)lrow * cur.ldb + lch * 8;
    const bf16_t* apn = nxt.A + (size_t)lrow * nxt.lda + lch * 8;
    const bf16_t* bpn = nxt.Bt + (size_t)lrow * nxt.ldb + lch * 8;
    auto issue = [&](const bf16_t* ap, const bf16_t* bp, int lda, int ldb, int koffa, int koffb, int slot) {
        unsigned char* base = lds + slot * STAGE + wid * 1024;
#pragma unroll
        for (int i = 0; i < MT; ++i)
            __builtin_amdgcn_global_load_lds((const GLB_AS unsigned*)(ap + (size_t)i * 64 * lda + koffa), (LDS_AS unsigned*)(base + i * 8192), 16, 0, 0);
#pragma unroll
        for (int i = 0; i < 2; ++i)
            __builtin_amdgcn_global_load_lds((const GLB_AS unsigned*)(bp + (size_t)i * 64 * ldb + koffb), (LDS_AS unsigned*)(base + (BMr + i * 64) * 128), 16, 0, 0);
    };
    const bool sw = (SWAPMODE == 1) || (SWAPMODE == 2 && wc == 0);
    const int sz = fr >> 1;
    const bool late = wid >= 4;
    const int nk = cur.nk;
    int s0 = st;
    if (first) {
        const int s1 = s0 == 2 ? 0 : s0 + 1;
        issue(apc, bpc, cur.lda, cur.ldb, 0, 0, s0);
        issue(apc, bpc, cur.lda, cur.ldb, cur.a_kstep, 64, s1);
        asm volatile("s_waitcnt vmcnt(%0)" ::"n"(NL) : "memory");
        __builtin_amdgcn_s_barrier();
        asm volatile("" ::: "memory");
    }
    for (int kt = 0; kt < nk; ++kt) {
        const int s2 = s0 >= 1 ? s0 - 1 : 2;
        const int idx = kt + 2;
        const bool incur = idx < nk, doi = incur || has_next;
        if (!late && doi) { if (incur) issue(apc, bpc, cur.lda, cur.ldb, idx * cur.a_kstep, idx * 64, s2); else issue(apn, bpn, nxt.lda, nxt.ldb, (idx - nk) * nxt.a_kstep, (idx - nk) * 64, s2); }
        const unsigned char* As = lds + s0 * STAGE;
        const unsigned char* Bs = As + BMr * 128;
#pragma unroll
        for (int ks = 0; ks < 2; ++ks) {
            bf16x8 af[MT], bfr[4];
            const int co = ((ks * 4 + fq) ^ sz) * 16;
#pragma unroll
            for (int m = 0; m < MT; ++m) af[m] = *(const bf16x8*)(As + (wr * 16 * MT + m * 16 + fr) * 128 + co);
#pragma unroll
            for (int n = 0; n < 4; ++n) bfr[n] = *(const bf16x8*)(Bs + (wc * 64 + n * 16 + fr) * 128 + co);
            if (sw) {
#pragma unroll
                for (int m = 0; m < MT; ++m)
#pragma unroll
                    for (int n = 0; n < 4; ++n) acc[m][n] = __builtin_amdgcn_mfma_f32_16x16x32_bf16(bfr[n], af[m], acc[m][n], 0, 0, 0);
            } else {
#pragma unroll
                for (int m = 0; m < MT; ++m)
#pragma unroll
                    for (int n = 0; n < 4; ++n) acc[m][n] = __builtin_amdgcn_mfma_f32_16x16x32_bf16(af[m], bfr[n], acc[m][n], 0, 0, 0);
            }
        }
        if (late && doi) { if (incur) issue(apc, bpc, cur.lda, cur.ldb, idx * cur.a_kstep, idx * 64, s2); else issue(apn, bpn, nxt.lda, nxt.ldb, (idx - nk) * nxt.a_kstep, (idx - nk) * 64, s2); }
        if (doi) asm volatile("s_waitcnt vmcnt(%0) lgkmcnt(0)" ::"n"(NL) : "memory");
        else asm volatile("s_waitcnt vmcnt(0) lgkmcnt(0)" ::: "memory");
        __builtin_amdgcn_s_barrier();
        asm volatile("" ::: "memory");
        s0 = s0 == 2 ? 0 : s0 + 1;
    }
    st = s0;
}
__device__ __forceinline__ void gemm_stream256(f32x4 (&acc)[8][4], const Seg& cur, const Seg& nxt, bool has_next, bool first, int& st, unsigned char* lds, int tid) {
    constexpr int STAGE = 512 * 128;
    const int wid = __builtin_amdgcn_readfirstlane(tid >> 6), lane = tid & 63, wr = wid >> 2, wc = wid & 3, fr = lane & 15, fq = lane >> 4;
    const int lrow = 8 * wid + (lane >> 3);
    const int lch = (lane & 7) ^ ((4 * wid + (lane >> 4)) & 7);
    const bf16_t* apc = cur.A + (size_t)lrow * cur.lda + lch * 8;
    const bf16_t* bpc = cur.Bt + (size_t)lrow * cur.ldb + lch * 8;
    const bf16_t* apn = nxt.A + (size_t)lrow * nxt.lda + lch * 8;
    const bf16_t* bpn = nxt.Bt + (size_t)lrow * nxt.ldb + lch * 8;
    auto issue = [&](const bf16_t* ap, const bf16_t* bp, int lda, int ldb, int koff, int slot) {
        unsigned char* base = lds + slot * STAGE + wid * 1024;
#pragma unroll
        for (int i = 0; i < 4; ++i)
            __builtin_amdgcn_global_load_lds((const GLB_AS unsigned*)(ap + (size_t)i * 64 * lda + koff), (LDS_AS unsigned*)(base + i * 8192), 16, 0, 0);
#pragma unroll
        for (int i = 0; i < 4; ++i)
            __builtin_amdgcn_global_load_lds((const GLB_AS unsigned*)(bp + (size_t)i * 64 * ldb + koff), (LDS_AS unsigned*)(base + (256 + i * 64) * 128), 16, 0, 0);
    };
    const int sz = fr >> 1;
    const bool late = wid >= 4;
    const int nk = cur.nk;
    int s0 = st;
    if (first) {
        issue(apc, bpc, cur.lda, cur.ldb, 0, s0);
        asm volatile("s_waitcnt vmcnt(0)" ::: "memory");
        __builtin_amdgcn_s_barrier();
        asm volatile("" ::: "memory");
    }
    for (int kt = 0; kt < nk; ++kt) {
        const int idx = kt + 1;
        const bool incur = idx < nk, doi = incur || has_next;
        if (!late && doi) { if (incur) issue(apc, bpc, cur.lda, cur.ldb, idx * 64, s0 ^ 1); else issue(apn, bpn, nxt.lda, nxt.ldb, 0, s0 ^ 1); }
        const unsigned char* As = lds + s0 * STAGE;
        const unsigned char* Bs = As + 256 * 128;
#pragma unroll
        for (int ks = 0; ks < 2; ++ks) {
            if (ks == 1 && late && doi) { if (incur) issue(apc, bpc, cur.lda, cur.ldb, idx * 64, s0 ^ 1); else issue(apn, bpn, nxt.lda, nxt.ldb, 0, s0 ^ 1); }
            bf16x8 af[8], bfr[4];
            const int co = ((ks * 4 + fq) ^ sz) * 16;
#pragma unroll
            for (int m = 0; m < 8; ++m) af[m] = *(const bf16x8*)(As + (wr * 128 + m * 16 + fr) * 128 + co);
#pragma unroll
            for (int n = 0; n < 4; ++n) bfr[n] = *(const bf16x8*)(Bs + (wc * 64 + n * 16 + fr) * 128 + co);
#pragma unroll
            for (int m = 0; m < 8; ++m)
#pragma unroll
                for (int n = 0; n < 4; ++n) acc[m][n] = __builtin_amdgcn_mfma_f32_16x16x32_bf16(bfr[n], af[m], acc[m][n], 0, 0, 0);
        }
        asm volatile("s_waitcnt vmcnt(0) lgkmcnt(0)" ::: "memory");
        __builtin_amdgcn_s_barrier();
        asm volatile("" ::: "memory");
        s0 ^= 1;
    }
    st = s0;
}
__device__ __forceinline__ void gemm_gate3(f32x4 (&g)[3][2][4], const bf16_t* __restrict__ A, const bf16_t* __restrict__ Bt0, int nk, unsigned char* lds, int tid) {
    constexpr int STAGE = 512 * 128;
    const int wid = __builtin_amdgcn_readfirstlane(tid >> 6), lane = tid & 63, wr = wid >> 1, wc = wid & 1, fr = lane & 15, fq = lane >> 4;
    const int lrow = 8 * wid + (lane >> 3);
    const int lch = (lane & 7) ^ ((4 * wid + (lane >> 4)) & 7);
    const unsigned loff = (unsigned)(lrow * 1024 + lch * 8);
    auto issue = [&](int kt, int stg) {
        unsigned char* base = lds + stg * STAGE + wid * 1024;
#pragma unroll
        for (int i = 0; i < 2; ++i)
            __builtin_amdgcn_global_load_lds((const GLB_AS unsigned*)((A + (size_t)i * 64 * 1024 + (size_t)kt * 64) + loff), (LDS_AS unsigned*)(base + i * 8192), 16, 0, 0);
#pragma unroll
        for (int j = 0; j < 6; ++j)
            __builtin_amdgcn_global_load_lds((const GLB_AS unsigned*)((Bt0 + ((size_t)(j >> 1) * 1024 + (j & 1) * 64) * 1024 + (size_t)kt * 64) + loff), (LDS_AS unsigned*)(base + (128 + j * 64) * 128), 16, 0, 0);
    };
    const int sz = fr >> 1;
    const bool late = wid >= 4;
    issue(0, 0);
    asm volatile("s_waitcnt vmcnt(0)" ::: "memory");
    __builtin_amdgcn_s_barrier();
    asm volatile("" ::: "memory");
    for (int kt = 0; kt < nk; ++kt) {
        if (!late && kt + 1 < nk) issue(kt + 1, (kt + 1) & 1);
        const unsigned char* As = lds + (kt & 1) * STAGE;
        const unsigned char* Bs = As + 128 * 128;
#pragma unroll
        for (int ks = 0; ks < 2; ++ks) {
            if (ks == 1 && late && kt + 1 < nk) issue(kt + 1, (kt + 1) & 1);
            const int co = ((ks * 4 + fq) ^ sz) * 16;
            bf16x8 af[2];
#pragma unroll
            for (int m = 0; m < 2; ++m) af[m] = *(const bf16x8*)(As + (wr * 32 + m * 16 + fr) * 128 + co);
#pragma unroll
            for (int i = 0; i < 3; ++i) {
                bf16x8 bfr[4];
#pragma unroll
                for (int n = 0; n < 4; ++n) bfr[n] = *(const bf16x8*)(Bs + (i * 128 + wc * 64 + n * 16 + fr) * 128 + co);
#pragma unroll
                for (int m = 0; m < 2; ++m)
#pragma unroll
                    for (int n = 0; n < 4; ++n) g[i][m][n] = __builtin_amdgcn_mfma_f32_16x16x32_bf16(bfr[n], af[m], g[i][m][n], 0, 0, 0);
                if (i < 2) __builtin_amdgcn_sched_barrier(0);
            }
        }
        asm volatile("s_waitcnt vmcnt(0) lgkmcnt(0)" ::: "memory");
        __builtin_amdgcn_s_barrier();
        asm volatile("" ::: "memory");
    }
}
template <int MT> __device__ __forceinline__ void zero_acc(f32x4 (&acc)[MT][4]) {
#pragma unroll
    for (int m = 0; m < MT; ++m)
#pragma unroll
        for (int n = 0; n < 4; ++n) acc[m][n] = (f32x4){0.f, 0.f, 0.f, 0.f};
}
__device__ __forceinline__ void tile_mn(int t, int nN, int& mt, int& nt) { const int per = 16 * nN, g = t / per, w = t % per; mt = g * 16 + (w & 15); nt = w >> 4; }

__device__ __forceinline__ int rowmap(int mode, int n) {
    if (mode == 1) return n < 672 ? n : n + 96;
    if (mode == 2) return n < DFF ? ((n >> 5) * 64 + (n & 31)) : (((n - DFF) >> 5) * 64 + 32 + ((n - DFF) & 31));
    return n;
}
__device__ __forceinline__ void convert_T(const float* __restrict__ src, int K, int N, bf16_t* __restrict__ dst, int mode, const float* __restrict__ ks, unsigned char* lds, int rot) {
    float* tile = (float*)lds;
    const int ntk = K / 64, ntn = (N + 63) / 64, tid = ltid();
    const int start = (blockIdx.x + gridDim.x - (rot % gridDim.x)) % gridDim.x;
    for (int t = start; t < ntk * ntn; t += gridDim.x) {
        const int tk = t % ntk, tn = t / ntk, k0 = tk * 64, n0 = tn * 64;
#pragma unroll
        for (int i = 0; i < 8; ++i) {
            const int kl = (tid >> 6) + 8 * i, nl = tid & 63, n = n0 + nl;
            tile[kl * 65 + nl] = n < N ? src[(size_t)(k0 + kl) * N + n] : 0.f;
        }
        __syncthreads();
        const int kp = (tid & 31) * 2;
        float s0 = 1.f, s1 = 1.f;
        if (ks) { s0 = ks[k0 + kp]; s1 = ks[k0 + kp + 1]; }
#pragma unroll
        for (int i = 0; i < 4; ++i) {
            const int nl = (tid >> 5) + 16 * i, n = n0 + nl;
            if (n < N) *(unsigned*)(dst + (size_t)rowmap(mode, n) * K + k0 + kp) = pk_bf16(tile[kp * 65 + nl] * s0, tile[(kp + 1) * 65 + nl] * s1);
        }
        __syncthreads();
    }
}
__device__ __forceinline__ void convert_layer(const Params& pin, int l, unsigned char* lds) {
    const Params p = launder(pin); l = launder_i(l);
    bf16_t* W = (bf16_t*)(p.ws + OFF_W);
    convert_T(p.w_in + (size_t)l * DM * DIN, DM, DIN, W + WO_IN, 1, nullptr, lds, 0);
    convert_T(p.ffn_w13 + (size_t)l * DM * 2 * DFF, DM, 2 * DFF, W + WO_13, 2, nullptr, lds, 40);
    convert_T(p.ffn_w2 + (size_t)l * DFF * DM, DFF, DM, W + WO_2, 0, nullptr, lds, 80);
    convert_T(p.w_out + (size_t)l * DM * DM, DM, DM, W + WO_OUT, 0, nullptr, lds, 120);
    convert_T(p.w_o_attn + (size_t)l * 512 * DM, 512, DM, W + WO_OA, 0, nullptr, lds, 136);
    convert_T(p.w_o_conv + (size_t)l * 512 * DM, 512, DM, W + WO_OC, 0, nullptr, lds, 8);
    convert_T(p.w_o_rwkv + (size_t)l * 512 * DM, 512, DM, W + WO_OR, 0, nullptr, lds, 136 + 8);
    convert_T(p.w_uq + (size_t)l * 384 * 768, 384, 768, W + WO_UQ, 0, p.q_norm + l * 384, lds, 16);
    convert_T(p.w_ukv + (size_t)l * 256 * 1024, 256, 1024, W + WO_UKV, 0, p.kv_norm + l * 256, lds, 88);
    for (int z = 0; z < 2; ++z) {
        convert_T(p.rw_w_up + ((size_t)l * 2 + z) * 64 * 512, 64, 512, W + WO_UP + (size_t)z * 512 * 64, 0, nullptr, lds, 152 + 8 * z);
        convert_T(p.rw_a_up + ((size_t)l * 2 + z) * 64 * 512, 64, 512, W + WO_AUP + (size_t)z * 512 * 64, 0, nullptr, lds, 168 + 8 * z);
    }
    convert_T(p.rw_g_up + (size_t)l * 128 * 512, 128, 512, W + WO_GUP, 0, nullptr, lds, 184);
}

__device__ __forceinline__ void modv_phase(const Params& pin, unsigned char* lds) {
    const Params p = launder(pin);
    float* s = (float*)lds;
    float* red = s + 17 * 1024;
    const int tid = ltid(), wid = tid >> 6, lane = tid & 63;
    for (int i = tid; i < 17 * 1024; i += NTHREADS) { const int r = i >> 10, k = i & 1023; const float v = r < 16 ? p.c[r * 1024 + k] : p.c_ctx[k]; s[i] = siluf_(v); }
    __syncthreads();
    float* modv = (float*)(p.ws + OFF_MODV);
    for (int g = blockIdx.x; g < 4 * 96; g += gridDim.x) {
        const int l = g / 96, n = (g % 96) * 64 + lane;
        const float* w = p.mod_w + (size_t)l * 1024 * 6144 + n;
        float acc[17];
#pragma unroll
        for (int r = 0; r < 17; ++r) acc[r] = 0.f;
        const int kb = wid * 128;
        for (int k = kb; k < kb + 128; k += 4) {
            const float w0 = w[(size_t)k * 6144], w1 = w[(size_t)(k + 1) * 6144], w2 = w[(size_t)(k + 2) * 6144], w3 = w[(size_t)(k + 3) * 6144];
#pragma unroll
            for (int r = 0; r < 17; ++r) { const f32x4 sv = *(const f32x4*)(s + r * 1024 + k); acc[r] += sv[0] * w0 + sv[1] * w1 + sv[2] * w2 + sv[3] * w3; }
        }
#pragma unroll
        for (int r = 0; r < 17; ++r) red[(wid * 17 + r) * 64 + lane] = acc[r];
        __syncthreads();
        for (int i = tid; i < 17 * 64; i += NTHREADS) {
            const int r = i >> 6, c = i & 63; float v = 0.f;
#pragma unroll
            for (int w8 = 0; w8 < 8; ++w8) v += red[(w8 * 17 + r) * 64 + c];
            const int nn = (g % 96) * 64 + c;
            modv[((size_t)l * 17 + r) * 6144 + nn] = v + p.mod_b[l * 6144 + nn];
        }
        __syncthreads();
    }
    if (blockIdx.x == gridDim.x - 1) {
        float* rope = (float*)(p.ws + OFF_ROPE);
        for (int i = tid; i < 512; i += NTHREADS) {
            const int pos = i >> 3, f = i & 7;
            const float inv = exp2f(-(float)f * (13.287712379549449f / 8.0f));
            const float ang = (float)pos * inv;
            rope[i * 2] = cosf(ang); rope[i * 2 + 1] = sinf(ang);
        }
    }
}

__device__ __forceinline__ void xmod0_phase(const Params& pin) {
    const Params p = launder(pin);
    const int tid = ltid(), wid = tid >> 6, lane = tid & 63;
    bf16_t* xm = (bf16_t*)(p.ws + OFF_R6);
    for (int row = blockIdx.x * 8 + wid; row < MROWS; row += gridDim.x * 8) {
        const int b = row / TPB, pp = row % TPB;
        const float* xp = x_rd(p, true, b, pp);
        const float* mv = modv_ptr(p, 0, b, pp);
#pragma unroll
        for (int i = 0; i < 4; ++i) {
            const int c = i * 256 + lane * 4;
            const f32x4 v = *(const f32x4*)(xp + c), sh = *(const f32x4*)(mv + c), sc = *(const f32x4*)(mv + 1024 + c);
            uint2 o; o.x = pk_bf16(v[0] * (1.f + sc[0]) + sh[0], v[1] * (1.f + sc[1]) + sh[1]); o.y = pk_bf16(v[2] * (1.f + sc[2]) + sh[2], v[3] * (1.f + sc[3]) + sh[3]);
            *(uint2*)(xm + (size_t)row * 1024 + c) = o;
        }
    }
}

__device__ __forceinline__ void p1_phase(const Params& pin, unsigned char* lds) {
    const Params p = launder(pin); const int tid = ltid();
    const bf16_t* A = (const bf16_t*)(p.ws + OFF_R6);
    const bf16_t* W = (const bf16_t*)(p.ws + OFF_W) + WO_IN;
    const int lane = tid & 63, wid = tid >> 6, wr = wid >> 2, wc = wid & 3, fr = lane & 15, fq = lane >> 4;
    auto seg = [&](int t) { int mt, nt; tile_mn(t, 17, mt, nt); Seg g; g.A = A + (size_t)mt * 256 * 1024; g.Bt = W + (size_t)nt * 256 * 1024; g.lda = 1024; g.a_kstep = 64; g.ldb = 1024; g.nk = 16; return g; };
    int st = 0; bool first = true;
    for (int t = blockIdx.x; t < 144 * 17; t += gridDim.x) {
        int mt, nt; tile_mn(t, 17, mt, nt);
        const int tn = t + gridDim.x; const bool hn = tn < 144 * 17;
        f32x4 acc[8][4]; zero_acc<8>(acc);
        gemm_stream256(acc, seg(t), seg(hn ? tn : t), hn, first, st, lds, tid); first = false;
        bf16_t* dst; int ld, cb, lim;
        if (nt < 3) { dst = (bf16_t*)(p.ws + OFF_R1); ld = 672; cb = nt * 256; lim = 672; }
        else if (nt < 9) { dst = (bf16_t*)(p.ws + OFF_R2); ld = 1536; cb = (nt - 3) * 256; lim = 1536; }
        else { dst = (bf16_t*)(p.ws + OFF_R3); ld = 1920; cb = (nt - 9) * 256; lim = 1920; }
#pragma unroll
        for (int m = 0; m < 8; ++m) {
            const size_t row = (size_t)mt * 256 + wr * 128 + m * 16 + fr;
#pragma unroll
            for (int n = 0; n < 4; n += 2) {
                uint2 a, b2;
                a.x = pk_bf16(acc[m][n][0], acc[m][n][1]); a.y = pk_bf16(acc[m][n][2], acc[m][n][3]);
                b2.x = pk_bf16(acc[m][n + 1][0], acc[m][n + 1][1]); b2.y = pk_bf16(acc[m][n + 1][2], acc[m][n + 1][3]);
                const uint4 w = widen16(a, b2);
                const int col = cb + wc * 64 + (n + (fq & 1)) * 16 + (fq >> 1) * 8;
                if (col < lim) *(uint4*)(dst + row * ld + col) = w;
            }
        }
    }
}

__device__ __forceinline__ void unpack8(const uint4 u, float (&f)[8]) {
    f[0] = bf_lo(u.x); f[1] = bf_hi(u.x); f[2] = bf_lo(u.y); f[3] = bf_hi(u.y); f[4] = bf_lo(u.z); f[5] = bf_hi(u.z); f[6] = bf_lo(u.w); f[7] = bf_hi(u.w);
}
__device__ __forceinline__ void p2a_phase(const Params& pin, int l) {
    const Params p = launder(pin); l = launder_i(l);
    const int tid = ltid(), wid = tid >> 6, lane = tid & 63;
    const bf16_t* Hm = (const bf16_t*)(p.ws + OFF_R1);
    const bf16_t* Hc = (const bf16_t*)(p.ws + OFF_R2);
    bf16_t* CV = (bf16_t*)(p.ws + OFF_R5);
    bf16_t* KR = (bf16_t*)(p.ws + OFF_KR);
    float* RSQ = (float*)(p.ws + OFF_RSQ);
    float* RSKV = (float*)(p.ws + OFF_RSKV);
    const float* rope = (const float*)(p.ws + OFF_ROPE);
    const float* cw = p.conv_w + (size_t)l * 3 * 512;
    const int c0 = lane * 8;
    float w0[8], w1[8], w2[8];
#pragma unroll
    for (int i = 0; i < 8; ++i) { w0[i] = cw[c0 + i]; w1[i] = cw[512 + c0 + i]; w2[i] = cw[1024 + c0 + i]; }
    for (int row = blockIdx.x * 8 + wid; row < MROWS; row += gridDim.x * 8) {
        const int pp = row % TPB;
        const bool hp = (pp != 0 && pp != CTXL), hn = (pp != CTXL - 1 && pp != TPB - 1);
        const bf16_t* hr = Hc + (size_t)row * 1536;
        float ch[8], cc[8], cb[8], u0[8], u1[8], u2[8];
        unpack8(*(const uint4*)(hr + c0), ch); unpack8(*(const uint4*)(hr + 1024 + c0), cc); unpack8(*(const uint4*)(hr + 512 + c0), cb);
#pragma unroll
        for (int i = 0; i < 8; ++i) u1[i] = cc[i] * ch[i];
        if (hp) { unpack8(*(const uint4*)(hr - 1536 + c0), ch); unpack8(*(const uint4*)(hr - 1536 + 1024 + c0), cc);
#pragma unroll
            for (int i = 0; i < 8; ++i) u0[i] = cc[i] * ch[i]; }
        else {
#pragma unroll
            for (int i = 0; i < 8; ++i) u0[i] = 0.f; }
        if (hn) { unpack8(*(const uint4*)(hr + 1536 + c0), ch); unpack8(*(const uint4*)(hr + 1536 + 1024 + c0), cc);
#pragma unroll
            for (int i = 0; i < 8; ++i) u2[i] = cc[i] * ch[i]; }
        else {
#pragma unroll
            for (int i = 0; i < 8; ++i) u2[i] = 0.f; }
        float o[8];
#pragma unroll
        for (int i = 0; i < 8; ++i) o[i] = cb[i] * (u0[i] * w0[i] + u1[i] * w1[i] + u2[i] * w2[i]);
        uint4 ov; ov.x = pk_bf16(o[0], o[1]); ov.y = pk_bf16(o[2], o[3]); ov.z = pk_bf16(o[4], o[5]); ov.w = pk_bf16(o[6], o[7]);
        *(uint4*)(CV + (size_t)row * 512 + c0) = ov;
        const bf16_t* hm = Hm + (size_t)row * 672;
        float sq = 0.f, skv = 0.f;
        if (lane < 48) { float f[8]; unpack8(*(const uint4*)(hm + lane * 8), f);
#pragma unroll
            for (int i = 0; i < 8; ++i) sq += f[i] * f[i]; }
        if (lane < 32) { float f[8]; unpack8(*(const uint4*)(hm + 384 + lane * 8), f);
#pragma unroll
            for (int i = 0; i < 8; ++i) skv += f[i] * f[i]; }
        sq = wave_sum(sq); skv = wave_sum(skv);
        if (lane == 0) { RSQ[row] = rsqrtf(sq * (1.0f / 384.0f) + 1e-6f); RSKV[row] = rsqrtf(skv * (1.0f / 256.0f) + 1e-6f); }
        {
            const int j = lane & 31;
            float v = bf1(hm[640 + j]);
            const float other = __shfl_xor(v, 8);
            if (pp >= CTXL) {
                const int tt = pp - CTXL;
                const int pos = (j < 16) ? (tt >> 6) : (tt & 63);
                const float cs = rope[(pos * 8 + (j & 7)) * 2], sn = rope[(pos * 8 + (j & 7)) * 2 + 1];
                v = (j & 8) ? (other * sn + v * cs) : (v * cs - other * sn);
            }
            if (lane < 32) KR[(size_t)row * 32 + j] = (bf16_t)(pk_bf16(v, v) & 0xffffu);
        }
    }
}

__device__ __forceinline__ void p2b_phase(const Params& pin, int l, unsigned char* lds) {
    const Params p = launder(pin); l = launder_i(l); const int tid = ltid();
    const bf16_t* Hm = (const bf16_t*)(p.ws + OFF_R1);
    const bf16_t* W = (const bf16_t*)(p.ws + OFF_W);
    const float* RSQ = (const float*)(p.ws + OFF_RSQ);
    const float* RSKV = (const float*)(p.ws + OFF_RSKV);
    const float* rope = (const float*)(p.ws + OFF_ROPE);
    bf16_t* Q = (bf16_t*)(p.ws + OFF_Q);
    bf16_t* KN = (bf16_t*)(p.ws + OFF_KN);
    bf16_t* VT = (bf16_t*)(p.ws + OFF_VT);
    const int lane = tid & 63, wid = tid >> 6, wr = wid >> 1, wc = wid & 1, fr = lane & 15, fq = lane >> 4;
    const int NQ = 144 * 6, NKV = 144 * 8;
    for (int t = blockIdx.x; t < NQ + NKV; t += gridDim.x) {
        f32x4 acc[4][4]; zero_acc<4>(acc);
        if (t < NQ) {
            int mt, nt; tile_mn(t, 6, mt, nt);
            gemm_mainloop<4, 1>(acc, Hm + (size_t)mt * 256 * 672, 672, 64, W + WO_UQ + (size_t)nt * 128 * 384, 384, 6, lds, tid);
            const int pp0 = (mt % 9) * 256; const bool latent = pp0 >= CTXL;
#pragma unroll
            for (int m = 0; m < 4; ++m) {
                const int lrow = wr * 64 + m * 16 + fr;
                const size_t row = (size_t)mt * 256 + lrow;
                const float sc = RSQ[row] * QSCALE;
                const int tt = pp0 + lrow - CTXL;
                uint2 qpk[4];
#pragma unroll
                for (int n = 0; n < 4; ++n) {
                    const int c16 = nt * 128 + wc * 64 + n * 16, r96 = c16 % 96;
                    float v[4];
#pragma unroll
                    for (int j = 0; j < 4; ++j) v[j] = acc[m][n][j] * sc;
                    if (latent && r96 >= 64) {
                        const int pos = (r96 == 64) ? (tt >> 6) : (tt & 63);
#pragma unroll
                        for (int j = 0; j < 4; ++j) {
                            const float other = __shfl_xor(v[j], 32);
                            const int fi = (fq & 1) * 4 + j;
                            const float cs = rope[(pos * 8 + fi) * 2], sn = rope[(pos * 8 + fi) * 2 + 1];
                            v[j] = (fq & 2) ? (other * sn + v[j] * cs) : (v[j] * cs - other * sn);
                        }
                    }
                    qpk[n].x = pk_bf16(v[0], v[1]); qpk[n].y = pk_bf16(v[2], v[3]);
                }
#pragma unroll
                for (int n = 0; n < 4; n += 2)
                    *(uint4*)(Q + row * 768 + nt * 128 + wc * 64 + (n + (fq & 1)) * 16 + (fq >> 1) * 8) = widen16(qpk[n], qpk[n + 1]);
            }
        } else {
            int mt, nt; tile_mn(t - NQ, 8, mt, nt);
            gemm_mainloop<4, 2>(acc, Hm + (size_t)mt * 256 * 672 + 384, 672, 64, W + WO_UKV + (size_t)nt * 128 * 256, 256, 4, lds, tid);
            const int b = mt / 9, pp0 = (mt % 9) * 256;
            if (wc == 0) {
#pragma unroll
                for (int m = 0; m < 4; ++m) {
                    const size_t row = (size_t)mt * 256 + wr * 64 + m * 16 + fr;
                    const float sc = RSKV[row];
#pragma unroll
                    for (int n = 0; n < 4; n += 2) {
                        uint2 a, b2;
                        a.x = pk_bf16(acc[m][n][0] * sc, acc[m][n][1] * sc); a.y = pk_bf16(acc[m][n][2] * sc, acc[m][n][3] * sc);
                        b2.x = pk_bf16(acc[m][n + 1][0] * sc, acc[m][n + 1][1] * sc); b2.y = pk_bf16(acc[m][n + 1][2] * sc, acc[m][n + 1][3] * sc);
                        *(uint4*)(KN + row * 512 + nt * 64 + (n + (fq & 1)) * 16 + (fq >> 1) * 8) = widen16(a, b2);
                    }
                }
            } else {
#pragma unroll
                for (int m = 0; m < 4; ++m) {
                    const int lrow = wr * 64 + m * 16 + fq * 4;
                    const f32x4 sc = *(const f32x4*)(RSKV + (size_t)mt * 256 + lrow);
#pragma unroll
                    for (int n = 0; n < 4; n += 2) {
                        uint2 a, b2;
                        a.x = pk_bf16(acc[m][n][0] * sc[0], acc[m][n][1] * sc[1]); a.y = pk_bf16(acc[m][n][2] * sc[2], acc[m][n][3] * sc[3]);
                        b2.x = pk_bf16(acc[m][n + 1][0] * sc[0], acc[m][n + 1][1] * sc[1]); b2.y = pk_bf16(acc[m][n + 1][2] * sc[2], acc[m][n + 1][3] * sc[3]);
                        const int dv = (n + (fq & 1)) * 16 + fr;
                        *(uint4*)(VT + ((size_t)(b * 8 + nt) * 64 + dv) * TPB + pp0 + wr * 64 + m * 16 + (fq >> 1) * 8) = widen16(a, b2);
                    }
                }
            }
        }
    }
    {
        const bf16_t* Hr = (const bf16_t*)(p.ws + OFF_R3);
        bf16_t* SG = (bf16_t*)(p.ws + OFF_SG);
        const float* mu = p.rw_mu + (size_t)l * 1920 + 1792;
        for (int i = blockIdx.x * NTHREADS + tid; i < MROWS * 16; i += gridDim.x * NTHREADS) {
            const int row = i >> 4, c0 = (i & 15) * 8, pp = row % TPB;
            const bool hp = (pp != 0 && pp != CTXL), hn = (pp != CTXL - 1 && pp != TPB - 1);
            const bf16_t* hr = Hr + (size_t)row * 1920 + 1792 + c0;
            float cur[8], pv[8], nx[8];
            unpack8(*(const uint4*)hr, cur);
            if (hp) unpack8(*(const uint4*)(hr - 1920), pv); else {
#pragma unroll
                for (int k = 0; k < 8; ++k) pv[k] = 0.f; }
            if (hn) unpack8(*(const uint4*)(hr + 1920), nx); else {
#pragma unroll
                for (int k = 0; k < 8; ++k) nx[k] = 0.f; }
            float o[8];
#pragma unroll
            for (int k = 0; k < 8; ++k) o[k] = sigmoidf_(cur[k] + (0.5f * (pv[k] + nx[k]) - cur[k]) * mu[c0 + k]);
            uint4 ov; ov.x = pk_bf16(o[0], o[1]); ov.y = pk_bf16(o[2], o[3]); ov.z = pk_bf16(o[4], o[5]); ov.w = pk_bf16(o[6], o[7]);
            *(uint4*)(SG + (size_t)row * 128 + c0) = ov;
        }
    }
}

#define FMAC_BC(acc, coef, s, J) asm("v_fmac_f32_dpp %0, %1, %2 row_newbcast:" #J " row_mask:0xf bank_mask:0xf" : "+v"(acc) : "v"(coef), "v"(s))
#define MUL_BC(dst, coef, s, J) asm("v_mul_f32_dpp %0, %1, %2 row_newbcast:" #J " row_mask:0xf bank_mask:0xf" : "=v"(dst) : "v"(coef), "v"(s))
#define REP16(X) X(0, 0) X(1, 1) X(2, 2) X(3, 3) X(4, 0) X(5, 1) X(6, 2) X(7, 3) X(8, 0) X(9, 1) X(10, 2) X(11, 3) X(12, 0) X(13, 1) X(14, 2) X(15, 3)
constexpr int FSTR = 6 * 64 + 4;
constexpr int CHUNK = 32, NCHUNK = TPB / CHUNK;

__device__ __forceinline__ int scan_pos(int z, int s) { return z == 0 ? s : (s < CTXL ? (CTXL - 1 - s) : (TPB + CTXL - 1 - s)); }

__device__ __forceinline__ void shift4(const bf16_t* hr, bool hp, bool hn, int col, const float* mu, float (&o)[4]) {
    const uint2 c = *(const uint2*)(hr + col);
    uint2 a = make_uint2(0u, 0u), b = make_uint2(0u, 0u);
    if (hp) a = *(const uint2*)(hr - 1920 + col);
    if (hn) b = *(const uint2*)(hr + 1920 + col);
    const f32x4 m = *(const f32x4*)(mu + col);
    const float cv[4] = {bf_lo(c.x), bf_hi(c.x), bf_lo(c.y), bf_hi(c.y)};
    const float av[4] = {bf_lo(a.x), bf_hi(a.x), bf_lo(a.y), bf_hi(a.y)};
    const float bv[4] = {bf_lo(b.x), bf_hi(b.x), bf_lo(b.y), bf_hi(b.y)};
#pragma unroll
    for (int i = 0; i < 4; ++i) o[i] = cv[i] + (0.5f * (av[i] + bv[i]) - cv[i]) * m[i];
}
__device__ __forceinline__ void shift8(const bf16_t* hr, bool hp, bool hn, int col, const float* mu, float (&o)[8]) {
    float cv[8], av[8], bv[8];
    unpack8(*(const uint4*)(hr + col), cv);
    if (hp) unpack8(*(const uint4*)(hr - 1920 + col), av); else {
#pragma unroll
        for (int i = 0; i < 8; ++i) av[i] = 0.f; }
    if (hn) unpack8(*(const uint4*)(hr + 1920 + col), bv); else {
#pragma unroll
        for (int i = 0; i < 8; ++i) bv[i] = 0.f; }
#pragma unroll
    for (int i = 0; i < 8; ++i) o[i] = cv[i] + (0.5f * (av[i] + bv[i]) - cv[i]) * mu[col + i];
}
__device__ __forceinline__ bf16x8 pack8(const float (&f)[8]) {
    union { uint4 u; bf16x8 v; } r;
    r.u.x = pk_bf16(f[0], f[1]); r.u.y = pk_bf16(f[2], f[3]); r.u.z = pk_bf16(f[4], f[5]); r.u.w = pk_bf16(f[6], f[7]);
    return r.v;
}

struct ProdState { f32x4 aw[4], aa[4]; };
struct Raw3x2 { uint2 c, a, b; };
__device__ __forceinline__ Raw3x2 ld3x2(const bf16_t* pc, const bf16_t* pa, const bf16_t* pb, bool hp, bool hn, int col) {
    Raw3x2 r; r.c = *(const uint2*)(pc + col); r.a = *(const uint2*)(pa + col); r.b = *(const uint2*)(pb + col);
    if (!hp) r.a = make_uint2(0u, 0u);
    if (!hn) r.b = make_uint2(0u, 0u);
    return r;
}
__device__ __forceinline__ void sh4(const Raw3x2& r, const f32x4 m, float (&o)[4]) {
    const float cv[4] = {bf_lo(r.c.x), bf_hi(r.c.x), bf_lo(r.c.y), bf_hi(r.c.y)};
    const float av[4] = {bf_lo(r.a.x), bf_hi(r.a.x), bf_lo(r.a.y), bf_hi(r.a.y)};
    const float bv[4] = {bf_lo(r.b.x), bf_hi(r.b.x), bf_lo(r.b.y), bf_hi(r.b.y)};
#pragma unroll
    for (int i = 0; i < 4; ++i) o[i] = cv[i] + (0.5f * (av[i] + bv[i]) - cv[i]) * m[i];
}
struct Raw3x4 { uint4 c, a, b; };
__device__ __forceinline__ Raw3x4 ld3x4(const bf16_t* pc, const bf16_t* pa, const bf16_t* pb, bool hp, bool hn, int col) {
    Raw3x4 r; r.c = *(const uint4*)(pc + col); r.a = *(const uint4*)(pa + col); r.b = *(const uint4*)(pb + col);
    if (!hp) r.a = make_uint4(0u, 0u, 0u, 0u);
    if (!hn) r.b = make_uint4(0u, 0u, 0u, 0u);
    return r;
}
__device__ __forceinline__ void sh8(const Raw3x4& r, const float* m, float (&o)[8]) {
    float cv[8], av[8], bv[8];
    unpack8(r.c, cv); unpack8(r.a, av); unpack8(r.b, bv);
    const f32x4 m0 = *(const f32x4*)m, m1 = *(const f32x4*)(m + 4);
#pragma unroll
    for (int i = 0; i < 8; ++i) o[i] = cv[i] + (0.5f * (av[i] + bv[i]) - cv[i]) * (i < 4 ? m0[i] : m1[i - 4]);
}
template <int N0>
__device__ __forceinline__ void scan_produce_elem(const float* pl, int fq, const Raw3x2 (&rr)[2], const Raw3x2 (&rk)[2], const Raw3x2 (&rv)[2],
                                                  const f32x4 (&aw)[2], const f32x4 (&aa)[2], float& ss, float* frow) {
#pragma unroll
    for (int nn = 0; nn < 2; ++nn) {
        const int n = N0 + nn;
        const int c4 = n * 16 + fq * 4;
        float r4[4], k4[4], v4[4];
        sh4(rr[nn], *(const f32x4*)(pl + 0 * 64 + c4), r4);
        sh4(rk[nn], *(const f32x4*)(pl + 1 * 64 + c4), k4);
        sh4(rv[nn], *(const f32x4*)(pl + 2 * 64 + c4), v4);
        const f32x4 w0 = *(const f32x4*)(pl + 3 * 64 + c4);
        const f32x4 a0 = *(const f32x4*)(pl + 4 * 64 + c4);
        const f32x4 kkp = *(const f32x4*)(pl + 5 * 64 + c4);
        const f32x4 kap = *(const f32x4*)(pl + 6 * 64 + c4);
        f32x4 dw, kd, kf4, a4;
#pragma unroll
        for (int j = 0; j < 4; ++j) {
            const float x = -(aw[nn][j] + w0[j]);
            const float sp = fmaxf(x, 0.f) + __logf(1.0f + __expf(-fabsf(x)));
            const float wl = -sp - 0.5f;
            dw[j] = __expf(-__expf(wl));
            const float a = __builtin_amdgcn_rcpf(1.0f + __expf(-(aa[nn][j] + a0[j])));
            a4[j] = a;
            const float kf = k4[j] * kkp[j];
            kf4[j] = kf; ss += kf * kf;
            kd[j] = k4[j] * (1.0f + (a - 1.0f) * kap[j]);
        }
        *(f32x4*)(frow + 0 * 64 + c4) = kf4;
        *(f32x4*)(frow + 1 * 64 + c4) = dw;
        *(f32x4*)(frow + 2 * 64 + c4) = a4;
        *(f32x4*)(frow + 3 * 64 + c4) = kd;
        *(f32x4*)(frow + 4 * 64 + c4) = (f32x4){r4[0], r4[1], r4[2], r4[3]};
        *(f32x4*)(frow + 5 * 64 + c4) = (f32x4){v4[0], v4[1], v4[2], v4[3]};
    }
}
__device__ __forceinline__ void scan_produce_A(const Params& p, const float* pl, int b, int h, int z, int s0, float* frow0, int lane, ProdState& st) {
    const int fr = lane & 15, fq = lane >> 4;
    const int pp = scan_pos(z, s0 + fr);
    const bool hp = (pp != 0 && pp != CTXL), hn = (pp != CTXL - 1 && pp != TPB - 1);
    const bf16_t* hr = (const bf16_t*)(p.ws + OFF_R3) + ((size_t)b * TPB + pp) * 1920;
    const bf16_t* W = (const bf16_t*)(p.ws + OFF_W);
    Raw3x4 qw[2], qa[2];
    const bf16_t* pc = hr + z * 64 + fq * 8; const bf16_t* pa = hp ? pc - 1920 : pc; const bf16_t* pb = hn ? pc + 1920 : pc;
#pragma unroll
    for (int ks = 0; ks < 2; ++ks) { qw[ks] = ld3x4(pc, pa, pb, hp, hn, 1536 + ks * 32); qa[ks] = ld3x4(pc, pa, pb, hp, hn, 1664 + ks * 32); }
    f32x4 accw[4], acca[4];
#pragma unroll
    for (int n = 0; n < 4; ++n) { accw[n] = (f32x4){0.f, 0.f, 0.f, 0.f}; acca[n] = (f32x4){0.f, 0.f, 0.f, 0.f}; }
#pragma unroll
    for (int ks = 0; ks < 2; ++ks) {
        bf16x8 bw[4], ba[4];
#pragma unroll
        for (int n = 0; n < 4; ++n) {
            const size_t wo = ((size_t)z * 512 + h * 64 + n * 16 + fr) * 64 + ks * 32 + fq * 8;
            bw[n] = *(const bf16x8*)(W + WO_UP + wo); ba[n] = *(const bf16x8*)(W + WO_AUP + wo);
        }
        float t8[8];
        sh8(qw[ks], pl + 7 * 64 + ks * 32 + fq * 8, t8);
#pragma unroll
        for (int i = 0; i < 8; ++i) { const float e = __expf(2.0f * t8[i]); t8[i] = 1.0f - 2.0f * __builtin_amdgcn_rcpf(e + 1.0f); }
        const bf16x8 aw = pack8(t8);
        sh8(qa[ks], pl + 8 * 64 + ks * 32 + fq * 8, t8);
        const bf16x8 aa = pack8(t8);
#pragma unroll
        for (int n = 0; n < 4; ++n) {
            accw[n] = __builtin_amdgcn_mfma_f32_16x16x32_bf16(bw[n], aw, accw[n], 0, 0, 0);
            acca[n] = __builtin_amdgcn_mfma_f32_16x16x32_bf16(ba[n], aa, acca[n], 0, 0, 0);
        }
    }
#pragma unroll
    for (int n = 0; n < 4; ++n) { st.aw[n] = accw[n]; st.aa[n] = acca[n]; }
}
__device__ __forceinline__ void scan_produce_B(const Params& p, const float* pl, int b, int h, int z, int s0, float* frow0, int lane, const ProdState& st) {
    const int fr = lane & 15, fq = lane >> 4;
    const int pp = scan_pos(z, s0 + fr);
    const bool hp = (pp != 0 && pp != CTXL), hn = (pp != CTXL - 1 && pp != TPB - 1);
    const bf16_t* hr = (const bf16_t*)(p.ws + OFF_R3) + ((size_t)b * TPB + pp) * 1920;
    Raw3x2 rr0[2], rk0[2], rv0[2], rr1[2], rk1[2], rv1[2];
    const bf16_t* pc = hr + h * 64 + fq * 4; const bf16_t* pa = hp ? pc - 1920 : pc; const bf16_t* pb = hn ? pc + 1920 : pc;
#pragma unroll
    for (int nn = 0; nn < 2; ++nn) {
        const int C4 = nn * 16, C5 = C4 + 32;
        rr0[nn] = ld3x2(pc, pa, pb, hp, hn, C4); rk0[nn] = ld3x2(pc, pa, pb, hp, hn, 512 + C4); rv0[nn] = ld3x2(pc, pa, pb, hp, hn, 1024 + C4);
        rr1[nn] = ld3x2(pc, pa, pb, hp, hn, C5); rk1[nn] = ld3x2(pc, pa, pb, hp, hn, 512 + C5); rv1[nn] = ld3x2(pc, pa, pb, hp, hn, 1024 + C5);
    }
    float ss = 0.f;
    float* frow = frow0 + fr * FSTR;
    const f32x4 w01[2] = {st.aw[0], st.aw[1]}, a01[2] = {st.aa[0], st.aa[1]}, w23[2] = {st.aw[2], st.aw[3]}, a23[2] = {st.aa[2], st.aa[3]};
    scan_produce_elem<0>(pl, fq, rr0, rk0, rv0, w01, a01, ss, frow);
    scan_produce_elem<2>(pl, fq, rr1, rk1, rv1, w23, a23, ss, frow);
    ss = fqsum(ss);
    const float inv = rsqrtf(fmaxf(ss, 1e-24f));
#pragma unroll
    for (int n = 0; n < 4; ++n) {
        const int c4 = n * 16 + fq * 4;
        f32x4 kk = *(const f32x4*)(frow + 0 * 64 + c4);
        f32x4 bb = *(const f32x4*)(frow + 2 * 64 + c4);
#pragma unroll
        for (int j = 0; j < 4; ++j) { kk[j] = kk[j] * inv; bb[j] = kk[j] * bb[j]; }
        *(f32x4*)(frow + 0 * 64 + c4) = kk;
        *(f32x4*)(frow + 2 * 64 + c4) = bb;
    }
}

typedef float f32x2 __attribute__((ext_vector_type(2)));
struct ScanHead { f32x4 kk[2]; f32x2 v; };
struct ScanBody { f32x4 w[2], bb[2], kd[2], r[2]; };
__device__ __forceinline__ void scan_ldh(ScanHead& c, const float* f, const float* fv) {
#pragma unroll
    for (int q = 0; q < 2; ++q) c.kk[q] = *(const f32x4*)(f + 0 * 64 + 4 * q);
    c.v = *(const f32x2*)fv;
}
__device__ __forceinline__ void scan_ldb(ScanBody& c, const float* f) {
#pragma unroll
    for (int q = 0; q < 2; ++q) {
        c.w[q] = *(const f32x4*)(f + 1 * 64 + 4 * q); c.bb[q] = *(const f32x4*)(f + 2 * 64 + 4 * q);
        c.kd[q] = *(const f32x4*)(f + 3 * 64 + 4 * q); c.r[q] = *(const f32x4*)(f + 4 * 64 + 4 * q);
    }
}
__device__ __forceinline__ void scan_unit(const Params& p, int l, int u, unsigned char* lds) {
    const int tid = ltid(), wid = __builtin_amdgcn_readfirstlane(tid >> 6), lane = tid & 63;
    const int b = u >> 4, h = (u >> 1) & 7, z = u & 1;
    float* fb = (float*)lds;
    bf16_t* Y = (bf16_t*)(p.ws + (z == 0 ? OFF_YF : OFF_YB));
    float* pl = fb + 3 * CHUNK * FSTR;
    for (int i = tid; i < 9 * 64; i += NTHREADS) {
        const int a = i >> 6, c = i & 63, C = h * 64 + c;
        float v;
        if (a < 3) v = p.rw_mu[(size_t)l * 1920 + a * 512 + C];
        else if (a == 3) v = p.rw_w0[((size_t)l * 2 + z) * 512 + C];
        else if (a == 4) v = p.rw_a0[((size_t)l * 2 + z) * 512 + C];
        else if (a == 5) v = p.rw_k_k[(size_t)l * 512 + C];
        else if (a == 6) v = p.rw_k_a[(size_t)l * 512 + C];
        else if (a == 7) v = p.rw_mu[(size_t)l * 1920 + 1536 + z * 64 + c];
        else v = p.rw_mu[(size_t)l * 1920 + 1664 + z * 64 + c];
        pl[i] = v;
    }
    __syncthreads();
    if (wid < 4) {
        f32x2 S2[8];
#pragma unroll
        for (int j = 0; j < 8; ++j) S2[j] = (f32x2){0.f, 0.f};
        __syncthreads();
        for (int c = 0; c < NCHUNK; ++c) {
            const float* fbc = fb + (c % 3) * CHUNK * FSTR + 8 * (lane & 7);
            const float* fbv = fb + (c % 3) * CHUNK * FSTR + 320 + 16 * wid + 2 * (lane >> 3);
            bf16_t* yp = Y + ((size_t)b * TPB) * 512 + h * 64 + 16 * wid + 2 * (lane >> 3);
            ScanHead ha, hb;
            scan_ldh(ha, fbc, fbv);
#define SCAN_STEP(HC, HN, SL) { \
                ScanBody bd; scan_ldb(bd, fbc + (SL) * FSTR); \
                if ((SL) + 1 < CHUNK) scan_ldh(HN, fbc + ((SL) + 1) * FSTR, fbv + ((SL) + 1) * FSTR); \
                f32x2 d0 = (f32x2){0.f, 0.f}, d1 = (f32x2){0.f, 0.f}; \
                _Pragma("unroll") for (int q = 0; q < 4; ++q) { const f32x2 k2 = (f32x2){HC.kk[q >> 1][2 * (q & 1)], HC.kk[q >> 1][2 * (q & 1) + 1]}; \
                    d0 = __builtin_elementwise_fma(S2[q], k2, d0); d1 = __builtin_elementwise_fma(S2[4 + q], k2, d1); } \
                const float sk0 = red8(d0[0] + d0[1]), sk1 = red8(d1[0] + d1[1]); \
                const f32x2 n0 = (f32x2){-sk0, -sk0}, n1 = (f32x2){-sk1, -sk1}, v0 = (f32x2){HC.v[0], HC.v[0]}, v1 = (f32x2){HC.v[1], HC.v[1]}; \
                f32x2 y0 = (f32x2){0.f, 0.f}, y1 = (f32x2){0.f, 0.f}; \
                _Pragma("unroll") for (int q = 0; q < 4; ++q) { \
                    const f32x2 w2 = (f32x2){bd.w[q >> 1][2 * (q & 1)], bd.w[q >> 1][2 * (q & 1) + 1]}, b2 = (f32x2){bd.bb[q >> 1][2 * (q & 1)], bd.bb[q >> 1][2 * (q & 1) + 1]}; \
                    const f32x2 kd2 = (f32x2){bd.kd[q >> 1][2 * (q & 1)], bd.kd[q >> 1][2 * (q & 1) + 1]}, r2 = (f32x2){bd.r[q >> 1][2 * (q & 1)], bd.r[q >> 1][2 * (q & 1) + 1]}; \
                    f32x2 t0 = S2[q] * w2; t0 = __builtin_elementwise_fma(b2, n0, t0); t0 = __builtin_elementwise_fma(kd2, v0, t0); \
                    f32x2 t1 = S2[4 + q] * w2; t1 = __builtin_elementwise_fma(b2, n1, t1); t1 = __builtin_elementwise_fma(kd2, v1, t1); \
                    S2[q] = t0; S2[4 + q] = t1; \
                    y0 = __builtin_elementwise_fma(t0, r2, y0); y1 = __builtin_elementwise_fma(t1, r2, y1); } \
                const float ya = red8(y0[0] + y0[1]), yb = red8(y1[0] + y1[1]); \
                const int pp = scan_pos(z, c * CHUNK + (SL)); \
                if ((lane & 7) == 0) *(unsigned*)(yp + (size_t)pp * 512) = pk_bf16(ya, yb); }
#pragma unroll 1
            for (int sl = 0; sl < CHUNK; sl += 2) {
                SCAN_STEP(ha, hb, sl)
                SCAN_STEP(hb, ha, sl + 1)
            }
            __syncthreads();
        }
    } else {
        ProdState st;
#pragma unroll
        for (int n = 0; n < 4; ++n) { st.aw[n] = (f32x4){0.f, 0.f, 0.f, 0.f}; st.aa[n] = (f32x4){0.f, 0.f, 0.f, 0.f}; }
        const int nrep = launder_i(1 + ((PROBE_MASK >> 10) & 1));
        const int pair = (wid - 4) >> 1, ph = (wid - 4) & 1;
        {
            float* f0 = fb + (pair % 3) * CHUNK * FSTR + ph * 16 * FSTR;
            scan_produce_A(p, pl, b, h, z, pair * CHUNK + ph * 16, f0, lane, st);
            if (pair == 0) scan_produce_B(p, pl, b, h, z, ph * 16, f0, lane, st);
        }
        __syncthreads();
        for (int c = 0; c < NCHUNK; ++c) {
            for (int rr_ = 0; rr_ < nrep; ++rr_) {
            if (pair == ((c + 1) & 1)) {
                if (c + 1 < NCHUNK) scan_produce_B(p, pl, b, h, z, (c + 1) * CHUNK + ph * 16, fb + ((c + 1) % 3) * CHUNK * FSTR + ph * 16 * FSTR, lane, st);
            } else {
                if (c + 2 < NCHUNK) scan_produce_A(p, pl, b, h, z, (c + 2) * CHUNK + ph * 16, fb + ((c + 2) % 3) * CHUNK * FSTR + ph * 16 * FSTR, lane, st);
            }
            }
            __syncthreads();
        }
    }
}

constexpr int ATT_STAGE = 20480;
__device__ __forceinline__ void attn_unit(const Params& p, int b, int h, int q0, int nkeys, unsigned char* lds, int do_write) {
    const int tid = ltid(), wid = __builtin_amdgcn_readfirstlane(tid >> 6), lane = tid & 63, fr = lane & 15, fq = lane >> 4;
    bf16_t* Q = (bf16_t*)(p.ws + OFF_Q);
    const bf16_t* KN = (const bf16_t*)(p.ws + OFF_KN);
    const bf16_t* KR = (const bf16_t*)(p.ws + OFF_KR);
    const bf16_t* VT = (const bf16_t*)(p.ws + OFF_VT);
    const size_t rb = (size_t)b * TPB;
    bf16x8 qf[2][3];
#pragma unroll
    for (int nq = 0; nq < 2; ++nq)
#pragma unroll
        for (int ks = 0; ks < 3; ++ks) qf[nq][ks] = *(const bf16x8*)(Q + (rb + q0 + wid * 32 + nq * 16 + fr) * 768 + h * 96 + ks * 32 + fq * 8);
    f32x4 oacc[4][2];
#pragma unroll
    for (int mt = 0; mt < 4; ++mt)
#pragma unroll
        for (int nq = 0; nq < 2; ++nq) oacc[mt][nq] = (f32x4){0.f, 0.f, 0.f, 0.f};
    float mrun[2] = {0.f, 0.f}, lsum[2] = {0.f, 0.f};
    const int c8 = (lane & 7) ^ ((4 * wid + (lane >> 4)) & 7);
    const bf16_t* knp = KN + (rb + 8 * wid + (lane >> 3)) * 512 + h * 64 + c8 * 8;
    const bf16_t* vtp = VT + ((size_t)(b * 8 + h) * 64 + 8 * wid + (lane >> 3)) * TPB + c8 * 8;
    const int c4 = (lane & 3) ^ ((lane >> 4) & 3);
    const bf16_t* krp = KR + (rb + 16 * (wid & 3) + (lane >> 2)) * 32 + c4 * 8;
    auto issue = [&](int t, int stg) {
        unsigned char* base = lds + stg * ATT_STAGE;
        const int k0 = t * 64;
        __builtin_amdgcn_global_load_lds((const GLB_AS unsigned*)(knp + (size_t)k0 * 512), (LDS_AS unsigned*)(base + wid * 1024), 16, 0, 0);
        __builtin_amdgcn_global_load_lds((const GLB_AS unsigned*)(vtp + k0), (LDS_AS unsigned*)(base + 12288 + wid * 1024), 16, 0, 0);
        if (wid < 4) __builtin_amdgcn_global_load_lds((const GLB_AS unsigned*)(krp + (size_t)k0 * 32), (LDS_AS unsigned*)(base + 8192 + wid * 1024), 16, 0, 0);
    };
    const int ntile = nkeys / 64;
    const int kz = fr >> 1, rz = (fr >> 2) & 3;
    issue(0, 0);
    asm volatile("s_waitcnt vmcnt(0)" ::: "memory");
    __builtin_amdgcn_s_barrier();
    asm volatile("" ::: "memory");
    for (int t = 0; t < ntile; ++t) {
        if (t + 1 < ntile) issue(t + 1, (t + 1) & 1);
        const unsigned char* Ks = lds + (t & 1) * ATT_STAGE;
        const unsigned char* Rs = Ks + 8192;
        const unsigned char* Vs = Ks + 12288;
        f32x4 sacc[4][2];
#pragma unroll
        for (int km = 0; km < 4; ++km)
#pragma unroll
            for (int nq = 0; nq < 2; ++nq) sacc[km][nq] = (f32x4){-mrun[nq], -mrun[nq], -mrun[nq], -mrun[nq]};
#pragma unroll
        for (int ks = 0; ks < 3; ++ks)
#pragma unroll
            for (int km = 0; km < 4; ++km) {
                const bf16x8 kf = ks < 2 ? *(const bf16x8*)(Ks + (km * 16 + fr) * 128 + (((ks * 4 + fq) ^ kz) * 16))
                                         : *(const bf16x8*)(Rs + (km * 16 + fr) * 64 + ((fq ^ rz) * 16));
#pragma unroll
                for (int nq = 0; nq < 2; ++nq) sacc[km][nq] = __builtin_amdgcn_mfma_f32_16x16x32_bf16(kf, qf[nq][ks], sacc[km][nq], 0, 0, 0);
            }
        float delta[2];
#pragma unroll
        for (int nq = 0; nq < 2; ++nq) {
            float mx = -1e30f;
#pragma unroll
            for (int km = 0; km < 4; ++km)
#pragma unroll
                for (int j = 0; j < 4; ++j) mx = fmaxf(mx, sacc[km][nq][j]);
            mx = fqmax(mx);
            delta[nq] = (t == 0) ? mx : fmaxf(mx, 0.f);
        }
        const bool exact = (t == 0) || (__builtin_amdgcn_ballot_w64(fmaxf(delta[0], delta[1]) > 60.0f) != 0ull);
        bf16x8 pf[2][2];
        float psum[2];
#pragma unroll
        for (int nq = 0; nq < 2; ++nq) {
            float ps = 0.f;
            if (exact) {
#pragma unroll
                for (int km = 0; km < 4; ++km)
#pragma unroll
                    for (int j = 0; j < 4; ++j) { const float e = __builtin_amdgcn_exp2f(sacc[km][nq][j] - delta[nq]); sacc[km][nq][j] = e; ps += e; }
            } else {
#pragma unroll
                for (int km = 0; km < 4; ++km)
#pragma unroll
                    for (int j = 0; j < 4; ++j) { const float e = __builtin_amdgcn_exp2f(sacc[km][nq][j]); sacc[km][nq][j] = e; ps += e; }
            }
            psum[nq] = ps;
#pragma unroll
            for (int kc = 0; kc < 2; ++kc) {
                union { uint4 u; bf16x8 v; } r;
                r.u.x = pk_bf16(sacc[2 * kc][nq][0], sacc[2 * kc][nq][1]); r.u.y = pk_bf16(sacc[2 * kc][nq][2], sacc[2 * kc][nq][3]);
                r.u.z = pk_bf16(sacc[2 * kc + 1][nq][0], sacc[2 * kc + 1][nq][1]); r.u.w = pk_bf16(sacc[2 * kc + 1][nq][2], sacc[2 * kc + 1][nq][3]);
                pf[kc][nq] = r.v;
            }
        }
        if (exact) {
#pragma unroll
            for (int nq = 0; nq < 2; ++nq) {
                const float alpha = (t == 0) ? 1.0f : __builtin_amdgcn_exp2f(-delta[nq]);
                lsum[nq] = lsum[nq] * alpha + psum[nq];
#pragma unroll
                for (int mt = 0; mt < 4; ++mt) oacc[mt][nq] = oacc[mt][nq] * alpha;
            }
        }
#pragma unroll
        for (int mt = 0; mt < 4; ++mt)
#pragma unroll
            for (int kc = 0; kc < 2; ++kc) {
                union { uint2 h2[2]; bf16x8 v; } r;
                const unsigned char* vrow = Vs + (mt * 16 + fr) * 128 + (fq & 1) * 8;
                r.h2[0] = *(const uint2*)(vrow + (((4 * kc + (fq >> 1)) ^ kz) * 16));
                r.h2[1] = *(const uint2*)(vrow + (((4 * kc + 2 + (fq >> 1)) ^ kz) * 16));
#pragma unroll
                for (int nq = 0; nq < 2; ++nq) oacc[mt][nq] = __builtin_amdgcn_mfma_f32_16x16x32_bf16(r.v, pf[kc][nq], oacc[mt][nq], 0, 0, 0);
            }
        if (!exact) {
#pragma unroll
            for (int nq = 0; nq < 2; ++nq) {
                const float alpha = __builtin_amdgcn_exp2f(-delta[nq]);
                lsum[nq] = (lsum[nq] + psum[nq]) * alpha;
#pragma unroll
                for (int mt = 0; mt < 4; ++mt) oacc[mt][nq] = oacc[mt][nq] * alpha;
            }
        }
#pragma unroll
        for (int nq = 0; nq < 2; ++nq) mrun[nq] += delta[nq];
        asm volatile("s_waitcnt vmcnt(0) lgkmcnt(0)" ::: "memory");
        __builtin_amdgcn_s_barrier();
        asm volatile("" ::: "memory");
    }
#pragma unroll
    for (int nq = 0; nq < 2; ++nq) {
        const float inv = 1.0f / fqsum(lsum[nq]);
        bf16_t* orow = Q + (rb + q0 + wid * 32 + nq * 16 + fr) * 768 + h * 96;
#pragma unroll
        for (int mt = 0; mt < 4; mt += 2) {
            uint2 a, b2;
            a.x = pk_bf16(oacc[mt][nq][0] * inv, oacc[mt][nq][1] * inv); a.y = pk_bf16(oacc[mt][nq][2] * inv, oacc[mt][nq][3] * inv);
            b2.x = pk_bf16(oacc[mt + 1][nq][0] * inv, oacc[mt + 1][nq][1] * inv); b2.y = pk_bf16(oacc[mt + 1][nq][2] * inv, oacc[mt + 1][nq][3] * inv);
            const uint4 w = widen16(a, b2);
            if (do_write) *(uint4*)(orow + (mt + (fq & 1)) * 16 + (fq >> 1) * 8) = w;
        }
    }
}

__device__ __forceinline__ void p3_phase(const Params& pin, int l, unsigned char* lds) {
    const Params p = launder(pin); l = launder_i(l);
    for (int r = 0, nr = launder_i(1 + ((PROBE_MASK >> 1) & 1)); r < nr; ++r)
        for (int u = blockIdx.x; u < 256; u += gridDim.x) scan_unit(p, l, u, lds);
    const int nunits = (l == DEPTH - 1) ? 1024 : 1152;
    for (int r = launder_i(((PROBE_MASK >> 9) & 1) ? 0 : 1); r < 2; ++r)
    for (int u = blockIdx.x; u < nunits; u += gridDim.x) {
        if (u < 1024) { const int bh = u >> 3, qt = u & 7; attn_unit(p, bh >> 3, bh & 7, CTXL + qt * 256, TPB, lds, r); }
        else { const int bh = u - 1024; attn_unit(p, bh >> 3, bh & 7, 0, CTXL, lds, r); }
    }
}

__device__ __forceinline__ void p35_phase(const Params& pin, int l, bool skip_ctx, unsigned char* lds) {
    const Params p = launder(pin); l = launder_i(l); const int tid = ltid();
    const bf16_t* SG = (const bf16_t*)(p.ws + OFF_SG);
    const bf16_t* W = (const bf16_t*)(p.ws + OFF_W) + WO_GUP;
    const bf16_t* YF = (const bf16_t*)(p.ws + OFF_YF);
    const bf16_t* YB = (const bf16_t*)(p.ws + OFF_YB);
    const bf16_t* Hr = (const bf16_t*)(p.ws + OFF_R3);
    bf16_t* RWO = (bf16_t*)(p.ws + OFF_RWO);
    const float* mu = p.rw_mu + (size_t)l * 1920;
    const int lane = tid & 63, wid = tid >> 6, wr = wid >> 1, wc = wid & 1, fr = lane & 15, fq = lane >> 4;
    float* gt = (float*)lds;
    constexpr int GP = 132;
    for (int t = blockIdx.x; t < 288 * 4; t += gridDim.x) {
        int mt, nt; tile_mn(t, 4, mt, nt);
        if (skip_ctx && (mt % 18) < 2) continue;
        f32x4 acc[2][4]; zero_acc<2>(acc);
        gemm_mainloop<2, 1>(acc, SG + (size_t)mt * 128 * 128, 128, 64, W + (size_t)nt * 128 * 128, 128, 2, lds, tid);
#pragma unroll
        for (int m = 0; m < 2; ++m)
#pragma unroll
            for (int n = 0; n < 4; ++n) *(f32x4*)(gt + (wr * 32 + m * 16 + fr) * GP + wc * 64 + n * 16 + fq * 4) = acc[m][n];
        __syncthreads();
        const int pp0 = (mt % 18) * 128;
#pragma unroll 1
        for (int it = 0; it < 4; ++it) {
            const int item = tid + it * NTHREADS, lrow = item >> 4, cg = item & 15, pp = pp0 + lrow;
            const size_t row = (size_t)mt * 128 + lrow;
            const int C = nt * 128 + cg * 8;
            const bool hp = (pp != 0 && pp != CTXL), hn = (pp != CTXL - 1 && pp != TPB - 1);
            const bf16_t* hr = Hr + row * 1920;
            float yf[8], yb[8], r8[8], k8[8], v8[8];
            unpack8(*(const uint4*)(YF + row * 512 + C), yf); unpack8(*(const uint4*)(YB + row * 512 + C), yb);
            shift8(hr, hp, hn, C, mu, r8); shift8(hr, hp, hn, 512 + C, mu, k8); shift8(hr, hp, hn, 1024 + C, mu, v8);
            const float* rkp = p.rw_r_k + (size_t)l * 512 + C;
            float s1 = 0.f, bs = 0.f;
#pragma unroll
            for (int i = 0; i < 8; ++i) { yf[i] += yb[i]; s1 += yf[i]; bs += r8[i] * k8[i] * rkp[i]; }
            s1 = red8(s1); bs = red8(bs);
            const float mean = s1 * (1.0f / 64.0f);
            float s2 = 0.f;
#pragma unroll
            for (int i = 0; i < 8; ++i) { const float d = yf[i] - mean; s2 += d * d; }
            s2 = red8(s2);
            const float rstd = rsqrtf(s2 * (1.0f / 64.0f) + 64e-5f);
            const float* ggp = p.rw_gn_g + (size_t)l * 512 + C; const float* gbp = p.rw_gn_b + (size_t)l * 512 + C;
            const f32x4 g0 = *(const f32x4*)(gt + lrow * GP + cg * 8), g1 = *(const f32x4*)(gt + lrow * GP + cg * 8 + 4);
            float o[8];
#pragma unroll
            for (int i = 0; i < 8; ++i) o[i] = ((yf[i] - mean) * rstd * ggp[i] + gbp[i] + bs * v8[i]) * (i < 4 ? g0[i] : g1[i - 4]);
            uint4 ov; ov.x = pk_bf16(o[0], o[1]); ov.y = pk_bf16(o[2], o[3]); ov.z = pk_bf16(o[4], o[5]); ov.w = pk_bf16(o[6], o[7]);
            *(uint4*)(RWO + row * 512 + C) = ov;
        }
        __syncthreads();
    }
}

__device__ __forceinline__ void p4_phase(const Params& pin, bool skip_ctx, unsigned char* lds) {
    const Params p = launder(pin); const int tid = ltid();
    const bf16_t* XM = (const bf16_t*)(p.ws + OFF_R6);
    const bf16_t* W = (const bf16_t*)(p.ws + OFF_W);
    bf16_t* MG = (bf16_t*)(p.ws + OFF_MRG);
    const int lane = tid & 63, wid = tid >> 6, wr = wid >> 1, wc = wid & 1, fr = lane & 15, fq = lane >> 4;
    for (int t = blockIdx.x; t < 288 * 8; t += gridDim.x) {
        int mt, nt; tile_mn(t, 8, mt, nt);
        if (skip_ctx && (mt % 18) < 2) continue;
        f32x4 g[3][2][4];
#pragma unroll
        for (int i = 0; i < 3; ++i) zero_acc<2>(g[i]);
        gemm_gate3(g, XM + (size_t)mt * 128 * 1024, W + WO_IN + (size_t)(4224 + nt * 128) * 1024, 16, lds, tid);
        typedef __fp16 h16x2 __attribute__((ext_vector_type(2)));
        h16x2 gp[3][2][4][2];
#pragma unroll
        for (int i = 0; i < 3; ++i)
#pragma unroll
            for (int m = 0; m < 2; ++m)
#pragma unroll
                for (int n = 0; n < 4; ++n) {
                    gp[i][m][n][0] = __builtin_amdgcn_cvt_pkrtz(sigmoidf_(g[i][m][n][0]), sigmoidf_(g[i][m][n][1]));
                    gp[i][m][n][1] = __builtin_amdgcn_cvt_pkrtz(sigmoidf_(g[i][m][n][2]), sigmoidf_(g[i][m][n][3]));
                }
        f32x4 mg[2][4]; zero_acc<2>(mg);
#pragma unroll 1
        for (int i = 0; i < 3; ++i) {
            const bf16_t* Ab; int lda, kst; const bf16_t* Wb;
            if (i == 0) { Ab = (const bf16_t*)(p.ws + OFF_Q); lda = 768; kst = 96; Wb = W + WO_OA; }
            else if (i == 1) { Ab = (const bf16_t*)(p.ws + OFF_R5); lda = 512; kst = 64; Wb = W + WO_OC; }
            else { Ab = (const bf16_t*)(p.ws + OFF_RWO); lda = 512; kst = 64; Wb = W + WO_OR; }
            f32x4 a[2][4]; zero_acc<2>(a);
            gemm_mainloop<2, 1>(a, Ab + (size_t)mt * 128 * lda, lda, kst, Wb + (size_t)nt * 128 * 512, 512, 8, lds, tid);
#pragma unroll
            for (int m = 0; m < 2; ++m)
#pragma unroll
                for (int n = 0; n < 4; ++n) {
                    const h16x2 g0 = i == 0 ? gp[0][m][n][0] : (i == 1 ? gp[1][m][n][0] : gp[2][m][n][0]);
                    const h16x2 g1 = i == 0 ? gp[0][m][n][1] : (i == 1 ? gp[1][m][n][1] : gp[2][m][n][1]);
                    mg[m][n][0] += (float)g0[0] * a[m][n][0]; mg[m][n][1] += (float)g0[1] * a[m][n][1];
                    mg[m][n][2] += (float)g1[0] * a[m][n][2]; mg[m][n][3] += (float)g1[1] * a[m][n][3];
                }
        }
#pragma unroll
        for (int m = 0; m < 2; ++m) {
            const size_t row = (size_t)mt * 128 + wr * 32 + m * 16 + fr;
#pragma unroll
            for (int n = 0; n < 4; n += 2) {
                uint2 a, b2;
                a.x = pk_bf16(mg[m][n][0], mg[m][n][1]); a.y = pk_bf16(mg[m][n][2], mg[m][n][3]);
                b2.x = pk_bf16(mg[m][n + 1][0], mg[m][n + 1][1]); b2.y = pk_bf16(mg[m][n + 1][2], mg[m][n + 1][3]);
                *(uint4*)(MG + row * 1024 + nt * 128 + wc * 64 + (n + (fq & 1)) * 16 + (fq >> 1) * 8) = widen16(a, b2);
            }
        }
    }
}

template <int MT>
__device__ __forceinline__ void resid_tile(const Params& p, int l, const bf16_t* A, int lda, int nk, const bf16_t* Wt, int ldb, int goff, bool x_from_input,
                                           const float* lng, const float* lnb, int row0, int nt, unsigned char* lds, int tid) {
    const int lane = tid & 63, wid = tid >> 6, wr = wid >> 1, wc = wid & 1, fr = lane & 15, fq = lane >> 4;
    f32x4 acc[MT][4]; zero_acc<MT>(acc);
    gemm_mainloop<MT, 1>(acc, A + (size_t)row0 * lda, lda, 64, Wt + (size_t)nt * 128 * ldb, ldb, nk, lds, tid);
    const int b = row0 / TPB, pp0 = row0 % TPB;
    const float* gv = modv_ptr(p, l, b, pp0) + goff;
    const float* stats = (const float*)(p.ws + OFF_STATS);
#pragma unroll
    for (int m = 0; m < MT; ++m) {
        const int lr = wr * 16 * MT + m * 16 + fr, pp = pp0 + lr;
        const float* xi = x_rd(p, x_from_input, b, pp);
        float* xo = x_wr(p, b, pp);
        float mean = 0.f, rstd = 1.f;
        if (!x_from_input) { const size_t row = (size_t)row0 + lr; mean = stats[row * 2]; rstd = stats[row * 2 + 1]; }
#pragma unroll
        for (int n = 0; n < 4; ++n) {
            const int col = nt * 128 + wc * 64 + n * 16 + fq * 4;
            f32x4 xv = *(const f32x4*)(xi + col); const f32x4 g4 = *(const f32x4*)(gv + col);
            if (!x_from_input) {
                const f32x4 lg = *(const f32x4*)(lng + col), lb = *(const f32x4*)(lnb + col);
#pragma unroll
                for (int j = 0; j < 4; ++j) xv[j] = (xv[j] - mean) * rstd * lg[j] + lb[j];
            }
            f32x4 o;
#pragma unroll
            for (int j = 0; j < 4; ++j) o[j] = ALPHA * xv[j] + g4[j] * acc[m][n][j];
            *(f32x4*)(xo + col) = o;
        }
    }
}
__device__ __forceinline__ void resid_tile256(const Params& p, int l, const bf16_t* A, int lda, int nk, const bf16_t* Wt, int ldb, int goff, bool x_from_input,
                                              const float* lng, const float* lnb, int row0, int nt256, unsigned char* lds, int tid) {
    const int lane = tid & 63, wid = tid >> 6, wr = wid >> 2, wc = wid & 3, fr = lane & 15, fq = lane >> 4;
    f32x4 acc[8][4]; zero_acc<8>(acc);
    Seg sg; sg.A = A + (size_t)row0 * lda; sg.Bt = Wt + (size_t)nt256 * 256 * ldb; sg.lda = lda; sg.a_kstep = 64; sg.ldb = ldb; sg.nk = nk;
    int st = 0;
    gemm_stream256(acc, sg, sg, false, true, st, lds, tid);
    const int b = row0 / TPB, pp0 = row0 % TPB;
    const float* gv = modv_ptr(p, l, b, pp0) + goff;
    const float* stats = (const float*)(p.ws + OFF_STATS);
#pragma unroll
    for (int m = 0; m < 8; ++m) {
        const int lr = wr * 128 + m * 16 + fr, pp = pp0 + lr;
        const float* xi = x_rd(p, x_from_input, b, pp);
        float* xo = x_wr(p, b, pp);
        float mean = 0.f, rstd = 1.f;
        if (!x_from_input) { const size_t row = (size_t)row0 + lr; mean = stats[row * 2]; rstd = stats[row * 2 + 1]; }
#pragma unroll
        for (int n = 0; n < 4; ++n) {
            const int col = nt256 * 256 + wc * 64 + n * 16 + fq * 4;
            f32x4 xv = *(const f32x4*)(xi + col); const f32x4 g4 = *(const f32x4*)(gv + col);
            if (!x_from_input) {
                const f32x4 lg = *(const f32x4*)(lng + col), lb = *(const f32x4*)(lnb + col);
#pragma unroll
                for (int j = 0; j < 4; ++j) xv[j] = (xv[j] - mean) * rstd * lg[j] + lb[j];
            }
            f32x4 o;
#pragma unroll
            for (int j = 0; j < 4; ++j) o[j] = ALPHA * xv[j] + g4[j] * acc[m][n][j];
            *(f32x4*)(xo + col) = o;
        }
    }
}
__device__ __forceinline__ void resid_gemm_phase(const Params& pin, int l, size_t a_off, int lda, int nk, size_t w_off, int ldb, int goff, bool x_from_input, const float* lng, const float* lnb, bool skip_ctx, unsigned char* lds) {
    const Params p = launder(pin); l = launder_i(l);
    const int tid = ltid();
    const bf16_t* A = (const bf16_t*)(p.ws + a_off);
    const bf16_t* Wt = (const bf16_t*)(p.ws + OFF_W) + w_off;
    if (gridDim.x == 256) {
        for (int t = blockIdx.x; t < 512; t += 256) {
            int mt, nt; tile_mn(t, 4, mt, nt);
            if (skip_ctx && (mt % 9) == 0) continue;
            resid_tile256(p, l, A, lda, nk, Wt, ldb, goff, x_from_input, lng, lnb, mt * 256, nt, lds, tid);
        }
        int mt, nt; tile_mn(512 + (blockIdx.x >> 2), 4, mt, nt);
        const int q = blockIdx.x & 3;
        if (!(skip_ctx && (mt % 9) == 0)) resid_tile<2>(p, l, A, lda, nk, Wt, ldb, goff, x_from_input, lng, lnb, mt * 256 + (q >> 1) * 128, nt * 2 + (q & 1), lds, tid);
    } else {
        for (int t = blockIdx.x; t < 144 * 8; t += gridDim.x) {
            int mt, nt; tile_mn(t, 8, mt, nt);
            if (skip_ctx && (mt % 9) == 0) continue;
            resid_tile<4>(p, l, A, lda, nk, Wt, ldb, goff, x_from_input, lng, lnb, mt * 256, nt, lds, tid);
        }
    }
}

__device__ __forceinline__ void ln_phase(const Params& pin, const float* g, const float* bta, int lmod, int shoff, bool write_xmod, bool write_x, bool skip_ctx) {
    const Params p = launder(pin); lmod = launder_i(lmod);
    const int tid = ltid(), wid = tid >> 6, lane = tid & 63;
    bf16_t* xm = (bf16_t*)(p.ws + OFF_R6);
    float* stats = (float*)(p.ws + OFF_STATS);
    for (int row = blockIdx.x * 8 + wid; row < MROWS; row += gridDim.x * 8) {
        const int b = row / TPB, pp = row % TPB;
        if (skip_ctx && pp < CTXL) continue;
        float* xp = x_wr(p, b, pp);
        f32x4 v[4];
        float s = 0.f;
#pragma unroll
        for (int i = 0; i < 4; ++i) { v[i] = *(const f32x4*)(xp + i * 256 + lane * 4); s += (v[i][0] + v[i][1]) + (v[i][2] + v[i][3]); }
        const float mean = wave_sum(s) * (1.0f / 1024.0f);
        float q = 0.f;
#pragma unroll
        for (int i = 0; i < 4; ++i)
#pragma unroll
            for (int j = 0; j < 4; ++j) { const float d = v[i][j] - mean; q += d * d; }
        const float rstd = rsqrtf(wave_sum(q) * (1.0f / 1024.0f) + 1e-5f);
        if (lane == 0) { stats[(size_t)row * 2] = mean; stats[(size_t)row * 2 + 1] = rstd; }
        const float* mv = write_xmod ? modv_ptr(p, lmod, b, pp) + shoff : nullptr;
#pragma unroll
        for (int i = 0; i < 4; ++i) {
            const int c = i * 256 + lane * 4;
            const f32x4 g4 = *(const f32x4*)(g + c), b4 = *(const f32x4*)(bta + c);
            f32x4 o;
#pragma unroll
            for (int j = 0; j < 4; ++j) o[j] = (v[i][j] - mean) * rstd * g4[j] + b4[j];
            if (write_x) *(f32x4*)(xp + c) = o;
            if (write_xmod) {
                const f32x4 sh = *(const f32x4*)(mv + c), sc = *(const f32x4*)(mv + 1024 + c);
                uint2 ov; ov.x = pk_bf16(o[0] * (1.f + sc[0]) + sh[0], o[1] * (1.f + sc[1]) + sh[1]); ov.y = pk_bf16(o[2] * (1.f + sc[2]) + sh[2], o[3] * (1.f + sc[3]) + sh[3]);
                *(uint2*)(xm + (size_t)row * 1024 + c) = ov;
            }
        }
    }
}

__device__ __forceinline__ void p7_phase(const Params& pin, bool skip_ctx, unsigned char* lds) {
    const Params p = launder(pin); const int tid = ltid();
    const bf16_t* A = (const bf16_t*)(p.ws + OFF_R6);
    const bf16_t* W = (const bf16_t*)(p.ws + OFF_W) + WO_13;
    bf16_t* HF = (bf16_t*)(p.ws + OFF_HF);
    const int lane = tid & 63, wid = tid >> 6, wr = wid >> 2, wc = wid & 3, fr = lane & 15, fq = lane >> 4;
    auto seg = [&](int t) { int mt, nt; tile_mn(t, 22, mt, nt); Seg g; g.A = A + (size_t)mt * 256 * 1024; g.Bt = W + (size_t)nt * 256 * 1024; g.lda = 1024; g.a_kstep = 64; g.ldb = 1024; g.nk = 16; return g; };
    auto valid = [&](int t) { int mt, nt; tile_mn(t, 22, mt, nt); return !(skip_ctx && (mt % 9) == 0); };
    auto nextv = [&](int t) { while (t < 144 * 22 && !valid(t)) t += gridDim.x; return t; };
    int st = 0; bool first = true;
    for (int t = nextv(blockIdx.x); t < 144 * 22;) {
        int mt, nt; tile_mn(t, 22, mt, nt);
        const int tn = nextv(t + gridDim.x); const bool hn = tn < 144 * 22;
        f32x4 acc[8][4]; zero_acc<8>(acc);
        gemm_stream256(acc, seg(t), seg(hn ? tn : t), hn, first, st, lds, tid); first = false;
        const int G = nt * 4 + wc;
#pragma unroll
        for (int m = 0; m < 8; ++m) {
            const size_t row = (size_t)mt * 256 + wr * 128 + m * 16 + fr;
            uint2 ov[2];
#pragma unroll
            for (int n = 0; n < 2; ++n) {
                float o[4];
#pragma unroll
                for (int j = 0; j < 4; ++j) o[j] = siluf_(acc[m][n][j]) * acc[m][n + 2][j];
                ov[n].x = pk_bf16(o[0], o[1]); ov[n].y = pk_bf16(o[2], o[3]);
            }
            *(uint4*)(HF + row * DFF + G * 32 + (fq & 1) * 16 + (fq >> 1) * 8) = widen16(ov[0], ov[1]);
        }
        t = tn;
    }
}

__global__ void __launch_bounds__(NTHREADS) fwd_megakernel(Params p) {
    extern __shared__ __attribute__((aligned(16))) unsigned char lds[];
    cg::grid_group grid = cg::this_grid();
    unsigned* gbar = (unsigned*)(p.ws + OFF_BAR); unsigned epoch = 0;
#define GSYNC() grid_barrier(gbar, epoch)
    if (p.ws == nullptr) grid.sync();
    modv_phase(p, lds);
    convert_layer(p, 0, lds);
    {
        bf16_t* Wm = (bf16_t*)(p.ws + OFF_W) + WO_IN + (size_t)672 * 1024;
        for (int i = blockIdx.x * NTHREADS + threadIdx.x; i < 96 * 1024 / 2; i += gridDim.x * NTHREADS) ((unsigned*)Wm)[i] = 0u;
    }
    GSYNC();
    xmod0_phase(p);
    GSYNC();
#pragma unroll 1
    for (int l = 0; l < DEPTH; ++l) {
        const bool last = (l == DEPTH - 1);
        for (int r = 0, nr = launder_i(1 + ((PROBE_MASK >> 2) & 1)); r < nr; ++r) p1_phase(p, lds);
        GSYNC();
        for (int r = 0, nr = launder_i(1 + ((PROBE_MASK >> 3) & 1)); r < nr; ++r) p2a_phase(p, l);
        GSYNC();
        for (int r = 0, nr = launder_i(1 + ((PROBE_MASK >> 4) & 1)); r < nr; ++r) p2b_phase(p, l, lds);
        GSYNC();
        p3_phase(p, l, lds);
        GSYNC();
        for (int r = 0, nr = launder_i(1 + ((PROBE_MASK >> 5) & 1)); r < nr; ++r) p35_phase(p, l, last, lds);
        GSYNC();
        for (int r = 0, nr = launder_i(1 + ((PROBE_MASK >> 6) & 1)); r < nr; ++r) p4_phase(p, last, lds);
        GSYNC();
        resid_gemm_phase(p, l, OFF_MRG, 1024, 16, WO_OUT, 1024, 2048, l == 0, p.ln2_g + (l > 0 ? l - 1 : 0) * 1024, p.ln2_b + (l > 0 ? l - 1 : 0) * 1024, last, lds);
        GSYNC();
        ln_phase(p, p.ln1_g + l * 1024, p.ln1_b + l * 1024, l, 3072, true, false, last);
        GSYNC();
        for (int r = 0, nr = launder_i(1 + ((PROBE_MASK >> 0) & 1)); r < nr; ++r) p7_phase(p, last, lds);
        GSYNC();
        resid_gemm_phase(p, l, OFF_HF, DFF, 44, WO_2, DFF, 5120, false, p.ln1_g + l * 1024, p.ln1_b + l * 1024, last, lds);
        GSYNC();
        ln_phase(p, p.ln2_g + l * 1024, p.ln2_b + l * 1024, last ? l : l + 1, 0, !last, last, last);
        if (!last) for (int r = 0, nr = launder_i(1 + ((PROBE_MASK >> 7) & 1)); r < nr; ++r) convert_layer(p, l + 1, lds);
        for (int r = 0, nr = launder_i(((PROBE_MASK >> 8) & 1) * 10); r < nr; ++r) GSYNC();
        GSYNC();
    }
}

extern "C" void kernel_launch(void* const* d_in, const int* in_sizes, int n_in, void* d_out,
                              int out_size, void* d_ws, size_t ws_size, hipStream_t stream) {
    static int grid_blocks = 0;
    if (!grid_blocks) {
        int dev = 0, cus = 0, per_cu = 0;
        hipGetDevice(&dev);
        hipDeviceGetAttribute(&cus, hipDeviceAttributeMultiprocessorCount, dev);
        if (hipFuncSetAttribute((const void*)fwd_megakernel, hipFuncAttributeMaxDynamicSharedMemorySize, LDS_BYTES) != hipSuccess)
            fprintf(stderr, "hipFuncSetAttribute failed\n");
        hipOccupancyMaxActiveBlocksPerMultiprocessor(&per_cu, (const void*)fwd_megakernel, NTHREADS, LDS_BYTES);
        if (per_cu < 1) fprintf(stderr, "occupancy query says %d blocks/CU\n", per_cu);
        (void)hipGetLastError();
        grid_blocks = cus > 0 ? cus : 256;
        if (ws_size < WS_END) { fprintf(stderr, "workspace too small: %zu < %zu\n", ws_size, (size_t)WS_END); grid_blocks = -1; }
        if (n_in != 33) { fprintf(stderr, "expected 33 inputs, got %d\n", n_in); grid_blocks = -1; }
    }
    if (grid_blocks < 0) return;
    if (hipMemsetAsync((unsigned char*)d_ws + OFF_BAR, 0, 1024, stream) != hipSuccess) fprintf(stderr, "memset failed\n");
    Params p{};
    const float** pp = (const float**)&p;
    for (int i = 0; i < 33; ++i) pp[i] = (const float*)d_in[i];
    p.out = (float*)d_out;
    p.ws = (unsigned char*)d_ws;
    void* args[] = {&p};
    hipError_t e = hipLaunchCooperativeKernel((void*)fwd_megakernel, dim3(grid_blocks), dim3(NTHREADS), args, LDS_BYTES, stream);
    if (e != hipSuccess) fprintf(stderr, "cooperative launch failed: %s (grid %d)\n", hipGetErrorString(e), grid_blocks);
}
```

```cpp
#include <hip/hip_runtime.h>
#include <hip/hip_cooperative_groups.h>
#include <cstdio>
#include <cstdint>
namespace cg = cooperative_groups;

typedef unsigned short bf16_t;
typedef short bf16x8 __attribute__((ext_vector_type(8)));
typedef float f32x4 __attribute__((ext_vector_type(4)));

#ifndef PROBE_MASK
#define PROBE_MASK 0
#endif
constexpr int BATCH = 16, SEQ = 2048, CTXL = 256, DM = 1024, DEPTH = 4, DFF = 2816, DIN = 7200;
constexpr int TPB = SEQ + CTXL;
constexpr int MROWS = BATCH * TPB;
constexpr int NTHREADS = 512;
constexpr int LDS_BYTES = 152 * 1024;
constexpr float ALPHA = 1.681792830507429f;
constexpr float QSCALE = 0.10206207261596575f * 1.4426950408889634f;

constexpr size_t WO_IN = 0;
constexpr size_t WO_UQ = WO_IN + (size_t)7296 * 1024;
constexpr size_t WO_UKV = WO_UQ + (size_t)768 * 384;
constexpr size_t WO_OA = WO_UKV + (size_t)1024 * 256;
constexpr size_t WO_OC = WO_OA + (size_t)1024 * 512;
constexpr size_t WO_OR = WO_OC + (size_t)1024 * 512;
constexpr size_t WO_OUT = WO_OR + (size_t)1024 * 512;
constexpr size_t WO_13 = WO_OUT + (size_t)1024 * 1024;
constexpr size_t WO_2 = WO_13 + (size_t)5632 * 1024;
constexpr size_t WO_UP = WO_2 + (size_t)1024 * 2816;
constexpr size_t WO_AUP = WO_UP + (size_t)2 * 512 * 64;
constexpr size_t WO_GUP = WO_AUP + (size_t)2 * 512 * 64;
constexpr size_t W_ELEMS = WO_GUP + (size_t)512 * 128;

constexpr size_t al256(size_t x) { return (x + 255) & ~(size_t)255; }
constexpr size_t OFF_BAR = 0;
constexpr size_t OFF_W = 1024;
constexpr size_t OFF_MODV = al256(OFF_W + W_ELEMS * 2);
constexpr size_t OFF_ROPE = al256(OFF_MODV + (size_t)4 * 17 * 6144 * 4);
constexpr size_t OFF_RSQ = al256(OFF_ROPE + 64 * 8 * 2 * 4);
constexpr size_t OFF_RSKV = al256(OFF_RSQ + (size_t)MROWS * 4);
constexpr size_t OFF_STATS = al256(OFF_RSKV + (size_t)MROWS * 4);
constexpr size_t OFF_XC = al256(OFF_STATS + (size_t)MROWS * 8);
constexpr size_t OFF_R1 = al256(OFF_XC + (size_t)BATCH * CTXL * DM * 4);
constexpr size_t OFF_R2 = al256(OFF_R1 + (size_t)MROWS * 672 * 2);
constexpr size_t OFF_R3 = OFF_R2 + (size_t)MROWS * 1536 * 2;
constexpr size_t OFF_R4 = al256(OFF_R3 + (size_t)MROWS * 1920 * 2);
constexpr size_t OFF_R5 = al256(OFF_R4 + (size_t)MROWS * (512 + 512 + 32) * 2);
constexpr size_t OFF_R6 = al256(OFF_R5 + (size_t)MROWS * 512 * 2);
constexpr size_t WS_END = al256(OFF_R6 + (size_t)MROWS * 1024 * 2);
constexpr size_t OFF_Q = OFF_R2;
constexpr size_t OFF_YF = OFF_R2 + (size_t)MROWS * 768 * 2;
constexpr size_t OFF_SG = OFF_YF + (size_t)MROWS * 512 * 2;
constexpr size_t OFF_YB = OFF_R1;
constexpr size_t OFF_KN = OFF_R4;
constexpr size_t OFF_VT = OFF_R4 + (size_t)MROWS * 512 * 2;
constexpr size_t OFF_KR = OFF_VT + (size_t)MROWS * 512 * 2;
constexpr size_t OFF_RWO = OFF_R4;
constexpr size_t OFF_MRG = OFF_R3;
constexpr size_t OFF_HF = OFF_R2;
static_assert(OFF_SG + (size_t)MROWS * 128 * 2 <= OFF_R3, "R2 overlay overflow");
static_assert((size_t)MROWS * 2816 * 2 <= OFF_R4 - OFF_R2, "HF overflow");

struct Params {
    const float *x, *c, *ctx, *c_ctx, *mod_w, *mod_b, *w_in, *q_norm, *w_uq, *kv_norm, *w_ukv, *w_o_attn,
        *conv_w, *w_o_conv, *rw_mu, *rw_w0, *rw_w_up, *rw_a0, *rw_a_up, *rw_g_up, *rw_k_k, *rw_k_a,
        *rw_r_k, *rw_gn_g, *rw_gn_b, *w_o_rwkv, *w_out, *ln1_g, *ln1_b, *ffn_w13, *ffn_w2, *ln2_g, *ln2_b;
    float* out;
    unsigned char* ws;
};

typedef __attribute__((address_space(1))) unsigned char gchar_t;
typedef __attribute__((address_space(1))) float gfloat_t;
__device__ __forceinline__ Params launder(const Params& a) {
    Params q = a;
    unsigned long long w = (unsigned long long)a.ws, o = (unsigned long long)a.out;
    unsigned wl = __builtin_amdgcn_readfirstlane((unsigned)w), wh = __builtin_amdgcn_readfirstlane((unsigned)(w >> 32));
    unsigned ol = __builtin_amdgcn_readfirstlane((unsigned)o), oh = __builtin_amdgcn_readfirstlane((unsigned)(o >> 32));
    asm volatile("" : "+s"(wl), "+s"(wh), "+s"(ol), "+s"(oh));
    w = ((unsigned long long)wh << 32) | wl; o = ((unsigned long long)oh << 32) | ol;
    q.ws = (unsigned char*)(gchar_t*)w; q.out = (float*)(gfloat_t*)o;
    return q;
}
__device__ __forceinline__ int launder_i(int v) { v = __builtin_amdgcn_readfirstlane(v); asm volatile("" : "+s"(v)); return v; }
__device__ __forceinline__ int ltid() { int t = threadIdx.x; asm volatile("" : "+v"(t)); return t; }
__device__ __forceinline__ unsigned pk_bf16(float lo, float hi) { unsigned r; asm("v_cvt_pk_bf16_f32 %0, %1, %2" : "=v"(r) : "v"(lo), "v"(hi)); return r; }
__device__ __forceinline__ float bf_lo(unsigned u) { return __uint_as_float(u << 16); }
__device__ __forceinline__ float bf_hi(unsigned u) { return __uint_as_float(u & 0xffff0000u); }
__device__ __forceinline__ float bf1(bf16_t h) { return __uint_as_float(((unsigned)h) << 16); }
__device__ __forceinline__ float x32sum(float x) { unsigned u = __float_as_uint(x); auto r = __builtin_amdgcn_permlane32_swap(u, u, false, false); return __uint_as_float(r[0]) + __uint_as_float(r[1]); }
__device__ __forceinline__ float x16sum(float x) { unsigned u = __float_as_uint(x); auto r = __builtin_amdgcn_permlane16_swap(u, u, false, false); return __uint_as_float(r[0]) + __uint_as_float(r[1]); }
__device__ __forceinline__ float x32max(float x) { unsigned u = __float_as_uint(x); auto r = __builtin_amdgcn_permlane32_swap(u, u, false, false); return fmaxf(__uint_as_float(r[0]), __uint_as_float(r[1])); }
__device__ __forceinline__ float x16max(float x) { unsigned u = __float_as_uint(x); auto r = __builtin_amdgcn_permlane16_swap(u, u, false, false); return fmaxf(__uint_as_float(r[0]), __uint_as_float(r[1])); }
__device__ __forceinline__ float fqsum(float x) { return x16sum(x32sum(x)); }
__device__ __forceinline__ float fqmax(float x) { return x16max(x32max(x)); }
__device__ __forceinline__ float wave_sum(float v) {
#pragma unroll
    for (int o = 1; o < 16; o <<= 1) v += __shfl_xor(v, o);
    return fqsum(v);
}
template <int CTRL> __device__ __forceinline__ float dpp_add(float x) { return x + __uint_as_float((unsigned)__builtin_amdgcn_update_dpp(0, (int)__float_as_uint(x), CTRL, 0xf, 0xf, true)); }
__device__ __forceinline__ float red8(float x) { x = dpp_add<0xB1>(x); x = dpp_add<0x4E>(x); x = dpp_add<0x141>(x); return x; }
__device__ __forceinline__ uint4 widen16(uint2 a, uint2 b) {
    auto r0 = __builtin_amdgcn_permlane16_swap(a.x, b.x, false, false);
    auto r1 = __builtin_amdgcn_permlane16_swap(a.y, b.y, false, false);
    return make_uint4(r0[0], r1[0], r0[1], r1[1]);
}
__device__ __forceinline__ float fexp(float x) { return __builtin_amdgcn_exp2f(x * 1.4426950408889634f); }
__device__ __forceinline__ float sigmoidf_(float x) { return __builtin_amdgcn_rcpf(1.0f + fexp(-x)); }
__device__ __forceinline__ float siluf_(float x) { return x * __builtin_amdgcn_rcpf(1.0f + fexp(-x)); }

__device__ __forceinline__ const float* x_rd(const Params& p, bool from_input, int b, int pp) {
    if (pp < CTXL) return (from_input ? p.ctx : (const float*)(p.ws + OFF_XC)) + ((size_t)b * CTXL + pp) * DM;
    return (from_input ? p.x : (const float*)p.out) + ((size_t)b * SEQ + (pp - CTXL)) * DM;
}
__device__ __forceinline__ float* x_wr(const Params& p, int b, int pp) {
    if (pp < CTXL) return (float*)(p.ws + OFF_XC) + ((size_t)b * CTXL + pp) * DM;
    return p.out + ((size_t)b * SEQ + (pp - CTXL)) * DM;
}
__device__ __forceinline__ const float* modv_ptr(const Params& p, int l, int b, int pp) {
    const int mr = pp < CTXL ? 16 : b;
    return (const float*)(p.ws + OFF_MODV) + ((size_t)l * 17 + mr) * 6144;
}

__device__ __forceinline__ void grid_barrier(unsigned* bar, unsigned& epoch) {
    asm volatile("s_waitcnt vmcnt(0) lgkmcnt(0)" ::: "memory");
    __syncthreads();
    epoch += 1;
    if (threadIdx.x == 0) {
        __builtin_amdgcn_fence(__ATOMIC_RELEASE, "agent");
        asm volatile("s_waitcnt vmcnt(0)" ::: "memory");
        const unsigned old = __hip_atomic_fetch_add(bar, 1u, __ATOMIC_RELAXED, __HIP_MEMORY_SCOPE_AGENT);
        if (old + 1u == epoch * gridDim.x) {
            __hip_atomic_store(bar + 64, epoch, __ATOMIC_RELAXED, __HIP_MEMORY_SCOPE_AGENT);
        } else {
            while (__hip_atomic_load(bar + 64, __ATOMIC_RELAXED, __HIP_MEMORY_SCOPE_AGENT) < epoch) __builtin_amdgcn_s_sleep(1);
        }
        __builtin_amdgcn_fence(__ATOMIC_ACQUIRE, "agent");
        asm volatile("s_waitcnt vmcnt(0)" ::: "memory");
    }
    __syncthreads();
}

#define LDS_AS __attribute__((address_space(3)))
#define GLB_AS __attribute__((address_space(1)))
template <int MT, int SWAPMODE>
__device__ __forceinline__ void gemm_mainloop(f32x4 (&acc)[MT][4], const bf16_t* __restrict__ A, int lda, int a_kstep,
                                              const bf16_t* __restrict__ Bt, int ldb, int nk, unsigned char* lds, int tid) {
    constexpr int BMr = 64 * MT;
    constexpr int STAGE = (BMr + 128) * 128;
    const int wid = __builtin_amdgcn_readfirstlane(tid >> 6), lane = tid & 63, wr = wid >> 1, wc = wid & 1, fr = lane & 15, fq = lane >> 4;
    const int lrow = 8 * wid + (lane >> 3);
    const int lch = (lane & 7) ^ ((4 * wid + (lane >> 4)) & 7);
    const bf16_t* ap = A + (size_t)lrow * lda + lch * 8;
    const bf16_t* bp = Bt + (size_t)lrow * ldb + lch * 8;
    auto issue = [&](int kt, int st) {
        unsigned char* base = lds + st * STAGE + wid * 1024;
#pragma unroll
        for (int i = 0; i < MT; ++i)
            __builtin_amdgcn_global_load_lds((const GLB_AS unsigned*)(ap + (size_t)i * 64 * lda + (size_t)kt * a_kstep), (LDS_AS unsigned*)(base + i * 8192), 16, 0, 0);
#pragma unroll
        for (int i = 0; i < 2; ++i)
            __builtin_amdgcn_global_load_lds((const GLB_AS unsigned*)(bp + (size_t)i * 64 * ldb + (size_t)kt * 64), (LDS_AS unsigned*)(base + (BMr + i * 64) * 128), 16, 0, 0);
    };
    const bool sw = (SWAPMODE == 1) || (SWAPMODE == 2 && wc == 0);
    const int sz = fr >> 1;
    constexpr int NL = MT + 2;
    const bool late = wid >= 4;
    issue(0, 0);
    if (nk > 1) { issue(1, 1); asm volatile("s_waitcnt vmcnt(%0)" ::"n"(NL) : "memory"); }
    else asm volatile("s_waitcnt vmcnt(0)" ::: "memory");
    __builtin_amdgcn_s_barrier();
    asm volatile("" ::: "memory");
    int st = 0;
    for (int kt = 0; kt < nk; ++kt) {
        const int st2 = st >= 1 ? st - 1 : 2;
        if (!late && kt + 2 < nk) issue(kt + 2, st2);
        const unsigned char* As = lds + st * STAGE;
        const unsigned char* Bs = As + BMr * 128;
#pragma unroll
        for (int ks = 0; ks < 2; ++ks) {
            bf16x8 af[MT], bfr[4];
            const int co = ((ks * 4 + fq) ^ sz) * 16;
#pragma unroll
            for (int m = 0; m < MT; ++m) af[m] = *(const bf16x8*)(As + (wr * 16 * MT + m * 16 + fr) * 128 + co);
#pragma unroll
            for (int n = 0; n < 4; ++n) bfr[n] = *(const bf16x8*)(Bs + (wc * 64 + n * 16 + fr) * 128 + co);
            if (sw) {
#pragma unroll
                for (int m = 0; m < MT; ++m)
#pragma unroll
                    for (int n = 0; n < 4; ++n) acc[m][n] = __builtin_amdgcn_mfma_f32_16x16x32_bf16(bfr[n], af[m], acc[m][n], 0, 0, 0);
            } else {
#pragma unroll
                for (int m = 0; m < MT; ++m)
#pragma unroll
                    for (int n = 0; n < 4; ++n) acc[m][n] = __builtin_amdgcn_mfma_f32_16x16x32_bf16(af[m], bfr[n], acc[m][n], 0, 0, 0);
            }
        }
        if (late && kt + 2 < nk) issue(kt + 2, st2);
        if (kt + 2 < nk) asm volatile("s_waitcnt vmcnt(%0) lgkmcnt(0)" ::"n"(NL) : "memory");
        else asm volatile("s_waitcnt vmcnt(0) lgkmcnt(0)" ::: "memory");
        __builtin_amdgcn_s_barrier();
        asm volatile("" ::: "memory");
        st = st == 2 ? 0 : st + 1;
    }
}
__device__ __forceinline__ void gemm_mainloop256(f32x4 (&acc)[8][4], const bf16_t* __restrict__ A, int lda,
                                                 const bf16_t* __restrict__ Bt, int ldb, int nk, unsigned char* lds, int tid) {
    constexpr int STAGE = 512 * 128;
    const int wid = __builtin_amdgcn_readfirstlane(tid >> 6), lane = tid & 63, wr = wid >> 2, wc = wid & 3, fr = lane & 15, fq = lane >> 4;
    const int lrow = 8 * wid + (lane >> 3);
    const int lch = (lane & 7) ^ ((4 * wid + (lane >> 4)) & 7);
    const bf16_t* ap = A + (size_t)lrow * lda + lch * 8;
    const bf16_t* bp = Bt + (size_t)lrow * ldb + lch * 8;
    auto issue = [&](int kt, int st) {
        unsigned char* base = lds + st * STAGE + wid * 1024;
#pragma unroll
        for (int i = 0; i < 4; ++i)
            __builtin_amdgcn_global_load_lds((const GLB_AS unsigned*)(ap + (size_t)i * 64 * lda + (size_t)kt * 64), (LDS_AS unsigned*)(base + i * 8192), 16, 0, 0);
#pragma unroll
        for (int i = 0; i < 4; ++i)
            __builtin_amdgcn_global_load_lds((const GLB_AS unsigned*)(bp + (size_t)i * 64 * ldb + (size_t)kt * 64), (LDS_AS unsigned*)(base + (256 + i * 64) * 128), 16, 0, 0);
    };
    const int sz = fr >> 1;
    const bool late = wid >= 4;
    issue(0, 0);
    asm volatile("s_waitcnt vmcnt(0)" ::: "memory");
    __builtin_amdgcn_s_barrier();
    asm volatile("" ::: "memory");
    for (int kt = 0; kt < nk; ++kt) {
        if (!late && kt + 1 < nk) issue(kt + 1, (kt + 1) & 1);
        const unsigned char* As = lds + (kt & 1) * STAGE;
        const unsigned char* Bs = As + 256 * 128;
#pragma unroll
        for (int ks = 0; ks < 2; ++ks) {
            if (ks == 1 && late && kt + 1 < nk) issue(kt + 1, (kt + 1) & 1);
            bf16x8 af[8], bfr[4];
            const int co = ((ks * 4 + fq) ^ sz) * 16;
#pragma unroll
            for (int m = 0; m < 8; ++m) af[m] = *(const bf16x8*)(As + (wr * 128 + m * 16 + fr) * 128 + co);
#pragma unroll
            for (int n = 0; n < 4; ++n) bfr[n] = *(const bf16x8*)(Bs + (wc * 64 + n * 16 + fr) * 128 + co);
#pragma unroll
            for (int m = 0; m < 8; ++m)
#pragma unroll
                for (int n = 0; n < 4; ++n) acc[m][n] = __builtin_amdgcn_mfma_f32_16x16x32_bf16(bfr[n], af[m], acc[m][n], 0, 0, 0);
        }
        asm volatile("s_waitcnt vmcnt(0) lgkmcnt(0)" ::: "memory");
        __builtin_amdgcn_s_barrier();
        asm volatile("" ::: "memory");
    }
}
struct Seg { const bf16_t* A; const bf16_t* Bt; int lda, a_kstep, ldb, nk; };
template <int MT, int SWAPMODE>
__device__ __forceinline__ void gemm_stream(f32x4 (&acc)[MT][4], const Seg& cur, const Seg& nxt, bool has_next, bool first, int& st,
                                            unsigned char* lds, int tid) {
    constexpr int BMr = 64 * MT;
    constexpr int STAGE = (BMr + 128) * 128;
    constexpr int NL = MT + 2;
    const int wid = __builtin_amdgcn_readfirstlane(tid >> 6), lane = tid & 63, wr = wid >> 1, wc = wid & 1, fr = lane & 15, fq = lane >> 4;
    const int lrow = 8 * wid + (lane >> 3);
    const int lch = (lane & 7) ^ ((4 * wid + (lane >> 4)) & 7);
    const bf16_t* apc = cur.A + (size_t)lrow * cur.lda + lch * 8;
    const bf16_t* bpc = cur.Bt + (size_t)lrow * cur.ldb + lch * 8;
    const bf16_t* apn = nxt.A + (size_t)lrow * nxt.lda + lch * 8;
    const bf16_t* bpn = nxt.Bt + (size_t)lrow * nxt.ldb + lch * 8;
    auto issue = [&](const bf16_t* ap, const bf16_t* bp, int lda, int ldb, int koffa, int koffb, int slot) {
        unsigned char* base = lds + slot * STAGE + wid * 1024;
#pragma unroll
        for (int i = 0; i < MT; ++i)
            __builtin_amdgcn_global_load_lds((const GLB_AS unsigned*)(ap + (size_t)i * 64 * lda + koffa), (LDS_AS unsigned*)(base + i * 8192), 16, 0, 0);
#pragma unroll
        for (int i = 0; i < 2; ++i)
            __builtin_amdgcn_global_load_lds((const GLB_AS unsigned*)(bp + (size_t)i * 64 * ldb + koffb), (LDS_AS unsigned*)(base + (BMr + i * 64) * 128), 16, 0, 0);
    };
    const bool sw = (SWAPMODE == 1) || (SWAPMODE == 2 && wc == 0);
    const int sz = fr >> 1;
    const bool late = wid >= 4;
    const int nk = cur.nk;
    int s0 = st;
    if (first) {
        const int s1 = s0 == 2 ? 0 : s0 + 1;
        issue(apc, bpc, cur.lda, cur.ldb, 0, 0, s0);
        issue(apc, bpc, cur.lda, cur.ldb, cur.a_kstep, 64, s1);
        asm volatile("s_waitcnt vmcnt(%0)" ::"n"(NL) : "memory");
        __builtin_amdgcn_s_barrier();
        asm volatile("" ::: "memory");
    }
    for (int kt = 0; kt < nk; ++kt) {
        const int s2 = s0 >= 1 ? s0 - 1 : 2;
        const int idx = kt + 2;
        const bool incur = idx < nk, doi = incur || has_next;
        if (!late && doi) { if (incur) issue(apc, bpc, cur.lda, cur.ldb, idx * cur.a_kstep, idx * 64, s2); else issue(apn, bpn, nxt.lda, nxt.ldb, (idx - nk) * nxt.a_kstep, (idx - nk) * 64, s2); }
        const unsigned char* As = lds + s0 * STAGE;
        const unsigned char* Bs = As + BMr * 128;
#pragma unroll
        for (int ks = 0; ks < 2; ++ks) {
            bf16x8 af[MT], bfr[4];
            const int co = ((ks * 4 + fq) ^ sz) * 16;
#pragma unroll
            for (int m = 0; m < MT; ++m) af[m] = *(const bf16x8*)(As + (wr * 16 * MT + m * 16 + fr) * 128 + co);
#pragma unroll
            for (int n = 0; n < 4; ++n) bfr[n] = *(const bf16x8*)(Bs + (wc * 64 + n * 16 + fr) * 128 + co);
            if (sw) {
#pragma unroll
                for (int m = 0; m < MT; ++m)
#pragma unroll
                    for (int n = 0; n < 4; ++n) acc[m][n] = __builtin_amdgcn_mfma_f32_16x16x32_bf16(bfr[n], af[m], acc[m][n], 0, 0, 0);
            } else {
#pragma unroll
                for (int m = 0; m < MT; ++m)
#pragma unroll
                    for (int n = 0; n < 4; ++n) acc[m][n] = __builtin_amdgcn_mfma_f32_16x16x32_bf16(af[m], bfr[n], acc[m][n], 0, 0, 0);
            }
        }
        if (late && doi) { if (incur) issue(apc, bpc, cur.lda, cur.ldb, idx * cur.a_kstep, idx * 64, s2); else issue(apn, bpn, nxt.lda, nxt.ldb, (idx - nk) * nxt.a_kstep, (idx - nk) * 64, s2); }
        if (doi) asm volatile("s_waitcnt vmcnt(%0) lgkmcnt(0)" ::"n"(NL) : "memory");
        else asm volatile("s_waitcnt vmcnt(0) lgkmcnt(0)" ::: "memory");
        __builtin_amdgcn_s_barrier();
        asm volatile("" ::: "memory");
        s0 = s0 == 2 ? 0 : s0 + 1;
    }
    st = s0;
}
__device__ __forceinline__ void gemm_stream256(f32x4 (&acc)[8][4], const Seg& cur, const Seg& nxt, bool has_next, bool first, int& st, unsigned char* lds, int tid) {
    constexpr int STAGE = 512 * 128;
    const int wid = __builtin_amdgcn_readfirstlane(tid >> 6), lane = tid & 63, wr = wid >> 2, wc = wid & 3, fr = lane & 15, fq = lane >> 4;
    const int lrow = 8 * wid + (lane >> 3);
    const int lch = (lane & 7) ^ ((4 * wid + (lane >> 4)) & 7);
    const bf16_t* apc = cur.A + (size_t)lrow * cur.lda + lch * 8;
    const bf16_t* bpc = cur.Bt + (size_t)lrow * cur.ldb + lch * 8;
    const bf16_t* apn = nxt.A + (size_t)lrow * nxt.lda + lch * 8;
    const bf16_t* bpn = nxt.Bt + (size_t)lrow * nxt.ldb + lch * 8;
    auto issue = [&](const bf16_t* ap, const bf16_t* bp, int lda, int ldb, int koff, int slot) {
        unsigned char* base = lds + slot * STAGE + wid * 1024;
#pragma unroll
        for (int i = 0; i < 4; ++i)
            __builtin_amdgcn_global_load_lds((const GLB_AS unsigned*)(ap + (size_t)i * 64 * lda + koff), (LDS_AS unsigned*)(base + i * 8192), 16, 0, 0);
#pragma unroll
        for (int i = 0; i < 4; ++i)
            __builtin_amdgcn_global_load_lds((const GLB_AS unsigned*)(bp + (size_t)i * 64 * ldb + koff), (LDS_AS unsigned*)(base + (256 + i * 64) * 128), 16, 0, 0);
    };
    const int sz = fr >> 1;
    const bool late = wid >= 4;
    const int nk = cur.nk;
    int s0 = st;
    if (first) {
        issue(apc, bpc, cur.lda, cur.ldb, 0, s0);
        asm volatile("s_waitcnt vmcnt(0)" ::: "memory");
        __builtin_amdgcn_s_barrier();
        asm volatile("" ::: "memory");
    }
    for (int kt = 0; kt < nk; ++kt) {
        const int idx = kt + 1;
        const bool incur = idx < nk, doi = incur || has_next;
        if (!late && doi) { if (incur) issue(apc, bpc, cur.lda, cur.ldb, idx * 64, s0 ^ 1); else issue(apn, bpn, nxt.lda, nxt.ldb, 0, s0 ^ 1); }
        const unsigned char* As = lds + s0 * STAGE;
        const unsigned char* Bs = As + 256 * 128;
#pragma unroll
        for (int ks = 0; ks < 2; ++ks) {
            if (ks == 1 && late && doi) { if (incur) issue(apc, bpc, cur.lda, cur.ldb, idx * 64, s0 ^ 1); else issue(apn, bpn, nxt.lda, nxt.ldb, 0, s0 ^ 1); }
            bf16x8 af[8], bfr[4];
            const int co = ((ks * 4 + fq) ^ sz) * 16;
#pragma unroll
            for (int m = 0; m < 8; ++m) af[m] = *(const bf16x8*)(As + (wr * 128 + m * 16 + fr) * 128 + co);
#pragma unroll
            for (int n = 0; n < 4; ++n) bfr[n] = *(const bf16x8*)(Bs + (wc * 64 + n * 16 + fr) * 128 + co);
#pragma unroll
            for (int m = 0; m < 8; ++m)
#pragma unroll
                for (int n = 0; n < 4; ++n) acc[m][n] = __builtin_amdgcn_mfma_f32_16x16x32_bf16(bfr[n], af[m], acc[m][n], 0, 0, 0);
        }
        asm volatile("s_waitcnt vmcnt(0) lgkmcnt(0)" ::: "memory");
        __builtin_amdgcn_s_barrier();
        asm volatile("" ::: "memory");
        s0 ^= 1;
    }
    st = s0;
}
__device__ __forceinline__ void gemm_gate3(f32x4 (&g)[3][2][4], const bf16_t* __restrict__ A, const bf16_t* __restrict__ Bt0, int nk, unsigned char* lds, int tid) {
    constexpr int STAGE = 512 * 128;
    const int wid = __builtin_amdgcn_readfirstlane(tid >> 6), lane = tid & 63, wr = wid >> 1, wc = wid & 1, fr = lane & 15, fq = lane >> 4;
    const int lrow = 8 * wid + (lane >> 3);
    const int lch = (lane & 7) ^ ((4 * wid + (lane >> 4)) & 7);
    const unsigned loff = (unsigned)(lrow * 1024 + lch * 8);
    auto issue = [&](int kt, int stg) {
        unsigned char* base = lds + stg * STAGE + wid * 1024;
#pragma unroll
        for (int i = 0; i < 2; ++i)
            __builtin_amdgcn_global_load_lds((const GLB_AS unsigned*)((A + (size_t)i * 64 * 1024 + (size_t)kt * 64) + loff), (LDS_AS unsigned*)(base + i * 8192), 16, 0, 0);
#pragma unroll
        for (int j = 0; j < 6; ++j)
            __builtin_amdgcn_global_load_lds((const GLB_AS unsigned*)((Bt0 + ((size_t)(j >> 1) * 1024 + (j & 1) * 64) * 1024 + (size_t)kt * 64) + loff), (LDS_AS unsigned*)(base + (128 + j * 64) * 128), 16, 0, 0);
    };
    const int sz = fr >> 1;
    const bool late = wid >= 4;
    issue(0, 0);
    asm volatile("s_waitcnt vmcnt(0)" ::: "memory");
    __builtin_amdgcn_s_barrier();
    asm volatile("" ::: "memory");
    for (int kt = 0; kt < nk; ++kt) {
        if (!late && kt + 1 < nk) issue(kt + 1, (kt + 1) & 1);
        const unsigned char* As = lds + (kt & 1) * STAGE;
        const unsigned char* Bs = As + 128 * 128;
#pragma unroll
        for (int ks = 0; ks < 2; ++ks) {
            if (ks == 1 && late && kt + 1 < nk) issue(kt + 1, (kt + 1) & 1);
            const int co = ((ks * 4 + fq) ^ sz) * 16;
            bf16x8 af[2];
#pragma unroll
            for (int m = 0; m < 2; ++m) af[m] = *(const bf16x8*)(As + (wr * 32 + m * 16 + fr) * 128 + co);
#pragma unroll
            for (int i = 0; i < 3; ++i) {
                bf16x8 bfr[4];
#pragma unroll
                for (int n = 0; n < 4; ++n) bfr[n] = *(const bf16x8*)(Bs + (i * 128 + wc * 64 + n * 16 + fr) * 128 + co);
#pragma unroll
                for (int m = 0; m < 2; ++m)
#pragma unroll
                    for (int n = 0; n < 4; ++n) g[i][m][n] = __builtin_amdgcn_mfma_f32_16x16x32_bf16(bfr[n], af[m], g[i][m][n], 0, 0, 0);
                if (i < 2) __builtin_amdgcn_sched_barrier(0);
            }
        }
        asm volatile("s_waitcnt vmcnt(0) lgkmcnt(0)" ::: "memory");
        __builtin_amdgcn_s_barrier();
        asm volatile("" ::: "memory");
    }
}
template <int MT> __device__ __forceinline__ void zero_acc(f32x4 (&acc)[MT][4]) {
#pragma unroll
    for (int m = 0; m < MT; ++m)
#pragma unroll
        for (int n = 0; n < 4; ++n) acc[m][n] = (f32x4){0.f, 0.f, 0.f, 0.f};
}
__device__ __forceinline__ void tile_mn(int t, int nN, int& mt, int& nt) { const int per = 16 * nN, g = t / per, w = t % per; mt = g * 16 + (w & 15); nt = w >> 4; }

__device__ __forceinline__ int rowmap(int mode, int n) {
    if (mode == 1) return n < 672 ? n : n + 96;
    if (mode == 2) return n < DFF ? ((n >> 5) * 64 + (n & 31)) : (((n - DFF) >> 5) * 64 + 32 + ((n - DFF) & 31));
    return n;
}
__device__ __forceinline__ void convert_T(const float* __restrict__ src, int K, int N, bf16_t* __restrict__ dst, int mode, const float* __restrict__ ks, unsigned char* lds, int rot) {
    float* tile = (float*)lds;
    const int ntk = K / 64, ntn = (N + 63) / 64, tid = ltid();
    const int start = (blockIdx.x + gridDim.x - (rot % gridDim.x)) % gridDim.x;
    for (int t = start; t < ntk * ntn; t += gridDim.x) {
        const int tk = t % ntk, tn = t / ntk, k0 = tk * 64, n0 = tn * 64;
#pragma unroll
        for (int i = 0; i < 8; ++i) {
            const int kl = (tid >> 6) + 8 * i, nl = tid & 63, n = n0 + nl;
            tile[kl * 65 + nl] = n < N ? src[(size_t)(k0 + kl) * N + n] : 0.f;
        }
        __syncthreads();
        const int kp = (tid & 31) * 2;
        float s0 = 1.f, s1 = 1.f;
        if (ks) { s0 = ks[k0 + kp]; s1 = ks[k0 + kp + 1]; }
#pragma unroll
        for (int i = 0; i < 4; ++i) {
            const int nl = (tid >> 5) + 16 * i, n = n0 + nl;
            if (n < N) *(unsigned*)(dst + (size_t)rowmap(mode, n) * K + k0 + kp) = pk_bf16(tile[kp * 65 + nl] * s0, tile[(kp + 1) * 65 + nl] * s1);
        }
        __syncthreads();
    }
}
__device__ __forceinline__ void convert_layer(const Params& pin, int l, unsigned char* lds) {
    const Params p = launder(pin); l = launder_i(l);
    bf16_t* W = (bf16_t*)(p.ws + OFF_W);
    convert_T(p.w_in + (size_t)l * DM * DIN, DM, DIN, W + WO_IN, 1, nullptr, lds, 0);
    convert_T(p.ffn_w13 + (size_t)l * DM * 2 * DFF, DM, 2 * DFF, W + WO_13, 2, nullptr, lds, 40);
    convert_T(p.ffn_w2 + (size_t)l * DFF * DM, DFF, DM, W + WO_2, 0, nullptr, lds, 80);
    convert_T(p.w_out + (size_t)l * DM * DM, DM, DM, W + WO_OUT, 0, nullptr, lds, 120);
    convert_T(p.w_o_attn + (size_t)l * 512 * DM, 512, DM, W + WO_OA, 0, nullptr, lds, 136);
    convert_T(p.w_o_conv + (size_t)l * 512 * DM, 512, DM, W + WO_OC, 0, nullptr, lds, 8);
    convert_T(p.w_o_rwkv + (size_t)l * 512 * DM, 512, DM, W + WO_OR, 0, nullptr, lds, 136 + 8);
    convert_T(p.w_uq + (size_t)l * 384 * 768, 384, 768, W + WO_UQ, 0, p.q_norm + l * 384, lds, 16);
    convert_T(p.w_ukv + (size_t)l * 256 * 1024, 256, 1024, W + WO_UKV, 0, p.kv_norm + l * 256, lds, 88);
    for (int z = 0; z < 2; ++z) {
        convert_T(p.rw_w_up + ((size_t)l * 2 + z) * 64 * 512, 64, 512, W + WO_UP + (size_t)z * 512 * 64, 0, nullptr, lds, 152 + 8 * z);
        convert_T(p.rw_a_up + ((size_t)l * 2 + z) * 64 * 512, 64, 512, W + WO_AUP + (size_t)z * 512 * 64, 0, nullptr, lds, 168 + 8 * z);
    }
    convert_T(p.rw_g_up + (size_t)l * 128 * 512, 128, 512, W + WO_GUP, 0, nullptr, lds, 184);
}

__device__ __forceinline__ void modv_phase(const Params& pin, unsigned char* lds) {
    const Params p = launder(pin);
    float* s = (float*)lds;
    float* red = s + 17 * 1024;
    const int tid = ltid(), wid = tid >> 6, lane = tid & 63;
    for (int i = tid; i < 17 * 1024; i += NTHREADS) { const int r = i >> 10, k = i & 1023; const float v = r < 16 ? p.c[r * 1024 + k] : p.c_ctx[k]; s[i] = siluf_(v); }
    __syncthreads();
    float* modv = (float*)(p.ws + OFF_MODV);
    for (int g = blockIdx.x; g < 4 * 96; g += gridDim.x) {
        const int l = g / 96, n = (g % 96) * 64 + lane;
        const float* w = p.mod_w + (size_t)l * 1024 * 6144 + n;
        float acc[17];
#pragma unroll
        for (int r = 0; r < 17; ++r) acc[r] = 0.f;
        const int kb = wid * 128;
        for (int k = kb; k < kb + 128; k += 4) {
            const float w0 = w[(size_t)k * 6144], w1 = w[(size_t)(k + 1) * 6144], w2 = w[(size_t)(k + 2) * 6144], w3 = w[(size_t)(k + 3) * 6144];
#pragma unroll
            for (int r = 0; r < 17; ++r) { const f32x4 sv = *(const f32x4*)(s + r * 1024 + k); acc[r] += sv[0] * w0 + sv[1] * w1 + sv[2] * w2 + sv[3] * w3; }
        }
#pragma unroll
        for (int r = 0; r < 17; ++r) red[(wid * 17 + r) * 64 + lane] = acc[r];
        __syncthreads();
        for (int i = tid; i < 17 * 64; i += NTHREADS) {
            const int r = i >> 6, c = i & 63; float v = 0.f;
#pragma unroll
            for (int w8 = 0; w8 < 8; ++w8) v += red[(w8 * 17 + r) * 64 + c];
            const int nn = (g % 96) * 64 + c;
            modv[((size_t)l * 17 + r) * 6144 + nn] = v + p.mod_b[l * 6144 + nn];
        }
        __syncthreads();
    }
    if (blockIdx.x == gridDim.x - 1) {
        float* rope = (float*)(p.ws + OFF_ROPE);
        for (int i = tid; i < 512; i += NTHREADS) {
            const int pos = i >> 3, f = i & 7;
            const float inv = exp2f(-(float)f * (13.287712379549449f / 8.0f));
            const float ang = (float)pos * inv;
            rope[i * 2] = cosf(ang); rope[i * 2 + 1] = sinf(ang);
        }
    }
}

__device__ __forceinline__ void xmod0_phase(const Params& pin) {
    const Params p = launder(pin);
    const int tid = ltid(), wid = tid >> 6, lane = tid & 63;
    bf16_t* xm = (bf16_t*)(p.ws + OFF_R6);
    for (int row = blockIdx.x * 8 + wid; row < MROWS; row += gridDim.x * 8) {
        const int b = row / TPB, pp = row % TPB;
        const float* xp = x_rd(p, true, b, pp);
        const float* mv = modv_ptr(p, 0, b, pp);
#pragma unroll
        for (int i = 0; i < 4; ++i) {
            const int c = i * 256 + lane * 4;
            const f32x4 v = *(const f32x4*)(xp + c), sh = *(const f32x4*)(mv + c), sc = *(const f32x4*)(mv + 1024 + c);
            uint2 o; o.x = pk_bf16(v[0] * (1.f + sc[0]) + sh[0], v[1] * (1.f + sc[1]) + sh[1]); o.y = pk_bf16(v[2] * (1.f + sc[2]) + sh[2], v[3] * (1.f + sc[3]) + sh[3]);
            *(uint2*)(xm + (size_t)row * 1024 + c) = o;
        }
    }
}

__device__ __forceinline__ void p1_phase(const Params& pin, unsigned char* lds) {
    const Params p = launder(pin); const int tid = ltid();
    const bf16_t* A = (const bf16_t*)(p.ws + OFF_R6);
    const bf16_t* W = (const bf16_t*)(p.ws + OFF_W) + WO_IN;
    const int lane = tid & 63, wid = tid >> 6, wr = wid >> 2, wc = wid & 3, fr = lane & 15, fq = lane >> 4;
    auto seg = [&](int t) { int mt, nt; tile_mn(t, 17, mt, nt); Seg g; g.A = A + (size_t)mt * 256 * 1024; g.Bt = W + (size_t)nt * 256 * 1024; g.lda = 1024; g.a_kstep = 64; g.ldb = 1024; g.nk = 16; return g; };
    int st = 0; bool first = true;
    for (int t = blockIdx.x; t < 144 * 17; t += gridDim.x) {
        int mt, nt; tile_mn(t, 17, mt, nt);
        const int tn = t + gridDim.x; const bool hn = tn < 144 * 17;
        f32x4 acc[8][4]; zero_acc<8>(acc);
        gemm_stream256(acc, seg(t), seg(hn ? tn : t), hn, first, st, lds, tid); first = false;
        bf16_t* dst; int ld, cb, lim;
        if (nt < 3) { dst = (bf16_t*)(p.ws + OFF_R1); ld = 672; cb = nt * 256; lim = 672; }
        else if (nt < 9) { dst = (bf16_t*)(p.ws + OFF_R2); ld = 1536; cb = (nt - 3) * 256; lim = 1536; }
        else { dst = (bf16_t*)(p.ws + OFF_R3); ld = 1920; cb = (nt - 9) * 256; lim = 1920; }
#pragma unroll
        for (int m = 0; m < 8; ++m) {
            const size_t row = (size_t)mt * 256 + wr * 128 + m * 16 + fr;
#pragma unroll
            for (int n = 0; n < 4; n += 2) {
                uint2 a, b2;
                a.x = pk_bf16(acc[m][n][0], acc[m][n][1]); a.y = pk_bf16(acc[m][n][2], acc[m][n][3]);
                b2.x = pk_bf16(acc[m][n + 1][0], acc[m][n + 1][1]); b2.y = pk_bf16(acc[m][n + 1][2], acc[m][n + 1][3]);
                const uint4 w = widen16(a, b2);
                const int col = cb + wc * 64 + (n + (fq & 1)) * 16 + (fq >> 1) * 8;
                if (col < lim) *(uint4*)(dst + row * ld + col) = w;
            }
        }
    }
}

__device__ __forceinline__ void unpack8(const uint4 u, float (&f)[8]) {
    f[0] = bf_lo(u.x); f[1] = bf_hi(u.x); f[2] = bf_lo(u.y); f[3] = bf_hi(u.y); f[4] = bf_lo(u.z); f[5] = bf_hi(u.z); f[6] = bf_lo(u.w); f[7] = bf_hi(u.w);
}
__device__ __forceinline__ void p2a_phase(const Params& pin, int l) {
    const Params p = launder(pin); l = launder_i(l);
    const int tid = ltid(), wid = tid >> 6, lane = tid & 63;
    const bf16_t* Hm = (const bf16_t*)(p.ws + OFF_R1);
    const bf16_t* Hc = (const bf16_t*)(p.ws + OFF_R2);
    bf16_t* CV = (bf16_t*)(p.ws + OFF_R5);
    bf16_t* KR = (bf16_t*)(p.ws + OFF_KR);
    float* RSQ = (float*)(p.ws + OFF_RSQ);
    float* RSKV = (float*)(p.ws + OFF_RSKV);
    const float* rope = (const float*)(p.ws + OFF_ROPE);
    const float* cw = p.conv_w + (size_t)l * 3 * 512;
    const int c0 = lane * 8;
    float w0[8], w1[8], w2[8];
#pragma unroll
    for (int i = 0; i < 8; ++i) { w0[i] = cw[c0 + i]; w1[i] = cw[512 + c0 + i]; w2[i] = cw[1024 + c0 + i]; }
    for (int row = blockIdx.x * 8 + wid; row < MROWS; row += gridDim.x * 8) {
        const int pp = row % TPB;
        const bool hp = (pp != 0 && pp != CTXL), hn = (pp != CTXL - 1 && pp != TPB - 1);
        const bf16_t* hr = Hc + (size_t)row * 1536;
        float ch[8], cc[8], cb[8], u0[8], u1[8], u2[8];
        unpack8(*(const uint4*)(hr + c0), ch); unpack8(*(const uint4*)(hr + 1024 + c0), cc); unpack8(*(const uint4*)(hr + 512 + c0), cb);
#pragma unroll
        for (int i = 0; i < 8; ++i) u1[i] = cc[i] * ch[i];
        if (hp) { unpack8(*(const uint4*)(hr - 1536 + c0), ch); unpack8(*(const uint4*)(hr - 1536 + 1024 + c0), cc);
#pragma unroll
            for (int i = 0; i < 8; ++i) u0[i] = cc[i] * ch[i]; }
        else {
#pragma unroll
            for (int i = 0; i < 8; ++i) u0[i] = 0.f; }
        if (hn) { unpack8(*(const uint4*)(hr + 1536 + c0), ch); unpack8(*(const uint4*)(hr + 1536 + 1024 + c0), cc);
#pragma unroll
            for (int i = 0; i < 8; ++i) u2[i] = cc[i] * ch[i]; }
        else {
#pragma unroll
            for (int i = 0; i < 8; ++i) u2[i] = 0.f; }
        float o[8];
#pragma unroll
        for (int i = 0; i < 8; ++i) o[i] = cb[i] * (u0[i] * w0[i] + u1[i] * w1[i] + u2[i] * w2[i]);
        uint4 ov; ov.x = pk_bf16(o[0], o[1]); ov.y = pk_bf16(o[2], o[3]); ov.z = pk_bf16(o[4], o[5]); ov.w = pk_bf16(o[6], o[7]);
        *(uint4*)(CV + (size_t)row * 512 + c0) = ov;
        const bf16_t* hm = Hm + (size_t)row * 672;
        float sq = 0.f, skv = 0.f;
        if (lane < 48) { float f[8]; unpack8(*(const uint4*)(hm + lane * 8), f);
#pragma unroll
            for (int i = 0; i < 8; ++i) sq += f[i] * f[i]; }
        if (lane < 32) { float f[8]; unpack8(*(const uint4*)(hm + 384 + lane * 8), f);
#pragma unroll
            for (int i = 0; i < 8; ++i) skv += f[i] * f[i]; }
        sq = wave_sum(sq); skv = wave_sum(skv);
        if (lane == 0) { RSQ[row] = rsqrtf(sq * (1.0f / 384.0f) + 1e-6f); RSKV[row] = rsqrtf(skv * (1.0f / 256.0f) + 1e-6f); }
        {
            const int j = lane & 31;
            float v = bf1(hm[640 + j]);
            const float other = __shfl_xor(v, 8);
            if (pp >= CTXL) {
                const int tt = pp - CTXL;
                const int pos = (j < 16) ? (tt >> 6) : (tt & 63);
                const float cs = rope[(pos * 8 + (j & 7)) * 2], sn = rope[(pos * 8 + (j & 7)) * 2 + 1];
                v = (j & 8) ? (other * sn + v * cs) : (v * cs - other * sn);
            }
            if (lane < 32) KR[(size_t)row * 32 + j] = (bf16_t)(pk_bf16(v, v) & 0xffffu);
        }
    }
}

__device__ __forceinline__ void p2b_phase(const Params& pin, int l, unsigned char* lds) {
    const Params p = launder(pin); l = launder_i(l); const int tid = ltid();
    const bf16_t* Hm = (const bf16_t*)(p.ws + OFF_R1);
    const bf16_t* W = (const bf16_t*)(p.ws + OFF_W);
    const float* RSQ = (const float*)(p.ws + OFF_RSQ);
    const float* RSKV = (const float*)(p.ws + OFF_RSKV);
    const float* rope = (const float*)(p.ws + OFF_ROPE);
    bf16_t* Q = (bf16_t*)(p.ws + OFF_Q);
    bf16_t* KN = (bf16_t*)(p.ws + OFF_KN);
    bf16_t* VT = (bf16_t*)(p.ws + OFF_VT);
    const int lane = tid & 63, wid = tid >> 6, wr = wid >> 1, wc = wid & 1, fr = lane & 15, fq = lane >> 4;
    const int NQ = 144 * 6, NKV = 144 * 8;
    for (int t = blockIdx.x; t < NQ + NKV; t += gridDim.x) {
        f32x4 acc[4][4]; zero_acc<4>(acc);
        if (t < NQ) {
            int mt, nt; tile_mn(t, 6, mt, nt);
            gemm_mainloop<4, 1>(acc, Hm + (size_t)mt * 256 * 672, 672, 64, W + WO_UQ + (size_t)nt * 128 * 384, 384, 6, lds, tid);
            const int pp0 = (mt % 9) * 256; const bool latent = pp0 >= CTXL;
#pragma unroll
            for (int m = 0; m < 4; ++m) {
                const int lrow = wr * 64 + m * 16 + fr;
                const size_t row = (size_t)mt * 256 + lrow;
                const float sc = RSQ[row] * QSCALE;
                const int tt = pp0 + lrow - CTXL;
                uint2 qpk[4];
#pragma unroll
                for (int n = 0; n < 4; ++n) {
                    const int c16 = nt * 128 + wc * 64 + n * 16, r96 = c16 % 96;
                    float v[4];
#pragma unroll
                    for (int j = 0; j < 4; ++j) v[j] = acc[m][n][j] * sc;
                    if (latent && r96 >= 64) {
                        const int pos = (r96 == 64) ? (tt >> 6) : (tt & 63);
#pragma unroll
                        for (int j = 0; j < 4; ++j) {
                            const float other = __shfl_xor(v[j], 32);
                            const int fi = (fq & 1) * 4 + j;
                            const float cs = rope[(pos * 8 + fi) * 2], sn = rope[(pos * 8 + fi) * 2 + 1];
                            v[j] = (fq & 2) ? (other * sn + v[j] * cs) : (v[j] * cs - other * sn);
                        }
                    }
                    qpk[n].x = pk_bf16(v[0], v[1]); qpk[n].y = pk_bf16(v[2], v[3]);
                }
#pragma unroll
                for (int n = 0; n < 4; n += 2)
                    *(uint4*)(Q + row * 768 + nt * 128 + wc * 64 + (n + (fq & 1)) * 16 + (fq >> 1) * 8) = widen16(qpk[n], qpk[n + 1]);
            }
        } else {
            int mt, nt; tile_mn(t - NQ, 8, mt, nt);
            gemm_mainloop<4, 2>(acc, Hm + (size_t)mt * 256 * 672 + 384, 672, 64, W + WO_UKV + (size_t)nt * 128 * 256, 256, 4, lds, tid);
            const int b = mt / 9, pp0 = (mt % 9) * 256;
            if (wc == 0) {
#pragma unroll
                for (int m = 0; m < 4; ++m) {
                    const size_t row = (size_t)mt * 256 + wr * 64 + m * 16 + fr;
                    const float sc = RSKV[row];
#pragma unroll
                    for (int n = 0; n < 4; n += 2) {
                        uint2 a, b2;
                        a.x = pk_bf16(acc[m][n][0] * sc, acc[m][n][1] * sc); a.y = pk_bf16(acc[m][n][2] * sc, acc[m][n][3] * sc);
                        b2.x = pk_bf16(acc[m][n + 1][0] * sc, acc[m][n + 1][1] * sc); b2.y = pk_bf16(acc[m][n + 1][2] * sc, acc[m][n + 1][3] * sc);
                        *(uint4*)(KN + row * 512 + nt * 64 + (n + (fq & 1)) * 16 + (fq >> 1) * 8) = widen16(a, b2);
                    }
                }
            } else {
#pragma unroll
                for (int m = 0; m < 4; ++m) {
                    const int lrow = wr * 64 + m * 16 + fq * 4;
                    const f32x4 sc = *(const f32x4*)(RSKV + (size_t)mt * 256 + lrow);
#pragma unroll
                    for (int n = 0; n < 4; n += 2) {
                        uint2 a, b2;
                        a.x = pk_bf16(acc[m][n][0] * sc[0], acc[m][n][1] * sc[1]); a.y = pk_bf16(acc[m][n][2] * sc[2], acc[m][n][3] * sc[3]);
                        b2.x = pk_bf16(acc[m][n + 1][0] * sc[0], acc[m][n + 1][1] * sc[1]); b2.y = pk_bf16(acc[m][n + 1][2] * sc[2], acc[m][n + 1][3] * sc[3]);
                        const int dv = (n + (fq & 1)) * 16 + fr;
                        *(uint4*)(VT + ((size_t)(b * 8 + nt) * 64 + dv) * TPB + pp0 + wr * 64 + m * 16 + (fq >> 1) * 8) = widen16(a, b2);
                    }
                }
            }
        }
    }
    {
        const bf16_t* Hr = (const bf16_t*)(p.ws + OFF_R3);
        bf16_t* SG = (bf16_t*)(p.ws + OFF_SG);
        const float* mu = p.rw_mu + (size_t)l * 1920 + 1792;
        for (int i = blockIdx.x * NTHREADS + tid; i < MROWS * 16; i += gridDim.x * NTHREADS) {
            const int row = i >> 4, c0 = (i & 15) * 8, pp = row % TPB;
            const bool hp = (pp != 0 && pp != CTXL), hn = (pp != CTXL - 1 && pp != TPB - 1);
            const bf16_t* hr = Hr + (size_t)row * 1920 + 1792 + c0;
            float cur[8], pv[8], nx[8];
            unpack8(*(const uint4*)hr, cur);
            if (hp) unpack8(*(const uint4*)(hr - 1920), pv); else {
#pragma unroll
                for (int k = 0; k < 8; ++k) pv[k] = 0.f; }
            if (hn) unpack8(*(const uint4*)(hr + 1920), nx); else {
#pragma unroll
                for (int k = 0; k < 8; ++k) nx[k] = 0.f; }
            float o[8];
#pragma unroll
            for (int k = 0; k < 8; ++k) o[k] = sigmoidf_(cur[k] + (0.5f * (pv[k] + nx[k]) - cur[k]) * mu[c0 + k]);
            uint4 ov; ov.x = pk_bf16(o[0], o[1]); ov.y = pk_bf16(o[2], o[3]); ov.z = pk_bf16(o[4], o[5]); ov.w = pk_bf16(o[6], o[7]);
            *(uint4*)(SG + (size_t)row * 128 + c0) = ov;
        }
    }
}

#define FMAC_BC(acc, coef, s, J) asm("v_fmac_f32_dpp %0, %1, %2 row_newbcast:" #J " row_mask:0xf bank_mask:0xf" : "+v"(acc) : "v"(coef), "v"(s))
#define MUL_BC(dst, coef, s, J) asm("v_mul_f32_dpp %0, %1, %2 row_newbcast:" #J " row_mask:0xf bank_mask:0xf" : "=v"(dst) : "v"(coef), "v"(s))
#define REP16(X) X(0, 0) X(1, 1) X(2, 2) X(3, 3) X(4, 0) X(5, 1) X(6, 2) X(7, 3) X(8, 0) X(9, 1) X(10, 2) X(11, 3) X(12, 0) X(13, 1) X(14, 2) X(15, 3)
constexpr int FSTR = 6 * 64 + 4;
constexpr int CHUNK = 32, NCHUNK = TPB / CHUNK;

__device__ __forceinline__ int scan_pos(int z, int s) { return z == 0 ? s : (s < CTXL ? (CTXL - 1 - s) : (TPB + CTXL - 1 - s)); }

__device__ __forceinline__ void shift4(const bf16_t* hr, bool hp, bool hn, int col, const float* mu, float (&o)[4]) {
    const uint2 c = *(const uint2*)(hr + col);
    uint2 a = make_uint2(0u, 0u), b = make_uint2(0u, 0u);
    if (hp) a = *(const uint2*)(hr - 1920 + col);
    if (hn) b = *(const uint2*)(hr + 1920 + col);
    const f32x4 m = *(const f32x4*)(mu + col);
    const float cv[4] = {bf_lo(c.x), bf_hi(c.x), bf_lo(c.y), bf_hi(c.y)};
    const float av[4] = {bf_lo(a.x), bf_hi(a.x), bf_lo(a.y), bf_hi(a.y)};
    const float bv[4] = {bf_lo(b.x), bf_hi(b.x), bf_lo(b.y), bf_hi(b.y)};
#pragma unroll
    for (int i = 0; i < 4; ++i) o[i] = cv[i] + (0.5f * (av[i] + bv[i]) - cv[i]) * m[i];
}
__device__ __forceinline__ void shift8(const bf16_t* hr, bool hp, bool hn, int col, const float* mu, float (&o)[8]) {
    float cv[8], av[8], bv[8];
    unpack8(*(const uint4*)(hr + col), cv);
    if (hp) unpack8(*(const uint4*)(hr - 1920 + col), av); else {
#pragma unroll
        for (int i = 0; i < 8; ++i) av[i] = 0.f; }
    if (hn) unpack8(*(const uint4*)(hr + 1920 + col), bv); else {
#pragma unroll
        for (int i = 0; i < 8; ++i) bv[i] = 0.f; }
#pragma unroll
    for (int i = 0; i < 8; ++i) o[i] = cv[i] + (0.5f * (av[i] + bv[i]) - cv[i]) * mu[col + i];
}
__device__ __forceinline__ bf16x8 pack8(const float (&f)[8]) {
    union { uint4 u; bf16x8 v; } r;
    r.u.x = pk_bf16(f[0], f[1]); r.u.y = pk_bf16(f[2], f[3]); r.u.z = pk_bf16(f[4], f[5]); r.u.w = pk_bf16(f[6], f[7]);
    return r.v;
}

struct ProdState { f32x4 aw[4], aa[4]; };
struct Raw3x2 { uint2 c, a, b; };
__device__ __forceinline__ Raw3x2 ld3x2(const bf16_t* pc, const bf16_t* pa, const bf16_t* pb, bool hp, bool hn, int col) {
    Raw3x2 r; r.c = *(const uint2*)(pc + col); r.a = *(const uint2*)(pa + col); r.b = *(const uint2*)(pb + col);
    if (!hp) r.a = make_uint2(0u, 0u);
    if (!hn) r.b = make_uint2(0u, 0u);
    return r;
}
__device__ __forceinline__ void sh4(const Raw3x2& r, const f32x4 m, float (&o)[4]) {
    const float cv[4] = {bf_lo(r.c.x), bf_hi(r.c.x), bf_lo(r.c.y), bf_hi(r.c.y)};
    const float av[4] = {bf_lo(r.a.x), bf_hi(r.a.x), bf_lo(r.a.y), bf_hi(r.a.y)};
    const float bv[4] = {bf_lo(r.b.x), bf_hi(r.b.x), bf_lo(r.b.y), bf_hi(r.b.y)};
#pragma unroll
    for (int i = 0; i < 4; ++i) o[i] = cv[i] + (0.5f * (av[i] + bv[i]) - cv[i]) * m[i];
}
struct Raw3x4 { uint4 c, a, b; };
__device__ __forceinline__ Raw3x4 ld3x4(const bf16_t* pc, const bf16_t* pa, const bf16_t* pb, bool hp, bool hn, int col) {
    Raw3x4 r; r.c = *(const uint4*)(pc + col); r.a = *(const uint4*)(pa + col); r.b = *(const uint4*)(pb + col);
    if (!hp) r.a = make_uint4(0u, 0u, 0u, 0u);
    if (!hn) r.b = make_uint4(0u, 0u, 0u, 0u);
    return r;
}
__device__ __forceinline__ void sh8(const Raw3x4& r, const float* m, float (&o)[8]) {
    float cv[8], av[8], bv[8];
    unpack8(r.c, cv); unpack8(r.a, av); unpack8(r.b, bv);
    const f32x4 m0 = *(const f32x4*)m, m1 = *(const f32x4*)(m + 4);
#pragma unroll
    for (int i = 0; i < 8; ++i) o[i] = cv[i] + (0.5f * (av[i] + bv[i]) - cv[i]) * (i < 4 ? m0[i] : m1[i - 4]);
}
template <int N0>
__device__ __forceinline__ void scan_produce_elem(const float* pl, int fq, const Raw3x2 (&rr)[2], const Raw3x2 (&rk)[2], const Raw3x2 (&rv)[2],
                                                  const f32x4 (&aw)[2], const f32x4 (&aa)[2], float& ss, float* frow) {
#pragma unroll
    for (int nn = 0; nn < 2; ++nn) {
        const int n = N0 + nn;
        const int c4 = n * 16 + fq * 4;
        float r4[4], k4[4], v4[4];
        sh4(rr[nn], *(const f32x4*)(pl + 0 * 64 + c4), r4);
        sh4(rk[nn], *(const f32x4*)(pl + 1 * 64 + c4), k4);
        sh4(rv[nn], *(const f32x4*)(pl + 2 * 64 + c4), v4);
        const f32x4 w0 = *(const f32x4*)(pl + 3 * 64 + c4);
        const f32x4 a0 = *(const f32x4*)(pl + 4 * 64 + c4);
        const f32x4 kkp = *(const f32x4*)(pl + 5 * 64 + c4);
        const f32x4 kap = *(const f32x4*)(pl + 6 * 64 + c4);
        f32x4 dw, kd, kf4, a4;
#pragma unroll
        for (int j = 0; j < 4; ++j) {
            const float sgx = __builtin_amdgcn_rcpf(1.0f + fexp(-(aw[nn][j] + w0[j])));
            dw[j] = fexp(-0.6065306597126334f * sgx);
            const float a = __builtin_amdgcn_rcpf(1.0f + fexp(-(aa[nn][j] + a0[j])));
            a4[j] = a;
            const float kf = k4[j] * kkp[j];
            kf4[j] = kf; ss += kf * kf;
            kd[j] = k4[j] * (1.0f + (a - 1.0f) * kap[j]);
        }
        *(f32x4*)(frow + 0 * 64 + c4) = kf4;
        *(f32x4*)(frow + 1 * 64 + c4) = dw;
        *(f32x4*)(frow + 2 * 64 + c4) = a4;
        *(f32x4*)(frow + 3 * 64 + c4) = kd;
        *(f32x4*)(frow + 4 * 64 + c4) = (f32x4){r4[0], r4[1], r4[2], r4[3]};
        *(f32x4*)(frow + 5 * 64 + c4) = (f32x4){v4[0], v4[1], v4[2], v4[3]};
    }
}
__device__ __forceinline__ void scan_produce_A(const Params& p, const float* pl, int b, int h, int z, int s0, float* frow0, int lane, ProdState& st) {
    const int fr = lane & 15, fq = lane >> 4;
    const int pp = scan_pos(z, s0 + fr);
    const bool hp = (pp != 0 && pp != CTXL), hn = (pp != CTXL - 1 && pp != TPB - 1);
    const bf16_t* hr = (const bf16_t*)(p.ws + OFF_R3) + ((size_t)b * TPB + pp) * 1920;
    const bf16_t* W = (const bf16_t*)(p.ws + OFF_W);
    Raw3x4 qw[2], qa[2];
    const bf16_t* pc = hr + z * 64 + fq * 8; const bf16_t* pa = hp ? pc - 1920 : pc; const bf16_t* pb = hn ? pc + 1920 : pc;
#pragma unroll
    for (int ks = 0; ks < 2; ++ks) { qw[ks] = ld3x4(pc, pa, pb, hp, hn, 1536 + ks * 32); qa[ks] = ld3x4(pc, pa, pb, hp, hn, 1664 + ks * 32); }
    f32x4 accw[4], acca[4];
#pragma unroll
    for (int n = 0; n < 4; ++n) { accw[n] = (f32x4){0.f, 0.f, 0.f, 0.f}; acca[n] = (f32x4){0.f, 0.f, 0.f, 0.f}; }
#pragma unroll
    for (int ks = 0; ks < 2; ++ks) {
        bf16x8 bw[4], ba[4];
#pragma unroll
        for (int n = 0; n < 4; ++n) {
            const size_t wo = ((size_t)z * 512 + h * 64 + n * 16 + fr) * 64 + ks * 32 + fq * 8;
            bw[n] = *(const bf16x8*)(W + WO_UP + wo); ba[n] = *(const bf16x8*)(W + WO_AUP + wo);
        }
        float t8[8];
        sh8(qw[ks], pl + 7 * 64 + ks * 32 + fq * 8, t8);
#pragma unroll
        for (int i = 0; i < 8; ++i) { const float e = fexp(2.0f * t8[i]); t8[i] = 1.0f - 2.0f * __builtin_amdgcn_rcpf(e + 1.0f); }
        const bf16x8 aw = pack8(t8);
        sh8(qa[ks], pl + 8 * 64 + ks * 32 + fq * 8, t8);
        const bf16x8 aa = pack8(t8);
#pragma unroll
        for (int n = 0; n < 4; ++n) {
            accw[n] = __builtin_amdgcn_mfma_f32_16x16x32_bf16(bw[n], aw, accw[n], 0, 0, 0);
            acca[n] = __builtin_amdgcn_mfma_f32_16x16x32_bf16(ba[n], aa, acca[n], 0, 0, 0);
        }
    }
#pragma unroll
    for (int n = 0; n < 4; ++n) { st.aw[n] = accw[n]; st.aa[n] = acca[n]; }
}
__device__ __forceinline__ void scan_produce_B(const Params& p, const float* pl, int b, int h, int z, int s0, float* frow0, int lane, const ProdState& st) {
    const int fr = lane & 15, fq = lane >> 4;
    const int pp = scan_pos(z, s0 + fr);
    const bool hp = (pp != 0 && pp != CTXL), hn = (pp != CTXL - 1 && pp != TPB - 1);
    const bf16_t* hr = (const bf16_t*)(p.ws + OFF_R3) + ((size_t)b * TPB + pp) * 1920;
    Raw3x2 rr0[2], rk0[2], rv0[2], rr1[2], rk1[2], rv1[2];
    const bf16_t* pc = hr + h * 64 + fq * 4; const bf16_t* pa = hp ? pc - 1920 : pc; const bf16_t* pb = hn ? pc + 1920 : pc;
#pragma unroll
    for (int nn = 0; nn < 2; ++nn) {
        const int C4 = nn * 16, C5 = C4 + 32;
        rr0[nn] = ld3x2(pc, pa, pb, hp, hn, C4); rk0[nn] = ld3x2(pc, pa, pb, hp, hn, 512 + C4); rv0[nn] = ld3x2(pc, pa, pb, hp, hn, 1024 + C4);
        rr1[nn] = ld3x2(pc, pa, pb, hp, hn, C5); rk1[nn] = ld3x2(pc, pa, pb, hp, hn, 512 + C5); rv1[nn] = ld3x2(pc, pa, pb, hp, hn, 1024 + C5);
    }
    float ss = 0.f;
    float* frow = frow0 + fr * FSTR;
    const f32x4 w01[2] = {st.aw[0], st.aw[1]}, a01[2] = {st.aa[0], st.aa[1]}, w23[2] = {st.aw[2], st.aw[3]}, a23[2] = {st.aa[2], st.aa[3]};
    scan_produce_elem<0>(pl, fq, rr0, rk0, rv0, w01, a01, ss, frow);
    scan_produce_elem<2>(pl, fq, rr1, rk1, rv1, w23, a23, ss, frow);
    ss = fqsum(ss);
    const float inv = rsqrtf(fmaxf(ss, 1e-24f));
#pragma unroll
    for (int n = 0; n < 4; ++n) {
        const int c4 = n * 16 + fq * 4;
        f32x4 kk = *(const f32x4*)(frow + 0 * 64 + c4);
        f32x4 bb = *(const f32x4*)(frow + 2 * 64 + c4);
#pragma unroll
        for (int j = 0; j < 4; ++j) { kk[j] = kk[j] * inv; bb[j] = kk[j] * bb[j]; }
        *(f32x4*)(frow + 0 * 64 + c4) = kk;
        *(f32x4*)(frow + 2 * 64 + c4) = bb;
    }
}

typedef float f32x2 __attribute__((ext_vector_type(2)));
struct ScanHead { f32x4 kk[2]; f32x2 v; };
struct ScanBody { f32x4 w[2], bb[2], kd[2], r[2]; };
__device__ __forceinline__ void scan_ldh(ScanHead& c, const float* f, const float* fv) {
#pragma unroll
    for (int q = 0; q < 2; ++q) c.kk[q] = *(const f32x4*)(f + 0 * 64 + 4 * q);
    c.v = *(const f32x2*)fv;
}
__device__ __forceinline__ void scan_ldb(ScanBody& c, const float* f) {
#pragma unroll
    for (int q = 0; q < 2; ++q) {
        c.w[q] = *(const f32x4*)(f + 1 * 64 + 4 * q); c.bb[q] = *(const f32x4*)(f + 2 * 64 + 4 * q);
        c.kd[q] = *(const f32x4*)(f + 3 * 64 + 4 * q); c.r[q] = *(const f32x4*)(f + 4 * 64 + 4 * q);
    }
}
__device__ __forceinline__ void scan_unit(const Params& p, int l, int u, unsigned char* lds) {
    const int tid = ltid(), wid = __builtin_amdgcn_readfirstlane(tid >> 6), lane = tid & 63;
    const int b = u >> 4, h = (u >> 1) & 7, z = u & 1;
    float* fb = (float*)lds;
    bf16_t* Y = (bf16_t*)(p.ws + (z == 0 ? OFF_YF : OFF_YB));
    float* pl = fb + 3 * CHUNK * FSTR;
    for (int i = tid; i < 9 * 64; i += NTHREADS) {
        const int a = i >> 6, c = i & 63, C = h * 64 + c;
        float v;
        if (a < 3) v = p.rw_mu[(size_t)l * 1920 + a * 512 + C];
        else if (a == 3) v = p.rw_w0[((size_t)l * 2 + z) * 512 + C];
        else if (a == 4) v = p.rw_a0[((size_t)l * 2 + z) * 512 + C];
        else if (a == 5) v = p.rw_k_k[(size_t)l * 512 + C];
        else if (a == 6) v = p.rw_k_a[(size_t)l * 512 + C];
        else if (a == 7) v = p.rw_mu[(size_t)l * 1920 + 1536 + z * 64 + c];
        else v = p.rw_mu[(size_t)l * 1920 + 1664 + z * 64 + c];
        pl[i] = v;
    }
    __syncthreads();
    if (wid < 4) {
        f32x2 S2[8];
#pragma unroll
        for (int j = 0; j < 8; ++j) S2[j] = (f32x2){0.f, 0.f};
        __syncthreads();
        for (int c = 0; c < NCHUNK; ++c) {
            const float* fbc = fb + (c % 3) * CHUNK * FSTR + 8 * (lane & 7);
            const float* fbv = fb + (c % 3) * CHUNK * FSTR + 320 + 16 * wid + 2 * (lane >> 3);
            bf16_t* yp = Y + ((size_t)b * TPB) * 512 + h * 64 + 16 * wid + 2 * (lane >> 3);
            ScanHead ha, hb;
            scan_ldh(ha, fbc, fbv);
#define SCAN_STEP(HC, HN, SL) { \
                ScanBody bd; scan_ldb(bd, fbc + (SL) * FSTR); \
                if ((SL) + 1 < CHUNK) scan_ldh(HN, fbc + ((SL) + 1) * FSTR, fbv + ((SL) + 1) * FSTR); \
                f32x2 d0 = (f32x2){0.f, 0.f}, d1 = (f32x2){0.f, 0.f}; \
                _Pragma("unroll") for (int q = 0; q < 4; ++q) { const f32x2 k2 = (f32x2){HC.kk[q >> 1][2 * (q & 1)], HC.kk[q >> 1][2 * (q & 1) + 1]}; \
                    d0 = __builtin_elementwise_fma(S2[q], k2, d0); d1 = __builtin_elementwise_fma(S2[4 + q], k2, d1); } \
                const float sk0 = red8(d0[0] + d0[1]), sk1 = red8(d1[0] + d1[1]); \
                const f32x2 n0 = (f32x2){-sk0, -sk0}, n1 = (f32x2){-sk1, -sk1}, v0 = (f32x2){HC.v[0], HC.v[0]}, v1 = (f32x2){HC.v[1], HC.v[1]}; \
                f32x2 y0 = (f32x2){0.f, 0.f}, y1 = (f32x2){0.f, 0.f}; \
                _Pragma("unroll") for (int q = 0; q < 4; ++q) { \
                    const f32x2 w2 = (f32x2){bd.w[q >> 1][2 * (q & 1)], bd.w[q >> 1][2 * (q & 1) + 1]}, b2 = (f32x2){bd.bb[q >> 1][2 * (q & 1)], bd.bb[q >> 1][2 * (q & 1) + 1]}; \
                    const f32x2 kd2 = (f32x2){bd.kd[q >> 1][2 * (q & 1)], bd.kd[q >> 1][2 * (q & 1) + 1]}, r2 = (f32x2){bd.r[q >> 1][2 * (q & 1)], bd.r[q >> 1][2 * (q & 1) + 1]}; \
                    f32x2 t0 = S2[q] * w2; t0 = __builtin_elementwise_fma(b2, n0, t0); t0 = __builtin_elementwise_fma(kd2, v0, t0); \
                    f32x2 t1 = S2[4 + q] * w2; t1 = __builtin_elementwise_fma(b2, n1, t1); t1 = __builtin_elementwise_fma(kd2, v1, t1); \
                    S2[q] = t0; S2[4 + q] = t1; \
                    y0 = __builtin_elementwise_fma(t0, r2, y0); y1 = __builtin_elementwise_fma(t1, r2, y1); } \
                const float ya = red8(y0[0] + y0[1]), yb = red8(y1[0] + y1[1]); \
                const int pp = scan_pos(z, c * CHUNK + (SL)); \
                if ((lane & 7) == 0) *(unsigned*)(yp + (size_t)pp * 512) = pk_bf16(ya, yb); }
#pragma unroll 1
            for (int sl = 0; sl < CHUNK; sl += 2) {
                SCAN_STEP(ha, hb, sl)
                SCAN_STEP(hb, ha, sl + 1)
            }
            __syncthreads();
        }
    } else {
        ProdState st;
#pragma unroll
        for (int n = 0; n < 4; ++n) { st.aw[n] = (f32x4){0.f, 0.f, 0.f, 0.f}; st.aa[n] = (f32x4){0.f, 0.f, 0.f, 0.f}; }
        const int nrep = launder_i(1 + ((PROBE_MASK >> 10) & 1));
        const int pair = (wid - 4) >> 1, ph = (wid - 4) & 1;
        {
            float* f0 = fb + (pair % 3) * CHUNK * FSTR + ph * 16 * FSTR;
            scan_produce_A(p, pl, b, h, z, pair * CHUNK + ph * 16, f0, lane, st);
            if (pair == 0) scan_produce_B(p, pl, b, h, z, ph * 16, f0, lane, st);
        }
        __syncthreads();
        for (int c = 0; c < NCHUNK; ++c) {
            for (int rr_ = 0; rr_ < nrep; ++rr_) {
            if (pair == ((c + 1) & 1)) {
                if (c + 1 < NCHUNK) scan_produce_B(p, pl, b, h, z, (c + 1) * CHUNK + ph * 16, fb + ((c + 1) % 3) * CHUNK * FSTR + ph * 16 * FSTR, lane, st);
            } else {
                if (c + 2 < NCHUNK) scan_produce_A(p, pl, b, h, z, (c + 2) * CHUNK + ph * 16, fb + ((c + 2) % 3) * CHUNK * FSTR + ph * 16 * FSTR, lane, st);
            }
            }
            __syncthreads();
        }
    }
}

constexpr int ATT_STAGE = 20480;
__device__ __forceinline__ void attn_unit(const Params& p, int b, int h, int q0, int nkeys, unsigned char* lds, int do_write) {
    const int tid = ltid(), wid = __builtin_amdgcn_readfirstlane(tid >> 6), lane = tid & 63, fr = lane & 15, fq = lane >> 4;
    bf16_t* Q = (bf16_t*)(p.ws + OFF_Q);
    const bf16_t* KN = (const bf16_t*)(p.ws + OFF_KN);
    const bf16_t* KR = (const bf16_t*)(p.ws + OFF_KR);
    const bf16_t* VT = (const bf16_t*)(p.ws + OFF_VT);
    const size_t rb = (size_t)b * TPB;
    bf16x8 qf[2][3];
#pragma unroll
    for (int nq = 0; nq < 2; ++nq)
#pragma unroll
        for (int ks = 0; ks < 3; ++ks) qf[nq][ks] = *(const bf16x8*)(Q + (rb + q0 + wid * 32 + nq * 16 + fr) * 768 + h * 96 + ks * 32 + fq * 8);
    f32x4 oacc[4][2];
#pragma unroll
    for (int mt = 0; mt < 4; ++mt)
#pragma unroll
        for (int nq = 0; nq < 2; ++nq) oacc[mt][nq] = (f32x4){0.f, 0.f, 0.f, 0.f};
    float mrun[2] = {0.f, 0.f}, lsum[2] = {0.f, 0.f};
    const int c8 = (lane & 7) ^ ((4 * wid + (lane >> 4)) & 7);
    const bf16_t* knp = KN + (rb + 8 * wid + (lane >> 3)) * 512 + h * 64 + c8 * 8;
    const bf16_t* vtp = VT + ((size_t)(b * 8 + h) * 64 + 8 * wid + (lane >> 3)) * TPB + c8 * 8;
    const int c4 = (lane & 3) ^ ((lane >> 4) & 3);
    const bf16_t* krp = KR + (rb + 16 * (wid & 3) + (lane >> 2)) * 32 + c4 * 8;
    auto issue = [&](int t, int stg) {
        unsigned char* base = lds + stg * ATT_STAGE;
        const int k0 = t * 64;
        __builtin_amdgcn_global_load_lds((const GLB_AS unsigned*)(knp + (size_t)k0 * 512), (LDS_AS unsigned*)(base + wid * 1024), 16, 0, 0);
        __builtin_amdgcn_global_load_lds((const GLB_AS unsigned*)(vtp + k0), (LDS_AS unsigned*)(base + 12288 + wid * 1024), 16, 0, 0);
        if (wid < 4) __builtin_amdgcn_global_load_lds((const GLB_AS unsigned*)(krp + (size_t)k0 * 32), (LDS_AS unsigned*)(base + 8192 + wid * 1024), 16, 0, 0);
    };
    const int ntile = nkeys / 64;
    const int kz = fr >> 1, rz = (fr >> 2) & 3;
    issue(0, 0);
    asm volatile("s_waitcnt vmcnt(0)" ::: "memory");
    __builtin_amdgcn_s_barrier();
    asm volatile("" ::: "memory");
    for (int t = 0; t < ntile; ++t) {
        if (t + 1 < ntile) issue(t + 1, (t + 1) & 1);
        const unsigned char* Ks = lds + (t & 1) * ATT_STAGE;
        const unsigned char* Rs = Ks + 8192;
        const unsigned char* Vs = Ks + 12288;
        f32x4 sacc[4][2];
#pragma unroll
        for (int km = 0; km < 4; ++km)
#pragma unroll
            for (int nq = 0; nq < 2; ++nq) sacc[km][nq] = (f32x4){-mrun[nq], -mrun[nq], -mrun[nq], -mrun[nq]};
#pragma unroll
        for (int ks = 0; ks < 3; ++ks)
#pragma unroll
            for (int km = 0; km < 4; ++km) {
                const bf16x8 kf = ks < 2 ? *(const bf16x8*)(Ks + (km * 16 + fr) * 128 + (((ks * 4 + fq) ^ kz) * 16))
                                         : *(const bf16x8*)(Rs + (km * 16 + fr) * 64 + ((fq ^ rz) * 16));
#pragma unroll
                for (int nq = 0; nq < 2; ++nq) sacc[km][nq] = __builtin_amdgcn_mfma_f32_16x16x32_bf16(kf, qf[nq][ks], sacc[km][nq], 0, 0, 0);
            }
        float delta[2];
#pragma unroll
        for (int nq = 0; nq < 2; ++nq) {
            float mx = -1e30f;
#pragma unroll
            for (int km = 0; km < 4; ++km)
#pragma unroll
                for (int j = 0; j < 4; ++j) mx = fmaxf(mx, sacc[km][nq][j]);
            mx = fqmax(mx);
            delta[nq] = (t == 0) ? mx : fmaxf(mx, 0.f);
        }
        const bool exact = (t == 0) || (__builtin_amdgcn_ballot_w64(fmaxf(delta[0], delta[1]) > 60.0f) != 0ull);
        bf16x8 pf[2][2];
        float psum[2];
#pragma unroll
        for (int nq = 0; nq < 2; ++nq) {
            float ps = 0.f;
            if (exact) {
#pragma unroll
                for (int km = 0; km < 4; ++km)
#pragma unroll
                    for (int j = 0; j < 4; ++j) { const float e = __builtin_amdgcn_exp2f(sacc[km][nq][j] - delta[nq]); sacc[km][nq][j] = e; ps += e; }
            } else {
#pragma unroll
                for (int km = 0; km < 4; ++km)
#pragma unroll
                    for (int j = 0; j < 4; ++j) { const float e = __builtin_amdgcn_exp2f(sacc[km][nq][j]); sacc[km][nq][j] = e; ps += e; }
            }
            psum[nq] = ps;
#pragma unroll
            for (int kc = 0; kc < 2; ++kc) {
                union { uint4 u; bf16x8 v; } r;
                r.u.x = pk_bf16(sacc[2 * kc][nq][0], sacc[2 * kc][nq][1]); r.u.y = pk_bf16(sacc[2 * kc][nq][2], sacc[2 * kc][nq][3]);
                r.u.z = pk_bf16(sacc[2 * kc + 1][nq][0], sacc[2 * kc + 1][nq][1]); r.u.w = pk_bf16(sacc[2 * kc + 1][nq][2], sacc[2 * kc + 1][nq][3]);
                pf[kc][nq] = r.v;
            }
        }
        if (exact) {
#pragma unroll
            for (int nq = 0; nq < 2; ++nq) {
                const float alpha = (t == 0) ? 1.0f : __builtin_amdgcn_exp2f(-delta[nq]);
                lsum[nq] = lsum[nq] * alpha + psum[nq];
#pragma unroll
                for (int mt = 0; mt < 4; ++mt) oacc[mt][nq] = oacc[mt][nq] * alpha;
            }
        }
#pragma unroll
        for (int mt = 0; mt < 4; ++mt)
#pragma unroll
            for (int kc = 0; kc < 2; ++kc) {
                union { uint2 h2[2]; bf16x8 v; } r;
                const unsigned char* vrow = Vs + (mt * 16 + fr) * 128 + (fq & 1) * 8;
                r.h2[0] = *(const uint2*)(vrow + (((4 * kc + (fq >> 1)) ^ kz) * 16));
                r.h2[1] = *(const uint2*)(vrow + (((4 * kc + 2 + (fq >> 1)) ^ kz) * 16));
#pragma unroll
                for (int nq = 0; nq < 2; ++nq) oacc[mt][nq] = __builtin_amdgcn_mfma_f32_16x16x32_bf16(r.v, pf[kc][nq], oacc[mt][nq], 0, 0, 0);
            }
        if (!exact) {
#pragma unroll
            for (int nq = 0; nq < 2; ++nq) {
                const float alpha = __builtin_amdgcn_exp2f(-delta[nq]);
                lsum[nq] = (lsum[nq] + psum[nq]) * alpha;
#pragma unroll
                for (int mt = 0; mt < 4; ++mt) oacc[mt][nq] = oacc[mt][nq] * alpha;
            }
        }
#pragma unroll
        for (int nq = 0; nq < 2; ++nq) mrun[nq] += delta[nq];
        asm volatile("s_waitcnt vmcnt(0) lgkmcnt(0)" ::: "memory");
        __builtin_amdgcn_s_barrier();
        asm volatile("" ::: "memory");
    }
#pragma unroll
    for (int nq = 0; nq < 2; ++nq) {
        const float inv = 1.0f / fqsum(lsum[nq]);
        bf16_t* orow = Q + (rb + q0 + wid * 32 + nq * 16 + fr) * 768 + h * 96;
#pragma unroll
        for (int mt = 0; mt < 4; mt += 2) {
            uint2 a, b2;
            a.x = pk_bf16(oacc[mt][nq][0] * inv, oacc[mt][nq][1] * inv); a.y = pk_bf16(oacc[mt][nq][2] * inv, oacc[mt][nq][3] * inv);
            b2.x = pk_bf16(oacc[mt + 1][nq][0] * inv, oacc[mt + 1][nq][1] * inv); b2.y = pk_bf16(oacc[mt + 1][nq][2] * inv, oacc[mt + 1][nq][3] * inv);
            const uint4 w = widen16(a, b2);
            if (do_write) *(uint4*)(orow + (mt + (fq & 1)) * 16 + (fq >> 1) * 8) = w;
        }
    }
}

__device__ __forceinline__ void p3_phase(const Params& pin, int l, unsigned char* lds) {
    const Params p = launder(pin); l = launder_i(l);
    for (int r = 0, nr = launder_i(1 + ((PROBE_MASK >> 1) & 1)); r < nr; ++r)
        for (int u = blockIdx.x; u < 256; u += gridDim.x) scan_unit(p, l, u, lds);
    const int nunits = (l == DEPTH - 1) ? 1024 : 1152;
    for (int r = launder_i(((PROBE_MASK >> 9) & 1) ? 0 : 1); r < 2; ++r)
    for (int u = blockIdx.x; u < nunits; u += gridDim.x) {
        if (u < 1024) { const int bh = u >> 3, qt = u & 7; attn_unit(p, bh >> 3, bh & 7, CTXL + qt * 256, TPB, lds, r); }
        else { const int bh = u - 1024; attn_unit(p, bh >> 3, bh & 7, 0, CTXL, lds, r); }
    }
}

__device__ __forceinline__ void p35_phase(const Params& pin, int l, bool skip_ctx, unsigned char* lds) {
    const Params p = launder(pin); l = launder_i(l); const int tid = ltid();
    const bf16_t* SG = (const bf16_t*)(p.ws + OFF_SG);
    const bf16_t* W = (const bf16_t*)(p.ws + OFF_W) + WO_GUP;
    const bf16_t* YF = (const bf16_t*)(p.ws + OFF_YF);
    const bf16_t* YB = (const bf16_t*)(p.ws + OFF_YB);
    const bf16_t* Hr = (const bf16_t*)(p.ws + OFF_R3);
    bf16_t* RWO = (bf16_t*)(p.ws + OFF_RWO);
    const float* mu = p.rw_mu + (size_t)l * 1920;
    const int lane = tid & 63, wid = tid >> 6, wr = wid >> 1, wc = wid & 1, fr = lane & 15, fq = lane >> 4;
    float* gt = (float*)lds;
    constexpr int GP = 132;
    for (int t = blockIdx.x; t < 288 * 4; t += gridDim.x) {
        int mt, nt; tile_mn(t, 4, mt, nt);
        if (skip_ctx && (mt % 18) < 2) continue;
        f32x4 acc[2][4]; zero_acc<2>(acc);
        gemm_mainloop<2, 1>(acc, SG + (size_t)mt * 128 * 128, 128, 64, W + (size_t)nt * 128 * 128, 128, 2, lds, tid);
#pragma unroll
        for (int m = 0; m < 2; ++m)
#pragma unroll
            for (int n = 0; n < 4; ++n) *(f32x4*)(gt + (wr * 32 + m * 16 + fr) * GP + wc * 64 + n * 16 + fq * 4) = acc[m][n];
        __syncthreads();
        const int pp0 = (mt % 18) * 128;
#pragma unroll 1
        for (int it = 0; it < 4; ++it) {
            const int item = tid + it * NTHREADS, lrow = item >> 4, cg = item & 15, pp = pp0 + lrow;
            const size_t row = (size_t)mt * 128 + lrow;
            const int C = nt * 128 + cg * 8;
            const bool hp = (pp != 0 && pp != CTXL), hn = (pp != CTXL - 1 && pp != TPB - 1);
            const bf16_t* hr = Hr + row * 1920;
            float yf[8], yb[8], r8[8], k8[8], v8[8];
            unpack8(*(const uint4*)(YF + row * 512 + C), yf); unpack8(*(const uint4*)(YB + row * 512 + C), yb);
            shift8(hr, hp, hn, C, mu, r8); shift8(hr, hp, hn, 512 + C, mu, k8); shift8(hr, hp, hn, 1024 + C, mu, v8);
            const float* rkp = p.rw_r_k + (size_t)l * 512 + C;
            float s1 = 0.f, bs = 0.f;
#pragma unroll
            for (int i = 0; i < 8; ++i) { yf[i] += yb[i]; s1 += yf[i]; bs += r8[i] * k8[i] * rkp[i]; }
            s1 = red8(s1); bs = red8(bs);
            const float mean = s1 * (1.0f / 64.0f);
            float s2 = 0.f;
#pragma unroll
            for (int i = 0; i < 8; ++i) { const float d = yf[i] - mean; s2 += d * d; }
            s2 = red8(s2);
            const float rstd = rsqrtf(s2 * (1.0f / 64.0f) + 64e-5f);
            const float* ggp = p.rw_gn_g + (size_t)l * 512 + C; const float* gbp = p.rw_gn_b + (size_t)l * 512 + C;
            const f32x4 g0 = *(const f32x4*)(gt + lrow * GP + cg * 8), g1 = *(const f32x4*)(gt + lrow * GP + cg * 8 + 4);
            float o[8];
#pragma unroll
            for (int i = 0; i < 8; ++i) o[i] = ((yf[i] - mean) * rstd * ggp[i] + gbp[i] + bs * v8[i]) * (i < 4 ? g0[i] : g1[i - 4]);
            uint4 ov; ov.x = pk_bf16(o[0], o[1]); ov.y = pk_bf16(o[2], o[3]); ov.z = pk_bf16(o[4], o[5]); ov.w = pk_bf16(o[6], o[7]);
            *(uint4*)(RWO + row * 512 + C) = ov;
        }
        __syncthreads();
    }
}

__device__ __forceinline__ void p4_phase(const Params& pin, bool skip_ctx, unsigned char* lds) {
    const Params p = launder(pin); const int tid = ltid();
    const bf16_t* XM = (const bf16_t*)(p.ws + OFF_R6);
    const bf16_t* W = (const bf16_t*)(p.ws + OFF_W);
    bf16_t* MG = (bf16_t*)(p.ws + OFF_MRG);
    const int lane = tid & 63, wid = tid >> 6, wr = wid >> 1, wc = wid & 1, fr = lane & 15, fq = lane >> 4;
    for (int t = blockIdx.x; t < 288 * 8; t += gridDim.x) {
        int mt, nt; tile_mn(t, 8, mt, nt);
        if (skip_ctx && (mt % 18) < 2) continue;
        f32x4 g[3][2][4];
#pragma unroll
        for (int i = 0; i < 3; ++i) zero_acc<2>(g[i]);
        gemm_gate3(g, XM + (size_t)mt * 128 * 1024, W + WO_IN + (size_t)(4224 + nt * 128) * 1024, 16, lds, tid);
        typedef __fp16 h16x2 __attribute__((ext_vector_type(2)));
        h16x2 gp[3][2][4][2];
#pragma unroll
        for (int i = 0; i < 3; ++i)
#pragma unroll
            for (int m = 0; m < 2; ++m)
#pragma unroll
                for (int n = 0; n < 4; ++n) {
                    gp[i][m][n][0] = __builtin_amdgcn_cvt_pkrtz(sigmoidf_(g[i][m][n][0]), sigmoidf_(g[i][m][n][1]));
                    gp[i][m][n][1] = __builtin_amdgcn_cvt_pkrtz(sigmoidf_(g[i][m][n][2]), sigmoidf_(g[i][m][n][3]));
                }
        f32x4 mg[2][4]; zero_acc<2>(mg);
#pragma unroll 1
        for (int i = 0; i < 3; ++i) {
            const bf16_t* Ab; int lda, kst; const bf16_t* Wb;
            if (i == 0) { Ab = (const bf16_t*)(p.ws + OFF_Q); lda = 768; kst = 96; Wb = W + WO_OA; }
            else if (i == 1) { Ab = (const bf16_t*)(p.ws + OFF_R5); lda = 512; kst = 64; Wb = W + WO_OC; }
            else { Ab = (const bf16_t*)(p.ws + OFF_RWO); lda = 512; kst = 64; Wb = W + WO_OR; }
            f32x4 a[2][4]; zero_acc<2>(a);
            gemm_mainloop<2, 1>(a, Ab + (size_t)mt * 128 * lda, lda, kst, Wb + (size_t)nt * 128 * 512, 512, 8, lds, tid);
#pragma unroll
            for (int m = 0; m < 2; ++m)
#pragma unroll
                for (int n = 0; n < 4; ++n) {
                    const h16x2 g0 = i == 0 ? gp[0][m][n][0] : (i == 1 ? gp[1][m][n][0] : gp[2][m][n][0]);
                    const h16x2 g1 = i == 0 ? gp[0][m][n][1] : (i == 1 ? gp[1][m][n][1] : gp[2][m][n][1]);
                    mg[m][n][0] += (float)g0[0] * a[m][n][0]; mg[m][n][1] += (float)g0[1] * a[m][n][1];
                    mg[m][n][2] += (float)g1[0] * a[m][n][2]; mg[m][n][3] += (float)g1[1] * a[m][n][3];
                }
        }
#pragma unroll
        for (int m = 0; m < 2; ++m) {
            const size_t row = (size_t)mt * 128 + wr * 32 + m * 16 + fr;
#pragma unroll
            for (int n = 0; n < 4; n += 2) {
                uint2 a, b2;
                a.x = pk_bf16(mg[m][n][0], mg[m][n][1]); a.y = pk_bf16(mg[m][n][2], mg[m][n][3]);
                b2.x = pk_bf16(mg[m][n + 1][0], mg[m][n + 1][1]); b2.y = pk_bf16(mg[m][n + 1][2], mg[m][n + 1][3]);
                *(uint4*)(MG + row * 1024 + nt * 128 + wc * 64 + (n + (fq & 1)) * 16 + (fq >> 1) * 8) = widen16(a, b2);
            }
        }
    }
}

template <int MT>
__device__ __forceinline__ void resid_tile(const Params& p, int l, const bf16_t* A, int lda, int nk, const bf16_t* Wt, int ldb, int goff, bool x_from_input,
                                           const float* lng, const float* lnb, int row0, int nt, unsigned char* lds, int tid) {
    const int lane = tid & 63, wid = tid >> 6, wr = wid >> 1, wc = wid & 1, fr = lane & 15, fq = lane >> 4;
    f32x4 acc[MT][4]; zero_acc<MT>(acc);
    gemm_mainloop<MT, 1>(acc, A + (size_t)row0 * lda, lda, 64, Wt + (size_t)nt * 128 * ldb, ldb, nk, lds, tid);
    const int b = row0 / TPB, pp0 = row0 % TPB;
    const float* gv = modv_ptr(p, l, b, pp0) + goff;
    const float* stats = (const float*)(p.ws + OFF_STATS);
#pragma unroll
    for (int m = 0; m < MT; ++m) {
        const int lr = wr * 16 * MT + m * 16 + fr, pp = pp0 + lr;
        const float* xi = x_rd(p, x_from_input, b, pp);
        float* xo = x_wr(p, b, pp);
        float mean = 0.f, rstd = 1.f;
        if (!x_from_input) { const size_t row = (size_t)row0 + lr; mean = stats[row * 2]; rstd = stats[row * 2 + 1]; }
#pragma unroll
        for (int n = 0; n < 4; ++n) {
            const int col = nt * 128 + wc * 64 + n * 16 + fq * 4;
            f32x4 xv = *(const f32x4*)(xi + col); const f32x4 g4 = *(const f32x4*)(gv + col);
            if (!x_from_input) {
                const f32x4 lg = *(const f32x4*)(lng + col), lb = *(const f32x4*)(lnb + col);
#pragma unroll
                for (int j = 0; j < 4; ++j) xv[j] = (xv[j] - mean) * rstd * lg[j] + lb[j];
            }
            f32x4 o;
#pragma unroll
            for (int j = 0; j < 4; ++j) o[j] = ALPHA * xv[j] + g4[j] * acc[m][n][j];
            *(f32x4*)(xo + col) = o;
        }
    }
}
__device__ __forceinline__ void resid_tile256(const Params& p, int l, const bf16_t* A, int lda, int nk, const bf16_t* Wt, int ldb, int goff, bool x_from_input,
                                              const float* lng, const float* lnb, int row0, int nt256, unsigned char* lds, int tid) {
    const int lane = tid & 63, wid = tid >> 6, wr = wid >> 2, wc = wid & 3, fr = lane & 15, fq = lane >> 4;
    f32x4 acc[8][4]; zero_acc<8>(acc);
    Seg sg; sg.A = A + (size_t)row0 * lda; sg.Bt = Wt + (size_t)nt256 * 256 * ldb; sg.lda = lda; sg.a_kstep = 64; sg.ldb = ldb; sg.nk = nk;
    int st = 0;
    gemm_stream256(acc, sg, sg, false, true, st, lds, tid);
    const int b = row0 / TPB, pp0 = row0 % TPB;
    const float* gv = modv_ptr(p, l, b, pp0) + goff;
    const float* stats = (const float*)(p.ws + OFF_STATS);
#pragma unroll
    for (int m = 0; m < 8; ++m) {
        const int lr = wr * 128 + m * 16 + fr, pp = pp0 + lr;
        const float* xi = x_rd(p, x_from_input, b, pp);
        float* xo = x_wr(p, b, pp);
        float mean = 0.f, rstd = 1.f;
        if (!x_from_input) { const size_t row = (size_t)row0 + lr; mean = stats[row * 2]; rstd = stats[row * 2 + 1]; }
#pragma unroll
        for (int n = 0; n < 4; ++n) {
            const int col = nt256 * 256 + wc * 64 + n * 16 + fq * 4;
            f32x4 xv = *(const f32x4*)(xi + col); const f32x4 g4 = *(const f32x4*)(gv + col);
            if (!x_from_input) {
                const f32x4 lg = *(const f32x4*)(lng + col), lb = *(const f32x4*)(lnb + col);
#pragma unroll
                for (int j = 0; j < 4; ++j) xv[j] = (xv[j] - mean) * rstd * lg[j] + lb[j];
            }
            f32x4 o;
#pragma unroll
            for (int j = 0; j < 4; ++j) o[j] = ALPHA * xv[j] + g4[j] * acc[m][n][j];
            *(f32x4*)(xo + col) = o;
        }
    }
}
__device__ __forceinline__ void resid_gemm_phase(const Params& pin, int l, size_t a_off, int lda, int nk, size_t w_off, int ldb, int goff, bool x_from_input, const float* lng, const float* lnb, bool skip_ctx, unsigned char* lds) {
    const Params p = launder(pin); l = launder_i(l);
    const int tid = ltid();
    const bf16_t* A = (const bf16_t*)(p.ws + a_off);
    const bf16_t* Wt = (const bf16_t*)(p.ws + OFF_W) + w_off;
    if (gridDim.x == 256) {
        for (int t = blockIdx.x; t < 512; t += 256) {
            int mt, nt; tile_mn(t, 4, mt, nt);
            if (skip_ctx && (mt % 9) == 0) continue;
            resid_tile256(p, l, A, lda, nk, Wt, ldb, goff, x_from_input, lng, lnb, mt * 256, nt, lds, tid);
        }
        int mt, nt; tile_mn(512 + (blockIdx.x >> 2), 4, mt, nt);
        const int q = blockIdx.x & 3;
        if (!(skip_ctx && (mt % 9) == 0)) resid_tile<2>(p, l, A, lda, nk, Wt, ldb, goff, x_from_input, lng, lnb, mt * 256 + (q >> 1) * 128, nt * 2 + (q & 1), lds, tid);
    } else {
        for (int t = blockIdx.x; t < 144 * 8; t += gridDim.x) {
            int mt, nt; tile_mn(t, 8, mt, nt);
            if (skip_ctx && (mt % 9) == 0) continue;
            resid_tile<4>(p, l, A, lda, nk, Wt, ldb, goff, x_from_input, lng, lnb, mt * 256, nt, lds, tid);
        }
    }
}

__device__ __forceinline__ void ln_phase(const Params& pin, const float* g, const float* bta, int lmod, int shoff, bool write_xmod, bool write_x, bool skip_ctx) {
    const Params p = launder(pin); lmod = launder_i(lmod);
    const int tid = ltid(), wid = tid >> 6, lane = tid & 63;
    bf16_t* xm = (bf16_t*)(p.ws + OFF_R6);
    float* stats = (float*)(p.ws + OFF_STATS);
    for (int row = blockIdx.x * 8 + wid; row < MROWS; row += gridDim.x * 8) {
        const int b = row / TPB, pp = row % TPB;
        if (skip_ctx && pp < CTXL) continue;
        float* xp = x_wr(p, b, pp);
        f32x4 v[4];
        float s = 0.f;
#pragma unroll
        for (int i = 0; i < 4; ++i) { v[i] = *(const f32x4*)(xp + i * 256 + lane * 4); s += (v[i][0] + v[i][1]) + (v[i][2] + v[i][3]); }
        const float mean = wave_sum(s) * (1.0f / 1024.0f);
        float q = 0.f;
#pragma unroll
        for (int i = 0; i < 4; ++i)
#pragma unroll
            for (int j = 0; j < 4; ++j) { const float d = v[i][j] - mean; q += d * d; }
        const float rstd = rsqrtf(wave_sum(q) * (1.0f / 1024.0f) + 1e-5f);
        if (lane == 0) { stats[(size_t)row * 2] = mean; stats[(size_t)row * 2 + 1] = rstd; }
        const float* mv = write_xmod ? modv_ptr(p, lmod, b, pp) + shoff : nullptr;
#pragma unroll
        for (int i = 0; i < 4; ++i) {
            const int c = i * 256 + lane * 4;
            const f32x4 g4 = *(const f32x4*)(g + c), b4 = *(const f32x4*)(bta + c);
            f32x4 o;
#pragma unroll
            for (int j = 0; j < 4; ++j) o[j] = (v[i][j] - mean) * rstd * g4[j] + b4[j];
            if (write_x) *(f32x4*)(xp + c) = o;
            if (write_xmod) {
                const f32x4 sh = *(const f32x4*)(mv + c), sc = *(const f32x4*)(mv + 1024 + c);
                uint2 ov; ov.x = pk_bf16(o[0] * (1.f + sc[0]) + sh[0], o[1] * (1.f + sc[1]) + sh[1]); ov.y = pk_bf16(o[2] * (1.f + sc[2]) + sh[2], o[3] * (1.f + sc[3]) + sh[3]);
                *(uint2*)(xm + (size_t)row * 1024 + c) = ov;
            }
        }
    }
}

__device__ __forceinline__ void p7_phase(const Params& pin, bool skip_ctx, unsigned char* lds) {
    const Params p = launder(pin); const int tid = ltid();
    const bf16_t* A = (const bf16_t*)(p.ws + OFF_R6);
    const bf16_t* W = (const bf16_t*)(p.ws + OFF_W) + WO_13;
    bf16_t* HF = (bf16_t*)(p.ws + OFF_HF);
    const int lane = tid & 63, wid = tid >> 6, wr = wid >> 2, wc = wid & 3, fr = lane & 15, fq = lane >> 4;
    auto seg = [&](int t) { int mt, nt; tile_mn(t, 22, mt, nt); Seg g; g.A = A + (size_t)mt * 256 * 1024; g.Bt = W + (size_t)nt * 256 * 1024; g.lda = 1024; g.a_kstep = 64; g.ldb = 1024; g.nk = 16; return g; };
    auto valid = [&](int t) { int mt, nt; tile_mn(t, 22, mt, nt); return !(skip_ctx && (mt % 9) == 0); };
    auto nextv = [&](int t) { while (t < 144 * 22 && !valid(t)) t += gridDim.x; return t; };
    int st = 0; bool first = true;
    for (int t = nextv(blockIdx.x); t < 144 * 22;) {
        int mt, nt; tile_mn(t, 22, mt, nt);
        const int tn = nextv(t + gridDim.x); const bool hn = tn < 144 * 22;
        f32x4 acc[8][4]; zero_acc<8>(acc);
        gemm_stream256(acc, seg(t), seg(hn ? tn : t), hn, first, st, lds, tid); first = false;
        const int G = nt * 4 + wc;
#pragma unroll
        for (int m = 0; m < 8; ++m) {
            const size_t row = (size_t)mt * 256 + wr * 128 + m * 16 + fr;
            uint2 ov[2];
#pragma unroll
            for (int n = 0; n < 2; ++n) {
                float o[4];
#pragma unroll
                for (int j = 0; j < 4; ++j) o[j] = siluf_(acc[m][n][j]) * acc[m][n + 2][j];
                ov[n].x = pk_bf16(o[0], o[1]); ov[n].y = pk_bf16(o[2], o[3]);
            }
            *(uint4*)(HF + row * DFF + G * 32 + (fq & 1) * 16 + (fq >> 1) * 8) = widen16(ov[0], ov[1]);
        }
        t = tn;
    }
}

__global__ void __launch_bounds__(NTHREADS) fwd_megakernel(Params p) {
    extern __shared__ __attribute__((aligned(16))) unsigned char lds[];
    cg::grid_group grid = cg::this_grid();
    unsigned* gbar = (unsigned*)(p.ws + OFF_BAR); unsigned epoch = 0;
#define GSYNC() grid_barrier(gbar, epoch)
    if (p.ws == nullptr) grid.sync();
    modv_phase(p, lds);
    convert_layer(p, 0, lds);
    {
        bf16_t* Wm = (bf16_t*)(p.ws + OFF_W) + WO_IN + (size_t)672 * 1024;
        for (int i = blockIdx.x * NTHREADS + threadIdx.x; i < 96 * 1024 / 2; i += gridDim.x * NTHREADS) ((unsigned*)Wm)[i] = 0u;
    }
    GSYNC();
    xmod0_phase(p);
    GSYNC();
#pragma unroll 1
    for (int l = 0; l < DEPTH; ++l) {
        const bool last = (l == DEPTH - 1);
        for (int r = 0, nr = launder_i(1 + ((PROBE_MASK >> 2) & 1)); r < nr; ++r) p1_phase(p, lds);
        GSYNC();
        for (int r = 0, nr = launder_i(1 + ((PROBE_MASK >> 3) & 1)); r < nr; ++r) p2a_phase(p, l);
        GSYNC();
        for (int r = 0, nr = launder_i(1 + ((PROBE_MASK >> 4) & 1)); r < nr; ++r) p2b_phase(p, l, lds);
        GSYNC();
        p3_phase(p, l, lds);
        GSYNC();
        for (int r = 0, nr = launder_i(1 + ((PROBE_MASK >> 5) & 1)); r < nr; ++r) p35_phase(p, l, last, lds);
        GSYNC();
        for (int r = 0, nr = launder_i(1 + ((PROBE_MASK >> 6) & 1)); r < nr; ++r) p4_phase(p, last, lds);
        GSYNC();
        resid_gemm_phase(p, l, OFF_MRG, 1024, 16, WO_OUT, 1024, 2048, l == 0, p.ln2_g + (l > 0 ? l - 1 : 0) * 1024, p.ln2_b + (l > 0 ? l - 1 : 0) * 1024, last, lds);
        GSYNC();
        ln_phase(p, p.ln1_g + l * 1024, p.ln1_b + l * 1024, l, 3072, true, false, last);
        GSYNC();
        for (int r = 0, nr = launder_i(1 + ((PROBE_MASK >> 0) & 1)); r < nr; ++r) p7_phase(p, last, lds);
        GSYNC();
        resid_gemm_phase(p, l, OFF_HF, DFF, 44, WO_2, DFF, 5120, false, p.ln1_g + l * 1024, p.ln1_b + l * 1024, last, lds);
        GSYNC();
        ln_phase(p, p.ln2_g + l * 1024, p.ln2_b + l * 1024, last ? l : l + 1, 0, !last, last, last);
        if (!last) for (int r = 0, nr = launder_i(1 + ((PROBE_MASK >> 7) & 1)); r < nr; ++r) convert_layer(p, l + 1, lds);
        for (int r = 0, nr = launder_i(((PROBE_MASK >> 8) & 1) * 10); r < nr; ++r) GSYNC();
        GSYNC();
    }
}

extern "C" void kernel_launch(void* const* d_in, const int* in_sizes, int n_in, void* d_out,
                              int out_size, void* d_ws, size_t ws_size, hipStream_t stream) {
    static int grid_blocks = 0;
    if (!grid_blocks) {
        int dev = 0, cus = 0, per_cu = 0;
        hipGetDevice(&dev);
        hipDeviceGetAttribute(&cus, hipDeviceAttributeMultiprocessorCount, dev);
        if (hipFuncSetAttribute((const void*)fwd_megakernel, hipFuncAttributeMaxDynamicSharedMemorySize, LDS_BYTES) != hipSuccess)
            fprintf(stderr, "hipFuncSetAttribute failed\n");
        hipOccupancyMaxActiveBlocksPerMultiprocessor(&per_cu, (const void*)fwd_megakernel, NTHREADS, LDS_BYTES);
        if (per_cu < 1) fprintf(stderr, "occupancy query says %d blocks/CU\n", per_cu);
        (void)hipGetLastError();
        grid_blocks = cus > 0 ? cus : 256;
        if (ws_size < WS_END) { fprintf(stderr, "workspace too small: %zu < %zu\n", ws_size, (size_t)WS_END); grid_blocks = -1; }
        if (n_in != 33) { fprintf(stderr, "expected 33 inputs, got %d\n", n_in); grid_blocks = -1; }
    }
    if (grid_blocks < 0) return;
    if (hipMemsetAsync((unsigned char*)d_ws + OFF_BAR, 0, 1024, stream) != hipSuccess) fprintf(stderr, "memset failed\n");
    Params p{};
    const float** pp = (const float**)&p;
    for (int i = 0; i < 33; ++i) pp[i] = (const float*)d_in[i];
    p.out = (float*)d_out;
    p.ws = (unsigned char*)d_ws;
    void* args[] = {&p};
    hipError_t e = hipLaunchCooperativeKernel((void*)fwd_megakernel, dim3(grid_blocks), dim3(NTHREADS), args, LDS_BYTES, stream);
    if (e != hipSuccess) fprintf(stderr, "cooperative launch failed: %s (grid %d)\n", hipGetErrorString(e), grid_blocks);
}
```

```cpp
#include <hip/hip_runtime.h>
#include <hip/hip_cooperative_groups.h>
#include <cstdio>
#include <cstdint>
namespace cg = cooperative_groups;

typedef unsigned short bf16_t;
typedef short bf16x8 __attribute__((ext_vector_type(8)));
typedef float f32x4 __attribute__((ext_vector_type(4)));

#ifndef PROBE_MASK
#define PROBE_MASK 0
#endif
constexpr int BATCH = 16, SEQ = 2048, CTXL = 256, DM = 1024, DEPTH = 4, DFF = 2816, DIN = 7200;
constexpr int TPB = SEQ + CTXL;
constexpr int MROWS = BATCH * TPB;
constexpr int NTHREADS = 512;
constexpr int LDS_BYTES = 152 * 1024;
constexpr float ALPHA = 1.681792830507429f;
constexpr float QSCALE = 0.10206207261596575f * 1.4426950408889634f;

constexpr size_t WO_IN = 0;
constexpr size_t WO_UQ = WO_IN + (size_t)7296 * 1024;
constexpr size_t WO_UKV = WO_UQ + (size_t)768 * 384;
constexpr size_t WO_OA = WO_UKV + (size_t)1024 * 256;
constexpr size_t WO_OC = WO_OA + (size_t)1024 * 512;
constexpr size_t WO_OR = WO_OC + (size_t)1024 * 512;
constexpr size_t WO_OUT = WO_OR + (size_t)1024 * 512;
constexpr size_t WO_13 = WO_OUT + (size_t)1024 * 1024;
constexpr size_t WO_2 = WO_13 + (size_t)5632 * 1024;
constexpr size_t WO_UP = WO_2 + (size_t)1024 * 2816;
constexpr size_t WO_AUP = WO_UP + (size_t)2 * 512 * 64;
constexpr size_t WO_GUP = WO_AUP + (size_t)2 * 512 * 64;
constexpr size_t W_ELEMS = WO_GUP + (size_t)512 * 128;

constexpr size_t al256(size_t x) { return (x + 255) & ~(size_t)255; }
constexpr size_t OFF_BAR = 0;
constexpr size_t OFF_W = 1024;
constexpr size_t OFF_MODV = al256(OFF_W + W_ELEMS * 2);
constexpr size_t OFF_ROPE = al256(OFF_MODV + (size_t)4 * 17 * 6144 * 4);
constexpr size_t OFF_RSQ = al256(OFF_ROPE + 64 * 8 * 2 * 4);
constexpr size_t OFF_RSKV = al256(OFF_RSQ + (size_t)MROWS * 4);
constexpr size_t OFF_STATS = al256(OFF_RSKV + (size_t)MROWS * 4);
constexpr size_t OFF_XC = al256(OFF_STATS + (size_t)MROWS * 8);
constexpr size_t OFF_R1 = al256(OFF_XC + (size_t)BATCH * CTXL * DM * 4);
constexpr size_t OFF_R2 = al256(OFF_R1 + (size_t)MROWS * 672 * 2);
constexpr size_t OFF_R3 = OFF_R2 + (size_t)MROWS * 1536 * 2;
constexpr size_t OFF_R4 = al256(OFF_R3 + (size_t)MROWS * 1920 * 2);
constexpr size_t OFF_R5 = al256(OFF_R4 + (size_t)MROWS * (512 + 512 + 32) * 2);
constexpr size_t OFF_R6 = al256(OFF_R5 + (size_t)MROWS * 512 * 2);
constexpr size_t WS_END = al256(OFF_R6 + (size_t)MROWS * 1024 * 2);
constexpr size_t OFF_Q = OFF_R2;
constexpr size_t OFF_YF = OFF_R2 + (size_t)MROWS * 768 * 2;
constexpr size_t OFF_SG = OFF_YF + (size_t)MROWS * 512 * 2;
constexpr size_t OFF_YB = OFF_R1;
constexpr size_t OFF_KN = OFF_R4;
constexpr size_t OFF_VT = OFF_R4 + (size_t)MROWS * 512 * 2;
constexpr size_t OFF_KR = OFF_VT + (size_t)MROWS * 512 * 2;
constexpr size_t OFF_RWO = OFF_R4;
constexpr size_t OFF_MRG = OFF_R3;
constexpr size_t OFF_HF = OFF_R2;
static_assert(OFF_SG + (size_t)MROWS * 128 * 2 <= OFF_R3, "R2 overlay overflow");
static_assert((size_t)MROWS * 2816 * 2 <= OFF_R4 - OFF_R2, "HF overflow");

struct Params {
    const float *x, *c, *ctx, *c_ctx, *mod_w, *mod_b, *w_in, *q_norm, *w_uq, *kv_norm, *w_ukv, *w_o_attn,
        *conv_w, *w_o_conv, *rw_mu, *rw_w0, *rw_w_up, *rw_a0, *rw_a_up, *rw_g_up, *rw_k_k, *rw_k_a,
        *rw_r_k, *rw_gn_g, *rw_gn_b, *w_o_rwkv, *w_out, *ln1_g, *ln1_b, *ffn_w13, *ffn_w2, *ln2_g, *ln2_b;
    float* out;
    unsigned char* ws;
};

typedef __attribute__((address_space(1))) unsigned char gchar_t;
typedef __attribute__((address_space(1))) float gfloat_t;
__device__ __forceinline__ Params launder(const Params& a) {
    Params q = a;
    unsigned long long w = (unsigned long long)a.ws, o = (unsigned long long)a.out;
    unsigned wl = __builtin_amdgcn_readfirstlane((unsigned)w), wh = __builtin_amdgcn_readfirstlane((unsigned)(w >> 32));
    unsigned ol = __builtin_amdgcn_readfirstlane((unsigned)o), oh = __builtin_amdgcn_readfirstlane((unsigned)(o >> 32));
    asm volatile("" : "+s"(wl), "+s"(wh), "+s"(ol), "+s"(oh));
    w = ((unsigned long long)wh << 32) | wl; o = ((unsigned long long)oh << 32) | ol;
    q.ws = (unsigned char*)(gchar_t*)w; q.out = (float*)(gfloat_t*)o;
    return q;
}
__device__ __forceinline__ int launder_i(int v) { v = __builtin_amdgcn_readfirstlane(v); asm volatile("" : "+s"(v)); return v; }
__device__ __forceinline__ int ltid() { int t = threadIdx.x; asm volatile("" : "+v"(t)); return t; }
__device__ __forceinline__ unsigned pk_bf16(float lo, float hi) { unsigned r; asm("v_cvt_pk_bf16_f32 %0, %1, %2" : "=v"(r) : "v"(lo), "v"(hi)); return r; }
__device__ __forceinline__ float bf_lo(unsigned u) { return __uint_as_float(u << 16); }
__device__ __forceinline__ float bf_hi(unsigned u) { return __uint_as_float(u & 0xffff0000u); }
__device__ __forceinline__ float bf1(bf16_t h) { return __uint_as_float(((unsigned)h) << 16); }
__device__ __forceinline__ float x32sum(float x) { unsigned u = __float_as_uint(x); auto r = __builtin_amdgcn_permlane32_swap(u, u, false, false); return __uint_as_float(r[0]) + __uint_as_float(r[1]); }
__device__ __forceinline__ float x16sum(float x) { unsigned u = __float_as_uint(x); auto r = __builtin_amdgcn_permlane16_swap(u, u, false, false); return __uint_as_float(r[0]) + __uint_as_float(r[1]); }
__device__ __forceinline__ float x32max(float x) { unsigned u = __float_as_uint(x); auto r = __builtin_amdgcn_permlane32_swap(u, u, false, false); return fmaxf(__uint_as_float(r[0]), __uint_as_float(r[1])); }
__device__ __forceinline__ float x16max(float x) { unsigned u = __float_as_uint(x); auto r = __builtin_amdgcn_permlane16_swap(u, u, false, false); return fmaxf(__uint_as_float(r[0]), __uint_as_float(r[1])); }
__device__ __forceinline__ float fqsum(float x) { return x16sum(x32sum(x)); }
__device__ __forceinline__ float fqmax(float x) { return x16max(x32max(x)); }

template <int CTRL> __device__ __forceinline__ float dpp_add(float x) { return x + __uint_as_float((unsigned)__builtin_amdgcn_update_dpp(0, (int)__float_as_uint(x), CTRL, 0xf, 0xf, true)); }
__device__ __forceinline__ float red8(float x) { x = dpp_add<0xB1>(x); x = dpp_add<0x4E>(x); x = dpp_add<0x141>(x); return x; }
__device__ __forceinline__ float wave_sum(float v) { v = dpp_add<0xB1>(v); v = dpp_add<0x4E>(v); v = dpp_add<0x141>(v); v = dpp_add<0x140>(v); return fqsum(v); }
__device__ __forceinline__ uint4 widen16(uint2 a, uint2 b) {
    auto r0 = __builtin_amdgcn_permlane16_swap(a.x, b.x, false, false);
    auto r1 = __builtin_amdgcn_permlane16_swap(a.y, b.y, false, false);
    return make_uint4(r0[0], r1[0], r0[1], r1[1]);
}
__device__ __forceinline__ float fexp(float x) { return __builtin_amdgcn_exp2f(x * 1.4426950408889634f); }
__device__ __forceinline__ float sigmoidf_(float x) { return __builtin_amdgcn_rcpf(1.0f + fexp(-x)); }
__device__ __forceinline__ float siluf_(float x) { return x * __builtin_amdgcn_rcpf(1.0f + fexp(-x)); }

__device__ __forceinline__ const float* x_rd(const Params& p, bool from_input, int b, int pp) {
    if (pp < CTXL) return (from_input ? p.ctx : (const float*)(p.ws + OFF_XC)) + ((size_t)b * CTXL + pp) * DM;
    return (from_input ? p.x : (const float*)p.out) + ((size_t)b * SEQ + (pp - CTXL)) * DM;
}
__device__ __forceinline__ float* x_wr(const Params& p, int b, int pp) {
    if (pp < CTXL) return (float*)(p.ws + OFF_XC) + ((size_t)b * CTXL + pp) * DM;
    return p.out + ((size_t)b * SEQ + (pp - CTXL)) * DM;
}
__device__ __forceinline__ const float* modv_ptr(const Params& p, int l, int b, int pp) {
    const int mr = pp < CTXL ? 16 : b;
    return (const float*)(p.ws + OFF_MODV) + ((size_t)l * 17 + mr) * 6144;
}

__device__ __forceinline__ void grid_barrier(unsigned* bar, unsigned& epoch) {
    asm volatile("s_waitcnt vmcnt(0) lgkmcnt(0)" ::: "memory");
    __syncthreads();
    epoch += 1;
    if (threadIdx.x == 0) {
        __builtin_amdgcn_fence(__ATOMIC_RELEASE, "agent");
        asm volatile("s_waitcnt vmcnt(0)" ::: "memory");
        const unsigned old = __hip_atomic_fetch_add(bar, 1u, __ATOMIC_RELAXED, __HIP_MEMORY_SCOPE_AGENT);
        if (old + 1u == epoch * gridDim.x) {
            __hip_atomic_store(bar + 64, epoch, __ATOMIC_RELAXED, __HIP_MEMORY_SCOPE_AGENT);
        } else {
            while (__hip_atomic_load(bar + 64, __ATOMIC_RELAXED, __HIP_MEMORY_SCOPE_AGENT) < epoch) __builtin_amdgcn_s_sleep(1);
        }
        __builtin_amdgcn_fence(__ATOMIC_ACQUIRE, "agent");
        asm volatile("s_waitcnt vmcnt(0)" ::: "memory");
    }
    __syncthreads();
}

#define LDS_AS __attribute__((address_space(3)))
#define GLB_AS __attribute__((address_space(1)))
template <int MT, int SWAPMODE>
__device__ __forceinline__ void gemm_mainloop(f32x4 (&acc)[MT][4], const bf16_t* __restrict__ A, int lda, int a_kstep,
                                              const bf16_t* __restrict__ Bt, int ldb, int nk, unsigned char* lds, int tid) {
    constexpr int BMr = 64 * MT;
    constexpr int STAGE = (BMr + 128) * 128;
    const int wid = __builtin_amdgcn_readfirstlane(tid >> 6), lane = tid & 63, wr = wid >> 1, wc = wid & 1, fr = lane & 15, fq = lane >> 4;
    const int lrow = 8 * wid + (lane >> 3);
    const int lch = (lane & 7) ^ ((4 * wid + (lane >> 4)) & 7);
    const bf16_t* ap = A + (size_t)lrow * lda + lch * 8;
    const bf16_t* bp = Bt + (size_t)lrow * ldb + lch * 8;
    auto issue = [&](int kt, int st) {
        unsigned char* base = lds + st * STAGE + wid * 1024;
#pragma unroll
        for (int i = 0; i < MT; ++i)
            __builtin_amdgcn_global_load_lds((const GLB_AS unsigned*)(ap + (size_t)i * 64 * lda + (size_t)kt * a_kstep), (LDS_AS unsigned*)(base + i * 8192), 16, 0, 0);
#pragma unroll
        for (int i = 0; i < 2; ++i)
            __builtin_amdgcn_global_load_lds((const GLB_AS unsigned*)(bp + (size_t)i * 64 * ldb + (size_t)kt * 64), (LDS_AS unsigned*)(base + (BMr + i * 64) * 128), 16, 0, 0);
    };
    const bool sw = (SWAPMODE == 1) || (SWAPMODE == 2 && wc == 0);
    const int sz = fr >> 1;
    constexpr int NL = MT + 2;
    const bool late = wid >= 4;
    issue(0, 0);
    if (nk > 1) { issue(1, 1); asm volatile("s_waitcnt vmcnt(%0)" ::"n"(NL) : "memory"); }
    else asm volatile("s_waitcnt vmcnt(0)" ::: "memory");
    __builtin_amdgcn_s_barrier();
    asm volatile("" ::: "memory");
    int st = 0;
    for (int kt = 0; kt < nk; ++kt) {
        const int st2 = st >= 1 ? st - 1 : 2;
        if (!late && kt + 2 < nk) issue(kt + 2, st2);
        const unsigned char* As = lds + st * STAGE;
        const unsigned char* Bs = As + BMr * 128;
#pragma unroll
        for (int ks = 0; ks < 2; ++ks) {
            bf16x8 af[MT], bfr[4];
            const int co = ((ks * 4 + fq) ^ sz) * 16;
#pragma unroll
            for (int m = 0; m < MT; ++m) af[m] = *(const bf16x8*)(As + (wr * 16 * MT + m * 16 + fr) * 128 + co);
#pragma unroll
            for (int n = 0; n < 4; ++n) bfr[n] = *(const bf16x8*)(Bs + (wc * 64 + n * 16 + fr) * 128 + co);
            if (sw) {
#pragma unroll
                for (int m = 0; m < MT; ++m)
#pragma unroll
                    for (int n = 0; n < 4; ++n) acc[m][n] = __builtin_amdgcn_mfma_f32_16x16x32_bf16(bfr[n], af[m], acc[m][n], 0, 0, 0);
            } else {
#pragma unroll
                for (int m = 0; m < MT; ++m)
#pragma unroll
                    for (int n = 0; n < 4; ++n) acc[m][n] = __builtin_amdgcn_mfma_f32_16x16x32_bf16(af[m], bfr[n], acc[m][n], 0, 0, 0);
            }
        }
        if (late && kt + 2 < nk) issue(kt + 2, st2);
        if (kt + 2 < nk) asm volatile("s_waitcnt vmcnt(%0) lgkmcnt(0)" ::"n"(NL) : "memory");
        else asm volatile("s_waitcnt vmcnt(0) lgkmcnt(0)" ::: "memory");
        __builtin_amdgcn_s_barrier();
        asm volatile("" ::: "memory");
        st = st == 2 ? 0 : st + 1;
    }
}
__device__ __forceinline__ void gemm_mainloop256(f32x4 (&acc)[8][4], const bf16_t* __restrict__ A, int lda,
                                                 const bf16_t* __restrict__ Bt, int ldb, int nk, unsigned char* lds, int tid) {
    constexpr int STAGE = 512 * 128;
    const int wid = __builtin_amdgcn_readfirstlane(tid >> 6), lane = tid & 63, wr = wid >> 2, wc = wid & 3, fr = lane & 15, fq = lane >> 4;
    const int lrow = 8 * wid + (lane >> 3);
    const int lch = (lane & 7) ^ ((4 * wid + (lane >> 4)) & 7);
    const bf16_t* ap = A + (size_t)lrow * lda + lch * 8;
    const bf16_t* bp = Bt + (size_t)lrow * ldb + lch * 8;
    auto issue = [&](int kt, int st) {
        unsigned char* base = lds + st * STAGE + wid * 1024;
#pragma unroll
        for (int i = 0; i < 4; ++i)
            __builtin_amdgcn_global_load_lds((const GLB_AS unsigned*)(ap + (size_t)i * 64 * lda + (size_t)kt * 64), (LDS_AS unsigned*)(base + i * 8192), 16, 0, 0);
#pragma unroll
        for (int i = 0; i < 4; ++i)
            __builtin_amdgcn_global_load_lds((const GLB_AS unsigned*)(bp + (size_t)i * 64 * ldb + (size_t)kt * 64), (LDS_AS unsigned*)(base + (256 + i * 64) * 128), 16, 0, 0);
    };
    const int sz = fr >> 1;
    const bool late = wid >= 4;
    issue(0, 0);
    asm volatile("s_waitcnt vmcnt(0)" ::: "memory");
    __builtin_amdgcn_s_barrier();
    asm volatile("" ::: "memory");
    for (int kt = 0; kt < nk; ++kt) {
        if (!late && kt + 1 < nk) issue(kt + 1, (kt + 1) & 1);
        const unsigned char* As = lds + (kt & 1) * STAGE;
        const unsigned char* Bs = As + 256 * 128;
#pragma unroll
        for (int ks = 0; ks < 2; ++ks) {
            if (ks == 1 && late && kt + 1 < nk) issue(kt + 1, (kt + 1) & 1);
            bf16x8 af[8], bfr[4];
            const int co = ((ks * 4 + fq) ^ sz) * 16;
#pragma unroll
            for (int m = 0; m < 8; ++m) af[m] = *(const bf16x8*)(As + (wr * 128 + m * 16 + fr) * 128 + co);
#pragma unroll
            for (int n = 0; n < 4; ++n) bfr[n] = *(const bf16x8*)(Bs + (wc * 64 + n * 16 + fr) * 128 + co);
#pragma unroll
            for (int m = 0; m < 8; ++m)
#pragma unroll
                for (int n = 0; n < 4; ++n) acc[m][n] = __builtin_amdgcn_mfma_f32_16x16x32_bf16(bfr[n], af[m], acc[m][n], 0, 0, 0);
        }
        asm volatile("s_waitcnt vmcnt(0) lgkmcnt(0)" ::: "memory");
        __builtin_amdgcn_s_barrier();
        asm volatile("" ::: "memory");
    }
}
struct Seg { const bf16_t* A; const bf16_t* Bt; int lda, a_kstep, ldb, nk; };
template <int MT, int SWAPMODE>
__device__ __forceinline__ void gemm_stream(f32x4 (&acc)[MT][4], const Seg& cur, const Seg& nxt, bool has_next, bool first, int& st,
                                            unsigned char* lds, int tid) {
    constexpr int BMr = 64 * MT;
    constexpr int STAGE = (BMr + 128) * 128;
    constexpr int NL = MT + 2;
    const int wid = __builtin_amdgcn_readfirstlane(tid >> 6), lane = tid & 63, wr = wid >> 1, wc = wid & 1, fr = lane & 15, fq = lane >> 4;
    const int lrow = 8 * wid + (lane >> 3);
    const int lch = (lane & 7) ^ ((4 * wid + (lane >> 4)) & 7);
    const bf16_t* apc = cur.A + (size_t)lrow * cur.lda + lch * 8;
    const bf16_t* bpc = cur.Bt + (size_t)lrow * cur.ldb + lch * 8;
    const bf16_t* apn = nxt.A + (size_t)lrow * nxt.lda + lch * 8;
    const bf16_t* bpn = nxt.Bt + (size_t)lrow * nxt.ldb + lch * 8;
    auto issue = [&](const bf16_t* ap, const bf16_t* bp, int lda, int ldb, int koffa, int koffb, int slot) {
        unsigned char* base = lds + slot * STAGE + wid * 1024;
#pragma unroll
        for (int i = 0; i < MT; ++i)
            __builtin_amdgcn_global_load_lds((const GLB_AS unsigned*)(ap + (size_t)i * 64 * lda + koffa), (LDS_AS unsigned*)(base + i * 8192), 16, 0, 0);
#pragma unroll
        for (int i = 0; i < 2; ++i)
            __builtin_amdgcn_global_load_lds((const GLB_AS unsigned*)(bp + (size_t)i * 64 * ldb + koffb), (LDS_AS unsigned*)(base + (BMr + i * 64) * 128), 16, 0, 0);
    };
    const bool sw = (SWAPMODE == 1) || (SWAPMODE == 2 && wc == 0);
    const int sz = fr >> 1;
    const bool late = wid >= 4;
    const int nk = cur.nk;
    int s0 = st;
    if (first) {
        const int s1 = s0 == 2 ? 0 : s0 + 1;
        issue(apc, bpc, cur.lda, cur.ldb, 0, 0, s0);
        issue(apc, bpc, cur.lda, cur.ldb, cur.a_kstep, 64, s1);
        asm volatile("s_waitcnt vmcnt(%0)" ::"n"(NL) : "memory");
        __builtin_amdgcn_s_barrier();
        asm volatile("" ::: "memory");
    }
    for (int kt = 0; kt < nk; ++kt) {
        const int s2 = s0 >= 1 ? s0 - 1 : 2;
        const int idx = kt + 2;
        const bool incur = idx < nk, doi = incur || has_next;
        if (!late && doi) { if (incur) issue(apc, bpc, cur.lda, cur.ldb, idx * cur.a_kstep, idx * 64, s2); else issue(apn, bpn, nxt.lda, nxt.ldb, (idx - nk) * nxt.a_kstep, (idx - nk) * 64, s2); }
        const unsigned char* As = lds + s0 * STAGE;
        const unsigned char* Bs = As + BMr * 128;
#pragma unroll
        for (int ks = 0; ks < 2; ++ks) {
            bf16x8 af[MT], bfr[4];
            const int co = ((ks * 4 + fq) ^ sz) * 16;
#pragma unroll
            for (int m = 0; m < MT; ++m) af[m] = *(const bf16x8*)(As + (wr * 16 * MT + m * 16 + fr) * 128 + co);
#pragma unroll
            for (int n = 0; n < 4; ++n) bfr[n] = *(const bf16x8*)(Bs + (wc * 64 + n * 16 + fr) * 128 + co);
            if (sw) {
#pragma unroll
                for (int m = 0; m < MT; ++m)
#pragma unroll
                    for (int n = 0; n < 4; ++n) acc[m][n] = __builtin_amdgcn_mfma_f32_16x16x32_bf16(bfr[n], af[m], acc[m][n], 0, 0, 0);
            } else {
#pragma unroll
                for (int m = 0; m < MT; ++m)
#pragma unroll
                    for (int n = 0; n < 4; ++n) acc[m][n] = __builtin_amdgcn_mfma_f32_16x16x32_bf16(af[m], bfr[n], acc[m][n], 0, 0, 0);
            }
        }
        if (late && doi) { if (incur) issue(apc, bpc, cur.lda, cur.ldb, idx * cur.a_kstep, idx * 64, s2); else issue(apn, bpn, nxt.lda, nxt.ldb, (idx - nk) * nxt.a_kstep, (idx - nk) * 64, s2); }
        if (doi) asm volatile("s_waitcnt vmcnt(%0) lgkmcnt(0)" ::"n"(NL) : "memory");
        else asm volatile("s_waitcnt vmcnt(0) lgkmcnt(0)" ::: "memory");
        __builtin_amdgcn_s_barrier();
        asm volatile("" ::: "memory");
        s0 = s0 == 2 ? 0 : s0 + 1;
    }
    st = s0;
}
__device__ __forceinline__ void gemm_stream256(f32x4 (&acc)[8][4], const Seg& cur, const Seg& nxt, bool has_next, bool first, int& st, unsigned char* lds, int tid) {
    constexpr int STAGE = 512 * 128;
    const int wid = __builtin_amdgcn_readfirstlane(tid >> 6), lane = tid & 63, wr = wid >> 2, wc = wid & 3, fr = lane & 15, fq = lane >> 4;
    const int lrow = 8 * wid + (lane >> 3);
    const int lch = (lane & 7) ^ ((4 * wid + (lane >> 4)) & 7);
    const bf16_t* apc = cur.A + (size_t)lrow * cur.lda + lch * 8;
    const bf16_t* bpc = cur.Bt + (size_t)lrow * cur.ldb + lch * 8;
    const bf16_t* apn = nxt.A + (size_t)lrow * nxt.lda + lch * 8;
    const bf16_t* bpn = nxt.Bt + (size_t)lrow * nxt.ldb + lch * 8;
    auto issue = [&](const bf16_t* ap, const bf16_t* bp, int lda, int ldb, int koff, int slot) {
        unsigned char* base = lds + slot * STAGE + wid * 1024;
#pragma unroll
        for (int i = 0; i < 4; ++i)
            __builtin_amdgcn_global_load_lds((const GLB_AS unsigned*)(ap + (size_t)i * 64 * lda + koff), (LDS_AS unsigned*)(base + i * 8192), 16, 0, 0);
#pragma unroll
        for (int i = 0; i < 4; ++i)
            __builtin_amdgcn_global_load_lds((const GLB_AS unsigned*)(bp + (size_t)i * 64 * ldb + koff), (LDS_AS unsigned*)(base + (256 + i * 64) * 128), 16, 0, 0);
    };
    const int sz = fr >> 1;
    const bool late = wid >= 4;
    const int nk = cur.nk;
    int s0 = st;
    if (first) {
        issue(apc, bpc, cur.lda, cur.ldb, 0, s0);
        asm volatile("s_waitcnt vmcnt(0)" ::: "memory");
        __builtin_amdgcn_s_barrier();
        asm volatile("" ::: "memory");
    }
    for (int kt = 0; kt < nk; ++kt) {
        const int idx = kt + 1;
        const bool incur = idx < nk, doi = incur || has_next;
        if (!late && doi) { if (incur) issue(apc, bpc, cur.lda, cur.ldb, idx * 64, s0 ^ 1); else issue(apn, bpn, nxt.lda, nxt.ldb, 0, s0 ^ 1); }
        const unsigned char* As = lds + s0 * STAGE;
        const unsigned char* Bs = As + 256 * 128;
#pragma unroll
        for (int ks = 0; ks < 2; ++ks) {
            if (ks == 1 && late && doi) { if (incur) issue(apc, bpc, cur.lda, cur.ldb, idx * 64, s0 ^ 1); else issue(apn, bpn, nxt.lda, nxt.ldb, 0, s0 ^ 1); }
            bf16x8 af[8], bfr[4];
            const int co = ((ks * 4 + fq) ^ sz) * 16;
#pragma unroll
            for (int m = 0; m < 8; ++m) af[m] = *(const bf16x8*)(As + (wr * 128 + m * 16 + fr) * 128 + co);
#pragma unroll
            for (int n = 0; n < 4; ++n) bfr[n] = *(const bf16x8*)(Bs + (wc * 64 + n * 16 + fr) * 128 + co);
#pragma unroll
            for (int m = 0; m < 8; ++m)
#pragma unroll
                for (int n = 0; n < 4; ++n) acc[m][n] = __builtin_amdgcn_mfma_f32_16x16x32_bf16(bfr[n], af[m], acc[m][n], 0, 0, 0);
        }
        asm volatile("s_waitcnt vmcnt(0) lgkmcnt(0)" ::: "memory");
        __builtin_amdgcn_s_barrier();
        asm volatile("" ::: "memory");
        s0 ^= 1;
    }
    st = s0;
}
__device__ __forceinline__ void gemm_gate3(f32x4 (&g)[3][2][4], const bf16_t* __restrict__ A, const bf16_t* __restrict__ Bt0, int nk, unsigned char* lds, int tid) {
    constexpr int STAGE = 512 * 128;
    const int wid = __builtin_amdgcn_readfirstlane(tid >> 6), lane = tid & 63, wr = wid >> 1, wc = wid & 1, fr = lane & 15, fq = lane >> 4;
    const int lrow = 8 * wid + (lane >> 3);
    const int lch = (lane & 7) ^ ((4 * wid + (lane >> 4)) & 7);
    const unsigned loff = (unsigned)(lrow * 1024 + lch * 8);
    auto issue = [&](int kt, int stg) {
        unsigned char* base = lds + stg * STAGE + wid * 1024;
#pragma unroll
        for (int i = 0; i < 2; ++i)
            __builtin_amdgcn_global_load_lds((const GLB_AS unsigned*)((A + (size_t)i * 64 * 1024 + (size_t)kt * 64) + loff), (LDS_AS unsigned*)(base + i * 8192), 16, 0, 0);
#pragma unroll
        for (int j = 0; j < 6; ++j)
            __builtin_amdgcn_global_load_lds((const GLB_AS unsigned*)((Bt0 + ((size_t)(j >> 1) * 1024 + (j & 1) * 64) * 1024 + (size_t)kt * 64) + loff), (LDS_AS unsigned*)(base + (128 + j * 64) * 128), 16, 0, 0);
    };
    const int sz = fr >> 1;
    const bool late = wid >= 4;
    issue(0, 0);
    asm volatile("s_waitcnt vmcnt(0)" ::: "memory");
    __builtin_amdgcn_s_barrier();
    asm volatile("" ::: "memory");
    for (int kt = 0; kt < nk; ++kt) {
        if (!late && kt + 1 < nk) issue(kt + 1, (kt + 1) & 1);
        const unsigned char* As = lds + (kt & 1) * STAGE;
        const unsigned char* Bs = As + 128 * 128;
#pragma unroll
        for (int ks = 0; ks < 2; ++ks) {
            if (ks == 1 && late && kt + 1 < nk) issue(kt + 1, (kt + 1) & 1);
            const int co = ((ks * 4 + fq) ^ sz) * 16;
            bf16x8 af[2];
#pragma unroll
            for (int m = 0; m < 2; ++m) af[m] = *(const bf16x8*)(As + (wr * 32 + m * 16 + fr) * 128 + co);
#pragma unroll
            for (int i = 0; i < 3; ++i) {
                bf16x8 bfr[4];
#pragma unroll
                for (int n = 0; n < 4; ++n) bfr[n] = *(const bf16x8*)(Bs + (i * 128 + wc * 64 + n * 16 + fr) * 128 + co);
#pragma unroll
                for (int m = 0; m < 2; ++m)
#pragma unroll
                    for (int n = 0; n < 4; ++n) g[i][m][n] = __builtin_amdgcn_mfma_f32_16x16x32_bf16(bfr[n], af[m], g[i][m][n], 0, 0, 0);
                if (i < 2) __builtin_amdgcn_sched_barrier(0);
            }
        }
        asm volatile("s_waitcnt vmcnt(0) lgkmcnt(0)" ::: "memory");
        __builtin_amdgcn_s_barrier();
        asm volatile("" ::: "memory");
    }
}
template <int MT> __device__ __forceinline__ void zero_acc(f32x4 (&acc)[MT][4]) {
#pragma unroll
    for (int m = 0; m < MT; ++m)
#pragma unroll
        for (int n = 0; n < 4; ++n) acc[m][n] = (f32x4){0.f, 0.f, 0.f, 0.f};
}
__device__ __forceinline__ void tile_mn(int t, int nN, int& mt, int& nt) { const int per = 16 * nN, g = t / per, w = t % per; mt = g * 16 + (w & 15); nt = w >> 4; }

__device__ __forceinline__ int rowmap(int mode, int n) {
    if (mode == 1) return n < 672 ? n : n + 96;
    if (mode == 2) return n < DFF ? ((n >> 5) * 64 + (n & 31)) : (((n - DFF) >> 5) * 64 + 32 + ((n - DFF) & 31));
    return n;
}
__device__ __forceinline__ void convert_T(const float* __restrict__ src, int K, int N, bf16_t* __restrict__ dst, int mode, const float* __restrict__ ks, unsigned char* lds, int rot) {
    float* tile = (float*)lds;
    const int ntk = K / 64, ntn = (N + 63) / 64, tid = ltid();
    const int start = (blockIdx.x + gridDim.x - (rot % gridDim.x)) % gridDim.x;
    for (int t = start; t < ntk * ntn; t += gridDim.x) {
        const int tk = t % ntk, tn = t / ntk, k0 = tk * 64, n0 = tn * 64;
#pragma unroll
        for (int i = 0; i < 8; ++i) {
            const int kl = (tid >> 6) + 8 * i, nl = tid & 63, n = n0 + nl;
            tile[kl * 65 + nl] = n < N ? src[(size_t)(k0 + kl) * N + n] : 0.f;
        }
        __syncthreads();
        const int kp = (tid & 31) * 2;
        float s0 = 1.f, s1 = 1.f;
        if (ks) { s0 = ks[k0 + kp]; s1 = ks[k0 + kp + 1]; }
#pragma unroll
        for (int i = 0; i < 4; ++i) {
            const int nl = (tid >> 5) + 16 * i, n = n0 + nl;
            if (n < N) *(unsigned*)(dst + (size_t)rowmap(mode, n) * K + k0 + kp) = pk_bf16(tile[kp * 65 + nl] * s0, tile[(kp + 1) * 65 + nl] * s1);
        }
        __syncthreads();
    }
}
__device__ __forceinline__ void convert_layer(const Params& pin, int l, unsigned char* lds) {
    const Params p = launder(pin); l = launder_i(l);
    bf16_t* W = (bf16_t*)(p.ws + OFF_W);
    convert_T(p.w_in + (size_t)l * DM * DIN, DM, DIN, W + WO_IN, 1, nullptr, lds, 0);
    convert_T(p.ffn_w13 + (size_t)l * DM * 2 * DFF, DM, 2 * DFF, W + WO_13, 2, nullptr, lds, 40);
    convert_T(p.ffn_w2 + (size_t)l * DFF * DM, DFF, DM, W + WO_2, 0, nullptr, lds, 80);
    convert_T(p.w_out + (size_t)l * DM * DM, DM, DM, W + WO_OUT, 0, nullptr, lds, 120);
    convert_T(p.w_o_attn + (size_t)l * 512 * DM, 512, DM, W + WO_OA, 0, nullptr, lds, 136);
    convert_T(p.w_o_conv + (size_t)l * 512 * DM, 512, DM, W + WO_OC, 0, nullptr, lds, 8);
    convert_T(p.w_o_rwkv + (size_t)l * 512 * DM, 512, DM, W + WO_OR, 0, nullptr, lds, 136 + 8);
    convert_T(p.w_uq + (size_t)l * 384 * 768, 384, 768, W + WO_UQ, 0, p.q_norm + l * 384, lds, 16);
    convert_T(p.w_ukv + (size_t)l * 256 * 1024, 256, 1024, W + WO_UKV, 0, p.kv_norm + l * 256, lds, 88);
    for (int z = 0; z < 2; ++z) {
        convert_T(p.rw_w_up + ((size_t)l * 2 + z) * 64 * 512, 64, 512, W + WO_UP + (size_t)z * 512 * 64, 0, nullptr, lds, 152 + 8 * z);
        convert_T(p.rw_a_up + ((size_t)l * 2 + z) * 64 * 512, 64, 512, W + WO_AUP + (size_t)z * 512 * 64, 0, nullptr, lds, 168 + 8 * z);
    }
    convert_T(p.rw_g_up + (size_t)l * 128 * 512, 128, 512, W + WO_GUP, 0, nullptr, lds, 184);
}

__device__ __forceinline__ void modv_phase(const Params& pin, unsigned char* lds) {
    const Params p = launder(pin);
    float* s = (float*)lds;
    float* red = s + 17 * 1024;
    const int tid = ltid(), wid = tid >> 6, lane = tid & 63;
    for (int i = tid; i < 17 * 1024; i += NTHREADS) { const int r = i >> 10, k = i & 1023; const float v = r < 16 ? p.c[r * 1024 + k] : p.c_ctx[k]; s[i] = siluf_(v); }
    __syncthreads();
    float* modv = (float*)(p.ws + OFF_MODV);
    for (int g = blockIdx.x; g < 4 * 96; g += gridDim.x) {
        const int l = g / 96, n = (g % 96) * 64 + lane;
        const float* w = p.mod_w + (size_t)l * 1024 * 6144 + n;
        float acc[17];
#pragma unroll
        for (int r = 0; r < 17; ++r) acc[r] = 0.f;
        const int kb = wid * 128;
        for (int k = kb; k < kb + 128; k += 4) {
            const float w0 = w[(size_t)k * 6144], w1 = w[(size_t)(k + 1) * 6144], w2 = w[(size_t)(k + 2) * 6144], w3 = w[(size_t)(k + 3) * 6144];
#pragma unroll
            for (int r = 0; r < 17; ++r) { const f32x4 sv = *(const f32x4*)(s + r * 1024 + k); acc[r] += sv[0] * w0 + sv[1] * w1 + sv[2] * w2 + sv[3] * w3; }
        }
#pragma unroll
        for (int r = 0; r < 17; ++r) red[(wid * 17 + r) * 64 + lane] = acc[r];
        __syncthreads();
        for (int i = tid; i < 17 * 64; i += NTHREADS) {
            const int r = i >> 6, c = i & 63; float v = 0.f;
#pragma unroll
            for (int w8 = 0; w8 < 8; ++w8) v += red[(w8 * 17 + r) * 64 + c];
            const int nn = (g % 96) * 64 + c;
            modv[((size_t)l * 17 + r) * 6144 + nn] = v + p.mod_b[l * 6144 + nn];
        }
        __syncthreads();
    }
    if (blockIdx.x == gridDim.x - 1) {
        float* rope = (float*)(p.ws + OFF_ROPE);
        for (int i = tid; i < 512; i += NTHREADS) {
            const int pos = i >> 3, f = i & 7;
            const float inv = exp2f(-(float)f * (13.287712379549449f / 8.0f));
            const float ang = (float)pos * inv;
            rope[i * 2] = cosf(ang); rope[i * 2 + 1] = sinf(ang);
        }
    }
}

__device__ __forceinline__ void xmod0_phase(const Params& pin) {
    const Params p = launder(pin);
    const int tid = ltid(), wid = tid >> 6, lane = tid & 63;
    bf16_t* xm = (bf16_t*)(p.ws + OFF_R6);
    for (int row = blockIdx.x * 8 + wid; row < MROWS; row += gridDim.x * 8) {
        const int b = row / TPB, pp = row % TPB;
        const float* xp = x_rd(p, true, b, pp);
        const float* mv = modv_ptr(p, 0, b, pp);
#pragma unroll
        for (int i = 0; i < 4; ++i) {
            const int c = i * 256 + lane * 4;
            const f32x4 v = *(const f32x4*)(xp + c), sh = *(const f32x4*)(mv + c), sc = *(const f32x4*)(mv + 1024 + c);
            uint2 o; o.x = pk_bf16(v[0] * (1.f + sc[0]) + sh[0], v[1] * (1.f + sc[1]) + sh[1]); o.y = pk_bf16(v[2] * (1.f + sc[2]) + sh[2], v[3] * (1.f + sc[3]) + sh[3]);
            *(uint2*)(xm + (size_t)row * 1024 + c) = o;
        }
    }
}

__device__ __forceinline__ void p1_phase(const Params& pin, unsigned char* lds) {
    const Params p = launder(pin); const int tid = ltid();
    const bf16_t* A = (const bf16_t*)(p.ws + OFF_R6);
    const bf16_t* W = (const bf16_t*)(p.ws + OFF_W) + WO_IN;
    const int lane = tid & 63, wid = tid >> 6, wr = wid >> 2, wc = wid & 3, fr = lane & 15, fq = lane >> 4;
    auto seg = [&](int t) { int mt, nt; tile_mn(t, 17, mt, nt); Seg g; g.A = A + (size_t)mt * 256 * 1024; g.Bt = W + (size_t)nt * 256 * 1024; g.lda = 1024; g.a_kstep = 64; g.ldb = 1024; g.nk = 16; return g; };
    int st = 0; bool first = true;
    for (int t = blockIdx.x; t < 144 * 17; t += gridDim.x) {
        int mt, nt; tile_mn(t, 17, mt, nt);
        const int tn = t + gridDim.x; const bool hn = tn < 144 * 17;
        f32x4 acc[8][4]; zero_acc<8>(acc);
        gemm_stream256(acc, seg(t), seg(hn ? tn : t), hn, first, st, lds, tid); first = false;
        bf16_t* dst; int ld, cb, lim;
        if (nt < 3) { dst = (bf16_t*)(p.ws + OFF_R1); ld = 672; cb = nt * 256; lim = 672; }
        else if (nt < 9) { dst = (bf16_t*)(p.ws + OFF_R2); ld = 1536; cb = (nt - 3) * 256; lim = 1536; }
        else { dst = (bf16_t*)(p.ws + OFF_R3); ld = 1920; cb = (nt - 9) * 256; lim = 1920; }
#pragma unroll
        for (int m = 0; m < 8; ++m) {
            const size_t row = (size_t)mt * 256 + wr * 128 + m * 16 + fr;
#pragma unroll
            for (int n = 0; n < 4; n += 2) {
                uint2 a, b2;
                a.x = pk_bf16(acc[m][n][0], acc[m][n][1]); a.y = pk_bf16(acc[m][n][2], acc[m][n][3]);
                b2.x = pk_bf16(acc[m][n + 1][0], acc[m][n + 1][1]); b2.y = pk_bf16(acc[m][n + 1][2], acc[m][n + 1][3]);
                const uint4 w = widen16(a, b2);
                const int col = cb + wc * 64 + (n + (fq & 1)) * 16 + (fq >> 1) * 8;
                if (col < lim) *(uint4*)(dst + row * ld + col) = w;
            }
        }
    }
}

__device__ __forceinline__ void unpack8(const uint4 u, float (&f)[8]) {
    f[0] = bf_lo(u.x); f[1] = bf_hi(u.x); f[2] = bf_lo(u.y); f[3] = bf_hi(u.y); f[4] = bf_lo(u.z); f[5] = bf_hi(u.z); f[6] = bf_lo(u.w); f[7] = bf_hi(u.w);
}
__device__ __forceinline__ void p2a_phase(const Params& pin, int l) {
    const Params p = launder(pin); l = launder_i(l);
    const int tid = ltid(), wid = tid >> 6, lane = tid & 63;
    const bf16_t* Hm = (const bf16_t*)(p.ws + OFF_R1);
    const bf16_t* Hc = (const bf16_t*)(p.ws + OFF_R2);
    bf16_t* CV = (bf16_t*)(p.ws + OFF_R5);
    bf16_t* KR = (bf16_t*)(p.ws + OFF_KR);
    float* RSQ = (float*)(p.ws + OFF_RSQ);
    float* RSKV = (float*)(p.ws + OFF_RSKV);
    const float* rope = (const float*)(p.ws + OFF_ROPE);
    const float* cw = p.conv_w + (size_t)l * 3 * 512;
    const int c0 = lane * 8;
    float w0[8], w1[8], w2[8];
#pragma unroll
    for (int i = 0; i < 8; ++i) { w0[i] = cw[c0 + i]; w1[i] = cw[512 + c0 + i]; w2[i] = cw[1024 + c0 + i]; }
    for (int row = blockIdx.x * 8 + wid; row < MROWS; row += gridDim.x * 8) {
        const int pp = row % TPB;
        const bool hp = (pp != 0 && pp != CTXL), hn = (pp != CTXL - 1 && pp != TPB - 1);
        const bf16_t* hr = Hc + (size_t)row * 1536;
        float ch[8], cc[8], cb[8], u0[8], u1[8], u2[8];
        unpack8(*(const uint4*)(hr + c0), ch); unpack8(*(const uint4*)(hr + 1024 + c0), cc); unpack8(*(const uint4*)(hr + 512 + c0), cb);
#pragma unroll
        for (int i = 0; i < 8; ++i) u1[i] = cc[i] * ch[i];
        if (hp) { unpack8(*(const uint4*)(hr - 1536 + c0), ch); unpack8(*(const uint4*)(hr - 1536 + 1024 + c0), cc);
#pragma unroll
            for (int i = 0; i < 8; ++i) u0[i] = cc[i] * ch[i]; }
        else {
#pragma unroll
            for (int i = 0; i < 8; ++i) u0[i] = 0.f; }
        if (hn) { unpack8(*(const uint4*)(hr + 1536 + c0), ch); unpack8(*(const uint4*)(hr + 1536 + 1024 + c0), cc);
#pragma unroll
            for (int i = 0; i < 8; ++i) u2[i] = cc[i] * ch[i]; }
        else {
#pragma unroll
            for (int i = 0; i < 8; ++i) u2[i] = 0.f; }
        float o[8];
#pragma unroll
        for (int i = 0; i < 8; ++i) o[i] = cb[i] * (u0[i] * w0[i] + u1[i] * w1[i] + u2[i] * w2[i]);
        uint4 ov; ov.x = pk_bf16(o[0], o[1]); ov.y = pk_bf16(o[2], o[3]); ov.z = pk_bf16(o[4], o[5]); ov.w = pk_bf16(o[6], o[7]);
        *(uint4*)(CV + (size_t)row * 512 + c0) = ov;
        const bf16_t* hm = Hm + (size_t)row * 672;
        float sq = 0.f, skv = 0.f;
        if (lane < 48) { float f[8]; unpack8(*(const uint4*)(hm + lane * 8), f);
#pragma unroll
            for (int i = 0; i < 8; ++i) sq += f[i] * f[i]; }
        if (lane < 32) { float f[8]; unpack8(*(const uint4*)(hm + 384 + lane * 8), f);
#pragma unroll
            for (int i = 0; i < 8; ++i) skv += f[i] * f[i]; }
        sq = wave_sum(sq); skv = wave_sum(skv);
        if (lane == 0) { RSQ[row] = __builtin_amdgcn_rsqf(sq * (1.0f / 384.0f) + 1e-6f); RSKV[row] = __builtin_amdgcn_rsqf(skv * (1.0f / 256.0f) + 1e-6f); }
        {
            const int j = lane & 31;
            float v = bf1(hm[640 + j]);
            const float other = __shfl_xor(v, 8);
            if (pp >= CTXL) {
                const int tt = pp - CTXL;
                const int pos = (j < 16) ? (tt >> 6) : (tt & 63);
                const float cs = rope[(pos * 8 + (j & 7)) * 2], sn = rope[(pos * 8 + (j & 7)) * 2 + 1];
                v = (j & 8) ? (other * sn + v * cs) : (v * cs - other * sn);
            }
            if (lane < 32) KR[(size_t)row * 32 + j] = (bf16_t)(pk_bf16(v, v) & 0xffffu);
        }
    }
}

__device__ __forceinline__ void p2b_phase(const Params& pin, int l, unsigned char* lds) {
    const Params p = launder(pin); l = launder_i(l); const int tid = ltid();
    const bf16_t* Hm = (const bf16_t*)(p.ws + OFF_R1);
    const bf16_t* W = (const bf16_t*)(p.ws + OFF_W);
    const float* RSQ = (const float*)(p.ws + OFF_RSQ);
    const float* RSKV = (const float*)(p.ws + OFF_RSKV);
    const float* rope = (const float*)(p.ws + OFF_ROPE);
    bf16_t* Q = (bf16_t*)(p.ws + OFF_Q);
    bf16_t* KN = (bf16_t*)(p.ws + OFF_KN);
    bf16_t* VT = (bf16_t*)(p.ws + OFF_VT);
    const int lane = tid & 63, wid = tid >> 6, wr = wid >> 1, wc = wid & 1, fr = lane & 15, fq = lane >> 4;
    const int NQ = 144 * 6, NKV = 144 * 8;
    for (int t = blockIdx.x; t < NQ + NKV; t += gridDim.x) {
        f32x4 acc[4][4]; zero_acc<4>(acc);
        if (t < NQ) {
            int mt, nt; tile_mn(t, 6, mt, nt);
            gemm_mainloop<4, 1>(acc, Hm + (size_t)mt * 256 * 672, 672, 64, W + WO_UQ + (size_t)nt * 128 * 384, 384, 6, lds, tid);
            const int pp0 = (mt % 9) * 256; const bool latent = pp0 >= CTXL;
#pragma unroll
            for (int m = 0; m < 4; ++m) {
                const int lrow = wr * 64 + m * 16 + fr;
                const size_t row = (size_t)mt * 256 + lrow;
                const float sc = RSQ[row] * QSCALE;
                const int tt = pp0 + lrow - CTXL;
                uint2 qpk[4];
#pragma unroll
                for (int n = 0; n < 4; ++n) {
                    const int c16 = nt * 128 + wc * 64 + n * 16, r96 = c16 % 96;
                    float v[4];
#pragma unroll
                    for (int j = 0; j < 4; ++j) v[j] = acc[m][n][j] * sc;
                    if (latent && r96 >= 64) {
                        const int pos = (r96 == 64) ? (tt >> 6) : (tt & 63);
#pragma unroll
                        for (int j = 0; j < 4; ++j) {
                            const float other = __shfl_xor(v[j], 32);
                            const int fi = (fq & 1) * 4 + j;
                            const float cs = rope[(pos * 8 + fi) * 2], sn = rope[(pos * 8 + fi) * 2 + 1];
                            v[j] = (fq & 2) ? (other * sn + v[j] * cs) : (v[j] * cs - other * sn);
                        }
                    }
                    qpk[n].x = pk_bf16(v[0], v[1]); qpk[n].y = pk_bf16(v[2], v[3]);
                }
#pragma unroll
                for (int n = 0; n < 4; n += 2)
                    *(uint4*)(Q + row * 768 + nt * 128 + wc * 64 + (n + (fq & 1)) * 16 + (fq >> 1) * 8) = widen16(qpk[n], qpk[n + 1]);
            }
        } else {
            int mt, nt; tile_mn(t - NQ, 8, mt, nt);
            gemm_mainloop<4, 2>(acc, Hm + (size_t)mt * 256 * 672 + 384, 672, 64, W + WO_UKV + (size_t)nt * 128 * 256, 256, 4, lds, tid);
            const int b = mt / 9, pp0 = (mt % 9) * 256;
            if (wc == 0) {
#pragma unroll
                for (int m = 0; m < 4; ++m) {
                    const size_t row = (size_t)mt * 256 + wr * 64 + m * 16 + fr;
                    const float sc = RSKV[row];
#pragma unroll
                    for (int n = 0; n < 4; n += 2) {
                        uint2 a, b2;
                        a.x = pk_bf16(acc[m][n][0] * sc, acc[m][n][1] * sc); a.y = pk_bf16(acc[m][n][2] * sc, acc[m][n][3] * sc);
                        b2.x = pk_bf16(acc[m][n + 1][0] * sc, acc[m][n + 1][1] * sc); b2.y = pk_bf16(acc[m][n + 1][2] * sc, acc[m][n + 1][3] * sc);
                        *(uint4*)(KN + row * 512 + nt * 64 + (n + (fq & 1)) * 16 + (fq >> 1) * 8) = widen16(a, b2);
                    }
                }
            } else {
#pragma unroll
                for (int m = 0; m < 4; ++m) {
                    const int lrow = wr * 64 + m * 16 + fq * 4;
                    const f32x4 sc = *(const f32x4*)(RSKV + (size_t)mt * 256 + lrow);
#pragma unroll
                    for (int n = 0; n < 4; n += 2) {
                        uint2 a, b2;
                        a.x = pk_bf16(acc[m][n][0] * sc[0], acc[m][n][1] * sc[1]); a.y = pk_bf16(acc[m][n][2] * sc[2], acc[m][n][3] * sc[3]);
                        b2.x = pk_bf16(acc[m][n + 1][0] * sc[0], acc[m][n + 1][1] * sc[1]); b2.y = pk_bf16(acc[m][n + 1][2] * sc[2], acc[m][n + 1][3] * sc[3]);
                        const int dv = (n + (fq & 1)) * 16 + fr;
                        *(uint4*)(VT + ((size_t)(b * 8 + nt) * 64 + dv) * TPB + pp0 + wr * 64 + m * 16 + (fq >> 1) * 8) = widen16(a, b2);
                    }
                }
            }
        }
    }
    {
        const bf16_t* Hr = (const bf16_t*)(p.ws + OFF_R3);
        bf16_t* SG = (bf16_t*)(p.ws + OFF_SG);
        const float* mu = p.rw_mu + (size_t)l * 1920 + 1792;
        for (int i = blockIdx.x * NTHREADS + tid; i < MROWS * 16; i += gridDim.x * NTHREADS) {
            const int row = i >> 4, c0 = (i & 15) * 8, pp = row % TPB;
            const bool hp = (pp != 0 && pp != CTXL), hn = (pp != CTXL - 1 && pp != TPB - 1);
            const bf16_t* hr = Hr + (size_t)row * 1920 + 1792 + c0;
            float cur[8], pv[8], nx[8];
            unpack8(*(const uint4*)hr, cur);
            if (hp) unpack8(*(const uint4*)(hr - 1920), pv); else {
#pragma unroll
                for (int k = 0; k < 8; ++k) pv[k] = 0.f; }
            if (hn) unpack8(*(const uint4*)(hr + 1920), nx); else {
#pragma unroll
                for (int k = 0; k < 8; ++k) nx[k] = 0.f; }
            float o[8];
#pragma unroll
            for (int k = 0; k < 8; ++k) o[k] = sigmoidf_(cur[k] + (0.5f * (pv[k] + nx[k]) - cur[k]) * mu[c0 + k]);
            uint4 ov; ov.x = pk_bf16(o[0], o[1]); ov.y = pk_bf16(o[2], o[3]); ov.z = pk_bf16(o[4], o[5]); ov.w = pk_bf16(o[6], o[7]);
            *(uint4*)(SG + (size_t)row * 128 + c0) = ov;
        }
    }
}

#define FMAC_BC(acc, coef, s, J) asm("v_fmac_f32_dpp %0, %1, %2 row_newbcast:" #J " row_mask:0xf bank_mask:0xf" : "+v"(acc) : "v"(coef), "v"(s))
#define MUL_BC(dst, coef, s, J) asm("v_mul_f32_dpp %0, %1, %2 row_newbcast:" #J " row_mask:0xf bank_mask:0xf" : "=v"(dst) : "v"(coef), "v"(s))
#define REP16(X) X(0, 0) X(1, 1) X(2, 2) X(3, 3) X(4, 0) X(5, 1) X(6, 2) X(7, 3) X(8, 0) X(9, 1) X(10, 2) X(11, 3) X(12, 0) X(13, 1) X(14, 2) X(15, 3)
constexpr int FSTR = 6 * 64 + 4;
constexpr int CHUNK = 32, NCHUNK = TPB / CHUNK;

__device__ __forceinline__ int scan_pos(int z, int s) { return z == 0 ? s : (s < CTXL ? (CTXL - 1 - s) : (TPB + CTXL - 1 - s)); }

__device__ __forceinline__ void shift4(const bf16_t* hr, bool hp, bool hn, int col, const float* mu, float (&o)[4]) {
    const uint2 c = *(const uint2*)(hr + col);
    uint2 a = make_uint2(0u, 0u), b = make_uint2(0u, 0u);
    if (hp) a = *(const uint2*)(hr - 1920 + col);
    if (hn) b = *(const uint2*)(hr + 1920 + col);
    const f32x4 m = *(const f32x4*)(mu + col);
    const float cv[4] = {bf_lo(c.x), bf_hi(c.x), bf_lo(c.y), bf_hi(c.y)};
    const float av[4] = {bf_lo(a.x), bf_hi(a.x), bf_lo(a.y), bf_hi(a.y)};
    const float bv[4] = {bf_lo(b.x), bf_hi(b.x), bf_lo(b.y), bf_hi(b.y)};
#pragma unroll
    for (int i = 0; i < 4; ++i) o[i] = cv[i] + (0.5f * (av[i] + bv[i]) - cv[i]) * m[i];
}
__device__ __forceinline__ void shift8(const bf16_t* hr, bool hp, bool hn, int col, const float* mu, float (&o)[8]) {
    float cv[8], av[8], bv[8];
    unpack8(*(const uint4*)(hr + col), cv);
    if (hp) unpack8(*(const uint4*)(hr - 1920 + col), av); else {
#pragma unroll
        for (int i = 0; i < 8; ++i) av[i] = 0.f; }
    if (hn) unpack8(*(const uint4*)(hr + 1920 + col), bv); else {
#pragma unroll
        for (int i = 0; i < 8; ++i) bv[i] = 0.f; }
#pragma unroll
    for (int i = 0; i < 8; ++i) o[i] = cv[i] + (0.5f * (av[i] + bv[i]) - cv[i]) * mu[col + i];
}
__device__ __forceinline__ bf16x8 pack8(const float (&f)[8]) {
    union { uint4 u; bf16x8 v; } r;
    r.u.x = pk_bf16(f[0], f[1]); r.u.y = pk_bf16(f[2], f[3]); r.u.z = pk_bf16(f[4], f[5]); r.u.w = pk_bf16(f[6], f[7]);
    return r.v;
}

struct ProdState { f32x4 aw[4], aa[4]; };
struct Raw3x2 { uint2 c, a, b; };
__device__ __forceinline__ Raw3x2 ld3x2(const bf16_t* pc, const bf16_t* pa, const bf16_t* pb, bool hp, bool hn, int col) {
    Raw3x2 r; r.c = *(const uint2*)(pc + col); r.a = *(const uint2*)(pa + col); r.b = *(const uint2*)(pb + col);
    if (!hp) r.a = make_uint2(0u, 0u);
    if (!hn) r.b = make_uint2(0u, 0u);
    return r;
}
__device__ __forceinline__ void sh4(const Raw3x2& r, const f32x4 m, float (&o)[4]) {
    const float cv[4] = {bf_lo(r.c.x), bf_hi(r.c.x), bf_lo(r.c.y), bf_hi(r.c.y)};
    const float av[4] = {bf_lo(r.a.x), bf_hi(r.a.x), bf_lo(r.a.y), bf_hi(r.a.y)};
    const float bv[4] = {bf_lo(r.b.x), bf_hi(r.b.x), bf_lo(r.b.y), bf_hi(r.b.y)};
#pragma unroll
    for (int i = 0; i < 4; ++i) o[i] = cv[i] + (0.5f * (av[i] + bv[i]) - cv[i]) * m[i];
}
struct Raw3x4 { uint4 c, a, b; };
__device__ __forceinline__ Raw3x4 ld3x4(const bf16_t* pc, const bf16_t* pa, const bf16_t* pb, bool hp, bool hn, int col) {
    Raw3x4 r; r.c = *(const uint4*)(pc + col); r.a = *(const uint4*)(pa + col); r.b = *(const uint4*)(pb + col);
    if (!hp) r.a = make_uint4(0u, 0u, 0u, 0u);
    if (!hn) r.b = make_uint4(0u, 0u, 0u, 0u);
    return r;
}
__device__ __forceinline__ void sh8(const Raw3x4& r, const float* m, float (&o)[8]) {
    float cv[8], av[8], bv[8];
    unpack8(r.c, cv); unpack8(r.a, av); unpack8(r.b, bv);
    const f32x4 m0 = *(const f32x4*)m, m1 = *(const f32x4*)(m + 4);
#pragma unroll
    for (int i = 0; i < 8; ++i) o[i] = cv[i] + (0.5f * (av[i] + bv[i]) - cv[i]) * (i < 4 ? m0[i] : m1[i - 4]);
}
template <int N0>
__device__ __forceinline__ void scan_produce_elem(const float* pl, int fq, const Raw3x2 (&rr)[2], const Raw3x2 (&rk)[2], const Raw3x2 (&rv)[2],
                                                  const f32x4 (&aw)[2], const f32x4 (&aa)[2], float& ss, float* frow) {
#pragma unroll
    for (int nn = 0; nn < 2; ++nn) {
        const int n = N0 + nn;
        const int c4 = n * 16 + fq * 4;
        float r4[4], k4[4], v4[4];
        sh4(rr[nn], *(const f32x4*)(pl + 0 * 64 + c4), r4);
        sh4(rk[nn], *(const f32x4*)(pl + 1 * 64 + c4), k4);
        sh4(rv[nn], *(const f32x4*)(pl + 2 * 64 + c4), v4);
        const f32x4 w0 = *(const f32x4*)(pl + 3 * 64 + c4);
        const f32x4 a0 = *(const f32x4*)(pl + 4 * 64 + c4);
        const f32x4 kkp = *(const f32x4*)(pl + 5 * 64 + c4);
        const f32x4 kap = *(const f32x4*)(pl + 6 * 64 + c4);
        f32x4 dw, kd, kf4, a4;
#pragma unroll
        for (int j = 0; j < 4; ++j) {
            const float sgx = __builtin_amdgcn_rcpf(1.0f + fexp(-(aw[nn][j] + w0[j])));
            dw[j] = fexp(-0.6065306597126334f * sgx);
            const float a = __builtin_amdgcn_rcpf(1.0f + fexp(-(aa[nn][j] + a0[j])));
            a4[j] = a;
            const float kf = k4[j] * kkp[j];
            kf4[j] = kf; ss += kf * kf;
            kd[j] = k4[j] * (1.0f + (a - 1.0f) * kap[j]);
        }
        *(f32x4*)(frow + 0 * 64 + c4) = kf4;
        *(f32x4*)(frow + 1 * 64 + c4) = dw;
        *(f32x4*)(frow + 2 * 64 + c4) = a4;
        *(f32x4*)(frow + 3 * 64 + c4) = kd;
        *(f32x4*)(frow + 4 * 64 + c4) = (f32x4){r4[0], r4[1], r4[2], r4[3]};
        *(f32x4*)(frow + 5 * 64 + c4) = (f32x4){v4[0], v4[1], v4[2], v4[3]};
    }
}
__device__ __forceinline__ void scan_produce_A(const Params& p, const float* pl, int b, int h, int z, int s0, float* frow0, int lane, ProdState& st) {
    const int fr = lane & 15, fq = lane >> 4;
    const int pp = scan_pos(z, s0 + fr);
    const bool hp = (pp != 0 && pp != CTXL), hn = (pp != CTXL - 1 && pp != TPB - 1);
    const bf16_t* hr = (const bf16_t*)(p.ws + OFF_R3) + ((size_t)b * TPB + pp) * 1920;
    const bf16_t* W = (const bf16_t*)(p.ws + OFF_W);
    Raw3x4 qw[2], qa[2];
    const bf16_t* pc = hr + z * 64 + fq * 8; const bf16_t* pa = hp ? pc - 1920 : pc; const bf16_t* pb = hn ? pc + 1920 : pc;
#pragma unroll
    for (int ks = 0; ks < 2; ++ks) { qw[ks] = ld3x4(pc, pa, pb, hp, hn, 1536 + ks * 32); qa[ks] = ld3x4(pc, pa, pb, hp, hn, 1664 + ks * 32); }
    f32x4 accw[4], acca[4];
#pragma unroll
    for (int n = 0; n < 4; ++n) { accw[n] = (f32x4){0.f, 0.f, 0.f, 0.f}; acca[n] = (f32x4){0.f, 0.f, 0.f, 0.f}; }
#pragma unroll
    for (int ks = 0; ks < 2; ++ks) {
        bf16x8 bw[4], ba[4];
#pragma unroll
        for (int n = 0; n < 4; ++n) {
            const size_t wo = ((size_t)z * 512 + h * 64 + n * 16 + fr) * 64 + ks * 32 + fq * 8;
            bw[n] = *(const bf16x8*)(W + WO_UP + wo); ba[n] = *(const bf16x8*)(W + WO_AUP + wo);
        }
        float t8[8];
        sh8(qw[ks], pl + 7 * 64 + ks * 32 + fq * 8, t8);
#pragma unroll
        for (int i = 0; i < 8; ++i) { const float e = fexp(2.0f * t8[i]); t8[i] = 1.0f - 2.0f * __builtin_amdgcn_rcpf(e + 1.0f); }
        const bf16x8 aw = pack8(t8);
        sh8(qa[ks], pl + 8 * 64 + ks * 32 + fq * 8, t8);
        const bf16x8 aa = pack8(t8);
#pragma unroll
        for (int n = 0; n < 4; ++n) {
            accw[n] = __builtin_amdgcn_mfma_f32_16x16x32_bf16(bw[n], aw, accw[n], 0, 0, 0);
            acca[n] = __builtin_amdgcn_mfma_f32_16x16x32_bf16(ba[n], aa, acca[n], 0, 0, 0);
        }
    }
#pragma unroll
    for (int n = 0; n < 4; ++n) { st.aw[n] = accw[n]; st.aa[n] = acca[n]; }
}
__device__ __forceinline__ void scan_produce_B(const Params& p, const float* pl, int b, int h, int z, int s0, float* frow0, int lane, const ProdState& st) {
    const int fr = lane & 15, fq = lane >> 4;
    const int pp = scan_pos(z, s0 + fr);
    const bool hp = (pp != 0 && pp != CTXL), hn = (pp != CTXL - 1 && pp != TPB - 1);
    const bf16_t* hr = (const bf16_t*)(p.ws + OFF_R3) + ((size_t)b * TPB + pp) * 1920;
    Raw3x2 rr0[2], rk0[2], rv0[2], rr1[2], rk1[2], rv1[2];
    const bf16_t* pc = hr + h * 64 + fq * 4; const bf16_t* pa = hp ? pc - 1920 : pc; const bf16_t* pb = hn ? pc + 1920 : pc;
#pragma unroll
    for (int nn = 0; nn < 2; ++nn) {
        const int C4 = nn * 16, C5 = C4 + 32;
        rr0[nn] = ld3x2(pc, pa, pb, hp, hn, C4); rk0[nn] = ld3x2(pc, pa, pb, hp, hn, 512 + C4); rv0[nn] = ld3x2(pc, pa, pb, hp, hn, 1024 + C4);
        rr1[nn] = ld3x2(pc, pa, pb, hp, hn, C5); rk1[nn] = ld3x2(pc, pa, pb, hp, hn, 512 + C5); rv1[nn] = ld3x2(pc, pa, pb, hp, hn, 1024 + C5);
    }
    float ss = 0.f;
    float* frow = frow0 + fr * FSTR;
    const f32x4 w01[2] = {st.aw[0], st.aw[1]}, a01[2] = {st.aa[0], st.aa[1]}, w23[2] = {st.aw[2], st.aw[3]}, a23[2] = {st.aa[2], st.aa[3]};
    scan_produce_elem<0>(pl, fq, rr0, rk0, rv0, w01, a01, ss, frow);
    scan_produce_elem<2>(pl, fq, rr1, rk1, rv1, w23, a23, ss, frow);
    ss = fqsum(ss);
    const float inv = __builtin_amdgcn_rsqf(fmaxf(ss, 1e-24f));
#pragma unroll
    for (int n = 0; n < 4; ++n) {
        const int c4 = n * 16 + fq * 4;
        f32x4 kk = *(const f32x4*)(frow + 0 * 64 + c4);
        f32x4 bb = *(const f32x4*)(frow + 2 * 64 + c4);
#pragma unroll
        for (int j = 0; j < 4; ++j) { kk[j] = kk[j] * inv; bb[j] = kk[j] * bb[j]; }
        *(f32x4*)(frow + 0 * 64 + c4) = kk;
        *(f32x4*)(frow + 2 * 64 + c4) = bb;
    }
}

typedef float f32x2 __attribute__((ext_vector_type(2)));
struct ScanHead { f32x4 kk[2]; f32x2 v; };
struct ScanBody { f32x4 w[2], bb[2], kd[2], r[2]; };
__device__ __forceinline__ void scan_ldh(ScanHead& c, const float* f, const float* fv) {
#pragma unroll
    for (int q = 0; q < 2; ++q) c.kk[q] = *(const f32x4*)(f + 0 * 64 + 4 * q);
    c.v = *(const f32x2*)fv;
}
__device__ __forceinline__ void scan_ldb(ScanBody& c, const float* f) {
#pragma unroll
    for (int q = 0; q < 2; ++q) {
        c.w[q] = *(const f32x4*)(f + 1 * 64 + 4 * q); c.bb[q] = *(const f32x4*)(f + 2 * 64 + 4 * q);
        c.kd[q] = *(const f32x4*)(f + 3 * 64 + 4 * q); c.r[q] = *(const f32x4*)(f + 4 * 64 + 4 * q);
    }
}
__device__ __forceinline__ void scan_unit(const Params& p, int l, int u, unsigned char* lds) {
    const int tid = ltid(), wid = __builtin_amdgcn_readfirstlane(tid >> 6), lane = tid & 63;
    const int b = u >> 4, h = (u >> 1) & 7, z = u & 1;
    float* fb = (float*)lds;
    bf16_t* Y = (bf16_t*)(p.ws + (z == 0 ? OFF_YF : OFF_YB));
    float* pl = fb + 3 * CHUNK * FSTR;
    for (int i = tid; i < 9 * 64; i += NTHREADS) {
        const int a = i >> 6, c = i & 63, C = h * 64 + c;
        float v;
        if (a < 3) v = p.rw_mu[(size_t)l * 1920 + a * 512 + C];
        else if (a == 3) v = p.rw_w0[((size_t)l * 2 + z) * 512 + C];
        else if (a == 4) v = p.rw_a0[((size_t)l * 2 + z) * 512 + C];
        else if (a == 5) v = p.rw_k_k[(size_t)l * 512 + C];
        else if (a == 6) v = p.rw_k_a[(size_t)l * 512 + C];
        else if (a == 7) v = p.rw_mu[(size_t)l * 1920 + 1536 + z * 64 + c];
        else v = p.rw_mu[(size_t)l * 1920 + 1664 + z * 64 + c];
        pl[i] = v;
    }
    __syncthreads();
    if (wid < 4) {
        f32x2 S2[8];
#pragma unroll
        for (int j = 0; j < 8; ++j) S2[j] = (f32x2){0.f, 0.f};
        __syncthreads();
        for (int c = 0; c < NCHUNK; ++c) {
            const float* fbc = fb + (c % 3) * CHUNK * FSTR + 8 * (lane & 7);
            const float* fbv = fb + (c % 3) * CHUNK * FSTR + 320 + 16 * wid + 2 * (lane >> 3);
            bf16_t* yp = Y + ((size_t)b * TPB) * 512 + h * 64 + 16 * wid + 2 * (lane >> 3);
            ScanHead ha, hb;
            scan_ldh(ha, fbc, fbv);
#define SCAN_STEP(HC, HN, SL) { \
                ScanBody bd; scan_ldb(bd, fbc + (SL) * FSTR); \
                if ((SL) + 1 < CHUNK) scan_ldh(HN, fbc + ((SL) + 1) * FSTR, fbv + ((SL) + 1) * FSTR); \
                f32x2 d0 = (f32x2){0.f, 0.f}, d1 = (f32x2){0.f, 0.f}; \
                _Pragma("unroll") for (int q = 0; q < 4; ++q) { const f32x2 k2 = (f32x2){HC.kk[q >> 1][2 * (q & 1)], HC.kk[q >> 1][2 * (q & 1) + 1]}; \
                    d0 = __builtin_elementwise_fma(S2[q], k2, d0); d1 = __builtin_elementwise_fma(S2[4 + q], k2, d1); } \
                const float sk0 = red8(d0[0] + d0[1]), sk1 = red8(d1[0] + d1[1]); \
                const f32x2 n0 = (f32x2){-sk0, -sk0}, n1 = (f32x2){-sk1, -sk1}, v0 = (f32x2){HC.v[0], HC.v[0]}, v1 = (f32x2){HC.v[1], HC.v[1]}; \
                f32x2 y0 = (f32x2){0.f, 0.f}, y1 = (f32x2){0.f, 0.f}; \
                _Pragma("unroll") for (int q = 0; q < 4; ++q) { \
                    const f32x2 w2 = (f32x2){bd.w[q >> 1][2 * (q & 1)], bd.w[q >> 1][2 * (q & 1) + 1]}, b2 = (f32x2){bd.bb[q >> 1][2 * (q & 1)], bd.bb[q >> 1][2 * (q & 1) + 1]}; \
                    const f32x2 kd2 = (f32x2){bd.kd[q >> 1][2 * (q & 1)], bd.kd[q >> 1][2 * (q & 1) + 1]}, r2 = (f32x2){bd.r[q >> 1][2 * (q & 1)], bd.r[q >> 1][2 * (q & 1) + 1]}; \
                    f32x2 t0 = S2[q] * w2; t0 = __builtin_elementwise_fma(b2, n0, t0); t0 = __builtin_elementwise_fma(kd2, v0, t0); \
                    f32x2 t1 = S2[4 + q] * w2; t1 = __builtin_elementwise_fma(b2, n1, t1); t1 = __builtin_elementwise_fma(kd2, v1, t1); \
                    S2[q] = t0; S2[4 + q] = t1; \
                    y0 = __builtin_elementwise_fma(t0, r2, y0); y1 = __builtin_elementwise_fma(t1, r2, y1); } \
                const float ya = red8(y0[0] + y0[1]), yb = red8(y1[0] + y1[1]); \
                const int pp = scan_pos(z, c * CHUNK + (SL)); \
                if ((lane & 7) == 0) *(unsigned*)(yp + (size_t)pp * 512) = pk_bf16(ya, yb); }
#pragma unroll 1
            for (int sl = 0; sl < CHUNK; sl += 2) {
                SCAN_STEP(ha, hb, sl)
                SCAN_STEP(hb, ha, sl + 1)
            }
            __syncthreads();
        }
    } else {
        ProdState st;
#pragma unroll
        for (int n = 0; n < 4; ++n) { st.aw[n] = (f32x4){0.f, 0.f, 0.f, 0.f}; st.aa[n] = (f32x4){0.f, 0.f, 0.f, 0.f}; }
        const int nrep = launder_i(1 + ((PROBE_MASK >> 10) & 1));
        const int pair = (wid - 4) >> 1, ph = (wid - 4) & 1;
        {
            float* f0 = fb + (pair % 3) * CHUNK * FSTR + ph * 16 * FSTR;
            scan_produce_A(p, pl, b, h, z, pair * CHUNK + ph * 16, f0, lane, st);
            if (pair == 0) scan_produce_B(p, pl, b, h, z, ph * 16, f0, lane, st);
        }
        __syncthreads();
        for (int c = 0; c < NCHUNK; ++c) {
            for (int rr_ = 0; rr_ < nrep; ++rr_) {
            if (pair == ((c + 1) & 1)) {
                if (c + 1 < NCHUNK) scan_produce_B(p, pl, b, h, z, (c + 1) * CHUNK + ph * 16, fb + ((c + 1) % 3) * CHUNK * FSTR + ph * 16 * FSTR, lane, st);
            } else {
                if (c + 2 < NCHUNK) scan_produce_A(p, pl, b, h, z, (c + 2) * CHUNK + ph * 16, fb + ((c + 2) % 3) * CHUNK * FSTR + ph * 16 * FSTR, lane, st);
            }
            }
            __syncthreads();
        }
    }
}

constexpr int ATT_STAGE = 20480;
__device__ __forceinline__ void attn_unit(const Params& p, int b, int h, int q0, int nkeys, unsigned char* lds, int do_write) {
    const int tid = ltid(), wid = __builtin_amdgcn_readfirstlane(tid >> 6), lane = tid & 63, fr = lane & 15, fq = lane >> 4;
    bf16_t* Q = (bf16_t*)(p.ws + OFF_Q);
    const bf16_t* KN = (const bf16_t*)(p.ws + OFF_KN);
    const bf16_t* KR = (const bf16_t*)(p.ws + OFF_KR);
    const bf16_t* VT = (const bf16_t*)(p.ws + OFF_VT);
    const size_t rb = (size_t)b * TPB;
    bf16x8 qf[2][3];
#pragma unroll
    for (int nq = 0; nq < 2; ++nq)
#pragma unroll
        for (int ks = 0; ks < 3; ++ks) qf[nq][ks] = *(const bf16x8*)(Q + (rb + q0 + wid * 32 + nq * 16 + fr) * 768 + h * 96 + ks * 32 + fq * 8);
    f32x4 oacc[4][2];
#pragma unroll
    for (int mt = 0; mt < 4; ++mt)
#pragma unroll
        for (int nq = 0; nq < 2; ++nq) oacc[mt][nq] = (f32x4){0.f, 0.f, 0.f, 0.f};
    float mrun[2] = {0.f, 0.f}, lsum[2] = {0.f, 0.f};
    const int c8 = (lane & 7) ^ ((4 * wid + (lane >> 4)) & 7);
    const bf16_t* knp = KN + (rb + 8 * wid + (lane >> 3)) * 512 + h * 64 + c8 * 8;
    const bf16_t* vtp = VT + ((size_t)(b * 8 + h) * 64 + 8 * wid + (lane >> 3)) * TPB + c8 * 8;
    const int c4 = (lane & 3) ^ ((lane >> 4) & 3);
    const bf16_t* krp = KR + (rb + 16 * (wid & 3) + (lane >> 2)) * 32 + c4 * 8;
    auto issue = [&](int t, int stg) {
        unsigned char* base = lds + stg * ATT_STAGE;
        const int k0 = t * 64;
        __builtin_amdgcn_global_load_lds((const GLB_AS unsigned*)(knp + (size_t)k0 * 512), (LDS_AS unsigned*)(base + wid * 1024), 16, 0, 0);
        __builtin_amdgcn_global_load_lds((const GLB_AS unsigned*)(vtp + k0), (LDS_AS unsigned*)(base + 12288 + wid * 1024), 16, 0, 0);
        if (wid < 4) __builtin_amdgcn_global_load_lds((const GLB_AS unsigned*)(krp + (size_t)k0 * 32), (LDS_AS unsigned*)(base + 8192 + wid * 1024), 16, 0, 0);
    };
    const int ntile = nkeys / 64;
    const int kz = fr >> 1, rz = (fr >> 2) & 3;
    issue(0, 0);
    asm volatile("s_waitcnt vmcnt(0)" ::: "memory");
    __builtin_amdgcn_s_barrier();
    asm volatile("" ::: "memory");
    for (int t = 0; t < ntile; ++t) {
        if (t + 1 < ntile) issue(t + 1, (t + 1) & 1);
        const unsigned char* Ks = lds + (t & 1) * ATT_STAGE;
        const unsigned char* Rs = Ks + 8192;
        const unsigned char* Vs = Ks + 12288;
        f32x4 sacc[4][2];
#pragma unroll
        for (int km = 0; km < 4; ++km)
#pragma unroll
            for (int nq = 0; nq < 2; ++nq) sacc[km][nq] = (f32x4){-mrun[nq], -mrun[nq], -mrun[nq], -mrun[nq]};
#pragma unroll
        for (int ks = 0; ks < 3; ++ks)
#pragma unroll
            for (int km = 0; km < 4; ++km) {
                const bf16x8 kf = ks < 2 ? *(const bf16x8*)(Ks + (km * 16 + fr) * 128 + (((ks * 4 + fq) ^ kz) * 16))
                                         : *(const bf16x8*)(Rs + (km * 16 + fr) * 64 + ((fq ^ rz) * 16));
#pragma unroll
                for (int nq = 0; nq < 2; ++nq) sacc[km][nq] = __builtin_amdgcn_mfma_f32_16x16x32_bf16(kf, qf[nq][ks], sacc[km][nq], 0, 0, 0);
            }
        float delta[2];
#pragma unroll
        for (int nq = 0; nq < 2; ++nq) {
            float mx = -1e30f;
#pragma unroll
            for (int km = 0; km < 4; ++km)
#pragma unroll
                for (int j = 0; j < 4; ++j) mx = fmaxf(mx, sacc[km][nq][j]);
            mx = fqmax(mx);
            delta[nq] = (t == 0) ? mx : fmaxf(mx, 0.f);
        }
        const bool exact = (t == 0) || (__builtin_amdgcn_ballot_w64(fmaxf(delta[0], delta[1]) > 60.0f) != 0ull);
        bf16x8 pf[2][2];
        float psum[2];
#pragma unroll
        for (int nq = 0; nq < 2; ++nq) {
            float ps = 0.f;
            if (exact) {
#pragma unroll
                for (int km = 0; km < 4; ++km)
#pragma unroll
                    for (int j = 0; j < 4; ++j) { const float e = __builtin_amdgcn_exp2f(sacc[km][nq][j] - delta[nq]); sacc[km][nq][j] = e; ps += e; }
            } else {
#pragma unroll
                for (int km = 0; km < 4; ++km)
#pragma unroll
                    for (int j = 0; j < 4; ++j) { const float e = __builtin_amdgcn_exp2f(sacc[km][nq][j]); sacc[km][nq][j] = e; ps += e; }
            }
            psum[nq] = ps;
#pragma unroll
            for (int kc = 0; kc < 2; ++kc) {
                union { uint4 u; bf16x8 v; } r;
                r.u.x = pk_bf16(sacc[2 * kc][nq][0], sacc[2 * kc][nq][1]); r.u.y = pk_bf16(sacc[2 * kc][nq][2], sacc[2 * kc][nq][3]);
                r.u.z = pk_bf16(sacc[2 * kc + 1][nq][0], sacc[2 * kc + 1][nq][1]); r.u.w = pk_bf16(sacc[2 * kc + 1][nq][2], sacc[2 * kc + 1][nq][3]);
                pf[kc][nq] = r.v;
            }
        }
        if (exact) {
#pragma unroll
            for (int nq = 0; nq < 2; ++nq) {
                const float alpha = (t == 0) ? 1.0f : __builtin_amdgcn_exp2f(-delta[nq]);
                lsum[nq] = lsum[nq] * alpha + psum[nq];
#pragma unroll
                for (int mt = 0; mt < 4; ++mt) oacc[mt][nq] = oacc[mt][nq] * alpha;
            }
        }
#pragma unroll
        for (int mt = 0; mt < 4; ++mt)
#pragma unroll
            for (int kc = 0; kc < 2; ++kc) {
                union { uint2 h2[2]; bf16x8 v; } r;
                const unsigned char* vrow = Vs + (mt * 16 + fr) * 128 + (fq & 1) * 8;
                r.h2[0] = *(const uint2*)(vrow + (((4 * kc + (fq >> 1)) ^ kz) * 16));
                r.h2[1] = *(const uint2*)(vrow + (((4 * kc + 2 + (fq >> 1)) ^ kz) * 16));
#pragma unroll
                for (int nq = 0; nq < 2; ++nq) oacc[mt][nq] = __builtin_amdgcn_mfma_f32_16x16x32_bf16(r.v, pf[kc][nq], oacc[mt][nq], 0, 0, 0);
            }
        if (!exact) {
#pragma unroll
            for (int nq = 0; nq < 2; ++nq) {
                const float alpha = __builtin_amdgcn_exp2f(-delta[nq]);
                lsum[nq] = (lsum[nq] + psum[nq]) * alpha;
#pragma unroll
                for (int mt = 0; mt < 4; ++mt) oacc[mt][nq] = oacc[mt][nq] * alpha;
            }
        }
#pragma unroll
        for (int nq = 0; nq < 2; ++nq) mrun[nq] += delta[nq];
        asm volatile("s_waitcnt vmcnt(0) lgkmcnt(0)" ::: "memory");
        __builtin_amdgcn_s_barrier();
        asm volatile("" ::: "memory");
    }
#pragma unroll
    for (int nq = 0; nq < 2; ++nq) {
        const float inv = 1.0f / fqsum(lsum[nq]);
        bf16_t* orow = Q + (rb + q0 + wid * 32 + nq * 16 + fr) * 768 + h * 96;
#pragma unroll
        for (int mt = 0; mt < 4; mt += 2) {
            uint2 a, b2;
            a.x = pk_bf16(oacc[mt][nq][0] * inv, oacc[mt][nq][1] * inv); a.y = pk_bf16(oacc[mt][nq][2] * inv, oacc[mt][nq][3] * inv);
            b2.x = pk_bf16(oacc[mt + 1][nq][0] * inv, oacc[mt + 1][nq][1] * inv); b2.y = pk_bf16(oacc[mt + 1][nq][2] * inv, oacc[mt + 1][nq][3] * inv);
            const uint4 w = widen16(a, b2);
            if (do_write) *(uint4*)(orow + (mt + (fq & 1)) * 16 + (fq >> 1) * 8) = w;
        }
    }
}

__device__ __forceinline__ void p3_phase(const Params& pin, int l, unsigned char* lds) {
    const Params p = launder(pin); l = launder_i(l);
    for (int r = 0, nr = launder_i(1 + ((PROBE_MASK >> 1) & 1)); r < nr; ++r)
        for (int u = blockIdx.x; u < 256; u += gridDim.x) scan_unit(p, l, u, lds);
    const int nunits = (l == DEPTH - 1) ? 1024 : 1152;
    for (int r = launder_i(((PROBE_MASK >> 9) & 1) ? 0 : 1); r < 2; ++r)
    for (int u = blockIdx.x; u < nunits; u += gridDim.x) {
        if (u < 1024) { const int bh = u >> 3, qt = u & 7; attn_unit(p, bh >> 3, bh & 7, CTXL + qt * 256, TPB, lds, r); }
        else { const int bh = u - 1024; attn_unit(p, bh >> 3, bh & 7, 0, CTXL, lds, r); }
    }
}

__device__ __forceinline__ void p35_phase(const Params& pin, int l, bool skip_ctx, unsigned char* lds) {
    const Params p = launder(pin); l = launder_i(l); const int tid = ltid();
    const bf16_t* SG = (const bf16_t*)(p.ws + OFF_SG);
    const bf16_t* W = (const bf16_t*)(p.ws + OFF_W) + WO_GUP;
    const bf16_t* YF = (const bf16_t*)(p.ws + OFF_YF);
    const bf16_t* YB = (const bf16_t*)(p.ws + OFF_YB);
    const bf16_t* Hr = (const bf16_t*)(p.ws + OFF_R3);
    bf16_t* RWO = (bf16_t*)(p.ws + OFF_RWO);
    const float* mu = p.rw_mu + (size_t)l * 1920;
    const int lane = tid & 63, wid = tid >> 6, wr = wid >> 1, wc = wid & 1, fr = lane & 15, fq = lane >> 4;
    float* gt = (float*)lds;
    constexpr int GP = 132;
    for (int t = blockIdx.x; t < 288 * 4; t += gridDim.x) {
        int mt, nt; tile_mn(t, 4, mt, nt);
        if (skip_ctx && (mt % 18) < 2) continue;
        f32x4 acc[2][4]; zero_acc<2>(acc);
        gemm_mainloop<2, 1>(acc, SG + (size_t)mt * 128 * 128, 128, 64, W + (size_t)nt * 128 * 128, 128, 2, lds, tid);
#pragma unroll
        for (int m = 0; m < 2; ++m)
#pragma unroll
            for (int n = 0; n < 4; ++n) *(f32x4*)(gt + (wr * 32 + m * 16 + fr) * GP + wc * 64 + n * 16 + fq * 4) = acc[m][n];
        __syncthreads();
        const int pp0 = (mt % 18) * 128;
#pragma unroll 1
        for (int it = 0; it < 4; ++it) {
            const int item = tid + it * NTHREADS, lrow = item >> 4, cg = item & 15, pp = pp0 + lrow;
            const size_t row = (size_t)mt * 128 + lrow;
            const int C = nt * 128 + cg * 8;
            const bool hp = (pp != 0 && pp != CTXL), hn = (pp != CTXL - 1 && pp != TPB - 1);
            const bf16_t* hr = Hr + row * 1920;
            float yf[8], yb[8], r8[8], k8[8], v8[8];
            unpack8(*(const uint4*)(YF + row * 512 + C), yf); unpack8(*(const uint4*)(YB + row * 512 + C), yb);
            shift8(hr, hp, hn, C, mu, r8); shift8(hr, hp, hn, 512 + C, mu, k8); shift8(hr, hp, hn, 1024 + C, mu, v8);
            const float* rkp = p.rw_r_k + (size_t)l * 512 + C;
            float s1 = 0.f, bs = 0.f;
#pragma unroll
            for (int i = 0; i < 8; ++i) { yf[i] += yb[i]; s1 += yf[i]; bs += r8[i] * k8[i] * rkp[i]; }
            s1 = red8(s1); bs = red8(bs);
            const float mean = s1 * (1.0f / 64.0f);
            float s2 = 0.f;
#pragma unroll
            for (int i = 0; i < 8; ++i) { const float d = yf[i] - mean; s2 += d * d; }
            s2 = red8(s2);
            const float rstd = __builtin_amdgcn_rsqf(s2 * (1.0f / 64.0f) + 64e-5f);
            const float* ggp = p.rw_gn_g + (size_t)l * 512 + C; const float* gbp = p.rw_gn_b + (size_t)l * 512 + C;
            const f32x4 g0 = *(const f32x4*)(gt + lrow * GP + cg * 8), g1 = *(const f32x4*)(gt + lrow * GP + cg * 8 + 4);
            float o[8];
#pragma unroll
            for (int i = 0; i < 8; ++i) o[i] = ((yf[i] - mean) * rstd * ggp[i] + gbp[i] + bs * v8[i]) * (i < 4 ? g0[i] : g1[i - 4]);
            uint4 ov; ov.x = pk_bf16(o[0], o[1]); ov.y = pk_bf16(o[2], o[3]); ov.z = pk_bf16(o[4], o[5]); ov.w = pk_bf16(o[6], o[7]);
            *(uint4*)(RWO + row * 512 + C) = ov;
        }
        __syncthreads();
    }
}

__device__ __forceinline__ void p4_phase(const Params& pin, bool skip_ctx, unsigned char* lds) {
    const Params p = launder(pin); const int tid = ltid();
    const bf16_t* XM = (const bf16_t*)(p.ws + OFF_R6);
    const bf16_t* W = (const bf16_t*)(p.ws + OFF_W);
    bf16_t* MG = (bf16_t*)(p.ws + OFF_MRG);
    const int lane = tid & 63, wid = tid >> 6, wr = wid >> 1, wc = wid & 1, fr = lane & 15, fq = lane >> 4;
    for (int t = blockIdx.x; t < 288 * 8; t += gridDim.x) {
        int mt, nt; tile_mn(t, 8, mt, nt);
        if (skip_ctx && (mt % 18) < 2) continue;
        f32x4 g[3][2][4];
#pragma unroll
        for (int i = 0; i < 3; ++i) zero_acc<2>(g[i]);
        gemm_gate3(g, XM + (size_t)mt * 128 * 1024, W + WO_IN + (size_t)(4224 + nt * 128) * 1024, 16, lds, tid);
        typedef __fp16 h16x2 __attribute__((ext_vector_type(2)));
        h16x2 gp[3][2][4][2];
#pragma unroll
        for (int i = 0; i < 3; ++i)
#pragma unroll
            for (int m = 0; m < 2; ++m)
#pragma unroll
                for (int n = 0; n < 4; ++n) {
                    gp[i][m][n][0] = __builtin_amdgcn_cvt_pkrtz(sigmoidf_(g[i][m][n][0]), sigmoidf_(g[i][m][n][1]));
                    gp[i][m][n][1] = __builtin_amdgcn_cvt_pkrtz(sigmoidf_(g[i][m][n][2]), sigmoidf_(g[i][m][n][3]));
                }
        f32x4 mg[2][4]; zero_acc<2>(mg);
#pragma unroll 1
        for (int i = 0; i < 3; ++i) {
            const bf16_t* Ab; int lda, kst; const bf16_t* Wb;
            if (i == 0) { Ab = (const bf16_t*)(p.ws + OFF_Q); lda = 768; kst = 96; Wb = W + WO_OA; }
            else if (i == 1) { Ab = (const bf16_t*)(p.ws + OFF_R5); lda = 512; kst = 64; Wb = W + WO_OC; }
            else { Ab = (const bf16_t*)(p.ws + OFF_RWO); lda = 512; kst = 64; Wb = W + WO_OR; }
            f32x4 a[2][4]; zero_acc<2>(a);
            gemm_mainloop<2, 1>(a, Ab + (size_t)mt * 128 * lda, lda, kst, Wb + (size_t)nt * 128 * 512, 512, 8, lds, tid);
#pragma unroll
            for (int m = 0; m < 2; ++m)
#pragma unroll
                for (int n = 0; n < 4; ++n) {
                    const h16x2 g0 = i == 0 ? gp[0][m][n][0] : (i == 1 ? gp[1][m][n][0] : gp[2][m][n][0]);
                    const h16x2 g1 = i == 0 ? gp[0][m][n][1] : (i == 1 ? gp[1][m][n][1] : gp[2][m][n][1]);
                    mg[m][n][0] += (float)g0[0] * a[m][n][0]; mg[m][n][1] += (float)g0[1] * a[m][n][1];
                    mg[m][n][2] += (float)g1[0] * a[m][n][2]; mg[m][n][3] += (float)g1[1] * a[m][n][3];
                }
        }
#pragma unroll
        for (int m = 0; m < 2; ++m) {
            const size_t row = (size_t)mt * 128 + wr * 32 + m * 16 + fr;
#pragma unroll
            for (int n = 0; n < 4; n += 2) {
                uint2 a, b2;
                a.x = pk_bf16(mg[m][n][0], mg[m][n][1]); a.y = pk_bf16(mg[m][n][2], mg[m][n][3]);
                b2.x = pk_bf16(mg[m][n + 1][0], mg[m][n + 1][1]); b2.y = pk_bf16(mg[m][n + 1][2], mg[m][n + 1][3]);
                *(uint4*)(MG + row * 1024 + nt * 128 + wc * 64 + (n + (fq & 1)) * 16 + (fq >> 1) * 8) = widen16(a, b2);
            }
        }
    }
}

template <int MT>
__device__ __forceinline__ void resid_tile(const Params& p, int l, const bf16_t* A, int lda, int nk, const bf16_t* Wt, int ldb, int goff, bool x_from_input,
                                           const float* lng, const float* lnb, int row0, int nt, unsigned char* lds, int tid) {
    const int lane = tid & 63, wid = tid >> 6, wr = wid >> 1, wc = wid & 1, fr = lane & 15, fq = lane >> 4;
    f32x4 acc[MT][4]; zero_acc<MT>(acc);
    gemm_mainloop<MT, 1>(acc, A + (size_t)row0 * lda, lda, 64, Wt + (size_t)nt * 128 * ldb, ldb, nk, lds, tid);
    const int b = row0 / TPB, pp0 = row0 % TPB;
    const float* gv = modv_ptr(p, l, b, pp0) + goff;
    const float* stats = (const float*)(p.ws + OFF_STATS);
#pragma unroll
    for (int m = 0; m < MT; ++m) {
        const int lr = wr * 16 * MT + m * 16 + fr, pp = pp0 + lr;
        const float* xi = x_rd(p, x_from_input, b, pp);
        float* xo = x_wr(p, b, pp);
        float mean = 0.f, rstd = 1.f;
        if (!x_from_input) { const size_t row = (size_t)row0 + lr; mean = stats[row * 2]; rstd = stats[row * 2 + 1]; }
#pragma unroll
        for (int n = 0; n < 4; ++n) {
            const int col = nt * 128 + wc * 64 + n * 16 + fq * 4;
            f32x4 xv = *(const f32x4*)(xi + col); const f32x4 g4 = *(const f32x4*)(gv + col);
            if (!x_from_input) {
                const f32x4 lg = *(const f32x4*)(lng + col), lb = *(const f32x4*)(lnb + col);
#pragma unroll
                for (int j = 0; j < 4; ++j) xv[j] = (xv[j] - mean) * rstd * lg[j] + lb[j];
            }
            f32x4 o;
#pragma unroll
            for (int j = 0; j < 4; ++j) o[j] = ALPHA * xv[j] + g4[j] * acc[m][n][j];
            *(f32x4*)(xo + col) = o;
        }
    }
}
__device__ __forceinline__ void resid_tile256(const Params& p, int l, const bf16_t* A, int lda, int nk, const bf16_t* Wt, int ldb, int goff, bool x_from_input,
                                              const float* lng, const float* lnb, int row0, int nt256, unsigned char* lds, int tid) {
    const int lane = tid & 63, wid = tid >> 6, wr = wid >> 2, wc = wid & 3, fr = lane & 15, fq = lane >> 4;
    f32x4 acc[8][4]; zero_acc<8>(acc);
    Seg sg; sg.A = A + (size_t)row0 * lda; sg.Bt = Wt + (size_t)nt256 * 256 * ldb; sg.lda = lda; sg.a_kstep = 64; sg.ldb = ldb; sg.nk = nk;
    int st = 0;
    gemm_stream256(acc, sg, sg, false, true, st, lds, tid);
    const int b = row0 / TPB, pp0 = row0 % TPB;
    const float* gv = modv_ptr(p, l, b, pp0) + goff;
    const float* stats = (const float*)(p.ws + OFF_STATS);
#pragma unroll
    for (int m = 0; m < 8; ++m) {
        const int lr = wr * 128 + m * 16 + fr, pp = pp0 + lr;
        const float* xi = x_rd(p, x_from_input, b, pp);
        float* xo = x_wr(p, b, pp);
        float mean = 0.f, rstd = 1.f;
        if (!x_from_input) { const size_t row = (size_t)row0 + lr; mean = stats[row * 2]; rstd = stats[row * 2 + 1]; }
#pragma unroll
        for (int n = 0; n < 4; ++n) {
            const int col = nt256 * 256 + wc * 64 + n * 16 + fq * 4;
            f32x4 xv = *(const f32x4*)(xi + col); const f32x4 g4 = *(const f32x4*)(gv + col);
            if (!x_from_input) {
                const f32x4 lg = *(const f32x4*)(lng + col), lb = *(const f32x4*)(lnb + col);
#pragma unroll
                for (int j = 0; j < 4; ++j) xv[j] = (xv[j] - mean) * rstd * lg[j] + lb[j];
            }
            f32x4 o;
#pragma unroll
            for (int j = 0; j < 4; ++j) o[j] = ALPHA * xv[j] + g4[j] * acc[m][n][j];
            *(f32x4*)(xo + col) = o;
        }
    }
}
__device__ __forceinline__ void resid_gemm_phase(const Params& pin, int l, size_t a_off, int lda, int nk, size_t w_off, int ldb, int goff, bool x_from_input, const float* lng, const float* lnb, bool skip_ctx, unsigned char* lds) {
    const Params p = launder(pin); l = launder_i(l);
    const int tid = ltid();
    const bf16_t* A = (const bf16_t*)(p.ws + a_off);
    const bf16_t* Wt = (const bf16_t*)(p.ws + OFF_W) + w_off;
    if (gridDim.x == 256) {
        for (int t = blockIdx.x; t < 512; t += 256) {
            int mt, nt; tile_mn(t, 4, mt, nt);
            if (skip_ctx && (mt % 9) == 0) continue;
            resid_tile256(p, l, A, lda, nk, Wt, ldb, goff, x_from_input, lng, lnb, mt * 256, nt, lds, tid);
        }
        int mt, nt; tile_mn(512 + (blockIdx.x >> 2), 4, mt, nt);
        const int q = blockIdx.x & 3;
        if (!(skip_ctx && (mt % 9) == 0)) resid_tile<2>(p, l, A, lda, nk, Wt, ldb, goff, x_from_input, lng, lnb, mt * 256 + (q >> 1) * 128, nt * 2 + (q & 1), lds, tid);
    } else {
        for (int t = blockIdx.x; t < 144 * 8; t += gridDim.x) {
            int mt, nt; tile_mn(t, 8, mt, nt);
            if (skip_ctx && (mt % 9) == 0) continue;
            resid_tile<4>(p, l, A, lda, nk, Wt, ldb, goff, x_from_input, lng, lnb, mt * 256, nt, lds, tid);
        }
    }
}

__device__ __forceinline__ void ln_phase(const Params& pin, const float* g, const float* bta, int lmod, int shoff, bool write_xmod, bool write_x, bool skip_ctx) {
    const Params p = launder(pin); lmod = launder_i(lmod);
    const int tid = ltid(), wid = tid >> 6, lane = tid & 63;
    bf16_t* xm = (bf16_t*)(p.ws + OFF_R6);
    float* stats = (float*)(p.ws + OFF_STATS);
    for (int row = blockIdx.x * 8 + wid; row < MROWS; row += gridDim.x * 8) {
        const int b = row / TPB, pp = row % TPB;
        if (skip_ctx && pp < CTXL) continue;
        float* xp = x_wr(p, b, pp);
        f32x4 v[4];
        float s = 0.f;
#pragma unroll
        for (int i = 0; i < 4; ++i) { v[i] = *(const f32x4*)(xp + i * 256 + lane * 4); s += (v[i][0] + v[i][1]) + (v[i][2] + v[i][3]); }
        const float mean = wave_sum(s) * (1.0f / 1024.0f);
        float q = 0.f;
#pragma unroll
        for (int i = 0; i < 4; ++i)
#pragma unroll
            for (int j = 0; j < 4; ++j) { const float d = v[i][j] - mean; q += d * d; }
        const float rstd = __builtin_amdgcn_rsqf(wave_sum(q) * (1.0f / 1024.0f) + 1e-5f);
        if (lane == 0) { stats[(size_t)row * 2] = mean; stats[(size_t)row * 2 + 1] = rstd; }
        const float* mv = write_xmod ? modv_ptr(p, lmod, b, pp) + shoff : nullptr;
#pragma unroll
        for (int i = 0; i < 4; ++i) {
            const int c = i * 256 + lane * 4;
            const f32x4 g4 = *(const f32x4*)(g + c), b4 = *(const f32x4*)(bta + c);
            f32x4 o;
#pragma unroll
            for (int j = 0; j < 4; ++j) o[j] = (v[i][j] - mean) * rstd * g4[j] + b4[j];
            if (write_x) *(f32x4*)(xp + c) = o;
            if (write_xmod) {
                const f32x4 sh = *(const f32x4*)(mv + c), sc = *(const f32x4*)(mv + 1024 + c);
                uint2 ov; ov.x = pk_bf16(o[0] * (1.f + sc[0]) + sh[0], o[1] * (1.f + sc[1]) + sh[1]); ov.y = pk_bf16(o[2] * (1.f + sc[2]) + sh[2], o[3] * (1.f + sc[3]) + sh[3]);
                *(uint2*)(xm + (size_t)row * 1024 + c) = ov;
            }
        }
    }
}

__device__ __forceinline__ void p7_phase(const Params& pin, bool skip_ctx, unsigned char* lds) {
    const Params p = launder(pin); const int tid = ltid();
    const bf16_t* A = (const bf16_t*)(p.ws + OFF_R6);
    const bf16_t* W = (const bf16_t*)(p.ws + OFF_W) + WO_13;
    bf16_t* HF = (bf16_t*)(p.ws + OFF_HF);
    const int lane = tid & 63, wid = tid >> 6, wr = wid >> 2, wc = wid & 3, fr = lane & 15, fq = lane >> 4;
    auto seg = [&](int t) { int mt, nt; tile_mn(t, 22, mt, nt); Seg g; g.A = A + (size_t)mt * 256 * 1024; g.Bt = W + (size_t)nt * 256 * 1024; g.lda = 1024; g.a_kstep = 64; g.ldb = 1024; g.nk = 16; return g; };
    auto valid = [&](int t) { int mt, nt; tile_mn(t, 22, mt, nt); return !(skip_ctx && (mt % 9) == 0); };
    auto nextv = [&](int t) { while (t < 144 * 22 && !valid(t)) t += gridDim.x; return t; };
    int st = 0; bool first = true;
    for (int t = nextv(blockIdx.x); t < 144 * 22;) {
        int mt, nt; tile_mn(t, 22, mt, nt);
        const int tn = nextv(t + gridDim.x); const bool hn = tn < 144 * 22;
        f32x4 acc[8][4]; zero_acc<8>(acc);
        gemm_stream256(acc, seg(t), seg(hn ? tn : t), hn, first, st, lds, tid); first = false;
        const int G = nt * 4 + wc;
#pragma unroll
        for (int m = 0; m < 8; ++m) {
            const size_t row = (size_t)mt * 256 + wr * 128 + m * 16 + fr;
            uint2 ov[2];
#pragma unroll
            for (int n = 0; n < 2; ++n) {
                float o[4];
#pragma unroll
                for (int j = 0; j < 4; ++j) o[j] = siluf_(acc[m][n][j]) * acc[m][n + 2][j];
                ov[n].x = pk_bf16(o[0], o[1]); ov[n].y = pk_bf16(o[2], o[3]);
            }
            *(uint4*)(HF + row * DFF + G * 32 + (fq & 1) * 16 + (fq >> 1) * 8) = widen16(ov[0], ov[1]);
        }
        t = tn;
    }
}

__global__ void __launch_bounds__(NTHREADS) fwd_megakernel(Params p) {
    extern __shared__ __attribute__((aligned(16))) unsigned char lds[];
    cg::grid_group grid = cg::this_grid();
    unsigned* gbar = (unsigned*)(p.ws + OFF_BAR); unsigned epoch = 0;
#define GSYNC() grid_barrier(gbar, epoch)
    if (p.ws == nullptr) grid.sync();
    modv_phase(p, lds);
    convert_layer(p, 0, lds);
    {
        bf16_t* Wm = (bf16_t*)(p.ws + OFF_W) + WO_IN + (size_t)672 * 1024;
        for (int i = blockIdx.x * NTHREADS + threadIdx.x; i < 96 * 1024 / 2; i += gridDim.x * NTHREADS) ((unsigned*)Wm)[i] = 0u;
    }
    GSYNC();
    xmod0_phase(p);
    GSYNC();
#pragma unroll 1
    for (int l = 0; l < DEPTH; ++l) {
        const bool last = (l == DEPTH - 1);
        for (int r = 0, nr = launder_i(1 + ((PROBE_MASK >> 2) & 1)); r < nr; ++r) p1_phase(p, lds);
        GSYNC();
        for (int r = 0, nr = launder_i(1 + ((PROBE_MASK >> 3) & 1)); r < nr; ++r) p2a_phase(p, l);
        GSYNC();
        for (int r = 0, nr = launder_i(1 + ((PROBE_MASK >> 4) & 1)); r < nr; ++r) p2b_phase(p, l, lds);
        GSYNC();
        p3_phase(p, l, lds);
        GSYNC();
        for (int r = 0, nr = launder_i(1 + ((PROBE_MASK >> 5) & 1)); r < nr; ++r) p35_phase(p, l, last, lds);
        GSYNC();
        for (int r = 0, nr = launder_i(1 + ((PROBE_MASK >> 6) & 1)); r < nr; ++r) p4_phase(p, last, lds);
        GSYNC();
        resid_gemm_phase(p, l, OFF_MRG, 1024, 16, WO_OUT, 1024, 2048, l == 0, p.ln2_g + (l > 0 ? l - 1 : 0) * 1024, p.ln2_b + (l > 0 ? l - 1 : 0) * 1024, last, lds);
        GSYNC();
        ln_phase(p, p.ln1_g + l * 1024, p.ln1_b + l * 1024, l, 3072, true, false, last);
        GSYNC();
        for (int r = 0, nr = launder_i(1 + ((PROBE_MASK >> 0) & 1)); r < nr; ++r) p7_phase(p, last, lds);
        GSYNC();
        resid_gemm_phase(p, l, OFF_HF, DFF, 44, WO_2, DFF, 5120, false, p.ln1_g + l * 1024, p.ln1_b + l * 1024, last, lds);
        GSYNC();
        ln_phase(p, p.ln2_g + l * 1024, p.ln2_b + l * 1024, last ? l : l + 1, 0, !last, last, last);
        if (!last) for (int r = 0, nr = launder_i(1 + ((PROBE_MASK >> 7) & 1)); r < nr; ++r) convert_layer(p, l + 1, lds);
        for (int r = 0, nr = launder_i(((PROBE_MASK >> 8) & 1) * 10); r < nr; ++r) GSYNC();
        GSYNC();
    }
}

extern "C" void kernel_launch(void* const* d_in, const int* in_sizes, int n_in, void* d_out,
                              int out_size, void* d_ws, size_t ws_size, hipStream_t stream) {
    static int grid_blocks = 0;
    if (!grid_blocks) {
        int dev = 0, cus = 0, per_cu = 0;
        hipGetDevice(&dev);
        hipDeviceGetAttribute(&cus, hipDeviceAttributeMultiprocessorCount, dev);
        if (hipFuncSetAttribute((const void*)fwd_megakernel, hipFuncAttributeMaxDynamicSharedMemorySize, LDS_BYTES) != hipSuccess)
            fprintf(stderr, "hipFuncSetAttribute failed\n");
        hipOccupancyMaxActiveBlocksPerMultiprocessor(&per_cu, (const void*)fwd_megakernel, NTHREADS, LDS_BYTES);
        if (per_cu < 1) fprintf(stderr, "occupancy query says %d blocks/CU\n", per_cu);
        (void)hipGetLastError();
        grid_blocks = cus > 0 ? cus : 256;
        if (ws_size < WS_END) { fprintf(stderr, "workspace too small: %zu < %zu\n", ws_size, (size_t)WS_END); grid_blocks = -1; }
        if (n_in != 33) { fprintf(stderr, "expected 33 inputs, got %d\n", n_in); grid_blocks = -1; }
    }
    if (grid_blocks < 0) return;
    if (hipMemsetAsync((unsigned char*)d_ws + OFF_BAR, 0, 1024, stream) != hipSuccess) fprintf(stderr, "memset failed\n");
    Params p{};
    const float** pp = (const float**)&p;
    for (int i = 0; i < 33; ++i) pp[i] = (const float*)d_in[i];
    p.out = (float*)d_out;
    p.ws = (unsigned char*)d_ws;
    void* args[] = {&p};
    hipError_t e = hipLaunchCooperativeKernel((void*)fwd_megakernel, dim3(grid_blocks), dim3(NTHREADS), args, LDS_BYTES, stream);
    if (e != hipSuccess) fprintf(stderr, "cooperative launch failed: %s (grid %d)\n", hipGetErrorString(e), grid_blocks);
}
```

```cpp
#include <hip/hip_runtime.h>
#include <hip/hip_cooperative_groups.h>
#include <cstdio>
#include <cstdint>
namespace cg = cooperative_groups;

typedef unsigned short bf16_t;
typedef short bf16x8 __attribute__((ext_vector_type(8)));
typedef float f32x4 __attribute__((ext_vector_type(4)));

#ifndef PROBE_MASK
#define PROBE_MASK 0
#endif
constexpr int BATCH = 16, SEQ = 2048, CTXL = 256, DM = 1024, DEPTH = 4, DFF = 2816, DIN = 7200;
constexpr int TPB = SEQ + CTXL;
constexpr int MROWS = BATCH * TPB;
constexpr int NTHREADS = 512;
constexpr int LDS_BYTES = 152 * 1024;
constexpr float ALPHA = 1.681792830507429f;
constexpr float QSCALE = 0.10206207261596575f * 1.4426950408889634f;

constexpr size_t WO_IN = 0;
constexpr size_t WO_UQ = WO_IN + (size_t)7296 * 1024;
constexpr size_t WO_UKV = WO_UQ + (size_t)768 * 384;
constexpr size_t WO_OA = WO_UKV + (size_t)1024 * 256;
constexpr size_t WO_OC = WO_OA + (size_t)1024 * 512;
constexpr size_t WO_OR = WO_OC + (size_t)1024 * 512;
constexpr size_t WO_OUT = WO_OR + (size_t)1024 * 512;
constexpr size_t WO_13 = WO_OUT + (size_t)1024 * 1024;
constexpr size_t WO_2 = WO_13 + (size_t)5632 * 1024;
constexpr size_t WO_UP = WO_2 + (size_t)1024 * 2816;
constexpr size_t WO_AUP = WO_UP + (size_t)2 * 512 * 64;
constexpr size_t WO_GUP = WO_AUP + (size_t)2 * 512 * 64;
constexpr size_t W_ELEMS = WO_GUP + (size_t)512 * 128;

constexpr size_t al256(size_t x) { return (x + 255) & ~(size_t)255; }
constexpr size_t OFF_BAR = 0;
constexpr size_t OFF_W = 1024;
constexpr size_t OFF_MODV = al256(OFF_W + W_ELEMS * 2);
constexpr size_t OFF_ROPE = al256(OFF_MODV + (size_t)4 * 17 * 6144 * 4);
constexpr size_t OFF_RSQ = al256(OFF_ROPE + 64 * 8 * 2 * 4);
constexpr size_t OFF_RSKV = al256(OFF_RSQ + (size_t)MROWS * 4);
constexpr size_t OFF_STATS = al256(OFF_RSKV + (size_t)MROWS * 4);
constexpr size_t OFF_XC = al256(OFF_STATS + (size_t)MROWS * 8);
constexpr size_t OFF_R1 = al256(OFF_XC + (size_t)BATCH * CTXL * DM * 4);
constexpr size_t OFF_R2 = al256(OFF_R1 + (size_t)MROWS * 672 * 2);
constexpr size_t OFF_R3 = OFF_R2 + (size_t)MROWS * 1536 * 2;
constexpr size_t OFF_R4 = al256(OFF_R3 + (size_t)MROWS * 1920 * 2);
constexpr size_t OFF_R5 = al256(OFF_R4 + (size_t)MROWS * (512 + 512 + 32) * 2);
constexpr size_t OFF_R6 = al256(OFF_R5 + (size_t)MROWS * 512 * 2);
constexpr size_t WS_END = al256(OFF_R6 + (size_t)MROWS * 1024 * 2);
constexpr size_t OFF_Q = OFF_R2;
constexpr size_t OFF_YF = OFF_R2 + (size_t)MROWS * 768 * 2;
constexpr size_t OFF_SG = OFF_YF + (size_t)MROWS * 512 * 2;
constexpr size_t OFF_YB = OFF_R1;
constexpr size_t OFF_KN = OFF_R4;
constexpr size_t OFF_VT = OFF_R4 + (size_t)MROWS * 512 * 2;
constexpr size_t OFF_KR = OFF_VT + (size_t)MROWS * 512 * 2;
constexpr size_t OFF_RWO = OFF_R4;
constexpr size_t OFF_MRG = OFF_R3;
constexpr size_t OFF_HF = OFF_R2;
static_assert(OFF_SG + (size_t)MROWS * 128 * 2 <= OFF_R3, "R2 overlay overflow");
static_assert((size_t)MROWS * 2816 * 2 <= OFF_R4 - OFF_R2, "HF overflow");

struct Params {
    const float *x, *c, *ctx, *c_ctx, *mod_w, *mod_b, *w_in, *q_norm, *w_uq, *kv_norm, *w_ukv, *w_o_attn,
        *conv_w, *w_o_conv, *rw_mu, *rw_w0, *rw_w_up, *rw_a0, *rw_a_up, *rw_g_up, *rw_k_k, *rw_k_a,
        *rw_r_k, *rw_gn_g, *rw_gn_b, *w_o_rwkv, *w_out, *ln1_g, *ln1_b, *ffn_w13, *ffn_w2, *ln2_g, *ln2_b;
    float* out;
    unsigned char* ws;
};

typedef __attribute__((address_space(1))) unsigned char gchar_t;
typedef __attribute__((address_space(1))) float gfloat_t;
__device__ __forceinline__ Params launder(const Params& a) {
    Params q = a;
    unsigned long long w = (unsigned long long)a.ws, o = (unsigned long long)a.out;
    unsigned wl = __builtin_amdgcn_readfirstlane((unsigned)w), wh = __builtin_amdgcn_readfirstlane((unsigned)(w >> 32));
    unsigned ol = __builtin_amdgcn_readfirstlane((unsigned)o), oh = __builtin_amdgcn_readfirstlane((unsigned)(o >> 32));
    asm volatile("" : "+s"(wl), "+s"(wh), "+s"(ol), "+s"(oh));
    w = ((unsigned long long)wh << 32) | wl; o = ((unsigned long long)oh << 32) | ol;
    q.ws = (unsigned char*)(gchar_t*)w; q.out = (float*)(gfloat_t*)o;
    return q;
}
__device__ __forceinline__ int launder_i(int v) { v = __builtin_amdgcn_readfirstlane(v); asm volatile("" : "+s"(v)); return v; }
__device__ __forceinline__ int ltid() { int t = threadIdx.x; asm volatile("" : "+v"(t)); return t; }
__device__ __forceinline__ unsigned pk_bf16(float lo, float hi) { unsigned r; asm("v_cvt_pk_bf16_f32 %0, %1, %2" : "=v"(r) : "v"(lo), "v"(hi)); return r; }
__device__ __forceinline__ float bf_lo(unsigned u) { return __uint_as_float(u << 16); }
__device__ __forceinline__ float bf_hi(unsigned u) { return __uint_as_float(u & 0xffff0000u); }
__device__ __forceinline__ float bf1(bf16_t h) { return __uint_as_float(((unsigned)h) << 16); }
__device__ __forceinline__ float x32sum(float x) { unsigned u = __float_as_uint(x); auto r = __builtin_amdgcn_permlane32_swap(u, u, false, false); return __uint_as_float(r[0]) + __uint_as_float(r[1]); }
__device__ __forceinline__ float x16sum(float x) { unsigned u = __float_as_uint(x); auto r = __builtin_amdgcn_permlane16_swap(u, u, false, false); return __uint_as_float(r[0]) + __uint_as_float(r[1]); }
__device__ __forceinline__ float x32max(float x) { unsigned u = __float_as_uint(x); auto r = __builtin_amdgcn_permlane32_swap(u, u, false, false); return fmaxf(__uint_as_float(r[0]), __uint_as_float(r[1])); }
__device__ __forceinline__ float x16max(float x) { unsigned u = __float_as_uint(x); auto r = __builtin_amdgcn_permlane16_swap(u, u, false, false); return fmaxf(__uint_as_float(r[0]), __uint_as_float(r[1])); }
__device__ __forceinline__ float fqsum(float x) { return x16sum(x32sum(x)); }
__device__ __forceinline__ float fqmax(float x) { return x16max(x32max(x)); }

template <int CTRL> __device__ __forceinline__ float dpp_add(float x) { return x + __uint_as_float((unsigned)__builtin_amdgcn_update_dpp(0, (int)__float_as_uint(x), CTRL, 0xf, 0xf, true)); }
__device__ __forceinline__ float red8(float x) { x = dpp_add<0xB1>(x); x = dpp_add<0x4E>(x); x = dpp_add<0x141>(x); return x; }
__device__ __forceinline__ float xor32_get(float x, int lane) { const unsigned u = __float_as_uint(x); auto r = __builtin_amdgcn_permlane32_swap(u, u, false, false); return __uint_as_float(lane < 32 ? r[1] : r[0]); }
__device__ __forceinline__ float xor8_get(float x) { return __uint_as_float((unsigned)__builtin_amdgcn_update_dpp(0, (int)__float_as_uint(x), 0x128, 0xf, 0xf, true)); }
__device__ __forceinline__ float wave_sum(float v) { v = dpp_add<0xB1>(v); v = dpp_add<0x4E>(v); v = dpp_add<0x141>(v); v = dpp_add<0x140>(v); return fqsum(v); }
__device__ __forceinline__ uint4 widen16(uint2 a, uint2 b) {
    auto r0 = __builtin_amdgcn_permlane16_swap(a.x, b.x, false, false);
    auto r1 = __builtin_amdgcn_permlane16_swap(a.y, b.y, false, false);
    return make_uint4(r0[0], r1[0], r0[1], r1[1]);
}
__device__ __forceinline__ float fexp(float x) { return __builtin_amdgcn_exp2f(x * 1.4426950408889634f); }
__device__ __forceinline__ float sigmoidf_(float x) { return __builtin_amdgcn_rcpf(1.0f + fexp(-x)); }
__device__ __forceinline__ float siluf_(float x) { return x * __builtin_amdgcn_rcpf(1.0f + fexp(-x)); }

__device__ __forceinline__ const float* x_rd(const Params& p, bool from_input, int b, int pp) {
    if (pp < CTXL) return (from_input ? p.ctx : (const float*)(p.ws + OFF_XC)) + ((size_t)b * CTXL + pp) * DM;
    return (from_input ? p.x : (const float*)p.out) + ((size_t)b * SEQ + (pp - CTXL)) * DM;
}
__device__ __forceinline__ float* x_wr(const Params& p, int b, int pp) {
    if (pp < CTXL) return (float*)(p.ws + OFF_XC) + ((size_t)b * CTXL + pp) * DM;
    return p.out + ((size_t)b * SEQ + (pp - CTXL)) * DM;
}
__device__ __forceinline__ const float* modv_ptr(const Params& p, int l, int b, int pp) {
    const int mr = pp < CTXL ? 16 : b;
    return (const float*)(p.ws + OFF_MODV) + ((size_t)l * 17 + mr) * 6144;
}

__device__ __forceinline__ void grid_barrier(unsigned* bar, unsigned& epoch) {
    asm volatile("s_waitcnt vmcnt(0) lgkmcnt(0)" ::: "memory");
    __syncthreads();
    epoch += 1;
    if (threadIdx.x == 0) {
        __builtin_amdgcn_fence(__ATOMIC_RELEASE, "agent");
        asm volatile("s_waitcnt vmcnt(0)" ::: "memory");
        const unsigned old = __hip_atomic_fetch_add(bar, 1u, __ATOMIC_RELAXED, __HIP_MEMORY_SCOPE_AGENT);
        if (old + 1u == epoch * gridDim.x) {
            __hip_atomic_store(bar + 64, epoch, __ATOMIC_RELAXED, __HIP_MEMORY_SCOPE_AGENT);
        } else {
            while (__hip_atomic_load(bar + 64, __ATOMIC_RELAXED, __HIP_MEMORY_SCOPE_AGENT) < epoch) __builtin_amdgcn_s_sleep(1);
        }
        __builtin_amdgcn_fence(__ATOMIC_ACQUIRE, "agent");
        asm volatile("s_waitcnt vmcnt(0)" ::: "memory");
    }
    __syncthreads();
}

#define LDS_AS __attribute__((address_space(3)))
#define GLB_AS __attribute__((address_space(1)))
template <int MT, int SWAPMODE>
__device__ __forceinline__ void gemm_mainloop(f32x4 (&acc)[MT][4], const bf16_t* __restrict__ A, int lda, int a_kstep,
                                              const bf16_t* __restrict__ Bt, int ldb, int nk, unsigned char* lds, int tid) {
    constexpr int BMr = 64 * MT;
    constexpr int STAGE = (BMr + 128) * 128;
    const int wid = __builtin_amdgcn_readfirstlane(tid >> 6), lane = tid & 63, wr = wid >> 1, wc = wid & 1, fr = lane & 15, fq = lane >> 4;
    const int lrow = 8 * wid + (lane >> 3);
    const int lch = (lane & 7) ^ ((4 * wid + (lane >> 4)) & 7);
    const bf16_t* ap = A + (size_t)lrow * lda + lch * 8;
    const bf16_t* bp = Bt + (size_t)lrow * ldb + lch * 8;
    auto issue = [&](int kt, int st) {
        unsigned char* base = lds + st * STAGE + wid * 1024;
#pragma unroll
        for (int i = 0; i < MT; ++i)
            __builtin_amdgcn_global_load_lds((const GLB_AS unsigned*)(ap + (size_t)i * 64 * lda + (size_t)kt * a_kstep), (LDS_AS unsigned*)(base + i * 8192), 16, 0, 0);
#pragma unroll
        for (int i = 0; i < 2; ++i)
            __builtin_amdgcn_global_load_lds((const GLB_AS unsigned*)(bp + (size_t)i * 64 * ldb + (size_t)kt * 64), (LDS_AS unsigned*)(base + (BMr + i * 64) * 128), 16, 0, 0);
    };
    const bool sw = (SWAPMODE == 1) || (SWAPMODE == 2 && wc == 0);
    const int sz = fr >> 1;
    constexpr int NL = MT + 2;
    const bool late = wid >= 4;
    issue(0, 0);
    if (nk > 1) { issue(1, 1); asm volatile("s_waitcnt vmcnt(%0)" ::"n"(NL) : "memory"); }
    else asm volatile("s_waitcnt vmcnt(0)" ::: "memory");
    __builtin_amdgcn_s_barrier();
    asm volatile("" ::: "memory");
    int st = 0;
    for (int kt = 0; kt < nk; ++kt) {
        const int st2 = st >= 1 ? st - 1 : 2;
        if (!late && kt + 2 < nk) issue(kt + 2, st2);
        const unsigned char* As = lds + st * STAGE;
        const unsigned char* Bs = As + BMr * 128;
#pragma unroll
        for (int ks = 0; ks < 2; ++ks) {
            bf16x8 af[MT], bfr[4];
            const int co = ((ks * 4 + fq) ^ sz) * 16;
#pragma unroll
            for (int m = 0; m < MT; ++m) af[m] = *(const bf16x8*)(As + (wr * 16 * MT + m * 16 + fr) * 128 + co);
#pragma unroll
            for (int n = 0; n < 4; ++n) bfr[n] = *(const bf16x8*)(Bs + (wc * 64 + n * 16 + fr) * 128 + co);
            if (sw) {
#pragma unroll
                for (int m = 0; m < MT; ++m)
#pragma unroll
                    for (int n = 0; n < 4; ++n) acc[m][n] = __builtin_amdgcn_mfma_f32_16x16x32_bf16(bfr[n], af[m], acc[m][n], 0, 0, 0);
            } else {
#pragma unroll
                for (int m = 0; m < MT; ++m)
#pragma unroll
                    for (int n = 0; n < 4; ++n) acc[m][n] = __builtin_amdgcn_mfma_f32_16x16x32_bf16(af[m], bfr[n], acc[m][n], 0, 0, 0);
            }
        }
        if (late && kt + 2 < nk) issue(kt + 2, st2);
        if (kt + 2 < nk) asm volatile("s_waitcnt vmcnt(%0) lgkmcnt(0)" ::"n"(NL) : "memory");
        else asm volatile("s_waitcnt vmcnt(0) lgkmcnt(0)" ::: "memory");
        __builtin_amdgcn_s_barrier();
        asm volatile("" ::: "memory");
        st = st == 2 ? 0 : st + 1;
    }
}
__device__ __forceinline__ void gemm_mainloop256(f32x4 (&acc)[8][4], const bf16_t* __restrict__ A, int lda,
                                                 const bf16_t* __restrict__ Bt, int ldb, int nk, unsigned char* lds, int tid) {
    constexpr int STAGE = 512 * 128;
    const int wid = __builtin_amdgcn_readfirstlane(tid >> 6), lane = tid & 63, wr = wid >> 2, wc = wid & 3, fr = lane & 15, fq = lane >> 4;
    const int lrow = 8 * wid + (lane >> 3);
    const int lch = (lane & 7) ^ ((4 * wid + (lane >> 4)) & 7);
    const bf16_t* ap = A + (size_t)lrow * lda + lch * 8;
    const bf16_t* bp = Bt + (size_t)lrow * ldb + lch * 8;
    auto issue = [&](int kt, int st) {
        unsigned char* base = lds + st * STAGE + wid * 1024;
#pragma unroll
        for (int i = 0; i < 4; ++i)
            __builtin_amdgcn_global_load_lds((const GLB_AS unsigned*)(ap + (size_t)i * 64 * lda + (size_t)kt * 64), (LDS_AS unsigned*)(base + i * 8192), 16, 0, 0);
#pragma unroll
        for (int i = 0; i < 4; ++i)
            __builtin_amdgcn_global_load_lds((const GLB_AS unsigned*)(bp + (size_t)i * 64 * ldb + (size_t)kt * 64), (LDS_AS unsigned*)(base + (256 + i * 64) * 128), 16, 0, 0);
    };
    const int sz = fr >> 1;
    const bool late = wid >= 4;
    issue(0, 0);
    asm volatile("s_waitcnt vmcnt(0)" ::: "memory");
    __builtin_amdgcn_s_barrier();
    asm volatile("" ::: "memory");
    for (int kt = 0; kt < nk; ++kt) {
        if (!late && kt + 1 < nk) issue(kt + 1, (kt + 1) & 1);
        const unsigned char* As = lds + (kt & 1) * STAGE;
        const unsigned char* Bs = As + 256 * 128;
#pragma unroll
        for (int ks = 0; ks < 2; ++ks) {
            if (ks == 1 && late && kt + 1 < nk) issue(kt + 1, (kt + 1) & 1);
            bf16x8 af[8], bfr[4];
            const int co = ((ks * 4 + fq) ^ sz) * 16;
#pragma unroll
            for (int m = 0; m < 8; ++m) af[m] = *(const bf16x8*)(As + (wr * 128 + m * 16 + fr) * 128 + co);
#pragma unroll
            for (int n = 0; n < 4; ++n) bfr[n] = *(const bf16x8*)(Bs + (wc * 64 + n * 16 + fr) * 128 + co);
#pragma unroll
            for (int m = 0; m < 8; ++m)
#pragma unroll
                for (int n = 0; n < 4; ++n) acc[m][n] = __builtin_amdgcn_mfma_f32_16x16x32_bf16(bfr[n], af[m], acc[m][n], 0, 0, 0);
        }
        asm volatile("s_waitcnt vmcnt(0) lgkmcnt(0)" ::: "memory");
        __builtin_amdgcn_s_barrier();
        asm volatile("" ::: "memory");
    }
}
struct Seg { const bf16_t* A; const bf16_t* Bt; int lda, a_kstep, ldb, nk; };
template <int MT, int SWAPMODE>
__device__ __forceinline__ void gemm_stream(f32x4 (&acc)[MT][4], const Seg& cur, const Seg& nxt, bool has_next, bool first, int& st,
                                            unsigned char* lds, int tid) {
    constexpr int BMr = 64 * MT;
    constexpr int STAGE = (BMr + 128) * 128;
    constexpr int NL = MT + 2;
    const int wid = __builtin_amdgcn_readfirstlane(tid >> 6), lane = tid & 63, wr = wid >> 1, wc = wid & 1, fr = lane & 15, fq = lane >> 4;
    const int lrow = 8 * wid + (lane >> 3);
    const int lch = (lane & 7) ^ ((4 * wid + (lane >> 4)) & 7);
    const bf16_t* apc = cur.A + (size_t)lrow * cur.lda + lch * 8;
    const bf16_t* bpc = cur.Bt + (size_t)lrow * cur.ldb + lch * 8;
    const bf16_t* apn = nxt.A + (size_t)lrow * nxt.lda + lch * 8;
    const bf16_t* bpn = nxt.Bt + (size_t)lrow * nxt.ldb + lch * 8;
    auto issue = [&](const bf16_t* ap, const bf16_t* bp, int lda, int ldb, int koffa, int koffb, int slot) {
        unsigned char* base = lds + slot * STAGE + wid * 1024;
#pragma unroll
        for (int i = 0; i < MT; ++i)
            __builtin_amdgcn_global_load_lds((const GLB_AS unsigned*)(ap + (size_t)i * 64 * lda + koffa), (LDS_AS unsigned*)(base + i * 8192), 16, 0, 0);
#pragma unroll
        for (int i = 0; i < 2; ++i)
            __builtin_amdgcn_global_load_lds((const GLB_AS unsigned*)(bp + (size_t)i * 64 * ldb + koffb), (LDS_AS unsigned*)(base + (BMr + i * 64) * 128), 16, 0, 0);
    };
    const bool sw = (SWAPMODE == 1) || (SWAPMODE == 2 && wc == 0);
    const int sz = fr >> 1;
    const bool late = wid >= 4;
    const int nk = cur.nk;
    int s0 = st;
    if (first) {
        const int s1 = s0 == 2 ? 0 : s0 + 1;
        issue(apc, bpc, cur.lda, cur.ldb, 0, 0, s0);
        issue(apc, bpc, cur.lda, cur.ldb, cur.a_kstep, 64, s1);
        asm volatile("s_waitcnt vmcnt(%0)" ::"n"(NL) : "memory");
        __builtin_amdgcn_s_barrier();
        asm volatile("" ::: "memory");
    }
    for (int kt = 0; kt < nk; ++kt) {
        const int s2 = s0 >= 1 ? s0 - 1 : 2;
        const int idx = kt + 2;
        const bool incur = idx < nk, doi = incur || has_next;
        if (!late && doi) { if (incur) issue(apc, bpc, cur.lda, cur.ldb, idx * cur.a_kstep, idx * 64, s2); else issue(apn, bpn, nxt.lda, nxt.ldb, (idx - nk) * nxt.a_kstep, (idx - nk) * 64, s2); }
        const unsigned char* As = lds + s0 * STAGE;
        const unsigned char* Bs = As + BMr * 128;
#pragma unroll
        for (int ks = 0; ks < 2; ++ks) {
            bf16x8 af[MT], bfr[4];
            const int co = ((ks * 4 + fq) ^ sz) * 16;
#pragma unroll
            for (int m = 0; m < MT; ++m) af[m] = *(const bf16x8*)(As + (wr * 16 * MT + m * 16 + fr) * 128 + co);
#pragma unroll
            for (int n = 0; n < 4; ++n) bfr[n] = *(const bf16x8*)(Bs + (wc * 64 + n * 16 + fr) * 128 + co);
            if (sw) {
#pragma unroll
                for (int m = 0; m < MT; ++m)
#pragma unroll
                    for (int n = 0; n < 4; ++n) acc[m][n] = __builtin_amdgcn_mfma_f32_16x16x32_bf16(bfr[n], af[m], acc[m][n], 0, 0, 0);
            } else {
#pragma unroll
                for (int m = 0; m < MT; ++m)
#pragma unroll
                    for (int n = 0; n < 4; ++n) acc[m][n] = __builtin_amdgcn_mfma_f32_16x16x32_bf16(af[m], bfr[n], acc[m][n], 0, 0, 0);
            }
        }
        if (late && doi) { if (incur) issue(apc, bpc, cur.lda, cur.ldb, idx * cur.a_kstep, idx * 64, s2); else issue(apn, bpn, nxt.lda, nxt.ldb, (idx - nk) * nxt.a_kstep, (idx - nk) * 64, s2); }
        if (doi) asm volatile("s_waitcnt vmcnt(%0) lgkmcnt(0)" ::"n"(NL) : "memory");
        else asm volatile("s_waitcnt vmcnt(0) lgkmcnt(0)" ::: "memory");
        __builtin_amdgcn_s_barrier();
        asm volatile("" ::: "memory");
        s0 = s0 == 2 ? 0 : s0 + 1;
    }
    st = s0;
}
__device__ __forceinline__ void gemm_stream256(f32x4 (&acc)[8][4], const Seg& cur, const Seg& nxt, bool has_next, bool first, int& st, unsigned char* lds, int tid) {
    constexpr int STAGE = 512 * 128;
    const int wid = __builtin_amdgcn_readfirstlane(tid >> 6), lane = tid & 63, wr = wid >> 2, wc = wid & 3, fr = lane & 15, fq = lane >> 4;
    const int lrow = 8 * wid + (lane >> 3);
    const int lch = (lane & 7) ^ ((4 * wid + (lane >> 4)) & 7);
    const bf16_t* apc = cur.A + (size_t)lrow * cur.lda + lch * 8;
    const bf16_t* bpc = cur.Bt + (size_t)lrow * cur.ldb + lch * 8;
    const bf16_t* apn = nxt.A + (size_t)lrow * nxt.lda + lch * 8;
    const bf16_t* bpn = nxt.Bt + (size_t)lrow * nxt.ldb + lch * 8;
    auto issue = [&](const bf16_t* ap, const bf16_t* bp, int lda, int ldb, int koff, int slot) {
        unsigned char* base = lds + slot * STAGE + wid * 1024;
#pragma unroll
        for (int i = 0; i < 4; ++i)
            __builtin_amdgcn_global_load_lds((const GLB_AS unsigned*)(ap + (size_t)i * 64 * lda + koff), (LDS_AS unsigned*)(base + i * 8192), 16, 0, 0);
#pragma unroll
        for (int i = 0; i < 4; ++i)
            __builtin_amdgcn_global_load_lds((const GLB_AS unsigned*)(bp + (size_t)i * 64 * ldb + koff), (LDS_AS unsigned*)(base + (256 + i * 64) * 128), 16, 0, 0);
    };
    const int sz = fr >> 1;
    const bool late = wid >= 4;
    const int nk = cur.nk;
    int s0 = st;
    if (first) {
        issue(apc, bpc, cur.lda, cur.ldb, 0, s0);
        asm volatile("s_waitcnt vmcnt(0)" ::: "memory");
        __builtin_amdgcn_s_barrier();
        asm volatile("" ::: "memory");
    }
    for (int kt = 0; kt < nk; ++kt) {
        const int idx = kt + 1;
        const bool incur = idx < nk, doi = incur || has_next;
        if (!late && doi) { if (incur) issue(apc, bpc, cur.lda, cur.ldb, idx * 64, s0 ^ 1); else issue(apn, bpn, nxt.lda, nxt.ldb, 0, s0 ^ 1); }
        const unsigned char* As = lds + s0 * STAGE;
        const unsigned char* Bs = As + 256 * 128;
#pragma unroll
        for (int ks = 0; ks < 2; ++ks) {
            if (ks == 1 && late && doi) { if (incur) issue(apc, bpc, cur.lda, cur.ldb, idx * 64, s0 ^ 1); else issue(apn, bpn, nxt.lda, nxt.ldb, 0, s0 ^ 1); }
            bf16x8 af[8], bfr[4];
            const int co = ((ks * 4 + fq) ^ sz) * 16;
#pragma unroll
            for (int m = 0; m < 8; ++m) af[m] = *(const bf16x8*)(As + (wr * 128 + m * 16 + fr) * 128 + co);
#pragma unroll
            for (int n = 0; n < 4; ++n) bfr[n] = *(const bf16x8*)(Bs + (wc * 64 + n * 16 + fr) * 128 + co);
#pragma unroll
            for (int m = 0; m < 8; ++m)
#pragma unroll
                for (int n = 0; n < 4; ++n) acc[m][n] = __builtin_amdgcn_mfma_f32_16x16x32_bf16(bfr[n], af[m], acc[m][n], 0, 0, 0);
        }
        asm volatile("s_waitcnt vmcnt(0) lgkmcnt(0)" ::: "memory");
        __builtin_amdgcn_s_barrier();
        asm volatile("" ::: "memory");
        s0 ^= 1;
    }
    st = s0;
}
__device__ __forceinline__ void gemm_gate3(f32x4 (&g)[3][2][4], const bf16_t* __restrict__ A, const bf16_t* __restrict__ Bt0, int nk, unsigned char* lds, int tid) {
    constexpr int STAGE = 512 * 128;
    const int wid = __builtin_amdgcn_readfirstlane(tid >> 6), lane = tid & 63, wr = wid >> 1, wc = wid & 1, fr = lane & 15, fq = lane >> 4;
    const int lrow = 8 * wid + (lane >> 3);
    const int lch = (lane & 7) ^ ((4 * wid + (lane >> 4)) & 7);
    const unsigned loff = (unsigned)(lrow * 1024 + lch * 8);
    auto issue = [&](int kt, int stg) {
        unsigned char* base = lds + stg * STAGE + wid * 1024;
#pragma unroll
        for (int i = 0; i < 2; ++i)
            __builtin_amdgcn_global_load_lds((const GLB_AS unsigned*)((A + (size_t)i * 64 * 1024 + (size_t)kt * 64) + loff), (LDS_AS unsigned*)(base + i * 8192), 16, 0, 0);
#pragma unroll
        for (int j = 0; j < 6; ++j)
            __builtin_amdgcn_global_load_lds((const GLB_AS unsigned*)((Bt0 + ((size_t)(j >> 1) * 1024 + (j & 1) * 64) * 1024 + (size_t)kt * 64) + loff), (LDS_AS unsigned*)(base + (128 + j * 64) * 128), 16, 0, 0);
    };
    const int sz = fr >> 1;
    const bool late = wid >= 4;
    issue(0, 0);
    asm volatile("s_waitcnt vmcnt(0)" ::: "memory");
    __builtin_amdgcn_s_barrier();
    asm volatile("" ::: "memory");
    for (int kt = 0; kt < nk; ++kt) {
        if (!late && kt + 1 < nk) issue(kt + 1, (kt + 1) & 1);
        const unsigned char* As = lds + (kt & 1) * STAGE;
        const unsigned char* Bs = As + 128 * 128;
#pragma unroll
        for (int ks = 0; ks < 2; ++ks) {
            if (ks == 1 && late && kt + 1 < nk) issue(kt + 1, (kt + 1) & 1);
            const int co = ((ks * 4 + fq) ^ sz) * 16;
            bf16x8 af[2];
#pragma unroll
            for (int m = 0; m < 2; ++m) af[m] = *(const bf16x8*)(As + (wr * 32 + m * 16 + fr) * 128 + co);
#pragma unroll
            for (int i = 0; i < 3; ++i) {
                bf16x8 bfr[4];
#pragma unroll
                for (int n = 0; n < 4; ++n) bfr[n] = *(const bf16x8*)(Bs + (i * 128 + wc * 64 + n * 16 + fr) * 128 + co);
#pragma unroll
                for (int m = 0; m < 2; ++m)
#pragma unroll
                    for (int n = 0; n < 4; ++n) g[i][m][n] = __builtin_amdgcn_mfma_f32_16x16x32_bf16(bfr[n], af[m], g[i][m][n], 0, 0, 0);
                if (i < 2) __builtin_amdgcn_sched_barrier(0);
            }
        }
        asm volatile("s_waitcnt vmcnt(0) lgkmcnt(0)" ::: "memory");
        __builtin_amdgcn_s_barrier();
        asm volatile("" ::: "memory");
    }
}
template <int MT> __device__ __forceinline__ void zero_acc(f32x4 (&acc)[MT][4]) {
#pragma unroll
    for (int m = 0; m < MT; ++m)
#pragma unroll
        for (int n = 0; n < 4; ++n) acc[m][n] = (f32x4){0.f, 0.f, 0.f, 0.f};
}
__device__ __forceinline__ void tile_mn(int t, int nN, int& mt, int& nt) { const int per = 16 * nN, g = t / per, w = t % per; mt = g * 16 + (w & 15); nt = w >> 4; }

__device__ __forceinline__ int rowmap(int mode, int n) {
    if (mode == 1) return n < 672 ? n : n + 96;
    if (mode == 2) return n < DFF ? ((n >> 5) * 64 + (n & 31)) : (((n - DFF) >> 5) * 64 + 32 + ((n - DFF) & 31));
    return n;
}
__device__ __forceinline__ void convert_T(const float* __restrict__ src, int K, int N, bf16_t* __restrict__ dst, int mode, const float* __restrict__ ks, unsigned char* lds, int rot) {
    float* tile = (float*)lds;
    const int ntk = K / 64, ntn = (N + 63) / 64, tid = ltid();
    const int start = (blockIdx.x + gridDim.x - (rot % gridDim.x)) % gridDim.x;
    for (int t = start; t < ntk * ntn; t += gridDim.x) {
        const int tk = t % ntk, tn = t / ntk, k0 = tk * 64, n0 = tn * 64;
#pragma unroll
        for (int i = 0; i < 8; ++i) {
            const int kl = (tid >> 6) + 8 * i, nl = tid & 63, n = n0 + nl;
            tile[kl * 65 + nl] = n < N ? src[(size_t)(k0 + kl) * N + n] : 0.f;
        }
        __syncthreads();
        const int kp = (tid & 31) * 2;
        float s0 = 1.f, s1 = 1.f;
        if (ks) { s0 = ks[k0 + kp]; s1 = ks[k0 + kp + 1]; }
#pragma unroll
        for (int i = 0; i < 4; ++i) {
            const int nl = (tid >> 5) + 16 * i, n = n0 + nl;
            if (n < N) *(unsigned*)(dst + (size_t)rowmap(mode, n) * K + k0 + kp) = pk_bf16(tile[kp * 65 + nl] * s0, tile[(kp + 1) * 65 + nl] * s1);
        }
        __syncthreads();
    }
}
__device__ __forceinline__ void convert_layer(const Params& pin, int l, unsigned char* lds) {
    const Params p = launder(pin); l = launder_i(l);
    bf16_t* W = (bf16_t*)(p.ws + OFF_W);
    convert_T(p.w_in + (size_t)l * DM * DIN, DM, DIN, W + WO_IN, 1, nullptr, lds, 0);
    convert_T(p.ffn_w13 + (size_t)l * DM * 2 * DFF, DM, 2 * DFF, W + WO_13, 2, nullptr, lds, 40);
    convert_T(p.ffn_w2 + (size_t)l * DFF * DM, DFF, DM, W + WO_2, 0, nullptr, lds, 80);
    convert_T(p.w_out + (size_t)l * DM * DM, DM, DM, W + WO_OUT, 0, nullptr, lds, 120);
    convert_T(p.w_o_attn + (size_t)l * 512 * DM, 512, DM, W + WO_OA, 0, nullptr, lds, 136);
    convert_T(p.w_o_conv + (size_t)l * 512 * DM, 512, DM, W + WO_OC, 0, nullptr, lds, 8);
    convert_T(p.w_o_rwkv + (size_t)l * 512 * DM, 512, DM, W + WO_OR, 0, nullptr, lds, 136 + 8);
    convert_T(p.w_uq + (size_t)l * 384 * 768, 384, 768, W + WO_UQ, 0, p.q_norm + l * 384, lds, 16);
    convert_T(p.w_ukv + (size_t)l * 256 * 1024, 256, 1024, W + WO_UKV, 0, p.kv_norm + l * 256, lds, 88);
    for (int z = 0; z < 2; ++z) {
        convert_T(p.rw_w_up + ((size_t)l * 2 + z) * 64 * 512, 64, 512, W + WO_UP + (size_t)z * 512 * 64, 0, nullptr, lds, 152 + 8 * z);
        convert_T(p.rw_a_up + ((size_t)l * 2 + z) * 64 * 512, 64, 512, W + WO_AUP + (size_t)z * 512 * 64, 0, nullptr, lds, 168 + 8 * z);
    }
    convert_T(p.rw_g_up + (size_t)l * 128 * 512, 128, 512, W + WO_GUP, 0, nullptr, lds, 184);
}

__device__ __forceinline__ void modv_phase(const Params& pin, unsigned char* lds) {
    const Params p = launder(pin);
    float* s = (float*)lds;
    float* red = s + 17 * 1024;
    const int tid = ltid(), wid = tid >> 6, lane = tid & 63;
    for (int i = tid; i < 17 * 1024; i += NTHREADS) { const int r = i >> 10, k = i & 1023; const float v = r < 16 ? p.c[r * 1024 + k] : p.c_ctx[k]; s[i] = siluf_(v); }
    __syncthreads();
    float* modv = (float*)(p.ws + OFF_MODV);
    for (int g = blockIdx.x; g < 4 * 96; g += gridDim.x) {
        const int l = g / 96, n = (g % 96) * 64 + lane;
        const float* w = p.mod_w + (size_t)l * 1024 * 6144 + n;
        float acc[17];
#pragma unroll
        for (int r = 0; r < 17; ++r) acc[r] = 0.f;
        const int kb = wid * 128;
        for (int k = kb; k < kb + 128; k += 4) {
            const float w0 = w[(size_t)k * 6144], w1 = w[(size_t)(k + 1) * 6144], w2 = w[(size_t)(k + 2) * 6144], w3 = w[(size_t)(k + 3) * 6144];
#pragma unroll
            for (int r = 0; r < 17; ++r) { const f32x4 sv = *(const f32x4*)(s + r * 1024 + k); acc[r] += sv[0] * w0 + sv[1] * w1 + sv[2] * w2 + sv[3] * w3; }
        }
#pragma unroll
        for (int r = 0; r < 17; ++r) red[(wid * 17 + r) * 64 + lane] = acc[r];
        __syncthreads();
        for (int i = tid; i < 17 * 64; i += NTHREADS) {
            const int r = i >> 6, c = i & 63; float v = 0.f;
#pragma unroll
            for (int w8 = 0; w8 < 8; ++w8) v += red[(w8 * 17 + r) * 64 + c];
            const int nn = (g % 96) * 64 + c;
            modv[((size_t)l * 17 + r) * 6144 + nn] = v + p.mod_b[l * 6144 + nn];
        }
        __syncthreads();
    }
    if (blockIdx.x == gridDim.x - 1) {
        float* rope = (float*)(p.ws + OFF_ROPE);
        for (int i = tid; i < 512; i += NTHREADS) {
            const int pos = i >> 3, f = i & 7;
            const float inv = exp2f(-(float)f * (13.287712379549449f / 8.0f));
            const float ang = (float)pos * inv;
            rope[i * 2] = cosf(ang); rope[i * 2 + 1] = sinf(ang);
        }
    }
}

__device__ __forceinline__ void xmod0_phase(const Params& pin) {
    const Params p = launder(pin);
    const int tid = ltid(), wid = tid >> 6, lane = tid & 63;
    bf16_t* xm = (bf16_t*)(p.ws + OFF_R6);
    for (int row = blockIdx.x * 8 + wid; row < MROWS; row += gridDim.x * 8) {
        const int b = row / TPB, pp = row % TPB;
        const float* xp = x_rd(p, true, b, pp);
        const float* mv = modv_ptr(p, 0, b, pp);
#pragma unroll
        for (int i = 0; i < 4; ++i) {
            const int c = i * 256 + lane * 4;
            const f32x4 v = *(const f32x4*)(xp + c), sh = *(const f32x4*)(mv + c), sc = *(const f32x4*)(mv + 1024 + c);
            uint2 o; o.x = pk_bf16(v[0] * (1.f + sc[0]) + sh[0], v[1] * (1.f + sc[1]) + sh[1]); o.y = pk_bf16(v[2] * (1.f + sc[2]) + sh[2], v[3] * (1.f + sc[3]) + sh[3]);
            *(uint2*)(xm + (size_t)row * 1024 + c) = o;
        }
    }
}

__device__ __forceinline__ void p1_phase(const Params& pin, unsigned char* lds) {
    const Params p = launder(pin); const int tid = ltid();
    const bf16_t* A = (const bf16_t*)(p.ws + OFF_R6);
    const bf16_t* W = (const bf16_t*)(p.ws + OFF_W) + WO_IN;
    const int lane = tid & 63, wid = tid >> 6, wr = wid >> 2, wc = wid & 3, fr = lane & 15, fq = lane >> 4;
    auto seg = [&](int t) { int mt, nt; tile_mn(t, 17, mt, nt); Seg g; g.A = A + (size_t)mt * 256 * 1024; g.Bt = W + (size_t)nt * 256 * 1024; g.lda = 1024; g.a_kstep = 64; g.ldb = 1024; g.nk = 16; return g; };
    int st = 0; bool first = true;
    for (int t = blockIdx.x; t < 144 * 17; t += gridDim.x) {
        int mt, nt; tile_mn(t, 17, mt, nt);
        const int tn = t + gridDim.x; const bool hn = tn < 144 * 17;
        f32x4 acc[8][4]; zero_acc<8>(acc);
        gemm_stream256(acc, seg(t), seg(hn ? tn : t), hn, first, st, lds, tid); first = false;
        bf16_t* dst; int ld, cb, lim;
        if (nt < 3) { dst = (bf16_t*)(p.ws + OFF_R1); ld = 672; cb = nt * 256; lim = 672; }
        else if (nt < 9) { dst = (bf16_t*)(p.ws + OFF_R2); ld = 1536; cb = (nt - 3) * 256; lim = 1536; }
        else { dst = (bf16_t*)(p.ws + OFF_R3); ld = 1920; cb = (nt - 9) * 256; lim = 1920; }
#pragma unroll
        for (int m = 0; m < 8; ++m) {
            const size_t row = (size_t)mt * 256 + wr * 128 + m * 16 + fr;
#pragma unroll
            for (int n = 0; n < 4; n += 2) {
                uint2 a, b2;
                a.x = pk_bf16(acc[m][n][0], acc[m][n][1]); a.y = pk_bf16(acc[m][n][2], acc[m][n][3]);
                b2.x = pk_bf16(acc[m][n + 1][0], acc[m][n + 1][1]); b2.y = pk_bf16(acc[m][n + 1][2], acc[m][n + 1][3]);
                const uint4 w = widen16(a, b2);
                const int col = cb + wc * 64 + (n + (fq & 1)) * 16 + (fq >> 1) * 8;
                if (col < lim) *(uint4*)(dst + row * ld + col) = w;
            }
        }
    }
}

__device__ __forceinline__ void unpack8(const uint4 u, float (&f)[8]) {
    f[0] = bf_lo(u.x); f[1] = bf_hi(u.x); f[2] = bf_lo(u.y); f[3] = bf_hi(u.y); f[4] = bf_lo(u.z); f[5] = bf_hi(u.z); f[6] = bf_lo(u.w); f[7] = bf_hi(u.w);
}
__device__ __forceinline__ void p2a_phase(const Params& pin, int l) {
    const Params p = launder(pin); l = launder_i(l);
    const int tid = ltid(), wid = tid >> 6, lane = tid & 63;
    const bf16_t* Hm = (const bf16_t*)(p.ws + OFF_R1);
    const bf16_t* Hc = (const bf16_t*)(p.ws + OFF_R2);
    bf16_t* CV = (bf16_t*)(p.ws + OFF_R5);
    bf16_t* KR = (bf16_t*)(p.ws + OFF_KR);
    float* RSQ = (float*)(p.ws + OFF_RSQ);
    float* RSKV = (float*)(p.ws + OFF_RSKV);
    const float* rope = (const float*)(p.ws + OFF_ROPE);
    const float* cw = p.conv_w + (size_t)l * 3 * 512;
    const int c0 = lane * 8;
    float w0[8], w1[8], w2[8];
#pragma unroll
    for (int i = 0; i < 8; ++i) { w0[i] = cw[c0 + i]; w1[i] = cw[512 + c0 + i]; w2[i] = cw[1024 + c0 + i]; }
    for (int row = blockIdx.x * 8 + wid; row < MROWS; row += gridDim.x * 8) {
        const int pp = row % TPB;
        const bool hp = (pp != 0 && pp != CTXL), hn = (pp != CTXL - 1 && pp != TPB - 1);
        const bf16_t* hr = Hc + (size_t)row * 1536;
        float ch[8], cc[8], cb[8], u0[8], u1[8], u2[8];
        unpack8(*(const uint4*)(hr + c0), ch); unpack8(*(const uint4*)(hr + 1024 + c0), cc); unpack8(*(const uint4*)(hr + 512 + c0), cb);
#pragma unroll
        for (int i = 0; i < 8; ++i) u1[i] = cc[i] * ch[i];
        if (hp) { unpack8(*(const uint4*)(hr - 1536 + c0), ch); unpack8(*(const uint4*)(hr - 1536 + 1024 + c0), cc);
#pragma unroll
            for (int i = 0; i < 8; ++i) u0[i] = cc[i] * ch[i]; }
        else {
#pragma unroll
            for (int i = 0; i < 8; ++i) u0[i] = 0.f; }
        if (hn) { unpack8(*(const uint4*)(hr + 1536 + c0), ch); unpack8(*(const uint4*)(hr + 1536 + 1024 + c0), cc);
#pragma unroll
            for (int i = 0; i < 8; ++i) u2[i] = cc[i] * ch[i]; }
        else {
#pragma unroll
            for (int i = 0; i < 8; ++i) u2[i] = 0.f; }
        float o[8];
#pragma unroll
        for (int i = 0; i < 8; ++i) o[i] = cb[i] * (u0[i] * w0[i] + u1[i] * w1[i] + u2[i] * w2[i]);
        uint4 ov; ov.x = pk_bf16(o[0], o[1]); ov.y = pk_bf16(o[2], o[3]); ov.z = pk_bf16(o[4], o[5]); ov.w = pk_bf16(o[6], o[7]);
        *(uint4*)(CV + (size_t)row * 512 + c0) = ov;
        const bf16_t* hm = Hm + (size_t)row * 672;
        float sq = 0.f, skv = 0.f;
        if (lane < 48) { float f[8]; unpack8(*(const uint4*)(hm + lane * 8), f);
#pragma unroll
            for (int i = 0; i < 8; ++i) sq += f[i] * f[i]; }
        if (lane < 32) { float f[8]; unpack8(*(const uint4*)(hm + 384 + lane * 8), f);
#pragma unroll
            for (int i = 0; i < 8; ++i) skv += f[i] * f[i]; }
        sq = wave_sum(sq); skv = wave_sum(skv);
        if (lane == 0) { RSQ[row] = __builtin_amdgcn_rsqf(sq * (1.0f / 384.0f) + 1e-6f); RSKV[row] = __builtin_amdgcn_rsqf(skv * (1.0f / 256.0f) + 1e-6f); }
        {
            const int j = lane & 31;
            float v = bf1(hm[640 + j]);
            const float other = xor8_get(v);
            if (pp >= CTXL) {
                const int tt = pp - CTXL;
                const int pos = (j < 16) ? (tt >> 6) : (tt & 63);
                const float cs = rope[(pos * 8 + (j & 7)) * 2], sn = rope[(pos * 8 + (j & 7)) * 2 + 1];
                v = (j & 8) ? (other * sn + v * cs) : (v * cs - other * sn);
            }
            if (lane < 32) KR[(size_t)row * 32 + j] = (bf16_t)(pk_bf16(v, v) & 0xffffu);
        }
    }
}

__device__ __forceinline__ void p2b_phase(const Params& pin, int l, unsigned char* lds) {
    const Params p = launder(pin); l = launder_i(l); const int tid = ltid();
    const bf16_t* Hm = (const bf16_t*)(p.ws + OFF_R1);
    const bf16_t* W = (const bf16_t*)(p.ws + OFF_W);
    const float* RSQ = (const float*)(p.ws + OFF_RSQ);
    const float* RSKV = (const float*)(p.ws + OFF_RSKV);
    const float* rope = (const float*)(p.ws + OFF_ROPE);
    bf16_t* Q = (bf16_t*)(p.ws + OFF_Q);
    bf16_t* KN = (bf16_t*)(p.ws + OFF_KN);
    bf16_t* VT = (bf16_t*)(p.ws + OFF_VT);
    const int lane = tid & 63, wid = tid >> 6, wr = wid >> 1, wc = wid & 1, fr = lane & 15, fq = lane >> 4;
    const int NQ = 144 * 6, NKV = 144 * 8;
    for (int t = blockIdx.x; t < NQ + NKV; t += gridDim.x) {
        f32x4 acc[4][4]; zero_acc<4>(acc);
        if (t < NQ) {
            int mt, nt; tile_mn(t, 6, mt, nt);
            gemm_mainloop<4, 1>(acc, Hm + (size_t)mt * 256 * 672, 672, 64, W + WO_UQ + (size_t)nt * 128 * 384, 384, 6, lds, tid);
            const int pp0 = (mt % 9) * 256; const bool latent = pp0 >= CTXL;
#pragma unroll
            for (int m = 0; m < 4; ++m) {
                const int lrow = wr * 64 + m * 16 + fr;
                const size_t row = (size_t)mt * 256 + lrow;
                const float sc = RSQ[row] * QSCALE;
                const int tt = pp0 + lrow - CTXL;
                uint2 qpk[4];
#pragma unroll
                for (int n = 0; n < 4; ++n) {
                    const int c16 = nt * 128 + wc * 64 + n * 16, r96 = c16 % 96;
                    float v[4];
#pragma unroll
                    for (int j = 0; j < 4; ++j) v[j] = acc[m][n][j] * sc;
                    if (latent && r96 >= 64) {
                        const int pos = (r96 == 64) ? (tt >> 6) : (tt & 63);
#pragma unroll
                        for (int j = 0; j < 4; ++j) {
                            const float other = xor32_get(v[j], lane);
                            const int fi = (fq & 1) * 4 + j;
                            const float cs = rope[(pos * 8 + fi) * 2], sn = rope[(pos * 8 + fi) * 2 + 1];
                            v[j] = (fq & 2) ? (other * sn + v[j] * cs) : (v[j] * cs - other * sn);
                        }
                    }
                    qpk[n].x = pk_bf16(v[0], v[1]); qpk[n].y = pk_bf16(v[2], v[3]);
                }
#pragma unroll
                for (int n = 0; n < 4; n += 2)
                    *(uint4*)(Q + row * 768 + nt * 128 + wc * 64 + (n + (fq & 1)) * 16 + (fq >> 1) * 8) = widen16(qpk[n], qpk[n + 1]);
            }
        } else {
            int mt, nt; tile_mn(t - NQ, 8, mt, nt);
            gemm_mainloop<4, 2>(acc, Hm + (size_t)mt * 256 * 672 + 384, 672, 64, W + WO_UKV + (size_t)nt * 128 * 256, 256, 4, lds, tid);
            const int b = mt / 9, pp0 = (mt % 9) * 256;
            if (wc == 0) {
#pragma unroll
                for (int m = 0; m < 4; ++m) {
                    const size_t row = (size_t)mt * 256 + wr * 64 + m * 16 + fr;
                    const float sc = RSKV[row];
#pragma unroll
                    for (int n = 0; n < 4; n += 2) {
                        uint2 a, b2;
                        a.x = pk_bf16(acc[m][n][0] * sc, acc[m][n][1] * sc); a.y = pk_bf16(acc[m][n][2] * sc, acc[m][n][3] * sc);
                        b2.x = pk_bf16(acc[m][n + 1][0] * sc, acc[m][n + 1][1] * sc); b2.y = pk_bf16(acc[m][n + 1][2] * sc, acc[m][n + 1][3] * sc);
                        *(uint4*)(KN + row * 512 + nt * 64 + (n + (fq & 1)) * 16 + (fq >> 1) * 8) = widen16(a, b2);
                    }
                }
            } else {
#pragma unroll
                for (int m = 0; m < 4; ++m) {
                    const int lrow = wr * 64 + m * 16 + fq * 4;
                    const f32x4 sc = *(const f32x4*)(RSKV + (size_t)mt * 256 + lrow);
#pragma unroll
                    for (int n = 0; n < 4; n += 2) {
                        uint2 a, b2;
                        a.x = pk_bf16(acc[m][n][0] * sc[0], acc[m][n][1] * sc[1]); a.y = pk_bf16(acc[m][n][2] * sc[2], acc[m][n][3] * sc[3]);
                        b2.x = pk_bf16(acc[m][n + 1][0] * sc[0], acc[m][n + 1][1] * sc[1]); b2.y = pk_bf16(acc[m][n + 1][2] * sc[2], acc[m][n + 1][3] * sc[3]);
                        const int dv = (n + (fq & 1)) * 16 + fr;
                        *(uint4*)(VT + ((size_t)(b * 8 + nt) * 64 + dv) * TPB + pp0 + wr * 64 + m * 16 + (fq >> 1) * 8) = widen16(a, b2);
                    }
                }
            }
        }
    }
    {
        const bf16_t* Hr = (const bf16_t*)(p.ws + OFF_R3);
        bf16_t* SG = (bf16_t*)(p.ws + OFF_SG);
        const float* mu = p.rw_mu + (size_t)l * 1920 + 1792;
        for (int i = blockIdx.x * NTHREADS + tid; i < MROWS * 16; i += gridDim.x * NTHREADS) {
            const int row = i >> 4, c0 = (i & 15) * 8, pp = row % TPB;
            const bool hp = (pp != 0 && pp != CTXL), hn = (pp != CTXL - 1 && pp != TPB - 1);
            const bf16_t* hr = Hr + (size_t)row * 1920 + 1792 + c0;
            float cur[8], pv[8], nx[8];
            unpack8(*(const uint4*)hr, cur);
            if (hp) unpack8(*(const uint4*)(hr - 1920), pv); else {
#pragma unroll
                for (int k = 0; k < 8; ++k) pv[k] = 0.f; }
            if (hn) unpack8(*(const uint4*)(hr + 1920), nx); else {
#pragma unroll
                for (int k = 0; k < 8; ++k) nx[k] = 0.f; }
            float o[8];
#pragma unroll
            for (int k = 0; k < 8; ++k) o[k] = sigmoidf_(cur[k] + (0.5f * (pv[k] + nx[k]) - cur[k]) * mu[c0 + k]);
            uint4 ov; ov.x = pk_bf16(o[0], o[1]); ov.y = pk_bf16(o[2], o[3]); ov.z = pk_bf16(o[4], o[5]); ov.w = pk_bf16(o[6], o[7]);
            *(uint4*)(SG + (size_t)row * 128 + c0) = ov;
        }
    }
}

#define FMAC_BC(acc, coef, s, J) asm("v_fmac_f32_dpp %0, %1, %2 row_newbcast:" #J " row_mask:0xf bank_mask:0xf" : "+v"(acc) : "v"(coef), "v"(s))
#define MUL_BC(dst, coef, s, J) asm("v_mul_f32_dpp %0, %1, %2 row_newbcast:" #J " row_mask:0xf bank_mask:0xf" : "=v"(dst) : "v"(coef), "v"(s))
#define REP16(X) X(0, 0) X(1, 1) X(2, 2) X(3, 3) X(4, 0) X(5, 1) X(6, 2) X(7, 3) X(8, 0) X(9, 1) X(10, 2) X(11, 3) X(12, 0) X(13, 1) X(14, 2) X(15, 3)
constexpr int FSTR = 6 * 64 + 4;
constexpr int CHUNK = 32, NCHUNK = TPB / CHUNK;

__device__ __forceinline__ int scan_pos(int z, int s) { return z == 0 ? s : (s < CTXL ? (CTXL - 1 - s) : (TPB + CTXL - 1 - s)); }

__device__ __forceinline__ void shift4(const bf16_t* hr, bool hp, bool hn, int col, const float* mu, float (&o)[4]) {
    const uint2 c = *(const uint2*)(hr + col);
    uint2 a = make_uint2(0u, 0u), b = make_uint2(0u, 0u);
    if (hp) a = *(const uint2*)(hr - 1920 + col);
    if (hn) b = *(const uint2*)(hr + 1920 + col);
    const f32x4 m = *(const f32x4*)(mu + col);
    const float cv[4] = {bf_lo(c.x), bf_hi(c.x), bf_lo(c.y), bf_hi(c.y)};
    const float av[4] = {bf_lo(a.x), bf_hi(a.x), bf_lo(a.y), bf_hi(a.y)};
    const float bv[4] = {bf_lo(b.x), bf_hi(b.x), bf_lo(b.y), bf_hi(b.y)};
#pragma unroll
    for (int i = 0; i < 4; ++i) o[i] = cv[i] + (0.5f * (av[i] + bv[i]) - cv[i]) * m[i];
}
__device__ __forceinline__ void shift8(const bf16_t* hr, bool hp, bool hn, int col, const float* mu, float (&o)[8]) {
    float cv[8], av[8], bv[8];
    unpack8(*(const uint4*)(hr + col), cv);
    if (hp) unpack8(*(const uint4*)(hr - 1920 + col), av); else {
#pragma unroll
        for (int i = 0; i < 8; ++i) av[i] = 0.f; }
    if (hn) unpack8(*(const uint4*)(hr + 1920 + col), bv); else {
#pragma unroll
        for (int i = 0; i < 8; ++i) bv[i] = 0.f; }
#pragma unroll
    for (int i = 0; i < 8; ++i) o[i] = cv[i] + (0.5f * (av[i] + bv[i]) - cv[i]) * mu[col + i];
}
__device__ __forceinline__ bf16x8 pack8(const float (&f)[8]) {
    union { uint4 u; bf16x8 v; } r;
    r.u.x = pk_bf16(f[0], f[1]); r.u.y = pk_bf16(f[2], f[3]); r.u.z = pk_bf16(f[4], f[5]); r.u.w = pk_bf16(f[6], f[7]);
    return r.v;
}

struct ProdState { f32x4 aw[4], aa[4]; };
struct Raw3x2 { uint2 c, a, b; };
__device__ __forceinline__ Raw3x2 ld3x2(const bf16_t* pc, const bf16_t* pa, const bf16_t* pb, bool hp, bool hn, int col) {
    Raw3x2 r; r.c = *(const uint2*)(pc + col); r.a = *(const uint2*)(pa + col); r.b = *(const uint2*)(pb + col);
    if (!hp) r.a = make_uint2(0u, 0u);
    if (!hn) r.b = make_uint2(0u, 0u);
    return r;
}
__device__ __forceinline__ void sh4(const Raw3x2& r, const f32x4 m, float (&o)[4]) {
    const float cv[4] = {bf_lo(r.c.x), bf_hi(r.c.x), bf_lo(r.c.y), bf_hi(r.c.y)};
    const float av[4] = {bf_lo(r.a.x), bf_hi(r.a.x), bf_lo(r.a.y), bf_hi(r.a.y)};
    const float bv[4] = {bf_lo(r.b.x), bf_hi(r.b.x), bf_lo(r.b.y), bf_hi(r.b.y)};
#pragma unroll
    for (int i = 0; i < 4; ++i) o[i] = cv[i] + (0.5f * (av[i] + bv[i]) - cv[i]) * m[i];
}
struct Raw3x4 { uint4 c, a, b; };
__device__ __forceinline__ Raw3x4 ld3x4(const bf16_t* pc, const bf16_t* pa, const bf16_t* pb, bool hp, bool hn, int col) {
    Raw3x4 r; r.c = *(const uint4*)(pc + col); r.a = *(const uint4*)(pa + col); r.b = *(const uint4*)(pb + col);
    if (!hp) r.a = make_uint4(0u, 0u, 0u, 0u);
    if (!hn) r.b = make_uint4(0u, 0u, 0u, 0u);
    return r;
}
__device__ __forceinline__ void sh8(const Raw3x4& r, const float* m, float (&o)[8]) {
    float cv[8], av[8], bv[8];
    unpack8(r.c, cv); unpack8(r.a, av); unpack8(r.b, bv);
    const f32x4 m0 = *(const f32x4*)m, m1 = *(const f32x4*)(m + 4);
#pragma unroll
    for (int i = 0; i < 8; ++i) o[i] = cv[i] + (0.5f * (av[i] + bv[i]) - cv[i]) * (i < 4 ? m0[i] : m1[i - 4]);
}
template <int N0>
__device__ __forceinline__ void scan_produce_elem(const float* pl, int fq, const Raw3x2 (&rr)[2], const Raw3x2 (&rk)[2], const Raw3x2 (&rv)[2],
                                                  const f32x4 (&aw)[2], const f32x4 (&aa)[2], float& ss, float* frow) {
#pragma unroll
    for (int nn = 0; nn < 2; ++nn) {
        const int n = N0 + nn;
        const int c4 = n * 16 + fq * 4;
        float r4[4], k4[4], v4[4];
        sh4(rr[nn], *(const f32x4*)(pl + 0 * 64 + c4), r4);
        sh4(rk[nn], *(const f32x4*)(pl + 1 * 64 + c4), k4);
        sh4(rv[nn], *(const f32x4*)(pl + 2 * 64 + c4), v4);
        const f32x4 w0 = *(const f32x4*)(pl + 3 * 64 + c4);
        const f32x4 a0 = *(const f32x4*)(pl + 4 * 64 + c4);
        const f32x4 kkp = *(const f32x4*)(pl + 5 * 64 + c4);
        const f32x4 kap = *(const f32x4*)(pl + 6 * 64 + c4);
        f32x4 dw, kd, kf4, a4;
#pragma unroll
        for (int j = 0; j < 4; ++j) {
            const float sgx = __builtin_amdgcn_rcpf(1.0f + fexp(-(aw[nn][j] + w0[j])));
            dw[j] = fexp(-0.6065306597126334f * sgx);
            const float a = __builtin_amdgcn_rcpf(1.0f + fexp(-(aa[nn][j] + a0[j])));
            a4[j] = a;
            const float kf = k4[j] * kkp[j];
            kf4[j] = kf; ss += kf * kf;
            kd[j] = k4[j] * (1.0f + (a - 1.0f) * kap[j]);
        }
        *(f32x4*)(frow + 0 * 64 + c4) = kf4;
        *(f32x4*)(frow + 1 * 64 + c4) = dw;
        *(f32x4*)(frow + 2 * 64 + c4) = a4;
        *(f32x4*)(frow + 3 * 64 + c4) = kd;
        *(f32x4*)(frow + 4 * 64 + c4) = (f32x4){r4[0], r4[1], r4[2], r4[3]};
        *(f32x4*)(frow + 5 * 64 + c4) = (f32x4){v4[0], v4[1], v4[2], v4[3]};
    }
}
__device__ __forceinline__ void scan_produce_A(const Params& p, const float* pl, int b, int h, int z, int s0, float* frow0, int lane, ProdState& st) {
    const int fr = lane & 15, fq = lane >> 4;
    const int pp = scan_pos(z, s0 + fr);
    const bool hp = (pp != 0 && pp != CTXL), hn = (pp != CTXL - 1 && pp != TPB - 1);
    const bf16_t* hr = (const bf16_t*)(p.ws + OFF_R3) + ((size_t)b * TPB + pp) * 1920;
    const bf16_t* W = (const bf16_t*)(p.ws + OFF_W);
    Raw3x4 qw[2], qa[2];
    const bf16_t* pc = hr + z * 64 + fq * 8; const bf16_t* pa = hp ? pc - 1920 : pc; const bf16_t* pb = hn ? pc + 1920 : pc;
#pragma unroll
    for (int ks = 0; ks < 2; ++ks) { qw[ks] = ld3x4(pc, pa, pb, hp, hn, 1536 + ks * 32); qa[ks] = ld3x4(pc, pa, pb, hp, hn, 1664 + ks * 32); }
    f32x4 accw[4], acca[4];
#pragma unroll
    for (int n = 0; n < 4; ++n) { accw[n] = (f32x4){0.f, 0.f, 0.f, 0.f}; acca[n] = (f32x4){0.f, 0.f, 0.f, 0.f}; }
#pragma unroll
    for (int ks = 0; ks < 2; ++ks) {
        bf16x8 bw[4], ba[4];
#pragma unroll
        for (int n = 0; n < 4; ++n) {
            const size_t wo = ((size_t)z * 512 + h * 64 + n * 16 + fr) * 64 + ks * 32 + fq * 8;
            bw[n] = *(const bf16x8*)(W + WO_UP + wo); ba[n] = *(const bf16x8*)(W + WO_AUP + wo);
        }
        float t8[8];
        sh8(qw[ks], pl + 7 * 64 + ks * 32 + fq * 8, t8);
#pragma unroll
        for (int i = 0; i < 8; ++i) { const float e = fexp(2.0f * t8[i]); t8[i] = 1.0f - 2.0f * __builtin_amdgcn_rcpf(e + 1.0f); }
        const bf16x8 aw = pack8(t8);
        sh8(qa[ks], pl + 8 * 64 + ks * 32 + fq * 8, t8);
        const bf16x8 aa = pack8(t8);
#pragma unroll
        for (int n = 0; n < 4; ++n) {
            accw[n] = __builtin_amdgcn_mfma_f32_16x16x32_bf16(bw[n], aw, accw[n], 0, 0, 0);
            acca[n] = __builtin_amdgcn_mfma_f32_16x16x32_bf16(ba[n], aa, acca[n], 0, 0, 0);
        }
    }
#pragma unroll
    for (int n = 0; n < 4; ++n) { st.aw[n] = accw[n]; st.aa[n] = acca[n]; }
}
__device__ __forceinline__ void scan_produce_B(const Params& p, const float* pl, int b, int h, int z, int s0, float* frow0, int lane, const ProdState& st) {
    const int fr = lane & 15, fq = lane >> 4;
    const int pp = scan_pos(z, s0 + fr);
    const bool hp = (pp != 0 && pp != CTXL), hn = (pp != CTXL - 1 && pp != TPB - 1);
    const bf16_t* hr = (const bf16_t*)(p.ws + OFF_R3) + ((size_t)b * TPB + pp) * 1920;
    Raw3x2 rr0[2], rk0[2], rv0[2], rr1[2], rk1[2], rv1[2];
    const bf16_t* pc = hr + h * 64 + fq * 4; const bf16_t* pa = hp ? pc - 1920 : pc; const bf16_t* pb = hn ? pc + 1920 : pc;
#pragma unroll
    for (int nn = 0; nn < 2; ++nn) {
        const int C4 = nn * 16, C5 = C4 + 32;
        rr0[nn] = ld3x2(pc, pa, pb, hp, hn, C4); rk0[nn] = ld3x2(pc, pa, pb, hp, hn, 512 + C4); rv0[nn] = ld3x2(pc, pa, pb, hp, hn, 1024 + C4);
        rr1[nn] = ld3x2(pc, pa, pb, hp, hn, C5); rk1[nn] = ld3x2(pc, pa, pb, hp, hn, 512 + C5); rv1[nn] = ld3x2(pc, pa, pb, hp, hn, 1024 + C5);
    }
    float ss = 0.f;
    float* frow = frow0 + fr * FSTR;
    const f32x4 w01[2] = {st.aw[0], st.aw[1]}, a01[2] = {st.aa[0], st.aa[1]}, w23[2] = {st.aw[2], st.aw[3]}, a23[2] = {st.aa[2], st.aa[3]};
    scan_produce_elem<0>(pl, fq, rr0, rk0, rv0, w01, a01, ss, frow);
    scan_produce_elem<2>(pl, fq, rr1, rk1, rv1, w23, a23, ss, frow);
    ss = fqsum(ss);
    const float inv = __builtin_amdgcn_rsqf(fmaxf(ss, 1e-24f));
#pragma unroll
    for (int n = 0; n < 4; ++n) {
        const int c4 = n * 16 + fq * 4;
        f32x4 kk = *(const f32x4*)(frow + 0 * 64 + c4);
        f32x4 bb = *(const f32x4*)(frow + 2 * 64 + c4);
#pragma unroll
        for (int j = 0; j < 4; ++j) { kk[j] = kk[j] * inv; bb[j] = kk[j] * bb[j]; }
        *(f32x4*)(frow + 0 * 64 + c4) = kk;
        *(f32x4*)(frow + 2 * 64 + c4) = bb;
    }
}

typedef float f32x2 __attribute__((ext_vector_type(2)));
struct ScanHead { f32x4 kk[2]; f32x2 v; };
struct ScanBody { f32x4 w[2], bb[2], kd[2], r[2]; };
__device__ __forceinline__ void scan_ldh(ScanHead& c, const float* f, const float* fv) {
#pragma unroll
    for (int q = 0; q < 2; ++q) c.kk[q] = *(const f32x4*)(f + 0 * 64 + 4 * q);
    c.v = *(const f32x2*)fv;
}
__device__ __forceinline__ void scan_ldb(ScanBody& c, const float* f) {
#pragma unroll
    for (int q = 0; q < 2; ++q) {
        c.w[q] = *(const f32x4*)(f + 1 * 64 + 4 * q); c.bb[q] = *(const f32x4*)(f + 2 * 64 + 4 * q);
        c.kd[q] = *(const f32x4*)(f + 3 * 64 + 4 * q); c.r[q] = *(const f32x4*)(f + 4 * 64 + 4 * q);
    }
}
__device__ __forceinline__ void scan_unit(const Params& p, int l, int u, unsigned char* lds) {
    const int tid = ltid(), wid = __builtin_amdgcn_readfirstlane(tid >> 6), lane = tid & 63;
    const int b = u >> 4, h = (u >> 1) & 7, z = u & 1;
    float* fb = (float*)lds;
    bf16_t* Y = (bf16_t*)(p.ws + (z == 0 ? OFF_YF : OFF_YB));
    float* pl = fb + 3 * CHUNK * FSTR;
    for (int i = tid; i < 9 * 64; i += NTHREADS) {
        const int a = i >> 6, c = i & 63, C = h * 64 + c;
        float v;
        if (a < 3) v = p.rw_mu[(size_t)l * 1920 + a * 512 + C];
        else if (a == 3) v = p.rw_w0[((size_t)l * 2 + z) * 512 + C];
        else if (a == 4) v = p.rw_a0[((size_t)l * 2 + z) * 512 + C];
        else if (a == 5) v = p.rw_k_k[(size_t)l * 512 + C];
        else if (a == 6) v = p.rw_k_a[(size_t)l * 512 + C];
        else if (a == 7) v = p.rw_mu[(size_t)l * 1920 + 1536 + z * 64 + c];
        else v = p.rw_mu[(size_t)l * 1920 + 1664 + z * 64 + c];
        pl[i] = v;
    }
    __syncthreads();
    if (wid < 4) {
        f32x2 S2[8];
#pragma unroll
        for (int j = 0; j < 8; ++j) S2[j] = (f32x2){0.f, 0.f};
        __syncthreads();
        for (int c = 0; c < NCHUNK; ++c) {
            const float* fbc = fb + (c % 3) * CHUNK * FSTR + 8 * (lane & 7);
            const float* fbv = fb + (c % 3) * CHUNK * FSTR + 320 + 16 * wid + 2 * (lane >> 3);
            bf16_t* yp = Y + ((size_t)b * TPB) * 512 + h * 64 + 16 * wid + 2 * (lane >> 3);
            ScanHead ha, hb;
            scan_ldh(ha, fbc, fbv);
#define SCAN_STEP(HC, HN, SL) { \
                ScanBody bd; scan_ldb(bd, fbc + (SL) * FSTR); \
                if ((SL) + 1 < CHUNK) scan_ldh(HN, fbc + ((SL) + 1) * FSTR, fbv + ((SL) + 1) * FSTR); \
                f32x2 d0 = (f32x2){0.f, 0.f}, d1 = (f32x2){0.f, 0.f}; \
                _Pragma("unroll") for (int q = 0; q < 4; ++q) { const f32x2 k2 = (f32x2){HC.kk[q >> 1][2 * (q & 1)], HC.kk[q >> 1][2 * (q & 1) + 1]}; \
                    d0 = __builtin_elementwise_fma(S2[q], k2, d0); d1 = __builtin_elementwise_fma(S2[4 + q], k2, d1); } \
                const float sk0 = red8(d0[0] + d0[1]), sk1 = red8(d1[0] + d1[1]); \
                const f32x2 n0 = (f32x2){-sk0, -sk0}, n1 = (f32x2){-sk1, -sk1}, v0 = (f32x2){HC.v[0], HC.v[0]}, v1 = (f32x2){HC.v[1], HC.v[1]}; \
                f32x2 y0 = (f32x2){0.f, 0.f}, y1 = (f32x2){0.f, 0.f}; \
                _Pragma("unroll") for (int q = 0; q < 4; ++q) { \
                    const f32x2 w2 = (f32x2){bd.w[q >> 1][2 * (q & 1)], bd.w[q >> 1][2 * (q & 1) + 1]}, b2 = (f32x2){bd.bb[q >> 1][2 * (q & 1)], bd.bb[q >> 1][2 * (q & 1) + 1]}; \
                    const f32x2 kd2 = (f32x2){bd.kd[q >> 1][2 * (q & 1)], bd.kd[q >> 1][2 * (q & 1) + 1]}, r2 = (f32x2){bd.r[q >> 1][2 * (q & 1)], bd.r[q >> 1][2 * (q & 1) + 1]}; \
                    f32x2 t0 = S2[q] * w2; t0 = __builtin_elementwise_fma(b2, n0, t0); t0 = __builtin_elementwise_fma(kd2, v0, t0); \
                    f32x2 t1 = S2[4 + q] * w2; t1 = __builtin_elementwise_fma(b2, n1, t1); t1 = __builtin_elementwise_fma(kd2, v1, t1); \
                    S2[q] = t0; S2[4 + q] = t1; \
                    y0 = __builtin_elementwise_fma(t0, r2, y0); y1 = __builtin_elementwise_fma(t1, r2, y1); } \
                const float ya = red8(y0[0] + y0[1]), yb = red8(y1[0] + y1[1]); \
                const int pp = scan_pos(z, c * CHUNK + (SL)); \
                if ((lane & 7) == 0) *(unsigned*)(yp + (size_t)pp * 512) = pk_bf16(ya, yb); }
#pragma unroll 1
            for (int sl = 0; sl < CHUNK; sl += 2) {
                SCAN_STEP(ha, hb, sl)
                SCAN_STEP(hb, ha, sl + 1)
            }
            __syncthreads();
        }
    } else {
        ProdState st;
#pragma unroll
        for (int n = 0; n < 4; ++n) { st.aw[n] = (f32x4){0.f, 0.f, 0.f, 0.f}; st.aa[n] = (f32x4){0.f, 0.f, 0.f, 0.f}; }
        const int nrep = launder_i(1 + ((PROBE_MASK >> 10) & 1));
        const int pair = (wid - 4) >> 1, ph = (wid - 4) & 1;
        {
            float* f0 = fb + (pair % 3) * CHUNK * FSTR + ph * 16 * FSTR;
            scan_produce_A(p, pl, b, h, z, pair * CHUNK + ph * 16, f0, lane, st);
            if (pair == 0) scan_produce_B(p, pl, b, h, z, ph * 16, f0, lane, st);
        }
        __syncthreads();
        for (int c = 0; c < NCHUNK; ++c) {
            for (int rr_ = 0; rr_ < nrep; ++rr_) {
            if (pair == ((c + 1) & 1)) {
                if (c + 1 < NCHUNK) scan_produce_B(p, pl, b, h, z, (c + 1) * CHUNK + ph * 16, fb + ((c + 1) % 3) * CHUNK * FSTR + ph * 16 * FSTR, lane, st);
            } else {
                if (c + 2 < NCHUNK) scan_produce_A(p, pl, b, h, z, (c + 2) * CHUNK + ph * 16, fb + ((c + 2) % 3) * CHUNK * FSTR + ph * 16 * FSTR, lane, st);
            }
            }
            __syncthreads();
        }
    }
}

constexpr int ATT_STAGE = 20480;
__device__ __forceinline__ void attn_unit(const Params& p, int b, int h, int q0, int nkeys, unsigned char* lds, int do_write) {
    const int tid = ltid(), wid = __builtin_amdgcn_readfirstlane(tid >> 6), lane = tid & 63, fr = lane & 15, fq = lane >> 4;
    bf16_t* Q = (bf16_t*)(p.ws + OFF_Q);
    const bf16_t* KN = (const bf16_t*)(p.ws + OFF_KN);
    const bf16_t* KR = (const bf16_t*)(p.ws + OFF_KR);
    const bf16_t* VT = (const bf16_t*)(p.ws + OFF_VT);
    const size_t rb = (size_t)b * TPB;
    bf16x8 qf[2][3];
#pragma unroll
    for (int nq = 0; nq < 2; ++nq)
#pragma unroll
        for (int ks = 0; ks < 3; ++ks) qf[nq][ks] = *(const bf16x8*)(Q + (rb + q0 + wid * 32 + nq * 16 + fr) * 768 + h * 96 + ks * 32 + fq * 8);
    f32x4 oacc[4][2];
#pragma unroll
    for (int mt = 0; mt < 4; ++mt)
#pragma unroll
        for (int nq = 0; nq < 2; ++nq) oacc[mt][nq] = (f32x4){0.f, 0.f, 0.f, 0.f};
    float mrun[2] = {0.f, 0.f}, lsum[2] = {0.f, 0.f};
    const int c8 = (lane & 7) ^ ((4 * wid + (lane >> 4)) & 7);
    const bf16_t* knp = KN + (rb + 8 * wid + (lane >> 3)) * 512 + h * 64 + c8 * 8;
    const bf16_t* vtp = VT + ((size_t)(b * 8 + h) * 64 + 8 * wid + (lane >> 3)) * TPB + c8 * 8;
    const int c4 = (lane & 3) ^ ((lane >> 4) & 3);
    const bf16_t* krp = KR + (rb + 16 * (wid & 3) + (lane >> 2)) * 32 + c4 * 8;
    auto issue = [&](int t, int stg) {
        unsigned char* base = lds + stg * ATT_STAGE;
        const int k0 = t * 64;
        __builtin_amdgcn_global_load_lds((const GLB_AS unsigned*)(knp + (size_t)k0 * 512), (LDS_AS unsigned*)(base + wid * 1024), 16, 0, 0);
        __builtin_amdgcn_global_load_lds((const GLB_AS unsigned*)(vtp + k0), (LDS_AS unsigned*)(base + 12288 + wid * 1024), 16, 0, 0);
        if (wid < 4) __builtin_amdgcn_global_load_lds((const GLB_AS unsigned*)(krp + (size_t)k0 * 32), (LDS_AS unsigned*)(base + 8192 + wid * 1024), 16, 0, 0);
    };
    const int ntile = nkeys / 64;
    const int kz = fr >> 1, rz = (fr >> 2) & 3;
    issue(0, 0);
    asm volatile("s_waitcnt vmcnt(0)" ::: "memory");
    __builtin_amdgcn_s_barrier();
    asm volatile("" ::: "memory");
    for (int t = 0; t < ntile; ++t) {
        if (t + 1 < ntile) issue(t + 1, (t + 1) & 1);
        const unsigned char* Ks = lds + (t & 1) * ATT_STAGE;
        const unsigned char* Rs = Ks + 8192;
        const unsigned char* Vs = Ks + 12288;
        f32x4 sacc[4][2];
#pragma unroll
        for (int km = 0; km < 4; ++km)
#pragma unroll
            for (int nq = 0; nq < 2; ++nq) sacc[km][nq] = (f32x4){-mrun[nq], -mrun[nq], -mrun[nq], -mrun[nq]};
#pragma unroll
        for (int ks = 0; ks < 3; ++ks)
#pragma unroll
            for (int km = 0; km < 4; ++km) {
                const bf16x8 kf = ks < 2 ? *(const bf16x8*)(Ks + (km * 16 + fr) * 128 + (((ks * 4 + fq) ^ kz) * 16))
                                         : *(const bf16x8*)(Rs + (km * 16 + fr) * 64 + ((fq ^ rz) * 16));
#pragma unroll
                for (int nq = 0; nq < 2; ++nq) sacc[km][nq] = __builtin_amdgcn_mfma_f32_16x16x32_bf16(kf, qf[nq][ks], sacc[km][nq], 0, 0, 0);
            }
        float delta[2];
#pragma unroll
        for (int nq = 0; nq < 2; ++nq) {
            float mx = -1e30f;
#pragma unroll
            for (int km = 0; km < 4; ++km)
#pragma unroll
                for (int j = 0; j < 4; ++j) mx = fmaxf(mx, sacc[km][nq][j]);
            mx = fqmax(mx);
            delta[nq] = (t == 0) ? mx : fmaxf(mx, 0.f);
        }
        const bool exact = (t == 0) || (__builtin_amdgcn_ballot_w64(fmaxf(delta[0], delta[1]) > 60.0f) != 0ull);
        bf16x8 pf[2][2];
        float psum[2];
#pragma unroll
        for (int nq = 0; nq < 2; ++nq) {
            float ps = 0.f;
            if (exact) {
#pragma unroll
                for (int km = 0; km < 4; ++km)
#pragma unroll
                    for (int j = 0; j < 4; ++j) { const float e = __builtin_amdgcn_exp2f(sacc[km][nq][j] - delta[nq]); sacc[km][nq][j] = e; ps += e; }
            } else {
#pragma unroll
                for (int km = 0; km < 4; ++km)
#pragma unroll
                    for (int j = 0; j < 4; ++j) { const float e = __builtin_amdgcn_exp2f(sacc[km][nq][j]); sacc[km][nq][j] = e; ps += e; }
            }
            psum[nq] = ps;
#pragma unroll
            for (int kc = 0; kc < 2; ++kc) {
                union { uint4 u; bf16x8 v; } r;
                r.u.x = pk_bf16(sacc[2 * kc][nq][0], sacc[2 * kc][nq][1]); r.u.y = pk_bf16(sacc[2 * kc][nq][2], sacc[2 * kc][nq][3]);
                r.u.z = pk_bf16(sacc[2 * kc + 1][nq][0], sacc[2 * kc + 1][nq][1]); r.u.w = pk_bf16(sacc[2 * kc + 1][nq][2], sacc[2 * kc + 1][nq][3]);
                pf[kc][nq] = r.v;
            }
        }
        if (exact) {
#pragma unroll
            for (int nq = 0; nq < 2; ++nq) {
                const float alpha = (t == 0) ? 1.0f : __builtin_amdgcn_exp2f(-delta[nq]);
                lsum[nq] = lsum[nq] * alpha + psum[nq];
#pragma unroll
                for (int mt = 0; mt < 4; ++mt) oacc[mt][nq] = oacc[mt][nq] * alpha;
            }
        }
#pragma unroll
        for (int mt = 0; mt < 4; ++mt)
#pragma unroll
            for (int kc = 0; kc < 2; ++kc) {
                union { uint2 h2[2]; bf16x8 v; } r;
                const unsigned char* vrow = Vs + (mt * 16 + fr) * 128 + (fq & 1) * 8;
                r.h2[0] = *(const uint2*)(vrow + (((4 * kc + (fq >> 1)) ^ kz) * 16));
                r.h2[1] = *(const uint2*)(vrow + (((4 * kc + 2 + (fq >> 1)) ^ kz) * 16));
#pragma unroll
                for (int nq = 0; nq < 2; ++nq) oacc[mt][nq] = __builtin_amdgcn_mfma_f32_16x16x32_bf16(r.v, pf[kc][nq], oacc[mt][nq], 0, 0, 0);
            }
        if (!exact) {
#pragma unroll
            for (int nq = 0; nq < 2; ++nq) {
                const float alpha = __builtin_amdgcn_exp2f(-delta[nq]);
                lsum[nq] = (lsum[nq] + psum[nq]) * alpha;
#pragma unroll
                for (int mt = 0; mt < 4; ++mt) oacc[mt][nq] = oacc[mt][nq] * alpha;
            }
        }
#pragma unroll
        for (int nq = 0; nq < 2; ++nq) mrun[nq] += delta[nq];
        asm volatile("s_waitcnt vmcnt(0) lgkmcnt(0)" ::: "memory");
        __builtin_amdgcn_s_barrier();
        asm volatile("" ::: "memory");
    }
#pragma unroll
    for (int nq = 0; nq < 2; ++nq) {
        const float inv = 1.0f / fqsum(lsum[nq]);
        bf16_t* orow = Q + (rb + q0 + wid * 32 + nq * 16 + fr) * 768 + h * 96;
#pragma unroll
        for (int mt = 0; mt < 4; mt += 2) {
            uint2 a, b2;
            a.x = pk_bf16(oacc[mt][nq][0] * inv, oacc[mt][nq][1] * inv); a.y = pk_bf16(oacc[mt][nq][2] * inv, oacc[mt][nq][3] * inv);
            b2.x = pk_bf16(oacc[mt + 1][nq][0] * inv, oacc[mt + 1][nq][1] * inv); b2.y = pk_bf16(oacc[mt + 1][nq][2] * inv, oacc[mt + 1][nq][3] * inv);
            const uint4 w = widen16(a, b2);
            if (do_write) *(uint4*)(orow + (mt + (fq & 1)) * 16 + (fq >> 1) * 8) = w;
        }
    }
}

__device__ __forceinline__ void p3_phase(const Params& pin, int l, unsigned char* lds) {
    const Params p = launder(pin); l = launder_i(l);
    for (int r = 0, nr = launder_i(1 + ((PROBE_MASK >> 1) & 1)); r < nr; ++r)
        for (int u = blockIdx.x; u < 256; u += gridDim.x) scan_unit(p, l, u, lds);
    const int nunits = (l == DEPTH - 1) ? 1024 : 1152;
    for (int r = launder_i(((PROBE_MASK >> 9) & 1) ? 0 : 1); r < 2; ++r)
    for (int u = blockIdx.x; u < nunits; u += gridDim.x) {
        if (u < 1024) { const int bh = u >> 3, qt = u & 7; attn_unit(p, bh >> 3, bh & 7, CTXL + qt * 256, TPB, lds, r); }
        else { const int bh = u - 1024; attn_unit(p, bh >> 3, bh & 7, 0, CTXL, lds, r); }
    }
}

__device__ __forceinline__ void p35_phase(const Params& pin, int l, bool skip_ctx, unsigned char* lds) {
    const Params p = launder(pin); l = launder_i(l); const int tid = ltid();
    const bf16_t* SG = (const bf16_t*)(p.ws + OFF_SG);
    const bf16_t* W = (const bf16_t*)(p.ws + OFF_W) + WO_GUP;
    const bf16_t* YF = (const bf16_t*)(p.ws + OFF_YF);
    const bf16_t* YB = (const bf16_t*)(p.ws + OFF_YB);
    const bf16_t* Hr = (const bf16_t*)(p.ws + OFF_R3);
    bf16_t* RWO = (bf16_t*)(p.ws + OFF_RWO);
    const float* mu = p.rw_mu + (size_t)l * 1920;
    const int lane = tid & 63, wid = tid >> 6, wr = wid >> 1, wc = wid & 1, fr = lane & 15, fq = lane >> 4;
    float* gt = (float*)lds;
    constexpr int GP = 132;
    for (int t = blockIdx.x; t < 288 * 4; t += gridDim.x) {
        int mt, nt; tile_mn(t, 4, mt, nt);
        if (skip_ctx && (mt % 18) < 2) continue;
        f32x4 acc[2][4]; zero_acc<2>(acc);
        gemm_mainloop<2, 1>(acc, SG + (size_t)mt * 128 * 128, 128, 64, W + (size_t)nt * 128 * 128, 128, 2, lds, tid);
#pragma unroll
        for (int m = 0; m < 2; ++m)
#pragma unroll
            for (int n = 0; n < 4; ++n) *(f32x4*)(gt + (wr * 32 + m * 16 + fr) * GP + wc * 64 + n * 16 + fq * 4) = acc[m][n];
        __syncthreads();
        const int pp0 = (mt % 18) * 128;
#pragma unroll 1
        for (int it = 0; it < 4; ++it) {
            const int item = tid + it * NTHREADS, lrow = item >> 4, cg = item & 15, pp = pp0 + lrow;
            const size_t row = (size_t)mt * 128 + lrow;
            const int C = nt * 128 + cg * 8;
            const bool hp = (pp != 0 && pp != CTXL), hn = (pp != CTXL - 1 && pp != TPB - 1);
            const bf16_t* hr = Hr + row * 1920;
            float yf[8], yb[8], r8[8], k8[8], v8[8];
            unpack8(*(const uint4*)(YF + row * 512 + C), yf); unpack8(*(const uint4*)(YB + row * 512 + C), yb);
            shift8(hr, hp, hn, C, mu, r8); shift8(hr, hp, hn, 512 + C, mu, k8); shift8(hr, hp, hn, 1024 + C, mu, v8);
            const float* rkp = p.rw_r_k + (size_t)l * 512 + C;
            float s1 = 0.f, bs = 0.f;
#pragma unroll
            for (int i = 0; i < 8; ++i) { yf[i] += yb[i]; s1 += yf[i]; bs += r8[i] * k8[i] * rkp[i]; }
            s1 = red8(s1); bs = red8(bs);
            const float mean = s1 * (1.0f / 64.0f);
            float s2 = 0.f;
#pragma unroll
            for (int i = 0; i < 8; ++i) { const float d = yf[i] - mean; s2 += d * d; }
            s2 = red8(s2);
            const float rstd = __builtin_amdgcn_rsqf(s2 * (1.0f / 64.0f) + 64e-5f);
            const float* ggp = p.rw_gn_g + (size_t)l * 512 + C; const float* gbp = p.rw_gn_b + (size_t)l * 512 + C;
            const f32x4 g0 = *(const f32x4*)(gt + lrow * GP + cg * 8), g1 = *(const f32x4*)(gt + lrow * GP + cg * 8 + 4);
            float o[8];
#pragma unroll
            for (int i = 0; i < 8; ++i) o[i] = ((yf[i] - mean) * rstd * ggp[i] + gbp[i] + bs * v8[i]) * (i < 4 ? g0[i] : g1[i - 4]);
            uint4 ov; ov.x = pk_bf16(o[0], o[1]); ov.y = pk_bf16(o[2], o[3]); ov.z = pk_bf16(o[4], o[5]); ov.w = pk_bf16(o[6], o[7]);
            *(uint4*)(RWO + row * 512 + C) = ov;
        }
        __syncthreads();
    }
}

__device__ __forceinline__ void p4_phase(const Params& pin, bool skip_ctx, unsigned char* lds) {
    const Params p = launder(pin); const int tid = ltid();
    const bf16_t* XM = (const bf16_t*)(p.ws + OFF_R6);
    const bf16_t* W = (const bf16_t*)(p.ws + OFF_W);
    bf16_t* MG = (bf16_t*)(p.ws + OFF_MRG);
    const int lane = tid & 63, wid = tid >> 6, wr = wid >> 1, wc = wid & 1, fr = lane & 15, fq = lane >> 4;
    for (int t = blockIdx.x; t < 288 * 8; t += gridDim.x) {
        int mt, nt; tile_mn(t, 8, mt, nt);
        if (skip_ctx && (mt % 18) < 2) continue;
        f32x4 g[3][2][4];
#pragma unroll
        for (int i = 0; i < 3; ++i) zero_acc<2>(g[i]);
        gemm_gate3(g, XM + (size_t)mt * 128 * 1024, W + WO_IN + (size_t)(4224 + nt * 128) * 1024, 16, lds, tid);
        typedef __fp16 h16x2 __attribute__((ext_vector_type(2)));
        h16x2 gp[3][2][4][2];
#pragma unroll
        for (int i = 0; i < 3; ++i)
#pragma unroll
            for (int m = 0; m < 2; ++m)
#pragma unroll
                for (int n = 0; n < 4; ++n) {
                    gp[i][m][n][0] = __builtin_amdgcn_cvt_pkrtz(sigmoidf_(g[i][m][n][0]), sigmoidf_(g[i][m][n][1]));
                    gp[i][m][n][1] = __builtin_amdgcn_cvt_pkrtz(sigmoidf_(g[i][m][n][2]), sigmoidf_(g[i][m][n][3]));
                }
        f32x4 mg[2][4]; zero_acc<2>(mg);
#pragma unroll 1
        for (int i = 0; i < 3; ++i) {
            const bf16_t* Ab; int lda, kst; const bf16_t* Wb;
            if (i == 0) { Ab = (const bf16_t*)(p.ws + OFF_Q); lda = 768; kst = 96; Wb = W + WO_OA; }
            else if (i == 1) { Ab = (const bf16_t*)(p.ws + OFF_R5); lda = 512; kst = 64; Wb = W + WO_OC; }
            else { Ab = (const bf16_t*)(p.ws + OFF_RWO); lda = 512; kst = 64; Wb = W + WO_OR; }
            f32x4 a[2][4]; zero_acc<2>(a);
            gemm_mainloop<2, 1>(a, Ab + (size_t)mt * 128 * lda, lda, kst, Wb + (size_t)nt * 128 * 512, 512, 8, lds, tid);
#pragma unroll
            for (int m = 0; m < 2; ++m)
#pragma unroll
                for (int n = 0; n < 4; ++n) {
                    const h16x2 g0 = i == 0 ? gp[0][m][n][0] : (i == 1 ? gp[1][m][n][0] : gp[2][m][n][0]);
                    const h16x2 g1 = i == 0 ? gp[0][m][n][1] : (i == 1 ? gp[1][m][n][1] : gp[2][m][n][1]);
                    mg[m][n][0] += (float)g0[0] * a[m][n][0]; mg[m][n][1] += (float)g0[1] * a[m][n][1];
                    mg[m][n][2] += (float)g1[0] * a[m][n][2]; mg[m][n][3] += (float)g1[1] * a[m][n][3];
                }
        }
#pragma unroll
        for (int m = 0; m < 2; ++m) {
            const size_t row = (size_t)mt * 128 + wr * 32 + m * 16 + fr;
#pragma unroll
            for (int n = 0; n < 4; n += 2) {
                uint2 a, b2;
                a.x = pk_bf16(mg[m][n][0], mg[m][n][1]); a.y = pk_bf16(mg[m][n][2], mg[m][n][3]);
                b2.x = pk_bf16(mg[m][n + 1][0], mg[m][n + 1][1]); b2.y = pk_bf16(mg[m][n + 1][2], mg[m][n + 1][3]);
                *(uint4*)(MG + row * 1024 + nt * 128 + wc * 64 + (n + (fq & 1)) * 16 + (fq >> 1) * 8) = widen16(a, b2);
            }
        }
    }
}

template <int MT>
__device__ __forceinline__ void resid_tile(const Params& p, int l, const bf16_t* A, int lda, int nk, const bf16_t* Wt, int ldb, int goff, bool x_from_input,
                                           const float* lng, const float* lnb, int row0, int nt, unsigned char* lds, int tid) {
    const int lane = tid & 63, wid = tid >> 6, wr = wid >> 1, wc = wid & 1, fr = lane & 15, fq = lane >> 4;
    f32x4 acc[MT][4]; zero_acc<MT>(acc);
    gemm_mainloop<MT, 1>(acc, A + (size_t)row0 * lda, lda, 64, Wt + (size_t)nt * 128 * ldb, ldb, nk, lds, tid);
    const int b = row0 / TPB, pp0 = row0 % TPB;
    const float* gv = modv_ptr(p, l, b, pp0) + goff;
    const float* stats = (const float*)(p.ws + OFF_STATS);
#pragma unroll
    for (int m = 0; m < MT; ++m) {
        const int lr = wr * 16 * MT + m * 16 + fr, pp = pp0 + lr;
        const float* xi = x_rd(p, x_from_input, b, pp);
        float* xo = x_wr(p, b, pp);
        float mean = 0.f, rstd = 1.f;
        if (!x_from_input) { const size_t row = (size_t)row0 + lr; mean = stats[row * 2]; rstd = stats[row * 2 + 1]; }
#pragma unroll
        for (int n = 0; n < 4; ++n) {
            const int col = nt * 128 + wc * 64 + n * 16 + fq * 4;
            f32x4 xv = *(const f32x4*)(xi + col); const f32x4 g4 = *(const f32x4*)(gv + col);
            if (!x_from_input) {
                const f32x4 lg = *(const f32x4*)(lng + col), lb = *(const f32x4*)(lnb + col);
#pragma unroll
                for (int j = 0; j < 4; ++j) xv[j] = (xv[j] - mean) * rstd * lg[j] + lb[j];
            }
            f32x4 o;
#pragma unroll
            for (int j = 0; j < 4; ++j) o[j] = ALPHA * xv[j] + g4[j] * acc[m][n][j];
            *(f32x4*)(xo + col) = o;
        }
    }
}
__device__ __forceinline__ void resid_tile256(const Params& p, int l, const bf16_t* A, int lda, int nk, const bf16_t* Wt, int ldb, int goff, bool x_from_input,
                                              const float* lng, const float* lnb, int row0, int nt256, unsigned char* lds, int tid) {
    const int lane = tid & 63, wid = tid >> 6, wr = wid >> 2, wc = wid & 3, fr = lane & 15, fq = lane >> 4;
    f32x4 acc[8][4]; zero_acc<8>(acc);
    Seg sg; sg.A = A + (size_t)row0 * lda; sg.Bt = Wt + (size_t)nt256 * 256 * ldb; sg.lda = lda; sg.a_kstep = 64; sg.ldb = ldb; sg.nk = nk;
    int st = 0;
    gemm_stream256(acc, sg, sg, false, true, st, lds, tid);
    const int b = row0 / TPB, pp0 = row0 % TPB;
    const float* gv = modv_ptr(p, l, b, pp0) + goff;
    const float* stats = (const float*)(p.ws + OFF_STATS);
#pragma unroll
    for (int m = 0; m < 8; ++m) {
        const int lr = wr * 128 + m * 16 + fr, pp = pp0 + lr;
        const float* xi = x_rd(p, x_from_input, b, pp);
        float* xo = x_wr(p, b, pp);
        float mean = 0.f, rstd = 1.f;
        if (!x_from_input) { const size_t row = (size_t)row0 + lr; mean = stats[row * 2]; rstd = stats[row * 2 + 1]; }
#pragma unroll
        for (int n = 0; n < 4; ++n) {
            const int col = nt256 * 256 + wc * 64 + n * 16 + fq * 4;
            f32x4 xv = *(const f32x4*)(xi + col); const f32x4 g4 = *(const f32x4*)(gv + col);
            if (!x_from_input) {
                const f32x4 lg = *(const f32x4*)(lng + col), lb = *(const f32x4*)(lnb + col);
#pragma unroll
                for (int j = 0; j < 4; ++j) xv[j] = (xv[j] - mean) * rstd * lg[j] + lb[j];
            }
            f32x4 o;
#pragma unroll
            for (int j = 0; j < 4; ++j) o[j] = ALPHA * xv[j] + g4[j] * acc[m][n][j];
            *(f32x4*)(xo + col) = o;
        }
    }
}
__device__ __forceinline__ void resid_gemm_phase(const Params& pin, int l, size_t a_off, int lda, int nk, size_t w_off, int ldb, int goff, bool x_from_input, const float* lng, const float* lnb, bool skip_ctx, unsigned char* lds) {
    const Params p = launder(pin); l = launder_i(l);
    const int tid = ltid();
    const bf16_t* A = (const bf16_t*)(p.ws + a_off);
    const bf16_t* Wt = (const bf16_t*)(p.ws + OFF_W) + w_off;
    if (gridDim.x == 256) {
        for (int t = blockIdx.x; t < 512; t += 256) {
            int mt, nt; tile_mn(t, 4, mt, nt);
            if (skip_ctx && (mt % 9) == 0) continue;
            resid_tile256(p, l, A, lda, nk, Wt, ldb, goff, x_from_input, lng, lnb, mt * 256, nt, lds, tid);
        }
        int mt, nt; tile_mn(512 + (blockIdx.x >> 2), 4, mt, nt);
        const int q = blockIdx.x & 3;
        if (!(skip_ctx && (mt % 9) == 0)) resid_tile<2>(p, l, A, lda, nk, Wt, ldb, goff, x_from_input, lng, lnb, mt * 256 + (q >> 1) * 128, nt * 2 + (q & 1), lds, tid);
    } else {
        for (int t = blockIdx.x; t < 144 * 8; t += gridDim.x) {
            int mt, nt; tile_mn(t, 8, mt, nt);
            if (skip_ctx && (mt % 9) == 0) continue;
            resid_tile<4>(p, l, A, lda, nk, Wt, ldb, goff, x_from_input, lng, lnb, mt * 256, nt, lds, tid);
        }
    }
}

__device__ __forceinline__ void ln_phase(const Params& pin, const float* g, const float* bta, int lmod, int shoff, bool write_xmod, bool write_x, bool skip_ctx) {
    const Params p = launder(pin); lmod = launder_i(lmod);
    const int tid = ltid(), wid = tid >> 6, lane = tid & 63;
    bf16_t* xm = (bf16_t*)(p.ws + OFF_R6);
    float* stats = (float*)(p.ws + OFF_STATS);
    for (int row = blockIdx.x * 8 + wid; row < MROWS; row += gridDim.x * 8) {
        const int b = row / TPB, pp = row % TPB;
        if (skip_ctx && pp < CTXL) continue;
        float* xp = x_wr(p, b, pp);
        f32x4 v[4];
        float s = 0.f;
#pragma unroll
        for (int i = 0; i < 4; ++i) { v[i] = *(const f32x4*)(xp + i * 256 + lane * 4); s += (v[i][0] + v[i][1]) + (v[i][2] + v[i][3]); }
        const float mean = wave_sum(s) * (1.0f / 1024.0f);
        float q = 0.f;
#pragma unroll
        for (int i = 0; i < 4; ++i)
#pragma unroll
            for (int j = 0; j < 4; ++j) { const float d = v[i][j] - mean; q += d * d; }
        const float rstd = __builtin_amdgcn_rsqf(wave_sum(q) * (1.0f / 1024.0f) + 1e-5f);
        if (lane == 0) { stats[(size_t)row * 2] = mean; stats[(size_t)row * 2 + 1] = rstd; }
        const float* mv = write_xmod ? modv_ptr(p, lmod, b, pp) + shoff : nullptr;
#pragma unroll
        for (int i = 0; i < 4; ++i) {
            const int c = i * 256 + lane * 4;
            const f32x4 g4 = *(const f32x4*)(g + c), b4 = *(const f32x4*)(bta + c);
            f32x4 o;
#pragma unroll
            for (int j = 0; j < 4; ++j) o[j] = (v[i][j] - mean) * rstd * g4[j] + b4[j];
            if (write_x) *(f32x4*)(xp + c) = o;
            if (write_xmod) {
                const f32x4 sh = *(const f32x4*)(mv + c), sc = *(const f32x4*)(mv + 1024 + c);
                uint2 ov; ov.x = pk_bf16(o[0] * (1.f + sc[0]) + sh[0], o[1] * (1.f + sc[1]) + sh[1]); ov.y = pk_bf16(o[2] * (1.f + sc[2]) + sh[2], o[3] * (1.f + sc[3]) + sh[3]);
                *(uint2*)(xm + (size_t)row * 1024 + c) = ov;
            }
        }
    }
}

__device__ __forceinline__ void p7_phase(const Params& pin, bool skip_ctx, unsigned char* lds) {
    const Params p = launder(pin); const int tid = ltid();
    const bf16_t* A = (const bf16_t*)(p.ws + OFF_R6);
    const bf16_t* W = (const bf16_t*)(p.ws + OFF_W) + WO_13;
    bf16_t* HF = (bf16_t*)(p.ws + OFF_HF);
    const int lane = tid & 63, wid = tid >> 6, wr = wid >> 2, wc = wid & 3, fr = lane & 15, fq = lane >> 4;
    auto seg = [&](int t) { int mt, nt; tile_mn(t, 22, mt, nt); Seg g; g.A = A + (size_t)mt * 256 * 1024; g.Bt = W + (size_t)nt * 256 * 1024; g.lda = 1024; g.a_kstep = 64; g.ldb = 1024; g.nk = 16; return g; };
    auto valid = [&](int t) { int mt, nt; tile_mn(t, 22, mt, nt); return !(skip_ctx && (mt % 9) == 0); };
    auto nextv = [&](int t) { while (t < 144 * 22 && !valid(t)) t += gridDim.x; return t; };
    int st = 0; bool first = true;
    for (int t = nextv(blockIdx.x); t < 144 * 22;) {
        int mt, nt; tile_mn(t, 22, mt, nt);
        const int tn = nextv(t + gridDim.x); const bool hn = tn < 144 * 22;
        f32x4 acc[8][4]; zero_acc<8>(acc);
        gemm_stream256(acc, seg(t), seg(hn ? tn : t), hn, first, st, lds, tid); first = false;
        const int G = nt * 4 + wc;
#pragma unroll
        for (int m = 0; m < 8; ++m) {
            const size_t row = (size_t)mt * 256 + wr * 128 + m * 16 + fr;
            uint2 ov[2];
#pragma unroll
            for (int n = 0; n < 2; ++n) {
                float o[4];
#pragma unroll
                for (int j = 0; j < 4; ++j) o[j] = siluf_(acc[m][n][j]) * acc[m][n + 2][j];
                ov[n].x = pk_bf16(o[0], o[1]); ov[n].y = pk_bf16(o[2], o[3]);
            }
            *(uint4*)(HF + row * DFF + G * 32 + (fq & 1) * 16 + (fq >> 1) * 8) = widen16(ov[0], ov[1]);
        }
        t = tn;
    }
}

__global__ void __launch_bounds__(NTHREADS) fwd_megakernel(Params p) {
    extern __shared__ __attribute__((aligned(16))) unsigned char lds[];
    cg::grid_group grid = cg::this_grid();
    unsigned* gbar = (unsigned*)(p.ws + OFF_BAR); unsigned epoch = 0;
#define GSYNC() grid_barrier(gbar, epoch)
    if (p.ws == nullptr) grid.sync();
    modv_phase(p, lds);
    convert_layer(p, 0, lds);
    {
        bf16_t* Wm = (bf16_t*)(p.ws + OFF_W) + WO_IN + (size_t)672 * 1024;
        for (int i = blockIdx.x * NTHREADS + threadIdx.x; i < 96 * 1024 / 2; i += gridDim.x * NTHREADS) ((unsigned*)Wm)[i] = 0u;
    }
    GSYNC();
    xmod0_phase(p);
    GSYNC();
#pragma unroll 1
    for (int l = 0; l < DEPTH; ++l) {
        const bool last = (l == DEPTH - 1);
        for (int r = 0, nr = launder_i(1 + ((PROBE_MASK >> 2) & 1)); r < nr; ++r) p1_phase(p, lds);
        GSYNC();
        for (int r = 0, nr = launder_i(1 + ((PROBE_MASK >> 3) & 1)); r < nr; ++r) p2a_phase(p, l);
        GSYNC();
        for (int r = 0, nr = launder_i(1 + ((PROBE_MASK >> 4) & 1)); r < nr; ++r) p2b_phase(p, l, lds);
        GSYNC();
        p3_phase(p, l, lds);
        GSYNC();
        for (int r = 0, nr = launder_i(1 + ((PROBE_MASK >> 5) & 1)); r < nr; ++r) p35_phase(p, l, last, lds);
        GSYNC();
        for (int r = 0, nr = launder_i(1 + ((PROBE_MASK >> 6) & 1)); r < nr; ++r) p4_phase(p, last, lds);
        GSYNC();
        resid_gemm_phase(p, l, OFF_MRG, 1024, 16, WO_OUT, 1024, 2048, l == 0, p.ln2_g + (l > 0 ? l - 1 : 0) * 1024, p.ln2_b + (l > 0 ? l - 1 : 0) * 1024, last, lds);
        GSYNC();
        ln_phase(p, p.ln1_g + l * 1024, p.ln1_b + l * 1024, l, 3072, true, false, last);
        GSYNC();
        for (int r = 0, nr = launder_i(1 + ((PROBE_MASK >> 0) & 1)); r < nr; ++r) p7_phase(p, last, lds);
        GSYNC();
        resid_gemm_phase(p, l, OFF_HF, DFF, 44, WO_2, DFF, 5120, false, p.ln1_g + l * 1024, p.ln1_b + l * 1024, last, lds);
        GSYNC();
        ln_phase(p, p.ln2_g + l * 1024, p.ln2_b + l * 1024, last ? l : l + 1, 0, !last, last, last);
        if (!last) for (int r = 0, nr = launder_i(1 + ((PROBE_MASK >> 7) & 1)); r < nr; ++r) convert_layer(p, l + 1, lds);
        for (int r = 0, nr = launder_i(((PROBE_MASK >> 8) & 1) * 10); r < nr; ++r) GSYNC();
        GSYNC();
    }
}

extern "C" void kernel_launch(void* const* d_in, const int* in_sizes, int n_in, void* d_out,
                              int out_size, void* d_ws, size_t ws_size, hipStream_t stream) {
    static int grid_blocks = 0;
    if (!grid_blocks) {
        int dev = 0, cus = 0, per_cu = 0;
        hipGetDevice(&dev);
        hipDeviceGetAttribute(&cus, hipDeviceAttributeMultiprocessorCount, dev);
        if (hipFuncSetAttribute((const void*)fwd_megakernel, hipFuncAttributeMaxDynamicSharedMemorySize, LDS_BYTES) != hipSuccess)
            fprintf(stderr, "hipFuncSetAttribute failed\n");
        hipOccupancyMaxActiveBlocksPerMultiprocessor(&per_cu, (const void*)fwd_megakernel, NTHREADS, LDS_BYTES);
        if (per_cu < 1) fprintf(stderr, "occupancy query says %d blocks/CU\n", per_cu);
        (void)hipGetLastError();
        grid_blocks = cus > 0 ? cus : 256;
        if (ws_size < WS_END) { fprintf(stderr, "workspace too small: %zu < %zu\n", ws_size, (size_t)WS_END); grid_blocks = -1; }
        if (n_in != 33) { fprintf(stderr, "expected 33 inputs, got %d\n", n_in); grid_blocks = -1; }
    }
    if (grid_blocks < 0) return;
    if (hipMemsetAsync((unsigned char*)d_ws + OFF_BAR, 0, 1024, stream) != hipSuccess) fprintf(stderr, "memset failed\n");
    Params p{};
    const float** pp = (const float**)&p;
    for (int i = 0; i < 33; ++i) pp[i] = (const float*)d_in[i];
    p.out = (float*)d_out;
    p.ws = (unsigned char*)d_ws;
    void* args[] = {&p};
    hipError_t e = hipLaunchCooperativeKernel((void*)fwd_megakernel, dim3(grid_blocks), dim3(NTHREADS), args, LDS_BYTES, stream);
    if (e != hipSuccess) fprintf(stderr, "cooperative launch failed: %s (grid %d)\n", hipGetErrorString(e), grid_blocks);
}
```

```cpp
#include <hip/hip_runtime.h>
#include <hip/hip_cooperative_groups.h>
#include <cstdio>
#include <cstdint>
namespace cg = cooperative_groups;

typedef unsigned short bf16_t;
typedef short bf16x8 __attribute__((ext_vector_type(8)));
typedef float f32x4 __attribute__((ext_vector_type(4)));

#ifndef PROBE_MASK
#define PROBE_MASK 0
#endif
constexpr int BATCH = 16, SEQ = 2048, CTXL = 256, DM = 1024, DEPTH = 4, DFF = 2816, DIN = 7200;
constexpr int TPB = SEQ + CTXL;
constexpr int MROWS = BATCH * TPB;
constexpr int NTHREADS = 512;
constexpr int LDS_BYTES = 152 * 1024;
constexpr float ALPHA = 1.681792830507429f;
constexpr float QSCALE = 0.10206207261596575f * 1.4426950408889634f;

constexpr size_t WO_IN = 0;
constexpr size_t WO_UQ = WO_IN + (size_t)7296 * 1024;
constexpr size_t WO_UKV = WO_UQ + (size_t)768 * 384;
constexpr size_t WO_OA = WO_UKV + (size_t)1024 * 256;
constexpr size_t WO_OC = WO_OA + (size_t)1024 * 512;
constexpr size_t WO_OR = WO_OC + (size_t)1024 * 512;
constexpr size_t WO_OUT = WO_OR + (size_t)1024 * 512;
constexpr size_t WO_13 = WO_OUT + (size_t)1024 * 1024;
constexpr size_t WO_2 = WO_13 + (size_t)5632 * 1024;
constexpr size_t WO_UP = WO_2 + (size_t)1024 * 2816;
constexpr size_t WO_AUP = WO_UP + (size_t)2 * 512 * 64;
constexpr size_t WO_GUP = WO_AUP + (size_t)2 * 512 * 64;
constexpr size_t W_ELEMS = WO_GUP + (size_t)512 * 128;

constexpr size_t al256(size_t x) { return (x + 255) & ~(size_t)255; }
constexpr size_t OFF_BAR = 0;
constexpr size_t OFF_ZROW = 1024;
constexpr size_t OFF_W = 8192;
constexpr size_t OFF_MODV = al256(OFF_W + W_ELEMS * 2);
constexpr size_t OFF_ROPE = al256(OFF_MODV + (size_t)4 * 17 * 6144 * 4);
constexpr size_t OFF_RSQ = al256(OFF_ROPE + 64 * 8 * 2 * 4);
constexpr size_t OFF_RSKV = al256(OFF_RSQ + (size_t)MROWS * 4);
constexpr size_t OFF_STATS = al256(OFF_RSKV + (size_t)MROWS * 4);
constexpr size_t OFF_XC = al256(OFF_STATS + (size_t)MROWS * 8);
constexpr size_t OFF_R1 = al256(OFF_XC + (size_t)BATCH * CTXL * DM * 4);
constexpr size_t OFF_R2 = al256(OFF_R1 + (size_t)MROWS * 672 * 2);
constexpr size_t OFF_R3 = OFF_R2 + (size_t)MROWS * 1536 * 2;
constexpr size_t OFF_R4 = al256(OFF_R3 + (size_t)MROWS * 1920 * 2);
constexpr size_t OFF_R5 = al256(OFF_R4 + (size_t)MROWS * (512 + 512 + 32) * 2);
constexpr size_t OFF_R6 = al256(OFF_R5 + (size_t)MROWS * 512 * 2);
constexpr size_t WS_END = al256(OFF_R6 + (size_t)MROWS * 1024 * 2);
constexpr size_t OFF_Q = OFF_R2;
constexpr size_t OFF_YF = OFF_R2 + (size_t)MROWS * 768 * 2;
constexpr size_t OFF_SG = OFF_YF + (size_t)MROWS * 512 * 2;
constexpr size_t OFF_YB = OFF_R1;
constexpr size_t OFF_KN = OFF_R4;
constexpr size_t OFF_VT = OFF_R4 + (size_t)MROWS * 512 * 2;
constexpr size_t OFF_KR = OFF_VT + (size_t)MROWS * 512 * 2;
constexpr size_t OFF_RWO = OFF_R4;
constexpr size_t OFF_MRG = OFF_R3;
constexpr size_t OFF_HF = OFF_R2;
static_assert(OFF_SG + (size_t)MROWS * 128 * 2 <= OFF_R3, "R2 overlay overflow");
static_assert((size_t)MROWS * 2816 * 2 <= OFF_R4 - OFF_R2, "HF overflow");

struct Params {
    const float *x, *c, *ctx, *c_ctx, *mod_w, *mod_b, *w_in, *q_norm, *w_uq, *kv_norm, *w_ukv, *w_o_attn,
        *conv_w, *w_o_conv, *rw_mu, *rw_w0, *rw_w_up, *rw_a0, *rw_a_up, *rw_g_up, *rw_k_k, *rw_k_a,
        *rw_r_k, *rw_gn_g, *rw_gn_b, *w_o_rwkv, *w_out, *ln1_g, *ln1_b, *ffn_w13, *ffn_w2, *ln2_g, *ln2_b;
    float* out;
    unsigned char* ws;
};

typedef __attribute__((address_space(1))) unsigned char gchar_t;
typedef __attribute__((address_space(1))) float gfloat_t;
__device__ __forceinline__ Params launder(const Params& a) {
    Params q = a;
    unsigned long long w = (unsigned long long)a.ws, o = (unsigned long long)a.out;
    unsigned wl = __builtin_amdgcn_readfirstlane((unsigned)w), wh = __builtin_amdgcn_readfirstlane((unsigned)(w >> 32));
    unsigned ol = __builtin_amdgcn_readfirstlane((unsigned)o), oh = __builtin_amdgcn_readfirstlane((unsigned)(o >> 32));
    asm volatile("" : "+s"(wl), "+s"(wh), "+s"(ol), "+s"(oh));
    w = ((unsigned long long)wh << 32) | wl; o = ((unsigned long long)oh << 32) | ol;
    q.ws = (unsigned char*)(gchar_t*)w; q.out = (float*)(gfloat_t*)o;
    return q;
}
__device__ __forceinline__ int launder_i(int v) { v = __builtin_amdgcn_readfirstlane(v); asm volatile("" : "+s"(v)); return v; }
__device__ __forceinline__ int ltid() { int t = threadIdx.x; asm volatile("" : "+v"(t)); return t; }
__device__ __forceinline__ unsigned pk_bf16(float lo, float hi) { unsigned r; asm("v_cvt_pk_bf16_f32 %0, %1, %2" : "=v"(r) : "v"(lo), "v"(hi)); return r; }
__device__ __forceinline__ float bf_lo(unsigned u) { return __uint_as_float(u << 16); }
__device__ __forceinline__ float bf_hi(unsigned u) { return __uint_as_float(u & 0xffff0000u); }
__device__ __forceinline__ float bf1(bf16_t h) { return __uint_as_float(((unsigned)h) << 16); }
__device__ __forceinline__ float x32sum(float x) { unsigned u = __float_as_uint(x); auto r = __builtin_amdgcn_permlane32_swap(u, u, false, false); return __uint_as_float(r[0]) + __uint_as_float(r[1]); }
__device__ __forceinline__ float x16sum(float x) { unsigned u = __float_as_uint(x); auto r = __builtin_amdgcn_permlane16_swap(u, u, false, false); return __uint_as_float(r[0]) + __uint_as_float(r[1]); }
__device__ __forceinline__ float x32max(float x) { unsigned u = __float_as_uint(x); auto r = __builtin_amdgcn_permlane32_swap(u, u, false, false); return fmaxf(__uint_as_float(r[0]), __uint_as_float(r[1])); }
__device__ __forceinline__ float x16max(float x) { unsigned u = __float_as_uint(x); auto r = __builtin_amdgcn_permlane16_swap(u, u, false, false); return fmaxf(__uint_as_float(r[0]), __uint_as_float(r[1])); }
__device__ __forceinline__ float fqsum(float x) { return x16sum(x32sum(x)); }
__device__ __forceinline__ float fqmax(float x) { return x16max(x32max(x)); }

template <int CTRL> __device__ __forceinline__ float dpp_add(float x) { return x + __uint_as_float((unsigned)__builtin_amdgcn_update_dpp(0, (int)__float_as_uint(x), CTRL, 0xf, 0xf, true)); }
__device__ __forceinline__ float red8(float x) { x = dpp_add<0xB1>(x); x = dpp_add<0x4E>(x); x = dpp_add<0x141>(x); return x; }
__device__ __forceinline__ float xor32_get(float x, int lane) { const unsigned u = __float_as_uint(x); auto r = __builtin_amdgcn_permlane32_swap(u, u, false, false); return __uint_as_float(lane < 32 ? r[1] : r[0]); }
__device__ __forceinline__ float xor8_get(float x) { return __uint_as_float((unsigned)__builtin_amdgcn_update_dpp(0, (int)__float_as_uint(x), 0x128, 0xf, 0xf, true)); }
__device__ __forceinline__ float wave_sum(float v) { v = dpp_add<0xB1>(v); v = dpp_add<0x4E>(v); v = dpp_add<0x141>(v); v = dpp_add<0x140>(v); return fqsum(v); }
__device__ __forceinline__ uint4 widen16(uint2 a, uint2 b) {
    auto r0 = __builtin_amdgcn_permlane16_swap(a.x, b.x, false, false);
    auto r1 = __builtin_amdgcn_permlane16_swap(a.y, b.y, false, false);
    return make_uint4(r0[0], r1[0], r0[1], r1[1]);
}
__device__ __forceinline__ float fexp(float x) { return __builtin_amdgcn_exp2f(x * 1.4426950408889634f); }
__device__ __forceinline__ float sigmoidf_(float x) { return __builtin_amdgcn_rcpf(1.0f + fexp(-x)); }
__device__ __forceinline__ float siluf_(float x) { return x * __builtin_amdgcn_rcpf(1.0f + fexp(-x)); }

__device__ __forceinline__ const float* x_rd(const Params& p, bool from_input, int b, int pp) {
    if (pp < CTXL) return (from_input ? p.ctx : (const float*)(p.ws + OFF_XC)) + ((size_t)b * CTXL + pp) * DM;
    return (from_input ? p.x : (const float*)p.out) + ((size_t)b * SEQ + (pp - CTXL)) * DM;
}
__device__ __forceinline__ float* x_wr(const Params& p, int b, int pp) {
    if (pp < CTXL) return (float*)(p.ws + OFF_XC) + ((size_t)b * CTXL + pp) * DM;
    return p.out + ((size_t)b * SEQ + (pp - CTXL)) * DM;
}
__device__ __forceinline__ const float* modv_ptr(const Params& p, int l, int b, int pp) {
    const int mr = pp < CTXL ? 16 : b;
    return (const float*)(p.ws + OFF_MODV) + ((size_t)l * 17 + mr) * 6144;
}

__device__ __forceinline__ void grid_barrier(unsigned* bar, unsigned& epoch) {
    asm volatile("s_waitcnt vmcnt(0) lgkmcnt(0)" ::: "memory");
    __syncthreads();
    epoch += 1;
    if (threadIdx.x == 0) {
        __builtin_amdgcn_fence(__ATOMIC_RELEASE, "agent");
        asm volatile("s_waitcnt vmcnt(0)" ::: "memory");
        const unsigned old = __hip_atomic_fetch_add(bar, 1u, __ATOMIC_RELAXED, __HIP_MEMORY_SCOPE_AGENT);
        if (old + 1u == epoch * gridDim.x) {
            __hip_atomic_store(bar + 64, epoch, __ATOMIC_RELAXED, __HIP_MEMORY_SCOPE_AGENT);
        } else {
            while (__hip_atomic_load(bar + 64, __ATOMIC_RELAXED, __HIP_MEMORY_SCOPE_AGENT) < epoch) __builtin_amdgcn_s_sleep(1);
        }
        __builtin_amdgcn_fence(__ATOMIC_ACQUIRE, "agent");
        asm volatile("s_waitcnt vmcnt(0)" ::: "memory");
    }
    __syncthreads();
}

#define LDS_AS __attribute__((address_space(3)))
#define GLB_AS __attribute__((address_space(1)))
template <int MT, int SWAPMODE>
__device__ __forceinline__ void gemm_mainloop(f32x4 (&acc)[MT][4], const bf16_t* __restrict__ A, int lda, int a_kstep,
                                              const bf16_t* __restrict__ Bt, int ldb, int nk, unsigned char* lds, int tid) {
    constexpr int BMr = 64 * MT;
    constexpr int STAGE = (BMr + 128) * 128;
    const int wid = __builtin_amdgcn_readfirstlane(tid >> 6), lane = tid & 63, wr = wid >> 1, wc = wid & 1, fr = lane & 15, fq = lane >> 4;
    const int lrow = 8 * wid + (lane >> 3);
    const int lch = (lane & 7) ^ ((4 * wid + (lane >> 4)) & 7);
    const bf16_t* ap = A + (size_t)lrow * lda + lch * 8;
    const bf16_t* bp = Bt + (size_t)lrow * ldb + lch * 8;
    auto issue = [&](int kt, int st) {
        unsigned char* base = lds + st * STAGE + wid * 1024;
#pragma unroll
        for (int i = 0; i < MT; ++i)
            __builtin_amdgcn_global_load_lds((const GLB_AS unsigned*)(ap + (size_t)i * 64 * lda + (size_t)kt * a_kstep), (LDS_AS unsigned*)(base + i * 8192), 16, 0, 0);
#pragma unroll
        for (int i = 0; i < 2; ++i)
            __builtin_amdgcn_global_load_lds((const GLB_AS unsigned*)(bp + (size_t)i * 64 * ldb + (size_t)kt * 64), (LDS_AS unsigned*)(base + (BMr + i * 64) * 128), 16, 0, 0);
    };
    const bool sw = (SWAPMODE == 1) || (SWAPMODE == 2 && wc == 0);
    const int sz = fr >> 1;
    constexpr int NL = MT + 2;
    const bool late = wid >= 4;
    issue(0, 0);
    if (nk > 1) { issue(1, 1); asm volatile("s_waitcnt vmcnt(%0)" ::"n"(NL) : "memory"); }
    else asm volatile("s_waitcnt vmcnt(0)" ::: "memory");
    __builtin_amdgcn_s_barrier();
    asm volatile("" ::: "memory");
    int st = 0;
    for (int kt = 0; kt < nk; ++kt) {
        const int st2 = st >= 1 ? st - 1 : 2;
        if (!late && kt + 2 < nk) issue(kt + 2, st2);
        const unsigned char* As = lds + st * STAGE;
        const unsigned char* Bs = As + BMr * 128;
#pragma unroll
        for (int ks = 0; ks < 2; ++ks) {
            bf16x8 af[MT], bfr[4];
            const int co = ((ks * 4 + fq) ^ sz) * 16;
#pragma unroll
            for (int m = 0; m < MT; ++m) af[m] = *(const bf16x8*)(As + (wr * 16 * MT + m * 16 + fr) * 128 + co);
#pragma unroll
            for (int n = 0; n < 4; ++n) bfr[n] = *(const bf16x8*)(Bs + (wc * 64 + n * 16 + fr) * 128 + co);
            if (sw) {
#pragma unroll
                for (int m = 0; m < MT; ++m)
#pragma unroll
                    for (int n = 0; n < 4; ++n) acc[m][n] = __builtin_amdgcn_mfma_f32_16x16x32_bf16(bfr[n], af[m], acc[m][n], 0, 0, 0);
            } else {
#pragma unroll
                for (int m = 0; m < MT; ++m)
#pragma unroll
                    for (int n = 0; n < 4; ++n) acc[m][n] = __builtin_amdgcn_mfma_f32_16x16x32_bf16(af[m], bfr[n], acc[m][n], 0, 0, 0);
            }
        }
        if (late && kt + 2 < nk) issue(kt + 2, st2);
        if (kt + 2 < nk) asm volatile("s_waitcnt vmcnt(%0) lgkmcnt(0)" ::"n"(NL) : "memory");
        else asm volatile("s_waitcnt vmcnt(0) lgkmcnt(0)" ::: "memory");
        __builtin_amdgcn_s_barrier();
        asm volatile("" ::: "memory");
        st = st == 2 ? 0 : st + 1;
    }
}
__device__ __forceinline__ void gemm_mainloop256(f32x4 (&acc)[8][4], const bf16_t* __restrict__ A, int lda,
                                                 const bf16_t* __restrict__ Bt, int ldb, int nk, unsigned char* lds, int tid) {
    constexpr int STAGE = 512 * 128;
    const int wid = __builtin_amdgcn_readfirstlane(tid >> 6), lane = tid & 63, wr = wid >> 2, wc = wid & 3, fr = lane & 15, fq = lane >> 4;
    const int lrow = 8 * wid + (lane >> 3);
    const int lch = (lane & 7) ^ ((4 * wid + (lane >> 4)) & 7);
    const bf16_t* ap = A + (size_t)lrow * lda + lch * 8;
    const bf16_t* bp = Bt + (size_t)lrow * ldb + lch * 8;
    auto issue = [&](int kt, int st) {
        unsigned char* base = lds + st * STAGE + wid * 1024;
#pragma unroll
        for (int i = 0; i < 4; ++i)
            __builtin_amdgcn_global_load_lds((const GLB_AS unsigned*)(ap + (size_t)i * 64 * lda + (size_t)kt * 64), (LDS_AS unsigned*)(base + i * 8192), 16, 0, 0);
#pragma unroll
        for (int i = 0; i < 4; ++i)
            __builtin_amdgcn_global_load_lds((const GLB_AS unsigned*)(bp + (size_t)i * 64 * ldb + (size_t)kt * 64), (LDS_AS unsigned*)(base + (256 + i * 64) * 128), 16, 0, 0);
    };
    const int sz = fr >> 1;
    const bool late = wid >= 4;
    issue(0, 0);
    asm volatile("s_waitcnt vmcnt(0)" ::: "memory");
    __builtin_amdgcn_s_barrier();
    asm volatile("" ::: "memory");
    for (int kt = 0; kt < nk; ++kt) {
        if (!late && kt + 1 < nk) issue(kt + 1, (kt + 1) & 1);
        const unsigned char* As = lds + (kt & 1) * STAGE;
        const unsigned char* Bs = As + 256 * 128;
#pragma unroll
        for (int ks = 0; ks < 2; ++ks) {
            if (ks == 1 && late && kt + 1 < nk) issue(kt + 1, (kt + 1) & 1);
            bf16x8 af[8], bfr[4];
            const int co = ((ks * 4 + fq) ^ sz) * 16;
#pragma unroll
            for (int m = 0; m < 8; ++m) af[m] = *(const bf16x8*)(As + (wr * 128 + m * 16 + fr) * 128 + co);
#pragma unroll
            for (int n = 0; n < 4; ++n) bfr[n] = *(const bf16x8*)(Bs + (wc * 64 + n * 16 + fr) * 128 + co);
#pragma unroll
            for (int m = 0; m < 8; ++m)
#pragma unroll
                for (int n = 0; n < 4; ++n) acc[m][n] = __builtin_amdgcn_mfma_f32_16x16x32_bf16(bfr[n], af[m], acc[m][n], 0, 0, 0);
        }
        asm volatile("s_waitcnt vmcnt(0) lgkmcnt(0)" ::: "memory");
        __builtin_amdgcn_s_barrier();
        asm volatile("" ::: "memory");
    }
}
struct Seg { const bf16_t* A; const bf16_t* Bt; int lda, a_kstep, ldb, nk; };
template <int MT, int SWAPMODE>
__device__ __forceinline__ void gemm_stream(f32x4 (&acc)[MT][4], const Seg& cur, const Seg& nxt, bool has_next, bool first, int& st,
                                            unsigned char* lds, int tid) {
    constexpr int BMr = 64 * MT;
    constexpr int STAGE = (BMr + 128) * 128;
    constexpr int NL = MT + 2;
    const int wid = __builtin_amdgcn_readfirstlane(tid >> 6), lane = tid & 63, wr = wid >> 1, wc = wid & 1, fr = lane & 15, fq = lane >> 4;
    const int lrow = 8 * wid + (lane >> 3);
    const int lch = (lane & 7) ^ ((4 * wid + (lane >> 4)) & 7);
    const bf16_t* apc = cur.A + (size_t)lrow * cur.lda + lch * 8;
    const bf16_t* bpc = cur.Bt + (size_t)lrow * cur.ldb + lch * 8;
    const bf16_t* apn = nxt.A + (size_t)lrow * nxt.lda + lch * 8;
    const bf16_t* bpn = nxt.Bt + (size_t)lrow * nxt.ldb + lch * 8;
    auto issue = [&](const bf16_t* ap, const bf16_t* bp, int lda, int ldb, int koffa, int koffb, int slot) {
        unsigned char* base = lds + slot * STAGE + wid * 1024;
#pragma unroll
        for (int i = 0; i < MT; ++i)
            __builtin_amdgcn_global_load_lds((const GLB_AS unsigned*)(ap + (size_t)i * 64 * lda + koffa), (LDS_AS unsigned*)(base + i * 8192), 16, 0, 0);
#pragma unroll
        for (int i = 0; i < 2; ++i)
            __builtin_amdgcn_global_load_lds((const GLB_AS unsigned*)(bp + (size_t)i * 64 * ldb + koffb), (LDS_AS unsigned*)(base + (BMr + i * 64) * 128), 16, 0, 0);
    };
    const bool sw = (SWAPMODE == 1) || (SWAPMODE == 2 && wc == 0);
    const int sz = fr >> 1;
    const bool late = wid >= 4;
    const int nk = cur.nk;
    int s0 = st;
    if (first) {
        const int s1 = s0 == 2 ? 0 : s0 + 1;
        issue(apc, bpc, cur.lda, cur.ldb, 0, 0, s0);
        issue(apc, bpc, cur.lda, cur.ldb, cur.a_kstep, 64, s1);
        asm volatile("s_waitcnt vmcnt(%0)" ::"n"(NL) : "memory");
        __builtin_amdgcn_s_barrier();
        asm volatile("" ::: "memory");
    }
    for (int kt = 0; kt < nk; ++kt) {
        const int s2 = s0 >= 1 ? s0 - 1 : 2;
        const int idx = kt + 2;
        const bool incur = idx < nk, doi = incur || has_next;
        if (!late && doi) { if (incur) issue(apc, bpc, cur.lda, cur.ldb, idx * cur.a_kstep, idx * 64, s2); else issue(apn, bpn, nxt.lda, nxt.ldb, (idx - nk) * nxt.a_kstep, (idx - nk) * 64, s2); }
        const unsigned char* As = lds + s0 * STAGE;
        const unsigned char* Bs = As + BMr * 128;
#pragma unroll
        for (int ks = 0; ks < 2; ++ks) {
            bf16x8 af[MT], bfr[4];
            const int co = ((ks * 4 + fq) ^ sz) * 16;
#pragma unroll
            for (int m = 0; m < MT; ++m) af[m] = *(const bf16x8*)(As + (wr * 16 * MT + m * 16 + fr) * 128 + co);
#pragma unroll
            for (int n = 0; n < 4; ++n) bfr[n] = *(const bf16x8*)(Bs + (wc * 64 + n * 16 + fr) * 128 + co);
            if (sw) {
#pragma unroll
                for (int m = 0; m < MT; ++m)
#pragma unroll
                    for (int n = 0; n < 4; ++n) acc[m][n] = __builtin_amdgcn_mfma_f32_16x16x32_bf16(bfr[n], af[m], acc[m][n], 0, 0, 0);
            } else {
#pragma unroll
                for (int m = 0; m < MT; ++m)
#pragma unroll
                    for (int n = 0; n < 4; ++n) acc[m][n] = __builtin_amdgcn_mfma_f32_16x16x32_bf16(af[m], bfr[n], acc[m][n], 0, 0, 0);
            }
        }
        if (late && doi) { if (incur) issue(apc, bpc, cur.lda, cur.ldb, idx * cur.a_kstep, idx * 64, s2); else issue(apn, bpn, nxt.lda, nxt.ldb, (idx - nk) * nxt.a_kstep, (idx - nk) * 64, s2); }
        if (doi) asm volatile("s_waitcnt vmcnt(%0) lgkmcnt(0)" ::"n"(NL) : "memory");
        else asm volatile("s_waitcnt vmcnt(0) lgkmcnt(0)" ::: "memory");
        __builtin_amdgcn_s_barrier();
        asm volatile("" ::: "memory");
        s0 = s0 == 2 ? 0 : s0 + 1;
    }
    st = s0;
}
__device__ __forceinline__ void gemm_stream256(f32x4 (&acc)[8][4], const Seg& cur, const Seg& nxt, bool has_next, bool first, int& st, unsigned char* lds, int tid) {
    constexpr int STAGE = 512 * 128;
    const int wid = __builtin_amdgcn_readfirstlane(tid >> 6), lane = tid & 63, wr = wid >> 2, wc = wid & 3, fr = lane & 15, fq = lane >> 4;
    const int lrow = 8 * wid + (lane >> 3);
    const int lch = (lane & 7) ^ ((4 * wid + (lane >> 4)) & 7);
    const bf16_t* apc = cur.A + (size_t)lrow * cur.lda + lch * 8;
    const bf16_t* bpc = cur.Bt + (size_t)lrow * cur.ldb + lch * 8;
    const bf16_t* apn = nxt.A + (size_t)lrow * nxt.lda + lch * 8;
    const bf16_t* bpn = nxt.Bt + (size_t)lrow * nxt.ldb + lch * 8;
    auto issue = [&](const bf16_t* ap, const bf16_t* bp, int lda, int ldb, int koff, int slot) {
        unsigned char* base = lds + slot * STAGE + wid * 1024;
#pragma unroll
        for (int i = 0; i < 4; ++i)
            __builtin_amdgcn_global_load_lds((const GLB_AS unsigned*)(ap + (size_t)i * 64 * lda + koff), (LDS_AS unsigned*)(base + i * 8192), 16, 0, 0);
#pragma unroll
        for (int i = 0; i < 4; ++i)
            __builtin_amdgcn_global_load_lds((const GLB_AS unsigned*)(bp + (size_t)i * 64 * ldb + koff), (LDS_AS unsigned*)(base + (256 + i * 64) * 128), 16, 0, 0);
    };
    const int sz = fr >> 1;
    const bool late = wid >= 4;
    const int nk = cur.nk;
    int s0 = st;
    if (first) {
        issue(apc, bpc, cur.lda, cur.ldb, 0, s0);
        asm volatile("s_waitcnt vmcnt(0)" ::: "memory");
        __builtin_amdgcn_s_barrier();
        asm volatile("" ::: "memory");
    }
    for (int kt = 0; kt < nk; ++kt) {
        const int idx = kt + 1;
        const bool incur = idx < nk, doi = incur || has_next;
        if (!late && doi) { if (incur) issue(apc, bpc, cur.lda, cur.ldb, idx * 64, s0 ^ 1); else issue(apn, bpn, nxt.lda, nxt.ldb, 0, s0 ^ 1); }
        const unsigned char* As = lds + s0 * STAGE;
        const unsigned char* Bs = As + 256 * 128;
#pragma unroll
        for (int ks = 0; ks < 2; ++ks) {
            if (ks == 1 && late && doi) { if (incur) issue(apc, bpc, cur.lda, cur.ldb, idx * 64, s0 ^ 1); else issue(apn, bpn, nxt.lda, nxt.ldb, 0, s0 ^ 1); }
            bf16x8 af[8], bfr[4];
            const int co = ((ks * 4 + fq) ^ sz) * 16;
#pragma unroll
            for (int m = 0; m < 8; ++m) af[m] = *(const bf16x8*)(As + (wr * 128 + m * 16 + fr) * 128 + co);
#pragma unroll
            for (int n = 0; n < 4; ++n) bfr[n] = *(const bf16x8*)(Bs + (wc * 64 + n * 16 + fr) * 128 + co);
#pragma unroll
            for (int m = 0; m < 8; ++m)
#pragma unroll
                for (int n = 0; n < 4; ++n) acc[m][n] = __builtin_amdgcn_mfma_f32_16x16x32_bf16(bfr[n], af[m], acc[m][n], 0, 0, 0);
        }
        asm volatile("s_waitcnt vmcnt(0) lgkmcnt(0)" ::: "memory");
        __builtin_amdgcn_s_barrier();
        asm volatile("" ::: "memory");
        s0 ^= 1;
    }
    st = s0;
}
__device__ __forceinline__ void gemm_gate3(f32x4 (&g)[3][2][4], const bf16_t* __restrict__ A, const bf16_t* __restrict__ Bt0, int nk, unsigned char* lds, int tid) {
    constexpr int STAGE = 512 * 128;
    const int wid = __builtin_amdgcn_readfirstlane(tid >> 6), lane = tid & 63, wr = wid >> 1, wc = wid & 1, fr = lane & 15, fq = lane >> 4;
    const int lrow = 8 * wid + (lane >> 3);
    const int lch = (lane & 7) ^ ((4 * wid + (lane >> 4)) & 7);
    const unsigned loff = (unsigned)(lrow * 1024 + lch * 8);
    auto issue = [&](int kt, int stg) {
        unsigned char* base = lds + stg * STAGE + wid * 1024;
#pragma unroll
        for (int i = 0; i < 2; ++i)
            __builtin_amdgcn_global_load_lds((const GLB_AS unsigned*)((A + (size_t)i * 64 * 1024 + (size_t)kt * 64) + loff), (LDS_AS unsigned*)(base + i * 8192), 16, 0, 0);
#pragma unroll
        for (int j = 0; j < 6; ++j)
            __builtin_amdgcn_global_load_lds((const GLB_AS unsigned*)((Bt0 + ((size_t)(j >> 1) * 1024 + (j & 1) * 64) * 1024 + (size_t)kt * 64) + loff), (LDS_AS unsigned*)(base + (128 + j * 64) * 128), 16, 0, 0);
    };
    const int sz = fr >> 1;
    const bool late = wid >= 4;
    issue(0, 0);
    asm volatile("s_waitcnt vmcnt(0)" ::: "memory");
    __builtin_amdgcn_s_barrier();
    asm volatile("" ::: "memory");
    for (int kt = 0; kt < nk; ++kt) {
        if (!late && kt + 1 < nk) issue(kt + 1, (kt + 1) & 1);
        const unsigned char* As = lds + (kt & 1) * STAGE;
        const unsigned char* Bs = As + 128 * 128;
#pragma unroll
        for (int ks = 0; ks < 2; ++ks) {
            if (ks == 1 && late && kt + 1 < nk) issue(kt + 1, (kt + 1) & 1);
            const int co = ((ks * 4 + fq) ^ sz) * 16;
            bf16x8 af[2];
#pragma unroll
            for (int m = 0; m < 2; ++m) af[m] = *(const bf16x8*)(As + (wr * 32 + m * 16 + fr) * 128 + co);
#pragma unroll
            for (int i = 0; i < 3; ++i) {
                bf16x8 bfr[4];
#pragma unroll
                for (int n = 0; n < 4; ++n) bfr[n] = *(const bf16x8*)(Bs + (i * 128 + wc * 64 + n * 16 + fr) * 128 + co);
#pragma unroll
                for (int m = 0; m < 2; ++m)
#pragma unroll
                    for (int n = 0; n < 4; ++n) g[i][m][n] = __builtin_amdgcn_mfma_f32_16x16x32_bf16(bfr[n], af[m], g[i][m][n], 0, 0, 0);
                if (i < 2) __builtin_amdgcn_sched_barrier(0);
            }
        }
        asm volatile("s_waitcnt vmcnt(0) lgkmcnt(0)" ::: "memory");
        __builtin_amdgcn_s_barrier();
        asm volatile("" ::: "memory");
    }
}
template <int MT> __device__ __forceinline__ void zero_acc(f32x4 (&acc)[MT][4]) {
#pragma unroll
    for (int m = 0; m < MT; ++m)
#pragma unroll
        for (int n = 0; n < 4; ++n) acc[m][n] = (f32x4){0.f, 0.f, 0.f, 0.f};
}
__device__ __forceinline__ void tile_mn(int t, int nN, int& mt, int& nt) { const int per = 16 * nN, g = t / per, w = t % per; mt = g * 16 + (w & 15); nt = w >> 4; }

__device__ __forceinline__ int rowmap(int mode, int n) {
    if (mode == 1) return n < 672 ? n : n + 96;
    if (mode == 2) return n < DFF ? ((n >> 5) * 64 + (n & 31)) : (((n - DFF) >> 5) * 64 + 32 + ((n - DFF) & 31));
    return n;
}
__device__ __forceinline__ void convert_T(const float* __restrict__ src, int K, int N, bf16_t* __restrict__ dst, int mode, const float* __restrict__ ks, unsigned char* lds, int rot) {
    float* tile = (float*)lds;
    const int ntk = K / 64, ntn = (N + 63) / 64, tid = ltid();
    const int start = (blockIdx.x + gridDim.x - (rot % gridDim.x)) % gridDim.x;
    for (int t = start; t < ntk * ntn; t += gridDim.x) {
        const int tk = t % ntk, tn = t / ntk, k0 = tk * 64, n0 = tn * 64;
#pragma unroll
        for (int i = 0; i < 8; ++i) {
            const int kl = (tid >> 6) + 8 * i, nl = tid & 63, n = n0 + nl;
            tile[kl * 65 + nl] = n < N ? src[(size_t)(k0 + kl) * N + n] : 0.f;
        }
        __syncthreads();
        const int kp = (tid & 31) * 2;
        float s0 = 1.f, s1 = 1.f;
        if (ks) { s0 = ks[k0 + kp]; s1 = ks[k0 + kp + 1]; }
#pragma unroll
        for (int i = 0; i < 4; ++i) {
            const int nl = (tid >> 5) + 16 * i, n = n0 + nl;
            if (n < N) *(unsigned*)(dst + (size_t)rowmap(mode, n) * K + k0 + kp) = pk_bf16(tile[kp * 65 + nl] * s0, tile[(kp + 1) * 65 + nl] * s1);
        }
        __syncthreads();
    }
}
__device__ __forceinline__ void convert_layer(const Params& pin, int l, unsigned char* lds) {
    const Params p = launder(pin); l = launder_i(l);
    bf16_t* W = (bf16_t*)(p.ws + OFF_W);
    convert_T(p.w_in + (size_t)l * DM * DIN, DM, DIN, W + WO_IN, 1, nullptr, lds, 0);
    convert_T(p.ffn_w13 + (size_t)l * DM * 2 * DFF, DM, 2 * DFF, W + WO_13, 2, nullptr, lds, 40);
    convert_T(p.ffn_w2 + (size_t)l * DFF * DM, DFF, DM, W + WO_2, 0, nullptr, lds, 80);
    convert_T(p.w_out + (size_t)l * DM * DM, DM, DM, W + WO_OUT, 0, nullptr, lds, 120);
    convert_T(p.w_o_attn + (size_t)l * 512 * DM, 512, DM, W + WO_OA, 0, nullptr, lds, 136);
    convert_T(p.w_o_conv + (size_t)l * 512 * DM, 512, DM, W + WO_OC, 0, nullptr, lds, 8);
    convert_T(p.w_o_rwkv + (size_t)l * 512 * DM, 512, DM, W + WO_OR, 0, nullptr, lds, 136 + 8);
    convert_T(p.w_uq + (size_t)l * 384 * 768, 384, 768, W + WO_UQ, 0, p.q_norm + l * 384, lds, 16);
    convert_T(p.w_ukv + (size_t)l * 256 * 1024, 256, 1024, W + WO_UKV, 0, p.kv_norm + l * 256, lds, 88);
    for (int z = 0; z < 2; ++z) {
        convert_T(p.rw_w_up + ((size_t)l * 2 + z) * 64 * 512, 64, 512, W + WO_UP + (size_t)z * 512 * 64, 0, nullptr, lds, 152 + 8 * z);
        convert_T(p.rw_a_up + ((size_t)l * 2 + z) * 64 * 512, 64, 512, W + WO_AUP + (size_t)z * 512 * 64, 0, nullptr, lds, 168 + 8 * z);
    }
    convert_T(p.rw_g_up + (size_t)l * 128 * 512, 128, 512, W + WO_GUP, 0, nullptr, lds, 184);
}

__device__ __forceinline__ void modv_phase(const Params& pin, unsigned char* lds) {
    const Params p = launder(pin);
    float* s = (float*)lds;
    float* red = s + 17 * 1024;
    const int tid = ltid(), wid = tid >> 6, lane = tid & 63;
    for (int i = tid; i < 17 * 1024; i += NTHREADS) { const int r = i >> 10, k = i & 1023; const float v = r < 16 ? p.c[r * 1024 + k] : p.c_ctx[k]; s[i] = siluf_(v); }
    __syncthreads();
    float* modv = (float*)(p.ws + OFF_MODV);
    for (int g = blockIdx.x; g < 4 * 96; g += gridDim.x) {
        const int l = g / 96, n = (g % 96) * 64 + lane;
        const float* w = p.mod_w + (size_t)l * 1024 * 6144 + n;
        float acc[17];
#pragma unroll
        for (int r = 0; r < 17; ++r) acc[r] = 0.f;
        const int kb = wid * 128;
        for (int k = kb; k < kb + 128; k += 4) {
            const float w0 = w[(size_t)k * 6144], w1 = w[(size_t)(k + 1) * 6144], w2 = w[(size_t)(k + 2) * 6144], w3 = w[(size_t)(k + 3) * 6144];
#pragma unroll
            for (int r = 0; r < 17; ++r) { const f32x4 sv = *(const f32x4*)(s + r * 1024 + k); acc[r] += sv[0] * w0 + sv[1] * w1 + sv[2] * w2 + sv[3] * w3; }
        }
#pragma unroll
        for (int r = 0; r < 17; ++r) red[(wid * 17 + r) * 64 + lane] = acc[r];
        __syncthreads();
        for (int i = tid; i < 17 * 64; i += NTHREADS) {
            const int r = i >> 6, c = i & 63; float v = 0.f;
#pragma unroll
            for (int w8 = 0; w8 < 8; ++w8) v += red[(w8 * 17 + r) * 64 + c];
            const int nn = (g % 96) * 64 + c;
            modv[((size_t)l * 17 + r) * 6144 + nn] = v + p.mod_b[l * 6144 + nn];
        }
        __syncthreads();
    }
    if (blockIdx.x == gridDim.x - 1) {
        float* rope = (float*)(p.ws + OFF_ROPE);
        for (int i = tid; i < 512; i += NTHREADS) {
            const int pos = i >> 3, f = i & 7;
            const float inv = exp2f(-(float)f * (13.287712379549449f / 8.0f));
            const float ang = (float)pos * inv;
            rope[i * 2] = cosf(ang); rope[i * 2 + 1] = sinf(ang);
        }
    }
}

__device__ __forceinline__ void xmod0_phase(const Params& pin) {
    const Params p = launder(pin);
    const int tid = ltid(), wid = tid >> 6, lane = tid & 63;
    bf16_t* xm = (bf16_t*)(p.ws + OFF_R6);
    for (int row = blockIdx.x * 8 + wid; row < MROWS; row += gridDim.x * 8) {
        const int b = row / TPB, pp = row % TPB;
        const float* xp = x_rd(p, true, b, pp);
        const float* mv = modv_ptr(p, 0, b, pp);
#pragma unroll
        for (int i = 0; i < 4; ++i) {
            const int c = i * 256 + lane * 4;
            const f32x4 v = *(const f32x4*)(xp + c), sh = *(const f32x4*)(mv + c), sc = *(const f32x4*)(mv + 1024 + c);
            uint2 o; o.x = pk_bf16(v[0] * (1.f + sc[0]) + sh[0], v[1] * (1.f + sc[1]) + sh[1]); o.y = pk_bf16(v[2] * (1.f + sc[2]) + sh[2], v[3] * (1.f + sc[3]) + sh[3]);
            *(uint2*)(xm + (size_t)row * 1024 + c) = o;
        }
    }
}

__device__ __forceinline__ void p1_phase(const Params& pin, unsigned char* lds) {
    const Params p = launder(pin); const int tid = ltid();
    const bf16_t* A = (const bf16_t*)(p.ws + OFF_R6);
    const bf16_t* W = (const bf16_t*)(p.ws + OFF_W) + WO_IN;
    const int lane = tid & 63, wid = tid >> 6, wr = wid >> 2, wc = wid & 3, fr = lane & 15, fq = lane >> 4;
    auto seg = [&](int t) { int mt, nt; tile_mn(t, 17, mt, nt); Seg g; g.A = A + (size_t)mt * 256 * 1024; g.Bt = W + (size_t)nt * 256 * 1024; g.lda = 1024; g.a_kstep = 64; g.ldb = 1024; g.nk = 16; return g; };
    int st = 0; bool first = true;
    for (int t = blockIdx.x; t < 144 * 17; t += gridDim.x) {
        int mt, nt; tile_mn(t, 17, mt, nt);
        const int tn = t + gridDim.x; const bool hn = tn < 144 * 17;
        f32x4 acc[8][4]; zero_acc<8>(acc);
        gemm_stream256(acc, seg(t), seg(hn ? tn : t), hn, first, st, lds, tid); first = false;
        bf16_t* dst; int ld, cb, lim;
        if (nt < 3) { dst = (bf16_t*)(p.ws + OFF_R1); ld = 672; cb = nt * 256; lim = 672; }
        else if (nt < 9) { dst = (bf16_t*)(p.ws + OFF_R2); ld = 1536; cb = (nt - 3) * 256; lim = 1536; }
        else { dst = (bf16_t*)(p.ws + OFF_R3); ld = 1920; cb = (nt - 9) * 256; lim = 1920; }
#pragma unroll
        for (int m = 0; m < 8; ++m) {
            const size_t row = (size_t)mt * 256 + wr * 128 + m * 16 + fr;
#pragma unroll
            for (int n = 0; n < 4; n += 2) {
                uint2 a, b2;
                a.x = pk_bf16(acc[m][n][0], acc[m][n][1]); a.y = pk_bf16(acc[m][n][2], acc[m][n][3]);
                b2.x = pk_bf16(acc[m][n + 1][0], acc[m][n + 1][1]); b2.y = pk_bf16(acc[m][n + 1][2], acc[m][n + 1][3]);
                const uint4 w = widen16(a, b2);
                const int col = cb + wc * 64 + (n + (fq & 1)) * 16 + (fq >> 1) * 8;
                if (col < lim) *(uint4*)(dst + row * ld + col) = w;
            }
        }
    }
}

__device__ __forceinline__ void unpack8(const uint4 u, float (&f)[8]) {
    f[0] = bf_lo(u.x); f[1] = bf_hi(u.x); f[2] = bf_lo(u.y); f[3] = bf_hi(u.y); f[4] = bf_lo(u.z); f[5] = bf_hi(u.z); f[6] = bf_lo(u.w); f[7] = bf_hi(u.w);
}
__device__ __forceinline__ void p2a_phase(const Params& pin, int l) {
    const Params p = launder(pin); l = launder_i(l);
    const int tid = ltid(), wid = tid >> 6, lane = tid & 63;
    const bf16_t* Hm = (const bf16_t*)(p.ws + OFF_R1);
    const bf16_t* Hc = (const bf16_t*)(p.ws + OFF_R2);
    bf16_t* CV = (bf16_t*)(p.ws + OFF_R5);
    bf16_t* KR = (bf16_t*)(p.ws + OFF_KR);
    float* RSQ = (float*)(p.ws + OFF_RSQ);
    float* RSKV = (float*)(p.ws + OFF_RSKV);
    const float* rope = (const float*)(p.ws + OFF_ROPE);
    const float* cw = p.conv_w + (size_t)l * 3 * 512;
    const int c0 = lane * 8;
    float w0[8], w1[8], w2[8];
#pragma unroll
    for (int i = 0; i < 8; ++i) { w0[i] = cw[c0 + i]; w1[i] = cw[512 + c0 + i]; w2[i] = cw[1024 + c0 + i]; }
    for (int row = blockIdx.x * 8 + wid; row < MROWS; row += gridDim.x * 8) {
        const int pp = row % TPB;
        const bool hp = (pp != 0 && pp != CTXL), hn = (pp != CTXL - 1 && pp != TPB - 1);
        const bf16_t* hr = Hc + (size_t)row * 1536;
        float ch[8], cc[8], cb[8], u0[8], u1[8], u2[8];
        unpack8(*(const uint4*)(hr + c0), ch); unpack8(*(const uint4*)(hr + 1024 + c0), cc); unpack8(*(const uint4*)(hr + 512 + c0), cb);
#pragma unroll
        for (int i = 0; i < 8; ++i) u1[i] = cc[i] * ch[i];
        if (hp) { unpack8(*(const uint4*)(hr - 1536 + c0), ch); unpack8(*(const uint4*)(hr - 1536 + 1024 + c0), cc);
#pragma unroll
            for (int i = 0; i < 8; ++i) u0[i] = cc[i] * ch[i]; }
        else {
#pragma unroll
            for (int i = 0; i < 8; ++i) u0[i] = 0.f; }
        if (hn) { unpack8(*(const uint4*)(hr + 1536 + c0), ch); unpack8(*(const uint4*)(hr + 1536 + 1024 + c0), cc);
#pragma unroll
            for (int i = 0; i < 8; ++i) u2[i] = cc[i] * ch[i]; }
        else {
#pragma unroll
            for (int i = 0; i < 8; ++i) u2[i] = 0.f; }
        float o[8];
#pragma unroll
        for (int i = 0; i < 8; ++i) o[i] = cb[i] * (u0[i] * w0[i] + u1[i] * w1[i] + u2[i] * w2[i]);
        uint4 ov; ov.x = pk_bf16(o[0], o[1]); ov.y = pk_bf16(o[2], o[3]); ov.z = pk_bf16(o[4], o[5]); ov.w = pk_bf16(o[6], o[7]);
        *(uint4*)(CV + (size_t)row * 512 + c0) = ov;
        const bf16_t* hm = Hm + (size_t)row * 672;
        float sq = 0.f, skv = 0.f;
        if (lane < 48) { float f[8]; unpack8(*(const uint4*)(hm + lane * 8), f);
#pragma unroll
            for (int i = 0; i < 8; ++i) sq += f[i] * f[i]; }
        if (lane < 32) { float f[8]; unpack8(*(const uint4*)(hm + 384 + lane * 8), f);
#pragma unroll
            for (int i = 0; i < 8; ++i) skv += f[i] * f[i]; }
        sq = wave_sum(sq); skv = wave_sum(skv);
        if (lane == 0) { RSQ[row] = __builtin_amdgcn_rsqf(sq * (1.0f / 384.0f) + 1e-6f); RSKV[row] = __builtin_amdgcn_rsqf(skv * (1.0f / 256.0f) + 1e-6f); }
        {
            const int j = lane & 31;
            float v = bf1(hm[640 + j]);
            const float other = xor8_get(v);
            if (pp >= CTXL) {
                const int tt = pp - CTXL;
                const int pos = (j < 16) ? (tt >> 6) : (tt & 63);
                const float cs = rope[(pos * 8 + (j & 7)) * 2], sn = rope[(pos * 8 + (j & 7)) * 2 + 1];
                v = (j & 8) ? (other * sn + v * cs) : (v * cs - other * sn);
            }
            if (lane < 32) KR[(size_t)row * 32 + j] = (bf16_t)(pk_bf16(v, v) & 0xffffu);
        }
    }
}

__device__ __forceinline__ void p2b_phase(const Params& pin, int l, unsigned char* lds) {
    const Params p = launder(pin); l = launder_i(l); const int tid = ltid();
    const bf16_t* Hm = (const bf16_t*)(p.ws + OFF_R1);
    const bf16_t* W = (const bf16_t*)(p.ws + OFF_W);
    const float* RSQ = (const float*)(p.ws + OFF_RSQ);
    const float* RSKV = (const float*)(p.ws + OFF_RSKV);
    const float* rope = (const float*)(p.ws + OFF_ROPE);
    bf16_t* Q = (bf16_t*)(p.ws + OFF_Q);
    bf16_t* KN = (bf16_t*)(p.ws + OFF_KN);
    bf16_t* VT = (bf16_t*)(p.ws + OFF_VT);
    const int lane = tid & 63, wid = tid >> 6, wr = wid >> 1, wc = wid & 1, fr = lane & 15, fq = lane >> 4;
    const int NQ = 144 * 6, NKV = 144 * 8;
    for (int t = blockIdx.x; t < NQ + NKV; t += gridDim.x) {
        f32x4 acc[4][4]; zero_acc<4>(acc);
        if (t < NQ) {
            int mt, nt; tile_mn(t, 6, mt, nt);
            gemm_mainloop<4, 1>(acc, Hm + (size_t)mt * 256 * 672, 672, 64, W + WO_UQ + (size_t)nt * 128 * 384, 384, 6, lds, tid);
            const int pp0 = (mt % 9) * 256; const bool latent = pp0 >= CTXL;
#pragma unroll
            for (int m = 0; m < 4; ++m) {
                const int lrow = wr * 64 + m * 16 + fr;
                const size_t row = (size_t)mt * 256 + lrow;
                const float sc = RSQ[row] * QSCALE;
                const int tt = pp0 + lrow - CTXL;
                uint2 qpk[4];
#pragma unroll
                for (int n = 0; n < 4; ++n) {
                    const int c16 = nt * 128 + wc * 64 + n * 16, r96 = c16 % 96;
                    float v[4];
#pragma unroll
                    for (int j = 0; j < 4; ++j) v[j] = acc[m][n][j] * sc;
                    if (latent && r96 >= 64) {
                        const int pos = (r96 == 64) ? (tt >> 6) : (tt & 63);
#pragma unroll
                        for (int j = 0; j < 4; ++j) {
                            const float other = xor32_get(v[j], lane);
                            const int fi = (fq & 1) * 4 + j;
                            const float cs = rope[(pos * 8 + fi) * 2], sn = rope[(pos * 8 + fi) * 2 + 1];
                            v[j] = (fq & 2) ? (other * sn + v[j] * cs) : (v[j] * cs - other * sn);
                        }
                    }
                    qpk[n].x = pk_bf16(v[0], v[1]); qpk[n].y = pk_bf16(v[2], v[3]);
                }
#pragma unroll
                for (int n = 0; n < 4; n += 2)
                    *(uint4*)(Q + row * 768 + nt * 128 + wc * 64 + (n + (fq & 1)) * 16 + (fq >> 1) * 8) = widen16(qpk[n], qpk[n + 1]);
            }
        } else {
            int mt, nt; tile_mn(t - NQ, 8, mt, nt);
            gemm_mainloop<4, 2>(acc, Hm + (size_t)mt * 256 * 672 + 384, 672, 64, W + WO_UKV + (size_t)nt * 128 * 256, 256, 4, lds, tid);
            const int b = mt / 9, pp0 = (mt % 9) * 256;
            if (wc == 0) {
#pragma unroll
                for (int m = 0; m < 4; ++m) {
                    const size_t row = (size_t)mt * 256 + wr * 64 + m * 16 + fr;
                    const float sc = RSKV[row];
#pragma unroll
                    for (int n = 0; n < 4; n += 2) {
                        uint2 a, b2;
                        a.x = pk_bf16(acc[m][n][0] * sc, acc[m][n][1] * sc); a.y = pk_bf16(acc[m][n][2] * sc, acc[m][n][3] * sc);
                        b2.x = pk_bf16(acc[m][n + 1][0] * sc, acc[m][n + 1][1] * sc); b2.y = pk_bf16(acc[m][n + 1][2] * sc, acc[m][n + 1][3] * sc);
                        *(uint4*)(KN + row * 512 + nt * 64 + (n + (fq & 1)) * 16 + (fq >> 1) * 8) = widen16(a, b2);
                    }
                }
            } else {
#pragma unroll
                for (int m = 0; m < 4; ++m) {
                    const int lrow = wr * 64 + m * 16 + fq * 4;
                    const f32x4 sc = *(const f32x4*)(RSKV + (size_t)mt * 256 + lrow);
#pragma unroll
                    for (int n = 0; n < 4; n += 2) {
                        uint2 a, b2;
                        a.x = pk_bf16(acc[m][n][0] * sc[0], acc[m][n][1] * sc[1]); a.y = pk_bf16(acc[m][n][2] * sc[2], acc[m][n][3] * sc[3]);
                        b2.x = pk_bf16(acc[m][n + 1][0] * sc[0], acc[m][n + 1][1] * sc[1]); b2.y = pk_bf16(acc[m][n + 1][2] * sc[2], acc[m][n + 1][3] * sc[3]);
                        const int dv = (n + (fq & 1)) * 16 + fr;
                        *(uint4*)(VT + ((size_t)(b * 8 + nt) * 64 + dv) * TPB + pp0 + wr * 64 + m * 16 + (fq >> 1) * 8) = widen16(a, b2);
                    }
                }
            }
        }
    }
    {
        const bf16_t* Hr = (const bf16_t*)(p.ws + OFF_R3);
        bf16_t* SG = (bf16_t*)(p.ws + OFF_SG);
        const float* mu = p.rw_mu + (size_t)l * 1920 + 1792;
        for (int i = blockIdx.x * NTHREADS + tid; i < MROWS * 16; i += gridDim.x * NTHREADS) {
            const int row = i >> 4, c0 = (i & 15) * 8, pp = row % TPB;
            const bool hp = (pp != 0 && pp != CTXL), hn = (pp != CTXL - 1 && pp != TPB - 1);
            const bf16_t* hr = Hr + (size_t)row * 1920 + 1792 + c0;
            float cur[8], pv[8], nx[8];
            unpack8(*(const uint4*)hr, cur);
            if (hp) unpack8(*(const uint4*)(hr - 1920), pv); else {
#pragma unroll
                for (int k = 0; k < 8; ++k) pv[k] = 0.f; }
            if (hn) unpack8(*(const uint4*)(hr + 1920), nx); else {
#pragma unroll
                for (int k = 0; k < 8; ++k) nx[k] = 0.f; }
            float o[8];
#pragma unroll
            for (int k = 0; k < 8; ++k) o[k] = sigmoidf_(cur[k] + (0.5f * (pv[k] + nx[k]) - cur[k]) * mu[c0 + k]);
            uint4 ov; ov.x = pk_bf16(o[0], o[1]); ov.y = pk_bf16(o[2], o[3]); ov.z = pk_bf16(o[4], o[5]); ov.w = pk_bf16(o[6], o[7]);
            *(uint4*)(SG + (size_t)row * 128 + c0) = ov;
        }
    }
}

#define FMAC_BC(acc, coef, s, J) asm("v_fmac_f32_dpp %0, %1, %2 row_newbcast:" #J " row_mask:0xf bank_mask:0xf" : "+v"(acc) : "v"(coef), "v"(s))
#define MUL_BC(dst, coef, s, J) asm("v_mul_f32_dpp %0, %1, %2 row_newbcast:" #J " row_mask:0xf bank_mask:0xf" : "=v"(dst) : "v"(coef), "v"(s))
#define REP16(X) X(0, 0) X(1, 1) X(2, 2) X(3, 3) X(4, 0) X(5, 1) X(6, 2) X(7, 3) X(8, 0) X(9, 1) X(10, 2) X(11, 3) X(12, 0) X(13, 1) X(14, 2) X(15, 3)
constexpr int FSTR = 6 * 64 + 4;
constexpr int CHUNK = 32, NCHUNK = TPB / CHUNK;

__device__ __forceinline__ int scan_pos(int z, int s) { return z == 0 ? s : (s < CTXL ? (CTXL - 1 - s) : (TPB + CTXL - 1 - s)); }

__device__ __forceinline__ void shift4(const bf16_t* hr, bool hp, bool hn, int col, const float* mu, float (&o)[4]) {
    const uint2 c = *(const uint2*)(hr + col);
    uint2 a = make_uint2(0u, 0u), b = make_uint2(0u, 0u);
    if (hp) a = *(const uint2*)(hr - 1920 + col);
    if (hn) b = *(const uint2*)(hr + 1920 + col);
    const f32x4 m = *(const f32x4*)(mu + col);
    const float cv[4] = {bf_lo(c.x), bf_hi(c.x), bf_lo(c.y), bf_hi(c.y)};
    const float av[4] = {bf_lo(a.x), bf_hi(a.x), bf_lo(a.y), bf_hi(a.y)};
    const float bv[4] = {bf_lo(b.x), bf_hi(b.x), bf_lo(b.y), bf_hi(b.y)};
#pragma unroll
    for (int i = 0; i < 4; ++i) o[i] = cv[i] + (0.5f * (av[i] + bv[i]) - cv[i]) * m[i];
}
__device__ __forceinline__ void shift8(const bf16_t* hr, bool hp, bool hn, int col, const float* mu, float (&o)[8]) {
    float cv[8], av[8], bv[8];
    unpack8(*(const uint4*)(hr + col), cv);
    if (hp) unpack8(*(const uint4*)(hr - 1920 + col), av); else {
#pragma unroll
        for (int i = 0; i < 8; ++i) av[i] = 0.f; }
    if (hn) unpack8(*(const uint4*)(hr + 1920 + col), bv); else {
#pragma unroll
        for (int i = 0; i < 8; ++i) bv[i] = 0.f; }
#pragma unroll
    for (int i = 0; i < 8; ++i) o[i] = cv[i] + (0.5f * (av[i] + bv[i]) - cv[i]) * mu[col + i];
}
__device__ __forceinline__ bf16x8 pack8(const float (&f)[8]) {
    union { uint4 u; bf16x8 v; } r;
    r.u.x = pk_bf16(f[0], f[1]); r.u.y = pk_bf16(f[2], f[3]); r.u.z = pk_bf16(f[4], f[5]); r.u.w = pk_bf16(f[6], f[7]);
    return r.v;
}

struct ProdState { f32x4 aw[4], aa[4]; };
struct Raw3x2 { uint2 c, a, b; };
__device__ __forceinline__ Raw3x2 ld3x2(const bf16_t* pc, const bf16_t* pa, const bf16_t* pb, bool hp, bool hn, int col) {
    Raw3x2 r; r.c = *(const uint2*)(pc + col); r.a = *(const uint2*)(pa + col); r.b = *(const uint2*)(pb + col);
    return r;
}
__device__ __forceinline__ void sh4(const Raw3x2& r, const f32x4 m, float (&o)[4]) {
    const float cv[4] = {bf_lo(r.c.x), bf_hi(r.c.x), bf_lo(r.c.y), bf_hi(r.c.y)};
    const float av[4] = {bf_lo(r.a.x), bf_hi(r.a.x), bf_lo(r.a.y), bf_hi(r.a.y)};
    const float bv[4] = {bf_lo(r.b.x), bf_hi(r.b.x), bf_lo(r.b.y), bf_hi(r.b.y)};
#pragma unroll
    for (int i = 0; i < 4; ++i) o[i] = cv[i] + (0.5f * (av[i] + bv[i]) - cv[i]) * m[i];
}
struct Raw3x4 { uint4 c, a, b; };
__device__ __forceinline__ Raw3x4 ld3x4(const bf16_t* pc, const bf16_t* pa, const bf16_t* pb, bool hp, bool hn, int col) {
    Raw3x4 r; r.c = *(const uint4*)(pc + col); r.a = *(const uint4*)(pa + col); r.b = *(const uint4*)(pb + col);
    return r;
}
__device__ __forceinline__ void sh8(const Raw3x4& r, const float* m, float (&o)[8]) {
    float cv[8], av[8], bv[8];
    unpack8(r.c, cv); unpack8(r.a, av); unpack8(r.b, bv);
    const f32x4 m0 = *(const f32x4*)m, m1 = *(const f32x4*)(m + 4);
#pragma unroll
    for (int i = 0; i < 8; ++i) o[i] = cv[i] + (0.5f * (av[i] + bv[i]) - cv[i]) * (i < 4 ? m0[i] : m1[i - 4]);
}
template <int N0>
__device__ __forceinline__ void scan_produce_elem(const float* pl, int fq, const Raw3x2 (&rr)[2], const Raw3x2 (&rk)[2], const Raw3x2 (&rv)[2],
                                                  const f32x4 (&aw)[2], const f32x4 (&aa)[2], float& ss, float* frow) {
#pragma unroll
    for (int nn = 0; nn < 2; ++nn) {
        const int n = N0 + nn;
        const int c4 = n * 16 + fq * 4;
        float r4[4], k4[4], v4[4];
        sh4(rr[nn], *(const f32x4*)(pl + 0 * 64 + c4), r4);
        sh4(rk[nn], *(const f32x4*)(pl + 1 * 64 + c4), k4);
        sh4(rv[nn], *(const f32x4*)(pl + 2 * 64 + c4), v4);
        const f32x4 w0 = *(const f32x4*)(pl + 3 * 64 + c4);
        const f32x4 a0 = *(const f32x4*)(pl + 4 * 64 + c4);
        const f32x4 kkp = *(const f32x4*)(pl + 5 * 64 + c4);
        const f32x4 kap = *(const f32x4*)(pl + 6 * 64 + c4);
        f32x4 dw, kd, kf4, a4;
#pragma unroll
        for (int j = 0; j < 4; ++j) {
            const float sgx = __builtin_amdgcn_rcpf(1.0f + fexp(-(aw[nn][j] + w0[j])));
            dw[j] = fexp(-0.6065306597126334f * sgx);
            const float a = __builtin_amdgcn_rcpf(1.0f + fexp(-(aa[nn][j] + a0[j])));
            a4[j] = a;
            const float kf = k4[j] * kkp[j];
            kf4[j] = kf; ss += kf * kf;
            kd[j] = k4[j] * (1.0f + (a - 1.0f) * kap[j]);
        }
        *(f32x4*)(frow + 0 * 64 + c4) = kf4;
        *(f32x4*)(frow + 1 * 64 + c4) = dw;
        *(f32x4*)(frow + 2 * 64 + c4) = a4;
        *(f32x4*)(frow + 3 * 64 + c4) = kd;
        *(f32x4*)(frow + 4 * 64 + c4) = (f32x4){r4[0], r4[1], r4[2], r4[3]};
        *(f32x4*)(frow + 5 * 64 + c4) = (f32x4){v4[0], v4[1], v4[2], v4[3]};
    }
}
__device__ __forceinline__ void scan_produce_A(const Params& p, const float* pl, int b, int h, int z, int s0, float* frow0, int lane, ProdState& st) {
    const int fr = lane & 15, fq = lane >> 4;
    const int pp = scan_pos(z, s0 + fr);
    const bool hp = (pp != 0 && pp != CTXL), hn = (pp != CTXL - 1 && pp != TPB - 1);
    const bf16_t* hr = (const bf16_t*)(p.ws + OFF_R3) + ((size_t)b * TPB + pp) * 1920;
    const bf16_t* W = (const bf16_t*)(p.ws + OFF_W);
    Raw3x4 qw[2], qa[2];
    const bf16_t* zr = (const bf16_t*)(p.ws + OFF_ZROW) + z * 64 + fq * 8;
    const bf16_t* pc = hr + z * 64 + fq * 8; const bf16_t* pa = hp ? pc - 1920 : zr; const bf16_t* pb = hn ? pc + 1920 : zr;
#pragma unroll
    for (int ks = 0; ks < 2; ++ks) { qw[ks] = ld3x4(pc, pa, pb, hp, hn, 1536 + ks * 32); qa[ks] = ld3x4(pc, pa, pb, hp, hn, 1664 + ks * 32); }
    f32x4 accw[4], acca[4];
#pragma unroll
    for (int n = 0; n < 4; ++n) { accw[n] = (f32x4){0.f, 0.f, 0.f, 0.f}; acca[n] = (f32x4){0.f, 0.f, 0.f, 0.f}; }
#pragma unroll
    for (int ks = 0; ks < 2; ++ks) {
        bf16x8 bw[4], ba[4];
#pragma unroll
        for (int n = 0; n < 4; ++n) {
            const size_t wo = ((size_t)z * 512 + h * 64 + n * 16 + fr) * 64 + ks * 32 + fq * 8;
            bw[n] = *(const bf16x8*)(W + WO_UP + wo); ba[n] = *(const bf16x8*)(W + WO_AUP + wo);
        }
        float t8[8];
        sh8(qw[ks], pl + 7 * 64 + ks * 32 + fq * 8, t8);
#pragma unroll
        for (int i = 0; i < 8; ++i) { const float e = fexp(2.0f * t8[i]); t8[i] = 1.0f - 2.0f * __builtin_amdgcn_rcpf(e + 1.0f); }
        const bf16x8 aw = pack8(t8);
        sh8(qa[ks], pl + 8 * 64 + ks * 32 + fq * 8, t8);
        const bf16x8 aa = pack8(t8);
#pragma unroll
        for (int n = 0; n < 4; ++n) {
            accw[n] = __builtin_amdgcn_mfma_f32_16x16x32_bf16(bw[n], aw, accw[n], 0, 0, 0);
            acca[n] = __builtin_amdgcn_mfma_f32_16x16x32_bf16(ba[n], aa, acca[n], 0, 0, 0);
        }
    }
#pragma unroll
    for (int n = 0; n < 4; ++n) { st.aw[n] = accw[n]; st.aa[n] = acca[n]; }
}
__device__ __forceinline__ void scan_produce_B(const Params& p, const float* pl, int b, int h, int z, int s0, float* frow0, int lane, const ProdState& st) {
    const int fr = lane & 15, fq = lane >> 4;
    const int pp = scan_pos(z, s0 + fr);
    const bool hp = (pp != 0 && pp != CTXL), hn = (pp != CTXL - 1 && pp != TPB - 1);
    const bf16_t* hr = (const bf16_t*)(p.ws + OFF_R3) + ((size_t)b * TPB + pp) * 1920;
    Raw3x2 rr0[2], rk0[2], rv0[2], rr1[2], rk1[2], rv1[2];
    const bf16_t* zr = (const bf16_t*)(p.ws + OFF_ZROW) + h * 64 + fq * 4;
    const bf16_t* pc = hr + h * 64 + fq * 4; const bf16_t* pa = hp ? pc - 1920 : zr; const bf16_t* pb = hn ? pc + 1920 : zr;
#pragma unroll
    for (int nn = 0; nn < 2; ++nn) {
        const int C4 = nn * 16, C5 = C4 + 32;
        rr0[nn] = ld3x2(pc, pa, pb, hp, hn, C4); rk0[nn] = ld3x2(pc, pa, pb, hp, hn, 512 + C4); rv0[nn] = ld3x2(pc, pa, pb, hp, hn, 1024 + C4);
        rr1[nn] = ld3x2(pc, pa, pb, hp, hn, C5); rk1[nn] = ld3x2(pc, pa, pb, hp, hn, 512 + C5); rv1[nn] = ld3x2(pc, pa, pb, hp, hn, 1024 + C5);
    }
    float ss = 0.f;
    float* frow = frow0 + fr * FSTR;
    const f32x4 w01[2] = {st.aw[0], st.aw[1]}, a01[2] = {st.aa[0], st.aa[1]}, w23[2] = {st.aw[2], st.aw[3]}, a23[2] = {st.aa[2], st.aa[3]};
    scan_produce_elem<0>(pl, fq, rr0, rk0, rv0, w01, a01, ss, frow);
    scan_produce_elem<2>(pl, fq, rr1, rk1, rv1, w23, a23, ss, frow);
    ss = fqsum(ss);
    const float inv = __builtin_amdgcn_rsqf(fmaxf(ss, 1e-24f));
#pragma unroll
    for (int n = 0; n < 4; ++n) {
        const int c4 = n * 16 + fq * 4;
        f32x4 kk = *(const f32x4*)(frow + 0 * 64 + c4);
        f32x4 bb = *(const f32x4*)(frow + 2 * 64 + c4);
#pragma unroll
        for (int j = 0; j < 4; ++j) { kk[j] = kk[j] * inv; bb[j] = kk[j] * bb[j]; }
        *(f32x4*)(frow + 0 * 64 + c4) = kk;
        *(f32x4*)(frow + 2 * 64 + c4) = bb;
    }
}

typedef float f32x2 __attribute__((ext_vector_type(2)));
struct ScanHead { f32x4 kk[2]; f32x2 v; };
struct ScanBody { f32x4 w[2], bb[2], kd[2], r[2]; };
__device__ __forceinline__ void scan_ldh(ScanHead& c, const float* f, const float* fv) {
#pragma unroll
    for (int q = 0; q < 2; ++q) c.kk[q] = *(const f32x4*)(f + 0 * 64 + 4 * q);
    c.v = *(const f32x2*)fv;
}
__device__ __forceinline__ void scan_ldb(ScanBody& c, const float* f) {
#pragma unroll
    for (int q = 0; q < 2; ++q) {
        c.w[q] = *(const f32x4*)(f + 1 * 64 + 4 * q); c.bb[q] = *(const f32x4*)(f + 2 * 64 + 4 * q);
        c.kd[q] = *(const f32x4*)(f + 3 * 64 + 4 * q); c.r[q] = *(const f32x4*)(f + 4 * 64 + 4 * q);
    }
}
__device__ __forceinline__ void scan_unit(const Params& p, int l, int u, unsigned char* lds) {
    const int tid = ltid(), wid = __builtin_amdgcn_readfirstlane(tid >> 6), lane = tid & 63;
    const int b = u >> 4, h = (u >> 1) & 7, z = u & 1;
    float* fb = (float*)lds;
    bf16_t* Y = (bf16_t*)(p.ws + (z == 0 ? OFF_YF : OFF_YB));
    float* pl = fb + 3 * CHUNK * FSTR;
    for (int i = tid; i < 9 * 64; i += NTHREADS) {
        const int a = i >> 6, c = i & 63, C = h * 64 + c;
        float v;
        if (a < 3) v = p.rw_mu[(size_t)l * 1920 + a * 512 + C];
        else if (a == 3) v = p.rw_w0[((size_t)l * 2 + z) * 512 + C];
        else if (a == 4) v = p.rw_a0[((size_t)l * 2 + z) * 512 + C];
        else if (a == 5) v = p.rw_k_k[(size_t)l * 512 + C];
        else if (a == 6) v = p.rw_k_a[(size_t)l * 512 + C];
        else if (a == 7) v = p.rw_mu[(size_t)l * 1920 + 1536 + z * 64 + c];
        else v = p.rw_mu[(size_t)l * 1920 + 1664 + z * 64 + c];
        pl[i] = v;
    }
    __syncthreads();
    if (wid < 4) {
        f32x2 S2[8];
#pragma unroll
        for (int j = 0; j < 8; ++j) S2[j] = (f32x2){0.f, 0.f};
        __syncthreads();
        for (int c = 0; c < NCHUNK; ++c) {
            const float* fbc = fb + (c % 3) * CHUNK * FSTR + 8 * (lane & 7);
            const float* fbv = fb + (c % 3) * CHUNK * FSTR + 320 + 16 * wid + 2 * (lane >> 3);
            bf16_t* yp = Y + ((size_t)b * TPB) * 512 + h * 64 + 16 * wid + 2 * (lane >> 3);
            ScanHead ha, hb;
            scan_ldh(ha, fbc, fbv);
#define SCAN_STEP(HC, HN, SL) { \
                ScanBody bd; scan_ldb(bd, fbc + (SL) * FSTR); \
                if ((SL) + 1 < CHUNK) scan_ldh(HN, fbc + ((SL) + 1) * FSTR, fbv + ((SL) + 1) * FSTR); \
                f32x2 d0 = (f32x2){0.f, 0.f}, d1 = (f32x2){0.f, 0.f}; \
                _Pragma("unroll") for (int q = 0; q < 4; ++q) { const f32x2 k2 = (f32x2){HC.kk[q >> 1][2 * (q & 1)], HC.kk[q >> 1][2 * (q & 1) + 1]}; \
                    d0 = __builtin_elementwise_fma(S2[q], k2, d0); d1 = __builtin_elementwise_fma(S2[4 + q], k2, d1); } \
                const float sk0 = red8(d0[0] + d0[1]), sk1 = red8(d1[0] + d1[1]); \
                const f32x2 n0 = (f32x2){-sk0, -sk0}, n1 = (f32x2){-sk1, -sk1}, v0 = (f32x2){HC.v[0], HC.v[0]}, v1 = (f32x2){HC.v[1], HC.v[1]}; \
                f32x2 y0 = (f32x2){0.f, 0.f}, y1 = (f32x2){0.f, 0.f}; \
                _Pragma("unroll") for (int q = 0; q < 4; ++q) { \
                    const f32x2 w2 = (f32x2){bd.w[q >> 1][2 * (q & 1)], bd.w[q >> 1][2 * (q & 1) + 1]}, b2 = (f32x2){bd.bb[q >> 1][2 * (q & 1)], bd.bb[q >> 1][2 * (q & 1) + 1]}; \
                    const f32x2 kd2 = (f32x2){bd.kd[q >> 1][2 * (q & 1)], bd.kd[q >> 1][2 * (q & 1) + 1]}, r2 = (f32x2){bd.r[q >> 1][2 * (q & 1)], bd.r[q >> 1][2 * (q & 1) + 1]}; \
                    f32x2 t0 = S2[q] * w2; t0 = __builtin_elementwise_fma(b2, n0, t0); t0 = __builtin_elementwise_fma(kd2, v0, t0); \
                    f32x2 t1 = S2[4 + q] * w2; t1 = __builtin_elementwise_fma(b2, n1, t1); t1 = __builtin_elementwise_fma(kd2, v1, t1); \
                    S2[q] = t0; S2[4 + q] = t1; \
                    y0 = __builtin_elementwise_fma(t0, r2, y0); y1 = __builtin_elementwise_fma(t1, r2, y1); } \
                const float ya = red8(y0[0] + y0[1]), yb = red8(y1[0] + y1[1]); \
                const int pp = scan_pos(z, c * CHUNK + (SL)); \
                if ((lane & 7) == 0) *(unsigned*)(yp + (size_t)pp * 512) = pk_bf16(ya, yb); }
#pragma unroll 1
            for (int sl = 0; sl < CHUNK; sl += 2) {
                SCAN_STEP(ha, hb, sl)
                SCAN_STEP(hb, ha, sl + 1)
            }
            __syncthreads();
        }
    } else {
        ProdState st;
#pragma unroll
        for (int n = 0; n < 4; ++n) { st.aw[n] = (f32x4){0.f, 0.f, 0.f, 0.f}; st.aa[n] = (f32x4){0.f, 0.f, 0.f, 0.f}; }
        const int nrep = launder_i(1 + ((PROBE_MASK >> 10) & 1));
        const int pair = (wid - 4) >> 1, ph = (wid - 4) & 1;
        {
            float* f0 = fb + (pair % 3) * CHUNK * FSTR + ph * 16 * FSTR;
            scan_produce_A(p, pl, b, h, z, pair * CHUNK + ph * 16, f0, lane, st);
            if (pair == 0) scan_produce_B(p, pl, b, h, z, ph * 16, f0, lane, st);
        }
        __syncthreads();
        for (int c = 0; c < NCHUNK; ++c) {
            for (int rr_ = 0; rr_ < nrep; ++rr_) {
            if (pair == ((c + 1) & 1)) {
                if (c + 1 < NCHUNK) scan_produce_B(p, pl, b, h, z, (c + 1) * CHUNK + ph * 16, fb + ((c + 1) % 3) * CHUNK * FSTR + ph * 16 * FSTR, lane, st);
            } else {
                if (c + 2 < NCHUNK) scan_produce_A(p, pl, b, h, z, (c + 2) * CHUNK + ph * 16, fb + ((c + 2) % 3) * CHUNK * FSTR + ph * 16 * FSTR, lane, st);
            }
            }
            __syncthreads();
        }
    }
}

constexpr int ATT_STAGE = 20480;
__device__ __forceinline__ void attn_unit(const Params& p, int b, int h, int q0, int nkeys, unsigned char* lds, int do_write) {
    const int tid = ltid(), wid = __builtin_amdgcn_readfirstlane(tid >> 6), lane = tid & 63, fr = lane & 15, fq = lane >> 4;
    bf16_t* Q = (bf16_t*)(p.ws + OFF_Q);
    const bf16_t* KN = (const bf16_t*)(p.ws + OFF_KN);
    const bf16_t* KR = (const bf16_t*)(p.ws + OFF_KR);
    const bf16_t* VT = (const bf16_t*)(p.ws + OFF_VT);
    const size_t rb = (size_t)b * TPB;
    bf16x8 qf[2][3];
#pragma unroll
    for (int nq = 0; nq < 2; ++nq)
#pragma unroll
        for (int ks = 0; ks < 3; ++ks) qf[nq][ks] = *(const bf16x8*)(Q + (rb + q0 + wid * 32 + nq * 16 + fr) * 768 + h * 96 + ks * 32 + fq * 8);
    f32x4 oacc[4][2];
#pragma unroll
    for (int mt = 0; mt < 4; ++mt)
#pragma unroll
        for (int nq = 0; nq < 2; ++nq) oacc[mt][nq] = (f32x4){0.f, 0.f, 0.f, 0.f};
    float mrun[2] = {0.f, 0.f}, lsum[2] = {0.f, 0.f};
    const int c8 = (lane & 7) ^ ((4 * wid + (lane >> 4)) & 7);
    const bf16_t* knp = KN + (rb + 8 * wid + (lane >> 3)) * 512 + h * 64 + c8 * 8;
    const bf16_t* vtp = VT + ((size_t)(b * 8 + h) * 64 + 8 * wid + (lane >> 3)) * TPB + c8 * 8;
    const int c4 = (lane & 3) ^ ((lane >> 4) & 3);
    const bf16_t* krp = KR + (rb + 16 * (wid & 3) + (lane >> 2)) * 32 + c4 * 8;
    auto issue = [&](int t, int stg) {
        unsigned char* base = lds + stg * ATT_STAGE;
        const int k0 = t * 64;
        __builtin_amdgcn_global_load_lds((const GLB_AS unsigned*)(knp + (size_t)k0 * 512), (LDS_AS unsigned*)(base + wid * 1024), 16, 0, 0);
        __builtin_amdgcn_global_load_lds((const GLB_AS unsigned*)(vtp + k0), (LDS_AS unsigned*)(base + 12288 + wid * 1024), 16, 0, 0);
        if (wid < 4) __builtin_amdgcn_global_load_lds((const GLB_AS unsigned*)(krp + (size_t)k0 * 32), (LDS_AS unsigned*)(base + 8192 + wid * 1024), 16, 0, 0);
    };
    const int ntile = nkeys / 64;
    const int kz = fr >> 1, rz = (fr >> 2) & 3;
    issue(0, 0);
    asm volatile("s_waitcnt vmcnt(0)" ::: "memory");
    __builtin_amdgcn_s_barrier();
    asm volatile("" ::: "memory");
    for (int t = 0; t < ntile; ++t) {
        if (t + 1 < ntile) issue(t + 1, (t + 1) & 1);
        const unsigned char* Ks = lds + (t & 1) * ATT_STAGE;
        const unsigned char* Rs = Ks + 8192;
        const unsigned char* Vs = Ks + 12288;
        f32x4 sacc[4][2];
#pragma unroll
        for (int km = 0; km < 4; ++km)
#pragma unroll
            for (int nq = 0; nq < 2; ++nq) sacc[km][nq] = (f32x4){-mrun[nq], -mrun[nq], -mrun[nq], -mrun[nq]};
#pragma unroll
        for (int ks = 0; ks < 3; ++ks)
#pragma unroll
            for (int km = 0; km < 4; ++km) {
                const bf16x8 kf = ks < 2 ? *(const bf16x8*)(Ks + (km * 16 + fr) * 128 + (((ks * 4 + fq) ^ kz) * 16))
                                         : *(const bf16x8*)(Rs + (km * 16 + fr) * 64 + ((fq ^ rz) * 16));
#pragma unroll
                for (int nq = 0; nq < 2; ++nq) sacc[km][nq] = __builtin_amdgcn_mfma_f32_16x16x32_bf16(kf, qf[nq][ks], sacc[km][nq], 0, 0, 0);
            }
        float delta[2];
#pragma unroll
        for (int nq = 0; nq < 2; ++nq) {
            float mx = -1e30f;
#pragma unroll
            for (int km = 0; km < 4; ++km)
#pragma unroll
                for (int j = 0; j < 4; ++j) mx = fmaxf(mx, sacc[km][nq][j]);
            mx = fqmax(mx);
            delta[nq] = (t == 0) ? mx : fmaxf(mx, 0.f);
        }
        const bool exact = (t == 0) || (__builtin_amdgcn_ballot_w64(fmaxf(delta[0], delta[1]) > 60.0f) != 0ull);
        bf16x8 pf[2][2];
        float psum[2];
#pragma unroll
        for (int nq = 0; nq < 2; ++nq) {
            float ps = 0.f;
            if (exact) {
#pragma unroll
                for (int km = 0; km < 4; ++km)
#pragma unroll
                    for (int j = 0; j < 4; ++j) { const float e = __builtin_amdgcn_exp2f(sacc[km][nq][j] - delta[nq]); sacc[km][nq][j] = e; ps += e; }
            } else {
#pragma unroll
                for (int km = 0; km < 4; ++km)
#pragma unroll
                    for (int j = 0; j < 4; ++j) { const float e = __builtin_amdgcn_exp2f(sacc[km][nq][j]); sacc[km][nq][j] = e; ps += e; }
            }
            psum[nq] = ps;
#pragma unroll
            for (int kc = 0; kc < 2; ++kc) {
                union { uint4 u; bf16x8 v; } r;
                r.u.x = pk_bf16(sacc[2 * kc][nq][0], sacc[2 * kc][nq][1]); r.u.y = pk_bf16(sacc[2 * kc][nq][2], sacc[2 * kc][nq][3]);
                r.u.z = pk_bf16(sacc[2 * kc + 1][nq][0], sacc[2 * kc + 1][nq][1]); r.u.w = pk_bf16(sacc[2 * kc + 1][nq][2], sacc[2 * kc + 1][nq][3]);
                pf[kc][nq] = r.v;
            }
        }
        if (exact) {
#pragma unroll
            for (int nq = 0; nq < 2; ++nq) {
                const float alpha = (t == 0) ? 1.0f : __builtin_amdgcn_exp2f(-delta[nq]);
                lsum[nq] = lsum[nq] * alpha + psum[nq];
#pragma unroll
                for (int mt = 0; mt < 4; ++mt) oacc[mt][nq] = oacc[mt][nq] * alpha;
            }
        }
#pragma unroll
        for (int mt = 0; mt < 4; ++mt)
#pragma unroll
            for (int kc = 0; kc < 2; ++kc) {
                union { uint2 h2[2]; bf16x8 v; } r;
                const unsigned char* vrow = Vs + (mt * 16 + fr) * 128 + (fq & 1) * 8;
                r.h2[0] = *(const uint2*)(vrow + (((4 * kc + (fq >> 1)) ^ kz) * 16));
                r.h2[1] = *(const uint2*)(vrow + (((4 * kc + 2 + (fq >> 1)) ^ kz) * 16));
#pragma unroll
                for (int nq = 0; nq < 2; ++nq) oacc[mt][nq] = __builtin_amdgcn_mfma_f32_16x16x32_bf16(r.v, pf[kc][nq], oacc[mt][nq], 0, 0, 0);
            }
        if (!exact) {
#pragma unroll
            for (int nq = 0; nq < 2; ++nq) {
                const float alpha = __builtin_amdgcn_exp2f(-delta[nq]);
                lsum[nq] = (lsum[nq] + psum[nq]) * alpha;
#pragma unroll
                for (int mt = 0; mt < 4; ++mt) oacc[mt][nq] = oacc[mt][nq] * alpha;
            }
        }
#pragma unroll
        for (int nq = 0; nq < 2; ++nq) mrun[nq] += delta[nq];
        asm volatile("s_waitcnt vmcnt(0) lgkmcnt(0)" ::: "memory");
        __builtin_amdgcn_s_barrier();
        asm volatile("" ::: "memory");
    }
#pragma unroll
    for (int nq = 0; nq < 2; ++nq) {
        const float inv = 1.0f / fqsum(lsum[nq]);
        bf16_t* orow = Q + (rb + q0 + wid * 32 + nq * 16 + fr) * 768 + h * 96;
#pragma unroll
        for (int mt = 0; mt < 4; mt += 2) {
            uint2 a, b2;
            a.x = pk_bf16(oacc[mt][nq][0] * inv, oacc[mt][nq][1] * inv); a.y = pk_bf16(oacc[mt][nq][2] * inv, oacc[mt][nq][3] * inv);
            b2.x = pk_bf16(oacc[mt + 1][nq][0] * inv, oacc[mt + 1][nq][1] * inv); b2.y = pk_bf16(oacc[mt + 1][nq][2] * inv, oacc[mt + 1][nq][3] * inv);
            const uint4 w = widen16(a, b2);
            if (do_write) *(uint4*)(orow + (mt + (fq & 1)) * 16 + (fq >> 1) * 8) = w;
        }
    }
}

__device__ __forceinline__ void p3_phase(const Params& pin, int l, unsigned char* lds) {
    const Params p = launder(pin); l = launder_i(l);
    for (int r = 0, nr = launder_i(1 + ((PROBE_MASK >> 1) & 1)); r < nr; ++r)
        for (int u = blockIdx.x; u < 256; u += gridDim.x) scan_unit(p, l, u, lds);
    const int nunits = (l == DEPTH - 1) ? 1024 : 1152;
    for (int r = launder_i(((PROBE_MASK >> 9) & 1) ? 0 : 1); r < 2; ++r)
    for (int u = blockIdx.x; u < nunits; u += gridDim.x) {
        if (u < 1024) { const int bh = u >> 3, qt = u & 7; attn_unit(p, bh >> 3, bh & 7, CTXL + qt * 256, TPB, lds, r); }
        else { const int bh = u - 1024; attn_unit(p, bh >> 3, bh & 7, 0, CTXL, lds, r); }
    }
}

__device__ __forceinline__ void p35_phase(const Params& pin, int l, bool skip_ctx, unsigned char* lds) {
    const Params p = launder(pin); l = launder_i(l); const int tid = ltid();
    const bf16_t* SG = (const bf16_t*)(p.ws + OFF_SG);
    const bf16_t* W = (const bf16_t*)(p.ws + OFF_W) + WO_GUP;
    const bf16_t* YF = (const bf16_t*)(p.ws + OFF_YF);
    const bf16_t* YB = (const bf16_t*)(p.ws + OFF_YB);
    const bf16_t* Hr = (const bf16_t*)(p.ws + OFF_R3);
    bf16_t* RWO = (bf16_t*)(p.ws + OFF_RWO);
    const float* mu = p.rw_mu + (size_t)l * 1920;
    const int lane = tid & 63, wid = tid >> 6, wr = wid >> 1, wc = wid & 1, fr = lane & 15, fq = lane >> 4;
    float* gt = (float*)lds;
    constexpr int GP = 132;
    for (int t = blockIdx.x; t < 288 * 4; t += gridDim.x) {
        int mt, nt; tile_mn(t, 4, mt, nt);
        if (skip_ctx && (mt % 18) < 2) continue;
        f32x4 acc[2][4]; zero_acc<2>(acc);
        gemm_mainloop<2, 1>(acc, SG + (size_t)mt * 128 * 128, 128, 64, W + (size_t)nt * 128 * 128, 128, 2, lds, tid);
#pragma unroll
        for (int m = 0; m < 2; ++m)
#pragma unroll
            for (int n = 0; n < 4; ++n) *(f32x4*)(gt + (wr * 32 + m * 16 + fr) * GP + wc * 64 + n * 16 + fq * 4) = acc[m][n];
        __syncthreads();
        const int pp0 = (mt % 18) * 128;
#pragma unroll 1
        for (int it = 0; it < 4; ++it) {
            const int item = tid + it * NTHREADS, lrow = item >> 4, cg = item & 15, pp = pp0 + lrow;
            const size_t row = (size_t)mt * 128 + lrow;
            const int C = nt * 128 + cg * 8;
            const bool hp = (pp != 0 && pp != CTXL), hn = (pp != CTXL - 1 && pp != TPB - 1);
            const bf16_t* hr = Hr + row * 1920;
            float yf[8], yb[8], r8[8], k8[8], v8[8];
            unpack8(*(const uint4*)(YF + row * 512 + C), yf); unpack8(*(const uint4*)(YB + row * 512 + C), yb);
            shift8(hr, hp, hn, C, mu, r8); shift8(hr, hp, hn, 512 + C, mu, k8); shift8(hr, hp, hn, 1024 + C, mu, v8);
            const float* rkp = p.rw_r_k + (size_t)l * 512 + C;
            float s1 = 0.f, bs = 0.f;
#pragma unroll
            for (int i = 0; i < 8; ++i) { yf[i] += yb[i]; s1 += yf[i]; bs += r8[i] * k8[i] * rkp[i]; }
            s1 = red8(s1); bs = red8(bs);
            const float mean = s1 * (1.0f / 64.0f);
            float s2 = 0.f;
#pragma unroll
            for (int i = 0; i < 8; ++i) { const float d = yf[i] - mean; s2 += d * d; }
            s2 = red8(s2);
            const float rstd = __builtin_amdgcn_rsqf(s2 * (1.0f / 64.0f) + 64e-5f);
            const float* ggp = p.rw_gn_g + (size_t)l * 512 + C; const float* gbp = p.rw_gn_b + (size_t)l * 512 + C;
            const f32x4 g0 = *(const f32x4*)(gt + lrow * GP + cg * 8), g1 = *(const f32x4*)(gt + lrow * GP + cg * 8 + 4);
            float o[8];
#pragma unroll
            for (int i = 0; i < 8; ++i) o[i] = ((yf[i] - mean) * rstd * ggp[i] + gbp[i] + bs * v8[i]) * (i < 4 ? g0[i] : g1[i - 4]);
            uint4 ov; ov.x = pk_bf16(o[0], o[1]); ov.y = pk_bf16(o[2], o[3]); ov.z = pk_bf16(o[4], o[5]); ov.w = pk_bf16(o[6], o[7]);
            *(uint4*)(RWO + row * 512 + C) = ov;
        }
        __syncthreads();
    }
}

__device__ __forceinline__ void p4_phase(const Params& pin, bool skip_ctx, unsigned char* lds) {
    const Params p = launder(pin); const int tid = ltid();
    const bf16_t* XM = (const bf16_t*)(p.ws + OFF_R6);
    const bf16_t* W = (const bf16_t*)(p.ws + OFF_W);
    bf16_t* MG = (bf16_t*)(p.ws + OFF_MRG);
    const int lane = tid & 63, wid = tid >> 6, wr = wid >> 1, wc = wid & 1, fr = lane & 15, fq = lane >> 4;
    for (int t = blockIdx.x; t < 288 * 8; t += gridDim.x) {
        int mt, nt; tile_mn(t, 8, mt, nt);
        if (skip_ctx && (mt % 18) < 2) continue;
        f32x4 g[3][2][4];
#pragma unroll
        for (int i = 0; i < 3; ++i) zero_acc<2>(g[i]);
        gemm_gate3(g, XM + (size_t)mt * 128 * 1024, W + WO_IN + (size_t)(4224 + nt * 128) * 1024, 16, lds, tid);
        typedef __fp16 h16x2 __attribute__((ext_vector_type(2)));
        h16x2 gp[3][2][4][2];
#pragma unroll
        for (int i = 0; i < 3; ++i)
#pragma unroll
            for (int m = 0; m < 2; ++m)
#pragma unroll
                for (int n = 0; n < 4; ++n) {
                    gp[i][m][n][0] = __builtin_amdgcn_cvt_pkrtz(sigmoidf_(g[i][m][n][0]), sigmoidf_(g[i][m][n][1]));
                    gp[i][m][n][1] = __builtin_amdgcn_cvt_pkrtz(sigmoidf_(g[i][m][n][2]), sigmoidf_(g[i][m][n][3]));
                }
        f32x4 mg[2][4]; zero_acc<2>(mg);
#pragma unroll 1
        for (int i = 0; i < 3; ++i) {
            const bf16_t* Ab; int lda, kst; const bf16_t* Wb;
            if (i == 0) { Ab = (const bf16_t*)(p.ws + OFF_Q); lda = 768; kst = 96; Wb = W + WO_OA; }
            else if (i == 1) { Ab = (const bf16_t*)(p.ws + OFF_R5); lda = 512; kst = 64; Wb = W + WO_OC; }
            else { Ab = (const bf16_t*)(p.ws + OFF_RWO); lda = 512; kst = 64; Wb = W + WO_OR; }
            f32x4 a[2][4]; zero_acc<2>(a);
            gemm_mainloop<2, 1>(a, Ab + (size_t)mt * 128 * lda, lda, kst, Wb + (size_t)nt * 128 * 512, 512, 8, lds, tid);
#pragma unroll
            for (int m = 0; m < 2; ++m)
#pragma unroll
                for (int n = 0; n < 4; ++n) {
                    const h16x2 g0 = i == 0 ? gp[0][m][n][0] : (i == 1 ? gp[1][m][n][0] : gp[2][m][n][0]);
                    const h16x2 g1 = i == 0 ? gp[0][m][n][1] : (i == 1 ? gp[1][m][n][1] : gp[2][m][n][1]);
                    mg[m][n][0] += (float)g0[0] * a[m][n][0]; mg[m][n][1] += (float)g0[1] * a[m][n][1];
                    mg[m][n][2] += (float)g1[0] * a[m][n][2]; mg[m][n][3] += (float)g1[1] * a[m][n][3];
                }
        }
#pragma unroll
        for (int m = 0; m < 2; ++m) {
            const size_t row = (size_t)mt * 128 + wr * 32 + m * 16 + fr;
#pragma unroll
            for (int n = 0; n < 4; n += 2) {
                uint2 a, b2;
                a.x = pk_bf16(mg[m][n][0], mg[m][n][1]); a.y = pk_bf16(mg[m][n][2], mg[m][n][3]);
                b2.x = pk_bf16(mg[m][n + 1][0], mg[m][n + 1][1]); b2.y = pk_bf16(mg[m][n + 1][2], mg[m][n + 1][3]);
                *(uint4*)(MG + row * 1024 + nt * 128 + wc * 64 + (n + (fq & 1)) * 16 + (fq >> 1) * 8) = widen16(a, b2);
            }
        }
    }
}

template <int MT>
__device__ __forceinline__ void resid_tile(const Params& p, int l, const bf16_t* A, int lda, int nk, const bf16_t* Wt, int ldb, int goff, bool x_from_input,
                                           const float* lng, const float* lnb, int row0, int nt, unsigned char* lds, int tid) {
    const int lane = tid & 63, wid = tid >> 6, wr = wid >> 1, wc = wid & 1, fr = lane & 15, fq = lane >> 4;
    f32x4 acc[MT][4]; zero_acc<MT>(acc);
    gemm_mainloop<MT, 1>(acc, A + (size_t)row0 * lda, lda, 64, Wt + (size_t)nt * 128 * ldb, ldb, nk, lds, tid);
    const int b = row0 / TPB, pp0 = row0 % TPB;
    const float* gv = modv_ptr(p, l, b, pp0) + goff;
    const float* stats = (const float*)(p.ws + OFF_STATS);
#pragma unroll
    for (int m = 0; m < MT; ++m) {
        const int lr = wr * 16 * MT + m * 16 + fr, pp = pp0 + lr;
        const float* xi = x_rd(p, x_from_input, b, pp);
        float* xo = x_wr(p, b, pp);
        float mean = 0.f, rstd = 1.f;
        if (!x_from_input) { const size_t row = (size_t)row0 + lr; mean = stats[row * 2]; rstd = stats[row * 2 + 1]; }
#pragma unroll
        for (int n = 0; n < 4; ++n) {
            const int col = nt * 128 + wc * 64 + n * 16 + fq * 4;
            f32x4 xv = *(const f32x4*)(xi + col); const f32x4 g4 = *(const f32x4*)(gv + col);
            if (!x_from_input) {
                const f32x4 lg = *(const f32x4*)(lng + col), lb = *(const f32x4*)(lnb + col);
#pragma unroll
                for (int j = 0; j < 4; ++j) xv[j] = (xv[j] - mean) * rstd * lg[j] + lb[j];
            }
            f32x4 o;
#pragma unroll
            for (int j = 0; j < 4; ++j) o[j] = ALPHA * xv[j] + g4[j] * acc[m][n][j];
            *(f32x4*)(xo + col) = o;
        }
    }
}
__device__ __forceinline__ void resid_tile256(const Params& p, int l, const bf16_t* A, int lda, int nk, const bf16_t* Wt, int ldb, int goff, bool x_from_input,
                                              const float* lng, const float* lnb, int row0, int nt256, unsigned char* lds, int tid) {
    const int lane = tid & 63, wid = tid >> 6, wr = wid >> 2, wc = wid & 3, fr = lane & 15, fq = lane >> 4;
    f32x4 acc[8][4]; zero_acc<8>(acc);
    Seg sg; sg.A = A + (size_t)row0 * lda; sg.Bt = Wt + (size_t)nt256 * 256 * ldb; sg.lda = lda; sg.a_kstep = 64; sg.ldb = ldb; sg.nk = nk;
    int st = 0;
    gemm_stream256(acc, sg, sg, false, true, st, lds, tid);
    const int b = row0 / TPB, pp0 = row0 % TPB;
    const float* gv = modv_ptr(p, l, b, pp0) + goff;
    const float* stats = (const float*)(p.ws + OFF_STATS);
#pragma unroll
    for (int m = 0; m < 8; ++m) {
        const int lr = wr * 128 + m * 16 + fr, pp = pp0 + lr;
        const float* xi = x_rd(p, x_from_input, b, pp);
        float* xo = x_wr(p, b, pp);
        float mean = 0.f, rstd = 1.f;
        if (!x_from_input) { const size_t row = (size_t)row0 + lr; mean = stats[row * 2]; rstd = stats[row * 2 + 1]; }
#pragma unroll
        for (int n = 0; n < 4; ++n) {
            const int col = nt256 * 256 + wc * 64 + n * 16 + fq * 4;
            f32x4 xv = *(const f32x4*)(xi + col); const f32x4 g4 = *(const f32x4*)(gv + col);
            if (!x_from_input) {
                const f32x4 lg = *(const f32x4*)(lng + col), lb = *(const f32x4*)(lnb + col);
#pragma unroll
                for (int j = 0; j < 4; ++j) xv[j] = (xv[j] - mean) * rstd * lg[j] + lb[j];
            }
            f32x4 o;
#pragma unroll
            for (int j = 0; j < 4; ++j) o[j] = ALPHA * xv[j] + g4[j] * acc[m][n][j];
            *(f32x4*)(xo + col) = o;
        }
    }
}
__device__ __forceinline__ void resid_gemm_phase(const Params& pin, int l, size_t a_off, int lda, int nk, size_t w_off, int ldb, int goff, bool x_from_input, const float* lng, const float* lnb, bool skip_ctx, unsigned char* lds) {
    const Params p = launder(pin); l = launder_i(l);
    const int tid = ltid();
    const bf16_t* A = (const bf16_t*)(p.ws + a_off);
    const bf16_t* Wt = (const bf16_t*)(p.ws + OFF_W) + w_off;
    if (gridDim.x == 256) {
        for (int t = blockIdx.x; t < 512; t += 256) {
            int mt, nt; tile_mn(t, 4, mt, nt);
            if (skip_ctx && (mt % 9) == 0) continue;
            resid_tile256(p, l, A, lda, nk, Wt, ldb, goff, x_from_input, lng, lnb, mt * 256, nt, lds, tid);
        }
        int mt, nt; tile_mn(512 + (blockIdx.x >> 2), 4, mt, nt);
        const int q = blockIdx.x & 3;
        if (!(skip_ctx && (mt % 9) == 0)) resid_tile<2>(p, l, A, lda, nk, Wt, ldb, goff, x_from_input, lng, lnb, mt * 256 + (q >> 1) * 128, nt * 2 + (q & 1), lds, tid);
    } else {
        for (int t = blockIdx.x; t < 144 * 8; t += gridDim.x) {
            int mt, nt; tile_mn(t, 8, mt, nt);
            if (skip_ctx && (mt % 9) == 0) continue;
            resid_tile<4>(p, l, A, lda, nk, Wt, ldb, goff, x_from_input, lng, lnb, mt * 256, nt, lds, tid);
        }
    }
}

__device__ __forceinline__ void ln_phase(const Params& pin, const float* g, const float* bta, int lmod, int shoff, bool write_xmod, bool write_x, bool skip_ctx) {
    const Params p = launder(pin); lmod = launder_i(lmod);
    const int tid = ltid(), wid = tid >> 6, lane = tid & 63;
    bf16_t* xm = (bf16_t*)(p.ws + OFF_R6);
    float* stats = (float*)(p.ws + OFF_STATS);
    for (int row = blockIdx.x * 8 + wid; row < MROWS; row += gridDim.x * 8) {
        const int b = row / TPB, pp = row % TPB;
        if (skip_ctx && pp < CTXL) continue;
        float* xp = x_wr(p, b, pp);
        f32x4 v[4];
        float s = 0.f;
#pragma unroll
        for (int i = 0; i < 4; ++i) { v[i] = *(const f32x4*)(xp + i * 256 + lane * 4); s += (v[i][0] + v[i][1]) + (v[i][2] + v[i][3]); }
        const float mean = wave_sum(s) * (1.0f / 1024.0f);
        float q = 0.f;
#pragma unroll
        for (int i = 0; i < 4; ++i)
#pragma unroll
            for (int j = 0; j < 4; ++j) { const float d = v[i][j] - mean; q += d * d; }
        const float rstd = __builtin_amdgcn_rsqf(wave_sum(q) * (1.0f / 1024.0f) + 1e-5f);
        if (lane == 0) { stats[(size_t)row * 2] = mean; stats[(size_t)row * 2 + 1] = rstd; }
        const float* mv = write_xmod ? modv_ptr(p, lmod, b, pp) + shoff : nullptr;
#pragma unroll
        for (int i = 0; i < 4; ++i) {
            const int c = i * 256 + lane * 4;
            const f32x4 g4 = *(const f32x4*)(g + c), b4 = *(const f32x4*)(bta + c);
            f32x4 o;
#pragma unroll
            for (int j = 0; j < 4; ++j) o[j] = (v[i][j] - mean) * rstd * g4[j] + b4[j];
            if (write_x) *(f32x4*)(xp + c) = o;
            if (write_xmod) {
                const f32x4 sh = *(const f32x4*)(mv + c), sc = *(const f32x4*)(mv + 1024 + c);
                uint2 ov; ov.x = pk_bf16(o[0] * (1.f + sc[0]) + sh[0], o[1] * (1.f + sc[1]) + sh[1]); ov.y = pk_bf16(o[2] * (1.f + sc[2]) + sh[2], o[3] * (1.f + sc[3]) + sh[3]);
                *(uint2*)(xm + (size_t)row * 1024 + c) = ov;
            }
        }
    }
}

__device__ __forceinline__ void p7_phase(const Params& pin, bool skip_ctx, unsigned char* lds) {
    const Params p = launder(pin); const int tid = ltid();
    const bf16_t* A = (const bf16_t*)(p.ws + OFF_R6);
    const bf16_t* W = (const bf16_t*)(p.ws + OFF_W) + WO_13;
    bf16_t* HF = (bf16_t*)(p.ws + OFF_HF);
    const int lane = tid & 63, wid = tid >> 6, wr = wid >> 2, wc = wid & 3, fr = lane & 15, fq = lane >> 4;
    auto seg = [&](int t) { int mt, nt; tile_mn(t, 22, mt, nt); Seg g; g.A = A + (size_t)mt * 256 * 1024; g.Bt = W + (size_t)nt * 256 * 1024; g.lda = 1024; g.a_kstep = 64; g.ldb = 1024; g.nk = 16; return g; };
    auto valid = [&](int t) { int mt, nt; tile_mn(t, 22, mt, nt); return !(skip_ctx && (mt % 9) == 0); };
    auto nextv = [&](int t) { while (t < 144 * 22 && !valid(t)) t += gridDim.x; return t; };
    int st = 0; bool first = true;
    for (int t = nextv(blockIdx.x); t < 144 * 22;) {
        int mt, nt; tile_mn(t, 22, mt, nt);
        const int tn = nextv(t + gridDim.x); const bool hn = tn < 144 * 22;
        f32x4 acc[8][4]; zero_acc<8>(acc);
        gemm_stream256(acc, seg(t), seg(hn ? tn : t), hn, first, st, lds, tid); first = false;
        const int G = nt * 4 + wc;
#pragma unroll
        for (int m = 0; m < 8; ++m) {
            const size_t row = (size_t)mt * 256 + wr * 128 + m * 16 + fr;
            uint2 ov[2];
#pragma unroll
            for (int n = 0; n < 2; ++n) {
                float o[4];
#pragma unroll
                for (int j = 0; j < 4; ++j) o[j] = siluf_(acc[m][n][j]) * acc[m][n + 2][j];
                ov[n].x = pk_bf16(o[0], o[1]); ov[n].y = pk_bf16(o[2], o[3]);
            }
            *(uint4*)(HF + row * DFF + G * 32 + (fq & 1) * 16 + (fq >> 1) * 8) = widen16(ov[0], ov[1]);
        }
        t = tn;
    }
}

__global__ void __launch_bounds__(NTHREADS) fwd_megakernel(Params p) {
    extern __shared__ __attribute__((aligned(16))) unsigned char lds[];
    cg::grid_group grid = cg::this_grid();
    unsigned* gbar = (unsigned*)(p.ws + OFF_BAR); unsigned epoch = 0;
#define GSYNC() grid_barrier(gbar, epoch)
    if (p.ws == nullptr) grid.sync();
    modv_phase(p, lds);
    convert_layer(p, 0, lds);
    {
        bf16_t* Wm = (bf16_t*)(p.ws + OFF_W) + WO_IN + (size_t)672 * 1024;
        for (int i = blockIdx.x * NTHREADS + threadIdx.x; i < 96 * 1024 / 2; i += gridDim.x * NTHREADS) ((unsigned*)Wm)[i] = 0u;
    }
    GSYNC();
    xmod0_phase(p);
    GSYNC();
#pragma unroll 1
    for (int l = 0; l < DEPTH; ++l) {
        const bool last = (l == DEPTH - 1);
        for (int r = 0, nr = launder_i(1 + ((PROBE_MASK >> 2) & 1)); r < nr; ++r) p1_phase(p, lds);
        GSYNC();
        for (int r = 0, nr = launder_i(1 + ((PROBE_MASK >> 3) & 1)); r < nr; ++r) p2a_phase(p, l);
        GSYNC();
        for (int r = 0, nr = launder_i(1 + ((PROBE_MASK >> 4) & 1)); r < nr; ++r) p2b_phase(p, l, lds);
        GSYNC();
        p3_phase(p, l, lds);
        GSYNC();
        for (int r = 0, nr = launder_i(1 + ((PROBE_MASK >> 5) & 1)); r < nr; ++r) p35_phase(p, l, last, lds);
        GSYNC();
        for (int r = 0, nr = launder_i(1 + ((PROBE_MASK >> 6) & 1)); r < nr; ++r) p4_phase(p, last, lds);
        GSYNC();
        resid_gemm_phase(p, l, OFF_MRG, 1024, 16, WO_OUT, 1024, 2048, l == 0, p.ln2_g + (l > 0 ? l - 1 : 0) * 1024, p.ln2_b + (l > 0 ? l - 1 : 0) * 1024, last, lds);
        GSYNC();
        ln_phase(p, p.ln1_g + l * 1024, p.ln1_b + l * 1024, l, 3072, true, false, last);
        GSYNC();
        for (int r = 0, nr = launder_i(1 + ((PROBE_MASK >> 0) & 1)); r < nr; ++r) p7_phase(p, last, lds);
        GSYNC();
        resid_gemm_phase(p, l, OFF_HF, DFF, 44, WO_2, DFF, 5120, false, p.ln1_g + l * 1024, p.ln1_b + l * 1024, last, lds);
        GSYNC();
        ln_phase(p, p.ln2_g + l * 1024, p.ln2_b + l * 1024, last ? l : l + 1, 0, !last, last, last);
        if (!last) for (int r = 0, nr = launder_i(1 + ((PROBE_MASK >> 7) & 1)); r < nr; ++r) convert_layer(p, l + 1, lds);
        for (int r = 0, nr = launder_i(((PROBE_MASK >> 8) & 1) * 10); r < nr; ++r) GSYNC();
        GSYNC();
    }
}

extern "C" void kernel_launch(void* const* d_in, const int* in_sizes, int n_in, void* d_out,
                              int out_size, void* d_ws, size_t ws_size, hipStream_t stream) {
    static int grid_blocks = 0;
    if (!grid_blocks) {
        int dev = 0, cus = 0, per_cu = 0;
        hipGetDevice(&dev);
        hipDeviceGetAttribute(&cus, hipDeviceAttributeMultiprocessorCount, dev);
        if (hipFuncSetAttribute((const void*)fwd_megakernel, hipFuncAttributeMaxDynamicSharedMemorySize, LDS_BYTES) != hipSuccess)
            fprintf(stderr, "hipFuncSetAttribute failed\n");
        hipOccupancyMaxActiveBlocksPerMultiprocessor(&per_cu, (const void*)fwd_megakernel, NTHREADS, LDS_BYTES);
        if (per_cu < 1) fprintf(stderr, "occupancy query says %d blocks/CU\n", per_cu);
        (void)hipGetLastError();
        grid_blocks = cus > 0 ? cus : 256;
        if (ws_size < WS_END) { fprintf(stderr, "workspace too small: %zu < %zu\n", ws_size, (size_t)WS_END); grid_blocks = -1; }
        if (n_in != 33) { fprintf(stderr, "expected 33 inputs, got %d\n", n_in); grid_blocks = -1; }
    }
    if (grid_blocks < 0) return;
    if (hipMemsetAsync((unsigned char*)d_ws + OFF_BAR, 0, 8192, stream) != hipSuccess) fprintf(stderr, "memset failed\n");
    Params p{};
    const float** pp = (const float**)&p;
    for (int i = 0; i < 33; ++i) pp[i] = (const float*)d_in[i];
    p.out = (float*)d_out;
    p.ws = (unsigned char*)d_ws;
    void* args[] = {&p};
    hipError_t e = hipLaunchCooperativeKernel((void*)fwd_megakernel, dim3(grid_blocks), dim3(NTHREADS), args, LDS_BYTES, stream);
    if (e != hipSuccess) fprintf(stderr, "cooperative launch failed: %s (grid %d)\n", hipGetErrorString(e), grid_blocks);
}
```

```cpp
#include <hip/hip_runtime.h>
#include <hip/hip_cooperative_groups.h>
#include <cstdio>
#include <cstdint>
namespace cg = cooperative_groups;

typedef unsigned short bf16_t;
typedef short bf16x8 __attribute__((ext_vector_type(8)));
typedef float f32x4 __attribute__((ext_vector_type(4)));

#ifndef PROBE_MASK
#define PROBE_MASK 0
#endif
constexpr int BATCH = 16, SEQ = 2048, CTXL = 256, DM = 1024, DEPTH = 4, DFF = 2816, DIN = 7200;
constexpr int TPB = SEQ + CTXL;
constexpr int MROWS = BATCH * TPB;
constexpr int NTHREADS = 512;
constexpr int LDS_BYTES = 152 * 1024;
constexpr float ALPHA = 1.681792830507429f;
constexpr float QSCALE = 0.10206207261596575f * 1.4426950408889634f;

constexpr size_t WO_IN = 0;
constexpr size_t WO_UQ = WO_IN + (size_t)7296 * 1024;
constexpr size_t WO_UKV = WO_UQ + (size_t)768 * 384;
constexpr size_t WO_OA = WO_UKV + (size_t)1024 * 256;
constexpr size_t WO_OC = WO_OA + (size_t)1024 * 512;
constexpr size_t WO_OR = WO_OC + (size_t)1024 * 512;
constexpr size_t WO_OUT = WO_OR + (size_t)1024 * 512;
constexpr size_t WO_13 = WO_OUT + (size_t)1024 * 1024;
constexpr size_t WO_2 = WO_13 + (size_t)5632 * 1024;
constexpr size_t WO_UP = WO_2 + (size_t)1024 * 2816;
constexpr size_t WO_AUP = WO_UP + (size_t)2 * 512 * 64;
constexpr size_t WO_GUP = WO_AUP + (size_t)2 * 512 * 64;
constexpr size_t W_ELEMS = WO_GUP + (size_t)512 * 128;

constexpr size_t al256(size_t x) { return (x + 255) & ~(size_t)255; }
constexpr size_t OFF_BAR = 0;
constexpr size_t OFF_ZROW = 1024;
constexpr size_t OFF_W = 8192;
constexpr size_t OFF_MODV = al256(OFF_W + W_ELEMS * 2);
constexpr size_t OFF_ROPE = al256(OFF_MODV + (size_t)4 * 17 * 6144 * 4);
constexpr size_t OFF_RSQ = al256(OFF_ROPE + 64 * 8 * 2 * 4);
constexpr size_t OFF_RSKV = al256(OFF_RSQ + (size_t)MROWS * 4);
constexpr size_t OFF_STATS = al256(OFF_RSKV + (size_t)MROWS * 4);
constexpr size_t OFF_XC = al256(OFF_STATS + (size_t)MROWS * 8);
constexpr size_t OFF_R1 = al256(OFF_XC + (size_t)BATCH * CTXL * DM * 4);
constexpr size_t OFF_R2 = al256(OFF_R1 + (size_t)MROWS * 672 * 2);
constexpr size_t OFF_R3 = OFF_R2 + (size_t)MROWS * 1536 * 2;
constexpr size_t OFF_R4 = al256(OFF_R3 + (size_t)MROWS * 1920 * 2);
constexpr size_t OFF_R5 = al256(OFF_R4 + (size_t)MROWS * (512 + 512 + 32) * 2);
constexpr size_t OFF_R6 = al256(OFF_R5 + (size_t)MROWS * 512 * 2);
constexpr size_t WS_END = al256(OFF_R6 + (size_t)MROWS * 1024 * 2);
constexpr size_t OFF_Q = OFF_R2;
constexpr size_t OFF_YF = OFF_R2 + (size_t)MROWS * 768 * 2;
constexpr size_t OFF_SG = OFF_YF + (size_t)MROWS * 512 * 2;
constexpr size_t OFF_YB = OFF_R1;
constexpr size_t OFF_KN = OFF_R4;
constexpr size_t OFF_VT = OFF_R4 + (size_t)MROWS * 512 * 2;
constexpr size_t OFF_KR = OFF_VT + (size_t)MROWS * 512 * 2;
constexpr size_t OFF_RWO = OFF_R4;
constexpr size_t OFF_MRG = OFF_R3;
constexpr size_t OFF_HF = OFF_R2;
static_assert(OFF_SG + (size_t)MROWS * 128 * 2 <= OFF_R3, "R2 overlay overflow");
static_assert((size_t)MROWS * 2816 * 2 <= OFF_R4 - OFF_R2, "HF overflow");

struct Params {
    const float *x, *c, *ctx, *c_ctx, *mod_w, *mod_b, *w_in, *q_norm, *w_uq, *kv_norm, *w_ukv, *w_o_attn,
        *conv_w, *w_o_conv, *rw_mu, *rw_w0, *rw_w_up, *rw_a0, *rw_a_up, *rw_g_up, *rw_k_k, *rw_k_a,
        *rw_r_k, *rw_gn_g, *rw_gn_b, *w_o_rwkv, *w_out, *ln1_g, *ln1_b, *ffn_w13, *ffn_w2, *ln2_g, *ln2_b;
    float* out;
    unsigned char* ws;
};

typedef __attribute__((address_space(1))) unsigned char gchar_t;
typedef __attribute__((address_space(1))) float gfloat_t;
__device__ __forceinline__ Params launder(const Params& a) {
    Params q = a;
    unsigned long long w = (unsigned long long)a.ws, o = (unsigned long long)a.out;
    unsigned wl = __builtin_amdgcn_readfirstlane((unsigned)w), wh = __builtin_amdgcn_readfirstlane((unsigned)(w >> 32));
    unsigned ol = __builtin_amdgcn_readfirstlane((unsigned)o), oh = __builtin_amdgcn_readfirstlane((unsigned)(o >> 32));
    asm volatile("" : "+s"(wl), "+s"(wh), "+s"(ol), "+s"(oh));
    w = ((unsigned long long)wh << 32) | wl; o = ((unsigned long long)oh << 32) | ol;
    q.ws = (unsigned char*)(gchar_t*)w; q.out = (float*)(gfloat_t*)o;
    return q;
}
__device__ __forceinline__ int launder_i(int v) { v = __builtin_amdgcn_readfirstlane(v); asm volatile("" : "+s"(v)); return v; }
__device__ __forceinline__ int ltid() { int t = threadIdx.x; asm volatile("" : "+v"(t)); return t; }
__device__ __forceinline__ unsigned pk_bf16(float lo, float hi) { unsigned r; asm("v_cvt_pk_bf16_f32 %0, %1, %2" : "=v"(r) : "v"(lo), "v"(hi)); return r; }
__device__ __forceinline__ float bf_lo(unsigned u) { return __uint_as_float(u << 16); }
__device__ __forceinline__ float bf_hi(unsigned u) { return __uint_as_float(u & 0xffff0000u); }
__device__ __forceinline__ float bf1(bf16_t h) { return __uint_as_float(((unsigned)h) << 16); }
__device__ __forceinline__ float x32sum(float x) { unsigned u = __float_as_uint(x); auto r = __builtin_amdgcn_permlane32_swap(u, u, false, false); return __uint_as_float(r[0]) + __uint_as_float(r[1]); }
__device__ __forceinline__ float x16sum(float x) { unsigned u = __float_as_uint(x); auto r = __builtin_amdgcn_permlane16_swap(u, u, false, false); return __uint_as_float(r[0]) + __uint_as_float(r[1]); }
__device__ __forceinline__ float x32max(float x) { unsigned u = __float_as_uint(x); auto r = __builtin_amdgcn_permlane32_swap(u, u, false, false); return fmaxf(__uint_as_float(r[0]), __uint_as_float(r[1])); }
__device__ __forceinline__ float x16max(float x) { unsigned u = __float_as_uint(x); auto r = __builtin_amdgcn_permlane16_swap(u, u, false, false); return fmaxf(__uint_as_float(r[0]), __uint_as_float(r[1])); }
__device__ __forceinline__ float fqsum(float x) { return x16sum(x32sum(x)); }
__device__ __forceinline__ float fqmax(float x) { return x16max(x32max(x)); }

template <int CTRL> __device__ __forceinline__ float dpp_add(float x) { return x + __uint_as_float((unsigned)__builtin_amdgcn_update_dpp(0, (int)__float_as_uint(x), CTRL, 0xf, 0xf, true)); }
__device__ __forceinline__ float red8(float x) { x = dpp_add<0xB1>(x); x = dpp_add<0x4E>(x); x = dpp_add<0x141>(x); return x; }
__device__ __forceinline__ float xor32_get(float x, int lane) { const unsigned u = __float_as_uint(x); auto r = __builtin_amdgcn_permlane32_swap(u, u, false, false); return __uint_as_float(lane < 32 ? r[1] : r[0]); }
__device__ __forceinline__ float xor8_get(float x) { return __uint_as_float((unsigned)__builtin_amdgcn_update_dpp(0, (int)__float_as_uint(x), 0x128, 0xf, 0xf, true)); }
__device__ __forceinline__ float wave_sum(float v) { v = dpp_add<0xB1>(v); v = dpp_add<0x4E>(v); v = dpp_add<0x141>(v); v = dpp_add<0x140>(v); return fqsum(v); }
__device__ __forceinline__ uint4 widen16(uint2 a, uint2 b) {
    auto r0 = __builtin_amdgcn_permlane16_swap(a.x, b.x, false, false);
    auto r1 = __builtin_amdgcn_permlane16_swap(a.y, b.y, false, false);
    return make_uint4(r0[0], r1[0], r0[1], r1[1]);
}
__device__ __forceinline__ float fexp(float x) { return __builtin_amdgcn_exp2f(x * 1.4426950408889634f); }
__device__ __forceinline__ float sigmoidf_(float x) { return __builtin_amdgcn_rcpf(1.0f + fexp(-x)); }
__device__ __forceinline__ float siluf_(float x) { return x * __builtin_amdgcn_rcpf(1.0f + fexp(-x)); }

__device__ __forceinline__ const float* x_rd(const Params& p, bool from_input, int b, int pp) {
    if (pp < CTXL) return (from_input ? p.ctx : (const float*)(p.ws + OFF_XC)) + ((size_t)b * CTXL + pp) * DM;
    return (from_input ? p.x : (const float*)p.out) + ((size_t)b * SEQ + (pp - CTXL)) * DM;
}
__device__ __forceinline__ float* x_wr(const Params& p, int b, int pp) {
    if (pp < CTXL) return (float*)(p.ws + OFF_XC) + ((size_t)b * CTXL + pp) * DM;
    return p.out + ((size_t)b * SEQ + (pp - CTXL)) * DM;
}
__device__ __forceinline__ const float* modv_ptr(const Params& p, int l, int b, int pp) {
    const int mr = pp < CTXL ? 16 : b;
    return (const float*)(p.ws + OFF_MODV) + ((size_t)l * 17 + mr) * 6144;
}

__device__ __forceinline__ void grid_barrier(unsigned* bar, unsigned& epoch) {
    asm volatile("s_waitcnt vmcnt(0) lgkmcnt(0)" ::: "memory");
    __syncthreads();
    epoch += 1;
    if (threadIdx.x == 0) {
        __builtin_amdgcn_fence(__ATOMIC_RELEASE, "agent");
        asm volatile("s_waitcnt vmcnt(0)" ::: "memory");
        const unsigned old = __hip_atomic_fetch_add(bar, 1u, __ATOMIC_RELAXED, __HIP_MEMORY_SCOPE_AGENT);
        if (old + 1u == epoch * gridDim.x) {
            __hip_atomic_store(bar + 64, epoch, __ATOMIC_RELAXED, __HIP_MEMORY_SCOPE_AGENT);
        } else {
            while (__hip_atomic_load(bar + 64, __ATOMIC_RELAXED, __HIP_MEMORY_SCOPE_AGENT) < epoch) __builtin_amdgcn_s_sleep(1);
        }
        __builtin_amdgcn_fence(__ATOMIC_ACQUIRE, "agent");
        asm volatile("s_waitcnt vmcnt(0)" ::: "memory");
    }
    __syncthreads();
}

#define LDS_AS __attribute__((address_space(3)))
#define GLB_AS __attribute__((address_space(1)))
template <int MT, int SWAPMODE>
__device__ __forceinline__ void gemm_mainloop(f32x4 (&acc)[MT][4], const bf16_t* __restrict__ A, int lda, int a_kstep,
                                              const bf16_t* __restrict__ Bt, int ldb, int nk, unsigned char* lds, int tid) {
    constexpr int BMr = 64 * MT;
    constexpr int STAGE = (BMr + 128) * 128;
    const int wid = __builtin_amdgcn_readfirstlane(tid >> 6), lane = tid & 63, wr = wid >> 1, wc = wid & 1, fr = lane & 15, fq = lane >> 4;
    const int lrow = 8 * wid + (lane >> 3);
    const int lch = (lane & 7) ^ ((4 * wid + (lane >> 4)) & 7);
    const bf16_t* ap = A + (size_t)lrow * lda + lch * 8;
    const bf16_t* bp = Bt + (size_t)lrow * ldb + lch * 8;
    auto issue = [&](int kt, int st) {
        unsigned char* base = lds + st * STAGE + wid * 1024;
#pragma unroll
        for (int i = 0; i < MT; ++i)
            __builtin_amdgcn_global_load_lds((const GLB_AS unsigned*)(ap + (size_t)i * 64 * lda + (size_t)kt * a_kstep), (LDS_AS unsigned*)(base + i * 8192), 16, 0, 0);
#pragma unroll
        for (int i = 0; i < 2; ++i)
            __builtin_amdgcn_global_load_lds((const GLB_AS unsigned*)(bp + (size_t)i * 64 * ldb + (size_t)kt * 64), (LDS_AS unsigned*)(base + (BMr + i * 64) * 128), 16, 0, 0);
    };
    const bool sw = (SWAPMODE == 1) || (SWAPMODE == 2 && wc == 0);
    const int sz = fr >> 1;
    constexpr int NL = MT + 2;
    const bool late = wid >= 4;
    issue(0, 0);
    if (nk > 1) { issue(1, 1); asm volatile("s_waitcnt vmcnt(%0)" ::"n"(NL) : "memory"); }
    else asm volatile("s_waitcnt vmcnt(0)" ::: "memory");
    __builtin_amdgcn_s_barrier();
    asm volatile("" ::: "memory");
    int st = 0;
    for (int kt = 0; kt < nk; ++kt) {
        const int st2 = st >= 1 ? st - 1 : 2;
        if (!late && kt + 2 < nk) issue(kt + 2, st2);
        const unsigned char* As = lds + st * STAGE;
        const unsigned char* Bs = As + BMr * 128;
#pragma unroll
        for (int ks = 0; ks < 2; ++ks) {
            bf16x8 af[MT], bfr[4];
            const int co = ((ks * 4 + fq) ^ sz) * 16;
#pragma unroll
            for (int m = 0; m < MT; ++m) af[m] = *(const bf16x8*)(As + (wr * 16 * MT + m * 16 + fr) * 128 + co);
#pragma unroll
            for (int n = 0; n < 4; ++n) bfr[n] = *(const bf16x8*)(Bs + (wc * 64 + n * 16 + fr) * 128 + co);
            if (sw) {
#pragma unroll
                for (int m = 0; m < MT; ++m)
#pragma unroll
                    for (int n = 0; n < 4; ++n) acc[m][n] = __builtin_amdgcn_mfma_f32_16x16x32_bf16(bfr[n], af[m], acc[m][n], 0, 0, 0);
            } else {
#pragma unroll
                for (int m = 0; m < MT; ++m)
#pragma unroll
                    for (int n = 0; n < 4; ++n) acc[m][n] = __builtin_amdgcn_mfma_f32_16x16x32_bf16(af[m], bfr[n], acc[m][n], 0, 0, 0);
            }
        }
        if (late && kt + 2 < nk) issue(kt + 2, st2);
        if (kt + 2 < nk) asm volatile("s_waitcnt vmcnt(%0) lgkmcnt(0)" ::"n"(NL) : "memory");
        else asm volatile("s_waitcnt vmcnt(0) lgkmcnt(0)" ::: "memory");
        __builtin_amdgcn_s_barrier();
        asm volatile("" ::: "memory");
        st = st == 2 ? 0 : st + 1;
    }
}
__device__ __forceinline__ void gemm_mainloop256(f32x4 (&acc)[8][4], const bf16_t* __restrict__ A, int lda,
                                                 const bf16_t* __restrict__ Bt, int ldb, int nk, unsigned char* lds, int tid) {
    constexpr int STAGE = 512 * 128;
    const int wid = __builtin_amdgcn_readfirstlane(tid >> 6), lane = tid & 63, wr = wid >> 2, wc = wid & 3, fr = lane & 15, fq = lane >> 4;
    const int lrow = 8 * wid + (lane >> 3);
    const int lch = (lane & 7) ^ ((4 * wid + (lane >> 4)) & 7);
    const bf16_t* ap = A + (size_t)lrow * lda + lch * 8;
    const bf16_t* bp = Bt + (size_t)lrow * ldb + lch * 8;
    auto issue = [&](int kt, int st) {
        unsigned char* base = lds + st * STAGE + wid * 1024;
#pragma unroll
        for (int i = 0; i < 4; ++i)
            __builtin_amdgcn_global_load_lds((const GLB_AS unsigned*)(ap + (size_t)i * 64 * lda + (size_t)kt * 64), (LDS_AS unsigned*)(base + i * 8192), 16, 0, 0);
#pragma unroll
        for (int i = 0; i < 4; ++i)
            __builtin_amdgcn_global_load_lds((const GLB_AS unsigned*)(bp + (size_t)i * 64 * ldb + (size_t)kt * 64), (LDS_AS unsigned*)(base + (256 + i * 64) * 128), 16, 0, 0);
    };
    const int sz = fr >> 1;
    const bool late = wid >= 4;
    issue(0, 0);
    asm volatile("s_waitcnt vmcnt(0)" ::: "memory");
    __builtin_amdgcn_s_barrier();
    asm volatile("" ::: "memory");
    for (int kt = 0; kt < nk; ++kt) {
        if (!late && kt + 1 < nk) issue(kt + 1, (kt + 1) & 1);
        const unsigned char* As = lds + (kt & 1) * STAGE;
        const unsigned char* Bs = As + 256 * 128;
#pragma unroll
        for (int ks = 0; ks < 2; ++ks) {
            if (ks == 1 && late && kt + 1 < nk) issue(kt + 1, (kt + 1) & 1);
            bf16x8 af[8], bfr[4];
            const int co = ((ks * 4 + fq) ^ sz) * 16;
#pragma unroll
            for (int m = 0; m < 8; ++m) af[m] = *(const bf16x8*)(As + (wr * 128 + m * 16 + fr) * 128 + co);
#pragma unroll
            for (int n = 0; n < 4; ++n) bfr[n] = *(const bf16x8*)(Bs + (wc * 64 + n * 16 + fr) * 128 + co);
#pragma unroll
            for (int m = 0; m < 8; ++m)
#pragma unroll
                for (int n = 0; n < 4; ++n) acc[m][n] = __builtin_amdgcn_mfma_f32_16x16x32_bf16(bfr[n], af[m], acc[m][n], 0, 0, 0);
        }
        asm volatile("s_waitcnt vmcnt(0) lgkmcnt(0)" ::: "memory");
        __builtin_amdgcn_s_barrier();
        asm volatile("" ::: "memory");
    }
}
struct Seg { const bf16_t* A; const bf16_t* Bt; int lda, a_kstep, ldb, nk; };
template <int MT, int SWAPMODE>
__device__ __forceinline__ void gemm_stream(f32x4 (&acc)[MT][4], const Seg& cur, const Seg& nxt, bool has_next, bool first, int& st,
                                            unsigned char* lds, int tid) {
    constexpr int BMr = 64 * MT;
    constexpr int STAGE = (BMr + 128) * 128;
    constexpr int NL = MT + 2;
    const int wid = __builtin_amdgcn_readfirstlane(tid >> 6), lane = tid & 63, wr = wid >> 1, wc = wid & 1, fr = lane & 15, fq = lane >> 4;
    const int lrow = 8 * wid + (lane >> 3);
    const int lch = (lane & 7) ^ ((4 * wid + (lane >> 4)) & 7);
    const bf16_t* apc = cur.A + (size_t)lrow * cur.lda + lch * 8;
    const bf16_t* bpc = cur.Bt + (size_t)lrow * cur.ldb + lch * 8;
    const bf16_t* apn = nxt.A + (size_t)lrow * nxt.lda + lch * 8;
    const bf16_t* bpn = nxt.Bt + (size_t)lrow * nxt.ldb + lch * 8;
    auto issue = [&](const bf16_t* ap, const bf16_t* bp, int lda, int ldb, int koffa, int koffb, int slot) {
        unsigned char* base = lds + slot * STAGE + wid * 1024;
#pragma unroll
        for (int i = 0; i < MT; ++i)
            __builtin_amdgcn_global_load_lds((const GLB_AS unsigned*)(ap + (size_t)i * 64 * lda + koffa), (LDS_AS unsigned*)(base + i * 8192), 16, 0, 0);
#pragma unroll
        for (int i = 0; i < 2; ++i)
            __builtin_amdgcn_global_load_lds((const GLB_AS unsigned*)(bp + (size_t)i * 64 * ldb + koffb), (LDS_AS unsigned*)(base + (BMr + i * 64) * 128), 16, 0, 0);
    };
    const bool sw = (SWAPMODE == 1) || (SWAPMODE == 2 && wc == 0);
    const int sz = fr >> 1;
    const bool late = wid >= 4;
    const int nk = cur.nk;
    int s0 = st;
    if (first) {
        const int s1 = s0 == 2 ? 0 : s0 + 1;
        issue(apc, bpc, cur.lda, cur.ldb, 0, 0, s0);
        issue(apc, bpc, cur.lda, cur.ldb, cur.a_kstep, 64, s1);
        asm volatile("s_waitcnt vmcnt(%0)" ::"n"(NL) : "memory");
        __builtin_amdgcn_s_barrier();
        asm volatile("" ::: "memory");
    }
    for (int kt = 0; kt < nk; ++kt) {
        const int s2 = s0 >= 1 ? s0 - 1 : 2;
        const int idx = kt + 2;
        const bool incur = idx < nk, doi = incur || has_next;
        if (!late && doi) { if (incur) issue(apc, bpc, cur.lda, cur.ldb, idx * cur.a_kstep, idx * 64, s2); else issue(apn, bpn, nxt.lda, nxt.ldb, (idx - nk) * nxt.a_kstep, (idx - nk) * 64, s2); }
        const unsigned char* As = lds + s0 * STAGE;
        const unsigned char* Bs = As + BMr * 128;
#pragma unroll
        for (int ks = 0; ks < 2; ++ks) {
            bf16x8 af[MT], bfr[4];
            const int co = ((ks * 4 + fq) ^ sz) * 16;
#pragma unroll
            for (int m = 0; m < MT; ++m) af[m] = *(const bf16x8*)(As + (wr * 16 * MT + m * 16 + fr) * 128 + co);
#pragma unroll
            for (int n = 0; n < 4; ++n) bfr[n] = *(const bf16x8*)(Bs + (wc * 64 + n * 16 + fr) * 128 + co);
            if (sw) {
#pragma unroll
                for (int m = 0; m < MT; ++m)
#pragma unroll
                    for (int n = 0; n < 4; ++n) acc[m][n] = __builtin_amdgcn_mfma_f32_16x16x32_bf16(bfr[n], af[m], acc[m][n], 0, 0, 0);
            } else {
#pragma unroll
                for (int m = 0; m < MT; ++m)
#pragma unroll
                    for (int n = 0; n < 4; ++n) acc[m][n] = __builtin_amdgcn_mfma_f32_16x16x32_bf16(af[m], bfr[n], acc[m][n], 0, 0, 0);
            }
        }
        if (late && doi) { if (incur) issue(apc, bpc, cur.lda, cur.ldb, idx * cur.a_kstep, idx * 64, s2); else issue(apn, bpn, nxt.lda, nxt.ldb, (idx - nk) * nxt.a_kstep, (idx - nk) * 64, s2); }
        if (doi) asm volatile("s_waitcnt vmcnt(%0) lgkmcnt(0)" ::"n"(NL) : "memory");
        else asm volatile("s_waitcnt vmcnt(0) lgkmcnt(0)" ::: "memory");
        __builtin_amdgcn_s_barrier();
        asm volatile("" ::: "memory");
        s0 = s0 == 2 ? 0 : s0 + 1;
    }
    st = s0;
}
__device__ __forceinline__ void gemm_stream256(f32x4 (&acc)[8][4], const Seg& cur, const Seg& nxt, bool has_next, bool first, int& st, unsigned char* lds, int tid) {
    constexpr int STAGE = 512 * 128;
    const int wid = __builtin_amdgcn_readfirstlane(tid >> 6), lane = tid & 63, wr = wid >> 2, wc = wid & 3, fr = lane & 15, fq = lane >> 4;
    const int lrow = 8 * wid + (lane >> 3);
    const int lch = (lane & 7) ^ ((4 * wid + (lane >> 4)) & 7);
    const bf16_t* apc = cur.A + (size_t)lrow * cur.lda + lch * 8;
    const bf16_t* bpc = cur.Bt + (size_t)lrow * cur.ldb + lch * 8;
    const bf16_t* apn = nxt.A + (size_t)lrow * nxt.lda + lch * 8;
    const bf16_t* bpn = nxt.Bt + (size_t)lrow * nxt.ldb + lch * 8;
    auto issue = [&](const bf16_t* ap, const bf16_t* bp, int lda, int ldb, int koff, int slot) {
        unsigned char* base = lds + slot * STAGE + wid * 1024;
#pragma unroll
        for (int i = 0; i < 4; ++i)
            __builtin_amdgcn_global_load_lds((const GLB_AS unsigned*)(ap + (size_t)i * 64 * lda + koff), (LDS_AS unsigned*)(base + i * 8192), 16, 0, 0);
#pragma unroll
        for (int i = 0; i < 4; ++i)
            __builtin_amdgcn_global_load_lds((const GLB_AS unsigned*)(bp + (size_t)i * 64 * ldb + koff), (LDS_AS unsigned*)(base + (256 + i * 64) * 128), 16, 0, 0);
    };
    const int sz = fr >> 1;
    const bool late = wid >= 4;
    const int nk = cur.nk;
    int s0 = st;
    if (first) {
        issue(apc, bpc, cur.lda, cur.ldb, 0, s0);
        asm volatile("s_waitcnt vmcnt(0)" ::: "memory");
        __builtin_amdgcn_s_barrier();
        asm volatile("" ::: "memory");
    }
    for (int kt = 0; kt < nk; ++kt) {
        const int idx = kt + 1;
        const bool incur = idx < nk, doi = incur || has_next;
        if (!late && doi) { if (incur) issue(apc, bpc, cur.lda, cur.ldb, idx * 64, s0 ^ 1); else issue(apn, bpn, nxt.lda, nxt.ldb, 0, s0 ^ 1); }
        const unsigned char* As = lds + s0 * STAGE;
        const unsigned char* Bs = As + 256 * 128;
#pragma unroll
        for (int ks = 0; ks < 2; ++ks) {
            if (ks == 1 && late && doi) { if (incur) issue(apc, bpc, cur.lda, cur.ldb, idx * 64, s0 ^ 1); else issue(apn, bpn, nxt.lda, nxt.ldb, 0, s0 ^ 1); }
            bf16x8 af[8], bfr[4];
            const int co = ((ks * 4 + fq) ^ sz) * 16;
#pragma unroll
            for (int m = 0; m < 8; ++m) af[m] = *(const bf16x8*)(As + (wr * 128 + m * 16 + fr) * 128 + co);
#pragma unroll
            for (int n = 0; n < 4; ++n) bfr[n] = *(const bf16x8*)(Bs + (wc * 64 + n * 16 + fr) * 128 + co);
#pragma unroll
            for (int m = 0; m < 8; ++m)
#pragma unroll
                for (int n = 0; n < 4; ++n) acc[m][n] = __builtin_amdgcn_mfma_f32_16x16x32_bf16(bfr[n], af[m], acc[m][n], 0, 0, 0);
        }
        asm volatile("s_waitcnt vmcnt(0) lgkmcnt(0)" ::: "memory");
        __builtin_amdgcn_s_barrier();
        asm volatile("" ::: "memory");
        s0 ^= 1;
    }
    st = s0;
}
__device__ __forceinline__ void gemm_gate3(f32x4 (&g)[3][2][4], const bf16_t* __restrict__ A, const bf16_t* __restrict__ Bt0, int nk, unsigned char* lds, int tid) {
    constexpr int STAGE = 512 * 128;
    const int wid = __builtin_amdgcn_readfirstlane(tid >> 6), lane = tid & 63, wr = wid >> 1, wc = wid & 1, fr = lane & 15, fq = lane >> 4;
    const int lrow = 8 * wid + (lane >> 3);
    const int lch = (lane & 7) ^ ((4 * wid + (lane >> 4)) & 7);
    const unsigned loff = (unsigned)(lrow * 1024 + lch * 8);
    auto issue = [&](int kt, int stg) {
        unsigned char* base = lds + stg * STAGE + wid * 1024;
#pragma unroll
        for (int i = 0; i < 2; ++i)
            __builtin_amdgcn_global_load_lds((const GLB_AS unsigned*)((A + (size_t)i * 64 * 1024 + (size_t)kt * 64) + loff), (LDS_AS unsigned*)(base + i * 8192), 16, 0, 0);
#pragma unroll
        for (int j = 0; j < 6; ++j)
            __builtin_amdgcn_global_load_lds((const GLB_AS unsigned*)((Bt0 + ((size_t)(j >> 1) * 1024 + (j & 1) * 64) * 1024 + (size_t)kt * 64) + loff), (LDS_AS unsigned*)(base + (128 + j * 64) * 128), 16, 0, 0);
    };
    const int sz = fr >> 1;
    const bool late = wid >= 4;
    issue(0, 0);
    asm volatile("s_waitcnt vmcnt(0)" ::: "memory");
    __builtin_amdgcn_s_barrier();
    asm volatile("" ::: "memory");
    for (int kt = 0; kt < nk; ++kt) {
        if (!late && kt + 1 < nk) issue(kt + 1, (kt + 1) & 1);
        const unsigned char* As = lds + (kt & 1) * STAGE;
        const unsigned char* Bs = As + 128 * 128;
#pragma unroll
        for (int ks = 0; ks < 2; ++ks) {
            if (ks == 1 && late && kt + 1 < nk) issue(kt + 1, (kt + 1) & 1);
            const int co = ((ks * 4 + fq) ^ sz) * 16;
            bf16x8 af[2];
#pragma unroll
            for (int m = 0; m < 2; ++m) af[m] = *(const bf16x8*)(As + (wr * 32 + m * 16 + fr) * 128 + co);
#pragma unroll
            for (int i = 0; i < 3; ++i) {
                bf16x8 bfr[4];
#pragma unroll
                for (int n = 0; n < 4; ++n) bfr[n] = *(const bf16x8*)(Bs + (i * 128 + wc * 64 + n * 16 + fr) * 128 + co);
#pragma unroll
                for (int m = 0; m < 2; ++m)
#pragma unroll
                    for (int n = 0; n < 4; ++n) g[i][m][n] = __builtin_amdgcn_mfma_f32_16x16x32_bf16(bfr[n], af[m], g[i][m][n], 0, 0, 0);
                if (i < 2) __builtin_amdgcn_sched_barrier(0);
            }
        }
        asm volatile("s_waitcnt vmcnt(0) lgkmcnt(0)" ::: "memory");
        __builtin_amdgcn_s_barrier();
        asm volatile("" ::: "memory");
    }
}
template <int MT> __device__ __forceinline__ void zero_acc(f32x4 (&acc)[MT][4]) {
#pragma unroll
    for (int m = 0; m < MT; ++m)
#pragma unroll
        for (int n = 0; n < 4; ++n) acc[m][n] = (f32x4){0.f, 0.f, 0.f, 0.f};
}
__device__ __forceinline__ void tile_mn(int t, int nN, int& mt, int& nt) { const int per = 16 * nN, g = t / per, w = t % per; mt = g * 16 + (w & 15); nt = w >> 4; }

__device__ __forceinline__ int rowmap(int mode, int n) {
    if (mode == 1) return n < 672 ? n : n + 96;
    if (mode == 2) return n < DFF ? ((n >> 5) * 64 + (n & 31)) : (((n - DFF) >> 5) * 64 + 32 + ((n - DFF) & 31));
    return n;
}
__device__ __forceinline__ void convert_T(const float* __restrict__ src, int K, int N, bf16_t* __restrict__ dst, int mode, const float* __restrict__ ks, unsigned char* lds, int rot) {
    float* tile = (float*)lds;
    const int ntk = K / 64, ntn = (N + 63) / 64, tid = ltid();
    const int start = (blockIdx.x + gridDim.x - (rot % gridDim.x)) % gridDim.x;
    for (int t = start; t < ntk * ntn; t += gridDim.x) {
        const int tk = t % ntk, tn = t / ntk, k0 = tk * 64, n0 = tn * 64;
#pragma unroll
        for (int i = 0; i < 8; ++i) {
            const int kl = (tid >> 6) + 8 * i, nl = tid & 63, n = n0 + nl;
            tile[kl * 65 + nl] = n < N ? src[(size_t)(k0 + kl) * N + n] : 0.f;
        }
        __syncthreads();
        const int kp = (tid & 31) * 2;
        float s0 = 1.f, s1 = 1.f;
        if (ks) { s0 = ks[k0 + kp]; s1 = ks[k0 + kp + 1]; }
#pragma unroll
        for (int i = 0; i < 4; ++i) {
            const int nl = (tid >> 5) + 16 * i, n = n0 + nl;
            if (n < N) *(unsigned*)(dst + (size_t)rowmap(mode, n) * K + k0 + kp) = pk_bf16(tile[kp * 65 + nl] * s0, tile[(kp + 1) * 65 + nl] * s1);
        }
        __syncthreads();
    }
}
__device__ __forceinline__ void convert_layer(const Params& pin, int l, unsigned char* lds) {
    const Params p = launder(pin); l = launder_i(l);
    bf16_t* W = (bf16_t*)(p.ws + OFF_W);
    convert_T(p.w_in + (size_t)l * DM * DIN, DM, DIN, W + WO_IN, 1, nullptr, lds, 0);
    convert_T(p.ffn_w13 + (size_t)l * DM * 2 * DFF, DM, 2 * DFF, W + WO_13, 2, nullptr, lds, 40);
    convert_T(p.ffn_w2 + (size_t)l * DFF * DM, DFF, DM, W + WO_2, 0, nullptr, lds, 80);
    convert_T(p.w_out + (size_t)l * DM * DM, DM, DM, W + WO_OUT, 0, nullptr, lds, 120);
    convert_T(p.w_o_attn + (size_t)l * 512 * DM, 512, DM, W + WO_OA, 0, nullptr, lds, 136);
    convert_T(p.w_o_conv + (size_t)l * 512 * DM, 512, DM, W + WO_OC, 0, nullptr, lds, 8);
    convert_T(p.w_o_rwkv + (size_t)l * 512 * DM, 512, DM, W + WO_OR, 0, nullptr, lds, 136 + 8);
    convert_T(p.w_uq + (size_t)l * 384 * 768, 384, 768, W + WO_UQ, 0, p.q_norm + l * 384, lds, 16);
    convert_T(p.w_ukv + (size_t)l * 256 * 1024, 256, 1024, W + WO_UKV, 0, p.kv_norm + l * 256, lds, 88);
    for (int z = 0; z < 2; ++z) {
        convert_T(p.rw_w_up + ((size_t)l * 2 + z) * 64 * 512, 64, 512, W + WO_UP + (size_t)z * 512 * 64, 0, nullptr, lds, 152 + 8 * z);
        convert_T(p.rw_a_up + ((size_t)l * 2 + z) * 64 * 512, 64, 512, W + WO_AUP + (size_t)z * 512 * 64, 0, nullptr, lds, 168 + 8 * z);
    }
    convert_T(p.rw_g_up + (size_t)l * 128 * 512, 128, 512, W + WO_GUP, 0, nullptr, lds, 184);
}

__device__ __forceinline__ void modv_phase(const Params& pin, unsigned char* lds) {
    const Params p = launder(pin);
    float* s = (float*)lds;
    float* red = s + 17 * 1024;
    const int tid = ltid(), wid = tid >> 6, lane = tid & 63;
    for (int i = tid; i < 17 * 1024; i += NTHREADS) { const int r = i >> 10, k = i & 1023; const float v = r < 16 ? p.c[r * 1024 + k] : p.c_ctx[k]; s[i] = siluf_(v); }
    __syncthreads();
    float* modv = (float*)(p.ws + OFF_MODV);
    for (int g = blockIdx.x; g < 4 * 96; g += gridDim.x) {
        const int l = g / 96, n = (g % 96) * 64 + lane;
        const float* w = p.mod_w + (size_t)l * 1024 * 6144 + n;
        float acc[17];
#pragma unroll
        for (int r = 0; r < 17; ++r) acc[r] = 0.f;
        const int kb = wid * 128;
        for (int k = kb; k < kb + 128; k += 4) {
            const float w0 = w[(size_t)k * 6144], w1 = w[(size_t)(k + 1) * 6144], w2 = w[(size_t)(k + 2) * 6144], w3 = w[(size_t)(k + 3) * 6144];
#pragma unroll
            for (int r = 0; r < 17; ++r) { const f32x4 sv = *(const f32x4*)(s + r * 1024 + k); acc[r] += sv[0] * w0 + sv[1] * w1 + sv[2] * w2 + sv[3] * w3; }
        }
#pragma unroll
        for (int r = 0; r < 17; ++r) red[(wid * 17 + r) * 64 + lane] = acc[r];
        __syncthreads();
        for (int i = tid; i < 17 * 64; i += NTHREADS) {
            const int r = i >> 6, c = i & 63; float v = 0.f;
#pragma unroll
            for (int w8 = 0; w8 < 8; ++w8) v += red[(w8 * 17 + r) * 64 + c];
            const int nn = (g % 96) * 64 + c;
            modv[((size_t)l * 17 + r) * 6144 + nn] = v + p.mod_b[l * 6144 + nn];
        }
        __syncthreads();
    }
    if (blockIdx.x == gridDim.x - 1) {
        float* rope = (float*)(p.ws + OFF_ROPE);
        for (int i = tid; i < 512; i += NTHREADS) {
            const int pos = i >> 3, f = i & 7;
            const float inv = exp2f(-(float)f * (13.287712379549449f / 8.0f));
            const float ang = (float)pos * inv;
            rope[i * 2] = cosf(ang); rope[i * 2 + 1] = sinf(ang);
        }
    }
}

__device__ __forceinline__ void xmod0_phase(const Params& pin) {
    const Params p = launder(pin);
    const int tid = ltid(), wid = tid >> 6, lane = tid & 63;
    bf16_t* xm = (bf16_t*)(p.ws + OFF_R6);
    for (int row = blockIdx.x * 8 + wid; row < MROWS; row += gridDim.x * 8) {
        const int b = row / TPB, pp = row % TPB;
        const float* xp = x_rd(p, true, b, pp);
        const float* mv = modv_ptr(p, 0, b, pp);
#pragma unroll
        for (int i = 0; i < 4; ++i) {
            const int c = i * 256 + lane * 4;
            const f32x4 v = *(const f32x4*)(xp + c), sh = *(const f32x4*)(mv + c), sc = *(const f32x4*)(mv + 1024 + c);
            uint2 o; o.x = pk_bf16(v[0] * (1.f + sc[0]) + sh[0], v[1] * (1.f + sc[1]) + sh[1]); o.y = pk_bf16(v[2] * (1.f + sc[2]) + sh[2], v[3] * (1.f + sc[3]) + sh[3]);
            *(uint2*)(xm + (size_t)row * 1024 + c) = o;
        }
    }
}

__device__ __forceinline__ void p1_phase(const Params& pin, unsigned char* lds) {
    const Params p = launder(pin); const int tid = ltid();
    const bf16_t* A = (const bf16_t*)(p.ws + OFF_R6);
    const bf16_t* W = (const bf16_t*)(p.ws + OFF_W) + WO_IN;
    const int lane = tid & 63, wid = tid >> 6, wr = wid >> 2, wc = wid & 3, fr = lane & 15, fq = lane >> 4;
    auto seg = [&](int t) { int mt, nt; tile_mn(t, 17, mt, nt); Seg g; g.A = A + (size_t)mt * 256 * 1024; g.Bt = W + (size_t)nt * 256 * 1024; g.lda = 1024; g.a_kstep = 64; g.ldb = 1024; g.nk = 16; return g; };
    int st = 0; bool first = true;
    for (int t = blockIdx.x; t < 144 * 17; t += gridDim.x) {
        int mt, nt; tile_mn(t, 17, mt, nt);
        const int tn = t + gridDim.x; const bool hn = tn < 144 * 17;
        f32x4 acc[8][4]; zero_acc<8>(acc);
        gemm_stream256(acc, seg(t), seg(hn ? tn : t), hn, first, st, lds, tid); first = false;
        bf16_t* dst; int ld, cb, lim;
        if (nt < 3) { dst = (bf16_t*)(p.ws + OFF_R1); ld = 672; cb = nt * 256; lim = 672; }
        else if (nt < 9) { dst = (bf16_t*)(p.ws + OFF_R2); ld = 1536; cb = (nt - 3) * 256; lim = 1536; }
        else { dst = (bf16_t*)(p.ws + OFF_R3); ld = 1920; cb = (nt - 9) * 256; lim = 1920; }
#pragma unroll
        for (int m = 0; m < 8; ++m) {
            const size_t row = (size_t)mt * 256 + wr * 128 + m * 16 + fr;
#pragma unroll
            for (int n = 0; n < 4; n += 2) {
                uint2 a, b2;
                a.x = pk_bf16(acc[m][n][0], acc[m][n][1]); a.y = pk_bf16(acc[m][n][2], acc[m][n][3]);
                b2.x = pk_bf16(acc[m][n + 1][0], acc[m][n + 1][1]); b2.y = pk_bf16(acc[m][n + 1][2], acc[m][n + 1][3]);
                const uint4 w = widen16(a, b2);
                const int col = cb + wc * 64 + (n + (fq & 1)) * 16 + (fq >> 1) * 8;
                if (col < lim) *(uint4*)(dst + row * ld + col) = w;
            }
        }
    }
}

__device__ __forceinline__ void unpack8(const uint4 u, float (&f)[8]) {
    f[0] = bf_lo(u.x); f[1] = bf_hi(u.x); f[2] = bf_lo(u.y); f[3] = bf_hi(u.y); f[4] = bf_lo(u.z); f[5] = bf_hi(u.z); f[6] = bf_lo(u.w); f[7] = bf_hi(u.w);
}
__device__ __forceinline__ void p2a_phase(const Params& pin, int l) {
    const Params p = launder(pin); l = launder_i(l);
    const int tid = ltid(), wid = tid >> 6, lane = tid & 63;
    const bf16_t* Hm = (const bf16_t*)(p.ws + OFF_R1);
    const bf16_t* Hc = (const bf16_t*)(p.ws + OFF_R2);
    bf16_t* CV = (bf16_t*)(p.ws + OFF_R5);
    bf16_t* KR = (bf16_t*)(p.ws + OFF_KR);
    float* RSQ = (float*)(p.ws + OFF_RSQ);
    float* RSKV = (float*)(p.ws + OFF_RSKV);
    const float* rope = (const float*)(p.ws + OFF_ROPE);
    const float* cw = p.conv_w + (size_t)l * 3 * 512;
    const int c0 = lane * 8;
    float w0[8], w1[8], w2[8];
#pragma unroll
    for (int i = 0; i < 8; ++i) { w0[i] = cw[c0 + i]; w1[i] = cw[512 + c0 + i]; w2[i] = cw[1024 + c0 + i]; }
    for (int row = blockIdx.x * 8 + wid; row < MROWS; row += gridDim.x * 8) {
        const int pp = row % TPB;
        const bool hp = (pp != 0 && pp != CTXL), hn = (pp != CTXL - 1 && pp != TPB - 1);
        const bf16_t* hr = Hc + (size_t)row * 1536;
        float ch[8], cc[8], cb[8], u0[8], u1[8], u2[8];
        unpack8(*(const uint4*)(hr + c0), ch); unpack8(*(const uint4*)(hr + 1024 + c0), cc); unpack8(*(const uint4*)(hr + 512 + c0), cb);
#pragma unroll
        for (int i = 0; i < 8; ++i) u1[i] = cc[i] * ch[i];
        if (hp) { unpack8(*(const uint4*)(hr - 1536 + c0), ch); unpack8(*(const uint4*)(hr - 1536 + 1024 + c0), cc);
#pragma unroll
            for (int i = 0; i < 8; ++i) u0[i] = cc[i] * ch[i]; }
        else {
#pragma unroll
            for (int i = 0; i < 8; ++i) u0[i] = 0.f; }
        if (hn) { unpack8(*(const uint4*)(hr + 1536 + c0), ch); unpack8(*(const uint4*)(hr + 1536 + 1024 + c0), cc);
#pragma unroll
            for (int i = 0; i < 8; ++i) u2[i] = cc[i] * ch[i]; }
        else {
#pragma unroll
            for (int i = 0; i < 8; ++i) u2[i] = 0.f; }
        float o[8];
#pragma unroll
        for (int i = 0; i < 8; ++i) o[i] = cb[i] * (u0[i] * w0[i] + u1[i] * w1[i] + u2[i] * w2[i]);
        uint4 ov; ov.x = pk_bf16(o[0], o[1]); ov.y = pk_bf16(o[2], o[3]); ov.z = pk_bf16(o[4], o[5]); ov.w = pk_bf16(o[6], o[7]);
        *(uint4*)(CV + (size_t)row * 512 + c0) = ov;
        const bf16_t* hm = Hm + (size_t)row * 672;
        float sq = 0.f, skv = 0.f;
        if (lane < 48) { float f[8]; unpack8(*(const uint4*)(hm + lane * 8), f);
#pragma unroll
            for (int i = 0; i < 8; ++i) sq += f[i] * f[i]; }
        if (lane < 32) { float f[8]; unpack8(*(const uint4*)(hm + 384 + lane * 8), f);
#pragma unroll
            for (int i = 0; i < 8; ++i) skv += f[i] * f[i]; }
        sq = wave_sum(sq); skv = wave_sum(skv);
        if (lane == 0) { RSQ[row] = __builtin_amdgcn_rsqf(sq * (1.0f / 384.0f) + 1e-6f); RSKV[row] = __builtin_amdgcn_rsqf(skv * (1.0f / 256.0f) + 1e-6f); }
        {
            const int j = lane & 31;
            float v = bf1(hm[640 + j]);
            const float other = xor8_get(v);
            if (pp >= CTXL) {
                const int tt = pp - CTXL;
                const int pos = (j < 16) ? (tt >> 6) : (tt & 63);
                const float cs = rope[(pos * 8 + (j & 7)) * 2], sn = rope[(pos * 8 + (j & 7)) * 2 + 1];
                v = (j & 8) ? (other * sn + v * cs) : (v * cs - other * sn);
            }
            if (lane < 32) KR[(size_t)row * 32 + j] = (bf16_t)(pk_bf16(v, v) & 0xffffu);
        }
    }
}

__device__ __forceinline__ void p2b_phase(const Params& pin, int l, unsigned char* lds) {
    const Params p = launder(pin); l = launder_i(l); const int tid = ltid();
    const bf16_t* Hm = (const bf16_t*)(p.ws + OFF_R1);
    const bf16_t* W = (const bf16_t*)(p.ws + OFF_W);
    const float* RSQ = (const float*)(p.ws + OFF_RSQ);
    const float* RSKV = (const float*)(p.ws + OFF_RSKV);
    const float* rope = (const float*)(p.ws + OFF_ROPE);
    bf16_t* Q = (bf16_t*)(p.ws + OFF_Q);
    bf16_t* KN = (bf16_t*)(p.ws + OFF_KN);
    bf16_t* VT = (bf16_t*)(p.ws + OFF_VT);
    const int lane = tid & 63, wid = tid >> 6, wr = wid >> 1, wc = wid & 1, fr = lane & 15, fq = lane >> 4;
    const int NQ = 144 * 6, NKV = 144 * 8;
    for (int t = blockIdx.x; t < NQ + NKV; t += gridDim.x) {
        f32x4 acc[4][4]; zero_acc<4>(acc);
        if (t < NQ) {
            int mt, nt; tile_mn(t, 6, mt, nt);
            gemm_mainloop<4, 1>(acc, Hm + (size_t)mt * 256 * 672, 672, 64, W + WO_UQ + (size_t)nt * 128 * 384, 384, 6, lds, tid);
            const int pp0 = (mt % 9) * 256; const bool latent = pp0 >= CTXL;
#pragma unroll
            for (int m = 0; m < 4; ++m) {
                const int lrow = wr * 64 + m * 16 + fr;
                const size_t row = (size_t)mt * 256 + lrow;
                const float sc = RSQ[row] * QSCALE;
                const int tt = pp0 + lrow - CTXL;
                uint2 qpk[4];
#pragma unroll
                for (int n = 0; n < 4; ++n) {
                    const int c16 = nt * 128 + wc * 64 + n * 16, r96 = c16 % 96;
                    float v[4];
#pragma unroll
                    for (int j = 0; j < 4; ++j) v[j] = acc[m][n][j] * sc;
                    if (latent && r96 >= 64) {
                        const int pos = (r96 == 64) ? (tt >> 6) : (tt & 63);
#pragma unroll
                        for (int j = 0; j < 4; ++j) {
                            const float other = xor32_get(v[j], lane);
                            const int fi = (fq & 1) * 4 + j;
                            const float cs = rope[(pos * 8 + fi) * 2], sn = rope[(pos * 8 + fi) * 2 + 1];
                            v[j] = (fq & 2) ? (other * sn + v[j] * cs) : (v[j] * cs - other * sn);
                        }
                    }
                    qpk[n].x = pk_bf16(v[0], v[1]); qpk[n].y = pk_bf16(v[2], v[3]);
                }
#pragma unroll
                for (int n = 0; n < 4; n += 2)
                    *(uint4*)(Q + row * 768 + nt * 128 + wc * 64 + (n + (fq & 1)) * 16 + (fq >> 1) * 8) = widen16(qpk[n], qpk[n + 1]);
            }
        } else {
            int mt, nt; tile_mn(t - NQ, 8, mt, nt);
            gemm_mainloop<4, 2>(acc, Hm + (size_t)mt * 256 * 672 + 384, 672, 64, W + WO_UKV + (size_t)nt * 128 * 256, 256, 4, lds, tid);
            const int b = mt / 9, pp0 = (mt % 9) * 256;
            if (wc == 0) {
#pragma unroll
                for (int m = 0; m < 4; ++m) {
                    const size_t row = (size_t)mt * 256 + wr * 64 + m * 16 + fr;
                    const float sc = RSKV[row];
#pragma unroll
                    for (int n = 0; n < 4; n += 2) {
                        uint2 a, b2;
                        a.x = pk_bf16(acc[m][n][0] * sc, acc[m][n][1] * sc); a.y = pk_bf16(acc[m][n][2] * sc, acc[m][n][3] * sc);
                        b2.x = pk_bf16(acc[m][n + 1][0] * sc, acc[m][n + 1][1] * sc); b2.y = pk_bf16(acc[m][n + 1][2] * sc, acc[m][n + 1][3] * sc);
                        *(uint4*)(KN + row * 512 + nt * 64 + (n + (fq & 1)) * 16 + (fq >> 1) * 8) = widen16(a, b2);
                    }
                }
            } else {
#pragma unroll
                for (int m = 0; m < 4; ++m) {
                    const int lrow = wr * 64 + m * 16 + fq * 4;
                    const f32x4 sc = *(const f32x4*)(RSKV + (size_t)mt * 256 + lrow);
#pragma unroll
                    for (int n = 0; n < 4; n += 2) {
                        uint2 a, b2;
                        a.x = pk_bf16(acc[m][n][0] * sc[0], acc[m][n][1] * sc[1]); a.y = pk_bf16(acc[m][n][2] * sc[2], acc[m][n][3] * sc[3]);
                        b2.x = pk_bf16(acc[m][n + 1][0] * sc[0], acc[m][n + 1][1] * sc[1]); b2.y = pk_bf16(acc[m][n + 1][2] * sc[2], acc[m][n + 1][3] * sc[3]);
                        const int dv = (n + (fq & 1)) * 16 + fr;
                        *(uint4*)(VT + ((size_t)(b * 8 + nt) * 64 + dv) * TPB + pp0 + wr * 64 + m * 16 + (fq >> 1) * 8) = widen16(a, b2);
                    }
                }
            }
        }
    }
    {
        const bf16_t* Hr = (const bf16_t*)(p.ws + OFF_R3);
        bf16_t* SG = (bf16_t*)(p.ws + OFF_SG);
        const float* mu = p.rw_mu + (size_t)l * 1920 + 1792;
        for (int i = blockIdx.x * NTHREADS + tid; i < MROWS * 16; i += gridDim.x * NTHREADS) {
            const int row = i >> 4, c0 = (i & 15) * 8, pp = row % TPB;
            const bool hp = (pp != 0 && pp != CTXL), hn = (pp != CTXL - 1 && pp != TPB - 1);
            const bf16_t* hr = Hr + (size_t)row * 1920 + 1792 + c0;
            float cur[8], pv[8], nx[8];
            unpack8(*(const uint4*)hr, cur);
            if (hp) unpack8(*(const uint4*)(hr - 1920), pv); else {
#pragma unroll
                for (int k = 0; k < 8; ++k) pv[k] = 0.f; }
            if (hn) unpack8(*(const uint4*)(hr + 1920), nx); else {
#pragma unroll
                for (int k = 0; k < 8; ++k) nx[k] = 0.f; }
            float o[8];
#pragma unroll
            for (int k = 0; k < 8; ++k) o[k] = sigmoidf_(cur[k] + (0.5f * (pv[k] + nx[k]) - cur[k]) * mu[c0 + k]);
            uint4 ov; ov.x = pk_bf16(o[0], o[1]); ov.y = pk_bf16(o[2], o[3]); ov.z = pk_bf16(o[4], o[5]); ov.w = pk_bf16(o[6], o[7]);
            *(uint4*)(SG + (size_t)row * 128 + c0) = ov;
        }
    }
}

#define FMAC_BC(acc, coef, s, J) asm("v_fmac_f32_dpp %0, %1, %2 row_newbcast:" #J " row_mask:0xf bank_mask:0xf" : "+v"(acc) : "v"(coef), "v"(s))
#define MUL_BC(dst, coef, s, J) asm("v_mul_f32_dpp %0, %1, %2 row_newbcast:" #J " row_mask:0xf bank_mask:0xf" : "=v"(dst) : "v"(coef), "v"(s))
#define REP16(X) X(0, 0) X(1, 1) X(2, 2) X(3, 3) X(4, 0) X(5, 1) X(6, 2) X(7, 3) X(8, 0) X(9, 1) X(10, 2) X(11, 3) X(12, 0) X(13, 1) X(14, 2) X(15, 3)
constexpr int FSTR = 6 * 64 + 4;
constexpr int CHUNK = 32, NCHUNK = TPB / CHUNK;

__device__ __forceinline__ int scan_pos(int z, int s) { return z == 0 ? s : (s < CTXL ? (CTXL - 1 - s) : (TPB + CTXL - 1 - s)); }

__device__ __forceinline__ void shift4(const bf16_t* hr, bool hp, bool hn, int col, const float* mu, float (&o)[4]) {
    const uint2 c = *(const uint2*)(hr + col);
    uint2 a = make_uint2(0u, 0u), b = make_uint2(0u, 0u);
    if (hp) a = *(const uint2*)(hr - 1920 + col);
    if (hn) b = *(const uint2*)(hr + 1920 + col);
    const f32x4 m = *(const f32x4*)(mu + col);
    const float cv[4] = {bf_lo(c.x), bf_hi(c.x), bf_lo(c.y), bf_hi(c.y)};
    const float av[4] = {bf_lo(a.x), bf_hi(a.x), bf_lo(a.y), bf_hi(a.y)};
    const float bv[4] = {bf_lo(b.x), bf_hi(b.x), bf_lo(b.y), bf_hi(b.y)};
#pragma unroll
    for (int i = 0; i < 4; ++i) o[i] = cv[i] + (0.5f * (av[i] + bv[i]) - cv[i]) * m[i];
}
__device__ __forceinline__ void shift8(const bf16_t* hr, bool hp, bool hn, int col, const float* mu, float (&o)[8]) {
    float cv[8], av[8], bv[8];
    unpack8(*(const uint4*)(hr + col), cv);
    if (hp) unpack8(*(const uint4*)(hr - 1920 + col), av); else {
#pragma unroll
        for (int i = 0; i < 8; ++i) av[i] = 0.f; }
    if (hn) unpack8(*(const uint4*)(hr + 1920 + col), bv); else {
#pragma unroll
        for (int i = 0; i < 8; ++i) bv[i] = 0.f; }
#pragma unroll
    for (int i = 0; i < 8; ++i) o[i] = cv[i] + (0.5f * (av[i] + bv[i]) - cv[i]) * mu[col + i];
}
__device__ __forceinline__ bf16x8 pack8(const float (&f)[8]) {
    union { uint4 u; bf16x8 v; } r;
    r.u.x = pk_bf16(f[0], f[1]); r.u.y = pk_bf16(f[2], f[3]); r.u.z = pk_bf16(f[4], f[5]); r.u.w = pk_bf16(f[6], f[7]);
    return r.v;
}

struct ProdState { f32x4 aw[4], aa[4]; };
struct Raw3x2 { uint2 c, a, b; };
__device__ __forceinline__ Raw3x2 ld3x2(const bf16_t* pc, const bf16_t* pa, const bf16_t* pb, bool hp, bool hn, int col) {
    Raw3x2 r; r.c = *(const uint2*)(pc + col); r.a = *(const uint2*)(pa + col); r.b = *(const uint2*)(pb + col);
    return r;
}
__device__ __forceinline__ void sh4(const Raw3x2& r, const f32x4 m, float (&o)[4]) {
    const float cv[4] = {bf_lo(r.c.x), bf_hi(r.c.x), bf_lo(r.c.y), bf_hi(r.c.y)};
    const float av[4] = {bf_lo(r.a.x), bf_hi(r.a.x), bf_lo(r.a.y), bf_hi(r.a.y)};
    const float bv[4] = {bf_lo(r.b.x), bf_hi(r.b.x), bf_lo(r.b.y), bf_hi(r.b.y)};
#pragma unroll
    for (int i = 0; i < 4; ++i) o[i] = cv[i] + (0.5f * (av[i] + bv[i]) - cv[i]) * m[i];
}
struct Raw3x4 { uint4 c, a, b; };
__device__ __forceinline__ Raw3x4 ld3x4(const bf16_t* pc, const bf16_t* pa, const bf16_t* pb, bool hp, bool hn, int col) {
    Raw3x4 r; r.c = *(const uint4*)(pc + col); r.a = *(const uint4*)(pa + col); r.b = *(const uint4*)(pb + col);
    return r;
}
__device__ __forceinline__ void sh8(const Raw3x4& r, const float* m, float (&o)[8]) {
    float cv[8], av[8], bv[8];
    unpack8(r.c, cv); unpack8(r.a, av); unpack8(r.b, bv);
    const f32x4 m0 = *(const f32x4*)m, m1 = *(const f32x4*)(m + 4);
#pragma unroll
    for (int i = 0; i < 8; ++i) o[i] = cv[i] + (0.5f * (av[i] + bv[i]) - cv[i]) * (i < 4 ? m0[i] : m1[i - 4]);
}
template <int N0>
__device__ __forceinline__ void scan_produce_elem(const float* pl, int fq, const Raw3x2 (&rr)[2], const Raw3x2 (&rk)[2], const Raw3x2 (&rv)[2],
                                                  const f32x4 (&aw)[2], const f32x4 (&aa)[2], float& ss, float* frow) {
#pragma unroll
    for (int nn = 0; nn < 2; ++nn) {
        const int n = N0 + nn;
        const int c4 = n * 16 + fq * 4;
        float r4[4], k4[4], v4[4];
        sh4(rr[nn], *(const f32x4*)(pl + 0 * 64 + c4), r4);
        sh4(rk[nn], *(const f32x4*)(pl + 1 * 64 + c4), k4);
        sh4(rv[nn], *(const f32x4*)(pl + 2 * 64 + c4), v4);
        const f32x4 w0 = *(const f32x4*)(pl + 3 * 64 + c4);
        const f32x4 a0 = *(const f32x4*)(pl + 4 * 64 + c4);
        const f32x4 kkp = *(const f32x4*)(pl + 5 * 64 + c4);
        const f32x4 kap = *(const f32x4*)(pl + 6 * 64 + c4);
        f32x4 dw, kd, kf4, a4;
#pragma unroll
        for (int j = 0; j < 4; ++j) {
            const float sgx = __builtin_amdgcn_rcpf(1.0f + fexp(-(aw[nn][j] + w0[j])));
            dw[j] = fexp(-0.6065306597126334f * sgx);
            const float a = __builtin_amdgcn_rcpf(1.0f + fexp(-(aa[nn][j] + a0[j])));
            a4[j] = a;
            const float kf = k4[j] * kkp[j];
            kf4[j] = kf; ss += kf * kf;
            kd[j] = k4[j] * (1.0f + (a - 1.0f) * kap[j]);
        }
        *(f32x4*)(frow + 0 * 64 + c4) = kf4;
        *(f32x4*)(frow + 1 * 64 + c4) = dw;
        *(f32x4*)(frow + 2 * 64 + c4) = a4;
        *(f32x4*)(frow + 3 * 64 + c4) = kd;
        *(f32x4*)(frow + 4 * 64 + c4) = (f32x4){r4[0], r4[1], r4[2], r4[3]};
        *(f32x4*)(frow + 5 * 64 + c4) = (f32x4){v4[0], v4[1], v4[2], v4[3]};
    }
}
__device__ __forceinline__ void scan_produce_A(const Params& p, const float* pl, int b, int h, int z, int s0, float* frow0, int lane, ProdState& st) {
    const int fr = lane & 15, fq = lane >> 4;
    const int pp = scan_pos(z, s0 + fr);
    const bool hp = (pp != 0 && pp != CTXL), hn = (pp != CTXL - 1 && pp != TPB - 1);
    const bf16_t* hr = (const bf16_t*)(p.ws + OFF_R3) + ((size_t)b * TPB + pp) * 1920;
    const bf16_t* W = (const bf16_t*)(p.ws + OFF_W);
    Raw3x4 qw[2], qa[2];
    const bf16_t* zr = (const bf16_t*)(p.ws + OFF_ZROW) + z * 64 + fq * 8;
    const bf16_t* pc = hr + z * 64 + fq * 8; const bf16_t* pa = hp ? pc - 1920 : zr; const bf16_t* pb = hn ? pc + 1920 : zr;
#pragma unroll
    for (int ks = 0; ks < 2; ++ks) { qw[ks] = ld3x4(pc, pa, pb, hp, hn, 1536 + ks * 32); qa[ks] = ld3x4(pc, pa, pb, hp, hn, 1664 + ks * 32); }
    f32x4 accw[4], acca[4];
#pragma unroll
    for (int n = 0; n < 4; ++n) { accw[n] = (f32x4){0.f, 0.f, 0.f, 0.f}; acca[n] = (f32x4){0.f, 0.f, 0.f, 0.f}; }
#pragma unroll
    for (int ks = 0; ks < 2; ++ks) {
        bf16x8 bw[4], ba[4];
#pragma unroll
        for (int n = 0; n < 4; ++n) {
            const size_t wo = ((size_t)z * 512 + h * 64 + n * 16 + fr) * 64 + ks * 32 + fq * 8;
            bw[n] = *(const bf16x8*)(W + WO_UP + wo); ba[n] = *(const bf16x8*)(W + WO_AUP + wo);
        }
        float t8[8];
        sh8(qw[ks], pl + 7 * 64 + ks * 32 + fq * 8, t8);
#pragma unroll
        for (int i = 0; i < 8; ++i) { const float e = fexp(2.0f * t8[i]); t8[i] = 1.0f - 2.0f * __builtin_amdgcn_rcpf(e + 1.0f); }
        const bf16x8 aw = pack8(t8);
        sh8(qa[ks], pl + 8 * 64 + ks * 32 + fq * 8, t8);
        const bf16x8 aa = pack8(t8);
#pragma unroll
        for (int n = 0; n < 4; ++n) {
            accw[n] = __builtin_amdgcn_mfma_f32_16x16x32_bf16(bw[n], aw, accw[n], 0, 0, 0);
            acca[n] = __builtin_amdgcn_mfma_f32_16x16x32_bf16(ba[n], aa, acca[n], 0, 0, 0);
        }
    }
#pragma unroll
    for (int n = 0; n < 4; ++n) { st.aw[n] = accw[n]; st.aa[n] = acca[n]; }
}
__device__ __forceinline__ void scan_produce_B(const Params& p, const float* pl, int b, int h, int z, int s0, float* frow0, int lane, const ProdState& st) {
    const int fr = lane & 15, fq = lane >> 4;
    const int pp = scan_pos(z, s0 + fr);
    const bool hp = (pp != 0 && pp != CTXL), hn = (pp != CTXL - 1 && pp != TPB - 1);
    const bf16_t* hr = (const bf16_t*)(p.ws + OFF_R3) + ((size_t)b * TPB + pp) * 1920;
    Raw3x2 rr0[2], rk0[2], rv0[2], rr1[2], rk1[2], rv1[2];
    const bf16_t* zr = (const bf16_t*)(p.ws + OFF_ZROW) + h * 64 + fq * 4;
    const bf16_t* pc = hr + h * 64 + fq * 4; const bf16_t* pa = hp ? pc - 1920 : zr; const bf16_t* pb = hn ? pc + 1920 : zr;
#pragma unroll
    for (int nn = 0; nn < 2; ++nn) {
        const int C4 = nn * 16, C5 = C4 + 32;
        rr0[nn] = ld3x2(pc, pa, pb, hp, hn, C4); rk0[nn] = ld3x2(pc, pa, pb, hp, hn, 512 + C4); rv0[nn] = ld3x2(pc, pa, pb, hp, hn, 1024 + C4);
        rr1[nn] = ld3x2(pc, pa, pb, hp, hn, C5); rk1[nn] = ld3x2(pc, pa, pb, hp, hn, 512 + C5); rv1[nn] = ld3x2(pc, pa, pb, hp, hn, 1024 + C5);
    }
    float ss = 0.f;
    float* frow = frow0 + fr * FSTR;
    const f32x4 w01[2] = {st.aw[0], st.aw[1]}, a01[2] = {st.aa[0], st.aa[1]}, w23[2] = {st.aw[2], st.aw[3]}, a23[2] = {st.aa[2], st.aa[3]};
    scan_produce_elem<0>(pl, fq, rr0, rk0, rv0, w01, a01, ss, frow);
    scan_produce_elem<2>(pl, fq, rr1, rk1, rv1, w23, a23, ss, frow);
    ss = fqsum(ss);
    const float inv = __builtin_amdgcn_rsqf(fmaxf(ss, 1e-24f));
#pragma unroll
    for (int n = 0; n < 4; ++n) {
        const int c4 = n * 16 + fq * 4;
        f32x4 kk = *(const f32x4*)(frow + 0 * 64 + c4);
        f32x4 bb = *(const f32x4*)(frow + 2 * 64 + c4);
#pragma unroll
        for (int j = 0; j < 4; ++j) { kk[j] = kk[j] * inv; bb[j] = kk[j] * bb[j]; }
        *(f32x4*)(frow + 0 * 64 + c4) = kk;
        *(f32x4*)(frow + 2 * 64 + c4) = bb;
    }
}

typedef float f32x2 __attribute__((ext_vector_type(2)));
struct ScanHead { f32x4 kk[2]; f32x2 v; };
struct ScanBody { f32x4 w[2], bb[2], kd[2], r[2]; };
__device__ __forceinline__ void scan_ldh(ScanHead& c, const float* f, const float* fv) {
#pragma unroll
    for (int q = 0; q < 2; ++q) c.kk[q] = *(const f32x4*)(f + 0 * 64 + 4 * q);
    c.v = *(const f32x2*)fv;
}
__device__ __forceinline__ void scan_ldb(ScanBody& c, const float* f) {
#pragma unroll
    for (int q = 0; q < 2; ++q) {
        c.w[q] = *(const f32x4*)(f + 1 * 64 + 4 * q); c.bb[q] = *(const f32x4*)(f + 2 * 64 + 4 * q);
        c.kd[q] = *(const f32x4*)(f + 3 * 64 + 4 * q); c.r[q] = *(const f32x4*)(f + 4 * 64 + 4 * q);
    }
}
__device__ __forceinline__ void scan_unit(const Params& p, int l, int u, unsigned char* lds) {
    const int tid = ltid(), wid = __builtin_amdgcn_readfirstlane(tid >> 6), lane = tid & 63;
    const int b = u >> 4, h = (u >> 1) & 7, z = u & 1;
    float* fb = (float*)lds;
    bf16_t* Y = (bf16_t*)(p.ws + (z == 0 ? OFF_YF : OFF_YB));
    float* pl = fb + 3 * CHUNK * FSTR;
    for (int i = tid; i < 9 * 64; i += NTHREADS) {
        const int a = i >> 6, c = i & 63, C = h * 64 + c;
        float v;
        if (a < 3) v = p.rw_mu[(size_t)l * 1920 + a * 512 + C];
        else if (a == 3) v = p.rw_w0[((size_t)l * 2 + z) * 512 + C];
        else if (a == 4) v = p.rw_a0[((size_t)l * 2 + z) * 512 + C];
        else if (a == 5) v = p.rw_k_k[(size_t)l * 512 + C];
        else if (a == 6) v = p.rw_k_a[(size_t)l * 512 + C];
        else if (a == 7) v = p.rw_mu[(size_t)l * 1920 + 1536 + z * 64 + c];
        else v = p.rw_mu[(size_t)l * 1920 + 1664 + z * 64 + c];
        pl[i] = v;
    }
    __syncthreads();
    if (wid < 4) {
        f32x2 S2[8];
#pragma unroll
        for (int j = 0; j < 8; ++j) S2[j] = (f32x2){0.f, 0.f};
        __syncthreads();
        for (int c = 0; c < NCHUNK; ++c) {
            const float* fbc = fb + (c % 3) * CHUNK * FSTR + 8 * (lane & 7);
            const float* fbv = fb + (c % 3) * CHUNK * FSTR + 320 + 16 * wid + 2 * (lane >> 3);
            bf16_t* yp = Y + ((size_t)b * TPB) * 512 + h * 64 + 16 * wid + 2 * (lane >> 3);
            ScanHead ha, hb;
            scan_ldh(ha, fbc, fbv);
#define SCAN_STEP(HC, HN, SL) { \
                ScanBody bd; scan_ldb(bd, fbc + (SL) * FSTR); \
                if ((SL) + 1 < CHUNK) scan_ldh(HN, fbc + ((SL) + 1) * FSTR, fbv + ((SL) + 1) * FSTR); \
                f32x2 d0 = (f32x2){0.f, 0.f}, d1 = (f32x2){0.f, 0.f}; \
                _Pragma("unroll") for (int q = 0; q < 4; ++q) { const f32x2 k2 = (f32x2){HC.kk[q >> 1][2 * (q & 1)], HC.kk[q >> 1][2 * (q & 1) + 1]}; \
                    d0 = __builtin_elementwise_fma(S2[q], k2, d0); d1 = __builtin_elementwise_fma(S2[4 + q], k2, d1); } \
                const float sk0 = red8(d0[0] + d0[1]), sk1 = red8(d1[0] + d1[1]); \
                const f32x2 n0 = (f32x2){-sk0, -sk0}, n1 = (f32x2){-sk1, -sk1}, v0 = (f32x2){HC.v[0], HC.v[0]}, v1 = (f32x2){HC.v[1], HC.v[1]}; \
                f32x2 y0 = (f32x2){0.f, 0.f}, y1 = (f32x2){0.f, 0.f}; \
                _Pragma("unroll") for (int q = 0; q < 4; ++q) { \
                    const f32x2 w2 = (f32x2){bd.w[q >> 1][2 * (q & 1)], bd.w[q >> 1][2 * (q & 1) + 1]}, b2 = (f32x2){bd.bb[q >> 1][2 * (q & 1)], bd.bb[q >> 1][2 * (q & 1) + 1]}; \
                    const f32x2 kd2 = (f32x2){bd.kd[q >> 1][2 * (q & 1)], bd.kd[q >> 1][2 * (q & 1) + 1]}, r2 = (f32x2){bd.r[q >> 1][2 * (q & 1)], bd.r[q >> 1][2 * (q & 1) + 1]}; \
                    f32x2 t0 = S2[q] * w2; t0 = __builtin_elementwise_fma(b2, n0, t0); t0 = __builtin_elementwise_fma(kd2, v0, t0); \
                    f32x2 t1 = S2[4 + q] * w2; t1 = __builtin_elementwise_fma(b2, n1, t1); t1 = __builtin_elementwise_fma(kd2, v1, t1); \
                    S2[q] = t0; S2[4 + q] = t1; \
                    y0 = __builtin_elementwise_fma(t0, r2, y0); y1 = __builtin_elementwise_fma(t1, r2, y1); } \
                const float ya = red8(y0[0] + y0[1]), yb = red8(y1[0] + y1[1]); \
                const int pp = scan_pos(z, c * CHUNK + (SL)); \
                *(unsigned*)(yp + (size_t)pp * 512) = pk_bf16(ya, yb); }
#pragma unroll 1
            for (int sl = 0; sl < CHUNK; sl += 2) {
                SCAN_STEP(ha, hb, sl)
                SCAN_STEP(hb, ha, sl + 1)
            }
            __syncthreads();
        }
    } else {
        ProdState st;
#pragma unroll
        for (int n = 0; n < 4; ++n) { st.aw[n] = (f32x4){0.f, 0.f, 0.f, 0.f}; st.aa[n] = (f32x4){0.f, 0.f, 0.f, 0.f}; }
        const int nrep = launder_i(1 + ((PROBE_MASK >> 10) & 1));
        const int pair = (wid - 4) >> 1, ph = (wid - 4) & 1;
        {
            float* f0 = fb + (pair % 3) * CHUNK * FSTR + ph * 16 * FSTR;
            scan_produce_A(p, pl, b, h, z, pair * CHUNK + ph * 16, f0, lane, st);
            if (pair == 0) scan_produce_B(p, pl, b, h, z, ph * 16, f0, lane, st);
        }
        __syncthreads();
        for (int c = 0; c < NCHUNK; ++c) {
            for (int rr_ = 0; rr_ < nrep; ++rr_) {
            if (pair == ((c + 1) & 1)) {
                if (c + 1 < NCHUNK) scan_produce_B(p, pl, b, h, z, (c + 1) * CHUNK + ph * 16, fb + ((c + 1) % 3) * CHUNK * FSTR + ph * 16 * FSTR, lane, st);
            } else {
                if (c + 2 < NCHUNK) scan_produce_A(p, pl, b, h, z, (c + 2) * CHUNK + ph * 16, fb + ((c + 2) % 3) * CHUNK * FSTR + ph * 16 * FSTR, lane, st);
            }
            }
            __syncthreads();
        }
    }
}

constexpr int ATT_STAGE = 20480;
__device__ __forceinline__ void attn_unit(const Params& p, int b, int h, int q0, int nkeys, unsigned char* lds, int do_write) {
    const int tid = ltid(), wid = __builtin_amdgcn_readfirstlane(tid >> 6), lane = tid & 63, fr = lane & 15, fq = lane >> 4;
    bf16_t* Q = (bf16_t*)(p.ws + OFF_Q);
    const bf16_t* KN = (const bf16_t*)(p.ws + OFF_KN);
    const bf16_t* KR = (const bf16_t*)(p.ws + OFF_KR);
    const bf16_t* VT = (const bf16_t*)(p.ws + OFF_VT);
    const size_t rb = (size_t)b * TPB;
    bf16x8 qf[2][3];
#pragma unroll
    for (int nq = 0; nq < 2; ++nq)
#pragma unroll
        for (int ks = 0; ks < 3; ++ks) qf[nq][ks] = *(const bf16x8*)(Q + (rb + q0 + wid * 32 + nq * 16 + fr) * 768 + h * 96 + ks * 32 + fq * 8);
    f32x4 oacc[4][2];
#pragma unroll
    for (int mt = 0; mt < 4; ++mt)
#pragma unroll
        for (int nq = 0; nq < 2; ++nq) oacc[mt][nq] = (f32x4){0.f, 0.f, 0.f, 0.f};
    float mrun[2] = {0.f, 0.f}, lsum[2] = {0.f, 0.f};
    const int c8 = (lane & 7) ^ ((4 * wid + (lane >> 4)) & 7);
    const bf16_t* knp = KN + (rb + 8 * wid + (lane >> 3)) * 512 + h * 64 + c8 * 8;
    const bf16_t* vtp = VT + ((size_t)(b * 8 + h) * 64 + 8 * wid + (lane >> 3)) * TPB + c8 * 8;
    const int c4 = (lane & 3) ^ ((lane >> 4) & 3);
    const bf16_t* krp = KR + (rb + 16 * (wid & 3) + (lane >> 2)) * 32 + c4 * 8;
    auto issue = [&](int t, int stg) {
        unsigned char* base = lds + stg * ATT_STAGE;
        const int k0 = t * 64;
        __builtin_amdgcn_global_load_lds((const GLB_AS unsigned*)(knp + (size_t)k0 * 512), (LDS_AS unsigned*)(base + wid * 1024), 16, 0, 0);
        __builtin_amdgcn_global_load_lds((const GLB_AS unsigned*)(vtp + k0), (LDS_AS unsigned*)(base + 12288 + wid * 1024), 16, 0, 0);
        if (wid < 4) __builtin_amdgcn_global_load_lds((const GLB_AS unsigned*)(krp + (size_t)k0 * 32), (LDS_AS unsigned*)(base + 8192 + wid * 1024), 16, 0, 0);
    };
    const int ntile = nkeys / 64;
    const int kz = fr >> 1, rz = (fr >> 2) & 3;
    issue(0, 0);
    asm volatile("s_waitcnt vmcnt(0)" ::: "memory");
    __builtin_amdgcn_s_barrier();
    asm volatile("" ::: "memory");
    for (int t = 0; t < ntile; ++t) {
        if (t + 1 < ntile) issue(t + 1, (t + 1) & 1);
        const unsigned char* Ks = lds + (t & 1) * ATT_STAGE;
        const unsigned char* Rs = Ks + 8192;
        const unsigned char* Vs = Ks + 12288;
        f32x4 sacc[4][2];
#pragma unroll
        for (int km = 0; km < 4; ++km)
#pragma unroll
            for (int nq = 0; nq < 2; ++nq) sacc[km][nq] = (f32x4){-mrun[nq], -mrun[nq], -mrun[nq], -mrun[nq]};
#pragma unroll
        for (int ks = 0; ks < 3; ++ks)
#pragma unroll
            for (int km = 0; km < 4; ++km) {
                const bf16x8 kf = ks < 2 ? *(const bf16x8*)(Ks + (km * 16 + fr) * 128 + (((ks * 4 + fq) ^ kz) * 16))
                                         : *(const bf16x8*)(Rs + (km * 16 + fr) * 64 + ((fq ^ rz) * 16));
#pragma unroll
                for (int nq = 0; nq < 2; ++nq) sacc[km][nq] = __builtin_amdgcn_mfma_f32_16x16x32_bf16(kf, qf[nq][ks], sacc[km][nq], 0, 0, 0);
            }
        float delta[2];
#pragma unroll
        for (int nq = 0; nq < 2; ++nq) {
            float mx = -1e30f;
#pragma unroll
            for (int km = 0; km < 4; ++km)
#pragma unroll
                for (int j = 0; j < 4; ++j) mx = fmaxf(mx, sacc[km][nq][j]);
            mx = fqmax(mx);
            delta[nq] = (t == 0) ? mx : fmaxf(mx, 0.f);
        }
        const bool exact = (t == 0) || (__builtin_amdgcn_ballot_w64(fmaxf(delta[0], delta[1]) > 60.0f) != 0ull);
        bf16x8 pf[2][2];
        float psum[2];
#pragma unroll
        for (int nq = 0; nq < 2; ++nq) {
            float ps = 0.f;
            if (exact) {
#pragma unroll
                for (int km = 0; km < 4; ++km)
#pragma unroll
                    for (int j = 0; j < 4; ++j) { const float e = __builtin_amdgcn_exp2f(sacc[km][nq][j] - delta[nq]); sacc[km][nq][j] = e; ps += e; }
            } else {
#pragma unroll
                for (int km = 0; km < 4; ++km)
#pragma unroll
                    for (int j = 0; j < 4; ++j) { const float e = __builtin_amdgcn_exp2f(sacc[km][nq][j]); sacc[km][nq][j] = e; ps += e; }
            }
            psum[nq] = ps;
#pragma unroll
            for (int kc = 0; kc < 2; ++kc) {
                union { uint4 u; bf16x8 v; } r;
                r.u.x = pk_bf16(sacc[2 * kc][nq][0], sacc[2 * kc][nq][1]); r.u.y = pk_bf16(sacc[2 * kc][nq][2], sacc[2 * kc][nq][3]);
                r.u.z = pk_bf16(sacc[2 * kc + 1][nq][0], sacc[2 * kc + 1][nq][1]); r.u.w = pk_bf16(sacc[2 * kc + 1][nq][2], sacc[2 * kc + 1][nq][3]);
                pf[kc][nq] = r.v;
            }
        }
        if (exact) {
#pragma unroll
            for (int nq = 0; nq < 2; ++nq) {
                const float alpha = (t == 0) ? 1.0f : __builtin_amdgcn_exp2f(-delta[nq]);
                lsum[nq] = lsum[nq] * alpha + psum[nq];
#pragma unroll
                for (int mt = 0; mt < 4; ++mt) oacc[mt][nq] = oacc[mt][nq] * alpha;
            }
        }
#pragma unroll
        for (int mt = 0; mt < 4; ++mt)
#pragma unroll
            for (int kc = 0; kc < 2; ++kc) {
                union { uint2 h2[2]; bf16x8 v; } r;
                const unsigned char* vrow = Vs + (mt * 16 + fr) * 128 + (fq & 1) * 8;
                r.h2[0] = *(const uint2*)(vrow + (((4 * kc + (fq >> 1)) ^ kz) * 16));
                r.h2[1] = *(const uint2*)(vrow + (((4 * kc + 2 + (fq >> 1)) ^ kz) * 16));
#pragma unroll
                for (int nq = 0; nq < 2; ++nq) oacc[mt][nq] = __builtin_amdgcn_mfma_f32_16x16x32_bf16(r.v, pf[kc][nq], oacc[mt][nq], 0, 0, 0);
            }
        if (!exact) {
#pragma unroll
            for (int nq = 0; nq < 2; ++nq) {
                const float alpha = __builtin_amdgcn_exp2f(-delta[nq]);
                lsum[nq] = (lsum[nq] + psum[nq]) * alpha;
#pragma unroll
                for (int mt = 0; mt < 4; ++mt) oacc[mt][nq] = oacc[mt][nq] * alpha;
            }
        }
#pragma unroll
        for (int nq = 0; nq < 2; ++nq) mrun[nq] += delta[nq];
        asm volatile("s_waitcnt vmcnt(0) lgkmcnt(0)" ::: "memory");
        __builtin_amdgcn_s_barrier();
        asm volatile("" ::: "memory");
    }
#pragma unroll
    for (int nq = 0; nq < 2; ++nq) {
        const float inv = 1.0f / fqsum(lsum[nq]);
        bf16_t* orow = Q + (rb + q0 + wid * 32 + nq * 16 + fr) * 768 + h * 96;
#pragma unroll
        for (int mt = 0; mt < 4; mt += 2) {
            uint2 a, b2;
            a.x = pk_bf16(oacc[mt][nq][0] * inv, oacc[mt][nq][1] * inv); a.y = pk_bf16(oacc[mt][nq][2] * inv, oacc[mt][nq][3] * inv);
            b2.x = pk_bf16(oacc[mt + 1][nq][0] * inv, oacc[mt + 1][nq][1] * inv); b2.y = pk_bf16(oacc[mt + 1][nq][2] * inv, oacc[mt + 1][nq][3] * inv);
            const uint4 w = widen16(a, b2);
            if (do_write) *(uint4*)(orow + (mt + (fq & 1)) * 16 + (fq >> 1) * 8) = w;
        }
    }
}

__device__ __forceinline__ void p3_phase(const Params& pin, int l, unsigned char* lds) {
    const Params p = launder(pin); l = launder_i(l);
    for (int r = 0, nr = launder_i(1 + ((PROBE_MASK >> 1) & 1)); r < nr; ++r)
        for (int u = blockIdx.x; u < 256; u += gridDim.x) scan_unit(p, l, u, lds);
    const int nunits = (l == DEPTH - 1) ? 1024 : 1152;
    for (int r = launder_i(((PROBE_MASK >> 9) & 1) ? 0 : 1); r < 2; ++r)
    for (int u = blockIdx.x; u < nunits; u += gridDim.x) {
        if (u < 1024) { const int bh = u >> 3, qt = u & 7; attn_unit(p, bh >> 3, bh & 7, CTXL + qt * 256, TPB, lds, r); }
        else { const int bh = u - 1024; attn_unit(p, bh >> 3, bh & 7, 0, CTXL, lds, r); }
    }
}

__device__ __forceinline__ void p35_phase(const Params& pin, int l, bool skip_ctx, unsigned char* lds) {
    const Params p = launder(pin); l = launder_i(l); const int tid = ltid();
    const bf16_t* SG = (const bf16_t*)(p.ws + OFF_SG);
    const bf16_t* W = (const bf16_t*)(p.ws + OFF_W) + WO_GUP;
    const bf16_t* YF = (const bf16_t*)(p.ws + OFF_YF);
    const bf16_t* YB = (const bf16_t*)(p.ws + OFF_YB);
    const bf16_t* Hr = (const bf16_t*)(p.ws + OFF_R3);
    bf16_t* RWO = (bf16_t*)(p.ws + OFF_RWO);
    const float* mu = p.rw_mu + (size_t)l * 1920;
    const int lane = tid & 63, wid = tid >> 6, wr = wid >> 1, wc = wid & 1, fr = lane & 15, fq = lane >> 4;
    float* gt = (float*)lds;
    constexpr int GP = 132;
    for (int t = blockIdx.x; t < 288 * 4; t += gridDim.x) {
        int mt, nt; tile_mn(t, 4, mt, nt);
        if (skip_ctx && (mt % 18) < 2) continue;
        f32x4 acc[2][4]; zero_acc<2>(acc);
        gemm_mainloop<2, 1>(acc, SG + (size_t)mt * 128 * 128, 128, 64, W + (size_t)nt * 128 * 128, 128, 2, lds, tid);
#pragma unroll
        for (int m = 0; m < 2; ++m)
#pragma unroll
            for (int n = 0; n < 4; ++n) *(f32x4*)(gt + (wr * 32 + m * 16 + fr) * GP + wc * 64 + n * 16 + fq * 4) = acc[m][n];
        __syncthreads();
        const int pp0 = (mt % 18) * 128;
#pragma unroll 1
        for (int it = 0; it < 4; ++it) {
            const int item = tid + it * NTHREADS, lrow = item >> 4, cg = item & 15, pp = pp0 + lrow;
            const size_t row = (size_t)mt * 128 + lrow;
            const int C = nt * 128 + cg * 8;
            const bool hp = (pp != 0 && pp != CTXL), hn = (pp != CTXL - 1 && pp != TPB - 1);
            const bf16_t* hr = Hr + row * 1920;
            float yf[8], yb[8], r8[8], k8[8], v8[8];
            unpack8(*(const uint4*)(YF + row * 512 + C), yf); unpack8(*(const uint4*)(YB + row * 512 + C), yb);
            shift8(hr, hp, hn, C, mu, r8); shift8(hr, hp, hn, 512 + C, mu, k8); shift8(hr, hp, hn, 1024 + C, mu, v8);
            const float* rkp = p.rw_r_k + (size_t)l * 512 + C;
            float s1 = 0.f, bs = 0.f;
#pragma unroll
            for (int i = 0; i < 8; ++i) { yf[i] += yb[i]; s1 += yf[i]; bs += r8[i] * k8[i] * rkp[i]; }
            s1 = red8(s1); bs = red8(bs);
            const float mean = s1 * (1.0f / 64.0f);
            float s2 = 0.f;
#pragma unroll
            for (int i = 0; i < 8; ++i) { const float d = yf[i] - mean; s2 += d * d; }
            s2 = red8(s2);
            const float rstd = __builtin_amdgcn_rsqf(s2 * (1.0f / 64.0f) + 64e-5f);
            const float* ggp = p.rw_gn_g + (size_t)l * 512 + C; const float* gbp = p.rw_gn_b + (size_t)l * 512 + C;
            const f32x4 g0 = *(const f32x4*)(gt + lrow * GP + cg * 8), g1 = *(const f32x4*)(gt + lrow * GP + cg * 8 + 4);
            float o[8];
#pragma unroll
            for (int i = 0; i < 8; ++i) o[i] = ((yf[i] - mean) * rstd * ggp[i] + gbp[i] + bs * v8[i]) * (i < 4 ? g0[i] : g1[i - 4]);
            uint4 ov; ov.x = pk_bf16(o[0], o[1]); ov.y = pk_bf16(o[2], o[3]); ov.z = pk_bf16(o[4], o[5]); ov.w = pk_bf16(o[6], o[7]);
            *(uint4*)(RWO + row * 512 + C) = ov;
        }
        __syncthreads();
    }
}

__device__ __forceinline__ void p4_phase(const Params& pin, bool skip_ctx, unsigned char* lds) {
    const Params p = launder(pin); const int tid = ltid();
    const bf16_t* XM = (const bf16_t*)(p.ws + OFF_R6);
    const bf16_t* W = (const bf16_t*)(p.ws + OFF_W);
    bf16_t* MG = (bf16_t*)(p.ws + OFF_MRG);
    const int lane = tid & 63, wid = tid >> 6, wr = wid >> 1, wc = wid & 1, fr = lane & 15, fq = lane >> 4;
    for (int t = blockIdx.x; t < 288 * 8; t += gridDim.x) {
        int mt, nt; tile_mn(t, 8, mt, nt);
        if (skip_ctx && (mt % 18) < 2) continue;
        f32x4 g[3][2][4];
#pragma unroll
        for (int i = 0; i < 3; ++i) zero_acc<2>(g[i]);
        gemm_gate3(g, XM + (size_t)mt * 128 * 1024, W + WO_IN + (size_t)(4224 + nt * 128) * 1024, 16, lds, tid);
        typedef __fp16 h16x2 __attribute__((ext_vector_type(2)));
        h16x2 gp[3][2][4][2];
#pragma unroll
        for (int i = 0; i < 3; ++i)
#pragma unroll
            for (int m = 0; m < 2; ++m)
#pragma unroll
                for (int n = 0; n < 4; ++n) {
                    gp[i][m][n][0] = __builtin_amdgcn_cvt_pkrtz(sigmoidf_(g[i][m][n][0]), sigmoidf_(g[i][m][n][1]));
                    gp[i][m][n][1] = __builtin_amdgcn_cvt_pkrtz(sigmoidf_(g[i][m][n][2]), sigmoidf_(g[i][m][n][3]));
                }
        f32x4 mg[2][4]; zero_acc<2>(mg);
#pragma unroll 1
        for (int i = 0; i < 3; ++i) {
            const bf16_t* Ab; int lda, kst; const bf16_t* Wb;
            if (i == 0) { Ab = (const bf16_t*)(p.ws + OFF_Q); lda = 768; kst = 96; Wb = W + WO_OA; }
            else if (i == 1) { Ab = (const bf16_t*)(p.ws + OFF_R5); lda = 512; kst = 64; Wb = W + WO_OC; }
            else { Ab = (const bf16_t*)(p.ws + OFF_RWO); lda = 512; kst = 64; Wb = W + WO_OR; }
            f32x4 a[2][4]; zero_acc<2>(a);
            gemm_mainloop<2, 1>(a, Ab + (size_t)mt * 128 * lda, lda, kst, Wb + (size_t)nt * 128 * 512, 512, 8, lds, tid);
#pragma unroll
            for (int m = 0; m < 2; ++m)
#pragma unroll
                for (int n = 0; n < 4; ++n) {
                    const h16x2 g0 = i == 0 ? gp[0][m][n][0] : (i == 1 ? gp[1][m][n][0] : gp[2][m][n][0]);
                    const h16x2 g1 = i == 0 ? gp[0][m][n][1] : (i == 1 ? gp[1][m][n][1] : gp[2][m][n][1]);
                    mg[m][n][0] += (float)g0[0] * a[m][n][0]; mg[m][n][1] += (float)g0[1] * a[m][n][1];
                    mg[m][n][2] += (float)g1[0] * a[m][n][2]; mg[m][n][3] += (float)g1[1] * a[m][n][3];
                }
        }
#pragma unroll
        for (int m = 0; m < 2; ++m) {
            const size_t row = (size_t)mt * 128 + wr * 32 + m * 16 + fr;
#pragma unroll
            for (int n = 0; n < 4; n += 2) {
                uint2 a, b2;
                a.x = pk_bf16(mg[m][n][0], mg[m][n][1]); a.y = pk_bf16(mg[m][n][2], mg[m][n][3]);
                b2.x = pk_bf16(mg[m][n + 1][0], mg[m][n + 1][1]); b2.y = pk_bf16(mg[m][n + 1][2], mg[m][n + 1][3]);
                *(uint4*)(MG + row * 1024 + nt * 128 + wc * 64 + (n + (fq & 1)) * 16 + (fq >> 1) * 8) = widen16(a, b2);
            }
        }
    }
}

template <int MT>
__device__ __forceinline__ void resid_tile(const Params& p, int l, const bf16_t* A, int lda, int nk, const bf16_t* Wt, int ldb, int goff, bool x_from_input,
                                           const float* lng, const float* lnb, int row0, int nt, unsigned char* lds, int tid) {
    const int lane = tid & 63, wid = tid >> 6, wr = wid >> 1, wc = wid & 1, fr = lane & 15, fq = lane >> 4;
    f32x4 acc[MT][4]; zero_acc<MT>(acc);
    gemm_mainloop<MT, 1>(acc, A + (size_t)row0 * lda, lda, 64, Wt + (size_t)nt * 128 * ldb, ldb, nk, lds, tid);
    const int b = row0 / TPB, pp0 = row0 % TPB;
    const float* gv = modv_ptr(p, l, b, pp0) + goff;
    const float* stats = (const float*)(p.ws + OFF_STATS);
#pragma unroll
    for (int m = 0; m < MT; ++m) {
        const int lr = wr * 16 * MT + m * 16 + fr, pp = pp0 + lr;
        const float* xi = x_rd(p, x_from_input, b, pp);
        float* xo = x_wr(p, b, pp);
        float mean = 0.f, rstd = 1.f;
        if (!x_from_input) { const size_t row = (size_t)row0 + lr; mean = stats[row * 2]; rstd = stats[row * 2 + 1]; }
#pragma unroll
        for (int n = 0; n < 4; ++n) {
            const int col = nt * 128 + wc * 64 + n * 16 + fq * 4;
            f32x4 xv = *(const f32x4*)(xi + col); const f32x4 g4 = *(const f32x4*)(gv + col);
            if (!x_from_input) {
                const f32x4 lg = *(const f32x4*)(lng + col), lb = *(const f32x4*)(lnb + col);
#pragma unroll
                for (int j = 0; j < 4; ++j) xv[j] = (xv[j] - mean) * rstd * lg[j] + lb[j];
            }
            f32x4 o;
#pragma unroll
            for (int j = 0; j < 4; ++j) o[j] = ALPHA * xv[j] + g4[j] * acc[m][n][j];
            *(f32x4*)(xo + col) = o;
        }
    }
}
__device__ __forceinline__ void resid_tile256(const Params& p, int l, const bf16_t* A, int lda, int nk, const bf16_t* Wt, int ldb, int goff, bool x_from_input,
                                              const float* lng, const float* lnb, int row0, int nt256, unsigned char* lds, int tid) {
    const int lane = tid & 63, wid = tid >> 6, wr = wid >> 2, wc = wid & 3, fr = lane & 15, fq = lane >> 4;
    f32x4 acc[8][4]; zero_acc<8>(acc);
    Seg sg; sg.A = A + (size_t)row0 * lda; sg.Bt = Wt + (size_t)nt256 * 256 * ldb; sg.lda = lda; sg.a_kstep = 64; sg.ldb = ldb; sg.nk = nk;
    int st = 0;
    gemm_stream256(acc, sg, sg, false, true, st, lds, tid);
    const int b = row0 / TPB, pp0 = row0 % TPB;
    const float* gv = modv_ptr(p, l, b, pp0) + goff;
    const float* stats = (const float*)(p.ws + OFF_STATS);
#pragma unroll
    for (int m = 0; m < 8; ++m) {
        const int lr = wr * 128 + m * 16 + fr, pp = pp0 + lr;
        const float* xi = x_rd(p, x_from_input, b, pp);
        float* xo = x_wr(p, b, pp);
        float mean = 0.f, rstd = 1.f;
        if (!x_from_input) { const size_t row = (size_t)row0 + lr; mean = stats[row * 2]; rstd = stats[row * 2 + 1]; }
#pragma unroll
        for (int n = 0; n < 4; ++n) {
            const int col = nt256 * 256 + wc * 64 + n * 16 + fq * 4;
            f32x4 xv = *(const f32x4*)(xi + col); const f32x4 g4 = *(const f32x4*)(gv + col);
            if (!x_from_input) {
                const f32x4 lg = *(const f32x4*)(lng + col), lb = *(const f32x4*)(lnb + col);
#pragma unroll
                for (int j = 0; j < 4; ++j) xv[j] = (xv[j] - mean) * rstd * lg[j] + lb[j];
            }
            f32x4 o;
#pragma unroll
            for (int j = 0; j < 4; ++j) o[j] = ALPHA * xv[j] + g4[j] * acc[m][n][j];
            *(f32x4*)(xo + col) = o;
        }
    }
}
__device__ __forceinline__ void resid_gemm_phase(const Params& pin, int l, size_t a_off, int lda, int nk, size_t w_off, int ldb, int goff, bool x_from_input, const float* lng, const float* lnb, bool skip_ctx, unsigned char* lds) {
    const Params p = launder(pin); l = launder_i(l);
    const int tid = ltid();
    const bf16_t* A = (const bf16_t*)(p.ws + a_off);
    const bf16_t* Wt = (const bf16_t*)(p.ws + OFF_W) + w_off;
    if (gridDim.x == 256) {
        for (int t = blockIdx.x; t < 512; t += 256) {
            int mt, nt; tile_mn(t, 4, mt, nt);
            if (skip_ctx && (mt % 9) == 0) continue;
            resid_tile256(p, l, A, lda, nk, Wt, ldb, goff, x_from_input, lng, lnb, mt * 256, nt, lds, tid);
        }
        int mt, nt; tile_mn(512 + (blockIdx.x >> 2), 4, mt, nt);
        const int q = blockIdx.x & 3;
        if (!(skip_ctx && (mt % 9) == 0)) resid_tile<2>(p, l, A, lda, nk, Wt, ldb, goff, x_from_input, lng, lnb, mt * 256 + (q >> 1) * 128, nt * 2 + (q & 1), lds, tid);
    } else {
        for (int t = blockIdx.x; t < 144 * 8; t += gridDim.x) {
            int mt, nt; tile_mn(t, 8, mt, nt);
            if (skip_ctx && (mt % 9) == 0) continue;
            resid_tile<4>(p, l, A, lda, nk, Wt, ldb, goff, x_from_input, lng, lnb, mt * 256, nt, lds, tid);
        }
    }
}

__device__ __forceinline__ void ln_phase(const Params& pin, const float* g, const float* bta, int lmod, int shoff, bool write_xmod, bool write_x, bool skip_ctx) {
    const Params p = launder(pin); lmod = launder_i(lmod);
    const int tid = ltid(), wid = tid >> 6, lane = tid & 63;
    bf16_t* xm = (bf16_t*)(p.ws + OFF_R6);
    float* stats = (float*)(p.ws + OFF_STATS);
    for (int row = blockIdx.x * 8 + wid; row < MROWS; row += gridDim.x * 8) {
        const int b = row / TPB, pp = row % TPB;
        if (skip_ctx && pp < CTXL) continue;
        float* xp = x_wr(p, b, pp);
        f32x4 v[4];
        float s = 0.f;
#pragma unroll
        for (int i = 0; i < 4; ++i) { v[i] = *(const f32x4*)(xp + i * 256 + lane * 4); s += (v[i][0] + v[i][1]) + (v[i][2] + v[i][3]); }
        const float mean = wave_sum(s) * (1.0f / 1024.0f);
        float q = 0.f;
#pragma unroll
        for (int i = 0; i < 4; ++i)
#pragma unroll
            for (int j = 0; j < 4; ++j) { const float d = v[i][j] - mean; q += d * d; }
        const float rstd = __builtin_amdgcn_rsqf(wave_sum(q) * (1.0f / 1024.0f) + 1e-5f);
        if (lane == 0) { stats[(size_t)row * 2] = mean; stats[(size_t)row * 2 + 1] = rstd; }
        const float* mv = write_xmod ? modv_ptr(p, lmod, b, pp) + shoff : nullptr;
#pragma unroll
        for (int i = 0; i < 4; ++i) {
            const int c = i * 256 + lane * 4;
            const f32x4 g4 = *(const f32x4*)(g + c), b4 = *(const f32x4*)(bta + c);
            f32x4 o;
#pragma unroll
            for (int j = 0; j < 4; ++j) o[j] = (v[i][j] - mean) * rstd * g4[j] + b4[j];
            if (write_x) *(f32x4*)(xp + c) = o;
            if (write_xmod) {
                const f32x4 sh = *(const f32x4*)(mv + c), sc = *(const f32x4*)(mv + 1024 + c);
                uint2 ov; ov.x = pk_bf16(o[0] * (1.f + sc[0]) + sh[0], o[1] * (1.f + sc[1]) + sh[1]); ov.y = pk_bf16(o[2] * (1.f + sc[2]) + sh[2], o[3] * (1.f + sc[3]) + sh[3]);
                *(uint2*)(xm + (size_t)row * 1024 + c) = ov;
            }
        }
    }
}

__device__ __forceinline__ void p7_phase(const Params& pin, bool skip_ctx, unsigned char* lds) {
    const Params p = launder(pin); const int tid = ltid();
    const bf16_t* A = (const bf16_t*)(p.ws + OFF_R6);
    const bf16_t* W = (const bf16_t*)(p.ws + OFF_W) + WO_13;
    bf16_t* HF = (bf16_t*)(p.ws + OFF_HF);
    const int lane = tid & 63, wid = tid >> 6, wr = wid >> 2, wc = wid & 3, fr = lane & 15, fq = lane >> 4;
    auto seg = [&](int t) { int mt, nt; tile_mn(t, 22, mt, nt); Seg g; g.A = A + (size_t)mt * 256 * 1024; g.Bt = W + (size_t)nt * 256 * 1024; g.lda = 1024; g.a_kstep = 64; g.ldb = 1024; g.nk = 16; return g; };
    auto valid = [&](int t) { int mt, nt; tile_mn(t, 22, mt, nt); return !(skip_ctx && (mt % 9) == 0); };
    auto nextv = [&](int t) { while (t < 144 * 22 && !valid(t)) t += gridDim.x; return t; };
    int st = 0; bool first = true;
    for (int t = nextv(blockIdx.x); t < 144 * 22;) {
        int mt, nt; tile_mn(t, 22, mt, nt);
        const int tn = nextv(t + gridDim.x); const bool hn = tn < 144 * 22;
        f32x4 acc[8][4]; zero_acc<8>(acc);
        gemm_stream256(acc, seg(t), seg(hn ? tn : t), hn, first, st, lds, tid); first = false;
        const int G = nt * 4 + wc;
#pragma unroll
        for (int m = 0; m < 8; ++m) {
            const size_t row = (size_t)mt * 256 + wr * 128 + m * 16 + fr;
            uint2 ov[2];
#pragma unroll
            for (int n = 0; n < 2; ++n) {
                float o[4];
#pragma unroll
                for (int j = 0; j < 4; ++j) o[j] = siluf_(acc[m][n][j]) * acc[m][n + 2][j];
                ov[n].x = pk_bf16(o[0], o[1]); ov[n].y = pk_bf16(o[2], o[3]);
            }
            *(uint4*)(HF + row * DFF + G * 32 + (fq & 1) * 16 + (fq >> 1) * 8) = widen16(ov[0], ov[1]);
        }
        t = tn;
    }
}

__global__ void __launch_bounds__(NTHREADS) fwd_megakernel(Params p) {
    extern __shared__ __attribute__((aligned(16))) unsigned char lds[];
    cg::grid_group grid = cg::this_grid();
    unsigned* gbar = (unsigned*)(p.ws + OFF_BAR); unsigned epoch = 0;
#define GSYNC() grid_barrier(gbar, epoch)
    if (p.ws == nullptr) grid.sync();
    modv_phase(p, lds);
    convert_layer(p, 0, lds);
    {
        bf16_t* Wm = (bf16_t*)(p.ws + OFF_W) + WO_IN + (size_t)672 * 1024;
        for (int i = blockIdx.x * NTHREADS + threadIdx.x; i < 96 * 1024 / 2; i += gridDim.x * NTHREADS) ((unsigned*)Wm)[i] = 0u;
    }
    GSYNC();
    xmod0_phase(p);
    GSYNC();
#pragma unroll 1
    for (int l = 0; l < DEPTH; ++l) {
        const bool last = (l == DEPTH - 1);
        for (int r = 0, nr = launder_i(1 + ((PROBE_MASK >> 2) & 1)); r < nr; ++r) p1_phase(p, lds);
        GSYNC();
        for (int r = 0, nr = launder_i(1 + ((PROBE_MASK >> 3) & 1)); r < nr; ++r) p2a_phase(p, l);
        GSYNC();
        for (int r = 0, nr = launder_i(1 + ((PROBE_MASK >> 4) & 1)); r < nr; ++r) p2b_phase(p, l, lds);
        GSYNC();
        p3_phase(p, l, lds);
        GSYNC();
        for (int r = 0, nr = launder_i(1 + ((PROBE_MASK >> 5) & 1)); r < nr; ++r) p35_phase(p, l, last, lds);
        GSYNC();
        for (int r = 0, nr = launder_i(1 + ((PROBE_MASK >> 6) & 1)); r < nr; ++r) p4_phase(p, last, lds);
        GSYNC();
        resid_gemm_phase(p, l, OFF_MRG, 1024, 16, WO_OUT, 1024, 2048, l == 0, p.ln2_g + (l > 0 ? l - 1 : 0) * 1024, p.ln2_b + (l > 0 ? l - 1 : 0) * 1024, last, lds);
        GSYNC();
        ln_phase(p, p.ln1_g + l * 1024, p.ln1_b + l * 1024, l, 3072, true, false, last);
        GSYNC();
        for (int r = 0, nr = launder_i(1 + ((PROBE_MASK >> 0) & 1)); r < nr; ++r) p7_phase(p, last, lds);
        GSYNC();
        resid_gemm_phase(p, l, OFF_HF, DFF, 44, WO_2, DFF, 5120, false, p.ln1_g + l * 1024, p.ln1_b + l * 1024, last, lds);
        GSYNC();
        ln_phase(p, p.ln2_g + l * 1024, p.ln2_b + l * 1024, last ? l : l + 1, 0, !last, last, last);
        if (!last) for (int r = 0, nr = launder_i(1 + ((PROBE_MASK >> 7) & 1)); r < nr; ++r) convert_layer(p, l + 1, lds);
        for (int r = 0, nr = launder_i(((PROBE_MASK >> 8) & 1) * 10); r < nr; ++r) GSYNC();
        GSYNC();
    }
}

extern "C" void kernel_launch(void* const* d_in, const int* in_sizes, int n_in, void* d_out,
                              int out_size, void* d_ws, size_t ws_size, hipStream_t stream) {
    static int grid_blocks = 0;
    if (!grid_blocks) {
        int dev = 0, cus = 0, per_cu = 0;
        hipGetDevice(&dev);
        hipDeviceGetAttribute(&cus, hipDeviceAttributeMultiprocessorCount, dev);
        if (hipFuncSetAttribute((const void*)fwd_megakernel, hipFuncAttributeMaxDynamicSharedMemorySize, LDS_BYTES) != hipSuccess)
            fprintf(stderr, "hipFuncSetAttribute failed\n");
        hipOccupancyMaxActiveBlocksPerMultiprocessor(&per_cu, (const void*)fwd_megakernel, NTHREADS, LDS_BYTES);
        if (per_cu < 1) fprintf(stderr, "occupancy query says %d blocks/CU\n", per_cu);
        (void)hipGetLastError();
        grid_blocks = cus > 0 ? cus : 256;
        if (ws_size < WS_END) { fprintf(stderr, "workspace too small: %zu < %zu\n", ws_size, (size_t)WS_END); grid_blocks = -1; }
        if (n_in != 33) { fprintf(stderr, "expected 33 inputs, got %d\n", n_in); grid_blocks = -1; }
    }
    if (grid_blocks < 0) return;
    if (hipMemsetAsync((unsigned char*)d_ws + OFF_BAR, 0, 8192, stream) != hipSuccess) fprintf(stderr, "memset failed\n");
    Params p{};
    const float** pp = (const float**)&p;
    for (int i = 0; i < 33; ++i) pp[i] = (const float*)d_in[i];
    p.out = (float*)d_out;
    p.ws = (unsigned char*)d_ws;
    void* args[] = {&p};
    hipError_t e = hipLaunchCooperativeKernel((void*)fwd_megakernel, dim3(grid_blocks), dim3(NTHREADS), args, LDS_BYTES, stream);
    if (e != hipSuccess) fprintf(stderr, "cooperative launch failed: %s (grid %d)\n", hipGetErrorString(e), grid_blocks);
}
```

```cpp
#include <hip/hip_runtime.h>
#include <hip/hip_cooperative_groups.h>
#include <cstdio>
#include <cstdint>
namespace cg = cooperative_groups;

typedef unsigned short bf16_t;
typedef short bf16x8 __attribute__((ext_vector_type(8)));
typedef float f32x4 __attribute__((ext_vector_type(4)));

#ifndef PROBE_MASK
#define PROBE_MASK 0
#endif
constexpr int BATCH = 16, SEQ = 2048, CTXL = 256, DM = 1024, DEPTH = 4, DFF = 2816, DIN = 7200;
constexpr int TPB = SEQ + CTXL;
constexpr int MROWS = BATCH * TPB;
constexpr int NTHREADS = 512;
constexpr int LDS_BYTES = 152 * 1024;
constexpr float ALPHA = 1.681792830507429f;
constexpr float QSCALE = 0.10206207261596575f * 1.4426950408889634f;

constexpr size_t WO_IN = 0;
constexpr size_t WO_UQ = WO_IN + (size_t)7296 * 1024;
constexpr size_t WO_UKV = WO_UQ + (size_t)768 * 384;
constexpr size_t WO_OA = WO_UKV + (size_t)1024 * 256;
constexpr size_t WO_OC = WO_OA + (size_t)1024 * 512;
constexpr size_t WO_OR = WO_OC + (size_t)1024 * 512;
constexpr size_t WO_OUT = WO_OR + (size_t)1024 * 512;
constexpr size_t WO_13 = WO_OUT + (size_t)1024 * 1024;
constexpr size_t WO_2 = WO_13 + (size_t)5632 * 1024;
constexpr size_t WO_UP = WO_2 + (size_t)1024 * 2816;
constexpr size_t WO_AUP = WO_UP + (size_t)2 * 512 * 64;
constexpr size_t WO_GUP = WO_AUP + (size_t)2 * 512 * 64;
constexpr size_t W_ELEMS = WO_GUP + (size_t)512 * 128;

constexpr size_t al256(size_t x) { return (x + 255) & ~(size_t)255; }
constexpr size_t OFF_BAR = 0;
constexpr size_t OFF_ZROW = 1024;
constexpr size_t OFF_W = 8192;
constexpr size_t OFF_MODV = al256(OFF_W + W_ELEMS * 2);
constexpr size_t OFF_ROPE = al256(OFF_MODV + (size_t)4 * 17 * 6144 * 4);
constexpr size_t OFF_RSQ = al256(OFF_ROPE + 64 * 8 * 2 * 4);
constexpr size_t OFF_RSKV = al256(OFF_RSQ + (size_t)MROWS * 4);
constexpr size_t OFF_STATS = al256(OFF_RSKV + (size_t)MROWS * 4);
constexpr size_t OFF_XC = al256(OFF_STATS + (size_t)MROWS * 8);
constexpr size_t OFF_R1 = al256(OFF_XC + (size_t)BATCH * CTXL * DM * 4);
constexpr size_t OFF_R2 = al256(OFF_R1 + (size_t)MROWS * 672 * 2);
constexpr size_t OFF_R3 = OFF_R2 + (size_t)MROWS * 1536 * 2;
constexpr size_t OFF_R4 = al256(OFF_R3 + (size_t)MROWS * 1920 * 2);
constexpr size_t OFF_R5 = al256(OFF_R4 + (size_t)MROWS * (512 + 512 + 32) * 2);
constexpr size_t OFF_R6 = al256(OFF_R5 + (size_t)MROWS * 512 * 2);
constexpr size_t WS_END = al256(OFF_R6 + (size_t)MROWS * 1024 * 2);
constexpr size_t OFF_Q = OFF_R2;
constexpr size_t OFF_YF = OFF_R2 + (size_t)MROWS * 768 * 2;
constexpr size_t OFF_SG = OFF_YF + (size_t)MROWS * 512 * 2;
constexpr size_t OFF_YB = OFF_R1;
constexpr size_t OFF_KN = OFF_R4;
constexpr size_t OFF_VT = OFF_R4 + (size_t)MROWS * 512 * 2;
constexpr size_t OFF_KR = OFF_VT + (size_t)MROWS * 512 * 2;
constexpr size_t OFF_RWO = OFF_R4;
constexpr size_t OFF_MRG = OFF_R3;
constexpr size_t OFF_HF = OFF_R2;
static_assert(OFF_SG + (size_t)MROWS * 128 * 2 <= OFF_R3, "R2 overlay overflow");
static_assert((size_t)MROWS * 2816 * 2 <= OFF_R4 - OFF_R2, "HF overflow");

struct Params {
    const float *x, *c, *ctx, *c_ctx, *mod_w, *mod_b, *w_in, *q_norm, *w_uq, *kv_norm, *w_ukv, *w_o_attn,
        *conv_w, *w_o_conv, *rw_mu, *rw_w0, *rw_w_up, *rw_a0, *rw_a_up, *rw_g_up, *rw_k_k, *rw_k_a,
        *rw_r_k, *rw_gn_g, *rw_gn_b, *w_o_rwkv, *w_out, *ln1_g, *ln1_b, *ffn_w13, *ffn_w2, *ln2_g, *ln2_b;
    float* out;
    unsigned char* ws;
};

typedef __attribute__((address_space(1))) unsigned char gchar_t;
typedef __attribute__((address_space(1))) float gfloat_t;
__device__ __forceinline__ Params launder(const Params& a) {
    Params q = a;
    unsigned long long w = (unsigned long long)a.ws, o = (unsigned long long)a.out;
    unsigned wl = __builtin_amdgcn_readfirstlane((unsigned)w), wh = __builtin_amdgcn_readfirstlane((unsigned)(w >> 32));
    unsigned ol = __builtin_amdgcn_readfirstlane((unsigned)o), oh = __builtin_amdgcn_readfirstlane((unsigned)(o >> 32));
    asm volatile("" : "+s"(wl), "+s"(wh), "+s"(ol), "+s"(oh));
    w = ((unsigned long long)wh << 32) | wl; o = ((unsigned long long)oh << 32) | ol;
    q.ws = (unsigned char*)(gchar_t*)w; q.out = (float*)(gfloat_t*)o;
    return q;
}
__device__ __forceinline__ int launder_i(int v) { v = __builtin_amdgcn_readfirstlane(v); asm volatile("" : "+s"(v)); return v; }
__device__ __forceinline__ int ltid() { int t = threadIdx.x; asm volatile("" : "+v"(t)); return t; }
__device__ __forceinline__ unsigned pk_bf16(float lo, float hi) { unsigned r; asm("v_cvt_pk_bf16_f32 %0, %1, %2" : "=v"(r) : "v"(lo), "v"(hi)); return r; }
__device__ __forceinline__ float bf_lo(unsigned u) { return __uint_as_float(u << 16); }
__device__ __forceinline__ float bf_hi(unsigned u) { return __uint_as_float(u & 0xffff0000u); }
__device__ __forceinline__ float bf1(bf16_t h) { return __uint_as_float(((unsigned)h) << 16); }
__device__ __forceinline__ float x32sum(float x) { unsigned u = __float_as_uint(x); auto r = __builtin_amdgcn_permlane32_swap(u, u, false, false); return __uint_as_float(r[0]) + __uint_as_float(r[1]); }
__device__ __forceinline__ float x16sum(float x) { unsigned u = __float_as_uint(x); auto r = __builtin_amdgcn_permlane16_swap(u, u, false, false); return __uint_as_float(r[0]) + __uint_as_float(r[1]); }
__device__ __forceinline__ float x32max(float x) { unsigned u = __float_as_uint(x); auto r = __builtin_amdgcn_permlane32_swap(u, u, false, false); return fmaxf(__uint_as_float(r[0]), __uint_as_float(r[1])); }
__device__ __forceinline__ float x16max(float x) { unsigned u = __float_as_uint(x); auto r = __builtin_amdgcn_permlane16_swap(u, u, false, false); return fmaxf(__uint_as_float(r[0]), __uint_as_float(r[1])); }
__device__ __forceinline__ float fqsum(float x) { return x16sum(x32sum(x)); }
__device__ __forceinline__ float fqmax(float x) { return x16max(x32max(x)); }

template <int CTRL> __device__ __forceinline__ float dpp_add(float x) { return x + __uint_as_float((unsigned)__builtin_amdgcn_update_dpp(0, (int)__float_as_uint(x), CTRL, 0xf, 0xf, true)); }
__device__ __forceinline__ float red8(float x) { x = dpp_add<0xB1>(x); x = dpp_add<0x4E>(x); x = dpp_add<0x141>(x); return x; }
__device__ __forceinline__ float xor32_get(float x, int lane) { const unsigned u = __float_as_uint(x); auto r = __builtin_amdgcn_permlane32_swap(u, u, false, false); return __uint_as_float(lane < 32 ? r[1] : r[0]); }
__device__ __forceinline__ float xor8_get(float x) { return __uint_as_float((unsigned)__builtin_amdgcn_update_dpp(0, (int)__float_as_uint(x), 0x128, 0xf, 0xf, true)); }
__device__ __forceinline__ float wave_sum(float v) { v = dpp_add<0xB1>(v); v = dpp_add<0x4E>(v); v = dpp_add<0x141>(v); v = dpp_add<0x140>(v); return fqsum(v); }
__device__ __forceinline__ uint4 widen16(uint2 a, uint2 b) {
    auto r0 = __builtin_amdgcn_permlane16_swap(a.x, b.x, false, false);
    auto r1 = __builtin_amdgcn_permlane16_swap(a.y, b.y, false, false);
    return make_uint4(r0[0], r1[0], r0[1], r1[1]);
}
__device__ __forceinline__ float fexp(float x) { return __builtin_amdgcn_exp2f(x * 1.4426950408889634f); }
__device__ __forceinline__ float sigmoidf_(float x) { return __builtin_amdgcn_rcpf(1.0f + fexp(-x)); }
__device__ __forceinline__ float siluf_(float x) { return x * __builtin_amdgcn_rcpf(1.0f + fexp(-x)); }

__device__ __forceinline__ const float* x_rd(const Params& p, bool from_input, int b, int pp) {
    if (pp < CTXL) return (from_input ? p.ctx : (const float*)(p.ws + OFF_XC)) + ((size_t)b * CTXL + pp) * DM;
    return (from_input ? p.x : (const float*)p.out) + ((size_t)b * SEQ + (pp - CTXL)) * DM;
}
__device__ __forceinline__ float* x_wr(const Params& p, int b, int pp) {
    if (pp < CTXL) return (float*)(p.ws + OFF_XC) + ((size_t)b * CTXL + pp) * DM;
    return p.out + ((size_t)b * SEQ + (pp - CTXL)) * DM;
}
__device__ __forceinline__ const float* modv_ptr(const Params& p, int l, int b, int pp) {
    const int mr = pp < CTXL ? 16 : b;
    return (const float*)(p.ws + OFF_MODV) + ((size_t)l * 17 + mr) * 6144;
}

__device__ __forceinline__ void grid_barrier(unsigned* bar, unsigned& epoch) {
    asm volatile("s_waitcnt vmcnt(0) lgkmcnt(0)" ::: "memory");
    __syncthreads();
    epoch += 1;
    if (threadIdx.x == 0) {
        __builtin_amdgcn_fence(__ATOMIC_RELEASE, "agent");
        asm volatile("s_waitcnt vmcnt(0)" ::: "memory");
        const unsigned old = __hip_atomic_fetch_add(bar, 1u, __ATOMIC_RELAXED, __HIP_MEMORY_SCOPE_AGENT);
        if (old + 1u == epoch * gridDim.x) {
            __hip_atomic_store(bar + 64, epoch, __ATOMIC_RELAXED, __HIP_MEMORY_SCOPE_AGENT);
        } else {
            while (__hip_atomic_load(bar + 64, __ATOMIC_RELAXED, __HIP_MEMORY_SCOPE_AGENT) < epoch) __builtin_amdgcn_s_sleep(1);
        }
        __builtin_amdgcn_fence(__ATOMIC_ACQUIRE, "agent");
        asm volatile("s_waitcnt vmcnt(0)" ::: "memory");
    }
    __syncthreads();
}

#define LDS_AS __attribute__((address_space(3)))
#define GLB_AS __attribute__((address_space(1)))
template <int MT, int SWAPMODE>
__device__ __forceinline__ void gemm_mainloop(f32x4 (&acc)[MT][4], const bf16_t* __restrict__ A, int lda, int a_kstep,
                                              const bf16_t* __restrict__ Bt, int ldb, int nk, unsigned char* lds, int tid) {
    constexpr int BMr = 64 * MT;
    constexpr int STAGE = (BMr + 128) * 128;
    const int wid = __builtin_amdgcn_readfirstlane(tid >> 6), lane = tid & 63, wr = wid >> 1, wc = wid & 1, fr = lane & 15, fq = lane >> 4;
    const int lrow = 8 * wid + (lane >> 3);
    const int lch = (lane & 7) ^ ((4 * wid + (lane >> 4)) & 7);
    const bf16_t* ap = A + (size_t)lrow * lda + lch * 8;
    const bf16_t* bp = Bt + (size_t)lrow * ldb + lch * 8;
    auto issue = [&](int kt, int st) {
        unsigned char* base = lds + st * STAGE + wid * 1024;
#pragma unroll
        for (int i = 0; i < MT; ++i)
            __builtin_amdgcn_global_load_lds((const GLB_AS unsigned*)(ap + (size_t)i * 64 * lda + (size_t)kt * a_kstep), (LDS_AS unsigned*)(base + i * 8192), 16, 0, 0);
#pragma unroll
        for (int i = 0; i < 2; ++i)
            __builtin_amdgcn_global_load_lds((const GLB_AS unsigned*)(bp + (size_t)i * 64 * ldb + (size_t)kt * 64), (LDS_AS unsigned*)(base + (BMr + i * 64) * 128), 16, 0, 0);
    };
    const bool sw = (SWAPMODE == 1) || (SWAPMODE == 2 && wc == 0);
    const int sz = fr >> 1;
    constexpr int NL = MT + 2;
    const bool late = wid >= 4;
    issue(0, 0);
    if (nk > 1) { issue(1, 1); asm volatile("s_waitcnt vmcnt(%0)" ::"n"(NL) : "memory"); }
    else asm volatile("s_waitcnt vmcnt(0)" ::: "memory");
    __builtin_amdgcn_s_barrier();
    asm volatile("" ::: "memory");
    int st = 0;
    for (int kt = 0; kt < nk; ++kt) {
        const int st2 = st >= 1 ? st - 1 : 2;
        if (!late && kt + 2 < nk) issue(kt + 2, st2);
        const unsigned char* As = lds + st * STAGE;
        const unsigned char* Bs = As + BMr * 128;
#pragma unroll
        for (int ks = 0; ks < 2; ++ks) {
            bf16x8 af[MT], bfr[4];
            const int co = ((ks * 4 + fq) ^ sz) * 16;
#pragma unroll
            for (int m = 0; m < MT; ++m) af[m] = *(const bf16x8*)(As + (wr * 16 * MT + m * 16 + fr) * 128 + co);
#pragma unroll
            for (int n = 0; n < 4; ++n) bfr[n] = *(const bf16x8*)(Bs + (wc * 64 + n * 16 + fr) * 128 + co);
            if (sw) {
#pragma unroll
                for (int m = 0; m < MT; ++m)
#pragma unroll
                    for (int n = 0; n < 4; ++n) acc[m][n] = __builtin_amdgcn_mfma_f32_16x16x32_bf16(bfr[n], af[m], acc[m][n], 0, 0, 0);
            } else {
#pragma unroll
                for (int m = 0; m < MT; ++m)
#pragma unroll
                    for (int n = 0; n < 4; ++n) acc[m][n] = __builtin_amdgcn_mfma_f32_16x16x32_bf16(af[m], bfr[n], acc[m][n], 0, 0, 0);
            }
        }
        if (late && kt + 2 < nk) issue(kt + 2, st2);
        if (kt + 2 < nk) asm volatile("s_waitcnt vmcnt(%0) lgkmcnt(0)" ::"n"(NL) : "memory");
        else asm volatile("s_waitcnt vmcnt(0) lgkmcnt(0)" ::: "memory");
        __builtin_amdgcn_s_barrier();
        asm volatile("" ::: "memory");
        st = st == 2 ? 0 : st + 1;
    }
}
__device__ __forceinline__ void gemm_mainloop256(f32x4 (&acc)[8][4], const bf16_t* __restrict__ A, int lda,
                                                 const bf16_t* __restrict__ Bt, int ldb, int nk, unsigned char* lds, int tid) {
    constexpr int STAGE = 512 * 128;
    const int wid = __builtin_amdgcn_readfirstlane(tid >> 6), lane = tid & 63, wr = wid >> 2, wc = wid & 3, fr = lane & 15, fq = lane >> 4;
    const int lrow = 8 * wid + (lane >> 3);
    const int lch = (lane & 7) ^ ((4 * wid + (lane >> 4)) & 7);
    const bf16_t* ap = A + (size_t)lrow * lda + lch * 8;
    const bf16_t* bp = Bt + (size_t)lrow * ldb + lch * 8;
    auto issue = [&](int kt, int st) {
        unsigned char* base = lds + st * STAGE + wid * 1024;
#pragma unroll
        for (int i = 0; i < 4; ++i)
            __builtin_amdgcn_global_load_lds((const GLB_AS unsigned*)(ap + (size_t)i * 64 * lda + (size_t)kt * 64), (LDS_AS unsigned*)(base + i * 8192), 16, 0, 0);
#pragma unroll
        for (int i = 0; i < 4; ++i)
            __builtin_amdgcn_global_load_lds((const GLB_AS unsigned*)(bp + (size_t)i * 64 * ldb + (size_t)kt * 64), (LDS_AS unsigned*)(base + (256 + i * 64) * 128), 16, 0, 0);
    };
    const int sz = fr >> 1;
    const bool late = wid >= 4;
    issue(0, 0);
    asm volatile("s_waitcnt vmcnt(0)" ::: "memory");
    __builtin_amdgcn_s_barrier();
    asm volatile("" ::: "memory");
    for (int kt = 0; kt < nk; ++kt) {
        if (!late && kt + 1 < nk) issue(kt + 1, (kt + 1) & 1);
        const unsigned char* As = lds + (kt & 1) * STAGE;
        const unsigned char* Bs = As + 256 * 128;
#pragma unroll
        for (int ks = 0; ks < 2; ++ks) {
            if (ks == 1 && late && kt + 1 < nk) issue(kt + 1, (kt + 1) & 1);
            bf16x8 af[8], bfr[4];
            const int co = ((ks * 4 + fq) ^ sz) * 16;
#pragma unroll
            for (int m = 0; m < 8; ++m) af[m] = *(const bf16x8*)(As + (wr * 128 + m * 16 + fr) * 128 + co);
#pragma unroll
            for (int n = 0; n < 4; ++n) bfr[n] = *(const bf16x8*)(Bs + (wc * 64 + n * 16 + fr) * 128 + co);
#pragma unroll
            for (int m = 0; m < 8; ++m)
#pragma unroll
                for (int n = 0; n < 4; ++n) acc[m][n] = __builtin_amdgcn_mfma_f32_16x16x32_bf16(bfr[n], af[m], acc[m][n], 0, 0, 0);
        }
        asm volatile("s_waitcnt vmcnt(0) lgkmcnt(0)" ::: "memory");
        __builtin_amdgcn_s_barrier();
        asm volatile("" ::: "memory");
    }
}
struct Seg { const bf16_t* A; const bf16_t* Bt; int lda, a_kstep, ldb, nk; };
template <int MT, int SWAPMODE>
__device__ __forceinline__ void gemm_stream(f32x4 (&acc)[MT][4], const Seg& cur, const Seg& nxt, bool has_next, bool first, int& st,
                                            unsigned char* lds, int tid) {
    constexpr int BMr = 64 * MT;
    constexpr int STAGE = (BMr + 128) * 128;
    constexpr int NL = MT + 2;
    const int wid = __builtin_amdgcn_readfirstlane(tid >> 6), lane = tid & 63, wr = wid >> 1, wc = wid & 1, fr = lane & 15, fq = lane >> 4;
    const int lrow = 8 * wid + (lane >> 3);
    const int lch = (lane & 7) ^ ((4 * wid + (lane >> 4)) & 7);
    const bf16_t* apc = cur.A + (size_t)lrow * cur.lda + lch * 8;
    const bf16_t* bpc = cur.Bt + (size_t)lrow * cur.ldb + lch * 8;
    const bf16_t* apn = nxt.A + (size_t)lrow * nxt.lda + lch * 8;
    const bf16_t* bpn = nxt.Bt + (size_t)lrow * nxt.ldb + lch * 8;
    auto issue = [&](const bf16_t* ap, const bf16_t* bp, int lda, int ldb, int koffa, int koffb, int slot) {
        unsigned char* base = lds + slot * STAGE + wid * 1024;
#pragma unroll
        for (int i = 0; i < MT; ++i)
            __builtin_amdgcn_global_load_lds((const GLB_AS unsigned*)(ap + (size_t)i * 64 * lda + koffa), (LDS_AS unsigned*)(base + i * 8192), 16, 0, 0);
#pragma unroll
        for (int i = 0; i < 2; ++i)
            __builtin_amdgcn_global_load_lds((const GLB_AS unsigned*)(bp + (size_t)i * 64 * ldb + koffb), (LDS_AS unsigned*)(base + (BMr + i * 64) * 128), 16, 0, 0);
    };
    const bool sw = (SWAPMODE == 1) || (SWAPMODE == 2 && wc == 0);
    const int sz = fr >> 1;
    const bool late = wid >= 4;
    const int nk = cur.nk;
    int s0 = st;
    if (first) {
        const int s1 = s0 == 2 ? 0 : s0 + 1;
        issue(apc, bpc, cur.lda, cur.ldb, 0, 0, s0);
        issue(apc, bpc, cur.lda, cur.ldb, cur.a_kstep, 64, s1);
        asm volatile("s_waitcnt vmcnt(%0)" ::"n"(NL) : "memory");
        __builtin_amdgcn_s_barrier();
        asm volatile("" ::: "memory");
    }
    for (int kt = 0; kt < nk; ++kt) {
        const int s2 = s0 >= 1 ? s0 - 1 : 2;
        const int idx = kt + 2;
        const bool incur = idx < nk, doi = incur || has_next;
        if (!late && doi) { if (incur) issue(apc, bpc, cur.lda, cur.ldb, idx * cur.a_kstep, idx * 64, s2); else issue(apn, bpn, nxt.lda, nxt.ldb, (idx - nk) * nxt.a_kstep, (idx - nk) * 64, s2); }
        const unsigned char* As = lds + s0 * STAGE;
        const unsigned char* Bs = As + BMr * 128;
#pragma unroll
        for (int ks = 0; ks < 2; ++ks) {
            bf16x8 af[MT], bfr[4];
            const int co = ((ks * 4 + fq) ^ sz) * 16;
#pragma unroll
            for (int m = 0; m < MT; ++m) af[m] = *(const bf16x8*)(As + (wr * 16 * MT + m * 16 + fr) * 128 + co);
#pragma unroll
            for (int n = 0; n < 4; ++n) bfr[n] = *(const bf16x8*)(Bs + (wc * 64 + n * 16 + fr) * 128 + co);
            if (sw) {
#pragma unroll
                for (int m = 0; m < MT; ++m)
#pragma unroll
                    for (int n = 0; n < 4; ++n) acc[m][n] = __builtin_amdgcn_mfma_f32_16x16x32_bf16(bfr[n], af[m], acc[m][n], 0, 0, 0);
            } else {
#pragma unroll
                for (int m = 0; m < MT; ++m)
#pragma unroll
                    for (int n = 0; n < 4; ++n) acc[m][n] = __builtin_amdgcn_mfma_f32_16x16x32_bf16(af[m], bfr[n], acc[m][n], 0, 0, 0);
            }
        }
        if (late && doi) { if (incur) issue(apc, bpc, cur.lda, cur.ldb, idx * cur.a_kstep, idx * 64, s2); else issue(apn, bpn, nxt.lda, nxt.ldb, (idx - nk) * nxt.a_kstep, (idx - nk) * 64, s2); }
        if (doi) asm volatile("s_waitcnt vmcnt(%0) lgkmcnt(0)" ::"n"(NL) : "memory");
        else asm volatile("s_waitcnt vmcnt(0) lgkmcnt(0)" ::: "memory");
        __builtin_amdgcn_s_barrier();
        asm volatile("" ::: "memory");
        s0 = s0 == 2 ? 0 : s0 + 1;
    }
    st = s0;
}
__device__ __forceinline__ void gemm_stream256(f32x4 (&acc)[8][4], const Seg& cur, const Seg& nxt, bool has_next, bool first, int& st, unsigned char* lds, int tid) {
    constexpr int STAGE = 512 * 128;
    const int wid = __builtin_amdgcn_readfirstlane(tid >> 6), lane = tid & 63, wr = wid >> 2, wc = wid & 3, fr = lane & 15, fq = lane >> 4;
    const int lrow = 8 * wid + (lane >> 3);
    const int lch = (lane & 7) ^ ((4 * wid + (lane >> 4)) & 7);
    const bf16_t* apc = cur.A + (size_t)lrow * cur.lda + lch * 8;
    const bf16_t* bpc = cur.Bt + (size_t)lrow * cur.ldb + lch * 8;
    const bf16_t* apn = nxt.A + (size_t)lrow * nxt.lda + lch * 8;
    const bf16_t* bpn = nxt.Bt + (size_t)lrow * nxt.ldb + lch * 8;
    auto issue = [&](const bf16_t* ap, const bf16_t* bp, int lda, int ldb, int koff, int slot) {
        unsigned char* base = lds + slot * STAGE + wid * 1024;
#pragma unroll
        for (int i = 0; i < 4; ++i)
            __builtin_amdgcn_global_load_lds((const GLB_AS unsigned*)(ap + (size_t)i * 64 * lda + koff), (LDS_AS unsigned*)(base + i * 8192), 16, 0, 0);
#pragma unroll
        for (int i = 0; i < 4; ++i)
            __builtin_amdgcn_global_load_lds((const GLB_AS unsigned*)(bp + (size_t)i * 64 * ldb + koff), (LDS_AS unsigned*)(base + (256 + i * 64) * 128), 16, 0, 0);
    };
    const int sz = fr >> 1;
    const bool late = wid >= 4;
    const int nk = cur.nk;
    int s0 = st;
    if (first) {
        issue(apc, bpc, cur.lda, cur.ldb, 0, s0);
        asm volatile("s_waitcnt vmcnt(0)" ::: "memory");
        __builtin_amdgcn_s_barrier();
        asm volatile("" ::: "memory");
    }
    for (int kt = 0; kt < nk; ++kt) {
        const int idx = kt + 1;
        const bool incur = idx < nk, doi = incur || has_next;
        if (!late && doi) { if (incur) issue(apc, bpc, cur.lda, cur.ldb, idx * 64, s0 ^ 1); else issue(apn, bpn, nxt.lda, nxt.ldb, 0, s0 ^ 1); }
        const unsigned char* As = lds + s0 * STAGE;
        const unsigned char* Bs = As + 256 * 128;
#pragma unroll
        for (int ks = 0; ks < 2; ++ks) {
            if (ks == 1 && late && doi) { if (incur) issue(apc, bpc, cur.lda, cur.ldb, idx * 64, s0 ^ 1); else issue(apn, bpn, nxt.lda, nxt.ldb, 0, s0 ^ 1); }
            bf16x8 af[8], bfr[4];
            const int co = ((ks * 4 + fq) ^ sz) * 16;
#pragma unroll
            for (int m = 0; m < 8; ++m) af[m] = *(const bf16x8*)(As + (wr * 128 + m * 16 + fr) * 128 + co);
#pragma unroll
            for (int n = 0; n < 4; ++n) bfr[n] = *(const bf16x8*)(Bs + (wc * 64 + n * 16 + fr) * 128 + co);
#pragma unroll
            for (int m = 0; m < 8; ++m)
#pragma unroll
                for (int n = 0; n < 4; ++n) acc[m][n] = __builtin_amdgcn_mfma_f32_16x16x32_bf16(bfr[n], af[m], acc[m][n], 0, 0, 0);
        }
        asm volatile("s_waitcnt vmcnt(0) lgkmcnt(0)" ::: "memory");
        __builtin_amdgcn_s_barrier();
        asm volatile("" ::: "memory");
        s0 ^= 1;
    }
    st = s0;
}
__device__ __forceinline__ void gemm_gate3(f32x4 (&g)[3][2][4], const bf16_t* __restrict__ A, const bf16_t* __restrict__ Bt0, int nk, unsigned char* lds, int tid) {
    constexpr int STAGE = 512 * 128;
    const int wid = __builtin_amdgcn_readfirstlane(tid >> 6), lane = tid & 63, wr = wid >> 1, wc = wid & 1, fr = lane & 15, fq = lane >> 4;
    const int lrow = 8 * wid + (lane >> 3);
    const int lch = (lane & 7) ^ ((4 * wid + (lane >> 4)) & 7);
    const unsigned loff = (unsigned)(lrow * 1024 + lch * 8);
    auto issue = [&](int kt, int stg) {
        unsigned char* base = lds + stg * STAGE + wid * 1024;
#pragma unroll
        for (int i = 0; i < 2; ++i)
            __builtin_amdgcn_global_load_lds((const GLB_AS unsigned*)((A + (size_t)i * 64 * 1024 + (size_t)kt * 64) + loff), (LDS_AS unsigned*)(base + i * 8192), 16, 0, 0);
#pragma unroll
        for (int j = 0; j < 6; ++j)
            __builtin_amdgcn_global_load_lds((const GLB_AS unsigned*)((Bt0 + ((size_t)(j >> 1) * 1024 + (j & 1) * 64) * 1024 + (size_t)kt * 64) + loff), (LDS_AS unsigned*)(base + (128 + j * 64) * 128), 16, 0, 0);
    };
    const int sz = fr >> 1;
    const bool late = wid >= 4;
    issue(0, 0);
    asm volatile("s_waitcnt vmcnt(0)" ::: "memory");
    __builtin_amdgcn_s_barrier();
    asm volatile("" ::: "memory");
    for (int kt = 0; kt < nk; ++kt) {
        if (!late && kt + 1 < nk) issue(kt + 1, (kt + 1) & 1);
        const unsigned char* As = lds + (kt & 1) * STAGE;
        const unsigned char* Bs = As + 128 * 128;
#pragma unroll
        for (int ks = 0; ks < 2; ++ks) {
            if (ks == 1 && late && kt + 1 < nk) issue(kt + 1, (kt + 1) & 1);
            const int co = ((ks * 4 + fq) ^ sz) * 16;
            bf16x8 af[2];
#pragma unroll
            for (int m = 0; m < 2; ++m) af[m] = *(const bf16x8*)(As + (wr * 32 + m * 16 + fr) * 128 + co);
#pragma unroll
            for (int i = 0; i < 3; ++i) {
                bf16x8 bfr[4];
#pragma unroll
                for (int n = 0; n < 4; ++n) bfr[n] = *(const bf16x8*)(Bs + (i * 128 + wc * 64 + n * 16 + fr) * 128 + co);
#pragma unroll
                for (int m = 0; m < 2; ++m)
#pragma unroll
                    for (int n = 0; n < 4; ++n) g[i][m][n] = __builtin_amdgcn_mfma_f32_16x16x32_bf16(bfr[n], af[m], g[i][m][n], 0, 0, 0);
                if (i < 2) __builtin_amdgcn_sched_barrier(0);
            }
        }
        asm volatile("s_waitcnt vmcnt(0) lgkmcnt(0)" ::: "memory");
        __builtin_amdgcn_s_barrier();
        asm volatile("" ::: "memory");
    }
}
template <int MT> __device__ __forceinline__ void zero_acc(f32x4 (&acc)[MT][4]) {
#pragma unroll
    for (int m = 0; m < MT; ++m)
#pragma unroll
        for (int n = 0; n < 4; ++n) acc[m][n] = (f32x4){0.f, 0.f, 0.f, 0.f};
}
__device__ __forceinline__ void tile_mn(int t, int nN, int& mt, int& nt) { const int per = 16 * nN, g = t / per, w = t % per; mt = g * 16 + (w & 15); nt = w >> 4; }

__device__ __forceinline__ int rowmap(int mode, int n) {
    if (mode == 1) return n < 672 ? n : n + 96;
    if (mode == 2) return n < DFF ? ((n >> 5) * 64 + (n & 31)) : (((n - DFF) >> 5) * 64 + 32 + ((n - DFF) & 31));
    return n;
}
__device__ __forceinline__ void convert_T(const float* __restrict__ src, int K, int N, bf16_t* __restrict__ dst, int mode, const float* __restrict__ ks, unsigned char* lds, int rot) {
    float* tile = (float*)lds;
    const int ntk = K / 64, ntn = (N + 63) / 64, tid = ltid();
    const int start = (blockIdx.x + gridDim.x - (rot % gridDim.x)) % gridDim.x;
    for (int t = start; t < ntk * ntn; t += gridDim.x) {
        const int tk = t % ntk, tn = t / ntk, k0 = tk * 64, n0 = tn * 64;
#pragma unroll
        for (int i = 0; i < 8; ++i) {
            const int kl = (tid >> 6) + 8 * i, nl = tid & 63, n = n0 + nl;
            tile[kl * 65 + nl] = n < N ? src[(size_t)(k0 + kl) * N + n] : 0.f;
        }
        __syncthreads();
        const int kp = (tid & 31) * 2;
        float s0 = 1.f, s1 = 1.f;
        if (ks) { s0 = ks[k0 + kp]; s1 = ks[k0 + kp + 1]; }
#pragma unroll
        for (int i = 0; i < 4; ++i) {
            const int nl = (tid >> 5) + 16 * i, n = n0 + nl;
            if (n < N) *(unsigned*)(dst + (size_t)rowmap(mode, n) * K + k0 + kp) = pk_bf16(tile[kp * 65 + nl] * s0, tile[(kp + 1) * 65 + nl] * s1);
        }
        __syncthreads();
    }
}
__device__ __forceinline__ void convert_layer(const Params& pin, int l, unsigned char* lds) {
    const Params p = launder(pin); l = launder_i(l);
    bf16_t* W = (bf16_t*)(p.ws + OFF_W);
    convert_T(p.w_in + (size_t)l * DM * DIN, DM, DIN, W + WO_IN, 1, nullptr, lds, 0);
    convert_T(p.ffn_w13 + (size_t)l * DM * 2 * DFF, DM, 2 * DFF, W + WO_13, 2, nullptr, lds, 40);
    convert_T(p.ffn_w2 + (size_t)l * DFF * DM, DFF, DM, W + WO_2, 0, nullptr, lds, 80);
    convert_T(p.w_out + (size_t)l * DM * DM, DM, DM, W + WO_OUT, 0, nullptr, lds, 120);
    convert_T(p.w_o_attn + (size_t)l * 512 * DM, 512, DM, W + WO_OA, 0, nullptr, lds, 136);
    convert_T(p.w_o_conv + (size_t)l * 512 * DM, 512, DM, W + WO_OC, 0, nullptr, lds, 8);
    convert_T(p.w_o_rwkv + (size_t)l * 512 * DM, 512, DM, W + WO_OR, 0, nullptr, lds, 136 + 8);
    convert_T(p.w_uq + (size_t)l * 384 * 768, 384, 768, W + WO_UQ, 0, p.q_norm + l * 384, lds, 16);
    convert_T(p.w_ukv + (size_t)l * 256 * 1024, 256, 1024, W + WO_UKV, 0, p.kv_norm + l * 256, lds, 88);
    for (int z = 0; z < 2; ++z) {
        convert_T(p.rw_w_up + ((size_t)l * 2 + z) * 64 * 512, 64, 512, W + WO_UP + (size_t)z * 512 * 64, 0, nullptr, lds, 152 + 8 * z);
        convert_T(p.rw_a_up + ((size_t)l * 2 + z) * 64 * 512, 64, 512, W + WO_AUP + (size_t)z * 512 * 64, 0, nullptr, lds, 168 + 8 * z);
    }
    convert_T(p.rw_g_up + (size_t)l * 128 * 512, 128, 512, W + WO_GUP, 0, nullptr, lds, 184);
}

__device__ __forceinline__ void modv_phase(const Params& pin, unsigned char* lds) {
    const Params p = launder(pin);
    float* s = (float*)lds;
    float* red = s + 17 * 1024;
    const int tid = ltid(), wid = tid >> 6, lane = tid & 63;
    for (int i = tid; i < 17 * 1024; i += NTHREADS) { const int r = i >> 10, k = i & 1023; const float v = r < 16 ? p.c[r * 1024 + k] : p.c_ctx[k]; s[i] = siluf_(v); }
    __syncthreads();
    float* modv = (float*)(p.ws + OFF_MODV);
    for (int g = blockIdx.x; g < 4 * 96; g += gridDim.x) {
        const int l = g / 96, n = (g % 96) * 64 + lane;
        const float* w = p.mod_w + (size_t)l * 1024 * 6144 + n;
        float acc[17];
#pragma unroll
        for (int r = 0; r < 17; ++r) acc[r] = 0.f;
        const int kb = wid * 128;
        for (int k = kb; k < kb + 128; k += 4) {
            const float w0 = w[(size_t)k * 6144], w1 = w[(size_t)(k + 1) * 6144], w2 = w[(size_t)(k + 2) * 6144], w3 = w[(size_t)(k + 3) * 6144];
#pragma unroll
            for (int r = 0; r < 17; ++r) { const f32x4 sv = *(const f32x4*)(s + r * 1024 + k); acc[r] += sv[0] * w0 + sv[1] * w1 + sv[2] * w2 + sv[3] * w3; }
        }
#pragma unroll
        for (int r = 0; r < 17; ++r) red[(wid * 17 + r) * 64 + lane] = acc[r];
        __syncthreads();
        for (int i = tid; i < 17 * 64; i += NTHREADS) {
            const int r = i >> 6, c = i & 63; float v = 0.f;
#pragma unroll
            for (int w8 = 0; w8 < 8; ++w8) v += red[(w8 * 17 + r) * 64 + c];
            const int nn = (g % 96) * 64 + c;
            modv[((size_t)l * 17 + r) * 6144 + nn] = v + p.mod_b[l * 6144 + nn];
        }
        __syncthreads();
    }
    if (blockIdx.x == gridDim.x - 1) {
        float* rope = (float*)(p.ws + OFF_ROPE);
        for (int i = tid; i < 512; i += NTHREADS) {
            const int pos = i >> 3, f = i & 7;
            const float inv = exp2f(-(float)f * (13.287712379549449f / 8.0f));
            const float ang = (float)pos * inv;
            rope[i * 2] = cosf(ang); rope[i * 2 + 1] = sinf(ang);
        }
    }
}

__device__ __forceinline__ void xmod0_phase(const Params& pin) {
    const Params p = launder(pin);
    const int tid = ltid(), wid = tid >> 6, lane = tid & 63;
    bf16_t* xm = (bf16_t*)(p.ws + OFF_R6);
    for (int row = blockIdx.x * 8 + wid; row < MROWS; row += gridDim.x * 8) {
        const int b = row / TPB, pp = row % TPB;
        const float* xp = x_rd(p, true, b, pp);
        const float* mv = modv_ptr(p, 0, b, pp);
#pragma unroll
        for (int i = 0; i < 4; ++i) {
            const int c = i * 256 + lane * 4;
            const f32x4 v = *(const f32x4*)(xp + c), sh = *(const f32x4*)(mv + c), sc = *(const f32x4*)(mv + 1024 + c);
            uint2 o; o.x = pk_bf16(v[0] * (1.f + sc[0]) + sh[0], v[1] * (1.f + sc[1]) + sh[1]); o.y = pk_bf16(v[2] * (1.f + sc[2]) + sh[2], v[3] * (1.f + sc[3]) + sh[3]);
            *(uint2*)(xm + (size_t)row * 1024 + c) = o;
        }
    }
}

__device__ __forceinline__ void p1_phase(const Params& pin, unsigned char* lds) {
    const Params p = launder(pin); const int tid = ltid();
    const bf16_t* A = (const bf16_t*)(p.ws + OFF_R6);
    const bf16_t* W = (const bf16_t*)(p.ws + OFF_W) + WO_IN;
    const int lane = tid & 63, wid = tid >> 6, wr = wid >> 2, wc = wid & 3, fr = lane & 15, fq = lane >> 4;
    auto seg = [&](int t) { int mt, nt; tile_mn(t, 17, mt, nt); Seg g; g.A = A + (size_t)mt * 256 * 1024; g.Bt = W + (size_t)nt * 256 * 1024; g.lda = 1024; g.a_kstep = 64; g.ldb = 1024; g.nk = 16; return g; };
    int st = 0; bool first = true;
    for (int t = blockIdx.x; t < 144 * 17; t += gridDim.x) {
        int mt, nt; tile_mn(t, 17, mt, nt);
        const int tn = t + gridDim.x; const bool hn = tn < 144 * 17;
        f32x4 acc[8][4]; zero_acc<8>(acc);
        gemm_stream256(acc, seg(t), seg(hn ? tn : t), hn, first, st, lds, tid); first = false;
        bf16_t* dst; int ld, cb, lim;
        if (nt < 3) { dst = (bf16_t*)(p.ws + OFF_R1); ld = 672; cb = nt * 256; lim = 672; }
        else if (nt < 9) { dst = (bf16_t*)(p.ws + OFF_R2); ld = 1536; cb = (nt - 3) * 256; lim = 1536; }
        else { dst = (bf16_t*)(p.ws + OFF_R3); ld = 1920; cb = (nt - 9) * 256; lim = 1920; }
#pragma unroll
        for (int m = 0; m < 8; ++m) {
            const size_t row = (size_t)mt * 256 + wr * 128 + m * 16 + fr;
#pragma unroll
            for (int n = 0; n < 4; n += 2) {
                uint2 a, b2;
                a.x = pk_bf16(acc[m][n][0], acc[m][n][1]); a.y = pk_bf16(acc[m][n][2], acc[m][n][3]);
                b2.x = pk_bf16(acc[m][n + 1][0], acc[m][n + 1][1]); b2.y = pk_bf16(acc[m][n + 1][2], acc[m][n + 1][3]);
                const uint4 w = widen16(a, b2);
                const int col = cb + wc * 64 + (n + (fq & 1)) * 16 + (fq >> 1) * 8;
                if (col < lim) *(uint4*)(dst + row * ld + col) = w;
            }
        }
    }
}

__device__ __forceinline__ void unpack8(const uint4 u, float (&f)[8]) {
    f[0] = bf_lo(u.x); f[1] = bf_hi(u.x); f[2] = bf_lo(u.y); f[3] = bf_hi(u.y); f[4] = bf_lo(u.z); f[5] = bf_hi(u.z); f[6] = bf_lo(u.w); f[7] = bf_hi(u.w);
}
__device__ __forceinline__ void p2a_phase(const Params& pin, int l) {
    const Params p = launder(pin); l = launder_i(l);
    const int tid = ltid(), wid = tid >> 6, lane = tid & 63;
    const bf16_t* Hm = (const bf16_t*)(p.ws + OFF_R1);
    const bf16_t* Hc = (const bf16_t*)(p.ws + OFF_R2);
    bf16_t* CV = (bf16_t*)(p.ws + OFF_R5);
    bf16_t* KR = (bf16_t*)(p.ws + OFF_KR);
    float* RSQ = (float*)(p.ws + OFF_RSQ);
    float* RSKV = (float*)(p.ws + OFF_RSKV);
    const float* rope = (const float*)(p.ws + OFF_ROPE);
    const float* cw = p.conv_w + (size_t)l * 3 * 512;
    const int c0 = lane * 8;
    float w0[8], w1[8], w2[8];
#pragma unroll
    for (int i = 0; i < 8; ++i) { w0[i] = cw[c0 + i]; w1[i] = cw[512 + c0 + i]; w2[i] = cw[1024 + c0 + i]; }
    for (int row = blockIdx.x * 8 + wid; row < MROWS; row += gridDim.x * 8) {
        const int pp = row % TPB;
        const bool hp = (pp != 0 && pp != CTXL), hn = (pp != CTXL - 1 && pp != TPB - 1);
        const bf16_t* hr = Hc + (size_t)row * 1536;
        float ch[8], cc[8], cb[8], u0[8], u1[8], u2[8];
        unpack8(*(const uint4*)(hr + c0), ch); unpack8(*(const uint4*)(hr + 1024 + c0), cc); unpack8(*(const uint4*)(hr + 512 + c0), cb);
#pragma unroll
        for (int i = 0; i < 8; ++i) u1[i] = cc[i] * ch[i];
        if (hp) { unpack8(*(const uint4*)(hr - 1536 + c0), ch); unpack8(*(const uint4*)(hr - 1536 + 1024 + c0), cc);
#pragma unroll
            for (int i = 0; i < 8; ++i) u0[i] = cc[i] * ch[i]; }
        else {
#pragma unroll
            for (int i = 0; i < 8; ++i) u0[i] = 0.f; }
        if (hn) { unpack8(*(const uint4*)(hr + 1536 + c0), ch); unpack8(*(const uint4*)(hr + 1536 + 1024 + c0), cc);
#pragma unroll
            for (int i = 0; i < 8; ++i) u2[i] = cc[i] * ch[i]; }
        else {
#pragma unroll
            for (int i = 0; i < 8; ++i) u2[i] = 0.f; }
        float o[8];
#pragma unroll
        for (int i = 0; i < 8; ++i) o[i] = cb[i] * (u0[i] * w0[i] + u1[i] * w1[i] + u2[i] * w2[i]);
        uint4 ov; ov.x = pk_bf16(o[0], o[1]); ov.y = pk_bf16(o[2], o[3]); ov.z = pk_bf16(o[4], o[5]); ov.w = pk_bf16(o[6], o[7]);
        *(uint4*)(CV + (size_t)row * 512 + c0) = ov;
        const bf16_t* hm = Hm + (size_t)row * 672;
        float sq = 0.f, skv = 0.f;
        if (lane < 48) { float f[8]; unpack8(*(const uint4*)(hm + lane * 8), f);
#pragma unroll
            for (int i = 0; i < 8; ++i) sq += f[i] * f[i]; }
        if (lane < 32) { float f[8]; unpack8(*(const uint4*)(hm + 384 + lane * 8), f);
#pragma unroll
            for (int i = 0; i < 8; ++i) skv += f[i] * f[i]; }
        sq = wave_sum(sq); skv = wave_sum(skv);
        if (lane == 0) { RSQ[row] = __builtin_amdgcn_rsqf(sq * (1.0f / 384.0f) + 1e-6f); RSKV[row] = __builtin_amdgcn_rsqf(skv * (1.0f / 256.0f) + 1e-6f); }
        {
            const int j = lane & 31;
            float v = bf1(hm[640 + j]);
            const float other = xor8_get(v);
            if (pp >= CTXL) {
                const int tt = pp - CTXL;
                const int pos = (j < 16) ? (tt >> 6) : (tt & 63);
                const float cs = rope[(pos * 8 + (j & 7)) * 2], sn = rope[(pos * 8 + (j & 7)) * 2 + 1];
                v = (j & 8) ? (other * sn + v * cs) : (v * cs - other * sn);
            }
            if (lane < 32) KR[(size_t)row * 32 + j] = (bf16_t)(pk_bf16(v, v) & 0xffffu);
        }
    }
}

__device__ __forceinline__ void p2b_phase(const Params& pin, int l, unsigned char* lds) {
    const Params p = launder(pin); l = launder_i(l); const int tid = ltid();
    const bf16_t* Hm = (const bf16_t*)(p.ws + OFF_R1);
    const bf16_t* W = (const bf16_t*)(p.ws + OFF_W);
    const float* RSQ = (const float*)(p.ws + OFF_RSQ);
    const float* RSKV = (const float*)(p.ws + OFF_RSKV);
    const float* rope = (const float*)(p.ws + OFF_ROPE);
    bf16_t* Q = (bf16_t*)(p.ws + OFF_Q);
    bf16_t* KN = (bf16_t*)(p.ws + OFF_KN);
    bf16_t* VT = (bf16_t*)(p.ws + OFF_VT);
    const int lane = tid & 63, wid = tid >> 6, wr = wid >> 1, wc = wid & 1, fr = lane & 15, fq = lane >> 4;
    const int NQ = 144 * 6, NKV = 144 * 8;
    for (int t = blockIdx.x; t < NQ + NKV; t += gridDim.x) {
        f32x4 acc[4][4]; zero_acc<4>(acc);
        if (t < NQ) {
            int mt, nt; tile_mn(t, 6, mt, nt);
            gemm_mainloop<4, 1>(acc, Hm + (size_t)mt * 256 * 672, 672, 64, W + WO_UQ + (size_t)nt * 128 * 384, 384, 6, lds, tid);
            const int pp0 = (mt % 9) * 256; const bool latent = pp0 >= CTXL;
#pragma unroll
            for (int m = 0; m < 4; ++m) {
                const int lrow = wr * 64 + m * 16 + fr;
                const size_t row = (size_t)mt * 256 + lrow;
                const float sc = RSQ[row] * QSCALE;
                const int tt = pp0 + lrow - CTXL;
                uint2 qpk[4];
#pragma unroll
                for (int n = 0; n < 4; ++n) {
                    const int c16 = nt * 128 + wc * 64 + n * 16, r96 = c16 % 96;
                    float v[4];
#pragma unroll
                    for (int j = 0; j < 4; ++j) v[j] = acc[m][n][j] * sc;
                    if (latent && r96 >= 64) {
                        const int pos = (r96 == 64) ? (tt >> 6) : (tt & 63);
#pragma unroll
                        for (int j = 0; j < 4; ++j) {
                            const float other = xor32_get(v[j], lane);
                            const int fi = (fq & 1) * 4 + j;
                            const float cs = rope[(pos * 8 + fi) * 2], sn = rope[(pos * 8 + fi) * 2 + 1];
                            v[j] = (fq & 2) ? (other * sn + v[j] * cs) : (v[j] * cs - other * sn);
                        }
                    }
                    qpk[n].x = pk_bf16(v[0], v[1]); qpk[n].y = pk_bf16(v[2], v[3]);
                }
#pragma unroll
                for (int n = 0; n < 4; n += 2)
                    *(uint4*)(Q + row * 768 + nt * 128 + wc * 64 + (n + (fq & 1)) * 16 + (fq >> 1) * 8) = widen16(qpk[n], qpk[n + 1]);
            }
        } else {
            int mt, nt; tile_mn(t - NQ, 8, mt, nt);
            gemm_mainloop<4, 2>(acc, Hm + (size_t)mt * 256 * 672 + 384, 672, 64, W + WO_UKV + (size_t)nt * 128 * 256, 256, 4, lds, tid);
            const int b = mt / 9, pp0 = (mt % 9) * 256;
            if (wc == 0) {
#pragma unroll
                for (int m = 0; m < 4; ++m) {
                    const size_t row = (size_t)mt * 256 + wr * 64 + m * 16 + fr;
                    const float sc = RSKV[row];
#pragma unroll
                    for (int n = 0; n < 4; n += 2) {
                        uint2 a, b2;
                        a.x = pk_bf16(acc[m][n][0] * sc, acc[m][n][1] * sc); a.y = pk_bf16(acc[m][n][2] * sc, acc[m][n][3] * sc);
                        b2.x = pk_bf16(acc[m][n + 1][0] * sc, acc[m][n + 1][1] * sc); b2.y = pk_bf16(acc[m][n + 1][2] * sc, acc[m][n + 1][3] * sc);
                        *(uint4*)(KN + row * 512 + nt * 64 + (n + (fq & 1)) * 16 + (fq >> 1) * 8) = widen16(a, b2);
                    }
                }
            } else {
#pragma unroll
                for (int m = 0; m < 4; ++m) {
                    const int lrow = wr * 64 + m * 16 + fq * 4;
                    const f32x4 sc = *(const f32x4*)(RSKV + (size_t)mt * 256 + lrow);
#pragma unroll
                    for (int n = 0; n < 4; n += 2) {
                        uint2 a, b2;
                        a.x = pk_bf16(acc[m][n][0] * sc[0], acc[m][n][1] * sc[1]); a.y = pk_bf16(acc[m][n][2] * sc[2], acc[m][n][3] * sc[3]);
                        b2.x = pk_bf16(acc[m][n + 1][0] * sc[0], acc[m][n + 1][1] * sc[1]); b2.y = pk_bf16(acc[m][n + 1][2] * sc[2], acc[m][n + 1][3] * sc[3]);
                        const int dv = (n + (fq & 1)) * 16 + fr;
                        *(uint4*)(VT + ((size_t)(b * 8 + nt) * 64 + dv) * TPB + pp0 + wr * 64 + m * 16 + (fq >> 1) * 8) = widen16(a, b2);
                    }
                }
            }
        }
    }
    {
        const bf16_t* Hr = (const bf16_t*)(p.ws + OFF_R3);
        bf16_t* SG = (bf16_t*)(p.ws + OFF_SG);
        const float* mu = p.rw_mu + (size_t)l * 1920 + 1792;
        for (int i = blockIdx.x * NTHREADS + tid; i < MROWS * 16; i += gridDim.x * NTHREADS) {
            const int row = i >> 4, c0 = (i & 15) * 8, pp = row % TPB;
            const bool hp = (pp != 0 && pp != CTXL), hn = (pp != CTXL - 1 && pp != TPB - 1);
            const bf16_t* hr = Hr + (size_t)row * 1920 + 1792 + c0;
            float cur[8], pv[8], nx[8];
            unpack8(*(const uint4*)hr, cur);
            if (hp) unpack8(*(const uint4*)(hr - 1920), pv); else {
#pragma unroll
                for (int k = 0; k < 8; ++k) pv[k] = 0.f; }
            if (hn) unpack8(*(const uint4*)(hr + 1920), nx); else {
#pragma unroll
                for (int k = 0; k < 8; ++k) nx[k] = 0.f; }
            float o[8];
#pragma unroll
            for (int k = 0; k < 8; ++k) o[k] = sigmoidf_(cur[k] + (0.5f * (pv[k] + nx[k]) - cur[k]) * mu[c0 + k]);
            uint4 ov; ov.x = pk_bf16(o[0], o[1]); ov.y = pk_bf16(o[2], o[3]); ov.z = pk_bf16(o[4], o[5]); ov.w = pk_bf16(o[6], o[7]);
            *(uint4*)(SG + (size_t)row * 128 + c0) = ov;
        }
    }
}

#define FMAC_BC(acc, coef, s, J) asm("v_fmac_f32_dpp %0, %1, %2 row_newbcast:" #J " row_mask:0xf bank_mask:0xf" : "+v"(acc) : "v"(coef), "v"(s))
#define MUL_BC(dst, coef, s, J) asm("v_mul_f32_dpp %0, %1, %2 row_newbcast:" #J " row_mask:0xf bank_mask:0xf" : "=v"(dst) : "v"(coef), "v"(s))
#define REP16(X) X(0, 0) X(1, 1) X(2, 2) X(3, 3) X(4, 0) X(5, 1) X(6, 2) X(7, 3) X(8, 0) X(9, 1) X(10, 2) X(11, 3) X(12, 0) X(13, 1) X(14, 2) X(15, 3)
constexpr int FSTR = 6 * 64 + 4;
constexpr int CHUNK = 32, NCHUNK = TPB / CHUNK;

__device__ __forceinline__ int scan_pos(int z, int s) { return z == 0 ? s : (s < CTXL ? (CTXL - 1 - s) : (TPB + CTXL - 1 - s)); }

__device__ __forceinline__ void shift4(const bf16_t* hr, bool hp, bool hn, int col, const float* mu, float (&o)[4]) {
    const uint2 c = *(const uint2*)(hr + col);
    uint2 a = make_uint2(0u, 0u), b = make_uint2(0u, 0u);
    if (hp) a = *(const uint2*)(hr - 1920 + col);
    if (hn) b = *(const uint2*)(hr + 1920 + col);
    const f32x4 m = *(const f32x4*)(mu + col);
    const float cv[4] = {bf_lo(c.x), bf_hi(c.x), bf_lo(c.y), bf_hi(c.y)};
    const float av[4] = {bf_lo(a.x), bf_hi(a.x), bf_lo(a.y), bf_hi(a.y)};
    const float bv[4] = {bf_lo(b.x), bf_hi(b.x), bf_lo(b.y), bf_hi(b.y)};
#pragma unroll
    for (int i = 0; i < 4; ++i) o[i] = cv[i] + (0.5f * (av[i] + bv[i]) - cv[i]) * m[i];
}
__device__ __forceinline__ void shift8(const bf16_t* hr, bool hp, bool hn, int col, const float* mu, float (&o)[8]) {
    float cv[8], av[8], bv[8];
    unpack8(*(const uint4*)(hr + col), cv);
    if (hp) unpack8(*(const uint4*)(hr - 1920 + col), av); else {
#pragma unroll
        for (int i = 0; i < 8; ++i) av[i] = 0.f; }
    if (hn) unpack8(*(const uint4*)(hr + 1920 + col), bv); else {
#pragma unroll
        for (int i = 0; i < 8; ++i) bv[i] = 0.f; }
#pragma unroll
    for (int i = 0; i < 8; ++i) o[i] = cv[i] + (0.5f * (av[i] + bv[i]) - cv[i]) * mu[col + i];
}
__device__ __forceinline__ bf16x8 pack8(const float (&f)[8]) {
    union { uint4 u; bf16x8 v; } r;
    r.u.x = pk_bf16(f[0], f[1]); r.u.y = pk_bf16(f[2], f[3]); r.u.z = pk_bf16(f[4], f[5]); r.u.w = pk_bf16(f[6], f[7]);
    return r.v;
}

struct ProdState { f32x4 aw[4], aa[4]; };
struct Raw3x2 { uint2 c, a, b; };
__device__ __forceinline__ Raw3x2 ld3x2(const bf16_t* pc, const bf16_t* pa, const bf16_t* pb, bool hp, bool hn, int col) {
    Raw3x2 r; r.c = *(const uint2*)(pc + col); r.a = *(const uint2*)(pa + col); r.b = *(const uint2*)(pb + col);
    return r;
}
__device__ __forceinline__ void sh4(const Raw3x2& r, const f32x4 m, float (&o)[4]) {
    const float cv[4] = {bf_lo(r.c.x), bf_hi(r.c.x), bf_lo(r.c.y), bf_hi(r.c.y)};
    const float av[4] = {bf_lo(r.a.x), bf_hi(r.a.x), bf_lo(r.a.y), bf_hi(r.a.y)};
    const float bv[4] = {bf_lo(r.b.x), bf_hi(r.b.x), bf_lo(r.b.y), bf_hi(r.b.y)};
#pragma unroll
    for (int i = 0; i < 4; ++i) o[i] = cv[i] + (0.5f * (av[i] + bv[i]) - cv[i]) * m[i];
}
struct Raw3x4 { uint4 c, a, b; };
__device__ __forceinline__ Raw3x4 ld3x4(const bf16_t* pc, const bf16_t* pa, const bf16_t* pb, bool hp, bool hn, int col) {
    Raw3x4 r; r.c = *(const uint4*)(pc + col); r.a = *(const uint4*)(pa + col); r.b = *(const uint4*)(pb + col);
    return r;
}
__device__ __forceinline__ void sh8(const Raw3x4& r, const float* m, float (&o)[8]) {
    float cv[8], av[8], bv[8];
    unpack8(r.c, cv); unpack8(r.a, av); unpack8(r.b, bv);
    const f32x4 m0 = *(const f32x4*)m, m1 = *(const f32x4*)(m + 4);
#pragma unroll
    for (int i = 0; i < 8; ++i) o[i] = cv[i] + (0.5f * (av[i] + bv[i]) - cv[i]) * (i < 4 ? m0[i] : m1[i - 4]);
}
template <int N0>
__device__ __forceinline__ void scan_produce_elem(const float* pl, int fq, const Raw3x2 (&rr)[2], const Raw3x2 (&rk)[2], const Raw3x2 (&rv)[2],
                                                  const f32x4 (&aw)[2], const f32x4 (&aa)[2], float& ss, float* frow) {
#pragma unroll
    for (int nn = 0; nn < 2; ++nn) {
        const int n = N0 + nn;
        const int c4 = n * 16 + fq * 4;
        float r4[4], k4[4], v4[4];
        sh4(rr[nn], *(const f32x4*)(pl + 0 * 64 + c4), r4);
        sh4(rk[nn], *(const f32x4*)(pl + 1 * 64 + c4), k4);
        sh4(rv[nn], *(const f32x4*)(pl + 2 * 64 + c4), v4);
        const f32x4 w0 = *(const f32x4*)(pl + 3 * 64 + c4);
        const f32x4 a0 = *(const f32x4*)(pl + 4 * 64 + c4);
        const f32x4 kkp = *(const f32x4*)(pl + 5 * 64 + c4);
        const f32x4 kap = *(const f32x4*)(pl + 6 * 64 + c4);
        f32x4 dw, kd, kf4, a4;
#pragma unroll
        for (int j = 0; j < 4; ++j) {
            const float sgx = __builtin_amdgcn_rcpf(1.0f + fexp(-(aw[nn][j] + w0[j])));
            dw[j] = fexp(-0.6065306597126334f * sgx);
            const float a = __builtin_amdgcn_rcpf(1.0f + fexp(-(aa[nn][j] + a0[j])));
            a4[j] = a;
            const float kf = k4[j] * kkp[j];
            kf4[j] = kf; ss += kf * kf;
            kd[j] = k4[j] * (1.0f + (a - 1.0f) * kap[j]);
        }
        *(f32x4*)(frow + 0 * 64 + c4) = kf4;
        *(f32x4*)(frow + 1 * 64 + c4) = dw;
        *(f32x4*)(frow + 2 * 64 + c4) = a4;
        *(f32x4*)(frow + 3 * 64 + c4) = kd;
        *(f32x4*)(frow + 4 * 64 + c4) = (f32x4){r4[0], r4[1], r4[2], r4[3]};
        *(f32x4*)(frow + 5 * 64 + c4) = (f32x4){v4[0], v4[1], v4[2], v4[3]};
    }
}
__device__ __forceinline__ void scan_produce_A(const Params& p, const float* pl, int b, int h, int z, int s0, float* frow0, int lane, ProdState& st) {
    const int fr = lane & 15, fq = lane >> 4;
    const int pp = scan_pos(z, s0 + fr);
    const bool hp = (pp != 0 && pp != CTXL), hn = (pp != CTXL - 1 && pp != TPB - 1);
    const bf16_t* hr = (const bf16_t*)(p.ws + OFF_R3) + ((size_t)b * TPB + pp) * 1920;
    const bf16_t* W = (const bf16_t*)(p.ws + OFF_W);
    Raw3x4 qw[2], qa[2];
    const bf16_t* zr = (const bf16_t*)(p.ws + OFF_ZROW) + z * 64 + fq * 8;
    const bf16_t* pc = hr + z * 64 + fq * 8; const bf16_t* pa = hp ? pc - 1920 : zr; const bf16_t* pb = hn ? pc + 1920 : zr;
#pragma unroll
    for (int ks = 0; ks < 2; ++ks) { qw[ks] = ld3x4(pc, pa, pb, hp, hn, 1536 + ks * 32); qa[ks] = ld3x4(pc, pa, pb, hp, hn, 1664 + ks * 32); }
    f32x4 accw[4], acca[4];
#pragma unroll
    for (int n = 0; n < 4; ++n) { accw[n] = (f32x4){0.f, 0.f, 0.f, 0.f}; acca[n] = (f32x4){0.f, 0.f, 0.f, 0.f}; }
#pragma unroll
    for (int ks = 0; ks < 2; ++ks) {
        bf16x8 bw[4], ba[4];
#pragma unroll
        for (int n = 0; n < 4; ++n) {
            const size_t wo = ((size_t)z * 512 + h * 64 + n * 16 + fr) * 64 + ks * 32 + fq * 8;
            bw[n] = *(const bf16x8*)(W + WO_UP + wo); ba[n] = *(const bf16x8*)(W + WO_AUP + wo);
        }
        float t8[8];
        sh8(qw[ks], pl + 7 * 64 + ks * 32 + fq * 8, t8);
#pragma unroll
        for (int i = 0; i < 8; ++i) { const float e = fexp(2.0f * t8[i]); t8[i] = 1.0f - 2.0f * __builtin_amdgcn_rcpf(e + 1.0f); }
        const bf16x8 aw = pack8(t8);
        sh8(qa[ks], pl + 8 * 64 + ks * 32 + fq * 8, t8);
        const bf16x8 aa = pack8(t8);
#pragma unroll
        for (int n = 0; n < 4; ++n) {
            accw[n] = __builtin_amdgcn_mfma_f32_16x16x32_bf16(bw[n], aw, accw[n], 0, 0, 0);
            acca[n] = __builtin_amdgcn_mfma_f32_16x16x32_bf16(ba[n], aa, acca[n], 0, 0, 0);
        }
    }
#pragma unroll
    for (int n = 0; n < 4; ++n) { st.aw[n] = accw[n]; st.aa[n] = acca[n]; }
}
__device__ __forceinline__ void scan_produce_B(const Params& p, const float* pl, int b, int h, int z, int s0, float* frow0, int lane, const ProdState& st) {
    const int fr = lane & 15, fq = lane >> 4;
    const int pp = scan_pos(z, s0 + fr);
    const bool hp = (pp != 0 && pp != CTXL), hn = (pp != CTXL - 1 && pp != TPB - 1);
    const bf16_t* hr = (const bf16_t*)(p.ws + OFF_R3) + ((size_t)b * TPB + pp) * 1920;
    Raw3x2 rr0[2], rk0[2], rv0[2], rr1[2], rk1[2], rv1[2];
    const bf16_t* zr = (const bf16_t*)(p.ws + OFF_ZROW) + h * 64 + fq * 4;
    const bf16_t* pc = hr + h * 64 + fq * 4; const bf16_t* pa = hp ? pc - 1920 : zr; const bf16_t* pb = hn ? pc + 1920 : zr;
#pragma unroll
    for (int nn = 0; nn < 2; ++nn) {
        const int C4 = nn * 16, C5 = C4 + 32;
        rr0[nn] = ld3x2(pc, pa, pb, hp, hn, C4); rk0[nn] = ld3x2(pc, pa, pb, hp, hn, 512 + C4); rv0[nn] = ld3x2(pc, pa, pb, hp, hn, 1024 + C4);
        rr1[nn] = ld3x2(pc, pa, pb, hp, hn, C5); rk1[nn] = ld3x2(pc, pa, pb, hp, hn, 512 + C5); rv1[nn] = ld3x2(pc, pa, pb, hp, hn, 1024 + C5);
    }
    float ss = 0.f;
    float* frow = frow0 + fr * FSTR;
    const f32x4 w01[2] = {st.aw[0], st.aw[1]}, a01[2] = {st.aa[0], st.aa[1]}, w23[2] = {st.aw[2], st.aw[3]}, a23[2] = {st.aa[2], st.aa[3]};
    scan_produce_elem<0>(pl, fq, rr0, rk0, rv0, w01, a01, ss, frow);
    scan_produce_elem<2>(pl, fq, rr1, rk1, rv1, w23, a23, ss, frow);
    ss = fqsum(ss);
    const float inv = __builtin_amdgcn_rsqf(fmaxf(ss, 1e-24f));
#pragma unroll
    for (int n = 0; n < 4; ++n) {
        const int c4 = n * 16 + fq * 4;
        f32x4 kk = *(const f32x4*)(frow + 0 * 64 + c4);
        f32x4 bb = *(const f32x4*)(frow + 2 * 64 + c4);
#pragma unroll
        for (int j = 0; j < 4; ++j) { kk[j] = kk[j] * inv; bb[j] = kk[j] * bb[j]; }
        *(f32x4*)(frow + 0 * 64 + c4) = kk;
        *(f32x4*)(frow + 2 * 64 + c4) = bb;
    }
}

typedef float f32x2 __attribute__((ext_vector_type(2)));
struct ScanHead { f32x4 kk[2]; f32x2 v; };
struct ScanBody { f32x4 w[2], bb[2], kd[2], r[2]; };
__device__ __forceinline__ void scan_ldh(ScanHead& c, const float* f, const float* fv) {
#pragma unroll
    for (int q = 0; q < 2; ++q) c.kk[q] = *(const f32x4*)(f + 0 * 64 + 4 * q);
    c.v = *(const f32x2*)fv;
}
__device__ __forceinline__ void scan_ldb(ScanBody& c, const float* f) {
#pragma unroll
    for (int q = 0; q < 2; ++q) {
        c.w[q] = *(const f32x4*)(f + 1 * 64 + 4 * q); c.bb[q] = *(const f32x4*)(f + 2 * 64 + 4 * q);
        c.kd[q] = *(const f32x4*)(f + 3 * 64 + 4 * q); c.r[q] = *(const f32x4*)(f + 4 * 64 + 4 * q);
    }
}
__device__ __forceinline__ void scan_unit(const Params& p, int l, int u, unsigned char* lds) {
    const int tid = ltid(), wid = __builtin_amdgcn_readfirstlane(tid >> 6), lane = tid & 63;
    const int b = u >> 4, h = (u >> 1) & 7, z = u & 1;
    float* fb = (float*)lds;
    bf16_t* Y = (bf16_t*)(p.ws + (z == 0 ? OFF_YF : OFF_YB));
    float* pl = fb + 3 * CHUNK * FSTR;
    for (int i = tid; i < 9 * 64; i += NTHREADS) {
        const int a = i >> 6, c = i & 63, C = h * 64 + c;
        float v;
        if (a < 3) v = p.rw_mu[(size_t)l * 1920 + a * 512 + C];
        else if (a == 3) v = p.rw_w0[((size_t)l * 2 + z) * 512 + C];
        else if (a == 4) v = p.rw_a0[((size_t)l * 2 + z) * 512 + C];
        else if (a == 5) v = p.rw_k_k[(size_t)l * 512 + C];
        else if (a == 6) v = p.rw_k_a[(size_t)l * 512 + C];
        else if (a == 7) v = p.rw_mu[(size_t)l * 1920 + 1536 + z * 64 + c];
        else v = p.rw_mu[(size_t)l * 1920 + 1664 + z * 64 + c];
        pl[i] = v;
    }
    __syncthreads();
    if (wid < 4) {
        f32x2 S2[8];
#pragma unroll
        for (int j = 0; j < 8; ++j) S2[j] = (f32x2){0.f, 0.f};
        __syncthreads();
        for (int c = 0; c < NCHUNK; ++c) {
            const float* fbc = fb + (c % 3) * CHUNK * FSTR + 8 * (lane & 7);
            const float* fbv = fb + (c % 3) * CHUNK * FSTR + 320 + 16 * wid + 2 * (lane >> 3);
            bf16_t* yp = Y + ((size_t)b * TPB) * 512 + h * 64 + 16 * wid + 2 * (lane >> 3);
            ScanHead ha, hb;
            scan_ldh(ha, fbc, fbv);
#define SCAN_STEP(HC, HN, SL) { \
                ScanBody bd; scan_ldb(bd, fbc + (SL) * FSTR); \
                scan_ldh(HN, fbc + ((SL) + 1) * FSTR, fbv + ((SL) + 1) * FSTR);     \
                f32x2 d0 = (f32x2){0.f, 0.f}, d1 = (f32x2){0.f, 0.f}; \
                _Pragma("unroll") for (int q = 0; q < 4; ++q) { const f32x2 k2 = (f32x2){HC.kk[q >> 1][2 * (q & 1)], HC.kk[q >> 1][2 * (q & 1) + 1]}; \
                    d0 = __builtin_elementwise_fma(S2[q], k2, d0); d1 = __builtin_elementwise_fma(S2[4 + q], k2, d1); } \
                const float sk0 = red8(d0[0] + d0[1]), sk1 = red8(d1[0] + d1[1]); \
                const f32x2 n0 = (f32x2){-sk0, -sk0}, n1 = (f32x2){-sk1, -sk1}, v0 = (f32x2){HC.v[0], HC.v[0]}, v1 = (f32x2){HC.v[1], HC.v[1]}; \
                f32x2 y0 = (f32x2){0.f, 0.f}, y1 = (f32x2){0.f, 0.f}; \
                _Pragma("unroll") for (int q = 0; q < 4; ++q) { \
                    const f32x2 w2 = (f32x2){bd.w[q >> 1][2 * (q & 1)], bd.w[q >> 1][2 * (q & 1) + 1]}, b2 = (f32x2){bd.bb[q >> 1][2 * (q & 1)], bd.bb[q >> 1][2 * (q & 1) + 1]}; \
                    const f32x2 kd2 = (f32x2){bd.kd[q >> 1][2 * (q & 1)], bd.kd[q >> 1][2 * (q & 1) + 1]}, r2 = (f32x2){bd.r[q >> 1][2 * (q & 1)], bd.r[q >> 1][2 * (q & 1) + 1]}; \
                    f32x2 t0 = S2[q] * w2; t0 = __builtin_elementwise_fma(b2, n0, t0); t0 = __builtin_elementwise_fma(kd2, v0, t0); \
                    f32x2 t1 = S2[4 + q] * w2; t1 = __builtin_elementwise_fma(b2, n1, t1); t1 = __builtin_elementwise_fma(kd2, v1, t1); \
                    S2[q] = t0; S2[4 + q] = t1; \
                    y0 = __builtin_elementwise_fma(t0, r2, y0); y1 = __builtin_elementwise_fma(t1, r2, y1); } \
                const float ya = red8(y0[0] + y0[1]), yb = red8(y1[0] + y1[1]); \
                const int pp = scan_pos(z, c * CHUNK + (SL)); \
                *(unsigned*)(yp + (size_t)pp * 512) = pk_bf16(ya, yb); }
#pragma unroll 1
            for (int sl = 0; sl < CHUNK; sl += 2) {
                SCAN_STEP(ha, hb, sl)
                SCAN_STEP(hb, ha, sl + 1)
            }
            __syncthreads();
        }
    } else {
        ProdState st;
#pragma unroll
        for (int n = 0; n < 4; ++n) { st.aw[n] = (f32x4){0.f, 0.f, 0.f, 0.f}; st.aa[n] = (f32x4){0.f, 0.f, 0.f, 0.f}; }
        const int nrep = launder_i(1 + ((PROBE_MASK >> 10) & 1));
        const int pair = (wid - 4) >> 1, ph = (wid - 4) & 1;
        {
            float* f0 = fb + (pair % 3) * CHUNK * FSTR + ph * 16 * FSTR;
            scan_produce_A(p, pl, b, h, z, pair * CHUNK + ph * 16, f0, lane, st);
            if (pair == 0) scan_produce_B(p, pl, b, h, z, ph * 16, f0, lane, st);
        }
        __syncthreads();
        for (int c = 0; c < NCHUNK; ++c) {
            for (int rr_ = 0; rr_ < nrep; ++rr_) {
            if (pair == ((c + 1) & 1)) {
                if (c + 1 < NCHUNK) scan_produce_B(p, pl, b, h, z, (c + 1) * CHUNK + ph * 16, fb + ((c + 1) % 3) * CHUNK * FSTR + ph * 16 * FSTR, lane, st);
            } else {
                if (c + 2 < NCHUNK) scan_produce_A(p, pl, b, h, z, (c + 2) * CHUNK + ph * 16, fb + ((c + 2) % 3) * CHUNK * FSTR + ph * 16 * FSTR, lane, st);
            }
            }
            __syncthreads();
        }
    }
}

constexpr int ATT_STAGE = 20480;
__device__ __forceinline__ void attn_unit(const Params& p, int b, int h, int q0, int nkeys, unsigned char* lds, int do_write) {
    const int tid = ltid(), wid = __builtin_amdgcn_readfirstlane(tid >> 6), lane = tid & 63, fr = lane & 15, fq = lane >> 4;
    bf16_t* Q = (bf16_t*)(p.ws + OFF_Q);
    const bf16_t* KN = (const bf16_t*)(p.ws + OFF_KN);
    const bf16_t* KR = (const bf16_t*)(p.ws + OFF_KR);
    const bf16_t* VT = (const bf16_t*)(p.ws + OFF_VT);
    const size_t rb = (size_t)b * TPB;
    bf16x8 qf[2][3];
#pragma unroll
    for (int nq = 0; nq < 2; ++nq)
#pragma unroll
        for (int ks = 0; ks < 3; ++ks) qf[nq][ks] = *(const bf16x8*)(Q + (rb + q0 + wid * 32 + nq * 16 + fr) * 768 + h * 96 + ks * 32 + fq * 8);
    f32x4 oacc[4][2];
#pragma unroll
    for (int mt = 0; mt < 4; ++mt)
#pragma unroll
        for (int nq = 0; nq < 2; ++nq) oacc[mt][nq] = (f32x4){0.f, 0.f, 0.f, 0.f};
    float mrun[2] = {0.f, 0.f}, lsum[2] = {0.f, 0.f};
    const int c8 = (lane & 7) ^ ((4 * wid + (lane >> 4)) & 7);
    const bf16_t* knp = KN + (rb + 8 * wid + (lane >> 3)) * 512 + h * 64 + c8 * 8;
    const bf16_t* vtp = VT + ((size_t)(b * 8 + h) * 64 + 8 * wid + (lane >> 3)) * TPB + c8 * 8;
    const int c4 = (lane & 3) ^ ((lane >> 4) & 3);
    const bf16_t* krp = KR + (rb + 16 * (wid & 3) + (lane >> 2)) * 32 + c4 * 8;
    auto issue = [&](int t, int stg) {
        unsigned char* base = lds + stg * ATT_STAGE;
        const int k0 = t * 64;
        __builtin_amdgcn_global_load_lds((const GLB_AS unsigned*)(knp + (size_t)k0 * 512), (LDS_AS unsigned*)(base + wid * 1024), 16, 0, 0);
        __builtin_amdgcn_global_load_lds((const GLB_AS unsigned*)(vtp + k0), (LDS_AS unsigned*)(base + 12288 + wid * 1024), 16, 0, 0);
        if (wid < 4) __builtin_amdgcn_global_load_lds((const GLB_AS unsigned*)(krp + (size_t)k0 * 32), (LDS_AS unsigned*)(base + 8192 + wid * 1024), 16, 0, 0);
    };
    const int ntile = nkeys / 64;
    const int kz = fr >> 1, rz = (fr >> 2) & 3;
    issue(0, 0);
    asm volatile("s_waitcnt vmcnt(0)" ::: "memory");
    __builtin_amdgcn_s_barrier();
    asm volatile("" ::: "memory");
    for (int t = 0; t < ntile; ++t) {
        if (t + 1 < ntile) issue(t + 1, (t + 1) & 1);
        const unsigned char* Ks = lds + (t & 1) * ATT_STAGE;
        const unsigned char* Rs = Ks + 8192;
        const unsigned char* Vs = Ks + 12288;
        f32x4 sacc[4][2];
#pragma unroll
        for (int km = 0; km < 4; ++km)
#pragma unroll
            for (int nq = 0; nq < 2; ++nq) sacc[km][nq] = (f32x4){-mrun[nq], -mrun[nq], -mrun[nq], -mrun[nq]};
#pragma unroll
        for (int ks = 0; ks < 3; ++ks)
#pragma unroll
            for (int km = 0; km < 4; ++km) {
                const bf16x8 kf = ks < 2 ? *(const bf16x8*)(Ks + (km * 16 + fr) * 128 + (((ks * 4 + fq) ^ kz) * 16))
                                         : *(const bf16x8*)(Rs + (km * 16 + fr) * 64 + ((fq ^ rz) * 16));
#pragma unroll
                for (int nq = 0; nq < 2; ++nq) sacc[km][nq] = __builtin_amdgcn_mfma_f32_16x16x32_bf16(kf, qf[nq][ks], sacc[km][nq], 0, 0, 0);
            }
        float delta[2];
#pragma unroll
        for (int nq = 0; nq < 2; ++nq) {
            float mx = -1e30f;
#pragma unroll
            for (int km = 0; km < 4; ++km)
#pragma unroll
                for (int j = 0; j < 4; ++j) mx = fmaxf(mx, sacc[km][nq][j]);
            mx = fqmax(mx);
            delta[nq] = (t == 0) ? mx : fmaxf(mx, 0.f);
        }
        const bool exact = (t == 0) || (__builtin_amdgcn_ballot_w64(fmaxf(delta[0], delta[1]) > 60.0f) != 0ull);
        bf16x8 pf[2][2];
        float psum[2];
#pragma unroll
        for (int nq = 0; nq < 2; ++nq) {
            float ps = 0.f;
            if (exact) {
#pragma unroll
                for (int km = 0; km < 4; ++km)
#pragma unroll
                    for (int j = 0; j < 4; ++j) { const float e = __builtin_amdgcn_exp2f(sacc[km][nq][j] - delta[nq]); sacc[km][nq][j] = e; ps += e; }
            } else {
#pragma unroll
                for (int km = 0; km < 4; ++km)
#pragma unroll
                    for (int j = 0; j < 4; ++j) { const float e = __builtin_amdgcn_exp2f(sacc[km][nq][j]); sacc[km][nq][j] = e; ps += e; }
            }
            psum[nq] = ps;
#pragma unroll
            for (int kc = 0; kc < 2; ++kc) {
                union { uint4 u; bf16x8 v; } r;
                r.u.x = pk_bf16(sacc[2 * kc][nq][0], sacc[2 * kc][nq][1]); r.u.y = pk_bf16(sacc[2 * kc][nq][2], sacc[2 * kc][nq][3]);
                r.u.z = pk_bf16(sacc[2 * kc + 1][nq][0], sacc[2 * kc + 1][nq][1]); r.u.w = pk_bf16(sacc[2 * kc + 1][nq][2], sacc[2 * kc + 1][nq][3]);
                pf[kc][nq] = r.v;
            }
        }
        if (exact) {
#pragma unroll
            for (int nq = 0; nq < 2; ++nq) {
                const float alpha = (t == 0) ? 1.0f : __builtin_amdgcn_exp2f(-delta[nq]);
                lsum[nq] = lsum[nq] * alpha + psum[nq];
#pragma unroll
                for (int mt = 0; mt < 4; ++mt) oacc[mt][nq] = oacc[mt][nq] * alpha;
            }
        }
#pragma unroll
        for (int mt = 0; mt < 4; ++mt)
#pragma unroll
            for (int kc = 0; kc < 2; ++kc) {
                union { uint2 h2[2]; bf16x8 v; } r;
                const unsigned char* vrow = Vs + (mt * 16 + fr) * 128 + (fq & 1) * 8;
                r.h2[0] = *(const uint2*)(vrow + (((4 * kc + (fq >> 1)) ^ kz) * 16));
                r.h2[1] = *(const uint2*)(vrow + (((4 * kc + 2 + (fq >> 1)) ^ kz) * 16));
#pragma unroll
                for (int nq = 0; nq < 2; ++nq) oacc[mt][nq] = __builtin_amdgcn_mfma_f32_16x16x32_bf16(r.v, pf[kc][nq], oacc[mt][nq], 0, 0, 0);
            }
        if (!exact) {
#pragma unroll
            for (int nq = 0; nq < 2; ++nq) {
                const float alpha = __builtin_amdgcn_exp2f(-delta[nq]);
                lsum[nq] = (lsum[nq] + psum[nq]) * alpha;
#pragma unroll
                for (int mt = 0; mt < 4; ++mt) oacc[mt][nq] = oacc[mt][nq] * alpha;
            }
        }
#pragma unroll
        for (int nq = 0; nq < 2; ++nq) mrun[nq] += delta[nq];
        asm volatile("s_waitcnt vmcnt(0) lgkmcnt(0)" ::: "memory");
        __builtin_amdgcn_s_barrier();
        asm volatile("" ::: "memory");
    }
#pragma unroll
    for (int nq = 0; nq < 2; ++nq) {
        const float inv = 1.0f / fqsum(lsum[nq]);
        bf16_t* orow = Q + (rb + q0 + wid * 32 + nq * 16 + fr) * 768 + h * 96;
#pragma unroll
        for (int mt = 0; mt < 4; mt += 2) {
            uint2 a, b2;
            a.x = pk_bf16(oacc[mt][nq][0] * inv, oacc[mt][nq][1] * inv); a.y = pk_bf16(oacc[mt][nq][2] * inv, oacc[mt][nq][3] * inv);
            b2.x = pk_bf16(oacc[mt + 1][nq][0] * inv, oacc[mt + 1][nq][1] * inv); b2.y = pk_bf16(oacc[mt + 1][nq][2] * inv, oacc[mt + 1][nq][3] * inv);
            const uint4 w = widen16(a, b2);
            if (do_write) *(uint4*)(orow + (mt + (fq & 1)) * 16 + (fq >> 1) * 8) = w;
        }
    }
}

__device__ __forceinline__ void p3_phase(const Params& pin, int l, unsigned char* lds) {
    const Params p = launder(pin); l = launder_i(l);
    for (int r = 0, nr = launder_i(1 + ((PROBE_MASK >> 1) & 1)); r < nr; ++r)
        for (int u = blockIdx.x; u < 256; u += gridDim.x) scan_unit(p, l, u, lds);
    const int nunits = (l == DEPTH - 1) ? 1024 : 1152;
    for (int r = launder_i(((PROBE_MASK >> 9) & 1) ? 0 : 1); r < 2; ++r)
    for (int u = blockIdx.x; u < nunits; u += gridDim.x) {
        if (u < 1024) { const int bh = u >> 3, qt = u & 7; attn_unit(p, bh >> 3, bh & 7, CTXL + qt * 256, TPB, lds, r); }
        else { const int bh = u - 1024; attn_unit(p, bh >> 3, bh & 7, 0, CTXL, lds, r); }
    }
}

__device__ __forceinline__ void p35_phase(const Params& pin, int l, bool skip_ctx, unsigned char* lds) {
    const Params p = launder(pin); l = launder_i(l); const int tid = ltid();
    const bf16_t* SG = (const bf16_t*)(p.ws + OFF_SG);
    const bf16_t* W = (const bf16_t*)(p.ws + OFF_W) + WO_GUP;
    const bf16_t* YF = (const bf16_t*)(p.ws + OFF_YF);
    const bf16_t* YB = (const bf16_t*)(p.ws + OFF_YB);
    const bf16_t* Hr = (const bf16_t*)(p.ws + OFF_R3);
    bf16_t* RWO = (bf16_t*)(p.ws + OFF_RWO);
    const float* mu = p.rw_mu + (size_t)l * 1920;
    const int lane = tid & 63, wid = tid >> 6, wr = wid >> 1, wc = wid & 1, fr = lane & 15, fq = lane >> 4;
    float* gt = (float*)lds;
    constexpr int GP = 132;
    for (int t = blockIdx.x; t < 288 * 4; t += gridDim.x) {
        int mt, nt; tile_mn(t, 4, mt, nt);
        if (skip_ctx && (mt % 18) < 2) continue;
        f32x4 acc[2][4]; zero_acc<2>(acc);
        gemm_mainloop<2, 1>(acc, SG + (size_t)mt * 128 * 128, 128, 64, W + (size_t)nt * 128 * 128, 128, 2, lds, tid);
#pragma unroll
        for (int m = 0; m < 2; ++m)
#pragma unroll
            for (int n = 0; n < 4; ++n) *(f32x4*)(gt + (wr * 32 + m * 16 + fr) * GP + wc * 64 + n * 16 + fq * 4) = acc[m][n];
        __syncthreads();
        const int pp0 = (mt % 18) * 128;
#pragma unroll 1
        for (int it = 0; it < 4; ++it) {
            const int item = tid + it * NTHREADS, lrow = item >> 4, cg = item & 15, pp = pp0 + lrow;
            const size_t row = (size_t)mt * 128 + lrow;
            const int C = nt * 128 + cg * 8;
            const bool hp = (pp != 0 && pp != CTXL), hn = (pp != CTXL - 1 && pp != TPB - 1);
            const bf16_t* hr = Hr + row * 1920;
            float yf[8], yb[8], r8[8], k8[8], v8[8];
            unpack8(*(const uint4*)(YF + row * 512 + C), yf); unpack8(*(const uint4*)(YB + row * 512 + C), yb);
            shift8(hr, hp, hn, C, mu, r8); shift8(hr, hp, hn, 512 + C, mu, k8); shift8(hr, hp, hn, 1024 + C, mu, v8);
            const float* rkp = p.rw_r_k + (size_t)l * 512 + C;
            float s1 = 0.f, bs = 0.f;
#pragma unroll
            for (int i = 0; i < 8; ++i) { yf[i] += yb[i]; s1 += yf[i]; bs += r8[i] * k8[i] * rkp[i]; }
            s1 = red8(s1); bs = red8(bs);
            const float mean = s1 * (1.0f / 64.0f);
            float s2 = 0.f;
#pragma unroll
            for (int i = 0; i < 8; ++i) { const float d = yf[i] - mean; s2 += d * d; }
            s2 = red8(s2);
            const float rstd = __builtin_amdgcn_rsqf(s2 * (1.0f / 64.0f) + 64e-5f);
            const float* ggp = p.rw_gn_g + (size_t)l * 512 + C; const float* gbp = p.rw_gn_b + (size_t)l * 512 + C;
            const f32x4 g0 = *(const f32x4*)(gt + lrow * GP + cg * 8), g1 = *(const f32x4*)(gt + lrow * GP + cg * 8 + 4);
            float o[8];
#pragma unroll
            for (int i = 0; i < 8; ++i) o[i] = ((yf[i] - mean) * rstd * ggp[i] + gbp[i] + bs * v8[i]) * (i < 4 ? g0[i] : g1[i - 4]);
            uint4 ov; ov.x = pk_bf16(o[0], o[1]); ov.y = pk_bf16(o[2], o[3]); ov.z = pk_bf16(o[4], o[5]); ov.w = pk_bf16(o[6], o[7]);
            *(uint4*)(RWO + row * 512 + C) = ov;
        }
        __syncthreads();
    }
}

__device__ __forceinline__ void p4_phase(const Params& pin, bool skip_ctx, unsigned char* lds) {
    const Params p = launder(pin); const int tid = ltid();
    const bf16_t* XM = (const bf16_t*)(p.ws + OFF_R6);
    const bf16_t* W = (const bf16_t*)(p.ws + OFF_W);
    bf16_t* MG = (bf16_t*)(p.ws + OFF_MRG);
    const int lane = tid & 63, wid = tid >> 6, wr = wid >> 1, wc = wid & 1, fr = lane & 15, fq = lane >> 4;
    for (int t = blockIdx.x; t < 288 * 8; t += gridDim.x) {
        int mt, nt; tile_mn(t, 8, mt, nt);
        if (skip_ctx && (mt % 18) < 2) continue;
        f32x4 g[3][2][4];
#pragma unroll
        for (int i = 0; i < 3; ++i) zero_acc<2>(g[i]);
        gemm_gate3(g, XM + (size_t)mt * 128 * 1024, W + WO_IN + (size_t)(4224 + nt * 128) * 1024, 16, lds, tid);
        typedef __fp16 h16x2 __attribute__((ext_vector_type(2)));
        h16x2 gp[3][2][4][2];
#pragma unroll
        for (int i = 0; i < 3; ++i)
#pragma unroll
            for (int m = 0; m < 2; ++m)
#pragma unroll
                for (int n = 0; n < 4; ++n) {
                    gp[i][m][n][0] = __builtin_amdgcn_cvt_pkrtz(sigmoidf_(g[i][m][n][0]), sigmoidf_(g[i][m][n][1]));
                    gp[i][m][n][1] = __builtin_amdgcn_cvt_pkrtz(sigmoidf_(g[i][m][n][2]), sigmoidf_(g[i][m][n][3]));
                }
        f32x4 mg[2][4]; zero_acc<2>(mg);
#pragma unroll 1
        for (int i = 0; i < 3; ++i) {
            const bf16_t* Ab; int lda, kst; const bf16_t* Wb;
            if (i == 0) { Ab = (const bf16_t*)(p.ws + OFF_Q); lda = 768; kst = 96; Wb = W + WO_OA; }
            else if (i == 1) { Ab = (const bf16_t*)(p.ws + OFF_R5); lda = 512; kst = 64; Wb = W + WO_OC; }
            else { Ab = (const bf16_t*)(p.ws + OFF_RWO); lda = 512; kst = 64; Wb = W + WO_OR; }
            f32x4 a[2][4]; zero_acc<2>(a);
            gemm_mainloop<2, 1>(a, Ab + (size_t)mt * 128 * lda, lda, kst, Wb + (size_t)nt * 128 * 512, 512, 8, lds, tid);
#pragma unroll
            for (int m = 0; m < 2; ++m)
#pragma unroll
                for (int n = 0; n < 4; ++n) {
                    const h16x2 g0 = i == 0 ? gp[0][m][n][0] : (i == 1 ? gp[1][m][n][0] : gp[2][m][n][0]);
                    const h16x2 g1 = i == 0 ? gp[0][m][n][1] : (i == 1 ? gp[1][m][n][1] : gp[2][m][n][1]);
                    mg[m][n][0] += (float)g0[0] * a[m][n][0]; mg[m][n][1] += (float)g0[1] * a[m][n][1];
                    mg[m][n][2] += (float)g1[0] * a[m][n][2]; mg[m][n][3] += (float)g1[1] * a[m][n][3];
                }
        }
#pragma unroll
        for (int m = 0; m < 2; ++m) {
            const size_t row = (size_t)mt * 128 + wr * 32 + m * 16 + fr;
#pragma unroll
            for (int n = 0; n < 4; n += 2) {
                uint2 a, b2;
                a.x = pk_bf16(mg[m][n][0], mg[m][n][1]); a.y = pk_bf16(mg[m][n][2], mg[m][n][3]);
                b2.x = pk_bf16(mg[m][n + 1][0], mg[m][n + 1][1]); b2.y = pk_bf16(mg[m][n + 1][2], mg[m][n + 1][3]);
                *(uint4*)(MG + row * 1024 + nt * 128 + wc * 64 + (n + (fq & 1)) * 16 + (fq >> 1) * 8) = widen16(a, b2);
            }
        }
    }
}

template <int MT>
__device__ __forceinline__ void resid_tile(const Params& p, int l, const bf16_t* A, int lda, int nk, const bf16_t* Wt, int ldb, int goff, bool x_from_input,
                                           const float* lng, const float* lnb, int row0, int nt, unsigned char* lds, int tid) {
    const int lane = tid & 63, wid = tid >> 6, wr = wid >> 1, wc = wid & 1, fr = lane & 15, fq = lane >> 4;
    f32x4 acc[MT][4]; zero_acc<MT>(acc);
    gemm_mainloop<MT, 1>(acc, A + (size_t)row0 * lda, lda, 64, Wt + (size_t)nt * 128 * ldb, ldb, nk, lds, tid);
    const int b = row0 / TPB, pp0 = row0 % TPB;
    const float* gv = modv_ptr(p, l, b, pp0) + goff;
    const float* stats = (const float*)(p.ws + OFF_STATS);
#pragma unroll
    for (int m = 0; m < MT; ++m) {
        const int lr = wr * 16 * MT + m * 16 + fr, pp = pp0 + lr;
        const float* xi = x_rd(p, x_from_input, b, pp);
        float* xo = x_wr(p, b, pp);
        float mean = 0.f, rstd = 1.f;
        if (!x_from_input) { const size_t row = (size_t)row0 + lr; mean = stats[row * 2]; rstd = stats[row * 2 + 1]; }
#pragma unroll
        for (int n = 0; n < 4; ++n) {
            const int col = nt * 128 + wc * 64 + n * 16 + fq * 4;
            f32x4 xv = *(const f32x4*)(xi + col); const f32x4 g4 = *(const f32x4*)(gv + col);
            if (!x_from_input) {
                const f32x4 lg = *(const f32x4*)(lng + col), lb = *(const f32x4*)(lnb + col);
#pragma unroll
                for (int j = 0; j < 4; ++j) xv[j] = (xv[j] - mean) * rstd * lg[j] + lb[j];
            }
            f32x4 o;
#pragma unroll
            for (int j = 0; j < 4; ++j) o[j] = ALPHA * xv[j] + g4[j] * acc[m][n][j];
            *(f32x4*)(xo + col) = o;
        }
    }
}
__device__ __forceinline__ void resid_tile256(const Params& p, int l, const bf16_t* A, int lda, int nk, const bf16_t* Wt, int ldb, int goff, bool x_from_input,
                                              const float* lng, const float* lnb, int row0, int nt256, unsigned char* lds, int tid) {
    const int lane = tid & 63, wid = tid >> 6, wr = wid >> 2, wc = wid & 3, fr = lane & 15, fq = lane >> 4;
    f32x4 acc[8][4]; zero_acc<8>(acc);
    Seg sg; sg.A = A + (size_t)row0 * lda; sg.Bt = Wt + (size_t)nt256 * 256 * ldb; sg.lda = lda; sg.a_kstep = 64; sg.ldb = ldb; sg.nk = nk;
    int st = 0;
    gemm_stream256(acc, sg, sg, false, true, st, lds, tid);
    const int b = row0 / TPB, pp0 = row0 % TPB;
    const float* gv = modv_ptr(p, l, b, pp0) + goff;
    const float* stats = (const float*)(p.ws + OFF_STATS);
#pragma unroll
    for (int m = 0; m < 8; ++m) {
        const int lr = wr * 128 + m * 16 + fr, pp = pp0 + lr;
        const float* xi = x_rd(p, x_from_input, b, pp);
        float* xo = x_wr(p, b, pp);
        float mean = 0.f, rstd = 1.f;
        if (!x_from_input) { const size_t row = (size_t)row0 + lr; mean = stats[row * 2]; rstd = stats[row * 2 + 1]; }
#pragma unroll
        for (int n = 0; n < 4; ++n) {
            const int col = nt256 * 256 + wc * 64 + n * 16 + fq * 4;
            f32x4 xv = *(const f32x4*)(xi + col); const f32x4 g4 = *(const f32x4*)(gv + col);
            if (!x_from_input) {
                const f32x4 lg = *(const f32x4*)(lng + col), lb = *(const f32x4*)(lnb + col);
#pragma unroll
                for (int j = 0; j < 4; ++j) xv[j] = (xv[j] - mean) * rstd * lg[j] + lb[j];
            }
            f32x4 o;
#pragma unroll
            for (int j = 0; j < 4; ++j) o[j] = ALPHA * xv[j] + g4[j] * acc[m][n][j];
            *(f32x4*)(xo + col) = o;
        }
    }
}
__device__ __forceinline__ void resid_gemm_phase(const Params& pin, int l, size_t a_off, int lda, int nk, size_t w_off, int ldb, int goff, bool x_from_input, const float* lng, const float* lnb, bool skip_ctx, unsigned char* lds) {
    const Params p = launder(pin); l = launder_i(l);
    const int tid = ltid();
    const bf16_t* A = (const bf16_t*)(p.ws + a_off);
    const bf16_t* Wt = (const bf16_t*)(p.ws + OFF_W) + w_off;
    if (gridDim.x == 256) {
        for (int t = blockIdx.x; t < 512; t += 256) {
            int mt, nt; tile_mn(t, 4, mt, nt);
            if (skip_ctx && (mt % 9) == 0) continue;
            resid_tile256(p, l, A, lda, nk, Wt, ldb, goff, x_from_input, lng, lnb, mt * 256, nt, lds, tid);
        }
        int mt, nt; tile_mn(512 + (blockIdx.x >> 2), 4, mt, nt);
        const int q = blockIdx.x & 3;
        if (!(skip_ctx && (mt % 9) == 0)) resid_tile<2>(p, l, A, lda, nk, Wt, ldb, goff, x_from_input, lng, lnb, mt * 256 + (q >> 1) * 128, nt * 2 + (q & 1), lds, tid);
    } else {
        for (int t = blockIdx.x; t < 144 * 8; t += gridDim.x) {
            int mt, nt; tile_mn(t, 8, mt, nt);
            if (skip_ctx && (mt % 9) == 0) continue;
            resid_tile<4>(p, l, A, lda, nk, Wt, ldb, goff, x_from_input, lng, lnb, mt * 256, nt, lds, tid);
        }
    }
}

__device__ __forceinline__ void ln_phase(const Params& pin, const float* g, const float* bta, int lmod, int shoff, bool write_xmod, bool write_x, bool skip_ctx) {
    const Params p = launder(pin); lmod = launder_i(lmod);
    const int tid = ltid(), wid = tid >> 6, lane = tid & 63;
    bf16_t* xm = (bf16_t*)(p.ws + OFF_R6);
    float* stats = (float*)(p.ws + OFF_STATS);
    for (int row = blockIdx.x * 8 + wid; row < MROWS; row += gridDim.x * 8) {
        const int b = row / TPB, pp = row % TPB;
        if (skip_ctx && pp < CTXL) continue;
        float* xp = x_wr(p, b, pp);
        f32x4 v[4];
        float s = 0.f;
#pragma unroll
        for (int i = 0; i < 4; ++i) { v[i] = *(const f32x4*)(xp + i * 256 + lane * 4); s += (v[i][0] + v[i][1]) + (v[i][2] + v[i][3]); }
        const float mean = wave_sum(s) * (1.0f / 1024.0f);
        float q = 0.f;
#pragma unroll
        for (int i = 0; i < 4; ++i)
#pragma unroll
            for (int j = 0; j < 4; ++j) { const float d = v[i][j] - mean; q += d * d; }
        const float rstd = __builtin_amdgcn_rsqf(wave_sum(q) * (1.0f / 1024.0f) + 1e-5f);
        if (lane == 0) { stats[(size_t)row * 2] = mean; stats[(size_t)row * 2 + 1] = rstd; }
        const float* mv = write_xmod ? modv_ptr(p, lmod, b, pp) + shoff : nullptr;
#pragma unroll
        for (int i = 0; i < 4; ++i) {
            const int c = i * 256 + lane * 4;
            const f32x4 g4 = *(const f32x4*)(g + c), b4 = *(const f32x4*)(bta + c);
            f32x4 o;
#pragma unroll
            for (int j = 0; j < 4; ++j) o[j] = (v[i][j] - mean) * rstd * g4[j] + b4[j];
            if (write_x) *(f32x4*)(xp + c) = o;
            if (write_xmod) {
                const f32x4 sh = *(const f32x4*)(mv + c), sc = *(const f32x4*)(mv + 1024 + c);
                uint2 ov; ov.x = pk_bf16(o[0] * (1.f + sc[0]) + sh[0], o[1] * (1.f + sc[1]) + sh[1]); ov.y = pk_bf16(o[2] * (1.f + sc[2]) + sh[2], o[3] * (1.f + sc[3]) + sh[3]);
                *(uint2*)(xm + (size_t)row * 1024 + c) = ov;
            }
        }
    }
}

__device__ __forceinline__ void p7_phase(const Params& pin, bool skip_ctx, unsigned char* lds) {
    const Params p = launder(pin); const int tid = ltid();
    const bf16_t* A = (const bf16_t*)(p.ws + OFF_R6);
    const bf16_t* W = (const bf16_t*)(p.ws + OFF_W) + WO_13;
    bf16_t* HF = (bf16_t*)(p.ws + OFF_HF);
    const int lane = tid & 63, wid = tid >> 6, wr = wid >> 2, wc = wid & 3, fr = lane & 15, fq = lane >> 4;
    auto seg = [&](int t) { int mt, nt; tile_mn(t, 22, mt, nt); Seg g; g.A = A + (size_t)mt * 256 * 1024; g.Bt = W + (size_t)nt * 256 * 1024; g.lda = 1024; g.a_kstep = 64; g.ldb = 1024; g.nk = 16; return g; };
    auto valid = [&](int t) { int mt, nt; tile_mn(t, 22, mt, nt); return !(skip_ctx && (mt % 9) == 0); };
    auto nextv = [&](int t) { while (t < 144 * 22 && !valid(t)) t += gridDim.x; return t; };
    int st = 0; bool first = true;
    for (int t = nextv(blockIdx.x); t < 144 * 22;) {
        int mt, nt; tile_mn(t, 22, mt, nt);
        const int tn = nextv(t + gridDim.x); const bool hn = tn < 144 * 22;
        f32x4 acc[8][4]; zero_acc<8>(acc);
        gemm_stream256(acc, seg(t), seg(hn ? tn : t), hn, first, st, lds, tid); first = false;
        const int G = nt * 4 + wc;
#pragma unroll
        for (int m = 0; m < 8; ++m) {
            const size_t row = (size_t)mt * 256 + wr * 128 + m * 16 + fr;
            uint2 ov[2];
#pragma unroll
            for (int n = 0; n < 2; ++n) {
                float o[4];
#pragma unroll
                for (int j = 0; j < 4; ++j) o[j] = siluf_(acc[m][n][j]) * acc[m][n + 2][j];
                ov[n].x = pk_bf16(o[0], o[1]); ov[n].y = pk_bf16(o[2], o[3]);
            }
            *(uint4*)(HF + row * DFF + G * 32 + (fq & 1) * 16 + (fq >> 1) * 8) = widen16(ov[0], ov[1]);
        }
        t = tn;
    }
}

__global__ void __launch_bounds__(NTHREADS) fwd_megakernel(Params p) {
    extern __shared__ __attribute__((aligned(16))) unsigned char lds[];
    cg::grid_group grid = cg::this_grid();
    unsigned* gbar = (unsigned*)(p.ws + OFF_BAR); unsigned epoch = 0;
#define GSYNC() grid_barrier(gbar, epoch)
    if (p.ws == nullptr) grid.sync();
    modv_phase(p, lds);
    convert_layer(p, 0, lds);
    {
        bf16_t* Wm = (bf16_t*)(p.ws + OFF_W) + WO_IN + (size_t)672 * 1024;
        for (int i = blockIdx.x * NTHREADS + threadIdx.x; i < 96 * 1024 / 2; i += gridDim.x * NTHREADS) ((unsigned*)Wm)[i] = 0u;
    }
    GSYNC();
    xmod0_phase(p);
    GSYNC();
#pragma unroll 1
    for (int l = 0; l < DEPTH; ++l) {
        const bool last = (l == DEPTH - 1);
        for (int r = 0, nr = launder_i(1 + ((PROBE_MASK >> 2) & 1)); r < nr; ++r) p1_phase(p, lds);
        GSYNC();
        for (int r = 0, nr = launder_i(1 + ((PROBE_MASK >> 3) & 1)); r < nr; ++r) p2a_phase(p, l);
        GSYNC();
        for (int r = 0, nr = launder_i(1 + ((PROBE_MASK >> 4) & 1)); r < nr; ++r) p2b_phase(p, l, lds);
        GSYNC();
        p3_phase(p, l, lds);
        GSYNC();
        for (int r = 0, nr = launder_i(1 + ((PROBE_MASK >> 5) & 1)); r < nr; ++r) p35_phase(p, l, last, lds);
        GSYNC();
        for (int r = 0, nr = launder_i(1 + ((PROBE_MASK >> 6) & 1)); r < nr; ++r) p4_phase(p, last, lds);
        GSYNC();
        resid_gemm_phase(p, l, OFF_MRG, 1024, 16, WO_OUT, 1024, 2048, l == 0, p.ln2_g + (l > 0 ? l - 1 : 0) * 1024, p.ln2_b + (l > 0 ? l - 1 : 0) * 1024, last, lds);
        GSYNC();
        ln_phase(p, p.ln1_g + l * 1024, p.ln1_b + l * 1024, l, 3072, true, false, last);
        GSYNC();
        for (int r = 0, nr = launder_i(1 + ((PROBE_MASK >> 0) & 1)); r < nr; ++r) p7_phase(p, last, lds);
        GSYNC();
        resid_gemm_phase(p, l, OFF_HF, DFF, 44, WO_2, DFF, 5120, false, p.ln1_g + l * 1024, p.ln1_b + l * 1024, last, lds);
        GSYNC();
        ln_phase(p, p.ln2_g + l * 1024, p.ln2_b + l * 1024, last ? l : l + 1, 0, !last, last, last);
        if (!last) for (int r = 0, nr = launder_i(1 + ((PROBE_MASK >> 7) & 1)); r < nr; ++r) convert_layer(p, l + 1, lds);
        for (int r = 0, nr = launder_i(((PROBE_MASK >> 8) & 1) * 10); r < nr; ++r) GSYNC();
        GSYNC();
    }
}

extern "C" void kernel_launch(void* const* d_in, const int* in_sizes, int n_in, void* d_out,
                              int out_size, void* d_ws, size_t ws_size, hipStream_t stream) {
    static int grid_blocks = 0;
    if (!grid_blocks) {
        int dev = 0, cus = 0, per_cu = 0;
        hipGetDevice(&dev);
        hipDeviceGetAttribute(&cus, hipDeviceAttributeMultiprocessorCount, dev);
        if (hipFuncSetAttribute((const void*)fwd_megakernel, hipFuncAttributeMaxDynamicSharedMemorySize, LDS_BYTES) != hipSuccess)
            fprintf(stderr, "hipFuncSetAttribute failed\n");
        hipOccupancyMaxActiveBlocksPerMultiprocessor(&per_cu, (const void*)fwd_megakernel, NTHREADS, LDS_BYTES);
        if (per_cu < 1) fprintf(stderr, "occupancy query says %d blocks/CU\n", per_cu);
        (void)hipGetLastError();
        grid_blocks = cus > 0 ? cus : 256;
        if (ws_size < WS_END) { fprintf(stderr, "workspace too small: %zu < %zu\n", ws_size, (size_t)WS_END); grid_blocks = -1; }
        if (n_in != 33) { fprintf(stderr, "expected 33 inputs, got %d\n", n_in); grid_blocks = -1; }
    }
    if (grid_blocks < 0) return;
    if (hipMemsetAsync((unsigned char*)d_ws + OFF_BAR, 0, 8192, stream) != hipSuccess) fprintf(stderr, "memset failed\n");
    Params p{};
    const float** pp = (const float**)&p;
    for (int i = 0; i < 33; ++i) pp[i] = (const float*)d_in[i];
    p.out = (float*)d_out;
    p.ws = (unsigned char*)d_ws;
    void* args[] = {&p};
    hipError_t e = hipLaunchCooperativeKernel((void*)fwd_megakernel, dim3(grid_blocks), dim3(NTHREADS), args, LDS_BYTES, stream);
    if (e != hipSuccess) fprintf(stderr, "cooperative launch failed: %s (grid %d)\n", hipGetErrorString(e), grid_blocks);
}
```

```cpp
#include <hip/hip_runtime.h>
#include <hip/hip_cooperative_groups.h>
#include <cstdio>
#include <cstdint>
namespace cg = cooperative_groups;

typedef unsigned short bf16_t;
typedef short bf16x8 __attribute__((ext_vector_type(8)));
typedef float f32x4 __attribute__((ext_vector_type(4)));

#ifndef PROBE_MASK
#define PROBE_MASK 0
#endif
constexpr int BATCH = 16, SEQ = 2048, CTXL = 256, DM = 1024, DEPTH = 4, DFF = 2816, DIN = 7200;
constexpr int TPB = SEQ + CTXL;
constexpr int MROWS = BATCH * TPB;
constexpr int NTHREADS = 512;
constexpr int LDS_BYTES = 152 * 1024;
constexpr float ALPHA = 1.681792830507429f;
constexpr float QSCALE = 0.10206207261596575f * 1.4426950408889634f;

constexpr size_t WO_IN = 0;
constexpr size_t WO_UQ = WO_IN + (size_t)7296 * 1024;
constexpr size_t WO_UKV = WO_UQ + (size_t)768 * 384;
constexpr size_t WO_OA = WO_UKV + (size_t)1024 * 256;
constexpr size_t WO_OC = WO_OA + (size_t)1024 * 512;
constexpr size_t WO_OR = WO_OC + (size_t)1024 * 512;
constexpr size_t WO_OUT = WO_OR + (size_t)1024 * 512;
constexpr size_t WO_13 = WO_OUT + (size_t)1024 * 1024;
constexpr size_t WO_2 = WO_13 + (size_t)5632 * 1024;
constexpr size_t WO_UP = WO_2 + (size_t)1024 * 2816;
constexpr size_t WO_AUP = WO_UP + (size_t)2 * 512 * 64;
constexpr size_t WO_GUP = WO_AUP + (size_t)2 * 512 * 64;
constexpr size_t W_ELEMS = WO_GUP + (size_t)512 * 128;

constexpr size_t al256(size_t x) { return (x + 255) & ~(size_t)255; }
constexpr size_t OFF_BAR = 0;
constexpr size_t OFF_ZROW = 1024;
constexpr size_t OFF_W = 8192;
constexpr size_t OFF_MODV = al256(OFF_W + W_ELEMS * 2);
constexpr size_t OFF_ROPE = al256(OFF_MODV + (size_t)4 * 17 * 6144 * 4);
constexpr size_t OFF_RSQ = al256(OFF_ROPE + 64 * 8 * 2 * 4);
constexpr size_t OFF_RSKV = al256(OFF_RSQ + (size_t)MROWS * 4);
constexpr size_t OFF_STATS = al256(OFF_RSKV + (size_t)MROWS * 4);
constexpr size_t OFF_XC = al256(OFF_STATS + (size_t)MROWS * 8);
constexpr size_t OFF_R1 = al256(OFF_XC + (size_t)BATCH * CTXL * DM * 4);
constexpr size_t OFF_R2 = al256(OFF_R1 + (size_t)MROWS * 672 * 2);
constexpr size_t OFF_R3 = OFF_R2 + (size_t)MROWS * 1536 * 2;
constexpr size_t OFF_R4 = al256(OFF_R3 + (size_t)MROWS * 1920 * 2);
constexpr size_t OFF_R5 = al256(OFF_R4 + (size_t)MROWS * (512 + 512 + 32) * 2);
constexpr size_t OFF_R6 = al256(OFF_R5 + (size_t)MROWS * 512 * 2);
constexpr size_t WS_END = al256(OFF_R6 + (size_t)MROWS * 1024 * 2);
constexpr size_t OFF_Q = OFF_R2;
constexpr size_t OFF_YF = OFF_R2 + (size_t)MROWS * 768 * 2;
constexpr size_t OFF_SG = OFF_YF + (size_t)MROWS * 512 * 2;
constexpr size_t OFF_YB = OFF_R1;
constexpr size_t OFF_KN = OFF_R4;
constexpr size_t OFF_VT = OFF_R4 + (size_t)MROWS * 512 * 2;
constexpr size_t OFF_KR = OFF_VT + (size_t)MROWS * 512 * 2;
constexpr size_t OFF_RWO = OFF_R4;
constexpr size_t OFF_MRG = OFF_R3;
constexpr size_t OFF_HF = OFF_R2;
static_assert(OFF_SG + (size_t)MROWS * 128 * 2 <= OFF_R3, "R2 overlay overflow");
static_assert((size_t)MROWS * 2816 * 2 <= OFF_R4 - OFF_R2, "HF overflow");

struct Params {
    const float *x, *c, *ctx, *c_ctx, *mod_w, *mod_b, *w_in, *q_norm, *w_uq, *kv_norm, *w_ukv, *w_o_attn,
        *conv_w, *w_o_conv, *rw_mu, *rw_w0, *rw_w_up, *rw_a0, *rw_a_up, *rw_g_up, *rw_k_k, *rw_k_a,
        *rw_r_k, *rw_gn_g, *rw_gn_b, *w_o_rwkv, *w_out, *ln1_g, *ln1_b, *ffn_w13, *ffn_w2, *ln2_g, *ln2_b;
    float* out;
    unsigned char* ws;
};

typedef __attribute__((address_space(1))) unsigned char gchar_t;
typedef __attribute__((address_space(1))) float gfloat_t;
__device__ __forceinline__ Params launder(const Params& a) {
    Params q = a;
    unsigned long long w = (unsigned long long)a.ws, o = (unsigned long long)a.out;
    unsigned wl = __builtin_amdgcn_readfirstlane((unsigned)w), wh = __builtin_amdgcn_readfirstlane((unsigned)(w >> 32));
    unsigned ol = __builtin_amdgcn_readfirstlane((unsigned)o), oh = __builtin_amdgcn_readfirstlane((unsigned)(o >> 32));
    asm volatile("" : "+s"(wl), "+s"(wh), "+s"(ol), "+s"(oh));
    w = ((unsigned long long)wh << 32) | wl; o = ((unsigned long long)oh << 32) | ol;
    q.ws = (unsigned char*)(gchar_t*)w; q.out = (float*)(gfloat_t*)o;
    return q;
}
__device__ __forceinline__ int launder_i(int v) { v = __builtin_amdgcn_readfirstlane(v); asm volatile("" : "+s"(v)); return v; }
__device__ __forceinline__ int ltid() { int t = threadIdx.x; asm volatile("" : "+v"(t)); return t; }
__device__ __forceinline__ unsigned pk_bf16(float lo, float hi) { unsigned r; asm("v_cvt_pk_bf16_f32 %0, %1, %2" : "=v"(r) : "v"(lo), "v"(hi)); return r; }
__device__ __forceinline__ float bf_lo(unsigned u) { return __uint_as_float(u << 16); }
__device__ __forceinline__ float bf_hi(unsigned u) { return __uint_as_float(u & 0xffff0000u); }
__device__ __forceinline__ float bf1(bf16_t h) { return __uint_as_float(((unsigned)h) << 16); }
__device__ __forceinline__ float x32sum(float x) { unsigned u = __float_as_uint(x); auto r = __builtin_amdgcn_permlane32_swap(u, u, false, false); return __uint_as_float(r[0]) + __uint_as_float(r[1]); }
__device__ __forceinline__ float x16sum(float x) { unsigned u = __float_as_uint(x); auto r = __builtin_amdgcn_permlane16_swap(u, u, false, false); return __uint_as_float(r[0]) + __uint_as_float(r[1]); }
__device__ __forceinline__ float x32max(float x) { unsigned u = __float_as_uint(x); auto r = __builtin_amdgcn_permlane32_swap(u, u, false, false); return fmaxf(__uint_as_float(r[0]), __uint_as_float(r[1])); }
__device__ __forceinline__ float x16max(float x) { unsigned u = __float_as_uint(x); auto r = __builtin_amdgcn_permlane16_swap(u, u, false, false); return fmaxf(__uint_as_float(r[0]), __uint_as_float(r[1])); }
__device__ __forceinline__ float fqsum(float x) { return x16sum(x32sum(x)); }
__device__ __forceinline__ float fqmax(float x) { return x16max(x32max(x)); }

template <int CTRL> __device__ __forceinline__ float dpp_add(float x) { return x + __uint_as_float((unsigned)__builtin_amdgcn_update_dpp(0, (int)__float_as_uint(x), CTRL, 0xf, 0xf, true)); }
__device__ __forceinline__ float red8(float x) { x = dpp_add<0xB1>(x); x = dpp_add<0x4E>(x); x = dpp_add<0x141>(x); return x; }
__device__ __forceinline__ float xor32_get(float x, int lane) { const unsigned u = __float_as_uint(x); auto r = __builtin_amdgcn_permlane32_swap(u, u, false, false); return __uint_as_float(lane < 32 ? r[1] : r[0]); }
__device__ __forceinline__ float xor8_get(float x) { return __uint_as_float((unsigned)__builtin_amdgcn_update_dpp(0, (int)__float_as_uint(x), 0x128, 0xf, 0xf, true)); }
__device__ __forceinline__ float wave_sum(float v) { v = dpp_add<0xB1>(v); v = dpp_add<0x4E>(v); v = dpp_add<0x141>(v); v = dpp_add<0x140>(v); return fqsum(v); }
__device__ __forceinline__ uint4 widen16(uint2 a, uint2 b) {
    auto r0 = __builtin_amdgcn_permlane16_swap(a.x, b.x, false, false);
    auto r1 = __builtin_amdgcn_permlane16_swap(a.y, b.y, false, false);
    return make_uint4(r0[0], r1[0], r0[1], r1[1]);
}
__device__ __forceinline__ float fexp(float x) { return __builtin_amdgcn_exp2f(x * 1.4426950408889634f); }
__device__ __forceinline__ float sigmoidf_(float x) { return __builtin_amdgcn_rcpf(1.0f + fexp(-x)); }
__device__ __forceinline__ float siluf_(float x) { return x * __builtin_amdgcn_rcpf(1.0f + fexp(-x)); }

__device__ __forceinline__ const float* x_rd(const Params& p, bool from_input, int b, int pp) {
    if (pp < CTXL) return (from_input ? p.ctx : (const float*)(p.ws + OFF_XC)) + ((size_t)b * CTXL + pp) * DM;
    return (from_input ? p.x : (const float*)p.out) + ((size_t)b * SEQ + (pp - CTXL)) * DM;
}
__device__ __forceinline__ float* x_wr(const Params& p, int b, int pp) {
    if (pp < CTXL) return (float*)(p.ws + OFF_XC) + ((size_t)b * CTXL + pp) * DM;
    return p.out + ((size_t)b * SEQ + (pp - CTXL)) * DM;
}
__device__ __forceinline__ const float* modv_ptr(const Params& p, int l, int b, int pp) {
    const int mr = pp < CTXL ? 16 : b;
    return (const float*)(p.ws + OFF_MODV) + ((size_t)l * 17 + mr) * 6144;
}

__device__ __forceinline__ void grid_barrier(unsigned* bar, unsigned& epoch) {
    asm volatile("s_waitcnt vmcnt(0) lgkmcnt(0)" ::: "memory");
    __syncthreads();
    epoch += 1;
    if (threadIdx.x == 0) {
        __builtin_amdgcn_fence(__ATOMIC_RELEASE, "agent");
        asm volatile("s_waitcnt vmcnt(0)" ::: "memory");
        const unsigned old = __hip_atomic_fetch_add(bar, 1u, __ATOMIC_RELAXED, __HIP_MEMORY_SCOPE_AGENT);
        if (old + 1u == epoch * gridDim.x) {
            __hip_atomic_store(bar + 64, epoch, __ATOMIC_RELAXED, __HIP_MEMORY_SCOPE_AGENT);
        } else {
            while (__hip_atomic_load(bar + 64, __ATOMIC_RELAXED, __HIP_MEMORY_SCOPE_AGENT) < epoch) __builtin_amdgcn_s_sleep(1);
        }
        __builtin_amdgcn_fence(__ATOMIC_ACQUIRE, "agent");
        asm volatile("s_waitcnt vmcnt(0)" ::: "memory");
    }
    __syncthreads();
}

#define LDS_AS __attribute__((address_space(3)))
#define GLB_AS __attribute__((address_space(1)))
template <int MT, int SWAPMODE>
__device__ __forceinline__ void gemm_mainloop(f32x4 (&acc)[MT][4], const bf16_t* __restrict__ A, int lda, int a_kstep,
                                              const bf16_t* __restrict__ Bt, int ldb, int nk, unsigned char* lds, int tid) {
    constexpr int BMr = 64 * MT;
    constexpr int STAGE = (BMr + 128) * 128;
    const int wid = __builtin_amdgcn_readfirstlane(tid >> 6), lane = tid & 63, wr = wid >> 1, wc = wid & 1, fr = lane & 15, fq = lane >> 4;
    const int lrow = 8 * wid + (lane >> 3);
    const int lch = (lane & 7) ^ ((4 * wid + (lane >> 4)) & 7);
    const bf16_t* ap = A + (size_t)lrow * lda + lch * 8;
    const bf16_t* bp = Bt + (size_t)lrow * ldb + lch * 8;
    auto issue = [&](int kt, int st) {
        unsigned char* base = lds + st * STAGE + wid * 1024;
#pragma unroll
        for (int i = 0; i < MT; ++i)
            __builtin_amdgcn_global_load_lds((const GLB_AS unsigned*)(ap + (size_t)i * 64 * lda + (size_t)kt * a_kstep), (LDS_AS unsigned*)(base + i * 8192), 16, 0, 0);
#pragma unroll
        for (int i = 0; i < 2; ++i)
            __builtin_amdgcn_global_load_lds((const GLB_AS unsigned*)(bp + (size_t)i * 64 * ldb + (size_t)kt * 64), (LDS_AS unsigned*)(base + (BMr + i * 64) * 128), 16, 0, 0);
    };
    const bool sw = (SWAPMODE == 1) || (SWAPMODE == 2 && wc == 0);
    const int sz = fr >> 1;
    constexpr int NL = MT + 2;
    const bool late = wid >= 4;
    issue(0, 0);
    if (nk > 1) { issue(1, 1); asm volatile("s_waitcnt vmcnt(%0)" ::"n"(NL) : "memory"); }
    else asm volatile("s_waitcnt vmcnt(0)" ::: "memory");
    __builtin_amdgcn_s_barrier();
    asm volatile("" ::: "memory");
    int st = 0;
    for (int kt = 0; kt < nk; ++kt) {
        const int st2 = st >= 1 ? st - 1 : 2;
        if (!late && kt + 2 < nk) issue(kt + 2, st2);
        const unsigned char* As = lds + st * STAGE;
        const unsigned char* Bs = As + BMr * 128;
#pragma unroll
        for (int ks = 0; ks < 2; ++ks) {
            bf16x8 af[MT], bfr[4];
            const int co = ((ks * 4 + fq) ^ sz) * 16;
#pragma unroll
            for (int m = 0; m < MT; ++m) af[m] = *(const bf16x8*)(As + (wr * 16 * MT + m * 16 + fr) * 128 + co);
#pragma unroll
            for (int n = 0; n < 4; ++n) bfr[n] = *(const bf16x8*)(Bs + (wc * 64 + n * 16 + fr) * 128 + co);
            if (sw) {
#pragma unroll
                for (int m = 0; m < MT; ++m)
#pragma unroll
                    for (int n = 0; n < 4; ++n) acc[m][n] = __builtin_amdgcn_mfma_f32_16x16x32_bf16(bfr[n], af[m], acc[m][n], 0, 0, 0);
            } else {
#pragma unroll
                for (int m = 0; m < MT; ++m)
#pragma unroll
                    for (int n = 0; n < 4; ++n) acc[m][n] = __builtin_amdgcn_mfma_f32_16x16x32_bf16(af[m], bfr[n], acc[m][n], 0, 0, 0);
            }
        }
        if (late && kt + 2 < nk) issue(kt + 2, st2);
        if (kt + 2 < nk) asm volatile("s_waitcnt vmcnt(%0) lgkmcnt(0)" ::"n"(NL) : "memory");
        else asm volatile("s_waitcnt vmcnt(0) lgkmcnt(0)" ::: "memory");
        __builtin_amdgcn_s_barrier();
        asm volatile("" ::: "memory");
        st = st == 2 ? 0 : st + 1;
    }
}
__device__ __forceinline__ void gemm_mainloop256(f32x4 (&acc)[8][4], const bf16_t* __restrict__ A, int lda,
                                                 const bf16_t* __restrict__ Bt, int ldb, int nk, unsigned char* lds, int tid) {
    constexpr int STAGE = 512 * 128;
    const int wid = __builtin_amdgcn_readfirstlane(tid >> 6), lane = tid & 63, wr = wid >> 2, wc = wid & 3, fr = lane & 15, fq = lane >> 4;
    const int lrow = 8 * wid + (lane >> 3);
    const int lch = (lane & 7) ^ ((4 * wid + (lane >> 4)) & 7);
    const bf16_t* ap = A + (size_t)lrow * lda + lch * 8;
    const bf16_t* bp = Bt + (size_t)lrow * ldb + lch * 8;
    auto issue = [&](int kt, int st) {
        unsigned char* base = lds + st * STAGE + wid * 1024;
#pragma unroll
        for (int i = 0; i < 4; ++i)
            __builtin_amdgcn_global_load_lds((const GLB_AS unsigned*)(ap + (size_t)i * 64 * lda + (size_t)kt * 64), (LDS_AS unsigned*)(base + i * 8192), 16, 0, 0);
#pragma unroll
        for (int i = 0; i < 4; ++i)
            __builtin_amdgcn_global_load_lds((const GLB_AS unsigned*)(bp + (size_t)i * 64 * ldb + (size_t)kt * 64), (LDS_AS unsigned*)(base + (256 + i * 64) * 128), 16, 0, 0);
    };
    const int sz = fr >> 1;
    const bool late = wid >= 4;
    issue(0, 0);
    asm volatile("s_waitcnt vmcnt(0)" ::: "memory");
    __builtin_amdgcn_s_barrier();
    asm volatile("" ::: "memory");
    for (int kt = 0; kt < nk; ++kt) {
        if (!late && kt + 1 < nk) issue(kt + 1, (kt + 1) & 1);
        const unsigned char* As = lds + (kt & 1) * STAGE;
        const unsigned char* Bs = As + 256 * 128;
#pragma unroll
        for (int ks = 0; ks < 2; ++ks) {
            if (ks == 1 && late && kt + 1 < nk) issue(kt + 1, (kt + 1) & 1);
            bf16x8 af[8], bfr[4];
            const int co = ((ks * 4 + fq) ^ sz) * 16;
#pragma unroll
            for (int m = 0; m < 8; ++m) af[m] = *(const bf16x8*)(As + (wr * 128 + m * 16 + fr) * 128 + co);
#pragma unroll
            for (int n = 0; n < 4; ++n) bfr[n] = *(const bf16x8*)(Bs + (wc * 64 + n * 16 + fr) * 128 + co);
#pragma unroll
            for (int m = 0; m < 8; ++m)
#pragma unroll
                for (int n = 0; n < 4; ++n) acc[m][n] = __builtin_amdgcn_mfma_f32_16x16x32_bf16(bfr[n], af[m], acc[m][n], 0, 0, 0);
        }
        asm volatile("s_waitcnt vmcnt(0) lgkmcnt(0)" ::: "memory");
        __builtin_amdgcn_s_barrier();
        asm volatile("" ::: "memory");
    }
}
struct Seg { const bf16_t* A; const bf16_t* Bt; int lda, a_kstep, ldb, nk; };
template <int MT, int SWAPMODE>
__device__ __forceinline__ void gemm_stream(f32x4 (&acc)[MT][4], const Seg& cur, const Seg& nxt, bool has_next, bool first, int& st,
                                            unsigned char* lds, int tid) {
    constexpr int BMr = 64 * MT;
    constexpr int STAGE = (BMr + 128) * 128;
    constexpr int NL = MT + 2;
    const int wid = __builtin_amdgcn_readfirstlane(tid >> 6), lane = tid & 63, wr = wid >> 1, wc = wid & 1, fr = lane & 15, fq = lane >> 4;
    const int lrow = 8 * wid + (lane >> 3);
    const int lch = (lane & 7) ^ ((4 * wid + (lane >> 4)) & 7);
    const bf16_t* apc = cur.A + (size_t)lrow * cur.lda + lch * 8;
    const bf16_t* bpc = cur.Bt + (size_t)lrow * cur.ldb + lch * 8;
    const bf16_t* apn = nxt.A + (size_t)lrow * nxt.lda + lch * 8;
    const bf16_t* bpn = nxt.Bt + (size_t)lrow * nxt.ldb + lch * 8;
    auto issue = [&](const bf16_t* ap, const bf16_t* bp, int lda, int ldb, int koffa, int koffb, int slot) {
        unsigned char* base = lds + slot * STAGE + wid * 1024;
#pragma unroll
        for (int i = 0; i < MT; ++i)
            __builtin_amdgcn_global_load_lds((const GLB_AS unsigned*)(ap + (size_t)i * 64 * lda + koffa), (LDS_AS unsigned*)(base + i * 8192), 16, 0, 0);
#pragma unroll
        for (int i = 0; i < 2; ++i)
            __builtin_amdgcn_global_load_lds((const GLB_AS unsigned*)(bp + (size_t)i * 64 * ldb + koffb), (LDS_AS unsigned*)(base + (BMr + i * 64) * 128), 16, 0, 0);
    };
    const bool sw = (SWAPMODE == 1) || (SWAPMODE == 2 && wc == 0);
    const int sz = fr >> 1;
    const bool late = wid >= 4;
    const int nk = cur.nk;
    int s0 = st;
    if (first) {
        const int s1 = s0 == 2 ? 0 : s0 + 1;
        issue(apc, bpc, cur.lda, cur.ldb, 0, 0, s0);
        issue(apc, bpc, cur.lda, cur.ldb, cur.a_kstep, 64, s1);
        asm volatile("s_waitcnt vmcnt(%0)" ::"n"(NL) : "memory");
        __builtin_amdgcn_s_barrier();
        asm volatile("" ::: "memory");
    }
    for (int kt = 0; kt < nk; ++kt) {
        const int s2 = s0 >= 1 ? s0 - 1 : 2;
        const int idx = kt + 2;
        const bool incur = idx < nk, doi = incur || has_next;
        if (!late && doi) { if (incur) issue(apc, bpc, cur.lda, cur.ldb, idx * cur.a_kstep, idx * 64, s2); else issue(apn, bpn, nxt.lda, nxt.ldb, (idx - nk) * nxt.a_kstep, (idx - nk) * 64, s2); }
        const unsigned char* As = lds + s0 * STAGE;
        const unsigned char* Bs = As + BMr * 128;
#pragma unroll
        for (int ks = 0; ks < 2; ++ks) {
            bf16x8 af[MT], bfr[4];
            const int co = ((ks * 4 + fq) ^ sz) * 16;
#pragma unroll
            for (int m = 0; m < MT; ++m) af[m] = *(const bf16x8*)(As + (wr * 16 * MT + m * 16 + fr) * 128 + co);
#pragma unroll
            for (int n = 0; n < 4; ++n) bfr[n] = *(const bf16x8*)(Bs + (wc * 64 + n * 16 + fr) * 128 + co);
            if (sw) {
#pragma unroll
                for (int m = 0; m < MT; ++m)
#pragma unroll
                    for (int n = 0; n < 4; ++n) acc[m][n] = __builtin_amdgcn_mfma_f32_16x16x32_bf16(bfr[n], af[m], acc[m][n], 0, 0, 0);
            } else {
#pragma unroll
                for (int m = 0; m < MT; ++m)
#pragma unroll
                    for (int n = 0; n < 4; ++n) acc[m][n] = __builtin_amdgcn_mfma_f32_16x16x32_bf16(af[m], bfr[n], acc[m][n], 0, 0, 0);
            }
        }
        if (late && doi) { if (incur) issue(apc, bpc, cur.lda, cur.ldb, idx * cur.a_kstep, idx * 64, s2); else issue(apn, bpn, nxt.lda, nxt.ldb, (idx - nk) * nxt.a_kstep, (idx - nk) * 64, s2); }
        if (doi) asm volatile("s_waitcnt vmcnt(%0) lgkmcnt(0)" ::"n"(NL) : "memory");
        else asm volatile("s_waitcnt vmcnt(0) lgkmcnt(0)" ::: "memory");
        __builtin_amdgcn_s_barrier();
        asm volatile("" ::: "memory");
        s0 = s0 == 2 ? 0 : s0 + 1;
    }
    st = s0;
}
__device__ __forceinline__ void gemm_stream256(f32x4 (&acc)[8][4], const Seg& cur, const Seg& nxt, bool has_next, bool first, int& st, unsigned char* lds, int tid) {
    constexpr int STAGE = 512 * 128;
    const int wid = __builtin_amdgcn_readfirstlane(tid >> 6), lane = tid & 63, wr = wid >> 2, wc = wid & 3, fr = lane & 15, fq = lane >> 4;
    const int lrow = 8 * wid + (lane >> 3);
    const int lch = (lane & 7) ^ ((4 * wid + (lane >> 4)) & 7);
    const bf16_t* apc = cur.A + (size_t)lrow * cur.lda + lch * 8;
    const bf16_t* bpc = cur.Bt + (size_t)lrow * cur.ldb + lch * 8;
    const bf16_t* apn = nxt.A + (size_t)lrow * nxt.lda + lch * 8;
    const bf16_t* bpn = nxt.Bt + (size_t)lrow * nxt.ldb + lch * 8;
    auto issue = [&](const bf16_t* ap, const bf16_t* bp, int lda, int ldb, int koff, int slot) {
        unsigned char* base = lds + slot * STAGE + wid * 1024;
#pragma unroll
        for (int i = 0; i < 4; ++i)
            __builtin_amdgcn_global_load_lds((const GLB_AS unsigned*)(ap + (size_t)i * 64 * lda + koff), (LDS_AS unsigned*)(base + i * 8192), 16, 0, 0);
#pragma unroll
        for (int i = 0; i < 4; ++i)
            __builtin_amdgcn_global_load_lds((const GLB_AS unsigned*)(bp + (size_t)i * 64 * ldb + koff), (LDS_AS unsigned*)(base + (256 + i * 64) * 128), 16, 0, 0);
    };
    const int sz = fr >> 1;
    const bool late = wid >= 4;
    const int nk = cur.nk;
    int s0 = st;
    if (first) {
        issue(apc, bpc, cur.lda, cur.ldb, 0, s0);
        asm volatile("s_waitcnt vmcnt(0)" ::: "memory");
        __builtin_amdgcn_s_barrier();
        asm volatile("" ::: "memory");
    }
    for (int kt = 0; kt < nk; ++kt) {
        const int idx = kt + 1;
        const bool incur = idx < nk, doi = incur || has_next;
        if (!late && doi) { if (incur) issue(apc, bpc, cur.lda, cur.ldb, idx * 64, s0 ^ 1); else issue(apn, bpn, nxt.lda, nxt.ldb, 0, s0 ^ 1); }
        const unsigned char* As = lds + s0 * STAGE;
        const unsigned char* Bs = As + 256 * 128;
#pragma unroll
        for (int ks = 0; ks < 2; ++ks) {
            if (ks == 1 && late && doi) { if (incur) issue(apc, bpc, cur.lda, cur.ldb, idx * 64, s0 ^ 1); else issue(apn, bpn, nxt.lda, nxt.ldb, 0, s0 ^ 1); }
            bf16x8 af[8], bfr[4];
            const int co = ((ks * 4 + fq) ^ sz) * 16;
#pragma unroll
            for (int m = 0; m < 8; ++m) af[m] = *(const bf16x8*)(As + (wr * 128 + m * 16 + fr) * 128 + co);
#pragma unroll
            for (int n = 0; n < 4; ++n) bfr[n] = *(const bf16x8*)(Bs + (wc * 64 + n * 16 + fr) * 128 + co);
#pragma unroll
            for (int m = 0; m < 8; ++m)
#pragma unroll
                for (int n = 0; n < 4; ++n) acc[m][n] = __builtin_amdgcn_mfma_f32_16x16x32_bf16(bfr[n], af[m], acc[m][n], 0, 0, 0);
        }
        asm volatile("s_waitcnt vmcnt(0) lgkmcnt(0)" ::: "memory");
        __builtin_amdgcn_s_barrier();
        asm volatile("" ::: "memory");
        s0 ^= 1;
    }
    st = s0;
}
__device__ __forceinline__ void gemm_gate3(f32x4 (&g)[3][2][4], const bf16_t* __restrict__ A, const bf16_t* __restrict__ Bt0, int nk, unsigned char* lds, int tid) {
    constexpr int STAGE = 512 * 128;
    const int wid = __builtin_amdgcn_readfirstlane(tid >> 6), lane = tid & 63, wr = wid >> 1, wc = wid & 1, fr = lane & 15, fq = lane >> 4;
    const int lrow = 8 * wid + (lane >> 3);
    const int lch = (lane & 7) ^ ((4 * wid + (lane >> 4)) & 7);
    const unsigned loff = (unsigned)(lrow * 1024 + lch * 8);
    auto issue = [&](int kt, int stg) {
        unsigned char* base = lds + stg * STAGE + wid * 1024;
#pragma unroll
        for (int i = 0; i < 2; ++i)
            __builtin_amdgcn_global_load_lds((const GLB_AS unsigned*)((A + (size_t)i * 64 * 1024 + (size_t)kt * 64) + loff), (LDS_AS unsigned*)(base + i * 8192), 16, 0, 0);
#pragma unroll
        for (int j = 0; j < 6; ++j)
            __builtin_amdgcn_global_load_lds((const GLB_AS unsigned*)((Bt0 + ((size_t)(j >> 1) * 1024 + (j & 1) * 64) * 1024 + (size_t)kt * 64) + loff), (LDS_AS unsigned*)(base + (128 + j * 64) * 128), 16, 0, 0);
    };
    const int sz = fr >> 1;
    const bool late = wid >= 4;
    issue(0, 0);
    asm volatile("s_waitcnt vmcnt(0)" ::: "memory");
    __builtin_amdgcn_s_barrier();
    asm volatile("" ::: "memory");
    for (int kt = 0; kt < nk; ++kt) {
        if (!late && kt + 1 < nk) issue(kt + 1, (kt + 1) & 1);
        const unsigned char* As = lds + (kt & 1) * STAGE;
        const unsigned char* Bs = As + 128 * 128;
#pragma unroll
        for (int ks = 0; ks < 2; ++ks) {
            if (ks == 1 && late && kt + 1 < nk) issue(kt + 1, (kt + 1) & 1);
            const int co = ((ks * 4 + fq) ^ sz) * 16;
            bf16x8 af[2];
#pragma unroll
            for (int m = 0; m < 2; ++m) af[m] = *(const bf16x8*)(As + (wr * 32 + m * 16 + fr) * 128 + co);
#pragma unroll
            for (int i = 0; i < 3; ++i) {
                bf16x8 bfr[4];
#pragma unroll
                for (int n = 0; n < 4; ++n) bfr[n] = *(const bf16x8*)(Bs + (i * 128 + wc * 64 + n * 16 + fr) * 128 + co);
#pragma unroll
                for (int m = 0; m < 2; ++m)
#pragma unroll
                    for (int n = 0; n < 4; ++n) g[i][m][n] = __builtin_amdgcn_mfma_f32_16x16x32_bf16(bfr[n], af[m], g[i][m][n], 0, 0, 0);
                if (i < 2) __builtin_amdgcn_sched_barrier(0);
            }
        }
        asm volatile("s_waitcnt vmcnt(0) lgkmcnt(0)" ::: "memory");
        __builtin_amdgcn_s_barrier();
        asm volatile("" ::: "memory");
    }
}
template <int MT> __device__ __forceinline__ void zero_acc(f32x4 (&acc)[MT][4]) {
#pragma unroll
    for (int m = 0; m < MT; ++m)
#pragma unroll
        for (int n = 0; n < 4; ++n) acc[m][n] = (f32x4){0.f, 0.f, 0.f, 0.f};
}
__device__ __forceinline__ void tile_mn(int t, int nN, int& mt, int& nt) { const int per = 16 * nN, g = t / per, w = t % per; mt = g * 16 + (w & 15); nt = w >> 4; }

__device__ __forceinline__ int rowmap(int mode, int n) {
    if (mode == 1) return n < 672 ? n : n + 96;
    if (mode == 2) return n < DFF ? ((n >> 5) * 64 + (n & 31)) : (((n - DFF) >> 5) * 64 + 32 + ((n - DFF) & 31));
    return n;
}
__device__ __forceinline__ void convert_T(const float* __restrict__ src, int K, int N, bf16_t* __restrict__ dst, int mode, const float* __restrict__ ks, unsigned char* lds, int rot) {
    float* tile = (float*)lds;
    const int ntk = K / 64, ntn = (N + 63) / 64, tid = ltid();
    const int start = (blockIdx.x + gridDim.x - (rot % gridDim.x)) % gridDim.x;
    for (int t = start; t < ntk * ntn; t += gridDim.x) {
        const int tk = t % ntk, tn = t / ntk, k0 = tk * 64, n0 = tn * 64;
#pragma unroll
        for (int i = 0; i < 8; ++i) {
            const int kl = (tid >> 6) + 8 * i, nl = tid & 63, n = n0 + nl;
            tile[kl * 65 + nl] = n < N ? src[(size_t)(k0 + kl) * N + n] : 0.f;
        }
        __syncthreads();
        const int kp = (tid & 31) * 2;
        float s0 = 1.f, s1 = 1.f;
        if (ks) { s0 = ks[k0 + kp]; s1 = ks[k0 + kp + 1]; }
#pragma unroll
        for (int i = 0; i < 4; ++i) {
            const int nl = (tid >> 5) + 16 * i, n = n0 + nl;
            if (n < N) *(unsigned*)(dst + (size_t)rowmap(mode, n) * K + k0 + kp) = pk_bf16(tile[kp * 65 + nl] * s0, tile[(kp + 1) * 65 + nl] * s1);
        }
        __syncthreads();
    }
}
__device__ __forceinline__ void convert_layer(const Params& pin, int l, unsigned char* lds) {
    const Params p = launder(pin); l = launder_i(l);
    bf16_t* W = (bf16_t*)(p.ws + OFF_W);
    convert_T(p.w_in + (size_t)l * DM * DIN, DM, DIN, W + WO_IN, 1, nullptr, lds, 0);
    convert_T(p.ffn_w13 + (size_t)l * DM * 2 * DFF, DM, 2 * DFF, W + WO_13, 2, nullptr, lds, 40);
    convert_T(p.ffn_w2 + (size_t)l * DFF * DM, DFF, DM, W + WO_2, 0, nullptr, lds, 80);
    convert_T(p.w_out + (size_t)l * DM * DM, DM, DM, W + WO_OUT, 0, nullptr, lds, 120);
    convert_T(p.w_o_attn + (size_t)l * 512 * DM, 512, DM, W + WO_OA, 0, nullptr, lds, 136);
    convert_T(p.w_o_conv + (size_t)l * 512 * DM, 512, DM, W + WO_OC, 0, nullptr, lds, 8);
    convert_T(p.w_o_rwkv + (size_t)l * 512 * DM, 512, DM, W + WO_OR, 0, nullptr, lds, 136 + 8);
    convert_T(p.w_uq + (size_t)l * 384 * 768, 384, 768, W + WO_UQ, 0, p.q_norm + l * 384, lds, 16);
    convert_T(p.w_ukv + (size_t)l * 256 * 1024, 256, 1024, W + WO_UKV, 0, p.kv_norm + l * 256, lds, 88);
    for (int z = 0; z < 2; ++z) {
        convert_T(p.rw_w_up + ((size_t)l * 2 + z) * 64 * 512, 64, 512, W + WO_UP + (size_t)z * 512 * 64, 0, nullptr, lds, 152 + 8 * z);
        convert_T(p.rw_a_up + ((size_t)l * 2 + z) * 64 * 512, 64, 512, W + WO_AUP + (size_t)z * 512 * 64, 0, nullptr, lds, 168 + 8 * z);
    }
    convert_T(p.rw_g_up + (size_t)l * 128 * 512, 128, 512, W + WO_GUP, 0, nullptr, lds, 184);
}

__device__ __forceinline__ void modv_phase(const Params& pin, unsigned char* lds) {
    const Params p = launder(pin);
    float* s = (float*)lds;
    float* red = s + 17 * 1024;
    const int tid = ltid(), wid = tid >> 6, lane = tid & 63;
    for (int i = tid; i < 17 * 1024; i += NTHREADS) { const int r = i >> 10, k = i & 1023; const float v = r < 16 ? p.c[r * 1024 + k] : p.c_ctx[k]; s[i] = siluf_(v); }
    __syncthreads();
    float* modv = (float*)(p.ws + OFF_MODV);
    for (int g = blockIdx.x; g < 4 * 96; g += gridDim.x) {
        const int l = g / 96, n = (g % 96) * 64 + lane;
        const float* w = p.mod_w + (size_t)l * 1024 * 6144 + n;
        float acc[17];
#pragma unroll
        for (int r = 0; r < 17; ++r) acc[r] = 0.f;
        const int kb = wid * 128;
        for (int k = kb; k < kb + 128; k += 4) {
            const float w0 = w[(size_t)k * 6144], w1 = w[(size_t)(k + 1) * 6144], w2 = w[(size_t)(k + 2) * 6144], w3 = w[(size_t)(k + 3) * 6144];
#pragma unroll
            for (int r = 0; r < 17; ++r) { const f32x4 sv = *(const f32x4*)(s + r * 1024 + k); acc[r] += sv[0] * w0 + sv[1] * w1 + sv[2] * w2 + sv[3] * w3; }
        }
#pragma unroll
        for (int r = 0; r < 17; ++r) red[(wid * 17 + r) * 64 + lane] = acc[r];
        __syncthreads();
        for (int i = tid; i < 17 * 64; i += NTHREADS) {
            const int r = i >> 6, c = i & 63; float v = 0.f;
#pragma unroll
            for (int w8 = 0; w8 < 8; ++w8) v += red[(w8 * 17 + r) * 64 + c];
            const int nn = (g % 96) * 64 + c;
            modv[((size_t)l * 17 + r) * 6144 + nn] = v + p.mod_b[l * 6144 + nn];
        }
        __syncthreads();
    }
    if (blockIdx.x == gridDim.x - 1) {
        float* rope = (float*)(p.ws + OFF_ROPE);
        for (int i = tid; i < 512; i += NTHREADS) {
            const int pos = i >> 3, f = i & 7;
            const float inv = exp2f(-(float)f * (13.287712379549449f / 8.0f));
            const float ang = (float)pos * inv;
            rope[i * 2] = cosf(ang); rope[i * 2 + 1] = sinf(ang);
        }
    }
}

__device__ __forceinline__ void xmod0_phase(const Params& pin) {
    const Params p = launder(pin);
    const int tid = ltid(), wid = tid >> 6, lane = tid & 63;
    bf16_t* xm = (bf16_t*)(p.ws + OFF_R6);
    for (int row = blockIdx.x * 8 + wid; row < MROWS; row += gridDim.x * 8) {
        const int b = row / TPB, pp = row % TPB;
        const float* xp = x_rd(p, true, b, pp);
        const float* mv = modv_ptr(p, 0, b, pp);
#pragma unroll
        for (int i = 0; i < 4; ++i) {
            const int c = i * 256 + lane * 4;
            const f32x4 v = *(const f32x4*)(xp + c), sh = *(const f32x4*)(mv + c), sc = *(const f32x4*)(mv + 1024 + c);
            uint2 o; o.x = pk_bf16(v[0] * (1.f + sc[0]) + sh[0], v[1] * (1.f + sc[1]) + sh[1]); o.y = pk_bf16(v[2] * (1.f + sc[2]) + sh[2], v[3] * (1.f + sc[3]) + sh[3]);
            *(uint2*)(xm + (size_t)row * 1024 + c) = o;
        }
    }
}

__device__ __forceinline__ void p1_phase(const Params& pin, unsigned char* lds) {
    const Params p = launder(pin); const int tid = ltid();
    const bf16_t* A = (const bf16_t*)(p.ws + OFF_R6);
    const bf16_t* W = (const bf16_t*)(p.ws + OFF_W) + WO_IN;
    const int lane = tid & 63, wid = tid >> 6, wr = wid >> 2, wc = wid & 3, fr = lane & 15, fq = lane >> 4;
    auto seg = [&](int t) { int mt, nt; tile_mn(t, 17, mt, nt); Seg g; g.A = A + (size_t)mt * 256 * 1024; g.Bt = W + (size_t)nt * 256 * 1024; g.lda = 1024; g.a_kstep = 64; g.ldb = 1024; g.nk = 16; return g; };
    int st = 0; bool first = true;
    for (int t = blockIdx.x; t < 144 * 17; t += gridDim.x) {
        int mt, nt; tile_mn(t, 17, mt, nt);
        const int tn = t + gridDim.x; const bool hn = tn < 144 * 17;
        f32x4 acc[8][4]; zero_acc<8>(acc);
        gemm_stream256(acc, seg(t), seg(hn ? tn : t), hn, first, st, lds, tid); first = false;
        bf16_t* dst; int ld, cb, lim;
        if (nt < 3) { dst = (bf16_t*)(p.ws + OFF_R1); ld = 672; cb = nt * 256; lim = 672; }
        else if (nt < 9) { dst = (bf16_t*)(p.ws + OFF_R2); ld = 1536; cb = (nt - 3) * 256; lim = 1536; }
        else { dst = (bf16_t*)(p.ws + OFF_R3); ld = 1920; cb = (nt - 9) * 256; lim = 1920; }
#pragma unroll
        for (int m = 0; m < 8; ++m) {
            const size_t row = (size_t)mt * 256 + wr * 128 + m * 16 + fr;
#pragma unroll
            for (int n = 0; n < 4; n += 2) {
                uint2 a, b2;
                a.x = pk_bf16(acc[m][n][0], acc[m][n][1]); a.y = pk_bf16(acc[m][n][2], acc[m][n][3]);
                b2.x = pk_bf16(acc[m][n + 1][0], acc[m][n + 1][1]); b2.y = pk_bf16(acc[m][n + 1][2], acc[m][n + 1][3]);
                const uint4 w = widen16(a, b2);
                const int col = cb + wc * 64 + (n + (fq & 1)) * 16 + (fq >> 1) * 8;
                if (col < lim) *(uint4*)(dst + row * ld + col) = w;
            }
        }
    }
}

__device__ __forceinline__ void unpack8(const uint4 u, float (&f)[8]) {
    f[0] = bf_lo(u.x); f[1] = bf_hi(u.x); f[2] = bf_lo(u.y); f[3] = bf_hi(u.y); f[4] = bf_lo(u.z); f[5] = bf_hi(u.z); f[6] = bf_lo(u.w); f[7] = bf_hi(u.w);
}
__device__ __forceinline__ void p2a_phase(const Params& pin, int l) {
    const Params p = launder(pin); l = launder_i(l);
    const int tid = ltid(), wid = tid >> 6, lane = tid & 63;
    const bf16_t* Hm = (const bf16_t*)(p.ws + OFF_R1);
    const bf16_t* Hc = (const bf16_t*)(p.ws + OFF_R2);
    bf16_t* CV = (bf16_t*)(p.ws + OFF_R5);
    bf16_t* KR = (bf16_t*)(p.ws + OFF_KR);
    float* RSQ = (float*)(p.ws + OFF_RSQ);
    float* RSKV = (float*)(p.ws + OFF_RSKV);
    const float* rope = (const float*)(p.ws + OFF_ROPE);
    const float* cw = p.conv_w + (size_t)l * 3 * 512;
    const int c0 = lane * 8;
    float w0[8], w1[8], w2[8];
#pragma unroll
    for (int i = 0; i < 8; ++i) { w0[i] = cw[c0 + i]; w1[i] = cw[512 + c0 + i]; w2[i] = cw[1024 + c0 + i]; }
    for (int row = blockIdx.x * 8 + wid; row < MROWS; row += gridDim.x * 8) {
        const int pp = row % TPB;
        const bool hp = (pp != 0 && pp != CTXL), hn = (pp != CTXL - 1 && pp != TPB - 1);
        const bf16_t* hr = Hc + (size_t)row * 1536;
        float ch[8], cc[8], cb[8], u0[8], u1[8], u2[8];
        unpack8(*(const uint4*)(hr + c0), ch); unpack8(*(const uint4*)(hr + 1024 + c0), cc); unpack8(*(const uint4*)(hr + 512 + c0), cb);
#pragma unroll
        for (int i = 0; i < 8; ++i) u1[i] = cc[i] * ch[i];
        if (hp) { unpack8(*(const uint4*)(hr - 1536 + c0), ch); unpack8(*(const uint4*)(hr - 1536 + 1024 + c0), cc);
#pragma unroll
            for (int i = 0; i < 8; ++i) u0[i] = cc[i] * ch[i]; }
        else {
#pragma unroll
            for (int i = 0; i < 8; ++i) u0[i] = 0.f; }
        if (hn) { unpack8(*(const uint4*)(hr + 1536 + c0), ch); unpack8(*(const uint4*)(hr + 1536 + 1024 + c0), cc);
#pragma unroll
            for (int i = 0; i < 8; ++i) u2[i] = cc[i] * ch[i]; }
        else {
#pragma unroll
            for (int i = 0; i < 8; ++i) u2[i] = 0.f; }
        float o[8];
#pragma unroll
        for (int i = 0; i < 8; ++i) o[i] = cb[i] * (u0[i] * w0[i] + u1[i] * w1[i] + u2[i] * w2[i]);
        uint4 ov; ov.x = pk_bf16(o[0], o[1]); ov.y = pk_bf16(o[2], o[3]); ov.z = pk_bf16(o[4], o[5]); ov.w = pk_bf16(o[6], o[7]);
        *(uint4*)(CV + (size_t)row * 512 + c0) = ov;
        const bf16_t* hm = Hm + (size_t)row * 672;
        float sq = 0.f, skv = 0.f;
        if (lane < 48) { float f[8]; unpack8(*(const uint4*)(hm + lane * 8), f);
#pragma unroll
            for (int i = 0; i < 8; ++i) sq += f[i] * f[i]; }
        if (lane < 32) { float f[8]; unpack8(*(const uint4*)(hm + 384 + lane * 8), f);
#pragma unroll
            for (int i = 0; i < 8; ++i) skv += f[i] * f[i]; }
        sq = wave_sum(sq); skv = wave_sum(skv);
        RSQ[row] = __builtin_amdgcn_rsqf(sq * (1.0f / 384.0f) + 1e-6f); RSKV[row] = __builtin_amdgcn_rsqf(skv * (1.0f / 256.0f) + 1e-6f);
        {
            const int j = lane & 31;
            float v = bf1(hm[640 + j]);
            const float other = xor8_get(v);
            if (pp >= CTXL) {
                const int tt = pp - CTXL;
                const int pos = (j < 16) ? (tt >> 6) : (tt & 63);
                const float cs = rope[(pos * 8 + (j & 7)) * 2], sn = rope[(pos * 8 + (j & 7)) * 2 + 1];
                v = (j & 8) ? (other * sn + v * cs) : (v * cs - other * sn);
            }
            if (lane < 32) KR[(size_t)row * 32 + j] = (bf16_t)(pk_bf16(v, v) & 0xffffu);
        }
    }
}

__device__ __forceinline__ void p2b_phase(const Params& pin, int l, unsigned char* lds) {
    const Params p = launder(pin); l = launder_i(l); const int tid = ltid();
    const bf16_t* Hm = (const bf16_t*)(p.ws + OFF_R1);
    const bf16_t* W = (const bf16_t*)(p.ws + OFF_W);
    const float* RSQ = (const float*)(p.ws + OFF_RSQ);
    const float* RSKV = (const float*)(p.ws + OFF_RSKV);
    const float* rope = (const float*)(p.ws + OFF_ROPE);
    bf16_t* Q = (bf16_t*)(p.ws + OFF_Q);
    bf16_t* KN = (bf16_t*)(p.ws + OFF_KN);
    bf16_t* VT = (bf16_t*)(p.ws + OFF_VT);
    const int lane = tid & 63, wid = tid >> 6, wr = wid >> 1, wc = wid & 1, fr = lane & 15, fq = lane >> 4;
    const int NQ = 144 * 6, NKV = 144 * 8;
    for (int t = blockIdx.x; t < NQ + NKV; t += gridDim.x) {
        f32x4 acc[4][4]; zero_acc<4>(acc);
        if (t < NQ) {
            int mt, nt; tile_mn(t, 6, mt, nt);
            gemm_mainloop<4, 1>(acc, Hm + (size_t)mt * 256 * 672, 672, 64, W + WO_UQ + (size_t)nt * 128 * 384, 384, 6, lds, tid);
            const int pp0 = (mt % 9) * 256; const bool latent = pp0 >= CTXL;
#pragma unroll
            for (int m = 0; m < 4; ++m) {
                const int lrow = wr * 64 + m * 16 + fr;
                const size_t row = (size_t)mt * 256 + lrow;
                const float sc = RSQ[row] * QSCALE;
                const int tt = pp0 + lrow - CTXL;
                uint2 qpk[4];
#pragma unroll
                for (int n = 0; n < 4; ++n) {
                    const int c16 = nt * 128 + wc * 64 + n * 16, r96 = c16 % 96;
                    float v[4];
#pragma unroll
                    for (int j = 0; j < 4; ++j) v[j] = acc[m][n][j] * sc;
                    if (latent && r96 >= 64) {
                        const int pos = (r96 == 64) ? (tt >> 6) : (tt & 63);
#pragma unroll
                        for (int j = 0; j < 4; ++j) {
                            const float other = xor32_get(v[j], lane);
                            const int fi = (fq & 1) * 4 + j;
                            const float cs = rope[(pos * 8 + fi) * 2], sn = rope[(pos * 8 + fi) * 2 + 1];
                            v[j] = (fq & 2) ? (other * sn + v[j] * cs) : (v[j] * cs - other * sn);
                        }
                    }
                    qpk[n].x = pk_bf16(v[0], v[1]); qpk[n].y = pk_bf16(v[2], v[3]);
                }
#pragma unroll
                for (int n = 0; n < 4; n += 2)
                    *(uint4*)(Q + row * 768 + nt * 128 + wc * 64 + (n + (fq & 1)) * 16 + (fq >> 1) * 8) = widen16(qpk[n], qpk[n + 1]);
            }
        } else {
            int mt, nt; tile_mn(t - NQ, 8, mt, nt);
            gemm_mainloop<4, 2>(acc, Hm + (size_t)mt * 256 * 672 + 384, 672, 64, W + WO_UKV + (size_t)nt * 128 * 256, 256, 4, lds, tid);
            const int b = mt / 9, pp0 = (mt % 9) * 256;
            if (wc == 0) {
#pragma unroll
                for (int m = 0; m < 4; ++m) {
                    const size_t row = (size_t)mt * 256 + wr * 64 + m * 16 + fr;
                    const float sc = RSKV[row];
#pragma unroll
                    for (int n = 0; n < 4; n += 2) {
                        uint2 a, b2;
                        a.x = pk_bf16(acc[m][n][0] * sc, acc[m][n][1] * sc); a.y = pk_bf16(acc[m][n][2] * sc, acc[m][n][3] * sc);
                        b2.x = pk_bf16(acc[m][n + 1][0] * sc, acc[m][n + 1][1] * sc); b2.y = pk_bf16(acc[m][n + 1][2] * sc, acc[m][n + 1][3] * sc);
                        *(uint4*)(KN + row * 512 + nt * 64 + (n + (fq & 1)) * 16 + (fq >> 1) * 8) = widen16(a, b2);
                    }
                }
            } else {
#pragma unroll
                for (int m = 0; m < 4; ++m) {
                    const int lrow = wr * 64 + m * 16 + fq * 4;
                    const f32x4 sc = *(const f32x4*)(RSKV + (size_t)mt * 256 + lrow);
#pragma unroll
                    for (int n = 0; n < 4; n += 2) {
                        uint2 a, b2;
                        a.x = pk_bf16(acc[m][n][0] * sc[0], acc[m][n][1] * sc[1]); a.y = pk_bf16(acc[m][n][2] * sc[2], acc[m][n][3] * sc[3]);
                        b2.x = pk_bf16(acc[m][n + 1][0] * sc[0], acc[m][n + 1][1] * sc[1]); b2.y = pk_bf16(acc[m][n + 1][2] * sc[2], acc[m][n + 1][3] * sc[3]);
                        const int dv = (n + (fq & 1)) * 16 + fr;
                        *(uint4*)(VT + ((size_t)(b * 8 + nt) * 64 + dv) * TPB + pp0 + wr * 64 + m * 16 + (fq >> 1) * 8) = widen16(a, b2);
                    }
                }
            }
        }
    }
    {
        const bf16_t* Hr = (const bf16_t*)(p.ws + OFF_R3);
        bf16_t* SG = (bf16_t*)(p.ws + OFF_SG);
        const float* mu = p.rw_mu + (size_t)l * 1920 + 1792;
        for (int i = blockIdx.x * NTHREADS + tid; i < MROWS * 16; i += gridDim.x * NTHREADS) {
            const int row = i >> 4, c0 = (i & 15) * 8, pp = row % TPB;
            const bool hp = (pp != 0 && pp != CTXL), hn = (pp != CTXL - 1 && pp != TPB - 1);
            const bf16_t* hr = Hr + (size_t)row * 1920 + 1792 + c0;
            float cur[8], pv[8], nx[8];
            unpack8(*(const uint4*)hr, cur);
            if (hp) unpack8(*(const uint4*)(hr - 1920), pv); else {
#pragma unroll
                for (int k = 0; k < 8; ++k) pv[k] = 0.f; }
            if (hn) unpack8(*(const uint4*)(hr + 1920), nx); else {
#pragma unroll
                for (int k = 0; k < 8; ++k) nx[k] = 0.f; }
            float o[8];
#pragma unroll
            for (int k = 0; k < 8; ++k) o[k] = sigmoidf_(cur[k] + (0.5f * (pv[k] + nx[k]) - cur[k]) * mu[c0 + k]);
            uint4 ov; ov.x = pk_bf16(o[0], o[1]); ov.y = pk_bf16(o[2], o[3]); ov.z = pk_bf16(o[4], o[5]); ov.w = pk_bf16(o[6], o[7]);
            *(uint4*)(SG + (size_t)row * 128 + c0) = ov;
        }
    }
}

#define FMAC_BC(acc, coef, s, J) asm("v_fmac_f32_dpp %0, %1, %2 row_newbcast:" #J " row_mask:0xf bank_mask:0xf" : "+v"(acc) : "v"(coef), "v"(s))
#define MUL_BC(dst, coef, s, J) asm("v_mul_f32_dpp %0, %1, %2 row_newbcast:" #J " row_mask:0xf bank_mask:0xf" : "=v"(dst) : "v"(coef), "v"(s))
#define REP16(X) X(0, 0) X(1, 1) X(2, 2) X(3, 3) X(4, 0) X(5, 1) X(6, 2) X(7, 3) X(8, 0) X(9, 1) X(10, 2) X(11, 3) X(12, 0) X(13, 1) X(14, 2) X(15, 3)
constexpr int FSTR = 6 * 64 + 4;
constexpr int CHUNK = 32, NCHUNK = TPB / CHUNK;

__device__ __forceinline__ int scan_pos(int z, int s) { return z == 0 ? s : (s < CTXL ? (CTXL - 1 - s) : (TPB + CTXL - 1 - s)); }

__device__ __forceinline__ void shift4(const bf16_t* hr, bool hp, bool hn, int col, const float* mu, float (&o)[4]) {
    const uint2 c = *(const uint2*)(hr + col);
    uint2 a = make_uint2(0u, 0u), b = make_uint2(0u, 0u);
    if (hp) a = *(const uint2*)(hr - 1920 + col);
    if (hn) b = *(const uint2*)(hr + 1920 + col);
    const f32x4 m = *(const f32x4*)(mu + col);
    const float cv[4] = {bf_lo(c.x), bf_hi(c.x), bf_lo(c.y), bf_hi(c.y)};
    const float av[4] = {bf_lo(a.x), bf_hi(a.x), bf_lo(a.y), bf_hi(a.y)};
    const float bv[4] = {bf_lo(b.x), bf_hi(b.x), bf_lo(b.y), bf_hi(b.y)};
#pragma unroll
    for (int i = 0; i < 4; ++i) o[i] = cv[i] + (0.5f * (av[i] + bv[i]) - cv[i]) * m[i];
}
__device__ __forceinline__ void shift8(const bf16_t* hr, bool hp, bool hn, int col, const float* mu, float (&o)[8]) {
    float cv[8], av[8], bv[8];
    unpack8(*(const uint4*)(hr + col), cv);
    if (hp) unpack8(*(const uint4*)(hr - 1920 + col), av); else {
#pragma unroll
        for (int i = 0; i < 8; ++i) av[i] = 0.f; }
    if (hn) unpack8(*(const uint4*)(hr + 1920 + col), bv); else {
#pragma unroll
        for (int i = 0; i < 8; ++i) bv[i] = 0.f; }
#pragma unroll
    for (int i = 0; i < 8; ++i) o[i] = cv[i] + (0.5f * (av[i] + bv[i]) - cv[i]) * mu[col + i];
}
__device__ __forceinline__ bf16x8 pack8(const float (&f)[8]) {
    union { uint4 u; bf16x8 v; } r;
    r.u.x = pk_bf16(f[0], f[1]); r.u.y = pk_bf16(f[2], f[3]); r.u.z = pk_bf16(f[4], f[5]); r.u.w = pk_bf16(f[6], f[7]);
    return r.v;
}

struct ProdState { f32x4 aw[4], aa[4]; };
struct Raw3x2 { uint2 c, a, b; };
__device__ __forceinline__ Raw3x2 ld3x2(const bf16_t* pc, const bf16_t* pa, const bf16_t* pb, bool hp, bool hn, int col) {
    Raw3x2 r; r.c = *(const uint2*)(pc + col); r.a = *(const uint2*)(pa + col); r.b = *(const uint2*)(pb + col);
    return r;
}
__device__ __forceinline__ void sh4(const Raw3x2& r, const f32x4 m, float (&o)[4]) {
    const float cv[4] = {bf_lo(r.c.x), bf_hi(r.c.x), bf_lo(r.c.y), bf_hi(r.c.y)};
    const float av[4] = {bf_lo(r.a.x), bf_hi(r.a.x), bf_lo(r.a.y), bf_hi(r.a.y)};
    const float bv[4] = {bf_lo(r.b.x), bf_hi(r.b.x), bf_lo(r.b.y), bf_hi(r.b.y)};
#pragma unroll
    for (int i = 0; i < 4; ++i) o[i] = cv[i] + (0.5f * (av[i] + bv[i]) - cv[i]) * m[i];
}
struct Raw3x4 { uint4 c, a, b; };
__device__ __forceinline__ Raw3x4 ld3x4(const bf16_t* pc, const bf16_t* pa, const bf16_t* pb, bool hp, bool hn, int col) {
    Raw3x4 r; r.c = *(const uint4*)(pc + col); r.a = *(const uint4*)(pa + col); r.b = *(const uint4*)(pb + col);
    return r;
}
__device__ __forceinline__ void sh8(const Raw3x4& r, const float* m, float (&o)[8]) {
    float cv[8], av[8], bv[8];
    unpack8(r.c, cv); unpack8(r.a, av); unpack8(r.b, bv);
    const f32x4 m0 = *(const f32x4*)m, m1 = *(const f32x4*)(m + 4);
#pragma unroll
    for (int i = 0; i < 8; ++i) o[i] = cv[i] + (0.5f * (av[i] + bv[i]) - cv[i]) * (i < 4 ? m0[i] : m1[i - 4]);
}
template <int N0>
__device__ __forceinline__ void scan_produce_elem(const float* pl, int fq, const Raw3x2 (&rr)[2], const Raw3x2 (&rk)[2], const Raw3x2 (&rv)[2],
                                                  const f32x4 (&aw)[2], const f32x4 (&aa)[2], float& ss, float* frow) {
#pragma unroll
    for (int nn = 0; nn < 2; ++nn) {
        const int n = N0 + nn;
        const int c4 = n * 16 + fq * 4;
        float r4[4], k4[4], v4[4];
        sh4(rr[nn], *(const f32x4*)(pl + 0 * 64 + c4), r4);
        sh4(rk[nn], *(const f32x4*)(pl + 1 * 64 + c4), k4);
        sh4(rv[nn], *(const f32x4*)(pl + 2 * 64 + c4), v4);
        const f32x4 w0 = *(const f32x4*)(pl + 3 * 64 + c4);
        const f32x4 a0 = *(const f32x4*)(pl + 4 * 64 + c4);
        const f32x4 kkp = *(const f32x4*)(pl + 5 * 64 + c4);
        const f32x4 kap = *(const f32x4*)(pl + 6 * 64 + c4);
        f32x4 dw, kd, kf4, a4;
#pragma unroll
        for (int j = 0; j < 4; ++j) {
            const float sgx = __builtin_amdgcn_rcpf(1.0f + fexp(-(aw[nn][j] + w0[j])));
            dw[j] = fexp(-0.6065306597126334f * sgx);
            const float a = __builtin_amdgcn_rcpf(1.0f + fexp(-(aa[nn][j] + a0[j])));
            a4[j] = a;
            const float kf = k4[j] * kkp[j];
            kf4[j] = kf; ss += kf * kf;
            kd[j] = k4[j] * (1.0f + (a - 1.0f) * kap[j]);
        }
        *(f32x4*)(frow + 0 * 64 + c4) = kf4;
        *(f32x4*)(frow + 1 * 64 + c4) = dw;
        *(f32x4*)(frow + 2 * 64 + c4) = a4;
        *(f32x4*)(frow + 3 * 64 + c4) = kd;
        *(f32x4*)(frow + 4 * 64 + c4) = (f32x4){r4[0], r4[1], r4[2], r4[3]};
        *(f32x4*)(frow + 5 * 64 + c4) = (f32x4){v4[0], v4[1], v4[2], v4[3]};
    }
}
__device__ __forceinline__ void scan_produce_A(const Params& p, const float* pl, int b, int h, int z, int s0, float* frow0, int lane, ProdState& st) {
    const int fr = lane & 15, fq = lane >> 4;
    const int pp = scan_pos(z, s0 + fr);
    const bool hp = (pp != 0 && pp != CTXL), hn = (pp != CTXL - 1 && pp != TPB - 1);
    const bf16_t* hr = (const bf16_t*)(p.ws + OFF_R3) + ((size_t)b * TPB + pp) * 1920;
    const bf16_t* W = (const bf16_t*)(p.ws + OFF_W);
    Raw3x4 qw[2], qa[2];
    const bf16_t* zr = (const bf16_t*)(p.ws + OFF_ZROW) + z * 64 + fq * 8;
    const bf16_t* pc = hr + z * 64 + fq * 8; const bf16_t* pa = hp ? pc - 1920 : zr; const bf16_t* pb = hn ? pc + 1920 : zr;
#pragma unroll
    for (int ks = 0; ks < 2; ++ks) { qw[ks] = ld3x4(pc, pa, pb, hp, hn, 1536 + ks * 32); qa[ks] = ld3x4(pc, pa, pb, hp, hn, 1664 + ks * 32); }
    f32x4 accw[4], acca[4];
#pragma unroll
    for (int n = 0; n < 4; ++n) { accw[n] = (f32x4){0.f, 0.f, 0.f, 0.f}; acca[n] = (f32x4){0.f, 0.f, 0.f, 0.f}; }
#pragma unroll
    for (int ks = 0; ks < 2; ++ks) {
        bf16x8 bw[4], ba[4];
#pragma unroll
        for (int n = 0; n < 4; ++n) {
            const size_t wo = ((size_t)z * 512 + h * 64 + n * 16 + fr) * 64 + ks * 32 + fq * 8;
            bw[n] = *(const bf16x8*)(W + WO_UP + wo); ba[n] = *(const bf16x8*)(W + WO_AUP + wo);
        }
        float t8[8];
        sh8(qw[ks], pl + 7 * 64 + ks * 32 + fq * 8, t8);
#pragma unroll
        for (int i = 0; i < 8; ++i) { const float e = fexp(2.0f * t8[i]); t8[i] = 1.0f - 2.0f * __builtin_amdgcn_rcpf(e + 1.0f); }
        const bf16x8 aw = pack8(t8);
        sh8(qa[ks], pl + 8 * 64 + ks * 32 + fq * 8, t8);
        const bf16x8 aa = pack8(t8);
#pragma unroll
        for (int n = 0; n < 4; ++n) {
            accw[n] = __builtin_amdgcn_mfma_f32_16x16x32_bf16(bw[n], aw, accw[n], 0, 0, 0);
            acca[n] = __builtin_amdgcn_mfma_f32_16x16x32_bf16(ba[n], aa, acca[n], 0, 0, 0);
        }
    }
#pragma unroll
    for (int n = 0; n < 4; ++n) { st.aw[n] = accw[n]; st.aa[n] = acca[n]; }
}
__device__ __forceinline__ void scan_produce_B(const Params& p, const float* pl, int b, int h, int z, int s0, float* frow0, int lane, const ProdState& st) {
    const int fr = lane & 15, fq = lane >> 4;
    const int pp = scan_pos(z, s0 + fr);
    const bool hp = (pp != 0 && pp != CTXL), hn = (pp != CTXL - 1 && pp != TPB - 1);
    const bf16_t* hr = (const bf16_t*)(p.ws + OFF_R3) + ((size_t)b * TPB + pp) * 1920;
    Raw3x2 rr0[2], rk0[2], rv0[2], rr1[2], rk1[2], rv1[2];
    const bf16_t* zr = (const bf16_t*)(p.ws + OFF_ZROW) + h * 64 + fq * 4;
    const bf16_t* pc = hr + h * 64 + fq * 4; const bf16_t* pa = hp ? pc - 1920 : zr; const bf16_t* pb = hn ? pc + 1920 : zr;
#pragma unroll
    for (int nn = 0; nn < 2; ++nn) {
        const int C4 = nn * 16, C5 = C4 + 32;
        rr0[nn] = ld3x2(pc, pa, pb, hp, hn, C4); rk0[nn] = ld3x2(pc, pa, pb, hp, hn, 512 + C4); rv0[nn] = ld3x2(pc, pa, pb, hp, hn, 1024 + C4);
        rr1[nn] = ld3x2(pc, pa, pb, hp, hn, C5); rk1[nn] = ld3x2(pc, pa, pb, hp, hn, 512 + C5); rv1[nn] = ld3x2(pc, pa, pb, hp, hn, 1024 + C5);
    }
    float ss = 0.f;
    float* frow = frow0 + fr * FSTR;
    const f32x4 w01[2] = {st.aw[0], st.aw[1]}, a01[2] = {st.aa[0], st.aa[1]}, w23[2] = {st.aw[2], st.aw[3]}, a23[2] = {st.aa[2], st.aa[3]};
    scan_produce_elem<0>(pl, fq, rr0, rk0, rv0, w01, a01, ss, frow);
    scan_produce_elem<2>(pl, fq, rr1, rk1, rv1, w23, a23, ss, frow);
    ss = fqsum(ss);
    const float inv = __builtin_amdgcn_rsqf(fmaxf(ss, 1e-24f));
#pragma unroll
    for (int n = 0; n < 4; ++n) {
        const int c4 = n * 16 + fq * 4;
        f32x4 kk = *(const f32x4*)(frow + 0 * 64 + c4);
        f32x4 bb = *(const f32x4*)(frow + 2 * 64 + c4);
#pragma unroll
        for (int j = 0; j < 4; ++j) { kk[j] = kk[j] * inv; bb[j] = kk[j] * bb[j]; }
        *(f32x4*)(frow + 0 * 64 + c4) = kk;
        *(f32x4*)(frow + 2 * 64 + c4) = bb;
    }
}

typedef float f32x2 __attribute__((ext_vector_type(2)));
struct ScanHead { f32x4 kk[2]; f32x2 v; };
struct ScanBody { f32x4 w[2], bb[2], kd[2], r[2]; };
__device__ __forceinline__ void scan_ldh(ScanHead& c, const float* f, const float* fv) {
#pragma unroll
    for (int q = 0; q < 2; ++q) c.kk[q] = *(const f32x4*)(f + 0 * 64 + 4 * q);
    c.v = *(const f32x2*)fv;
}
__device__ __forceinline__ void scan_ldb(ScanBody& c, const float* f) {
#pragma unroll
    for (int q = 0; q < 2; ++q) {
        c.w[q] = *(const f32x4*)(f + 1 * 64 + 4 * q); c.bb[q] = *(const f32x4*)(f + 2 * 64 + 4 * q);
        c.kd[q] = *(const f32x4*)(f + 3 * 64 + 4 * q); c.r[q] = *(const f32x4*)(f + 4 * 64 + 4 * q);
    }
}
__device__ __forceinline__ void scan_unit(const Params& p, int l, int u, unsigned char* lds) {
    const int tid = ltid(), wid = __builtin_amdgcn_readfirstlane(tid >> 6), lane = tid & 63;
    const int b = u >> 4, h = (u >> 1) & 7, z = u & 1;
    float* fb = (float*)lds;
    bf16_t* Y = (bf16_t*)(p.ws + (z == 0 ? OFF_YF : OFF_YB));
    float* pl = fb + 3 * CHUNK * FSTR;
    for (int i = tid; i < 9 * 64; i += NTHREADS) {
        const int a = i >> 6, c = i & 63, C = h * 64 + c;
        float v;
        if (a < 3) v = p.rw_mu[(size_t)l * 1920 + a * 512 + C];
        else if (a == 3) v = p.rw_w0[((size_t)l * 2 + z) * 512 + C];
        else if (a == 4) v = p.rw_a0[((size_t)l * 2 + z) * 512 + C];
        else if (a == 5) v = p.rw_k_k[(size_t)l * 512 + C];
        else if (a == 6) v = p.rw_k_a[(size_t)l * 512 + C];
        else if (a == 7) v = p.rw_mu[(size_t)l * 1920 + 1536 + z * 64 + c];
        else v = p.rw_mu[(size_t)l * 1920 + 1664 + z * 64 + c];
        pl[i] = v;
    }
    __syncthreads();
    if (wid < 4) {
        f32x2 S2[8];
#pragma unroll
        for (int j = 0; j < 8; ++j) S2[j] = (f32x2){0.f, 0.f};
        __syncthreads();
        for (int c = 0; c < NCHUNK; ++c) {
            const float* fbc = fb + (c % 3) * CHUNK * FSTR + 8 * (lane & 7);
            const float* fbv = fb + (c % 3) * CHUNK * FSTR + 320 + 16 * wid + 2 * (lane >> 3);
            bf16_t* yp = Y + ((size_t)b * TPB) * 512 + h * 64 + 16 * wid + 2 * (lane >> 3);
            ScanHead ha, hb;
            scan_ldh(ha, fbc, fbv);
#define SCAN_STEP(HC, HN, SL) { \
                ScanBody bd; scan_ldb(bd, fbc + (SL) * FSTR); \
                scan_ldh(HN, fbc + ((SL) + 1) * FSTR, fbv + ((SL) + 1) * FSTR);     \
                f32x2 d0 = (f32x2){0.f, 0.f}, d1 = (f32x2){0.f, 0.f}; \
                _Pragma("unroll") for (int q = 0; q < 4; ++q) { const f32x2 k2 = (f32x2){HC.kk[q >> 1][2 * (q & 1)], HC.kk[q >> 1][2 * (q & 1) + 1]}; \
                    d0 = __builtin_elementwise_fma(S2[q], k2, d0); d1 = __builtin_elementwise_fma(S2[4 + q], k2, d1); } \
                const float sk0 = red8(d0[0] + d0[1]), sk1 = red8(d1[0] + d1[1]); \
                const f32x2 n0 = (f32x2){-sk0, -sk0}, n1 = (f32x2){-sk1, -sk1}, v0 = (f32x2){HC.v[0], HC.v[0]}, v1 = (f32x2){HC.v[1], HC.v[1]}; \
                f32x2 y0 = (f32x2){0.f, 0.f}, y1 = (f32x2){0.f, 0.f}; \
                _Pragma("unroll") for (int q = 0; q < 4; ++q) { \
                    const f32x2 w2 = (f32x2){bd.w[q >> 1][2 * (q & 1)], bd.w[q >> 1][2 * (q & 1) + 1]}, b2 = (f32x2){bd.bb[q >> 1][2 * (q & 1)], bd.bb[q >> 1][2 * (q & 1) + 1]}; \
                    const f32x2 kd2 = (f32x2){bd.kd[q >> 1][2 * (q & 1)], bd.kd[q >> 1][2 * (q & 1) + 1]}, r2 = (f32x2){bd.r[q >> 1][2 * (q & 1)], bd.r[q >> 1][2 * (q & 1) + 1]}; \
                    f32x2 t0 = S2[q] * w2; t0 = __builtin_elementwise_fma(b2, n0, t0); t0 = __builtin_elementwise_fma(kd2, v0, t0); \
                    f32x2 t1 = S2[4 + q] * w2; t1 = __builtin_elementwise_fma(b2, n1, t1); t1 = __builtin_elementwise_fma(kd2, v1, t1); \
                    S2[q] = t0; S2[4 + q] = t1; \
                    y0 = __builtin_elementwise_fma(t0, r2, y0); y1 = __builtin_elementwise_fma(t1, r2, y1); } \
                const float ya = red8(y0[0] + y0[1]), yb = red8(y1[0] + y1[1]); \
                const int pp = scan_pos(z, c * CHUNK + (SL)); \
                *(unsigned*)(yp + (size_t)pp * 512) = pk_bf16(ya, yb); }
#pragma unroll 1
            for (int sl = 0; sl < CHUNK; sl += 2) {
                SCAN_STEP(ha, hb, sl)
                SCAN_STEP(hb, ha, sl + 1)
            }
            __syncthreads();
        }
    } else {
        ProdState st;
#pragma unroll
        for (int n = 0; n < 4; ++n) { st.aw[n] = (f32x4){0.f, 0.f, 0.f, 0.f}; st.aa[n] = (f32x4){0.f, 0.f, 0.f, 0.f}; }
        const int nrep = launder_i(1 + ((PROBE_MASK >> 10) & 1));
        const int pair = (wid - 4) >> 1, ph = (wid - 4) & 1;
        {
            float* f0 = fb + (pair % 3) * CHUNK * FSTR + ph * 16 * FSTR;
            scan_produce_A(p, pl, b, h, z, pair * CHUNK + ph * 16, f0, lane, st);
            if (pair == 0) scan_produce_B(p, pl, b, h, z, ph * 16, f0, lane, st);
        }
        __syncthreads();
        for (int c = 0; c < NCHUNK; ++c) {
            for (int rr_ = 0; rr_ < nrep; ++rr_) {
            if (pair == ((c + 1) & 1)) {
                if (c + 1 < NCHUNK) scan_produce_B(p, pl, b, h, z, (c + 1) * CHUNK + ph * 16, fb + ((c + 1) % 3) * CHUNK * FSTR + ph * 16 * FSTR, lane, st);
            } else {
                if (c + 2 < NCHUNK) scan_produce_A(p, pl, b, h, z, (c + 2) * CHUNK + ph * 16, fb + ((c + 2) % 3) * CHUNK * FSTR + ph * 16 * FSTR, lane, st);
            }
            }
            __syncthreads();
        }
    }
}

constexpr int ATT_STAGE = 20480;
__device__ __forceinline__ void attn_unit(const Params& p, int b, int h, int q0, int nkeys, unsigned char* lds, int do_write) {
    const int tid = ltid(), wid = __builtin_amdgcn_readfirstlane(tid >> 6), lane = tid & 63, fr = lane & 15, fq = lane >> 4;
    bf16_t* Q = (bf16_t*)(p.ws + OFF_Q);
    const bf16_t* KN = (const bf16_t*)(p.ws + OFF_KN);
    const bf16_t* KR = (const bf16_t*)(p.ws + OFF_KR);
    const bf16_t* VT = (const bf16_t*)(p.ws + OFF_VT);
    const size_t rb = (size_t)b * TPB;
    bf16x8 qf[2][3];
#pragma unroll
    for (int nq = 0; nq < 2; ++nq)
#pragma unroll
        for (int ks = 0; ks < 3; ++ks) qf[nq][ks] = *(const bf16x8*)(Q + (rb + q0 + wid * 32 + nq * 16 + fr) * 768 + h * 96 + ks * 32 + fq * 8);
    f32x4 oacc[4][2];
#pragma unroll
    for (int mt = 0; mt < 4; ++mt)
#pragma unroll
        for (int nq = 0; nq < 2; ++nq) oacc[mt][nq] = (f32x4){0.f, 0.f, 0.f, 0.f};
    float mrun[2] = {0.f, 0.f}, lsum[2] = {0.f, 0.f};
    const int c8 = (lane & 7) ^ ((4 * wid + (lane >> 4)) & 7);
    const bf16_t* knp = KN + (rb + 8 * wid + (lane >> 3)) * 512 + h * 64 + c8 * 8;
    const bf16_t* vtp = VT + ((size_t)(b * 8 + h) * 64 + 8 * wid + (lane >> 3)) * TPB + c8 * 8;
    const int c4 = (lane & 3) ^ ((lane >> 4) & 3);
    const bf16_t* krp = KR + (rb + 16 * (wid & 3) + (lane >> 2)) * 32 + c4 * 8;
    auto issue = [&](int t, int stg) {
        unsigned char* base = lds + stg * ATT_STAGE;
        const int k0 = t * 64;
        __builtin_amdgcn_global_load_lds((const GLB_AS unsigned*)(knp + (size_t)k0 * 512), (LDS_AS unsigned*)(base + wid * 1024), 16, 0, 0);
        __builtin_amdgcn_global_load_lds((const GLB_AS unsigned*)(vtp + k0), (LDS_AS unsigned*)(base + 12288 + wid * 1024), 16, 0, 0);
        if (wid < 4) __builtin_amdgcn_global_load_lds((const GLB_AS unsigned*)(krp + (size_t)k0 * 32), (LDS_AS unsigned*)(base + 8192 + wid * 1024), 16, 0, 0);
    };
    const int ntile = nkeys / 64;
    const int kz = fr >> 1, rz = (fr >> 2) & 3;
    issue(0, 0);
    asm volatile("s_waitcnt vmcnt(0)" ::: "memory");
    __builtin_amdgcn_s_barrier();
    asm volatile("" ::: "memory");
    for (int t = 0; t < ntile; ++t) {
        if (t + 1 < ntile) issue(t + 1, (t + 1) & 1);
        const unsigned char* Ks = lds + (t & 1) * ATT_STAGE;
        const unsigned char* Rs = Ks + 8192;
        const unsigned char* Vs = Ks + 12288;
        f32x4 sacc[4][2];
#pragma unroll
        for (int km = 0; km < 4; ++km)
#pragma unroll
            for (int nq = 0; nq < 2; ++nq) sacc[km][nq] = (f32x4){-mrun[nq], -mrun[nq], -mrun[nq], -mrun[nq]};
#pragma unroll
        for (int ks = 0; ks < 3; ++ks)
#pragma unroll
            for (int km = 0; km < 4; ++km) {
                const bf16x8 kf = ks < 2 ? *(const bf16x8*)(Ks + (km * 16 + fr) * 128 + (((ks * 4 + fq) ^ kz) * 16))
                                         : *(const bf16x8*)(Rs + (km * 16 + fr) * 64 + ((fq ^ rz) * 16));
#pragma unroll
                for (int nq = 0; nq < 2; ++nq) sacc[km][nq] = __builtin_amdgcn_mfma_f32_16x16x32_bf16(kf, qf[nq][ks], sacc[km][nq], 0, 0, 0);
            }
        float delta[2];
#pragma unroll
        for (int nq = 0; nq < 2; ++nq) {
            float mx = -1e30f;
#pragma unroll
            for (int km = 0; km < 4; ++km)
#pragma unroll
                for (int j = 0; j < 4; ++j) mx = fmaxf(mx, sacc[km][nq][j]);
            mx = fqmax(mx);
            delta[nq] = (t == 0) ? mx : fmaxf(mx, 0.f);
        }
        const bool exact = (t == 0) || (__builtin_amdgcn_ballot_w64(fmaxf(delta[0], delta[1]) > 60.0f) != 0ull);
        bf16x8 pf[2][2];
        float psum[2];
#pragma unroll
        for (int nq = 0; nq < 2; ++nq) {
            float ps = 0.f;
            if (exact) {
#pragma unroll
                for (int km = 0; km < 4; ++km)
#pragma unroll
                    for (int j = 0; j < 4; ++j) { const float e = __builtin_amdgcn_exp2f(sacc[km][nq][j] - delta[nq]); sacc[km][nq][j] = e; ps += e; }
            } else {
#pragma unroll
                for (int km = 0; km < 4; ++km)
#pragma unroll
                    for (int j = 0; j < 4; ++j) { const float e = __builtin_amdgcn_exp2f(sacc[km][nq][j]); sacc[km][nq][j] = e; ps += e; }
            }
            psum[nq] = ps;
#pragma unroll
            for (int kc = 0; kc < 2; ++kc) {
                union { uint4 u; bf16x8 v; } r;
                r.u.x = pk_bf16(sacc[2 * kc][nq][0], sacc[2 * kc][nq][1]); r.u.y = pk_bf16(sacc[2 * kc][nq][2], sacc[2 * kc][nq][3]);
                r.u.z = pk_bf16(sacc[2 * kc + 1][nq][0], sacc[2 * kc + 1][nq][1]); r.u.w = pk_bf16(sacc[2 * kc + 1][nq][2], sacc[2 * kc + 1][nq][3]);
                pf[kc][nq] = r.v;
            }
        }
        if (exact) {
#pragma unroll
            for (int nq = 0; nq < 2; ++nq) {
                const float alpha = (t == 0) ? 1.0f : __builtin_amdgcn_exp2f(-delta[nq]);
                lsum[nq] = lsum[nq] * alpha + psum[nq];
#pragma unroll
                for (int mt = 0; mt < 4; ++mt) oacc[mt][nq] = oacc[mt][nq] * alpha;
            }
        }
#pragma unroll
        for (int mt = 0; mt < 4; ++mt)
#pragma unroll
            for (int kc = 0; kc < 2; ++kc) {
                union { uint2 h2[2]; bf16x8 v; } r;
                const unsigned char* vrow = Vs + (mt * 16 + fr) * 128 + (fq & 1) * 8;
                r.h2[0] = *(const uint2*)(vrow + (((4 * kc + (fq >> 1)) ^ kz) * 16));
                r.h2[1] = *(const uint2*)(vrow + (((4 * kc + 2 + (fq >> 1)) ^ kz) * 16));
#pragma unroll
                for (int nq = 0; nq < 2; ++nq) oacc[mt][nq] = __builtin_amdgcn_mfma_f32_16x16x32_bf16(r.v, pf[kc][nq], oacc[mt][nq], 0, 0, 0);
            }
        if (!exact) {
#pragma unroll
            for (int nq = 0; nq < 2; ++nq) {
                const float alpha = __builtin_amdgcn_exp2f(-delta[nq]);
                lsum[nq] = (lsum[nq] + psum[nq]) * alpha;
#pragma unroll
                for (int mt = 0; mt < 4; ++mt) oacc[mt][nq] = oacc[mt][nq] * alpha;
            }
        }
#pragma unroll
        for (int nq = 0; nq < 2; ++nq) mrun[nq] += delta[nq];
        asm volatile("s_waitcnt vmcnt(0) lgkmcnt(0)" ::: "memory");
        __builtin_amdgcn_s_barrier();
        asm volatile("" ::: "memory");
    }
#pragma unroll
    for (int nq = 0; nq < 2; ++nq) {
        const float inv = 1.0f / fqsum(lsum[nq]);
        bf16_t* orow = Q + (rb + q0 + wid * 32 + nq * 16 + fr) * 768 + h * 96;
#pragma unroll
        for (int mt = 0; mt < 4; mt += 2) {
            uint2 a, b2;
            a.x = pk_bf16(oacc[mt][nq][0] * inv, oacc[mt][nq][1] * inv); a.y = pk_bf16(oacc[mt][nq][2] * inv, oacc[mt][nq][3] * inv);
            b2.x = pk_bf16(oacc[mt + 1][nq][0] * inv, oacc[mt + 1][nq][1] * inv); b2.y = pk_bf16(oacc[mt + 1][nq][2] * inv, oacc[mt + 1][nq][3] * inv);
            const uint4 w = widen16(a, b2);
            if (do_write) *(uint4*)(orow + (mt + (fq & 1)) * 16 + (fq >> 1) * 8) = w;
        }
    }
}

__device__ __forceinline__ void p3_phase(const Params& pin, int l, unsigned char* lds) {
    const Params p = launder(pin); l = launder_i(l);
    for (int r = 0, nr = launder_i(1 + ((PROBE_MASK >> 1) & 1)); r < nr; ++r)
        for (int u = blockIdx.x; u < 256; u += gridDim.x) scan_unit(p, l, u, lds);
    const int nunits = (l == DEPTH - 1) ? 1024 : 1152;
    for (int r = launder_i(((PROBE_MASK >> 9) & 1) ? 0 : 1); r < 2; ++r)
    for (int u = blockIdx.x; u < nunits; u += gridDim.x) {
        if (u < 1024) { const int bh = u >> 3, qt = u & 7; attn_unit(p, bh >> 3, bh & 7, CTXL + qt * 256, TPB, lds, r); }
        else { const int bh = u - 1024; attn_unit(p, bh >> 3, bh & 7, 0, CTXL, lds, r); }
    }
}

__device__ __forceinline__ void p35_phase(const Params& pin, int l, bool skip_ctx, unsigned char* lds) {
    const Params p = launder(pin); l = launder_i(l); const int tid = ltid();
    const bf16_t* SG = (const bf16_t*)(p.ws + OFF_SG);
    const bf16_t* W = (const bf16_t*)(p.ws + OFF_W) + WO_GUP;
    const bf16_t* YF = (const bf16_t*)(p.ws + OFF_YF);
    const bf16_t* YB = (const bf16_t*)(p.ws + OFF_YB);
    const bf16_t* Hr = (const bf16_t*)(p.ws + OFF_R3);
    bf16_t* RWO = (bf16_t*)(p.ws + OFF_RWO);
    const float* mu = p.rw_mu + (size_t)l * 1920;
    const int lane = tid & 63, wid = tid >> 6, wr = wid >> 1, wc = wid & 1, fr = lane & 15, fq = lane >> 4;
    float* gt = (float*)lds;
    constexpr int GP = 132;
    for (int t = blockIdx.x; t < 288 * 4; t += gridDim.x) {
        int mt, nt; tile_mn(t, 4, mt, nt);
        if (skip_ctx && (mt % 18) < 2) continue;
        f32x4 acc[2][4]; zero_acc<2>(acc);
        gemm_mainloop<2, 1>(acc, SG + (size_t)mt * 128 * 128, 128, 64, W + (size_t)nt * 128 * 128, 128, 2, lds, tid);
#pragma unroll
        for (int m = 0; m < 2; ++m)
#pragma unroll
            for (int n = 0; n < 4; ++n) *(f32x4*)(gt + (wr * 32 + m * 16 + fr) * GP + wc * 64 + n * 16 + fq * 4) = acc[m][n];
        __syncthreads();
        const int pp0 = (mt % 18) * 128;
#pragma unroll 1
        for (int it = 0; it < 4; ++it) {
            const int item = tid + it * NTHREADS, lrow = item >> 4, cg = item & 15, pp = pp0 + lrow;
            const size_t row = (size_t)mt * 128 + lrow;
            const int C = nt * 128 + cg * 8;
            const bool hp = (pp != 0 && pp != CTXL), hn = (pp != CTXL - 1 && pp != TPB - 1);
            const bf16_t* hr = Hr + row * 1920;
            float yf[8], yb[8], r8[8], k8[8], v8[8];
            unpack8(*(const uint4*)(YF + row * 512 + C), yf); unpack8(*(const uint4*)(YB + row * 512 + C), yb);
            shift8(hr, hp, hn, C, mu, r8); shift8(hr, hp, hn, 512 + C, mu, k8); shift8(hr, hp, hn, 1024 + C, mu, v8);
            const float* rkp = p.rw_r_k + (size_t)l * 512 + C;
            float s1 = 0.f, bs = 0.f;
#pragma unroll
            for (int i = 0; i < 8; ++i) { yf[i] += yb[i]; s1 += yf[i]; bs += r8[i] * k8[i] * rkp[i]; }
            s1 = red8(s1); bs = red8(bs);
            const float mean = s1 * (1.0f / 64.0f);
            float s2 = 0.f;
#pragma unroll
            for (int i = 0; i < 8; ++i) { const float d = yf[i] - mean; s2 += d * d; }
            s2 = red8(s2);
            const float rstd = __builtin_amdgcn_rsqf(s2 * (1.0f / 64.0f) + 64e-5f);
            const float* ggp = p.rw_gn_g + (size_t)l * 512 + C; const float* gbp = p.rw_gn_b + (size_t)l * 512 + C;
            const f32x4 g0 = *(const f32x4*)(gt + lrow * GP + cg * 8), g1 = *(const f32x4*)(gt + lrow * GP + cg * 8 + 4);
            float o[8];
#pragma unroll
            for (int i = 0; i < 8; ++i) o[i] = ((yf[i] - mean) * rstd * ggp[i] + gbp[i] + bs * v8[i]) * (i < 4 ? g0[i] : g1[i - 4]);
            uint4 ov; ov.x = pk_bf16(o[0], o[1]); ov.y = pk_bf16(o[2], o[3]); ov.z = pk_bf16(o[4], o[5]); ov.w = pk_bf16(o[6], o[7]);
            *(uint4*)(RWO + row * 512 + C) = ov;
        }
        __syncthreads();
    }
}

__device__ __forceinline__ void p4_phase(const Params& pin, bool skip_ctx, unsigned char* lds) {
    const Params p = launder(pin); const int tid = ltid();
    const bf16_t* XM = (const bf16_t*)(p.ws + OFF_R6);
    const bf16_t* W = (const bf16_t*)(p.ws + OFF_W);
    bf16_t* MG = (bf16_t*)(p.ws + OFF_MRG);
    const int lane = tid & 63, wid = tid >> 6, wr = wid >> 1, wc = wid & 1, fr = lane & 15, fq = lane >> 4;
    for (int t = blockIdx.x; t < 288 * 8; t += gridDim.x) {
        int mt, nt; tile_mn(t, 8, mt, nt);
        if (skip_ctx && (mt % 18) < 2) continue;
        f32x4 g[3][2][4];
#pragma unroll
        for (int i = 0; i < 3; ++i) zero_acc<2>(g[i]);
        gemm_gate3(g, XM + (size_t)mt * 128 * 1024, W + WO_IN + (size_t)(4224 + nt * 128) * 1024, 16, lds, tid);
        typedef __fp16 h16x2 __attribute__((ext_vector_type(2)));
        h16x2 gp[3][2][4][2];
#pragma unroll
        for (int i = 0; i < 3; ++i)
#pragma unroll
            for (int m = 0; m < 2; ++m)
#pragma unroll
                for (int n = 0; n < 4; ++n) {
                    gp[i][m][n][0] = __builtin_amdgcn_cvt_pkrtz(sigmoidf_(g[i][m][n][0]), sigmoidf_(g[i][m][n][1]));
                    gp[i][m][n][1] = __builtin_amdgcn_cvt_pkrtz(sigmoidf_(g[i][m][n][2]), sigmoidf_(g[i][m][n][3]));
                }
        f32x4 mg[2][4]; zero_acc<2>(mg);
#pragma unroll 1
        for (int i = 0; i < 3; ++i) {
            const bf16_t* Ab; int lda, kst; const bf16_t* Wb;
            if (i == 0) { Ab = (const bf16_t*)(p.ws + OFF_Q); lda = 768; kst = 96; Wb = W + WO_OA; }
            else if (i == 1) { Ab = (const bf16_t*)(p.ws + OFF_R5); lda = 512; kst = 64; Wb = W + WO_OC; }
            else { Ab = (const bf16_t*)(p.ws + OFF_RWO); lda = 512; kst = 64; Wb = W + WO_OR; }
            f32x4 a[2][4]; zero_acc<2>(a);
            gemm_mainloop<2, 1>(a, Ab + (size_t)mt * 128 * lda, lda, kst, Wb + (size_t)nt * 128 * 512, 512, 8, lds, tid);
#pragma unroll
            for (int m = 0; m < 2; ++m)
#pragma unroll
                for (int n = 0; n < 4; ++n) {
                    const h16x2 g0 = i == 0 ? gp[0][m][n][0] : (i == 1 ? gp[1][m][n][0] : gp[2][m][n][0]);
                    const h16x2 g1 = i == 0 ? gp[0][m][n][1] : (i == 1 ? gp[1][m][n][1] : gp[2][m][n][1]);
                    mg[m][n][0] += (float)g0[0] * a[m][n][0]; mg[m][n][1] += (float)g0[1] * a[m][n][1];
                    mg[m][n][2] += (float)g1[0] * a[m][n][2]; mg[m][n][3] += (float)g1[1] * a[m][n][3];
                }
        }
#pragma unroll
        for (int m = 0; m < 2; ++m) {
            const size_t row = (size_t)mt * 128 + wr * 32 + m * 16 + fr;
#pragma unroll
            for (int n = 0; n < 4; n += 2) {
                uint2 a, b2;
                a.x = pk_bf16(mg[m][n][0], mg[m][n][1]); a.y = pk_bf16(mg[m][n][2], mg[m][n][3]);
                b2.x = pk_bf16(mg[m][n + 1][0], mg[m][n + 1][1]); b2.y = pk_bf16(mg[m][n + 1][2], mg[m][n + 1][3]);
                *(uint4*)(MG + row * 1024 + nt * 128 + wc * 64 + (n + (fq & 1)) * 16 + (fq >> 1) * 8) = widen16(a, b2);
            }
        }
    }
}

template <int MT>
__device__ __forceinline__ void resid_tile(const Params& p, int l, const bf16_t* A, int lda, int nk, const bf16_t* Wt, int ldb, int goff, bool x_from_input,
                                           const float* lng, const float* lnb, int row0, int nt, unsigned char* lds, int tid) {
    const int lane = tid & 63, wid = tid >> 6, wr = wid >> 1, wc = wid & 1, fr = lane & 15, fq = lane >> 4;
    f32x4 acc[MT][4]; zero_acc<MT>(acc);
    gemm_mainloop<MT, 1>(acc, A + (size_t)row0 * lda, lda, 64, Wt + (size_t)nt * 128 * ldb, ldb, nk, lds, tid);
    const int b = row0 / TPB, pp0 = row0 % TPB;
    const float* gv = modv_ptr(p, l, b, pp0) + goff;
    const float* stats = (const float*)(p.ws + OFF_STATS);
#pragma unroll
    for (int m = 0; m < MT; ++m) {
        const int lr = wr * 16 * MT + m * 16 + fr, pp = pp0 + lr;
        const float* xi = x_rd(p, x_from_input, b, pp);
        float* xo = x_wr(p, b, pp);
        float mean = 0.f, rstd = 1.f;
        if (!x_from_input) { const size_t row = (size_t)row0 + lr; mean = stats[row * 2]; rstd = stats[row * 2 + 1]; }
#pragma unroll
        for (int n = 0; n < 4; ++n) {
            const int col = nt * 128 + wc * 64 + n * 16 + fq * 4;
            f32x4 xv = *(const f32x4*)(xi + col); const f32x4 g4 = *(const f32x4*)(gv + col);
            if (!x_from_input) {
                const f32x4 lg = *(const f32x4*)(lng + col), lb = *(const f32x4*)(lnb + col);
#pragma unroll
                for (int j = 0; j < 4; ++j) xv[j] = (xv[j] - mean) * rstd * lg[j] + lb[j];
            }
            f32x4 o;
#pragma unroll
            for (int j = 0; j < 4; ++j) o[j] = ALPHA * xv[j] + g4[j] * acc[m][n][j];
            *(f32x4*)(xo + col) = o;
        }
    }
}
__device__ __forceinline__ void resid_tile256(const Params& p, int l, const bf16_t* A, int lda, int nk, const bf16_t* Wt, int ldb, int goff, bool x_from_input,
                                              const float* lng, const float* lnb, int row0, int nt256, unsigned char* lds, int tid) {
    const int lane = tid & 63, wid = tid >> 6, wr = wid >> 2, wc = wid & 3, fr = lane & 15, fq = lane >> 4;
    f32x4 acc[8][4]; zero_acc<8>(acc);
    Seg sg; sg.A = A + (size_t)row0 * lda; sg.Bt = Wt + (size_t)nt256 * 256 * ldb; sg.lda = lda; sg.a_kstep = 64; sg.ldb = ldb; sg.nk = nk;
    int st = 0;
    gemm_stream256(acc, sg, sg, false, true, st, lds, tid);
    const int b = row0 / TPB, pp0 = row0 % TPB;
    const float* gv = modv_ptr(p, l, b, pp0) + goff;
    const float* stats = (const float*)(p.ws + OFF_STATS);
#pragma unroll
    for (int m = 0; m < 8; ++m) {
        const int lr = wr * 128 + m * 16 + fr, pp = pp0 + lr;
        const float* xi = x_rd(p, x_from_input, b, pp);
        float* xo = x_wr(p, b, pp);
        float mean = 0.f, rstd = 1.f;
        if (!x_from_input) { const size_t row = (size_t)row0 + lr; mean = stats[row * 2]; rstd = stats[row * 2 + 1]; }
#pragma unroll
        for (int n = 0; n < 4; ++n) {
            const int col = nt256 * 256 + wc * 64 + n * 16 + fq * 4;
            f32x4 xv = *(const f32x4*)(xi + col); const f32x4 g4 = *(const f32x4*)(gv + col);
            if (!x_from_input) {
                const f32x4 lg = *(const f32x4*)(lng + col), lb = *(const f32x4*)(lnb + col);
#pragma unroll
                for (int j = 0; j < 4; ++j) xv[j] = (xv[j] - mean) * rstd * lg[j] + lb[j];
            }
            f32x4 o;
#pragma unroll
            for (int j = 0; j < 4; ++j) o[j] = ALPHA * xv[j] + g4[j] * acc[m][n][j];
            *(f32x4*)(xo + col) = o;
        }
    }
}
__device__ __forceinline__ void resid_gemm_phase(const Params& pin, int l, size_t a_off, int lda, int nk, size_t w_off, int ldb, int goff, bool x_from_input, const float* lng, const float* lnb, bool skip_ctx, unsigned char* lds) {
    const Params p = launder(pin); l = launder_i(l);
    const int tid = ltid();
    const bf16_t* A = (const bf16_t*)(p.ws + a_off);
    const bf16_t* Wt = (const bf16_t*)(p.ws + OFF_W) + w_off;
    if (gridDim.x == 256) {
        for (int t = blockIdx.x; t < 512; t += 256) {
            int mt, nt; tile_mn(t, 4, mt, nt);
            if (skip_ctx && (mt % 9) == 0) continue;
            resid_tile256(p, l, A, lda, nk, Wt, ldb, goff, x_from_input, lng, lnb, mt * 256, nt, lds, tid);
        }
        int mt, nt; tile_mn(512 + (blockIdx.x >> 2), 4, mt, nt);
        const int q = blockIdx.x & 3;
        if (!(skip_ctx && (mt % 9) == 0)) resid_tile<2>(p, l, A, lda, nk, Wt, ldb, goff, x_from_input, lng, lnb, mt * 256 + (q >> 1) * 128, nt * 2 + (q & 1), lds, tid);
    } else {
        for (int t = blockIdx.x; t < 144 * 8; t += gridDim.x) {
            int mt, nt; tile_mn(t, 8, mt, nt);
            if (skip_ctx && (mt % 9) == 0) continue;
            resid_tile<4>(p, l, A, lda, nk, Wt, ldb, goff, x_from_input, lng, lnb, mt * 256, nt, lds, tid);
        }
    }
}

__device__ __forceinline__ void ln_phase(const Params& pin, const float* g, const float* bta, int lmod, int shoff, bool write_xmod, bool write_x, bool skip_ctx) {
    const Params p = launder(pin); lmod = launder_i(lmod);
    const int tid = ltid(), wid = tid >> 6, lane = tid & 63;
    bf16_t* xm = (bf16_t*)(p.ws + OFF_R6);
    float* stats = (float*)(p.ws + OFF_STATS);
    for (int row = blockIdx.x * 8 + wid; row < MROWS; row += gridDim.x * 8) {
        const int b = row / TPB, pp = row % TPB;
        if (skip_ctx && pp < CTXL) continue;
        float* xp = x_wr(p, b, pp);
        f32x4 v[4];
        float s = 0.f;
#pragma unroll
        for (int i = 0; i < 4; ++i) { v[i] = *(const f32x4*)(xp + i * 256 + lane * 4); s += (v[i][0] + v[i][1]) + (v[i][2] + v[i][3]); }
        const float mean = wave_sum(s) * (1.0f / 1024.0f);
        float q = 0.f;
#pragma unroll
        for (int i = 0; i < 4; ++i)
#pragma unroll
            for (int j = 0; j < 4; ++j) { const float d = v[i][j] - mean; q += d * d; }
        const float rstd = __builtin_amdgcn_rsqf(wave_sum(q) * (1.0f / 1024.0f) + 1e-5f);
        *(float2*)(stats + (size_t)row * 2) = make_float2(mean, rstd);
        const float* mv = write_xmod ? modv_ptr(p, lmod, b, pp) + shoff : nullptr;
#pragma unroll
        for (int i = 0; i < 4; ++i) {
            const int c = i * 256 + lane * 4;
            const f32x4 g4 = *(const f32x4*)(g + c), b4 = *(const f32x4*)(bta + c);
            f32x4 o;
#pragma unroll
            for (int j = 0; j < 4; ++j) o[j] = (v[i][j] - mean) * rstd * g4[j] + b4[j];
            if (write_x) *(f32x4*)(xp + c) = o;
            if (write_xmod) {
                const f32x4 sh = *(const f32x4*)(mv + c), sc = *(const f32x4*)(mv + 1024 + c);
                uint2 ov; ov.x = pk_bf16(o[0] * (1.f + sc[0]) + sh[0], o[1] * (1.f + sc[1]) + sh[1]); ov.y = pk_bf16(o[2] * (1.f + sc[2]) + sh[2], o[3] * (1.f + sc[3]) + sh[3]);
                *(uint2*)(xm + (size_t)row * 1024 + c) = ov;
            }
        }
    }
}

__device__ __forceinline__ void p7_phase(const Params& pin, bool skip_ctx, unsigned char* lds) {
    const Params p = launder(pin); const int tid = ltid();
    const bf16_t* A = (const bf16_t*)(p.ws + OFF_R6);
    const bf16_t* W = (const bf16_t*)(p.ws + OFF_W) + WO_13;
    bf16_t* HF = (bf16_t*)(p.ws + OFF_HF);
    const int lane = tid & 63, wid = tid >> 6, wr = wid >> 2, wc = wid & 3, fr = lane & 15, fq = lane >> 4;
    auto seg = [&](int t) { int mt, nt; tile_mn(t, 22, mt, nt); Seg g; g.A = A + (size_t)mt * 256 * 1024; g.Bt = W + (size_t)nt * 256 * 1024; g.lda = 1024; g.a_kstep = 64; g.ldb = 1024; g.nk = 16; return g; };
    auto valid = [&](int t) { int mt, nt; tile_mn(t, 22, mt, nt); return !(skip_ctx && (mt % 9) == 0); };
    auto nextv = [&](int t) { while (t < 144 * 22 && !valid(t)) t += gridDim.x; return t; };
    int st = 0; bool first = true;
    for (int t = nextv(blockIdx.x); t < 144 * 22;) {
        int mt, nt; tile_mn(t, 22, mt, nt);
        const int tn = nextv(t + gridDim.x); const bool hn = tn < 144 * 22;
        f32x4 acc[8][4]; zero_acc<8>(acc);
        gemm_stream256(acc, seg(t), seg(hn ? tn : t), hn, first, st, lds, tid); first = false;
        const int G = nt * 4 + wc;
#pragma unroll
        for (int m = 0; m < 8; ++m) {
            const size_t row = (size_t)mt * 256 + wr * 128 + m * 16 + fr;
            uint2 ov[2];
#pragma unroll
            for (int n = 0; n < 2; ++n) {
                float o[4];
#pragma unroll
                for (int j = 0; j < 4; ++j) o[j] = siluf_(acc[m][n][j]) * acc[m][n + 2][j];
                ov[n].x = pk_bf16(o[0], o[1]); ov[n].y = pk_bf16(o[2], o[3]);
            }
            *(uint4*)(HF + row * DFF + G * 32 + (fq & 1) * 16 + (fq >> 1) * 8) = widen16(ov[0], ov[1]);
        }
        t = tn;
    }
}

__global__ void __launch_bounds__(NTHREADS) fwd_megakernel(Params p) {
    extern __shared__ __attribute__((aligned(16))) unsigned char lds[];
    cg::grid_group grid = cg::this_grid();
    unsigned* gbar = (unsigned*)(p.ws + OFF_BAR); unsigned epoch = 0;
#define GSYNC() grid_barrier(gbar, epoch)
    if (p.ws == nullptr) grid.sync();
    modv_phase(p, lds);
    convert_layer(p, 0, lds);
    {
        bf16_t* Wm = (bf16_t*)(p.ws + OFF_W) + WO_IN + (size_t)672 * 1024;
        for (int i = blockIdx.x * NTHREADS + threadIdx.x; i < 96 * 1024 / 2; i += gridDim.x * NTHREADS) ((unsigned*)Wm)[i] = 0u;
    }
    GSYNC();
    xmod0_phase(p);
    GSYNC();
#pragma unroll 1
    for (int l = 0; l < DEPTH; ++l) {
        const bool last = (l == DEPTH - 1);
        for (int r = 0, nr = launder_i(1 + ((PROBE_MASK >> 2) & 1)); r < nr; ++r) p1_phase(p, lds);
        GSYNC();
        for (int r = 0, nr = launder_i(1 + ((PROBE_MASK >> 3) & 1)); r < nr; ++r) p2a_phase(p, l);
        GSYNC();
        for (int r = 0, nr = launder_i(1 + ((PROBE_MASK >> 4) & 1)); r < nr; ++r) p2b_phase(p, l, lds);
        GSYNC();
        p3_phase(p, l, lds);
        GSYNC();
        for (int r = 0, nr = launder_i(1 + ((PROBE_MASK >> 5) & 1)); r < nr; ++r) p35_phase(p, l, last, lds);
        GSYNC();
        for (int r = 0, nr = launder_i(1 + ((PROBE_MASK >> 6) & 1)); r < nr; ++r) p4_phase(p, last, lds);
        GSYNC();
        resid_gemm_phase(p, l, OFF_MRG, 1024, 16, WO_OUT, 1024, 2048, l == 0, p.ln2_g + (l > 0 ? l - 1 : 0) * 1024, p.ln2_b + (l > 0 ? l - 1 : 0) * 1024, last, lds);
        GSYNC();
        ln_phase(p, p.ln1_g + l * 1024, p.ln1_b + l * 1024, l, 3072, true, false, last);
        GSYNC();
        for (int r = 0, nr = launder_i(1 + ((PROBE_MASK >> 0) & 1)); r < nr; ++r) p7_phase(p, last, lds);
        GSYNC();
        resid_gemm_phase(p, l, OFF_HF, DFF, 44, WO_2, DFF, 5120, false, p.ln1_g + l * 1024, p.ln1_b + l * 1024, last, lds);
        GSYNC();
        ln_phase(p, p.ln2_g + l * 1024, p.ln2_b + l * 1024, last ? l : l + 1, 0, !last, last, last);
        if (!last) for (int r = 0, nr = launder_i(1 + ((PROBE_MASK >> 7) & 1)); r < nr; ++r) convert_layer(p, l + 1, lds);
        for (int r = 0, nr = launder_i(((PROBE_MASK >> 8) & 1) * 10); r < nr; ++r) GSYNC();
        GSYNC();
    }
}

extern "C" void kernel_launch(void* const* d_in, const int* in_sizes, int n_in, void* d_out,
                              int out_size, void* d_ws, size_t ws_size, hipStream_t stream) {
    static int grid_blocks = 0;
    if (!grid_blocks) {
        int dev = 0, cus = 0, per_cu = 0;
        hipGetDevice(&dev);
        hipDeviceGetAttribute(&cus, hipDeviceAttributeMultiprocessorCount, dev);
        if (hipFuncSetAttribute((const void*)fwd_megakernel, hipFuncAttributeMaxDynamicSharedMemorySize, LDS_BYTES) != hipSuccess)
            fprintf(stderr, "hipFuncSetAttribute failed\n");
        hipOccupancyMaxActiveBlocksPerMultiprocessor(&per_cu, (const void*)fwd_megakernel, NTHREADS, LDS_BYTES);
        if (per_cu < 1) fprintf(stderr, "occupancy query says %d blocks/CU\n", per_cu);
        (void)hipGetLastError();
        grid_blocks = cus > 0 ? cus : 256;
        if (ws_size < WS_END) { fprintf(stderr, "workspace too small: %zu < %zu\n", ws_size, (size_t)WS_END); grid_blocks = -1; }
        if (n_in != 33) { fprintf(stderr, "expected 33 inputs, got %d\n", n_in); grid_blocks = -1; }
    }
    if (grid_blocks < 0) return;
    if (hipMemsetAsync((unsigned char*)d_ws + OFF_BAR, 0, 8192, stream) != hipSuccess) fprintf(stderr, "memset failed\n");
    Params p{};
    const float** pp = (const float**)&p;
    for (int i = 0; i < 33; ++i) pp[i] = (const float*)d_in[i];
    p.out = (float*)d_out;
    p.ws = (unsigned char*)d_ws;
    void* args[] = {&p};
    hipError_t e = hipLaunchCooperativeKernel((void*)fwd_megakernel, dim3(grid_blocks), dim3(NTHREADS), args, LDS_BYTES, stream);
    if (e != hipSuccess) fprintf(stderr, "cooperative launch failed: %s (grid %d)\n", hipGetErrorString(e), grid_blocks);
}
```
